# Optimizing an MI355X kernel written in HIP

```python
import math
import jax
import jax.numpy as jnp
from jax import lax
import numpy as np

D_MODEL = 1024
BATCH = 4
SEQ = 8192
DEPTH = 2

GRID_W = 64
CTX_LEN = 256
ROPE_BASE = 10000.0
NORM_EPS = 1e-6
LB_FLOOR = 1e-30
Q_BLOCK = 128
CHUNK = 64

GLA_HEADS = 4
GLA_DK = 32
GLA_DV = 64
GLA_GATE_RANK = 16
GLA_GATE_NORM = 16.0
HG_HEADS = 4
HG_DIM = 64
MLA_HEADS = 4
MLA_Q_RANK = 192
MLA_KV_RANK = 128
MLA_NOPE = 64
MLA_ROPE = 32
MLA_DV = 64
DIFF_HEADS = 4
DIFF_DQK = 32
DIFF_DV = 64
PEER_HEADS = 8
PEER_NKEYS = 128
PEER_N_EXPERTS = PEER_NKEYS * PEER_NKEYS
PEER_DQ = 256
PEER_TOPK = 16
TOKEN_BLOCK = 128

GLA_COLS = (GLA_HEADS * GLA_DK, GLA_HEADS * GLA_DK, GLA_HEADS * GLA_DV, GLA_HEADS * GLA_DV, GLA_GATE_RANK, GLA_GATE_RANK)
HG_COLS = (HG_HEADS * HG_DIM,) * 5
MLA_COLS = (MLA_Q_RANK, MLA_KV_RANK, MLA_ROPE)
DIFF_COLS = (DIFF_HEADS * 2 * DIFF_DQK, DIFF_HEADS * 2 * DIFF_DQK, DIFF_HEADS * DIFF_DV)
MIXER_COLS = (sum(GLA_COLS), sum(HG_COLS), sum(MLA_COLS), sum(DIFF_COLS))
IN_COLS = sum(MIXER_COLS)
MIX_WIDTH = GLA_HEADS * GLA_DV + HG_HEADS * HG_DIM + MLA_HEADS * MLA_DV + DIFF_HEADS * DIFF_DV

kernel_name = 'hybrid_prefix_dit_gla_hgrn2_mla_diff_peer'


def rms_norm(x, g):
    xf = x.astype(jnp.float32)
    y = xf * lax.rsqrt(jnp.mean(xf * xf, axis=-1, keepdims=True) + NORM_EPS)
    return (y * g.astype(jnp.float32)).astype(x.dtype)


def modulate(h, shift, scale):
    return h * (1 + scale) + shift


def split_cols(a, sizes):
    return jnp.split(a, np.cumsum(sizes)[:-1].tolist(), axis=-1)


def to_heads(a, n):
    B, L, _ = a.shape
    return a.reshape(B, L, n, -1).transpose(0, 2, 1, 3)


def bhld(a):
    return a.transpose(0, 2, 1, 3)


def merge_heads(a):
    B, n, L, d = a.shape
    return a.transpose(0, 2, 1, 3).reshape(B, L, n * d)


def rope_1d(x, pos):
    half = x.shape[-1] // 2
    freqs = ROPE_BASE ** (-jnp.arange(half, dtype=jnp.float32) / half)
    ang = pos.astype(jnp.float32)[:, None, None] * freqs
    cos, sin = jnp.cos(ang), jnp.sin(ang)
    x1 = x[..., :half].astype(jnp.float32)
    x2 = x[..., half:].astype(jnp.float32)
    return jnp.concatenate([x1 * cos - x2 * sin, x1 * sin + x2 * cos], axis=-1).astype(x.dtype)


def rope_2d(x, rows, cols):
    h = x.shape[-1] // 2
    return jnp.concatenate([rope_1d(x[..., :h], rows), rope_1d(x[..., h:], cols)], axis=-1)


def blocked_attention(q, k, v, scale):
    B, H, S, dq = q.shape
    dv = v.shape[-1]
    nb = S // Q_BLOCK
    qb = q.reshape(B, H, nb, Q_BLOCK, dq).transpose(2, 0, 1, 3, 4)

    def one(qi):
        s = jnp.einsum('bhqd,bhkd->bhqk', qi, k).astype(jnp.float32) * scale
        p = jax.nn.softmax(s, axis=-1)
        return jnp.einsum('bhqk,bhkv->bhqv', p.astype(v.dtype), v)

    o = lax.map(one, qb)
    return o.transpose(1, 2, 0, 3, 4).reshape(B, H, S, dv)


def gated_chunk_scan(q, k, v, log_g, s0):
    B, H, L, dk = q.shape
    dv = v.shape[-1]
    n = L // CHUNK

    def chunks(a):
        return a.reshape(B, H, n, CHUNK, a.shape[-1]).transpose(2, 0, 1, 3, 4)

    lower = jnp.tril(jnp.ones((CHUNK, CHUNK), dtype=bool))[:, :, None]

    def step(state, inp):
        qi, ki, vi, gi = [a.astype(jnp.float32) for a in inp]
        b = jnp.cumsum(gi, axis=2)
        inter = jnp.einsum('bhtk,bhkv->bhtv', qi * jnp.exp(b), state)
        rel = b[:, :, :, None, :] - b[:, :, None, :, :]
        decay = jnp.where(lower, jnp.exp(jnp.where(lower, rel, 0.0)), 0.0)
        scores = jnp.einsum('bhtk,bhsk,bhtsk->bhts', qi, ki, decay)
        intra = jnp.einsum('bhts,bhsv->bhtv', scores, vi)
        b_end = b[:, :, -1:, :]
        new_state = (jnp.exp(b_end[:, :, 0, :])[..., None] * state
                     + jnp.einsum('bhsk,bhsv->bhkv', ki * jnp.exp(b_end - b), vi))
        return new_state, inter + intra

    s_final, o = lax.scan(step, s0.astype(jnp.float32), (chunks(q), chunks(k), chunks(v), chunks(log_g)))
    o = o.transpose(1, 2, 0, 3, 4).reshape(B, H, L, dv)
    return o.astype(v.dtype), s_final


def bidirectional_prefix_scan(ctx_in, lat_in):
    q_c, kf_c, kb_c, v_c, gf_c, gb_c = ctx_in
    q_l, kf_l, kb_l, v_l, gf_l, gb_l = lat_in
    B, H, _, dk = q_c.shape
    dv = v_c.shape[-1]
    zero = jnp.zeros((B, H, dk, dv), jnp.float32)

    def flip(a):
        return jnp.flip(a, axis=2)

    o_cf, s_f = gated_chunk_scan(q_c, kf_c, v_c, gf_c, zero)
    o_cb, s_b = gated_chunk_scan(flip(q_c), flip(kb_c), flip(v_c), flip(gb_c), zero)
    o_lf, _ = gated_chunk_scan(q_l, kf_l, v_l, gf_l, s_f)
    o_lb, _ = gated_chunk_scan(flip(q_l), flip(kb_l), flip(v_l), flip(gb_l), s_b)
    return o_cf + flip(o_cb), o_lf + flip(o_lb)


def gla_mixer(p_c, p_l, w_gate, b_gate, g_norm, need_ctx):
    def prep(p):
        q, k, v, r, zf, zb = split_cols(p, GLA_COLS)
        gf = jax.nn.log_sigmoid((zf @ w_gate[0] + b_gate[0]).astype(jnp.float32)) / GLA_GATE_NORM
        gb = jax.nn.log_sigmoid((zb @ w_gate[1] + b_gate[1]).astype(jnp.float32)) / GLA_GATE_NORM
        q = to_heads(q * GLA_DK ** -0.5, GLA_HEADS)
        k = to_heads(k, GLA_HEADS)
        return (q, k, k, to_heads(v, GLA_HEADS), to_heads(gf, GLA_HEADS), to_heads(gb, GLA_HEADS)), r

    c_in, r_c = prep(p_c)
    l_in, r_l = prep(p_l)
    o_c, o_l = bidirectional_prefix_scan(c_in, l_in)

    def finish(o, r):
        return merge_heads(rms_norm(o, g_norm)) * jax.nn.silu(r)

    return (finish(o_c, r_c) if need_ctx else None), finish(o_l, r_l)


def hgrn2_mixer(p_c, p_l, lb, g_norm, need_ctx):
    lb = lb.astype(jnp.float32)
    log_lb = jnp.log(jnp.maximum(lb, LB_FLOOR))
    log_1mlb = jnp.log1p(-lb)

    def gates(z):
        z = z.astype(jnp.float32)
        log_f = jnp.logaddexp(log_lb, log_1mlb + jax.nn.log_sigmoid(z))
        k = (1.0 - lb) * jax.nn.sigmoid(-z)
        return to_heads(k, HG_HEADS), to_heads(log_f, HG_HEADS)

    def prep(p):
        q, i, og, zf, zb = split_cols(p, HG_COLS)
        kf, gf = gates(zf)
        kb, gb = gates(zb)
        return (to_heads(jax.nn.silu(q), HG_HEADS), kf, kb, to_heads(i, HG_HEADS), gf, gb), og

    c_in, og_c = prep(p_c)
    l_in, og_l = prep(p_l)
    o_c, o_l = bidirectional_prefix_scan(c_in, l_in)

    def finish(o, og):
        return merge_heads(rms_norm(o, g_norm)) * jax.nn.silu(og)

    return (finish(o_c, og_c) if need_ctx else None), finish(o_l, og_l)


def mla_mixer(p_c, p_l, g_q, g_kv, w_uq, w_ukv, pos, need_ctx):
    def prep(p, grid_pos):
        B, L, _ = p.shape
        c_q, c_kv, k_rope = split_cols(p, MLA_COLS)
        q = (rms_norm(c_q, g_q) @ w_uq).reshape(B, L, MLA_HEADS, MLA_NOPE + MLA_ROPE)
        kv = (rms_norm(c_kv, g_kv) @ w_ukv).reshape(B, L, MLA_HEADS, MLA_NOPE + MLA_DV)
        q_nope, q_rope = q[..., :MLA_NOPE], q[..., MLA_NOPE:]
        k_nope, v = kv[..., :MLA_NOPE], kv[..., MLA_NOPE:]
        k_rope = k_rope[:, :, None, :]
        if grid_pos is not None:
            q_rope = rope_2d(q_rope, *grid_pos)
            k_rope = rope_2d(k_rope, *grid_pos)
        q = jnp.concatenate([q_nope, q_rope], axis=-1)
        k = jnp.concatenate([k_nope, jnp.broadcast_to(k_rope, (B, L, MLA_HEADS, MLA_ROPE))], axis=-1)
        return bhld(q), bhld(k), bhld(v)

    scale = (MLA_NOPE + MLA_ROPE) ** -0.5
    q_c, k_c, v_c = prep(p_c, None)
    q_l, k_l, v_l = prep(p_l, pos)
    o_l = blocked_attention(q_l, jnp.concatenate([k_c, k_l], axis=2), jnp.concatenate([v_c, v_l], axis=2), scale)
    o_c = merge_heads(blocked_attention(q_c, k_c, v_c, scale)) if need_ctx else None
    return o_c, merge_heads(o_l)


def diff_mixer(p_c, p_l, lam_params, g_norm, lambda_init, pos, need_ctx):
    lq1, lk1, lq2, lk2 = lam_params[0], lam_params[1], lam_params[2], lam_params[3]
    lam = (jnp.exp(jnp.sum(lq1 * lk1).astype(jnp.float32)) - jnp.exp(jnp.sum(lq2 * lk2).astype(jnp.float32))
           + lambda_init)

    def prep(p, grid_pos):
        B, L, _ = p.shape
        q, k, v = split_cols(p, DIFF_COLS)
        q = q.reshape(B, L, 2 * DIFF_HEADS, DIFF_DQK)
        k = k.reshape(B, L, 2 * DIFF_HEADS, DIFF_DQK)
        v = jnp.repeat(v.reshape(B, L, DIFF_HEADS, DIFF_DV), 2, axis=2)
        if grid_pos is not None:
            q = rope_2d(q, *grid_pos)
            k = rope_2d(k, *grid_pos)
        return bhld(q), bhld(k), bhld(v)

    def finish(o):
        B, _, L, dv = o.shape
        o = o.reshape(B, DIFF_HEADS, 2, L, dv)
        o = o[:, :, 0] - lam.astype(o.dtype) * o[:, :, 1]
        return merge_heads(rms_norm(o, g_norm) * (1.0 - lambda_init))

    scale = DIFF_DQK ** -0.5
    q_c, k_c, v_c = prep(p_c, None)
    q_l, k_l, v_l = prep(p_l, pos)
    o_l = blocked_attention(q_l, jnp.concatenate([k_c, k_l], axis=2), jnp.concatenate([v_c, v_l], axis=2), scale)
    o_c = finish(blocked_attention(q_c, k_c, v_c, scale)) if need_ctx else None
    return o_c, finish(o_l)


def peer_ffn(h, w_q, keys, u, v):
    B, L, D = h.shape
    tok = h.reshape(-1, TOKEN_BLOCK, D)

    def one(xb):
        T = xb.shape[0]
        q = (xb @ w_q).reshape(T, PEER_HEADS, 2, PEER_DQ // 2)
        s = jnp.einsum('thpd,hpnd->thpn', q, keys).astype(jnp.float32)
        s_top, i_top = lax.top_k(s, PEER_TOPK)
        cand = (s_top[:, :, 0, :, None] + s_top[:, :, 1, None, :]).reshape(T, PEER_HEADS, -1)
        cidx = (i_top[:, :, 0, :, None] * PEER_NKEYS + i_top[:, :, 1, None, :]).reshape(T, PEER_HEADS, -1)
        best, sel = lax.top_k(cand, PEER_TOPK)
        eidx = jnp.take_along_axis(cidx, sel, axis=-1)
        g = jax.nn.softmax(best, axis=-1)
        act = jax.nn.gelu(jnp.einsum('td,thkd->thk', xb, u[eidx]).astype(jnp.float32))
        return jnp.einsum('thk,thkd->td', (g * act).astype(v.dtype), v[eidx]).astype(h.dtype)

    return lax.map(one, tok).reshape(B, L, D)


def setup_inputs(seed: int = 0) -> dict:
    key = jax.random.key(seed)
    ks = jax.random.split(key, 26)
    D = D_MODEL

    def nrm(k, shape, scale):
        return jax.random.normal(k, shape, jnp.float32) * scale

    def gain(k, shape):
        return 1.0 + nrm(k, shape, 0.02)

    return {
        'x': nrm(ks[0], (BATCH, SEQ, D), 1.0),
        'c': nrm(ks[1], (BATCH, D), 1.0),
        'ctx': nrm(ks[2], (BATCH, CTX_LEN, D), 1.0),
        'c_ctx': nrm(ks[3], (D,), 1.0),
        'ada_w': nrm(ks[4], (DEPTH, D, 6 * D), 0.5 * D ** -0.5),
        'ada_b': nrm(ks[5], (DEPTH, 6 * D), 0.02),
        'norm_mix_g': gain(ks[6], (DEPTH, D)),
        'norm_ffn_g': gain(ks[7], (DEPTH, D)),
        'w_in': nrm(ks[8], (DEPTH, D, IN_COLS), D ** -0.5),
        'w_out': nrm(ks[9], (DEPTH, MIX_WIDTH, D), MIX_WIDTH ** -0.5),
        'gla_gate_w': nrm(ks[10], (DEPTH, 2, GLA_GATE_RANK, GLA_HEADS * GLA_DK), GLA_GATE_RANK ** -0.5),
        'gla_gate_b': nrm(ks[11], (DEPTH, 2, GLA_HEADS * GLA_DK), 0.1),
        'gla_norm_g': gain(ks[12], (DEPTH, GLA_DV)),
        'hgrn_lb_raw': nrm(ks[13], (DEPTH, HG_HEADS * HG_DIM), 0.1),
        'hgrn_norm_g': gain(ks[14], (DEPTH, HG_DIM)),
        'mla_q_norm_g': gain(ks[15], (DEPTH, MLA_Q_RANK)),
        'mla_kv_norm_g': gain(ks[16], (DEPTH, MLA_KV_RANK)),
        'mla_w_uq': nrm(ks[17], (DEPTH, MLA_Q_RANK, MLA_HEADS * (MLA_NOPE + MLA_ROPE)), MLA_Q_RANK ** -0.5),
        'mla_w_ukv': nrm(ks[18], (DEPTH, MLA_KV_RANK, MLA_HEADS * (MLA_NOPE + MLA_DV)), MLA_KV_RANK ** -0.5),
        'diff_lambda': nrm(ks[19], (DEPTH, 4, DIFF_DQK), 0.1),
        'diff_norm_g': gain(ks[20], (DEPTH, DIFF_DV)),
        'peer_wq': nrm(ks[21], (DEPTH, D, PEER_HEADS * PEER_DQ), D ** -0.5),
        'peer_keys': nrm(ks[22], (DEPTH, PEER_HEADS, 2, PEER_NKEYS, PEER_DQ // 2), (PEER_DQ // 2) ** -0.5),
        'peer_u': nrm(ks[23], (DEPTH, PEER_N_EXPERTS, D), D ** -0.5),
        'peer_v': nrm(ks[24], (DEPTH, PEER_N_EXPERTS, D), 0.3),
        'final_norm_g': gain(ks[25], (D,)),
    }


def reference(x, c, ctx, c_ctx, ada_w, ada_b, norm_mix_g, norm_ffn_g, w_in, w_out,
              gla_gate_w, gla_gate_b, gla_norm_g, hgrn_lb_raw, hgrn_norm_g,
              mla_q_norm_g, mla_kv_norm_g, mla_w_uq, mla_w_ukv, diff_lambda, diff_norm_g,
              peer_wq, peer_keys, peer_u, peer_v, final_norm_g):
    L = x.shape[1]
    ROWS = L // GRID_W
    rows = jnp.repeat(jnp.arange(ROWS, dtype=jnp.int32), GRID_W)
    cols = jnp.tile(jnp.arange(GRID_W, dtype=jnp.int32), ROWS)
    pos = (rows, cols)

    lb_sm = jax.nn.softmax(hgrn_lb_raw.astype(jnp.float32), axis=0)
    lb_all = jnp.cumsum(lb_sm, axis=0) - lb_sm[0]

    silu_c = jax.nn.silu(c)
    silu_cc = jax.nn.silu(c_ctx)
    xc = ctx
    for l in range(DEPTH):
        need_ctx = l < DEPTH - 1
        lambda_init = 0.8 - 0.6 * math.exp(-0.3 * l)
        mod_l = jnp.split((silu_c @ ada_w[l] + ada_b[l])[:, None, :], 6, axis=-1)
        mod_c = jnp.split(silu_cc @ ada_w[l] + ada_b[l], 6, axis=-1)

        h_l = modulate(rms_norm(x, norm_mix_g[l]), mod_l[0], mod_l[1])
        h_c = modulate(rms_norm(xc, norm_mix_g[l]), mod_c[0], mod_c[1])
        gla_l, hg_l, mla_l, dif_l = split_cols(h_l @ w_in[l], MIXER_COLS)
        gla_c, hg_c, mla_c, dif_c = split_cols(h_c @ w_in[l], MIXER_COLS)

        a_c, a_l = gla_mixer(gla_c, gla_l, gla_gate_w[l], gla_gate_b[l], gla_norm_g[l], need_ctx)
        b_c, b_l = hgrn2_mixer(hg_c, hg_l, lb_all[l], hgrn_norm_g[l], need_ctx)
        m_c, m_l = mla_mixer(mla_c, mla_l, mla_q_norm_g[l], mla_kv_norm_g[l], mla_w_uq[l], mla_w_ukv[l], pos, need_ctx)
        d_c, d_l = diff_mixer(dif_c, dif_l, diff_lambda[l], diff_norm_g[l], lambda_init, pos, need_ctx)

        x = x + mod_l[2] * (jnp.concatenate([a_l, b_l, m_l, d_l], axis=-1) @ w_out[l])
        x = x + mod_l[5] * peer_ffn(modulate(rms_norm(x, norm_ffn_g[l]), mod_l[3], mod_l[4]),
                                    peer_wq[l], peer_keys[l], peer_u[l], peer_v[l])
        if need_ctx:
            xc = xc + mod_c[2] * (jnp.concatenate([a_c, b_c, m_c, d_c], axis=-1) @ w_out[l])
            xc = xc + mod_c[5] * peer_ffn(modulate(rms_norm(xc, norm_ffn_g[l]), mod_c[3], mod_c[4]),
                                          peer_wq[l], peer_keys[l], peer_u[l], peer_v[l])
    return rms_norm(x, final_norm_g)
```

```cpp
#include <hip/hip_runtime.h>
#include <cstdio>
#include <cstdint>

#ifndef MK_PER_PHASE
#define MK_PER_PHASE 1
#endif

constexpr int D = 1024, NB = 4, SEQ = 8192, CTX = 256, DEPTH = 2;
constexpr int RPB = CTX + SEQ;
constexpr int NR = NB * RPB;
constexpr int INC = 3200;
constexpr int GLA_Q = 0, GLA_K = 128, GLA_V = 256, GLA_R = 512, GLA_ZF = 768, GLA_ZB = 784;
constexpr int HG_Q = 800, HG_I = 1056, HG_OG = 1312, HG_ZF = 1568, HG_ZB = 1824;
constexpr int MLA_CQ = 2080, MLA_CKV = 2272, MLA_KR = 2400;
constexpr int DF_Q = 2432, DF_K = 2688, DF_V = 2944;
constexpr int NCHUNK = RPB / 64;
constexpr int NEXP = 16384;
constexpr float NORM_EPS = 1e-6f;

typedef unsigned short bf16_t;
typedef short bf16x8 __attribute__((ext_vector_type(8)));
typedef short s16x4 __attribute__((ext_vector_type(4)));
typedef float f32x16 __attribute__((ext_vector_type(16)));
typedef float f32x4 __attribute__((ext_vector_type(4)));
typedef unsigned u32x4 __attribute__((ext_vector_type(4)));
typedef unsigned u32x2 __attribute__((ext_vector_type(2)));

constexpr size_t al256(size_t x) { return (x + 255) / 256 * 256; }
constexpr size_t WS_CTL = 0;
constexpr size_t CTL_BYTES = 65536;
constexpr size_t WS_MOD = WS_CTL + CTL_BYTES;
constexpr size_t WS_XC = al256(WS_MOD + (size_t)2 * 5 * 6144 * 4);
constexpr size_t WS_WIN = al256(WS_XC + (size_t)NB * CTX * D * 4);
constexpr size_t WS_WOUT = al256(WS_WIN + (size_t)2 * INC * D * 2);
constexpr size_t WS_WQ = al256(WS_WOUT + (size_t)2 * D * D * 2);
constexpr size_t WS_WUQ = al256(WS_WQ + (size_t)2 * 2048 * D * 2);
constexpr size_t WS_WUKV = al256(WS_WUQ + (size_t)2 * 384 * 192 * 2);
constexpr size_t WS_KEYS = al256(WS_WUKV + (size_t)2 * 512 * 128 * 2);
constexpr size_t WS_HB = al256(WS_KEYS + (size_t)2 * 16 * 128 * 128 * 2);
constexpr size_t WS_QM = al256(WS_HB + (size_t)NR * D * 2);
constexpr size_t WS_KVM = al256(WS_QM + (size_t)NR * 384 * 2);
constexpr size_t WS_SG = al256(WS_KVM + (size_t)NR * 512 * 2);
constexpr size_t WS_SH = al256(WS_SG + (size_t)32 * NCHUNK * 2048 * 4);
constexpr size_t WS_DG = al256(WS_SH + (size_t)32 * NCHUNK * 4096 * 4);
constexpr size_t WS_DH = al256(WS_DG + (size_t)32 * NCHUNK * 32 * 4);
constexpr size_t WS_P = al256(WS_DH + (size_t)32 * NCHUNK * 64 * 4);
constexpr size_t WS_END = al256(WS_P + (size_t)NR * INC * 2);
constexpr size_t WS_TU = WS_P;
constexpr size_t WS_TV = WS_P + (size_t)NEXP * D * 2;
constexpr size_t WS_Q2 = WS_TV + (size_t)NEXP * D * 2;
static_assert(WS_Q2 + (size_t)NR * 2048 * 2 <= WS_END, "alias overflow");
constexpr size_t WS_EI = WS_SG;
constexpr size_t WS_EG = WS_EI + (size_t)NR * 128 * 4;
static_assert(WS_EG + (size_t)NR * 128 * 4 <= WS_DG, "alias overflow 2");

#define XB_TMO      128
#define XB_XCNT(j)  (256  + 64 * (j))
#define XB_XSUB(j)  (1280 + 64 * (j))
#define XB_XGEN(j)  (2304 + 64 * (j))
#define XB_TOP      3328
#define XB_TOPGEN   3392
#define XCD_BAR_WORDS 3456
#define XB_SPIN_CAP (1u << 22)
#define LAS __attribute__((address_space(3)))

__device__ __forceinline__ unsigned xb_ld(unsigned* p)              { return __hip_atomic_load(p, __ATOMIC_RELAXED, __HIP_MEMORY_SCOPE_AGENT); }
__device__ __forceinline__ unsigned xb_add(unsigned* p, unsigned v) { return __hip_atomic_fetch_add(p, v, __ATOMIC_RELAXED, __HIP_MEMORY_SCOPE_AGENT); }
__device__ __forceinline__ unsigned xb_xcc_id() { return (unsigned)__builtin_amdgcn_s_getreg((3 << 11) | 20) & 0xFu; }
#define XB_SPIN(cond, bar) do { unsigned _sp = 0; while (cond) { __builtin_amdgcn_s_sleep(1); \
    if ((++_sp & 255u) == 0u) { if (xb_ld(&(bar)[XB_TMO])) break; if (_sp > XB_SPIN_CAP) { atomicAdd(&(bar)[XB_TMO], 1u); break; } } } } while (0)

struct XcdBarrier { unsigned* bar; unsigned x; volatile LAS unsigned* st; };

__device__ __forceinline__ XcdBarrier xcd_barrier_post(unsigned* bar, volatile LAS unsigned* st) {
    XcdBarrier b; b.bar = bar; b.x = xb_xcc_id(); b.st = st;
    if (threadIdx.x == 0) (void)xb_add(&bar[XB_XCNT(b.x)], 1u);
    return b;
}
__device__ __forceinline__ void xcd_barrier_complete(unsigned* bar, unsigned x, unsigned& nloc, unsigned& nx) {
    const unsigned G = gridDim.x * gridDim.y * gridDim.z;
    unsigned sum, cnt, mine, sp = 0u;
    for (;;) {
        sum = 0u; cnt = 0u; mine = 0u;
#pragma unroll
        for (unsigned j = 0; j < 16; ++j) { const unsigned c = xb_ld(&bar[XB_XCNT(j)]); sum += c; cnt += (c > 0u) ? 1u : 0u; mine = (j == x) ? c : mine; }
        if (sum == G) break;
        __builtin_amdgcn_s_sleep(1);
        if ((++sp & 255u) == 0u) { if (xb_ld(&bar[XB_TMO])) break; if (sp > XB_SPIN_CAP) { atomicAdd(&bar[XB_TMO], 1u); break; } }
    }
    nloc = mine > 0u ? mine : 1u; nx = cnt > 0u ? cnt : 1u;
}
__device__ __forceinline__ void xcd_barrier(const XcdBarrier& b) {
    asm volatile("s_waitcnt vmcnt(0)" ::: "memory");
    __syncthreads();
    if (threadIdx.x == 0) {
        unsigned* bar = b.bar;
        __builtin_amdgcn_s_waitcnt(0);
        unsigned nloc = b.st[0], nx = b.st[1];
        if (nloc == 0u) { xcd_barrier_complete(bar, b.x, nloc, nx); b.st[0] = nloc; b.st[1] = nx; }
        const unsigned old = xb_add(&bar[XB_XSUB(b.x)], 1u);
        const unsigned gen = old / nloc;
        if (old + 1u == (gen + 1u) * nloc) {
            __builtin_amdgcn_fence(__ATOMIC_RELEASE, "agent");
            asm volatile("s_waitcnt vmcnt(0)" ::: "memory");
            const unsigned og = xb_add(&bar[XB_TOP], 1u);
            const unsigned tg = og / nx;
            if (og + 1u == (tg + 1u) * nx) xb_add(&bar[XB_TOPGEN], 1u);
            else XB_SPIN(xb_ld(&bar[XB_TOPGEN]) == tg, bar);
            __builtin_amdgcn_fence(__ATOMIC_ACQUIRE, "agent");
            xb_add(&bar[XB_XGEN(b.x)], 1u);
            asm volatile("s_waitcnt vmcnt(0)" ::: "memory");
        } else {
            XB_SPIN(xb_ld(&bar[XB_XGEN(b.x)]) == gen, bar);
            __builtin_amdgcn_fence(__ATOMIC_ACQUIRE, "agent");
            asm volatile("s_waitcnt vmcnt(0)" ::: "memory");
        }
    }
    __syncthreads();
}

typedef __bf16 bf16v2_t __attribute__((ext_vector_type(2)));
typedef float f32v2_t __attribute__((ext_vector_type(2)));
__device__ __forceinline__ unsigned cvtpk(float lo, float hi) { const f32v2_t v = {lo, hi}; const bf16v2_t b = __builtin_convertvector(v, bf16v2_t); return __builtin_bit_cast(unsigned, b); }
__device__ __forceinline__ bf16_t f2bf(float x) { const __bf16 b = (__bf16)x; return __builtin_bit_cast(bf16_t, b); }
__device__ __forceinline__ float bf2f(bf16_t h) { return __uint_as_float(((unsigned)h) << 16); }
__device__ __forceinline__ float bflo(unsigned w) { return __uint_as_float(w << 16); }
__device__ __forceinline__ float bfhi(unsigned w) { return __uint_as_float(w & 0xffff0000u); }
__device__ __forceinline__ float silu_f(float x) { return x / (1.f + __expf(-x)); }
__device__ __forceinline__ float logsigmoid_f(float z) { return fminf(z, 0.f) - log1pf(__expf(-fabsf(z))); }
__device__ __forceinline__ float wave_sum(float v) {
#pragma unroll
    for (int o = 32; o >= 1; o >>= 1) v += __shfl_xor(v, o, 64);
    return v;
}
__device__ __forceinline__ void zero_acc(f32x16& a) {
#pragma unroll
    for (int r = 0; r < 16; ++r) a[r] = 0.f;
    asm volatile("" : "+v"(a));
}
__device__ __forceinline__ int crow(int r, int hi) { return (r & 3) + 8 * (r >> 2) + 4 * hi; }

struct Params { const float* in[26]; float* out; unsigned char* ws; int ph_lo, ph_hi; };
typedef const __attribute__((address_space(4))) Params* KParams;
struct Ctx {
    KParams pp;
    int tid, lane, wid;
};
__device__ __forceinline__ Ctx fresh_ctx() {
    Ctx c; unsigned long long a = (unsigned long long)__builtin_amdgcn_kernarg_segment_ptr(); asm volatile("" : "+s"(a)); c.pp = (KParams)a;
    int t = threadIdx.x; asm volatile("" : "+v"(t)); c.tid = t; c.lane = t & 63; c.wid = __builtin_amdgcn_readfirstlane(t >> 6);
    return c;
}
#define CIN(i)   (c.pp->in[i])
#define COUT     (c.pp->out)
#define CWS(off) (c.pp->ws + (off))
#define C_MODT ((float*)CWS(WS_MOD))
#define C_XC   ((float*)CWS(WS_XC))
#define C_WIN  ((bf16_t*)CWS(WS_WIN))
#define C_WOUT ((bf16_t*)CWS(WS_WOUT))
#define C_WQ   ((bf16_t*)CWS(WS_WQ))
#define C_WUQ  ((bf16_t*)CWS(WS_WUQ))
#define C_WUKV ((bf16_t*)CWS(WS_WUKV))
#define C_KEYS ((bf16_t*)CWS(WS_KEYS))
#define C_HB   ((bf16_t*)CWS(WS_HB))
#define C_QM   ((bf16_t*)CWS(WS_QM))
#define C_KVM  ((bf16_t*)CWS(WS_KVM))
#define C_P    ((bf16_t*)CWS(WS_P))
#define C_TU   ((bf16_t*)CWS(WS_TU))
#define C_TV   ((bf16_t*)CWS(WS_TV))
#define C_Q2   ((bf16_t*)CWS(WS_Q2))
#define C_SG   ((float*)CWS(WS_SG))
#define C_SH   ((float*)CWS(WS_SH))
#define C_DG   ((float*)CWS(WS_DG))
#define C_DH   ((float*)CWS(WS_DH))
#define C_EI   ((int*)CWS(WS_EI))
#define C_EG   ((float*)CWS(WS_EG))

__device__ __forceinline__ float* xrow(const Ctx& c, int r) {
    const int b = r / RPB, j = r - b * RPB;
    return j < CTX ? C_XC + ((size_t)(b * CTX + j) << 10) : COUT + ((size_t)(b * SEQ + (j - CTX)) << 10);
}
__device__ __forceinline__ const float* inrow(const Ctx& c, int r) {
    const int b = r / RPB, j = r - b * RPB;
    return j < CTX ? CIN(2) + ((size_t)(b * CTX + j) << 10) : CIN(0) + ((size_t)(b * SEQ + (j - CTX)) << 10);
}

__device__ void p0_mod_item(const Ctx& c, int item, char* lds) {
    float* sc = (float*)lds;
    float* red = sc + 5 * 1024;
    const int tid = c.tid;
    for (int i = tid; i < 5 * 1024; i += 512) { const int v = i >> 10, k = i & 1023; const float x = (v < 4) ? CIN(1)[v * 1024 + k] : CIN(3)[k]; sc[i] = silu_f(x); }
    __syncthreads();
    const int l = item / 96, n0 = (item % 96) * 64;
    const int col = tid & 63, kg = tid >> 6;
    const float* w = CIN(4) + (size_t)l * 1024 * 6144 + n0 + col;
    float a[5] = {0.f, 0.f, 0.f, 0.f, 0.f};
#pragma unroll 8
    for (int kk = 0; kk < 128; ++kk) { const int k = kg * 128 + kk; const float wv = w[(size_t)k * 6144];
#pragma unroll
        for (int v = 0; v < 5; ++v) a[v] += sc[v * 1024 + k] * wv; }
#pragma unroll
    for (int v = 0; v < 5; ++v) red[(kg * 64 + col) * 5 + v] = a[v];
    __syncthreads();
    if (tid < 320) { const int cc = tid / 5, v = tid % 5; float s = 0.f;
#pragma unroll
        for (int g = 0; g < 8; ++g) s += red[(g * 64 + cc) * 5 + v];
        C_MODT[((size_t)l * 5 + v) * 6144 + n0 + cc] = s + CIN(5)[l * 6144 + n0 + cc]; }
    __syncthreads();
}
__device__ void p0_tr_tile(const float* __restrict__ src, bf16_t* __restrict__ dst, int K, int N, int k0, int n0, int tid, char* lds) {
    float* t = (float*)lds;
#pragma unroll
    for (int i = 0; i < 2; ++i) { const int k = (tid >> 4) + 32 * i, n4 = (tid & 15) * 4;
        const f32x4 v = *(const f32x4*)(src + (size_t)(k0 + k) * N + n0 + n4);
        t[k * 65 + n4 + 0] = v[0]; t[k * 65 + n4 + 1] = v[1]; t[k * 65 + n4 + 2] = v[2]; t[k * 65 + n4 + 3] = v[3]; }
    __syncthreads();
    { const int n = tid >> 3, k8 = (tid & 7) * 8; u32x4 w;
#pragma unroll
        for (int j = 0; j < 4; ++j) w[j] = cvtpk(t[(k8 + 2 * j) * 65 + n], t[(k8 + 2 * j + 1) * 65 + n]);
        *(u32x4*)(dst + (size_t)(n0 + n) * K + k0 + k8) = w; }
    __syncthreads();
}
__device__ void ph_p0(const Ctx& c, char* lds) {
    constexpr int T_WIN = 16 * 50, T_WOUT = 16 * 16, T_WQ = 16 * 32, T_UQ = 3 * 6, T_UKV = 2 * 8;
    constexpr int PER_L = T_WIN + T_WOUT + T_WQ + T_UQ + T_UKV;
    constexpr int NITEM = 192 + 2 * PER_L;
    for (int it = blockIdx.x; it < NITEM; it += gridDim.x) {
        if (it < 192) { p0_mod_item(c, it, lds); continue; }
        int t = it - 192; const int l = t / PER_L; t -= l * PER_L;
        if (t < T_WIN) { p0_tr_tile(CIN(8) + (size_t)l * D * INC, C_WIN + (size_t)l * INC * D, D, INC, (t / 50) * 64, (t % 50) * 64, c.tid, lds); continue; } t -= T_WIN;
        if (t < T_WOUT) { p0_tr_tile(CIN(9) + (size_t)l * D * D, C_WOUT + (size_t)l * D * D, D, D, (t / 16) * 64, (t % 16) * 64, c.tid, lds); continue; } t -= T_WOUT;
        if (t < T_WQ) { p0_tr_tile(CIN(21) + (size_t)l * D * 2048, C_WQ + (size_t)l * 2048 * D, D, 2048, (t / 32) * 64, (t % 32) * 64, c.tid, lds); continue; } t -= T_WQ;
        if (t < T_UQ) { p0_tr_tile(CIN(17) + (size_t)l * 192 * 384, C_WUQ + (size_t)l * 384 * 192, 192, 384, (t / 6) * 64, (t % 6) * 64, c.tid, lds); continue; } t -= T_UQ;
        p0_tr_tile(CIN(18) + (size_t)l * 128 * 512, C_WUKV + (size_t)l * 512 * 128, 128, 512, (t / 8) * 64, (t % 8) * 64, c.tid, lds);
    }
    const size_t nk8 = (size_t)2 * 16 * 128 * 128 / 8;
    for (size_t i = (size_t)blockIdx.x * 512 + c.tid; i < nk8; i += (size_t)gridDim.x * 512) {
        const f32x4 a = *(const f32x4*)(CIN(22) + i * 8), b = *(const f32x4*)(CIN(22) + i * 8 + 4);
        u32x4 w = {cvtpk(a[0], a[1]), cvtpk(a[2], a[3]), cvtpk(b[0], b[1]), cvtpk(b[2], b[3])};
        *(u32x4*)(C_KEYS + i * 8) = w;
    }
}

template <int WHICH>
__device__ void ph_norm(const Ctx& c, int l) {
    const float* g = CIN(WHICH == 0 ? 6 : 7) + l * D;
    const bool need_ctx = (l < DEPTH - 1);
    for (int r = blockIdx.x * 8 + c.wid; r < NR; r += gridDim.x * 8) {
        const int b = r / RPB, j = r - b * RPB; const bool isctx = j < CTX;
        if (WHICH == 1 && isctx && !need_ctx) continue;
        const float* src = (WHICH == 0 && l == 0) ? inrow(c, r) : xrow(c, r);
        f32x4 x[4]; float ss = 0.f;
#pragma unroll
        for (int i = 0; i < 4; ++i) { x[i] = *(const f32x4*)(src + i * 256 + c.lane * 4); ss += x[i][0] * x[i][0] + x[i][1] * x[i][1] + x[i][2] * x[i][2] + x[i][3] * x[i][3]; }
        ss = wave_sum(ss);
        const float rstd = rsqrtf(ss * (1.f / D) + NORM_EPS);
        const float* mt = C_MODT + ((size_t)l * 5 + (isctx ? 4 : b)) * 6144;
        const float* sh = mt + (WHICH == 0 ? 0 : 3) * D; const float* scl = mt + (WHICH == 0 ? 1 : 4) * D;
        bf16_t* dst = C_HB + (size_t)r * D;
        float* xr = xrow(c, r);
#pragma unroll
        for (int i = 0; i < 4; ++i) { const int col = i * 256 + c.lane * 4;
            const f32x4 gv = *(const f32x4*)(g + col), sv = *(const f32x4*)(sh + col), cv = *(const f32x4*)(scl + col);
            float y[4];
#pragma unroll
            for (int e = 0; e < 4; ++e) y[e] = x[i][e] * rstd * gv[e] * (1.f + cv[e]) + sv[e];
            u32x2 w = {cvtpk(y[0], y[1]), cvtpk(y[2], y[3])};
            *(u32x2*)(dst + col) = w;
            if (WHICH == 0 && l == 0) *(f32x4*)(xr + col) = x[i]; }
    }
}

constexpr int GEMM_LDS = 98304;
template <class Epi>
__device__ __forceinline__ void gemm_tile(const Ctx& c, const bf16_t* __restrict__ A, int lda, const bf16_t* __restrict__ Bt, int ldb, int K, int m0, int n0, char* lds, const Epi& epi) {
    const int tid = c.tid, lane = tid & 63, wid = tid >> 6, r32 = lane & 31, hi = lane >> 5, wm = wid >> 1, wn = wid & 1;
    char* As = lds; char* Bs = lds + 65536;
    f32x16 acc[2][2];
#pragma unroll
    for (int m = 0; m < 2; ++m)
#pragma unroll
        for (int n = 0; n < 2; ++n) zero_acc(acc[m][n]);
    u32x4 ra[4], rb[2];
    const int srow = tid >> 3, sch = tid & 7;
    const bf16_t* Ag = A + (size_t)(m0 + srow) * lda + sch * 8;
    const bf16_t* Bg = Bt + (size_t)(n0 + srow) * ldb + sch * 8;
    const int swoff = srow * 128 + ((sch ^ ((srow >> 1) & 7)) << 4);
#define GLOAD(k0) do { _Pragma("unroll") for (int i = 0; i < 4; ++i) ra[i] = *(const u32x4*)(Ag + (size_t)(64 * i) * lda + (k0)); \
                       _Pragma("unroll") for (int i = 0; i < 2; ++i) rb[i] = *(const u32x4*)(Bg + (size_t)(64 * i) * ldb + (k0)); } while (0)
#define SWRITE(buf) do { _Pragma("unroll") for (int i = 0; i < 4; ++i) *(u32x4*)(As + (buf) * 32768 + swoff + i * 8192) = ra[i]; \
                         _Pragma("unroll") for (int i = 0; i < 2; ++i) *(u32x4*)(Bs + (buf) * 16384 + swoff + i * 8192) = rb[i]; } while (0)
    const int nk = K >> 6;
    GLOAD(0); SWRITE(0); __syncthreads();
    for (int kt = 0; kt < nk; ++kt) {
        const int buf = kt & 1;
        if (kt + 1 < nk) GLOAD((kt + 1) * 64);
        const char* Ab = As + buf * 32768; const char* Bb = Bs + buf * 16384;
#pragma unroll
        for (int ks = 0; ks < 4; ++ks) {
            bf16x8 a[2], b[2];
#pragma unroll
            for (int m = 0; m < 2; ++m) { const int row = wm * 64 + m * 32 + r32; a[m] = *(const bf16x8*)(Ab + row * 128 + (((ks * 2 + hi) ^ ((row >> 1) & 7)) << 4)); }
#pragma unroll
            for (int n = 0; n < 2; ++n) { const int row = wn * 64 + n * 32 + r32; b[n] = *(const bf16x8*)(Bb + row * 128 + (((ks * 2 + hi) ^ ((row >> 1) & 7)) << 4)); }
#pragma unroll
            for (int m = 0; m < 2; ++m)
#pragma unroll
                for (int n = 0; n < 2; ++n) acc[m][n] = __builtin_amdgcn_mfma_f32_32x32x16_bf16(a[m], b[n], acc[m][n], 0, 0, 0);
        }
        if (kt + 1 < nk) SWRITE(buf ^ 1);
        __syncthreads();
    }
#undef GLOAD
#undef SWRITE
    epi(acc, m0 + wm * 64, n0 + wn * 64, r32, hi);
}
struct EpiBf16 {
    bf16_t* C; int ldc;
    __device__ __forceinline__ void operator()(const f32x16 (&acc)[2][2], int row0, int col0, int r32, int hi) const {
        bf16_t* base = C + (size_t)(row0 + 4 * hi) * ldc + col0 + r32;
#pragma unroll
        for (int m = 0; m < 2; ++m)
#pragma unroll
            for (int r = 0; r < 16; ++r) { bf16_t* p = base + (size_t)(m * 32 + (r & 3) + 8 * (r >> 2)) * ldc;
                p[0] = f2bf(acc[m][0][r]); p[32] = f2bf(acc[m][1][r]);
                asm volatile("" ::: "memory"); }
    }
};
struct EpiResid {
    const Ctx* c; const float* gate_l;
    __device__ __forceinline__ void operator()(const f32x16 (&acc)[2][2], int row0, int col0, int r32, int hi) const {
        const int b = row0 / RPB, j0 = row0 - b * RPB; const bool isctx = j0 < CTX;
        const float* gt = gate_l + (size_t)(isctx ? 4 : b) * 6144;
        float* xb = xrow(*c, row0);
        const float gv0 = gt[col0 + r32], gv1 = gt[col0 + 32 + r32];
        float* xq = xb + ((size_t)(4 * hi) << 10) + col0 + r32;
#pragma unroll
        for (int m = 0; m < 2; ++m)
#pragma unroll
            for (int r = 0; r < 16; ++r) { float* p = xq + ((size_t)(m * 32 + (r & 3) + 8 * (r >> 2)) << 10);
                const float a0 = p[0], a1 = p[32];
                p[0] = a0 + gv0 * acc[m][0][r]; p[32] = a1 + gv1 * acc[m][1][r];
                asm volatile("" ::: "memory"); }
    }
};

__device__ void ph_gemm_in(const Ctx& c, int l, char* lds) {
    EpiBf16 e{C_P, INC};
    const bf16_t* Bt = C_WIN + (size_t)l * INC * D;
    for (int it = blockIdx.x; it < 132 * 25; it += gridDim.x) { const int tm = it / 25, tn = it % 25; gemm_tile(c, C_HB, D, Bt, D, D, tm * 256, tn * 128, lds, e); }
}

template <int MX> struct ScanCfg;
template <> struct ScanCfg<0> { static constexpr int DK = 32; };
template <> struct ScanCfg<1> { static constexpr int DK = 64; };

template <int MX, bool WANT_Q>
__device__ __forceinline__ void scan_load(const Ctx& c, int l, int b, int h, int cc, int dir, float* qt, float* kt, float* gt, float* vt, float* tmp) {
    constexpr int DK = ScanCfg<MX>::DK, PK = DK + 1;
    const int tid = c.tid;
    const int rbase = b * RPB + cc * 64;
    if (MX == 0) {
        float* zt = tmp; float* wt = tmp + 64 * 16; float* bt = wt + 16 * 32;
        for (int i = tid; i < 64 * 16; i += 512) { const int t = i >> 4, k = i & 15; const int r = rbase + (dir ? 63 - t : t); zt[i] = bf2f(C_P[(size_t)r * INC + (dir ? GLA_ZB : GLA_ZF) + k]); }
        { const int i = tid; const int k = i >> 5, j = i & 31; wt[i] = CIN(10)[(((size_t)l * 2 + dir) * 16 + k) * 128 + h * 32 + j]; }
        if (tid < 32) bt[tid] = CIN(11)[((size_t)l * 2 + dir) * 128 + h * 32 + tid];
        __syncthreads();
        for (int i = tid; i < 64 * 32; i += 512) { const int t = i >> 5, j = i & 31; const int r = rbase + (dir ? 63 - t : t);
            float a = bt[j];
#pragma unroll
            for (int k = 0; k < 16; ++k) a += zt[t * 16 + k] * wt[k * 32 + j];
            gt[t * PK + j] = logsigmoid_f(a) * (1.f / 16.f);
            kt[t * PK + j] = bf2f(C_P[(size_t)r * INC + GLA_K + h * 32 + j]);
            if (WANT_Q) qt[t * PK + j] = bf2f(C_P[(size_t)r * INC + GLA_Q + h * 32 + j]) * 0.17677669529663687f; }
    } else {
        for (int i = tid; i < 64 * 64; i += 512) { const int t = i >> 6, j = i & 63; const int r = rbase + (dir ? 63 - t : t); const int ch = h * 64 + j;
            const float z = bf2f(C_P[(size_t)r * INC + (dir ? HG_ZB : HG_ZF) + ch]);
            float lb = 0.f;
            if (l > 0) { const float r0 = CIN(13)[ch], r1 = CIN(13)[256 + ch]; lb = 1.f / (1.f + __expf(r0 - r1)); }
            const float log_lb = __logf(fmaxf(lb, 1e-30f)), log_1mlb = log1pf(-lb);
            const float ls = logsigmoid_f(z); const float a1 = log_lb, a2 = log_1mlb + ls;
            gt[t * PK + j] = fmaxf(a1, a2) + log1pf(__expf(-fabsf(a1 - a2)));
            kt[t * PK + j] = (1.f - lb) / (1.f + __expf(z));
            if (WANT_Q) qt[t * PK + j] = silu_f(bf2f(C_P[(size_t)r * INC + HG_Q + ch])); }
    }
    for (int i = tid; i < 64 * 64; i += 512) { const int t = i >> 6, j = i & 63; const int r = rbase + (dir ? 63 - t : t);
        vt[t * 65 + j] = bf2f(C_P[(size_t)r * INC + (MX == 0 ? GLA_V : HG_I) + h * 64 + j]); }
    __syncthreads();
    if (tid < DK) { float s = 0.f; for (int t = 0; t < 64; ++t) { s += gt[t * PK + tid]; gt[t * PK + tid] = s; } }
    __syncthreads();
}

template <int MX>
__device__ void scanA_item(const Ctx& c, int l, int b, int h, int cc, int dir, char* lds) {
    constexpr int DK = ScanCfg<MX>::DK, PK = DK + 1, NJ = DK / 8;
    float* kt = (float*)lds; float* gt = kt + 64 * PK; float* vt = gt + 64 * PK; float* tmp = vt + 64 * 65;
    scan_load<MX, false>(c, l, b, h, cc, dir, nullptr, kt, gt, vt, tmp);
    const int tid = c.tid;
    for (int i = tid; i < 64 * DK; i += 512) { const int t = i / DK, k = i % DK; kt[t * PK + k] *= __expf(gt[63 * PK + k] - gt[t * PK + k]); }
    __syncthreads();
    const int ch = (b * 4 + h) * 2 + dir;
    { const int i = tid % DK, j0 = (tid / DK) * NJ; float a[NJ];
#pragma unroll
        for (int j = 0; j < NJ; ++j) a[j] = 0.f;
        for (int t = 0; t < 64; ++t) { const float kv = kt[t * PK + i];
#pragma unroll
            for (int j = 0; j < NJ; ++j) a[j] += kv * vt[t * 65 + j0 + j]; }
        float* S = (MX == 0 ? C_SG : C_SH) + ((size_t)ch * NCHUNK + cc) * (DK * 64) + i * 64 + j0;
#pragma unroll
        for (int j = 0; j < NJ; ++j) S[j] = a[j]; }
    if (tid < DK) (MX == 0 ? C_DG : C_DH)[((size_t)ch * NCHUNK + cc) * DK + tid] = __expf(gt[63 * PK + tid]);
    __syncthreads();
}
__device__ void scanB_item(const Ctx& c, int item) {
    const int e = item * 512 + c.tid;
    const bool hg = e >= 65536; const int ee = hg ? e - 65536 : e;
    const int DK = hg ? 64 : 32; const int per = DK * 64;
    const int ch = ee / per, ij = ee % per, i = ij >> 6; const int dir = ch & 1;
    float* S = (hg ? C_SH : C_SG) + (size_t)ch * NCHUNK * per + ij;
    const float* Dc = (hg ? C_DH : C_DG) + (size_t)ch * NCHUNK * DK + i;
    float st = 0.f;
    for (int n0 = 0; n0 < NCHUNK; n0 += 6) {
        float sv[6], dv[6];
#pragma unroll
        for (int u = 0; u < 6; ++u) { const int n = n0 + u; const int cc = dir ? (n < 4 ? 3 - n : 135 - n) : n; sv[u] = S[(size_t)cc * per]; dv[u] = Dc[(size_t)cc * DK]; }
#pragma unroll
        for (int u = 0; u < 6; ++u) { const int n = n0 + u; const int cc = dir ? (n < 4 ? 3 - n : 135 - n) : n; S[(size_t)cc * per] = st; st = dv[u] * st + sv[u]; }
    }
}
template <int MX>
__device__ void scanC_item(const Ctx& c, int l, int b, int h, int cc, char* lds) {
    constexpr int DK = ScanCfg<MX>::DK, PK = DK + 1;
    float* qt = (float*)lds; float* kt = qt + 64 * PK; float* gt = kt + 64 * PK; float* vt = gt + 64 * PK; float* sin_ = vt + 64 * 65;
    float* sc = sin_ + DK * 64; float* ot = sc + 64 * 65; float* tmp = ot + 64 * 65;
    const int tid = c.tid;
    for (int i = tid; i < 64 * 65; i += 512) ot[i] = 0.f;
    for (int dir = 0; dir < 2; ++dir) {
        scan_load<MX, true>(c, l, b, h, cc, dir, qt, kt, gt, vt, tmp);
        const int ch = (b * 4 + h) * 2 + dir;
        const float* Sg = (MX == 0 ? C_SG : C_SH) + ((size_t)ch * NCHUNK + cc) * (DK * 64);
        for (int i = tid; i < DK * 64; i += 512) sin_[i] = Sg[i];
        { const int t = tid >> 3, s0 = tid & 7; float a[8];
#pragma unroll
            for (int m = 0; m < 8; ++m) a[m] = 0.f;
            for (int k = 0; k < DK; ++k) { const float qv = qt[t * PK + k], bv = gt[t * PK + k];
#pragma unroll
                for (int m = 0; m < 8; ++m) { const int s = s0 + 8 * m; const float e = __expf(fminf(bv - gt[s * PK + k], 0.f)); a[m] += qv * kt[s * PK + k] * e; } }
#pragma unroll
            for (int m = 0; m < 8; ++m) { const int s = s0 + 8 * m; sc[t * 65 + s] = (s <= t) ? a[m] : 0.f; } }
        __syncthreads();
        { const int t = tid >> 3, j0 = (tid & 7) * 8; float a[8];
#pragma unroll
            for (int j = 0; j < 8; ++j) a[j] = 0.f;
            for (int k = 0; k < DK; ++k) { const float qv = qt[t * PK + k] * __expf(gt[t * PK + k]);
#pragma unroll
                for (int j = 0; j < 8; ++j) a[j] += qv * sin_[k * 64 + j0 + j]; }
            for (int s = 0; s <= t; ++s) { const float sv = sc[t * 65 + s];
#pragma unroll
                for (int j = 0; j < 8; ++j) a[j] += sv * vt[s * 65 + j0 + j]; }
            const int to = dir ? 63 - t : t;
#pragma unroll
            for (int j = 0; j < 8; ++j) ot[to * 65 + j0 + j] += a[j]; }
        __syncthreads();
    }
    { const int t = tid >> 3, j0 = (tid & 7) * 8; float o[8]; float ss = 0.f;
#pragma unroll
        for (int j = 0; j < 8; ++j) { o[j] = ot[t * 65 + j0 + j]; ss += o[j] * o[j]; }
        ss += __shfl_xor(ss, 1, 64); ss += __shfl_xor(ss, 2, 64); ss += __shfl_xor(ss, 4, 64);
        const float rstd = rsqrtf(ss * (1.f / 64.f) + NORM_EPS);
        const int r = b * RPB + cc * 64 + t;
        const float* gn = CIN(MX == 0 ? 12 : 14) + l * 64;
        const bf16_t* gp = C_P + (size_t)r * INC + (MX == 0 ? GLA_R : HG_OG) + h * 64 + j0;
        float y[8];
#pragma unroll
        for (int j = 0; j < 8; ++j) y[j] = o[j] * rstd * gn[j0 + j] * silu_f(bf2f(gp[j]));
        u32x4 w = {cvtpk(y[0], y[1]), cvtpk(y[2], y[3]), cvtpk(y[4], y[5]), cvtpk(y[6], y[7])};
        *(u32x4*)(C_HB + (size_t)r * D + MX * 256 + h * 64 + j0) = w; }
    __syncthreads();
}

__device__ __forceinline__ void rope_cs(int pos, int i, float& cs, float& sn) {
    const float freq = __expf(-(float)i * (9.210340371976184f / 8.f));
    const float ang = (float)pos * freq;
    const float n = rintf(ang * 0.15915494309189535f);
    float rr = fmaf(-n, 6.2831854820251465f, ang); rr = fmaf(-n, -1.7484555e-7f, rr);
    cs = __cosf(rr); sn = __sinf(rr);
}

__device__ void ph_prep_rows(const Ctx& c, int l) {
    const float* gq = CIN(15) + l * 192; const float* gkv = CIN(16) + l * 128;
    for (int r = blockIdx.x * 8 + c.wid; r < NR; r += gridDim.x * 8) {
        const int b = r / RPB, j = r - b * RPB; bf16_t* pr = C_P + (size_t)r * INC;
        { float v[3]; float ss = 0.f;
#pragma unroll
            for (int i = 0; i < 3; ++i) { v[i] = bf2f(pr[MLA_CQ + c.lane + 64 * i]); ss += v[i] * v[i]; }
            ss = wave_sum(ss); const float rstd = rsqrtf(ss * (1.f / 192.f) + NORM_EPS);
#pragma unroll
            for (int i = 0; i < 3; ++i) pr[MLA_CQ + c.lane + 64 * i] = f2bf(v[i] * rstd * gq[c.lane + 64 * i]); }
        { float v[2]; float ss = 0.f;
#pragma unroll
            for (int i = 0; i < 2; ++i) { v[i] = bf2f(pr[MLA_CKV + c.lane + 64 * i]); ss += v[i] * v[i]; }
            ss = wave_sum(ss); const float rstd = rsqrtf(ss * (1.f / 128.f) + NORM_EPS);
#pragma unroll
            for (int i = 0; i < 2; ++i) pr[MLA_CKV + c.lane + 64 * i] = f2bf(v[i] * rstd * gkv[c.lane + 64 * i]); }
        if (j >= CTX) { const int t = j - CTX; const int prow = t >> 6, pcol = t & 63;
            for (int pp = c.lane; pp < 34 * 8; pp += 64) { const int g = pp >> 3, i = pp & 7;
                int col; if (g < 16) col = DF_Q + (g >> 1) * 32 + (g & 1) * 16; else if (g < 32) col = DF_K + ((g - 16) >> 1) * 32 + (g & 1) * 16; else col = MLA_KR + (g - 32) * 16;
                float cs, sn; rope_cs((g & 1) ? pcol : prow, i, cs, sn);
                const float x1 = bf2f(pr[col + i]), x2 = bf2f(pr[col + 8 + i]);
                pr[col + i] = f2bf(x1 * cs - x2 * sn); pr[col + 8 + i] = f2bf(x1 * sn + x2 * cs); } }
    }
}
__device__ void ph_rope_q(const Ctx& c) {
    for (int r = blockIdx.x * 8 + c.wid; r < NR; r += gridDim.x * 8) {
        const int b = r / RPB, j = r - b * RPB; if (j < CTX) continue;
        const int t = j - CTX; const int prow = t >> 6, pcol = t & 63;
        const int h = c.lane >> 4, g = (c.lane >> 3) & 1, i = c.lane & 7;
        bf16_t* q = C_QM + (size_t)r * 384 + h * 96 + 64 + g * 16;
        float cs, sn; rope_cs(g ? pcol : prow, i, cs, sn);
        const float x1 = bf2f(q[i]), x2 = bf2f(q[8 + i]);
        q[i] = f2bf(x1 * cs - x2 * sn); q[8 + i] = f2bf(x1 * sn + x2 * cs);
    }
}

__device__ __forceinline__ int v_st(int k, int cidx) { const int kk = (k & ~0xC) | ((k & 4) << 1) | ((k & 8) >> 1); return ((kk >> 3) * 2 + (cidx >> 5)) * 512 + ((kk & 7) * 32 + (cidx & 31)) * 2; }
__device__ __forceinline__ int v_rd_base(int lane) { return ((lane & 3) << 3) | (((lane >> 2) & 3) << 6) | (((lane >> 4) & 1) << 5) | (((lane >> 5) & 1) << 8); }
constexpr int v_rd_off(int d0, int ks, int half) { return d0 * 512 + ks * 2048 + half * 1024; }
template <int OFF> __device__ __forceinline__ s16x4 tr_read(int vb) { s16x4 r; asm volatile("ds_read_b64_tr_b16 %0, %1 offset:%2" : "=&v"(r) : "v"(vb), "i"(OFF) : "memory"); return r; }
template <int D0> __device__ __forceinline__ void pv_one(f32x16& od, int vb, bf16x8 pa0, bf16x8 pa1, bf16x8 pa2, bf16x8 pa3) {
    const s16x4 l0 = tr_read<v_rd_off(D0, 0, 0)>(vb), h0 = tr_read<v_rd_off(D0, 0, 1)>(vb), l1 = tr_read<v_rd_off(D0, 1, 0)>(vb), h1 = tr_read<v_rd_off(D0, 1, 1)>(vb);
    const s16x4 l2 = tr_read<v_rd_off(D0, 2, 0)>(vb), h2 = tr_read<v_rd_off(D0, 2, 1)>(vb), l3 = tr_read<v_rd_off(D0, 3, 0)>(vb), h3 = tr_read<v_rd_off(D0, 3, 1)>(vb);
    asm volatile("s_waitcnt lgkmcnt(0)" ::: "memory"); __builtin_amdgcn_sched_barrier(0);
#define PKV(L, H) (bf16x8){L[0], L[1], L[2], L[3], H[0], H[1], H[2], H[3]}
    od = __builtin_amdgcn_mfma_f32_32x32x16_bf16(pa0, PKV(l0, h0), od, 0, 0, 0);
    od = __builtin_amdgcn_mfma_f32_32x32x16_bf16(pa1, PKV(l1, h1), od, 0, 0, 0);
    od = __builtin_amdgcn_mfma_f32_32x32x16_bf16(pa2, PKV(l2, h2), od, 0, 0, 0);
    od = __builtin_amdgcn_mfma_f32_32x32x16_bf16(pa3, PKV(l3, h3), od, 0, 0, 0);
#undef PKV
}
constexpr float ATT_THR = 8.f;
__device__ __forceinline__ void softmax_tile(f32x16& p0, f32x16& p1, float& m_reg, float& l_reg, float& alpha, const float C, const float thr,
                                             bf16x8& pa0, bf16x8& pa1, bf16x8& pa2, bf16x8& pa3) {
    float pmax = p0[0];
#pragma unroll
    for (int r = 1; r < 16; ++r) pmax = fmaxf(pmax, p0[r]);
#pragma unroll
    for (int r = 0; r < 16; ++r) pmax = fmaxf(pmax, p1[r]);
    { auto rr = __builtin_amdgcn_permlane32_swap(__float_as_uint(pmax), __float_as_uint(pmax), false, false); pmax = fmaxf(__uint_as_float(rr[0]), __uint_as_float(rr[1])); }
    float mn;
    if (__builtin_expect(__all(pmax - m_reg <= thr), 1)) { mn = m_reg; alpha = 1.f; }
    else { mn = fmaxf(m_reg, pmax); alpha = __builtin_amdgcn_exp2f((m_reg - mn) * C); m_reg = mn; }
    const float mnC = -mn * C;
    float ps = 0.f;
#pragma unroll
    for (int r = 0; r < 16; ++r) { p0[r] = __builtin_amdgcn_exp2f(fmaf(p0[r], C, mnC)); ps += p0[r]; }
#pragma unroll
    for (int r = 0; r < 16; ++r) { p1[r] = __builtin_amdgcn_exp2f(fmaf(p1[r], C, mnC)); ps += p1[r]; }
    { auto rr = __builtin_amdgcn_permlane32_swap(__float_as_uint(ps), __float_as_uint(ps), false, false); ps = __uint_as_float(rr[0]) + __uint_as_float(rr[1]); }
    l_reg = l_reg * alpha + ps;
#define PK4(P, BASE, OUT) do { unsigned a0 = cvtpk(P[BASE + 0], P[BASE + 1]), a1 = cvtpk(P[BASE + 2], P[BASE + 3]);   \
    unsigned b0 = cvtpk(P[BASE + 4], P[BASE + 5]), b1 = cvtpk(P[BASE + 6], P[BASE + 7]);                              \
    auto r0 = __builtin_amdgcn_permlane32_swap(a0, b0, false, false); auto r1 = __builtin_amdgcn_permlane32_swap(a1, b1, false, false); \
    u32x4 w = {r0[0], r1[0], r0[1], r1[1]}; OUT = *reinterpret_cast<bf16x8*>(&w); } while (0)
    PK4(p0, 0, pa0); PK4(p0, 8, pa1); PK4(p1, 0, pa2); PK4(p1, 8, pa3);
#undef PK4
}

constexpr int ATT_LDS = 2 * 16384 + 8192 + 8 * 64 * 4;
template <bool DIFF>
__device__ void attn_item(const Ctx& c, int l, int b, int hd, int qrow0, int krow0, int nkeys, char* lds) {
    constexpr int DQK = DIFF ? 32 : 96, NMAP = DIFF ? 2 : 1, ND0 = DQK / 16;
    constexpr int KP = DIFF ? 64 : 256;
    constexpr int KSZ = 64 * KP;
    const int tid = c.tid, lane = c.lane, wid = c.wid, r32 = lane & 31, hi = lane >> 5;
    char* K_lds = lds; char* V_lds = lds + 2 * 16384; float* wsl = (float*)(lds + 2 * 16384 + 8192) + wid * 64;
    const float scale = DIFF ? 0.17677669529663687f : 0.10206207261596575f;
    const float C = scale * 1.4426950408889634f, thr = ATT_THR / scale;
    bf16x8 qr[NMAP][ND0];
    { const int qrow = qrow0 + wid * 32 + r32;
#pragma unroll
        for (int m = 0; m < NMAP; ++m)
#pragma unroll
            for (int d0 = 0; d0 < ND0; ++d0) {
                const bf16_t* p = DIFF ? C_P + (size_t)qrow * INC + DF_Q + (hd * 2 + m) * 32 + d0 * 16 + hi * 8
                                       : C_QM + (size_t)qrow * 384 + hd * 96 + d0 * 16 + hi * 8;
                qr[m][d0] = *(const bf16x8*)p; } }
    f32x16 o[NMAP][2]; float m_reg[NMAP], l_reg[NMAP];
#pragma unroll
    for (int m = 0; m < NMAP; ++m) { m_reg[m] = -1e30f; l_reg[m] = 0.f;
#pragma unroll
        for (int d = 0; d < 2; ++d) zero_acc(o[m][d]); }
    const int vkey = tid >> 3, vch = tid & 7; const int vdst = v_st(vkey, vch * 8);
    u32x4 kreg0, kreg1, vreg;
    const int k0key = DIFF ? ((tid & 255) >> 2) : (tid / 12), k0ch = DIFF ? (tid & 3) : (tid % 12);
    const int k1key = (tid + 512) / 12, k1ch = (tid + 512) % 12; const bool k1on = (!DIFF) && (tid + 512 < 768);
    auto ksrc = [&](int key, int ch, int kr) -> const bf16_t* {
        const size_t r = (size_t)(kr + key);
        if (DIFF) return C_P + r * INC + DF_K + (hd * 2 + (tid >> 8)) * 32 + ch * 8;
        return (ch < 8) ? C_KVM + r * 512 + hd * 128 + ch * 8 : C_P + r * INC + MLA_KR + (ch - 8) * 8; };
    auto kdst = [&](int key, int ch) -> int {
        if (DIFF) return (tid >> 8) * KSZ + key * 64 + ((ch ^ ((key >> 2) & 3)) << 4);
        return key * 256 + ((ch * 16) ^ ((key & 7) << 4)); };
    const int kd0 = kdst(k0key, k0ch), kd1 = kdst(k1key, k1ch);
    const int vb = (int)(uintptr_t)V_lds + v_rd_base(lane);
#define ALOAD(kr) do { kreg0 = *(const u32x4*)ksrc(k0key, k0ch, (kr)); if (k1on) kreg1 = *(const u32x4*)ksrc(k1key, k1ch, (kr)); \
        vreg = *(const u32x4*)(DIFF ? C_P + (size_t)((kr) + vkey) * INC + DF_V + hd * 64 + vch * 8 : C_KVM + (size_t)((kr) + vkey) * 512 + hd * 128 + 64 + vch * 8); } while (0)
    const int NT = nkeys >> 6;
    ALOAD(krow0);
    for (int j = 0; j < NT; ++j) {
        __syncthreads();
        *(u32x4*)(K_lds + kd0) = kreg0; if (k1on) *(u32x4*)(K_lds + kd1) = kreg1; *(u32x4*)(V_lds + vdst) = vreg;
        __syncthreads();
        if (j + 1 < NT) ALOAD(krow0 + (j + 1) * 64);
#pragma unroll
        for (int m = 0; m < NMAP; ++m) {
            f32x16 p0, p1; zero_acc(p0); zero_acc(p1);
            const char* Kb = K_lds + m * KSZ;
#pragma unroll
            for (int d0 = 0; d0 < ND0; ++d0) {
                bf16x8 b0, b1;
                if (DIFF) { const int ch = d0 * 2 + hi; const int ra = r32, rb = 32 + r32;
                    b0 = *(const bf16x8*)(Kb + ra * 64 + ((ch ^ ((ra >> 2) & 3)) << 4)); b1 = *(const bf16x8*)(Kb + rb * 64 + ((ch ^ ((rb >> 2) & 3)) << 4)); }
                else { const int cb = d0 * 32 + hi * 16; const int ra = r32, rb = 32 + r32;
                    b0 = *(const bf16x8*)(Kb + ra * 256 + (cb ^ ((ra & 7) << 4))); b1 = *(const bf16x8*)(Kb + rb * 256 + (cb ^ ((rb & 7) << 4))); }
                p0 = __builtin_amdgcn_mfma_f32_32x32x16_bf16(b0, qr[m][d0], p0, 0, 0, 0);
                p1 = __builtin_amdgcn_mfma_f32_32x32x16_bf16(b1, qr[m][d0], p1, 0, 0, 0);
            }
            float alpha; bf16x8 pa0, pa1, pa2, pa3;
            softmax_tile(p0, p1, m_reg[m], l_reg[m], alpha, C, thr, pa0, pa1, pa2, pa3);
            if (__any(alpha < 1.f)) {
                if (hi == 0) wsl[r32] = alpha;
                asm volatile("s_waitcnt lgkmcnt(0)" ::: "memory");
#pragma unroll
                for (int r = 0; r < 16; ++r) { const float av = wsl[crow(r, hi)]; o[m][0][r] *= av; o[m][1][r] *= av; }
            }
            pv_one<0>(o[m][0], vb, pa0, pa1, pa2, pa3);
            pv_one<1>(o[m][1], vb, pa0, pa1, pa2, pa3);
        }
    }
#undef ALOAD
    float rli[NMAP][16];
#pragma unroll
    for (int m = 0; m < NMAP; ++m) {
        asm volatile("s_waitcnt lgkmcnt(0)" ::: "memory");
        if (hi == 0) wsl[r32] = l_reg[m];
        asm volatile("s_waitcnt lgkmcnt(0)" ::: "memory");
#pragma unroll
        for (int r = 0; r < 16; ++r) rli[m][r] = __builtin_amdgcn_rcpf(wsl[crow(r, hi)]);
    }
    const int orow0 = qrow0 + wid * 32;
    if (!DIFF) {
#pragma unroll
        for (int r = 0; r < 16; ++r) { bf16_t* dst = C_HB + (size_t)(orow0 + crow(r, hi)) * D + 512 + hd * 64 + r32;
            dst[0] = f2bf(o[0][0][r] * rli[0][r]); dst[32] = f2bf(o[0][1][r] * rli[0][r]); }
    } else {
        const float* lp = CIN(19) + l * 128;
        float s1 = 0.f, s2 = 0.f;
        for (int i = 0; i < 32; ++i) { s1 += lp[i] * lp[32 + i]; s2 += lp[64 + i] * lp[96 + i]; }
        const float lam_init = 0.8f - 0.6f * __expf(-0.3f * (float)l);
        const float lam = __expf(s1) - __expf(s2) + lam_init;
        const float* gn = CIN(20) + l * 64;
        const float g0 = gn[r32] * (1.f - lam_init), g1 = gn[32 + r32] * (1.f - lam_init);
#pragma unroll
        for (int r = 0; r < 16; ++r) {
            const float v0 = o[0][0][r] * rli[0][r] - lam * o[NMAP - 1][0][r] * rli[NMAP - 1][r];
            const float v1 = o[0][1][r] * rli[0][r] - lam * o[NMAP - 1][1][r] * rli[NMAP - 1][r];
            float ss = v0 * v0 + v1 * v1;
            ss += __shfl_xor(ss, 1, 64); ss += __shfl_xor(ss, 2, 64); ss += __shfl_xor(ss, 4, 64); ss += __shfl_xor(ss, 8, 64); ss += __shfl_xor(ss, 16, 64);
            const float rstd = rsqrtf(ss * (1.f / 64.f) + NORM_EPS);
            bf16_t* dst = C_HB + (size_t)(orow0 + crow(r, hi)) * D + 768 + hd * 64 + r32;
            dst[0] = f2bf(v0 * rstd * g0); dst[32] = f2bf(v1 * rstd * g1); }
    }
    __syncthreads();
}
__device__ void ph_attn(const Ctx& c, int l, char* lds) {
    const bool need_ctx = (l < DEPTH - 1);
    const int nitem = 1024 + (need_ctx ? 32 : 0);
    for (int it = blockIdx.x; it < nitem; it += gridDim.x) {
        if (it < 512) { const int b = it >> 7, hd = (it >> 5) & 3, qt = it & 31; attn_item<true>(c, l, b, hd, b * RPB + CTX + qt * 256, b * RPB, RPB, lds); }
        else if (it < 1024) { const int u = it - 512; const int b = u >> 7, hd = (u >> 5) & 3, qt = u & 31; attn_item<false>(c, l, b, hd, b * RPB + CTX + qt * 256, b * RPB, RPB, lds); }
        else { const int u = it - 1024; const int b = u & 3, hd = (u >> 2) & 3; if (u < 16) attn_item<true>(c, l, b, hd, b * RPB, b * RPB, CTX, lds); else attn_item<false>(c, l, b, hd, b * RPB, b * RPB, CTX, lds); }
    }
}

__device__ void cvt_tables(const Ctx& c, int l) {
    const size_t n8 = (size_t)NEXP * D / 8;
    const float* su = CIN(23) + (size_t)l * NEXP * D; const float* sv = CIN(24) + (size_t)l * NEXP * D;
    for (size_t i = (size_t)blockIdx.x * 512 + c.tid; i < 2 * n8; i += (size_t)gridDim.x * 512) {
        const bool isu = i < n8; const size_t j = isu ? i : i - n8; const float* s = (isu ? su : sv) + j * 8;
        const f32x4 a = *(const f32x4*)s, b = *(const f32x4*)(s + 4);
        u32x4 w = {cvtpk(a[0], a[1]), cvtpk(a[2], a[3]), cvtpk(b[0], b[1]), cvtpk(b[2], b[3])};
        *(u32x4*)((isu ? C_TU : C_TV) + j * 8) = w;
    }
}
__device__ __forceinline__ unsigned ford(float x) { const unsigned u = __float_as_uint(x); return (u & 0x80000000u) ? ~u : (u | 0x80000000u); }
__device__ __forceinline__ float funord(unsigned k) { const unsigned u = (k & 0x80000000u) ? (k & 0x7fffffffu) : ~k; return __uint_as_float(u); }
constexpr int TOPK_LDS = 2 * 128 * 129 * 4;
__device__ void peer_topk_item(const Ctx& c, int l, int tm, int h, char* lds) {
    float* S = (float*)lds;
    const int tid = c.tid, lane = c.lane, wid = c.wid, r32 = lane & 31, hi = lane >> 5, wm = wid >> 1, wn = wid & 1;
    const int row0 = tm * 128;
#pragma unroll
    for (int p = 0; p < 2; ++p) {
        f32x16 acc[2];
        zero_acc(acc[0]); zero_acc(acc[1]);
        const bf16_t* Ap = C_Q2 + (size_t)(row0 + wm * 32 + r32) * 2048 + h * 256 + p * 128 + hi * 8;
        const bf16_t* Bp = C_KEYS + ((((size_t)l * 8 + h) * 2 + p) * 128 + wn * 64 + r32) * 128 + hi * 8;
#pragma unroll
        for (int ks = 0; ks < 8; ++ks) {
            const bf16x8 a = *(const bf16x8*)(Ap + ks * 16);
            const bf16x8 b0 = *(const bf16x8*)(Bp + ks * 16), b1 = *(const bf16x8*)(Bp + 32 * 128 + ks * 16);
            acc[0] = __builtin_amdgcn_mfma_f32_32x32x16_bf16(a, b0, acc[0], 0, 0, 0);
            acc[1] = __builtin_amdgcn_mfma_f32_32x32x16_bf16(a, b1, acc[1], 0, 0, 0);
        }
#pragma unroll
        for (int n = 0; n < 2; ++n)
#pragma unroll
            for (int r = 0; r < 16; ++r) S[(p * 128 + wm * 32 + crow(r, hi)) * 129 + wn * 64 + n * 32 + r32] = acc[n][r];
    }
    __syncthreads();
    unsigned tk[16];
    if (tid < 256) {
        const float* sr = S + tid * 129;
#pragma unroll
        for (int i = 0; i < 16; ++i) tk[i] = 0u;
        for (int n = 0; n < 128; ++n) { unsigned key = (ford(sr[n]) & ~127u) | (unsigned)(127 - n);
#pragma unroll
            for (int i = 0; i < 16; ++i) { const unsigned hi_ = max(key, tk[i]); key = min(key, tk[i]); tk[i] = hi_; } }
    }
    __syncthreads();
    unsigned* L = (unsigned*)lds;
    if (tid < 256) {
#pragma unroll
        for (int i = 0; i < 16; ++i) L[tid * 17 + i] = tk[i];
    }
    __syncthreads();
    if (tid < 128) {
        const unsigned* l0 = L + tid * 17; const unsigned* l1 = L + (128 + tid) * 17;
        float s0[16], s1[16];
#pragma unroll
        for (int i = 0; i < 16; ++i) { s0[i] = funord(l0[i] & ~127u); s1[i] = funord(l1[i] & ~127u); }
        unsigned bk[16];
#pragma unroll
        for (int i = 0; i < 16; ++i) bk[i] = 0u;
#pragma unroll
        for (int i = 0; i < 16; ++i)
#pragma unroll
            for (int j = 0; j < 16; ++j) if ((i + 1) * (j + 1) <= 16) {
                unsigned key = (ford(s0[i] + s1[j]) & ~255u) | (unsigned)(255 - (i * 16 + j));
#pragma unroll
                for (int q = 0; q < 16; ++q) { const unsigned hi_ = max(key, bk[q]); key = min(key, bk[q]); bk[q] = hi_; } }
        float best[16]; int eid[16]; float mx = -1e30f;
#pragma unroll
        for (int q = 0; q < 16; ++q) { const int ij = 255 - (int)(bk[q] & 255u); const int i = ij >> 4, j = ij & 15;
            const unsigned k0 = l0[i], k1 = l1[j];
            best[q] = funord(k0 & ~127u) + funord(k1 & ~127u);
            eid[q] = (127 - (int)(k0 & 127u)) * 128 + (127 - (int)(k1 & 127u));
            mx = fmaxf(mx, best[q]); }
        float sum = 0.f;
#pragma unroll
        for (int q = 0; q < 16; ++q) { best[q] = __expf(best[q] - mx); sum += best[q]; }
        const float inv = 1.f / sum;
        const size_t o = (size_t)(row0 + tid) * 128 + h * 16;
#pragma unroll
        for (int q = 0; q < 16; ++q) { C_EI[o + q] = eid[q]; C_EG[o + q] = best[q] * inv; }
    }
    __syncthreads();
}
__device__ void ph_peer_expert(const Ctx& c, int l, char* lds) {
    const bool need_ctx = (l < DEPTH - 1);
    float* wl = (float*)lds + c.wid * 256;
    int* el = (int*)(wl + 128);
    const int lane = c.lane, sub = lane & 15, grp = lane >> 4;
    for (int r = blockIdx.x * 8 + c.wid; r < NR; r += gridDim.x * 8) {
        const int b = r / RPB, j = r - b * RPB; const bool isctx = j < CTX;
        if (isctx && !need_ctx) continue;
        u32x4 xq[8];
        const bf16_t* xr = C_HB + (size_t)r * D;
#pragma unroll
        for (int jj = 0; jj < 8; ++jj) xq[jj] = *(const u32x4*)(xr + jj * 128 + sub * 8);
        const int e0 = C_EI[(size_t)r * 128 + lane], e1 = C_EI[(size_t)r * 128 + 64 + lane];
        const float g0 = C_EG[(size_t)r * 128 + lane], g1 = C_EG[(size_t)r * 128 + 64 + lane];
        el[lane] = e0; el[64 + lane] = e1;
        asm volatile("s_waitcnt lgkmcnt(0)" ::: "memory");
        float myact0 = 0.f, myact1 = 0.f;
        for (int g = 0; g < 32; ++g) {
            const int p = g * 4 + grp; const int e = el[p];
            const bf16_t* ur = C_TU + (size_t)e * D + sub * 8;
            float a = 0.f;
#pragma unroll
            for (int jj = 0; jj < 8; ++jj) { const u32x4 uv = *(const u32x4*)(ur + jj * 128);
#pragma unroll
                for (int q = 0; q < 4; ++q) { a = fmaf(bflo(uv[q]), bflo(xq[jj][q]), a); a = fmaf(bfhi(uv[q]), bfhi(xq[jj][q]), a); } }
            a += __shfl_xor(a, 1, 64); a += __shfl_xor(a, 2, 64); a += __shfl_xor(a, 4, 64); a += __shfl_xor(a, 8, 64);
            const float v0 = __shfl(a, ((lane & 3) << 4), 64);
            if ((lane >> 2) == (g & 15)) { if (g < 16) myact0 = v0; else myact1 = v0; }
        }
        auto gelu = [](float x) { const float u = 0.7978845608028654f * (x + 0.044715f * x * x * x); const float t = 1.f - 2.f / (1.f + __expf(2.f * u)); return 0.5f * x * (1.f + t); };
        wl[lane] = g0 * gelu(myact0); wl[64 + lane] = g1 * gelu(myact1);
        asm volatile("s_waitcnt lgkmcnt(0)" ::: "memory");
        float acc[16];
#pragma unroll
        for (int q = 0; q < 16; ++q) acc[q] = 0.f;
        for (int p = 0; p < 128; p += 4) {
            u32x4 vv[4][2]; float wv[4];
#pragma unroll
            for (int u = 0; u < 4; ++u) { const int e = el[p + u]; wv[u] = wl[p + u]; const bf16_t* vr = C_TV + (size_t)e * D + lane * 8; vv[u][0] = *(const u32x4*)vr; vv[u][1] = *(const u32x4*)(vr + 512); }
#pragma unroll
            for (int u = 0; u < 4; ++u)
#pragma unroll
                for (int i = 0; i < 2; ++i)
#pragma unroll
                    for (int q = 0; q < 4; ++q) { acc[i * 8 + 2 * q] = fmaf(wv[u], bflo(vv[u][i][q]), acc[i * 8 + 2 * q]); acc[i * 8 + 2 * q + 1] = fmaf(wv[u], bfhi(vv[u][i][q]), acc[i * 8 + 2 * q + 1]); }
        }
        const float* gt = C_MODT + ((size_t)l * 5 + (isctx ? 4 : b)) * 6144 + 5 * D;
        float* xo = xrow(c, r);
#pragma unroll
        for (int i = 0; i < 2; ++i)
#pragma unroll
            for (int q4 = 0; q4 < 2; ++q4) { const int col = i * 512 + lane * 8 + q4 * 4;
                f32x4 xv = *(f32x4*)(xo + col); const f32x4 gv = *(const f32x4*)(gt + col);
#pragma unroll
                for (int e = 0; e < 4; ++e) xv[e] += gv[e] * acc[i * 8 + q4 * 4 + e];
                *(f32x4*)(xo + col) = xv; }
    }
}
__device__ void ph_final(const Ctx& c) {
    const float* g = CIN(25);
    for (int r = blockIdx.x * 8 + c.wid; r < NB * SEQ; r += gridDim.x * 8) {
        float* xr = COUT + ((size_t)r << 10);
        f32x4 x[4]; float ss = 0.f;
#pragma unroll
        for (int i = 0; i < 4; ++i) { x[i] = *(const f32x4*)(xr + i * 256 + c.lane * 4); ss += x[i][0] * x[i][0] + x[i][1] * x[i][1] + x[i][2] * x[i][2] + x[i][3] * x[i][3]; }
        ss = wave_sum(ss); const float rstd = rsqrtf(ss * (1.f / D) + NORM_EPS);
#pragma unroll
        for (int i = 0; i < 4; ++i) { const int col = i * 256 + c.lane * 4; const f32x4 gv = *(const f32x4*)(g + col); f32x4 y;
#pragma unroll
            for (int e = 0; e < 4; ++e) y[e] = x[i][e] * rstd * gv[e];
            *(f32x4*)(xr + col) = y; }
    }
}

constexpr int LDS_BYTES = 144 * 1024;
static_assert(TOPK_LDS + 16 <= LDS_BYTES && GEMM_LDS + 16 <= LDS_BYTES && ATT_LDS + 16 <= LDS_BYTES, "LDS budget");
constexpr int N_PHASES = 1 + 11 * DEPTH + 1;
extern __shared__ __attribute__((aligned(16))) char g_lds[];

#define PHASE_FN __device__ __forceinline__ void
PHASE_FN f_p0() { const Ctx c = fresh_ctx(); ph_p0(c, g_lds); }
PHASE_FN f_norm0(int l) { const Ctx c = fresh_ctx(); ph_norm<0>(c, l); }
PHASE_FN f_norm1(int l) { const Ctx c = fresh_ctx(); ph_norm<1>(c, l); }
PHASE_FN f_gemm_in(int l) { const Ctx c = fresh_ctx(); ph_gemm_in(c, l, g_lds); }
PHASE_FN f_prep(int l) {
    const Ctx c = fresh_ctx(); char* lds = g_lds;
    ph_prep_rows(c, l);
    for (int it = blockIdx.x; it < 2 * 16 * NCHUNK * 2; it += gridDim.x) {
        const int mx = it & 1; int u = it >> 1; const int dir = u & 1; u >>= 1; const int cc = u % NCHUNK; u /= NCHUNK; const int h = u & 3, b = u >> 2;
        if (mx == 0) scanA_item<0>(c, l, b, h, cc, dir, lds); else scanA_item<1>(c, l, b, h, cc, dir, lds); }
}
PHASE_FN f_upproj(int l) {
    const Ctx c = fresh_ctx(); char* lds = g_lds;
    EpiBf16 eq{C_QM, 384}, ekv{C_KVM, 512};
    for (int it = blockIdx.x; it < 132 * 7 + 384; it += gridDim.x) {
        if (it < 132 * 7) { const int tm = it / 7, tn = it % 7;
            if (tn < 3) gemm_tile(c, C_P + MLA_CQ, INC, C_WUQ + (size_t)l * 384 * 192, 192, 192, tm * 256, tn * 128, lds, eq);
            else gemm_tile(c, C_P + MLA_CKV, INC, C_WUKV + (size_t)l * 512 * 128, 128, 128, tm * 256, (tn - 3) * 128, lds, ekv); }
        else scanB_item(c, it - 132 * 7); }
}
PHASE_FN f_scanc(int l) {
    const Ctx c = fresh_ctx(); char* lds = g_lds; const bool need_ctx = (l < DEPTH - 1);
    ph_rope_q(c);
    for (int it = blockIdx.x; it < 2 * 16 * NCHUNK; it += gridDim.x) {
        const int mx = it & 1; int u = it >> 1; const int cc = u % NCHUNK; u /= NCHUNK; const int h = u & 3, b = u >> 2;
        if (cc < 4 && !need_ctx) continue;
        if (mx == 0) scanC_item<0>(c, l, b, h, cc, lds); else scanC_item<1>(c, l, b, h, cc, lds); }
}
PHASE_FN f_attn(int l) { const Ctx c = fresh_ctx(); ph_attn(c, l, g_lds); }
PHASE_FN f_gemm_out(int l) {
    const Ctx c = fresh_ctx(); char* lds = g_lds; const bool need_ctx = (l < DEPTH - 1);
    EpiResid e{&c, C_MODT + (size_t)l * 5 * 6144 + 2 * D};
    for (int it = blockIdx.x; it < 132 * 8; it += gridDim.x) { const int tm = it / 8, tn = it % 8;
        if ((tm % 33) == 0 && !need_ctx) continue;
        gemm_tile(c, C_HB, D, C_WOUT + (size_t)l * D * D, D, D, tm * 256, tn * 128, lds, e); }
    cvt_tables(c, l);
}
PHASE_FN f_peer_q(int l) {
    const Ctx c = fresh_ctx(); char* lds = g_lds; const bool need_ctx = (l < DEPTH - 1);
    EpiBf16 e{C_Q2, 2048};
    for (int it = blockIdx.x; it < 132 * 16; it += gridDim.x) { const int tm = it / 16, tn = it % 16;
        if ((tm % 33) == 0 && !need_ctx) continue;
        gemm_tile(c, C_HB, D, C_WQ + (size_t)l * 2048 * D, D, D, tm * 256, tn * 128, lds, e); }
}
PHASE_FN f_topk(int l) {
    const Ctx c = fresh_ctx(); char* lds = g_lds; const bool need_ctx = (l < DEPTH - 1);
    for (int it = blockIdx.x; it < 264 * 8; it += gridDim.x) { const int tm = it >> 3, h = it & 7;
        if ((tm % 66) < 2 && !need_ctx) continue;
        peer_topk_item(c, l, tm, h, lds); }
}
PHASE_FN f_expert(int l) { const Ctx c = fresh_ctx(); ph_peer_expert(c, l, g_lds); }
PHASE_FN f_final() { const Ctx c = fresh_ctx(); ph_final(c); }

__global__ void __launch_bounds__(512, 2) mk_fwd(Params p) {
    volatile LAS unsigned* bst = (volatile LAS unsigned*)(g_lds + LDS_BYTES - 16);
    if (threadIdx.x == 0) { bst[0] = 0u; bst[1] = 0u; bst[2] = 0u; bst[3] = 0u; }
    __syncthreads();
    XcdBarrier bar; bar.bar = (unsigned*)(p.ws + WS_CTL); bar.x = 0; bar.st = bst;
    const int lo = p.ph_lo, hi = p.ph_hi;
    const bool multi = (hi - lo) > 1;
    if (multi) bar = xcd_barrier_post((unsigned*)(p.ws + WS_CTL), bst);
#ifndef PHMASK
#define PHMASK 0xFFFF
#endif
#define EN(s) ((PHMASK >> (s)) & 1)
#define IN(k) (lo <= (k) && (k) < hi)
#define SEAM(k) do { if (IN(k) && IN((k) + 1)) xcd_barrier(bar); } while (0)
    if (EN(0) && IN(0)) f_p0();
    SEAM(0);
#define LAYER(l) do { constexpr int base = 1 + 11 * (l); \
        if (EN(1) && IN(base + 0)) f_norm0(l); SEAM(base + 0); \
        if (EN(2) && IN(base + 1)) f_gemm_in(l); SEAM(base + 1); \
        if (EN(3) && IN(base + 2)) f_prep(l); SEAM(base + 2); \
        if (EN(4) && IN(base + 3)) f_upproj(l); SEAM(base + 3); \
        if (EN(5) && IN(base + 4)) f_scanc(l); SEAM(base + 4); \
        if (EN(6) && IN(base + 5)) f_attn(l); SEAM(base + 5); \
        if (EN(7) && IN(base + 6)) f_gemm_out(l); SEAM(base + 6); \
        if (EN(8) && IN(base + 7)) f_norm1(l); SEAM(base + 7); \
        if (EN(9) && IN(base + 8)) f_peer_q(l); SEAM(base + 8); \
        if (EN(10) && IN(base + 9)) f_topk(l); SEAM(base + 9); \
        if (EN(11) && IN(base + 10)) f_expert(l); SEAM(base + 10); } while (0)
    LAYER(0);
    LAYER(1);
#undef LAYER
    if (EN(12) && IN(N_PHASES - 1)) f_final();
#undef IN
#undef SEAM
}

#ifdef DBG_STOP
#ifndef DBG_LO
#define DBG_LO WS_MOD
#endif
#ifndef DBG_HI
#define DBG_HI WS_END
#endif
#ifndef DBG_X
#define DBG_X 1
#endif
__global__ void __launch_bounds__(512) mk_dump(float* out, const unsigned* ws) {
    const size_t NOUT = (size_t)NB * SEQ * D; const size_t lo = (size_t)(DBG_LO) / 4, hi = (size_t)(DBG_HI) / 4;
    for (size_t i = (size_t)blockIdx.x * 512 + threadIdx.x; i < NOUT; i += (size_t)gridDim.x * 512) {
        float a = 0.f;
        if (DBG_X) { const unsigned w = __float_as_uint(out[i]); a += (float)((w ^ (w >> 16)) & 0xFFFFu) * 1e-3f; }
        for (size_t j = lo + i; j < hi; j += NOUT) { const unsigned w = ws[j]; a += (float)((w ^ (w >> 16)) & 0xFFFFu) * 1e-3f; }
#ifdef DBG_LO2
        for (size_t j = (size_t)(DBG_LO2) / 4 + i; j < (size_t)(DBG_HI2) / 4; j += NOUT) { const unsigned w = ws[j]; a += (float)((w ^ (w >> 16)) & 0xFFFFu) * 1e-3f; }
#endif
        out[i] = a;
    }
}
#endif
extern "C" void kernel_launch(void* const* d_in, const int* in_sizes, int n_in, void* d_out, int out_size, void* d_ws, size_t ws_size, hipStream_t stream) {
    static int grid = 0;
    if (grid == 0) {
        if (n_in != 26 || in_sizes[0] != NB * SEQ * D || out_size != NB * SEQ * D || ws_size < WS_END) {
            fprintf(stderr, "kernel_launch: shape/workspace mismatch: n_in %d in0 %d out %d ws %zu (need %zu); nothing launched\n", n_in, n_in > 0 ? in_sizes[0] : -1, out_size, ws_size, (size_t)WS_END);
            grid = -1; return; }
        int dev = 0, cus = 0, per_cu = 0;
        if (hipGetDevice(&dev) != hipSuccess || hipDeviceGetAttribute(&cus, hipDeviceAttributeMultiprocessorCount, dev) != hipSuccess) { grid = -1; return; }
        if (hipFuncSetAttribute((const void*)mk_fwd, hipFuncAttributeMaxDynamicSharedMemorySize, LDS_BYTES) != hipSuccess) { fprintf(stderr, "kernel_launch: hipFuncSetAttribute failed\n"); grid = -1; return; }
        if (hipOccupancyMaxActiveBlocksPerMultiprocessor(&per_cu, (const void*)mk_fwd, 512, LDS_BYTES) != hipSuccess || per_cu < 1)
            fprintf(stderr, "kernel_launch: note: occupancy query reports %d workgroups per CU\n", per_cu);
        (void)hipGetLastError();
        grid = cus;
    }
    if (grid < 0) return;
    if (hipMemsetAsync((char*)d_ws + WS_CTL, 0, CTL_BYTES, stream) != hipSuccess) { fprintf(stderr, "kernel_launch: memset failed\n"); return; }
    Params p{};
    for (int i = 0; i < 26; ++i) p.in[i] = (const float*)d_in[i];
    p.out = (float*)d_out; p.ws = (unsigned char*)d_ws;
#ifdef DBG_STOP
    for (int k = 0; k < DBG_STOP; ++k) { p.ph_lo = k; p.ph_hi = k + 1; hipLaunchKernelGGL(mk_fwd, dim3(grid), dim3(512), LDS_BYTES, stream, p); }
    hipLaunchKernelGGL(mk_dump, dim3(1024), dim3(512), 0, stream, (float*)d_out, (const unsigned*)d_ws);
#elif MK_PER_PHASE
    for (int k = 0; k < N_PHASES; ++k) { p.ph_lo = k; p.ph_hi = k + 1; hipLaunchKernelGGL(mk_fwd, dim3(grid), dim3(512), LDS_BYTES, stream, p); }
#else
    p.ph_lo = 0; p.ph_hi = N_PHASES; hipLaunchKernelGGL(mk_fwd, dim3(grid), dim3(512), LDS_BYTES, stream, p);
#endif
    const hipError_t le = hipPeekAtLastError();
    if (le != hipSuccess) fprintf(stderr, "kernel_launch: launch failed: %s\n", hipGetErrorName(le));
}
```

```cpp
#include <hip/hip_runtime.h>
#include <cstdio>
#include <cstdint>

#ifndef MK_PER_PHASE
#define MK_PER_PHASE 0
#endif

constexpr int D = 1024, NB = 4, SEQ = 8192, CTX = 256, DEPTH = 2;
constexpr int RPB = CTX + SEQ;
constexpr int NR = NB * RPB;
constexpr int INC = 3200;
constexpr int GLA_Q = 0, GLA_K = 128, GLA_V = 256, GLA_R = 512, GLA_ZF = 768, GLA_ZB = 784;
constexpr int HG_Q = 800, HG_I = 1056, HG_OG = 1312, HG_ZF = 1568, HG_ZB = 1824;
constexpr int MLA_CQ = 2080, MLA_CKV = 2272, MLA_KR = 2400;
constexpr int DF_Q = 2432, DF_K = 2688, DF_V = 2944;
constexpr int NCHUNK = RPB / 64;
constexpr int NEXP = 16384;
constexpr float NORM_EPS = 1e-6f;

typedef unsigned short bf16_t;
typedef short bf16x8 __attribute__((ext_vector_type(8)));
typedef short s16x4 __attribute__((ext_vector_type(4)));
typedef float f32x16 __attribute__((ext_vector_type(16)));
typedef float f32x4 __attribute__((ext_vector_type(4)));
typedef unsigned u32x4 __attribute__((ext_vector_type(4)));
typedef unsigned u32x2 __attribute__((ext_vector_type(2)));

constexpr size_t al256(size_t x) { return (x + 255) / 256 * 256; }
constexpr size_t WS_CTL = 0;
constexpr size_t CTL_BYTES = 65536;
constexpr size_t WS_MOD = WS_CTL + CTL_BYTES;
constexpr size_t WS_XC = al256(WS_MOD + (size_t)2 * 5 * 6144 * 4);
constexpr size_t WS_WIN = al256(WS_XC + (size_t)NB * CTX * D * 4);
constexpr size_t WS_WOUT = al256(WS_WIN + (size_t)2 * INC * D * 2);
constexpr size_t WS_WQ = al256(WS_WOUT + (size_t)2 * D * D * 2);
constexpr size_t WS_WUQ = al256(WS_WQ + (size_t)2 * 2048 * D * 2);
constexpr size_t WS_WUKV = al256(WS_WUQ + (size_t)2 * 384 * 192 * 2);
constexpr size_t WS_KEYS = al256(WS_WUKV + (size_t)2 * 512 * 128 * 2);
constexpr size_t WS_HB = al256(WS_KEYS + (size_t)2 * 16 * 128 * 128 * 2);
constexpr size_t WS_QM = al256(WS_HB + (size_t)NR * D * 2);
constexpr size_t WS_KVM = al256(WS_QM + (size_t)NR * 384 * 2);
constexpr size_t WS_SG = al256(WS_KVM + (size_t)NR * 512 * 2);
constexpr size_t WS_SH = al256(WS_SG + (size_t)32 * NCHUNK * 2048 * 4);
constexpr size_t WS_DG = al256(WS_SH + (size_t)32 * NCHUNK * 4096 * 4);
constexpr size_t WS_DH = al256(WS_DG + (size_t)32 * NCHUNK * 32 * 4);
constexpr size_t WS_P = al256(WS_DH + (size_t)32 * NCHUNK * 64 * 4);
constexpr size_t WS_END = al256(WS_P + (size_t)NR * INC * 2);
constexpr size_t WS_TU = WS_P;
constexpr size_t WS_TV = WS_P + (size_t)NEXP * D * 2;
constexpr size_t WS_Q2 = WS_TV + (size_t)NEXP * D * 2;
static_assert(WS_Q2 + (size_t)NR * 2048 * 2 <= WS_END, "alias overflow");
constexpr size_t WS_EI = WS_SG;
constexpr size_t WS_EG = WS_EI + (size_t)NR * 128 * 4;
static_assert(WS_EG + (size_t)NR * 128 * 4 <= WS_DG, "alias overflow 2");

#define XB_TMO      128
#define XB_XCNT(j)  (256  + 64 * (j))
#define XB_XSUB(j)  (1280 + 64 * (j))
#define XB_XGEN(j)  (2304 + 64 * (j))
#define XB_TOP      3328
#define XB_TOPGEN   3392
#define XCD_BAR_WORDS 3456
#define XB_SPIN_CAP (1u << 22)
#define LAS __attribute__((address_space(3)))

__device__ __forceinline__ unsigned xb_ld(unsigned* p)              { return __hip_atomic_load(p, __ATOMIC_RELAXED, __HIP_MEMORY_SCOPE_AGENT); }
__device__ __forceinline__ unsigned xb_add(unsigned* p, unsigned v) { return __hip_atomic_fetch_add(p, v, __ATOMIC_RELAXED, __HIP_MEMORY_SCOPE_AGENT); }
__device__ __forceinline__ unsigned xb_xcc_id() { return (unsigned)__builtin_amdgcn_s_getreg((3 << 11) | 20) & 0xFu; }
#define XB_SPIN(cond, bar) do { unsigned _sp = 0; while (cond) { __builtin_amdgcn_s_sleep(1); \
    if ((++_sp & 255u) == 0u) { if (xb_ld(&(bar)[XB_TMO])) break; if (_sp > XB_SPIN_CAP) { atomicAdd(&(bar)[XB_TMO], 1u); break; } } } } while (0)

struct XcdBarrier { unsigned* bar; unsigned x; volatile LAS unsigned* st; };

__device__ __forceinline__ XcdBarrier xcd_barrier_post(unsigned* bar, volatile LAS unsigned* st) {
    XcdBarrier b; b.bar = bar; b.x = xb_xcc_id(); b.st = st;
    if (threadIdx.x == 0) (void)xb_add(&bar[XB_XCNT(b.x)], 1u);
    return b;
}
__device__ __forceinline__ void xcd_barrier_complete(unsigned* bar, unsigned x, unsigned& nloc, unsigned& nx) {
    const unsigned G = gridDim.x * gridDim.y * gridDim.z;
    unsigned sum, cnt, mine, sp = 0u;
    for (;;) {
        sum = 0u; cnt = 0u; mine = 0u;
#pragma unroll
        for (unsigned j = 0; j < 16; ++j) { const unsigned c = xb_ld(&bar[XB_XCNT(j)]); sum += c; cnt += (c > 0u) ? 1u : 0u; mine = (j == x) ? c : mine; }
        if (sum == G) break;
        __builtin_amdgcn_s_sleep(1);
        if ((++sp & 255u) == 0u) { if (xb_ld(&bar[XB_TMO])) break; if (sp > XB_SPIN_CAP) { atomicAdd(&bar[XB_TMO], 1u); break; } }
    }
    nloc = mine > 0u ? mine : 1u; nx = cnt > 0u ? cnt : 1u;
}
__device__ __forceinline__ void xcd_barrier(const XcdBarrier& b) {
    asm volatile("s_waitcnt vmcnt(0)" ::: "memory");
    __syncthreads();
    if (threadIdx.x == 0) {
        unsigned* bar = b.bar;
        __builtin_amdgcn_s_waitcnt(0);
        unsigned nloc = b.st[0], nx = b.st[1];
        if (nloc == 0u) { xcd_barrier_complete(bar, b.x, nloc, nx); b.st[0] = nloc; b.st[1] = nx; }
        const unsigned old = xb_add(&bar[XB_XSUB(b.x)], 1u);
        const unsigned gen = old / nloc;
        if (old + 1u == (gen + 1u) * nloc) {
            __builtin_amdgcn_fence(__ATOMIC_RELEASE, "agent");
            asm volatile("s_waitcnt vmcnt(0)" ::: "memory");
            const unsigned og = xb_add(&bar[XB_TOP], 1u);
            const unsigned tg = og / nx;
            if (og + 1u == (tg + 1u) * nx) xb_add(&bar[XB_TOPGEN], 1u);
            else XB_SPIN(xb_ld(&bar[XB_TOPGEN]) == tg, bar);
            __builtin_amdgcn_fence(__ATOMIC_ACQUIRE, "agent");
            xb_add(&bar[XB_XGEN(b.x)], 1u);
            asm volatile("s_waitcnt vmcnt(0)" ::: "memory");
        } else {
            XB_SPIN(xb_ld(&bar[XB_XGEN(b.x)]) == gen, bar);
            __builtin_amdgcn_fence(__ATOMIC_ACQUIRE, "agent");
            asm volatile("s_waitcnt vmcnt(0)" ::: "memory");
        }
    }
    __syncthreads();
}

typedef __bf16 bf16v2_t __attribute__((ext_vector_type(2)));
typedef float f32v2_t __attribute__((ext_vector_type(2)));
__device__ __forceinline__ unsigned cvtpk(float lo, float hi) { const f32v2_t v = {lo, hi}; const bf16v2_t b = __builtin_convertvector(v, bf16v2_t); return __builtin_bit_cast(unsigned, b); }
__device__ __forceinline__ bf16_t f2bf(float x) { const __bf16 b = (__bf16)x; return __builtin_bit_cast(bf16_t, b); }
__device__ __forceinline__ float bf2f(bf16_t h) { return __uint_as_float(((unsigned)h) << 16); }
__device__ __forceinline__ float bflo(unsigned w) { return __uint_as_float(w << 16); }
__device__ __forceinline__ float bfhi(unsigned w) { return __uint_as_float(w & 0xffff0000u); }
__device__ __forceinline__ float silu_f(float x) { return x / (1.f + __expf(-x)); }
__device__ __forceinline__ float logsigmoid_f(float z) { return fminf(z, 0.f) - log1pf(__expf(-fabsf(z))); }
__device__ __forceinline__ float wave_sum(float v) {
#pragma unroll
    for (int o = 32; o >= 1; o >>= 1) v += __shfl_xor(v, o, 64);
    return v;
}
__device__ __forceinline__ void zero_acc(f32x16& a) {
#pragma unroll
    for (int r = 0; r < 16; ++r) a[r] = 0.f;
    asm volatile("" : "+v"(a));
}
__device__ __forceinline__ int crow(int r, int hi) { return (r & 3) + 8 * (r >> 2) + 4 * hi; }

struct Params { const float* in[26]; float* out; unsigned char* ws; int ph_lo, ph_hi; };
typedef const __attribute__((address_space(4))) Params* KParams;
struct Ctx {
    KParams pp;
    int tid, lane, wid;
};
__device__ __forceinline__ Ctx fresh_ctx() {
    Ctx c; unsigned long long a = (unsigned long long)__builtin_amdgcn_kernarg_segment_ptr(); asm volatile("" : "+s"(a)); c.pp = (KParams)a;
    int t = threadIdx.x; asm volatile("" : "+v"(t)); c.tid = t; c.lane = t & 63; c.wid = __builtin_amdgcn_readfirstlane(t >> 6);
    return c;
}
#define CIN(i)   (c.pp->in[i])
#define COUT     (c.pp->out)
#define CWS(off) (c.pp->ws + (off))
#define C_MODT ((float*)CWS(WS_MOD))
#define C_XC   ((float*)CWS(WS_XC))
#define C_WIN  ((bf16_t*)CWS(WS_WIN))
#define C_WOUT ((bf16_t*)CWS(WS_WOUT))
#define C_WQ   ((bf16_t*)CWS(WS_WQ))
#define C_WUQ  ((bf16_t*)CWS(WS_WUQ))
#define C_WUKV ((bf16_t*)CWS(WS_WUKV))
#define C_KEYS ((bf16_t*)CWS(WS_KEYS))
#define C_HB   ((bf16_t*)CWS(WS_HB))
#define C_QM   ((bf16_t*)CWS(WS_QM))
#define C_KVM  ((bf16_t*)CWS(WS_KVM))
#define C_P    ((bf16_t*)CWS(WS_P))
#define C_TU   ((bf16_t*)CWS(WS_TU))
#define C_TV   ((bf16_t*)CWS(WS_TV))
#define C_Q2   ((bf16_t*)CWS(WS_Q2))
#define C_SG   ((float*)CWS(WS_SG))
#define C_SH   ((float*)CWS(WS_SH))
#define C_DG   ((float*)CWS(WS_DG))
#define C_DH   ((float*)CWS(WS_DH))
#define C_EI   ((int*)CWS(WS_EI))
#define C_EG   ((float*)CWS(WS_EG))

__device__ __forceinline__ float* xrow(const Ctx& c, int r) {
    const int b = r / RPB, j = r - b * RPB;
    return j < CTX ? C_XC + ((size_t)(b * CTX + j) << 10) : COUT + ((size_t)(b * SEQ + (j - CTX)) << 10);
}
__device__ __forceinline__ const float* inrow(const Ctx& c, int r) {
    const int b = r / RPB, j = r - b * RPB;
    return j < CTX ? CIN(2) + ((size_t)(b * CTX + j) << 10) : CIN(0) + ((size_t)(b * SEQ + (j - CTX)) << 10);
}

__device__ void p0_mod_item(const Ctx& c, int item, char* lds) {
    float* sc = (float*)lds;
    float* red = sc + 5 * 1024;
    const int tid = c.tid;
    for (int i = tid; i < 5 * 1024; i += 512) { const int v = i >> 10, k = i & 1023; const float x = (v < 4) ? CIN(1)[v * 1024 + k] : CIN(3)[k]; sc[i] = silu_f(x); }
    __syncthreads();
    const int l = item / 96, n0 = (item % 96) * 64;
    const int col = tid & 63, kg = tid >> 6;
    const float* w = CIN(4) + (size_t)l * 1024 * 6144 + n0 + col;
    float a[5] = {0.f, 0.f, 0.f, 0.f, 0.f};
#pragma unroll 8
    for (int kk = 0; kk < 128; ++kk) { const int k = kg * 128 + kk; const float wv = w[(size_t)k * 6144];
#pragma unroll
        for (int v = 0; v < 5; ++v) a[v] += sc[v * 1024 + k] * wv; }
#pragma unroll
    for (int v = 0; v < 5; ++v) red[(kg * 64 + col) * 5 + v] = a[v];
    __syncthreads();
    if (tid < 320) { const int cc = tid / 5, v = tid % 5; float s = 0.f;
#pragma unroll
        for (int g = 0; g < 8; ++g) s += red[(g * 64 + cc) * 5 + v];
        C_MODT[((size_t)l * 5 + v) * 6144 + n0 + cc] = s + CIN(5)[l * 6144 + n0 + cc]; }
    __syncthreads();
}
__device__ void p0_tr_tile(const float* __restrict__ src, bf16_t* __restrict__ dst, int K, int N, int k0, int n0, int tid, char* lds) {
    float* t = (float*)lds;
#pragma unroll
    for (int i = 0; i < 2; ++i) { const int k = (tid >> 4) + 32 * i, n4 = (tid & 15) * 4;
        const f32x4 v = *(const f32x4*)(src + (size_t)(k0 + k) * N + n0 + n4);
        t[k * 65 + n4 + 0] = v[0]; t[k * 65 + n4 + 1] = v[1]; t[k * 65 + n4 + 2] = v[2]; t[k * 65 + n4 + 3] = v[3]; }
    __syncthreads();
    { const int n = tid >> 3, k8 = (tid & 7) * 8; u32x4 w;
#pragma unroll
        for (int j = 0; j < 4; ++j) w[j] = cvtpk(t[(k8 + 2 * j) * 65 + n], t[(k8 + 2 * j + 1) * 65 + n]);
        *(u32x4*)(dst + (size_t)(n0 + n) * K + k0 + k8) = w; }
    __syncthreads();
}
__device__ void ph_p0(const Ctx& c, char* lds) {
    constexpr int T_WIN = 16 * 50, T_WOUT = 16 * 16, T_WQ = 16 * 32, T_UQ = 3 * 6, T_UKV = 2 * 8;
    constexpr int PER_L = T_WIN + T_WOUT + T_WQ + T_UQ + T_UKV;
    constexpr int NITEM = 192 + 2 * PER_L;
    for (int it = blockIdx.x; it < NITEM; it += gridDim.x) {
        if (it < 192) { p0_mod_item(c, it, lds); continue; }
        int t = it - 192; const int l = t / PER_L; t -= l * PER_L;
        if (t < T_WIN) { p0_tr_tile(CIN(8) + (size_t)l * D * INC, C_WIN + (size_t)l * INC * D, D, INC, (t / 50) * 64, (t % 50) * 64, c.tid, lds); continue; } t -= T_WIN;
        if (t < T_WOUT) { p0_tr_tile(CIN(9) + (size_t)l * D * D, C_WOUT + (size_t)l * D * D, D, D, (t / 16) * 64, (t % 16) * 64, c.tid, lds); continue; } t -= T_WOUT;
        if (t < T_WQ) { p0_tr_tile(CIN(21) + (size_t)l * D * 2048, C_WQ + (size_t)l * 2048 * D, D, 2048, (t / 32) * 64, (t % 32) * 64, c.tid, lds); continue; } t -= T_WQ;
        if (t < T_UQ) { p0_tr_tile(CIN(17) + (size_t)l * 192 * 384, C_WUQ + (size_t)l * 384 * 192, 192, 384, (t / 6) * 64, (t % 6) * 64, c.tid, lds); continue; } t -= T_UQ;
        p0_tr_tile(CIN(18) + (size_t)l * 128 * 512, C_WUKV + (size_t)l * 512 * 128, 128, 512, (t / 8) * 64, (t % 8) * 64, c.tid, lds);
    }
    const size_t nk8 = (size_t)2 * 16 * 128 * 128 / 8;
    for (size_t i = (size_t)blockIdx.x * 512 + c.tid; i < nk8; i += (size_t)gridDim.x * 512) {
        const f32x4 a = *(const f32x4*)(CIN(22) + i * 8), b = *(const f32x4*)(CIN(22) + i * 8 + 4);
        u32x4 w = {cvtpk(a[0], a[1]), cvtpk(a[2], a[3]), cvtpk(b[0], b[1]), cvtpk(b[2], b[3])};
        *(u32x4*)(C_KEYS + i * 8) = w;
    }
}

template <int WHICH>
__device__ void ph_norm(const Ctx& c, int l) {
    const float* g = CIN(WHICH == 0 ? 6 : 7) + l * D;
    const bool need_ctx = (l < DEPTH - 1);
    for (int r = blockIdx.x * 8 + c.wid; r < NR; r += gridDim.x * 8) {
        const int b = r / RPB, j = r - b * RPB; const bool isctx = j < CTX;
        if (WHICH == 1 && isctx && !need_ctx) continue;
        const float* src = (WHICH == 0 && l == 0) ? inrow(c, r) : xrow(c, r);
        f32x4 x[4]; float ss = 0.f;
#pragma unroll
        for (int i = 0; i < 4; ++i) { x[i] = *(const f32x4*)(src + i * 256 + c.lane * 4); ss += x[i][0] * x[i][0] + x[i][1] * x[i][1] + x[i][2] * x[i][2] + x[i][3] * x[i][3]; }
        ss = wave_sum(ss);
        const float rstd = rsqrtf(ss * (1.f / D) + NORM_EPS);
        const float* mt = C_MODT + ((size_t)l * 5 + (isctx ? 4 : b)) * 6144;
        const float* sh = mt + (WHICH == 0 ? 0 : 3) * D; const float* scl = mt + (WHICH == 0 ? 1 : 4) * D;
        bf16_t* dst = C_HB + (size_t)r * D;
        float* xr = xrow(c, r);
#pragma unroll
        for (int i = 0; i < 4; ++i) { const int col = i * 256 + c.lane * 4;
            const f32x4 gv = *(const f32x4*)(g + col), sv = *(const f32x4*)(sh + col), cv = *(const f32x4*)(scl + col);
            float y[4];
#pragma unroll
            for (int e = 0; e < 4; ++e) y[e] = x[i][e] * rstd * gv[e] * (1.f + cv[e]) + sv[e];
            u32x2 w = {cvtpk(y[0], y[1]), cvtpk(y[2], y[3])};
            *(u32x2*)(dst + col) = w;
            if (WHICH == 0 && l == 0) *(f32x4*)(xr + col) = x[i]; }
    }
}

constexpr int GEMM_LDS = 98304;
template <class Epi>
__device__ __forceinline__ void gemm_tile(const Ctx& c, const bf16_t* __restrict__ A, int lda, const bf16_t* __restrict__ Bt, int ldb, int K, int m0, int n0, char* lds, const Epi& epi) {
    const int tid = c.tid, lane = tid & 63, wid = tid >> 6, r32 = lane & 31, hi = lane >> 5, wm = wid >> 1, wn = wid & 1;
    char* As = lds; char* Bs = lds + 65536;
    f32x16 acc[2][2];
#pragma unroll
    for (int m = 0; m < 2; ++m)
#pragma unroll
        for (int n = 0; n < 2; ++n) zero_acc(acc[m][n]);
    u32x4 ra[4], rb[2];
    const int srow = tid >> 3, sch = tid & 7;
    const bf16_t* Ag = A + (size_t)(m0 + srow) * lda + sch * 8;
    const bf16_t* Bg = Bt + (size_t)(n0 + srow) * ldb + sch * 8;
    const int swoff = srow * 128 + ((sch ^ ((srow >> 1) & 7)) << 4);
#define GLOAD(k0) do { _Pragma("unroll") for (int i = 0; i < 4; ++i) ra[i] = *(const u32x4*)(Ag + (size_t)(64 * i) * lda + (k0)); \
                       _Pragma("unroll") for (int i = 0; i < 2; ++i) rb[i] = *(const u32x4*)(Bg + (size_t)(64 * i) * ldb + (k0)); } while (0)
#define SWRITE(buf) do { _Pragma("unroll") for (int i = 0; i < 4; ++i) *(u32x4*)(As + (buf) * 32768 + swoff + i * 8192) = ra[i]; \
                         _Pragma("unroll") for (int i = 0; i < 2; ++i) *(u32x4*)(Bs + (buf) * 16384 + swoff + i * 8192) = rb[i]; } while (0)
    const int nk = K >> 6;
    GLOAD(0); SWRITE(0); __syncthreads();
    for (int kt = 0; kt < nk; ++kt) {
        const int buf = kt & 1;
        if (kt + 1 < nk) GLOAD((kt + 1) * 64);
        const char* Ab = As + buf * 32768; const char* Bb = Bs + buf * 16384;
#pragma unroll
        for (int ks = 0; ks < 4; ++ks) {
            bf16x8 a[2], b[2];
#pragma unroll
            for (int m = 0; m < 2; ++m) { const int row = wm * 64 + m * 32 + r32; a[m] = *(const bf16x8*)(Ab + row * 128 + (((ks * 2 + hi) ^ ((row >> 1) & 7)) << 4)); }
#pragma unroll
            for (int n = 0; n < 2; ++n) { const int row = wn * 64 + n * 32 + r32; b[n] = *(const bf16x8*)(Bb + row * 128 + (((ks * 2 + hi) ^ ((row >> 1) & 7)) << 4)); }
#pragma unroll
            for (int m = 0; m < 2; ++m)
#pragma unroll
                for (int n = 0; n < 2; ++n) acc[m][n] = __builtin_amdgcn_mfma_f32_32x32x16_bf16(a[m], b[n], acc[m][n], 0, 0, 0);
        }
        if (kt + 1 < nk) SWRITE(buf ^ 1);
        __syncthreads();
    }
#undef GLOAD
#undef SWRITE
    epi(acc, m0 + wm * 64, n0 + wn * 64, r32, hi);
}
struct EpiBf16 {
    bf16_t* C; int ldc;
    __device__ __forceinline__ void operator()(const f32x16 (&acc)[2][2], int row0, int col0, int r32, int hi) const {
        bf16_t* base = C + (size_t)(row0 + 4 * hi) * ldc + col0 + r32;
#pragma unroll
        for (int m = 0; m < 2; ++m)
#pragma unroll
            for (int r = 0; r < 16; ++r) { bf16_t* p = base + (size_t)(m * 32 + (r & 3) + 8 * (r >> 2)) * ldc;
                p[0] = f2bf(acc[m][0][r]); p[32] = f2bf(acc[m][1][r]);
                asm volatile("" ::: "memory"); }
    }
};
struct EpiResid {
    const Ctx* c; const float* gate_l;
    __device__ __forceinline__ void operator()(const f32x16 (&acc)[2][2], int row0, int col0, int r32, int hi) const {
        const int b = row0 / RPB, j0 = row0 - b * RPB; const bool isctx = j0 < CTX;
        const float* gt = gate_l + (size_t)(isctx ? 4 : b) * 6144;
        float* xb = xrow(*c, row0);
        const float gv0 = gt[col0 + r32], gv1 = gt[col0 + 32 + r32];
        float* xq = xb + ((size_t)(4 * hi) << 10) + col0 + r32;
#pragma unroll
        for (int m = 0; m < 2; ++m)
#pragma unroll
            for (int r = 0; r < 16; ++r) { float* p = xq + ((size_t)(m * 32 + (r & 3) + 8 * (r >> 2)) << 10);
                const float a0 = p[0], a1 = p[32];
                p[0] = a0 + gv0 * acc[m][0][r]; p[32] = a1 + gv1 * acc[m][1][r];
                asm volatile("" ::: "memory"); }
    }
};

__device__ void ph_gemm_in(const Ctx& c, int l, char* lds) {
    EpiBf16 e{C_P, INC};
    const bf16_t* Bt = C_WIN + (size_t)l * INC * D;
    for (int it = blockIdx.x; it < 132 * 25; it += gridDim.x) { const int tm = it / 25, tn = it % 25; gemm_tile(c, C_HB, D, Bt, D, D, tm * 256, tn * 128, lds, e); }
}

template <int MX> struct ScanCfg;
template <> struct ScanCfg<0> { static constexpr int DK = 32; };
template <> struct ScanCfg<1> { static constexpr int DK = 64; };

template <int MX, bool WANT_Q>
__device__ __forceinline__ void scan_load(const Ctx& c, int l, int b, int h, int cc, int dir, float* qt, float* kt, float* gt, float* vt, float* tmp) {
    constexpr int DK = ScanCfg<MX>::DK, PK = DK + 1;
    const int tid = c.tid;
    const int rbase = b * RPB + cc * 64;
    if (MX == 0) {
        float* zt = tmp; float* wt = tmp + 64 * 16; float* bt = wt + 16 * 32;
        for (int i = tid; i < 64 * 16; i += 512) { const int t = i >> 4, k = i & 15; const int r = rbase + (dir ? 63 - t : t); zt[i] = bf2f(C_P[(size_t)r * INC + (dir ? GLA_ZB : GLA_ZF) + k]); }
        { const int i = tid; const int k = i >> 5, j = i & 31; wt[i] = CIN(10)[(((size_t)l * 2 + dir) * 16 + k) * 128 + h * 32 + j]; }
        if (tid < 32) bt[tid] = CIN(11)[((size_t)l * 2 + dir) * 128 + h * 32 + tid];
        __syncthreads();
        for (int i = tid; i < 64 * 32; i += 512) { const int t = i >> 5, j = i & 31; const int r = rbase + (dir ? 63 - t : t);
            float a = bt[j];
#pragma unroll
            for (int k = 0; k < 16; ++k) a += zt[t * 16 + k] * wt[k * 32 + j];
            gt[t * PK + j] = logsigmoid_f(a) * (1.f / 16.f);
            kt[t * PK + j] = bf2f(C_P[(size_t)r * INC + GLA_K + h * 32 + j]);
            if (WANT_Q) qt[t * PK + j] = bf2f(C_P[(size_t)r * INC + GLA_Q + h * 32 + j]) * 0.17677669529663687f; }
    } else {
        for (int i = tid; i < 64 * 64; i += 512) { const int t = i >> 6, j = i & 63; const int r = rbase + (dir ? 63 - t : t); const int ch = h * 64 + j;
            const float z = bf2f(C_P[(size_t)r * INC + (dir ? HG_ZB : HG_ZF) + ch]);
            float lb = 0.f;
            if (l > 0) { const float r0 = CIN(13)[ch], r1 = CIN(13)[256 + ch]; lb = 1.f / (1.f + __expf(r0 - r1)); }
            const float log_lb = __logf(fmaxf(lb, 1e-30f)), log_1mlb = log1pf(-lb);
            const float ls = logsigmoid_f(z); const float a1 = log_lb, a2 = log_1mlb + ls;
            gt[t * PK + j] = fmaxf(a1, a2) + log1pf(__expf(-fabsf(a1 - a2)));
            kt[t * PK + j] = (1.f - lb) / (1.f + __expf(z));
            if (WANT_Q) qt[t * PK + j] = silu_f(bf2f(C_P[(size_t)r * INC + HG_Q + ch])); }
    }
    for (int i = tid; i < 64 * 64; i += 512) { const int t = i >> 6, j = i & 63; const int r = rbase + (dir ? 63 - t : t);
        vt[t * 65 + j] = bf2f(C_P[(size_t)r * INC + (MX == 0 ? GLA_V : HG_I) + h * 64 + j]); }
    __syncthreads();
    if (tid < DK) { float s = 0.f; for (int t = 0; t < 64; ++t) { s += gt[t * PK + tid]; gt[t * PK + tid] = s; } }
    __syncthreads();
}

template <int MX>
__device__ void scanA_item(const Ctx& c, int l, int b, int h, int cc, int dir, char* lds) {
    constexpr int DK = ScanCfg<MX>::DK, PK = DK + 1, NJ = DK / 8;
    float* kt = (float*)lds; float* gt = kt + 64 * PK; float* vt = gt + 64 * PK; float* tmp = vt + 64 * 65;
    scan_load<MX, false>(c, l, b, h, cc, dir, nullptr, kt, gt, vt, tmp);
    const int tid = c.tid;
    for (int i = tid; i < 64 * DK; i += 512) { const int t = i / DK, k = i % DK; kt[t * PK + k] *= __expf(gt[63 * PK + k] - gt[t * PK + k]); }
    __syncthreads();
    const int ch = (b * 4 + h) * 2 + dir;
    { const int i = tid % DK, j0 = (tid / DK) * NJ; float a[NJ];
#pragma unroll
        for (int j = 0; j < NJ; ++j) a[j] = 0.f;
        for (int t = 0; t < 64; ++t) { const float kv = kt[t * PK + i];
#pragma unroll
            for (int j = 0; j < NJ; ++j) a[j] += kv * vt[t * 65 + j0 + j]; }
        float* S = (MX == 0 ? C_SG : C_SH) + ((size_t)ch * NCHUNK + cc) * (DK * 64) + i * 64 + j0;
#pragma unroll
        for (int j = 0; j < NJ; ++j) S[j] = a[j]; }
    if (tid < DK) (MX == 0 ? C_DG : C_DH)[((size_t)ch * NCHUNK + cc) * DK + tid] = __expf(gt[63 * PK + tid]);
    __syncthreads();
}
__device__ void scanB_item(const Ctx& c, int item) {
    const int e = item * 512 + c.tid;
    const bool hg = e >= 65536; const int ee = hg ? e - 65536 : e;
    const int DK = hg ? 64 : 32; const int per = DK * 64;
    const int ch = ee / per, ij = ee % per, i = ij >> 6; const int dir = ch & 1;
    float* S = (hg ? C_SH : C_SG) + (size_t)ch * NCHUNK * per + ij;
    const float* Dc = (hg ? C_DH : C_DG) + (size_t)ch * NCHUNK * DK + i;
    float st = 0.f;
    for (int n0 = 0; n0 < NCHUNK; n0 += 6) {
        float sv[6], dv[6];
#pragma unroll
        for (int u = 0; u < 6; ++u) { const int n = n0 + u; const int cc = dir ? (n < 4 ? 3 - n : 135 - n) : n; sv[u] = S[(size_t)cc * per]; dv[u] = Dc[(size_t)cc * DK]; }
#pragma unroll
        for (int u = 0; u < 6; ++u) { const int n = n0 + u; const int cc = dir ? (n < 4 ? 3 - n : 135 - n) : n; S[(size_t)cc * per] = st; st = dv[u] * st + sv[u]; }
    }
}
template <int MX>
__device__ void scanC_item(const Ctx& c, int l, int b, int h, int cc, char* lds) {
    constexpr int DK = ScanCfg<MX>::DK, PK = DK + 1;
    float* qt = (float*)lds; float* kt = qt + 64 * PK; float* gt = kt + 64 * PK; float* vt = gt + 64 * PK; float* sin_ = vt + 64 * 65;
    float* sc = sin_ + DK * 64; float* ot = sc + 64 * 65; float* tmp = ot + 64 * 65;
    const int tid = c.tid;
    for (int i = tid; i < 64 * 65; i += 512) ot[i] = 0.f;
    for (int dir = 0; dir < 2; ++dir) {
        scan_load<MX, true>(c, l, b, h, cc, dir, qt, kt, gt, vt, tmp);
        const int ch = (b * 4 + h) * 2 + dir;
        const float* Sg = (MX == 0 ? C_SG : C_SH) + ((size_t)ch * NCHUNK + cc) * (DK * 64);
        for (int i = tid; i < DK * 64; i += 512) sin_[i] = Sg[i];
        { const int t = tid >> 3, s0 = tid & 7; float a[8];
#pragma unroll
            for (int m = 0; m < 8; ++m) a[m] = 0.f;
            for (int k = 0; k < DK; ++k) { const float qv = qt[t * PK + k], bv = gt[t * PK + k];
#pragma unroll
                for (int m = 0; m < 8; ++m) { const int s = s0 + 8 * m; const float e = __expf(fminf(bv - gt[s * PK + k], 0.f)); a[m] += qv * kt[s * PK + k] * e; } }
#pragma unroll
            for (int m = 0; m < 8; ++m) { const int s = s0 + 8 * m; sc[t * 65 + s] = (s <= t) ? a[m] : 0.f; } }
        __syncthreads();
        { const int t = tid >> 3, j0 = (tid & 7) * 8; float a[8];
#pragma unroll
            for (int j = 0; j < 8; ++j) a[j] = 0.f;
            for (int k = 0; k < DK; ++k) { const float qv = qt[t * PK + k] * __expf(gt[t * PK + k]);
#pragma unroll
                for (int j = 0; j < 8; ++j) a[j] += qv * sin_[k * 64 + j0 + j]; }
            for (int s = 0; s <= t; ++s) { const float sv = sc[t * 65 + s];
#pragma unroll
                for (int j = 0; j < 8; ++j) a[j] += sv * vt[s * 65 + j0 + j]; }
            const int to = dir ? 63 - t : t;
#pragma unroll
            for (int j = 0; j < 8; ++j) ot[to * 65 + j0 + j] += a[j]; }
        __syncthreads();
    }
    { const int t = tid >> 3, j0 = (tid & 7) * 8; float o[8]; float ss = 0.f;
#pragma unroll
        for (int j = 0; j < 8; ++j) { o[j] = ot[t * 65 + j0 + j]; ss += o[j] * o[j]; }
        ss += __shfl_xor(ss, 1, 64); ss += __shfl_xor(ss, 2, 64); ss += __shfl_xor(ss, 4, 64);
        const float rstd = rsqrtf(ss * (1.f / 64.f) + NORM_EPS);
        const int r = b * RPB + cc * 64 + t;
        const float* gn = CIN(MX == 0 ? 12 : 14) + l * 64;
        const bf16_t* gp = C_P + (size_t)r * INC + (MX == 0 ? GLA_R : HG_OG) + h * 64 + j0;
        float y[8];
#pragma unroll
        for (int j = 0; j < 8; ++j) y[j] = o[j] * rstd * gn[j0 + j] * silu_f(bf2f(gp[j]));
        u32x4 w = {cvtpk(y[0], y[1]), cvtpk(y[2], y[3]), cvtpk(y[4], y[5]), cvtpk(y[6], y[7])};
        *(u32x4*)(C_HB + (size_t)r * D + MX * 256 + h * 64 + j0) = w; }
    __syncthreads();
}

__device__ __forceinline__ void rope_cs(int pos, int i, float& cs, float& sn) {
    const float freq = __expf(-(float)i * (9.210340371976184f / 8.f));
    const float ang = (float)pos * freq;
    const float n = rintf(ang * 0.15915494309189535f);
    float rr = fmaf(-n, 6.2831854820251465f, ang); rr = fmaf(-n, -1.7484555e-7f, rr);
    cs = __cosf(rr); sn = __sinf(rr);
}

__device__ void ph_prep_rows(const Ctx& c, int l) {
    const float* gq = CIN(15) + l * 192; const float* gkv = CIN(16) + l * 128;
    for (int r = blockIdx.x * 8 + c.wid; r < NR; r += gridDim.x * 8) {
        const int b = r / RPB, j = r - b * RPB; bf16_t* pr = C_P + (size_t)r * INC;
        { float v[3]; float ss = 0.f;
#pragma unroll
            for (int i = 0; i < 3; ++i) { v[i] = bf2f(pr[MLA_CQ + c.lane + 64 * i]); ss += v[i] * v[i]; }
            ss = wave_sum(ss); const float rstd = rsqrtf(ss * (1.f / 192.f) + NORM_EPS);
#pragma unroll
            for (int i = 0; i < 3; ++i) pr[MLA_CQ + c.lane + 64 * i] = f2bf(v[i] * rstd * gq[c.lane + 64 * i]); }
        { float v[2]; float ss = 0.f;
#pragma unroll
            for (int i = 0; i < 2; ++i) { v[i] = bf2f(pr[MLA_CKV + c.lane + 64 * i]); ss += v[i] * v[i]; }
            ss = wave_sum(ss); const float rstd = rsqrtf(ss * (1.f / 128.f) + NORM_EPS);
#pragma unroll
            for (int i = 0; i < 2; ++i) pr[MLA_CKV + c.lane + 64 * i] = f2bf(v[i] * rstd * gkv[c.lane + 64 * i]); }
        if (j >= CTX) { const int t = j - CTX; const int prow = t >> 6, pcol = t & 63;
            for (int pp = c.lane; pp < 34 * 8; pp += 64) { const int g = pp >> 3, i = pp & 7;
                int col; if (g < 16) col = DF_Q + (g >> 1) * 32 + (g & 1) * 16; else if (g < 32) col = DF_K + ((g - 16) >> 1) * 32 + (g & 1) * 16; else col = MLA_KR + (g - 32) * 16;
                float cs, sn; rope_cs((g & 1) ? pcol : prow, i, cs, sn);
                const float x1 = bf2f(pr[col + i]), x2 = bf2f(pr[col + 8 + i]);
                pr[col + i] = f2bf(x1 * cs - x2 * sn); pr[col + 8 + i] = f2bf(x1 * sn + x2 * cs); } }
    }
}
__device__ void ph_rope_q(const Ctx& c) {
    for (int r = blockIdx.x * 8 + c.wid; r < NR; r += gridDim.x * 8) {
        const int b = r / RPB, j = r - b * RPB; if (j < CTX) continue;
        const int t = j - CTX; const int prow = t >> 6, pcol = t & 63;
        const int h = c.lane >> 4, g = (c.lane >> 3) & 1, i = c.lane & 7;
        bf16_t* q = C_QM + (size_t)r * 384 + h * 96 + 64 + g * 16;
        float cs, sn; rope_cs(g ? pcol : prow, i, cs, sn);
        const float x1 = bf2f(q[i]), x2 = bf2f(q[8 + i]);
        q[i] = f2bf(x1 * cs - x2 * sn); q[8 + i] = f2bf(x1 * sn + x2 * cs);
    }
}

__device__ __forceinline__ int v_st(int k, int cidx) { const int kk = (k & ~0xC) | ((k & 4) << 1) | ((k & 8) >> 1); return ((kk >> 3) * 2 + (cidx >> 5)) * 512 + ((kk & 7) * 32 + (cidx & 31)) * 2; }
__device__ __forceinline__ int v_rd_base(int lane) { return ((lane & 3) << 3) | (((lane >> 2) & 3) << 6) | (((lane >> 4) & 1) << 5) | (((lane >> 5) & 1) << 8); }
constexpr int v_rd_off(int d0, int ks, int half) { return d0 * 512 + ks * 2048 + half * 1024; }
template <int OFF> __device__ __forceinline__ s16x4 tr_read(int vb) { s16x4 r; asm volatile("ds_read_b64_tr_b16 %0, %1 offset:%2" : "=&v"(r) : "v"(vb), "i"(OFF) : "memory"); return r; }
template <int D0> __device__ __forceinline__ void pv_one(f32x16& od, int vb, bf16x8 pa0, bf16x8 pa1, bf16x8 pa2, bf16x8 pa3) {
    const s16x4 l0 = tr_read<v_rd_off(D0, 0, 0)>(vb), h0 = tr_read<v_rd_off(D0, 0, 1)>(vb), l1 = tr_read<v_rd_off(D0, 1, 0)>(vb), h1 = tr_read<v_rd_off(D0, 1, 1)>(vb);
    const s16x4 l2 = tr_read<v_rd_off(D0, 2, 0)>(vb), h2 = tr_read<v_rd_off(D0, 2, 1)>(vb), l3 = tr_read<v_rd_off(D0, 3, 0)>(vb), h3 = tr_read<v_rd_off(D0, 3, 1)>(vb);
    asm volatile("s_waitcnt lgkmcnt(0)" ::: "memory"); __builtin_amdgcn_sched_barrier(0);
#define PKV(L, H) (bf16x8){L[0], L[1], L[2], L[3], H[0], H[1], H[2], H[3]}
    od = __builtin_amdgcn_mfma_f32_32x32x16_bf16(pa0, PKV(l0, h0), od, 0, 0, 0);
    od = __builtin_amdgcn_mfma_f32_32x32x16_bf16(pa1, PKV(l1, h1), od, 0, 0, 0);
    od = __builtin_amdgcn_mfma_f32_32x32x16_bf16(pa2, PKV(l2, h2), od, 0, 0, 0);
    od = __builtin_amdgcn_mfma_f32_32x32x16_bf16(pa3, PKV(l3, h3), od, 0, 0, 0);
#undef PKV
}
constexpr float ATT_THR = 8.f;
__device__ __forceinline__ void softmax_tile(f32x16& p0, f32x16& p1, float& m_reg, float& l_reg, float& alpha, const float C, const float thr,
                                             bf16x8& pa0, bf16x8& pa1, bf16x8& pa2, bf16x8& pa3) {
    float pmax = p0[0];
#pragma unroll
    for (int r = 1; r < 16; ++r) pmax = fmaxf(pmax, p0[r]);
#pragma unroll
    for (int r = 0; r < 16; ++r) pmax = fmaxf(pmax, p1[r]);
    { auto rr = __builtin_amdgcn_permlane32_swap(__float_as_uint(pmax), __float_as_uint(pmax), false, false); pmax = fmaxf(__uint_as_float(rr[0]), __uint_as_float(rr[1])); }
    float mn;
    if (__builtin_expect(__all(pmax - m_reg <= thr), 1)) { mn = m_reg; alpha = 1.f; }
    else { mn = fmaxf(m_reg, pmax); alpha = __builtin_amdgcn_exp2f((m_reg - mn) * C); m_reg = mn; }
    const float mnC = -mn * C;
    float ps = 0.f;
#pragma unroll
    for (int r = 0; r < 16; ++r) { p0[r] = __builtin_amdgcn_exp2f(fmaf(p0[r], C, mnC)); ps += p0[r]; }
#pragma unroll
    for (int r = 0; r < 16; ++r) { p1[r] = __builtin_amdgcn_exp2f(fmaf(p1[r], C, mnC)); ps += p1[r]; }
    { auto rr = __builtin_amdgcn_permlane32_swap(__float_as_uint(ps), __float_as_uint(ps), false, false); ps = __uint_as_float(rr[0]) + __uint_as_float(rr[1]); }
    l_reg = l_reg * alpha + ps;
#define PK4(P, BASE, OUT) do { unsigned a0 = cvtpk(P[BASE + 0], P[BASE + 1]), a1 = cvtpk(P[BASE + 2], P[BASE + 3]);   \
    unsigned b0 = cvtpk(P[BASE + 4], P[BASE + 5]), b1 = cvtpk(P[BASE + 6], P[BASE + 7]);                              \
    auto r0 = __builtin_amdgcn_permlane32_swap(a0, b0, false, false); auto r1 = __builtin_amdgcn_permlane32_swap(a1, b1, false, false); \
    u32x4 w = {r0[0], r1[0], r0[1], r1[1]}; OUT = *reinterpret_cast<bf16x8*>(&w); } while (0)
    PK4(p0, 0, pa0); PK4(p0, 8, pa1); PK4(p1, 0, pa2); PK4(p1, 8, pa3);
#undef PK4
}

constexpr int ATT_LDS = 2 * 16384 + 8192 + 8 * 64 * 4;
template <bool DIFF>
__device__ void attn_item(const Ctx& c, int l, int b, int hd, int qrow0, int krow0, int nkeys, char* lds) {
    constexpr int DQK = DIFF ? 32 : 96, NMAP = DIFF ? 2 : 1, ND0 = DQK / 16;
    constexpr int KP = DIFF ? 64 : 256;
    constexpr int KSZ = 64 * KP;
    const int tid = c.tid, lane = c.lane, wid = c.wid, r32 = lane & 31, hi = lane >> 5;
    char* K_lds = lds; char* V_lds = lds + 2 * 16384; float* wsl = (float*)(lds + 2 * 16384 + 8192) + wid * 64;
    const float scale = DIFF ? 0.17677669529663687f : 0.10206207261596575f;
    const float C = scale * 1.4426950408889634f, thr = ATT_THR / scale;
    bf16x8 qr[NMAP][ND0];
    { const int qrow = qrow0 + wid * 32 + r32;
#pragma unroll
        for (int m = 0; m < NMAP; ++m)
#pragma unroll
            for (int d0 = 0; d0 < ND0; ++d0) {
                const bf16_t* p = DIFF ? C_P + (size_t)qrow * INC + DF_Q + (hd * 2 + m) * 32 + d0 * 16 + hi * 8
                                       : C_QM + (size_t)qrow * 384 + hd * 96 + d0 * 16 + hi * 8;
                qr[m][d0] = *(const bf16x8*)p; } }
    f32x16 o[NMAP][2]; float m_reg[NMAP], l_reg[NMAP];
#pragma unroll
    for (int m = 0; m < NMAP; ++m) { m_reg[m] = -1e30f; l_reg[m] = 0.f;
#pragma unroll
        for (int d = 0; d < 2; ++d) zero_acc(o[m][d]); }
    const int vkey = tid >> 3, vch = tid & 7; const int vdst = v_st(vkey, vch * 8);
    u32x4 kreg0, kreg1, vreg;
    const int k0key = DIFF ? ((tid & 255) >> 2) : (tid / 12), k0ch = DIFF ? (tid & 3) : (tid % 12);
    const int k1key = (tid + 512) / 12, k1ch = (tid + 512) % 12; const bool k1on = (!DIFF) && (tid + 512 < 768);
    auto ksrc = [&](int key, int ch, int kr) -> const bf16_t* {
        const size_t r = (size_t)(kr + key);
        if (DIFF) return C_P + r * INC + DF_K + (hd * 2 + (tid >> 8)) * 32 + ch * 8;
        return (ch < 8) ? C_KVM + r * 512 + hd * 128 + ch * 8 : C_P + r * INC + MLA_KR + (ch - 8) * 8; };
    auto kdst = [&](int key, int ch) -> int {
        if (DIFF) return (tid >> 8) * KSZ + key * 64 + ((ch ^ ((key >> 2) & 3)) << 4);
        return key * 256 + ((ch * 16) ^ ((key & 7) << 4)); };
    const int kd0 = kdst(k0key, k0ch), kd1 = kdst(k1key, k1ch);
    const int vb = (int)(uintptr_t)V_lds + v_rd_base(lane);
#define ALOAD(kr) do { kreg0 = *(const u32x4*)ksrc(k0key, k0ch, (kr)); if (k1on) kreg1 = *(const u32x4*)ksrc(k1key, k1ch, (kr)); \
        vreg = *(const u32x4*)(DIFF ? C_P + (size_t)((kr) + vkey) * INC + DF_V + hd * 64 + vch * 8 : C_KVM + (size_t)((kr) + vkey) * 512 + hd * 128 + 64 + vch * 8); } while (0)
    const int NT = nkeys >> 6;
    ALOAD(krow0);
    for (int j = 0; j < NT; ++j) {
        __syncthreads();
        *(u32x4*)(K_lds + kd0) = kreg0; if (k1on) *(u32x4*)(K_lds + kd1) = kreg1; *(u32x4*)(V_lds + vdst) = vreg;
        __syncthreads();
        if (j + 1 < NT) ALOAD(krow0 + (j + 1) * 64);
#pragma unroll
        for (int m = 0; m < NMAP; ++m) {
            f32x16 p0, p1; zero_acc(p0); zero_acc(p1);
            const char* Kb = K_lds + m * KSZ;
#pragma unroll
            for (int d0 = 0; d0 < ND0; ++d0) {
                bf16x8 b0, b1;
                if (DIFF) { const int ch = d0 * 2 + hi; const int ra = r32, rb = 32 + r32;
                    b0 = *(const bf16x8*)(Kb + ra * 64 + ((ch ^ ((ra >> 2) & 3)) << 4)); b1 = *(const bf16x8*)(Kb + rb * 64 + ((ch ^ ((rb >> 2) & 3)) << 4)); }
                else { const int cb = d0 * 32 + hi * 16; const int ra = r32, rb = 32 + r32;
                    b0 = *(const bf16x8*)(Kb + ra * 256 + (cb ^ ((ra & 7) << 4))); b1 = *(const bf16x8*)(Kb + rb * 256 + (cb ^ ((rb & 7) << 4))); }
                p0 = __builtin_amdgcn_mfma_f32_32x32x16_bf16(b0, qr[m][d0], p0, 0, 0, 0);
                p1 = __builtin_amdgcn_mfma_f32_32x32x16_bf16(b1, qr[m][d0], p1, 0, 0, 0);
            }
            float alpha; bf16x8 pa0, pa1, pa2, pa3;
            softmax_tile(p0, p1, m_reg[m], l_reg[m], alpha, C, thr, pa0, pa1, pa2, pa3);
            if (__any(alpha < 1.f)) {
                if (hi == 0) wsl[r32] = alpha;
                asm volatile("s_waitcnt lgkmcnt(0)" ::: "memory");
#pragma unroll
                for (int r = 0; r < 16; ++r) { const float av = wsl[crow(r, hi)]; o[m][0][r] *= av; o[m][1][r] *= av; }
            }
            pv_one<0>(o[m][0], vb, pa0, pa1, pa2, pa3);
            pv_one<1>(o[m][1], vb, pa0, pa1, pa2, pa3);
        }
    }
#undef ALOAD
    float rli[NMAP][16];
#pragma unroll
    for (int m = 0; m < NMAP; ++m) {
        asm volatile("s_waitcnt lgkmcnt(0)" ::: "memory");
        if (hi == 0) wsl[r32] = l_reg[m];
        asm volatile("s_waitcnt lgkmcnt(0)" ::: "memory");
#pragma unroll
        for (int r = 0; r < 16; ++r) rli[m][r] = __builtin_amdgcn_rcpf(wsl[crow(r, hi)]);
    }
    const int orow0 = qrow0 + wid * 32;
    if (!DIFF) {
#pragma unroll
        for (int r = 0; r < 16; ++r) { bf16_t* dst = C_HB + (size_t)(orow0 + crow(r, hi)) * D + 512 + hd * 64 + r32;
            dst[0] = f2bf(o[0][0][r] * rli[0][r]); dst[32] = f2bf(o[0][1][r] * rli[0][r]); }
    } else {
        const float* lp = CIN(19) + l * 128;
        float s1 = 0.f, s2 = 0.f;
        for (int i = 0; i < 32; ++i) { s1 += lp[i] * lp[32 + i]; s2 += lp[64 + i] * lp[96 + i]; }
        const float lam_init = 0.8f - 0.6f * __expf(-0.3f * (float)l);
        const float lam = __expf(s1) - __expf(s2) + lam_init;
        const float* gn = CIN(20) + l * 64;
        const float g0 = gn[r32] * (1.f - lam_init), g1 = gn[32 + r32] * (1.f - lam_init);
#pragma unroll
        for (int r = 0; r < 16; ++r) {
            const float v0 = o[0][0][r] * rli[0][r] - lam * o[NMAP - 1][0][r] * rli[NMAP - 1][r];
            const float v1 = o[0][1][r] * rli[0][r] - lam * o[NMAP - 1][1][r] * rli[NMAP - 1][r];
            float ss = v0 * v0 + v1 * v1;
            ss += __shfl_xor(ss, 1, 64); ss += __shfl_xor(ss, 2, 64); ss += __shfl_xor(ss, 4, 64); ss += __shfl_xor(ss, 8, 64); ss += __shfl_xor(ss, 16, 64);
            const float rstd = rsqrtf(ss * (1.f / 64.f) + NORM_EPS);
            bf16_t* dst = C_HB + (size_t)(orow0 + crow(r, hi)) * D + 768 + hd * 64 + r32;
            dst[0] = f2bf(v0 * rstd * g0); dst[32] = f2bf(v1 * rstd * g1); }
    }
    __syncthreads();
}
__device__ void ph_attn(const Ctx& c, int l, char* lds) {
    const bool need_ctx = (l < DEPTH - 1);
    const int nitem = 1024 + (need_ctx ? 32 : 0);
    for (int it = blockIdx.x; it < nitem; it += gridDim.x) {
        if (it < 512) { const int b = it >> 7, hd = (it >> 5) & 3, qt = it & 31; attn_item<true>(c, l, b, hd, b * RPB + CTX + qt * 256, b * RPB, RPB, lds); }
        else if (it < 1024) { const int u = it - 512; const int b = u >> 7, hd = (u >> 5) & 3, qt = u & 31; attn_item<false>(c, l, b, hd, b * RPB + CTX + qt * 256, b * RPB, RPB, lds); }
        else { const int u = it - 1024; const int b = u & 3, hd = (u >> 2) & 3; if (u < 16) attn_item<true>(c, l, b, hd, b * RPB, b * RPB, CTX, lds); else attn_item<false>(c, l, b, hd, b * RPB, b * RPB, CTX, lds); }
    }
}

__device__ void cvt_tables(const Ctx& c, int l) {
    const size_t n8 = (size_t)NEXP * D / 8;
    const float* su = CIN(23) + (size_t)l * NEXP * D; const float* sv = CIN(24) + (size_t)l * NEXP * D;
    for (size_t i = (size_t)blockIdx.x * 512 + c.tid; i < 2 * n8; i += (size_t)gridDim.x * 512) {
        const bool isu = i < n8; const size_t j = isu ? i : i - n8; const float* s = (isu ? su : sv) + j * 8;
        const f32x4 a = *(const f32x4*)s, b = *(const f32x4*)(s + 4);
        u32x4 w = {cvtpk(a[0], a[1]), cvtpk(a[2], a[3]), cvtpk(b[0], b[1]), cvtpk(b[2], b[3])};
        *(u32x4*)((isu ? C_TU : C_TV) + j * 8) = w;
    }
}
__device__ __forceinline__ unsigned ford(float x) { const unsigned u = __float_as_uint(x); return (u & 0x80000000u) ? ~u : (u | 0x80000000u); }
__device__ __forceinline__ float funord(unsigned k) { const unsigned u = (k & 0x80000000u) ? (k & 0x7fffffffu) : ~k; return __uint_as_float(u); }
constexpr int TOPK_LDS = 2 * 128 * 129 * 4;
__device__ void peer_topk_item(const Ctx& c, int l, int tm, int h, char* lds) {
    float* S = (float*)lds;
    const int tid = c.tid, lane = c.lane, wid = c.wid, r32 = lane & 31, hi = lane >> 5, wm = wid >> 1, wn = wid & 1;
    const int row0 = tm * 128;
#pragma unroll
    for (int p = 0; p < 2; ++p) {
        f32x16 acc[2];
        zero_acc(acc[0]); zero_acc(acc[1]);
        const bf16_t* Ap = C_Q2 + (size_t)(row0 + wm * 32 + r32) * 2048 + h * 256 + p * 128 + hi * 8;
        const bf16_t* Bp = C_KEYS + ((((size_t)l * 8 + h) * 2 + p) * 128 + wn * 64 + r32) * 128 + hi * 8;
#pragma unroll
        for (int ks = 0; ks < 8; ++ks) {
            const bf16x8 a = *(const bf16x8*)(Ap + ks * 16);
            const bf16x8 b0 = *(const bf16x8*)(Bp + ks * 16), b1 = *(const bf16x8*)(Bp + 32 * 128 + ks * 16);
            acc[0] = __builtin_amdgcn_mfma_f32_32x32x16_bf16(a, b0, acc[0], 0, 0, 0);
            acc[1] = __builtin_amdgcn_mfma_f32_32x32x16_bf16(a, b1, acc[1], 0, 0, 0);
        }
#pragma unroll
        for (int n = 0; n < 2; ++n)
#pragma unroll
            for (int r = 0; r < 16; ++r) S[(p * 128 + wm * 32 + crow(r, hi)) * 129 + wn * 64 + n * 32 + r32] = acc[n][r];
    }
    __syncthreads();
    unsigned tk[16];
    if (tid < 256) {
        const float* sr = S + tid * 129;
#pragma unroll
        for (int i = 0; i < 16; ++i) tk[i] = 0u;
        for (int n = 0; n < 128; ++n) { unsigned key = (ford(sr[n]) & ~127u) | (unsigned)(127 - n);
#pragma unroll
            for (int i = 0; i < 16; ++i) { const unsigned hi_ = max(key, tk[i]); key = min(key, tk[i]); tk[i] = hi_; } }
    }
    __syncthreads();
    unsigned* L = (unsigned*)lds;
    if (tid < 256) {
#pragma unroll
        for (int i = 0; i < 16; ++i) L[tid * 17 + i] = tk[i];
    }
    __syncthreads();
    if (tid < 128) {
        const unsigned* l0 = L + tid * 17; const unsigned* l1 = L + (128 + tid) * 17;
        float s0[16], s1[16];
#pragma unroll
        for (int i = 0; i < 16; ++i) { s0[i] = funord(l0[i] & ~127u); s1[i] = funord(l1[i] & ~127u); }
        unsigned bk[16];
#pragma unroll
        for (int i = 0; i < 16; ++i) bk[i] = 0u;
#pragma unroll
        for (int i = 0; i < 16; ++i)
#pragma unroll
            for (int j = 0; j < 16; ++j) if ((i + 1) * (j + 1) <= 16) {
                unsigned key = (ford(s0[i] + s1[j]) & ~255u) | (unsigned)(255 - (i * 16 + j));
#pragma unroll
                for (int q = 0; q < 16; ++q) { const unsigned hi_ = max(key, bk[q]); key = min(key, bk[q]); bk[q] = hi_; } }
        float best[16]; int eid[16]; float mx = -1e30f;
#pragma unroll
        for (int q = 0; q < 16; ++q) { const int ij = 255 - (int)(bk[q] & 255u); const int i = ij >> 4, j = ij & 15;
            const unsigned k0 = l0[i], k1 = l1[j];
            best[q] = funord(k0 & ~127u) + funord(k1 & ~127u);
            eid[q] = (127 - (int)(k0 & 127u)) * 128 + (127 - (int)(k1 & 127u));
            mx = fmaxf(mx, best[q]); }
        float sum = 0.f;
#pragma unroll
        for (int q = 0; q < 16; ++q) { best[q] = __expf(best[q] - mx); sum += best[q]; }
        const float inv = 1.f / sum;
        const size_t o = (size_t)(row0 + tid) * 128 + h * 16;
#pragma unroll
        for (int q = 0; q < 16; ++q) { C_EI[o + q] = eid[q]; C_EG[o + q] = best[q] * inv; }
    }
    __syncthreads();
}
__device__ void ph_peer_expert(const Ctx& c, int l, char* lds) {
    const bool need_ctx = (l < DEPTH - 1);
    float* wl = (float*)lds + c.wid * 256;
    int* el = (int*)(wl + 128);
    const int lane = c.lane, sub = lane & 15, grp = lane >> 4;
    for (int r = blockIdx.x * 8 + c.wid; r < NR; r += gridDim.x * 8) {
        const int b = r / RPB, j = r - b * RPB; const bool isctx = j < CTX;
        if (isctx && !need_ctx) continue;
        u32x4 xq[8];
        const bf16_t* xr = C_HB + (size_t)r * D;
#pragma unroll
        for (int jj = 0; jj < 8; ++jj) xq[jj] = *(const u32x4*)(xr + jj * 128 + sub * 8);
        const int e0 = C_EI[(size_t)r * 128 + lane], e1 = C_EI[(size_t)r * 128 + 64 + lane];
        const float g0 = C_EG[(size_t)r * 128 + lane], g1 = C_EG[(size_t)r * 128 + 64 + lane];
        el[lane] = e0; el[64 + lane] = e1;
        asm volatile("s_waitcnt lgkmcnt(0)" ::: "memory");
        float myact0 = 0.f, myact1 = 0.f;
        for (int g = 0; g < 32; ++g) {
            const int p = g * 4 + grp; const int e = el[p];
            const bf16_t* ur = C_TU + (size_t)e * D + sub * 8;
            float a = 0.f;
#pragma unroll
            for (int jj = 0; jj < 8; ++jj) { const u32x4 uv = *(const u32x4*)(ur + jj * 128);
#pragma unroll
                for (int q = 0; q < 4; ++q) { a = fmaf(bflo(uv[q]), bflo(xq[jj][q]), a); a = fmaf(bfhi(uv[q]), bfhi(xq[jj][q]), a); } }
            a += __shfl_xor(a, 1, 64); a += __shfl_xor(a, 2, 64); a += __shfl_xor(a, 4, 64); a += __shfl_xor(a, 8, 64);
            const float v0 = __shfl(a, ((lane & 3) << 4), 64);
            if ((lane >> 2) == (g & 15)) { if (g < 16) myact0 = v0; else myact1 = v0; }
        }
        auto gelu = [](float x) { const float u = 0.7978845608028654f * (x + 0.044715f * x * x * x); const float t = 1.f - 2.f / (1.f + __expf(2.f * u)); return 0.5f * x * (1.f + t); };
        wl[lane] = g0 * gelu(myact0); wl[64 + lane] = g1 * gelu(myact1);
        asm volatile("s_waitcnt lgkmcnt(0)" ::: "memory");
        float acc[16];
#pragma unroll
        for (int q = 0; q < 16; ++q) acc[q] = 0.f;
        for (int p = 0; p < 128; p += 4) {
            u32x4 vv[4][2]; float wv[4];
#pragma unroll
            for (int u = 0; u < 4; ++u) { const int e = el[p + u]; wv[u] = wl[p + u]; const bf16_t* vr = C_TV + (size_t)e * D + lane * 8; vv[u][0] = *(const u32x4*)vr; vv[u][1] = *(const u32x4*)(vr + 512); }
#pragma unroll
            for (int u = 0; u < 4; ++u)
#pragma unroll
                for (int i = 0; i < 2; ++i)
#pragma unroll
                    for (int q = 0; q < 4; ++q) { acc[i * 8 + 2 * q] = fmaf(wv[u], bflo(vv[u][i][q]), acc[i * 8 + 2 * q]); acc[i * 8 + 2 * q + 1] = fmaf(wv[u], bfhi(vv[u][i][q]), acc[i * 8 + 2 * q + 1]); }
        }
        const float* gt = C_MODT + ((size_t)l * 5 + (isctx ? 4 : b)) * 6144 + 5 * D;
        float* xo = xrow(c, r);
#pragma unroll
        for (int i = 0; i < 2; ++i)
#pragma unroll
            for (int q4 = 0; q4 < 2; ++q4) { const int col = i * 512 + lane * 8 + q4 * 4;
                f32x4 xv = *(f32x4*)(xo + col); const f32x4 gv = *(const f32x4*)(gt + col);
#pragma unroll
                for (int e = 0; e < 4; ++e) xv[e] += gv[e] * acc[i * 8 + q4 * 4 + e];
                *(f32x4*)(xo + col) = xv; }
    }
}
__device__ void ph_final(const Ctx& c) {
    const float* g = CIN(25);
    for (int r = blockIdx.x * 8 + c.wid; r < NB * SEQ; r += gridDim.x * 8) {
        float* xr = COUT + ((size_t)r << 10);
        f32x4 x[4]; float ss = 0.f;
#pragma unroll
        for (int i = 0; i < 4; ++i) { x[i] = *(const f32x4*)(xr + i * 256 + c.lane * 4); ss += x[i][0] * x[i][0] + x[i][1] * x[i][1] + x[i][2] * x[i][2] + x[i][3] * x[i][3]; }
        ss = wave_sum(ss); const float rstd = rsqrtf(ss * (1.f / D) + NORM_EPS);
#pragma unroll
        for (int i = 0; i < 4; ++i) { const int col = i * 256 + c.lane * 4; const f32x4 gv = *(const f32x4*)(g + col); f32x4 y;
#pragma unroll
            for (int e = 0; e < 4; ++e) y[e] = x[i][e] * rstd * gv[e];
            *(f32x4*)(xr + col) = y; }
    }
}

constexpr int LDS_BYTES = 144 * 1024;
static_assert(TOPK_LDS + 16 <= LDS_BYTES && GEMM_LDS + 16 <= LDS_BYTES && ATT_LDS + 16 <= LDS_BYTES, "LDS budget");
constexpr int N_PHASES = 1 + 11 * DEPTH + 1;
extern __shared__ __attribute__((aligned(16))) char g_lds[];

#define PHASE_FN __device__ __forceinline__ void
PHASE_FN f_p0() { const Ctx c = fresh_ctx(); ph_p0(c, g_lds); }
PHASE_FN f_norm0(int l) { const Ctx c = fresh_ctx(); ph_norm<0>(c, l); }
PHASE_FN f_norm1(int l) { const Ctx c = fresh_ctx(); ph_norm<1>(c, l); }
PHASE_FN f_gemm_in(int l) { const Ctx c = fresh_ctx(); ph_gemm_in(c, l, g_lds); }
PHASE_FN f_prep(int l) {
    const Ctx c = fresh_ctx(); char* lds = g_lds;
    ph_prep_rows(c, l);
    for (int it = blockIdx.x; it < 2 * 16 * NCHUNK * 2; it += gridDim.x) {
        const int mx = it & 1; int u = it >> 1; const int dir = u & 1; u >>= 1; const int cc = u % NCHUNK; u /= NCHUNK; const int h = u & 3, b = u >> 2;
        if (mx == 0) scanA_item<0>(c, l, b, h, cc, dir, lds); else scanA_item<1>(c, l, b, h, cc, dir, lds); }
}
PHASE_FN f_upproj(int l) {
    const Ctx c = fresh_ctx(); char* lds = g_lds;
    EpiBf16 eq{C_QM, 384}, ekv{C_KVM, 512};
    for (int it = blockIdx.x; it < 132 * 7 + 384; it += gridDim.x) {
        if (it < 132 * 7) { const int tm = it / 7, tn = it % 7;
            if (tn < 3) gemm_tile(c, C_P + MLA_CQ, INC, C_WUQ + (size_t)l * 384 * 192, 192, 192, tm * 256, tn * 128, lds, eq);
            else gemm_tile(c, C_P + MLA_CKV, INC, C_WUKV + (size_t)l * 512 * 128, 128, 128, tm * 256, (tn - 3) * 128, lds, ekv); }
        else scanB_item(c, it - 132 * 7); }
}
PHASE_FN f_scanc(int l) {
    const Ctx c = fresh_ctx(); char* lds = g_lds; const bool need_ctx = (l < DEPTH - 1);
    ph_rope_q(c);
    for (int it = blockIdx.x; it < 2 * 16 * NCHUNK; it += gridDim.x) {
        const int mx = it & 1; int u = it >> 1; const int cc = u % NCHUNK; u /= NCHUNK; const int h = u & 3, b = u >> 2;
        if (cc < 4 && !need_ctx) continue;
        if (mx == 0) scanC_item<0>(c, l, b, h, cc, lds); else scanC_item<1>(c, l, b, h, cc, lds); }
}
PHASE_FN f_attn(int l) { const Ctx c = fresh_ctx(); ph_attn(c, l, g_lds); }
PHASE_FN f_gemm_out(int l) {
    const Ctx c = fresh_ctx(); char* lds = g_lds; const bool need_ctx = (l < DEPTH - 1);
    EpiResid e{&c, C_MODT + (size_t)l * 5 * 6144 + 2 * D};
    for (int it = blockIdx.x; it < 132 * 8; it += gridDim.x) { const int tm = it / 8, tn = it % 8;
        if ((tm % 33) == 0 && !need_ctx) continue;
        gemm_tile(c, C_HB, D, C_WOUT + (size_t)l * D * D, D, D, tm * 256, tn * 128, lds, e); }
    cvt_tables(c, l);
}
PHASE_FN f_peer_q(int l) {
    const Ctx c = fresh_ctx(); char* lds = g_lds; const bool need_ctx = (l < DEPTH - 1);
    EpiBf16 e{C_Q2, 2048};
    for (int it = blockIdx.x; it < 132 * 16; it += gridDim.x) { const int tm = it / 16, tn = it % 16;
        if ((tm % 33) == 0 && !need_ctx) continue;
        gemm_tile(c, C_HB, D, C_WQ + (size_t)l * 2048 * D, D, D, tm * 256, tn * 128, lds, e); }
}
PHASE_FN f_topk(int l) {
    const Ctx c = fresh_ctx(); char* lds = g_lds; const bool need_ctx = (l < DEPTH - 1);
    for (int it = blockIdx.x; it < 264 * 8; it += gridDim.x) { const int tm = it >> 3, h = it & 7;
        if ((tm % 66) < 2 && !need_ctx) continue;
        peer_topk_item(c, l, tm, h, lds); }
}
PHASE_FN f_expert(int l) { const Ctx c = fresh_ctx(); ph_peer_expert(c, l, g_lds); }
PHASE_FN f_final() { const Ctx c = fresh_ctx(); ph_final(c); }

__global__ void __launch_bounds__(512, 2) mk_fwd(Params p) {
    volatile LAS unsigned* bst = (volatile LAS unsigned*)(g_lds + LDS_BYTES - 16);
    if (threadIdx.x == 0) { bst[0] = 0u; bst[1] = 0u; bst[2] = 0u; bst[3] = 0u; }
    __syncthreads();
    XcdBarrier bar; bar.bar = (unsigned*)(p.ws + WS_CTL); bar.x = 0; bar.st = bst;
    const int lo = p.ph_lo, hi = p.ph_hi;
    const bool multi = (hi - lo) > 1;
    if (multi) bar = xcd_barrier_post((unsigned*)(p.ws + WS_CTL), bst);
#ifndef PHMASK
#define PHMASK 0xFFFF
#endif
#define EN(s) ((PHMASK >> (s)) & 1)
#define IN(k) (lo <= (k) && (k) < hi)
#define SEAM(k) do { if (IN(k) && IN((k) + 1)) xcd_barrier(bar); } while (0)
    if (EN(0) && IN(0)) f_p0();
    SEAM(0);
#define LAYER(l) do { constexpr int base = 1 + 11 * (l); \
        if (EN(1) && IN(base + 0)) f_norm0(l); SEAM(base + 0); \
        if (EN(2) && IN(base + 1)) f_gemm_in(l); SEAM(base + 1); \
        if (EN(3) && IN(base + 2)) f_prep(l); SEAM(base + 2); \
        if (EN(4) && IN(base + 3)) f_upproj(l); SEAM(base + 3); \
        if (EN(5) && IN(base + 4)) f_scanc(l); SEAM(base + 4); \
        if (EN(6) && IN(base + 5)) f_attn(l); SEAM(base + 5); \
        if (EN(7) && IN(base + 6)) f_gemm_out(l); SEAM(base + 6); \
        if (EN(8) && IN(base + 7)) f_norm1(l); SEAM(base + 7); \
        if (EN(9) && IN(base + 8)) f_peer_q(l); SEAM(base + 8); \
        if (EN(10) && IN(base + 9)) f_topk(l); SEAM(base + 9); \
        if (EN(11) && IN(base + 10)) f_expert(l); SEAM(base + 10); } while (0)
    LAYER(0);
    LAYER(1);
#undef LAYER
    if (EN(12) && IN(N_PHASES - 1)) f_final();
#undef IN
#undef SEAM
}

#ifdef DBG_STOP
#ifndef DBG_LO
#define DBG_LO WS_MOD
#endif
#ifndef DBG_HI
#define DBG_HI WS_END
#endif
#ifndef DBG_X
#define DBG_X 1
#endif
__global__ void __launch_bounds__(512) mk_dump(float* out, const unsigned* ws) {
    const size_t NOUT = (size_t)NB * SEQ * D; const size_t lo = (size_t)(DBG_LO) / 4, hi = (size_t)(DBG_HI) / 4;
    for (size_t i = (size_t)blockIdx.x * 512 + threadIdx.x; i < NOUT; i += (size_t)gridDim.x * 512) {
        float a = 0.f;
        if (DBG_X) { const unsigned w = __float_as_uint(out[i]); a += (float)((w ^ (w >> 16)) & 0xFFFFu) * 1e-3f; }
        for (size_t j = lo + i; j < hi; j += NOUT) { const unsigned w = ws[j]; a += (float)((w ^ (w >> 16)) & 0xFFFFu) * 1e-3f; }
#ifdef DBG_LO2
        for (size_t j = (size_t)(DBG_LO2) / 4 + i; j < (size_t)(DBG_HI2) / 4; j += NOUT) { const unsigned w = ws[j]; a += (float)((w ^ (w >> 16)) & 0xFFFFu) * 1e-3f; }
#endif
        out[i] = a;
    }
}
#endif
extern "C" void kernel_launch(void* const* d_in, const int* in_sizes, int n_in, void* d_out, int out_size, void* d_ws, size_t ws_size, hipStream_t stream) {
    static int grid = 0;
    if (grid == 0) {
        if (n_in != 26 || in_sizes[0] != NB * SEQ * D || out_size != NB * SEQ * D || ws_size < WS_END) {
            fprintf(stderr, "kernel_launch: shape/workspace mismatch: n_in %d in0 %d out %d ws %zu (need %zu); nothing launched\n", n_in, n_in > 0 ? in_sizes[0] : -1, out_size, ws_size, (size_t)WS_END);
            grid = -1; return; }
        int dev = 0, cus = 0, per_cu = 0;
        if (hipGetDevice(&dev) != hipSuccess || hipDeviceGetAttribute(&cus, hipDeviceAttributeMultiprocessorCount, dev) != hipSuccess) { grid = -1; return; }
        if (hipFuncSetAttribute((const void*)mk_fwd, hipFuncAttributeMaxDynamicSharedMemorySize, LDS_BYTES) != hipSuccess) { fprintf(stderr, "kernel_launch: hipFuncSetAttribute failed\n"); grid = -1; return; }
        if (hipOccupancyMaxActiveBlocksPerMultiprocessor(&per_cu, (const void*)mk_fwd, 512, LDS_BYTES) != hipSuccess || per_cu < 1)
            fprintf(stderr, "kernel_launch: note: occupancy query reports %d workgroups per CU\n", per_cu);
        (void)hipGetLastError();
        grid = cus;
    }
    if (grid < 0) return;
    if (hipMemsetAsync((char*)d_ws + WS_CTL, 0, CTL_BYTES, stream) != hipSuccess) { fprintf(stderr, "kernel_launch: memset failed\n"); return; }
    Params p{};
    for (int i = 0; i < 26; ++i) p.in[i] = (const float*)d_in[i];
    p.out = (float*)d_out; p.ws = (unsigned char*)d_ws;
#ifdef DBG_STOP
    for (int k = 0; k < DBG_STOP; ++k) { p.ph_lo = k; p.ph_hi = k + 1; hipLaunchKernelGGL(mk_fwd, dim3(grid), dim3(512), LDS_BYTES, stream, p); }
    hipLaunchKernelGGL(mk_dump, dim3(1024), dim3(512), 0, stream, (float*)d_out, (const unsigned*)d_ws);
#elif MK_PER_PHASE
    for (int k = 0; k < N_PHASES; ++k) { p.ph_lo = k; p.ph_hi = k + 1; hipLaunchKernelGGL(mk_fwd, dim3(grid), dim3(512), LDS_BYTES, stream, p); }
#else
    p.ph_lo = 0; p.ph_hi = N_PHASES; hipLaunchKernelGGL(mk_fwd, dim3(grid), dim3(512), LDS_BYTES, stream, p);
#endif
    const hipError_t le = hipPeekAtLastError();
    if (le != hipSuccess) fprintf(stderr, "kernel_launch: launch failed: %s\n", hipGetErrorName(le));
}
```

```cpp
#include <hip/hip_runtime.h>
#include <cstdio>
#include <cstdint>

#ifndef MK_PER_PHASE
#define MK_PER_PHASE 0
#endif

constexpr int D = 1024, NB = 4, SEQ = 8192, CTX = 256, DEPTH = 2;
constexpr int RPB = CTX + SEQ;
constexpr int NR = NB * RPB;
constexpr int INC = 3200;
constexpr int GLA_Q = 0, GLA_K = 128, GLA_V = 256, GLA_R = 512, GLA_ZF = 768, GLA_ZB = 784;
constexpr int HG_Q = 800, HG_I = 1056, HG_OG = 1312, HG_ZF = 1568, HG_ZB = 1824;
constexpr int MLA_CQ = 2080, MLA_CKV = 2272, MLA_KR = 2400;
constexpr int DF_Q = 2432, DF_K = 2688, DF_V = 2944;
constexpr int NCHUNK = RPB / 64;
constexpr int NEXP = 16384;
constexpr float NORM_EPS = 1e-6f;

typedef unsigned short bf16_t;
typedef short bf16x8 __attribute__((ext_vector_type(8)));
typedef short s16x4 __attribute__((ext_vector_type(4)));
typedef float f32x16 __attribute__((ext_vector_type(16)));
typedef float f32x4 __attribute__((ext_vector_type(4)));
typedef unsigned u32x4 __attribute__((ext_vector_type(4)));
typedef unsigned u32x2 __attribute__((ext_vector_type(2)));

constexpr size_t al256(size_t x) { return (x + 255) / 256 * 256; }
constexpr size_t WS_CTL = 0;
constexpr size_t CTL_BYTES = 65536;
constexpr size_t WS_MOD = WS_CTL + CTL_BYTES;
constexpr size_t WS_XC = al256(WS_MOD + (size_t)2 * 5 * 6144 * 4);
constexpr size_t WS_WIN = al256(WS_XC + (size_t)NB * CTX * D * 4);
constexpr size_t WS_WOUT = al256(WS_WIN + (size_t)2 * INC * D * 2);
constexpr size_t WS_WQ = al256(WS_WOUT + (size_t)2 * D * D * 2);
constexpr size_t WS_WUQ = al256(WS_WQ + (size_t)2 * 2048 * D * 2);
constexpr size_t WS_WUKV = al256(WS_WUQ + (size_t)2 * 384 * 192 * 2);
constexpr size_t WS_KEYS = al256(WS_WUKV + (size_t)2 * 512 * 128 * 2);
constexpr size_t WS_HB = al256(WS_KEYS + (size_t)2 * 16 * 128 * 128 * 2);
constexpr size_t WS_QM = al256(WS_HB + (size_t)NR * D * 2);
constexpr size_t WS_KVM = al256(WS_QM + (size_t)NR * 384 * 2);
constexpr size_t WS_SG = al256(WS_KVM + (size_t)NR * 512 * 2);
constexpr size_t WS_SH = al256(WS_SG + (size_t)32 * NCHUNK * 2048 * 4);
constexpr size_t WS_DG = al256(WS_SH + (size_t)32 * NCHUNK * 4096 * 4);
constexpr size_t WS_DH = al256(WS_DG + (size_t)32 * NCHUNK * 32 * 4);
constexpr size_t WS_P = al256(WS_DH + (size_t)32 * NCHUNK * 64 * 4);
constexpr size_t WS_END = al256(WS_P + (size_t)NR * INC * 2);
constexpr size_t WS_TU8 = WS_P;
constexpr size_t WS_TV8 = WS_P + (size_t)NEXP * D;
constexpr size_t WS_SU = WS_TV8 + (size_t)NEXP * D;
constexpr size_t WS_SV = WS_SU + (size_t)NEXP * 4;
constexpr size_t WS_Q2 = WS_P + (size_t)64 * 1024 * 1024;
constexpr size_t WS_PART = WS_Q2;
static_assert(WS_SV + (size_t)NEXP * 4 <= WS_Q2, "alias overflow 0");
static_assert(WS_Q2 + (size_t)NR * 2048 * 2 <= WS_END, "alias overflow");
constexpr size_t WS_EI = WS_SG;
constexpr size_t WS_EG = WS_EI + (size_t)NR * 128 * 4;
static_assert(WS_EG + (size_t)NR * 128 * 4 <= WS_DG, "alias overflow 2");

#define XB_TMO      128
#define XB_XCNT(j)  (256  + 64 * (j))
#define XB_XSUB(j)  (1280 + 64 * (j))
#define XB_XGEN(j)  (2304 + 64 * (j))
#define XB_TOP      3328
#define XB_TOPGEN   3392
#define XCD_BAR_WORDS 3456
#define XB_SPIN_CAP (1u << 22)
#define LAS __attribute__((address_space(3)))

__device__ __forceinline__ unsigned xb_ld(unsigned* p)              { return __hip_atomic_load(p, __ATOMIC_RELAXED, __HIP_MEMORY_SCOPE_AGENT); }
__device__ __forceinline__ unsigned xb_add(unsigned* p, unsigned v) { return __hip_atomic_fetch_add(p, v, __ATOMIC_RELAXED, __HIP_MEMORY_SCOPE_AGENT); }
__device__ __forceinline__ unsigned xb_xcc_id() { return (unsigned)__builtin_amdgcn_s_getreg((3 << 11) | 20) & 0xFu; }
#define XB_SPIN(cond, bar) do { unsigned _sp = 0; while (cond) { __builtin_amdgcn_s_sleep(1); \
    if ((++_sp & 255u) == 0u) { if (xb_ld(&(bar)[XB_TMO])) break; if (_sp > XB_SPIN_CAP) { atomicAdd(&(bar)[XB_TMO], 1u); break; } } } } while (0)

struct XcdBarrier { unsigned* bar; unsigned x; volatile LAS unsigned* st; };

__device__ __forceinline__ XcdBarrier xcd_barrier_post(unsigned* bar, volatile LAS unsigned* st) {
    XcdBarrier b; b.bar = bar; b.x = xb_xcc_id(); b.st = st;
    if (threadIdx.x == 0) (void)xb_add(&bar[XB_XCNT(b.x)], 1u);
    return b;
}
__device__ __forceinline__ void xcd_barrier_complete(unsigned* bar, unsigned x, unsigned& nloc, unsigned& nx) {
    const unsigned G = gridDim.x * gridDim.y * gridDim.z;
    unsigned sum, cnt, mine, sp = 0u;
    for (;;) {
        sum = 0u; cnt = 0u; mine = 0u;
#pragma unroll
        for (unsigned j = 0; j < 16; ++j) { const unsigned c = xb_ld(&bar[XB_XCNT(j)]); sum += c; cnt += (c > 0u) ? 1u : 0u; mine = (j == x) ? c : mine; }
        if (sum == G) break;
        __builtin_amdgcn_s_sleep(1);
        if ((++sp & 255u) == 0u) { if (xb_ld(&bar[XB_TMO])) break; if (sp > XB_SPIN_CAP) { atomicAdd(&bar[XB_TMO], 1u); break; } }
    }
    nloc = mine > 0u ? mine : 1u; nx = cnt > 0u ? cnt : 1u;
}
__device__ __forceinline__ void xcd_barrier(const XcdBarrier& b) {
    asm volatile("s_waitcnt vmcnt(0)" ::: "memory");
    __syncthreads();
    if (threadIdx.x == 0) {
        unsigned* bar = b.bar;
        __builtin_amdgcn_s_waitcnt(0);
        unsigned nloc = b.st[0], nx = b.st[1];
        if (nloc == 0u) { xcd_barrier_complete(bar, b.x, nloc, nx); b.st[0] = nloc; b.st[1] = nx; }
        const unsigned old = xb_add(&bar[XB_XSUB(b.x)], 1u);
        const unsigned gen = old / nloc;
        if (old + 1u == (gen + 1u) * nloc) {
            __builtin_amdgcn_fence(__ATOMIC_RELEASE, "agent");
            asm volatile("s_waitcnt vmcnt(0)" ::: "memory");
            const unsigned og = xb_add(&bar[XB_TOP], 1u);
            const unsigned tg = og / nx;
            if (og + 1u == (tg + 1u) * nx) xb_add(&bar[XB_TOPGEN], 1u);
            else XB_SPIN(xb_ld(&bar[XB_TOPGEN]) == tg, bar);
            __builtin_amdgcn_fence(__ATOMIC_ACQUIRE, "agent");
            xb_add(&bar[XB_XGEN(b.x)], 1u);
            asm volatile("s_waitcnt vmcnt(0)" ::: "memory");
        } else {
            XB_SPIN(xb_ld(&bar[XB_XGEN(b.x)]) == gen, bar);
            __builtin_amdgcn_fence(__ATOMIC_ACQUIRE, "agent");
            asm volatile("s_waitcnt vmcnt(0)" ::: "memory");
        }
    }
    __syncthreads();
}

typedef __bf16 bf16v2_t __attribute__((ext_vector_type(2)));
typedef float f32v2_t __attribute__((ext_vector_type(2)));
__device__ __forceinline__ unsigned cvtpk(float lo, float hi) { const f32v2_t v = {lo, hi}; const bf16v2_t b = __builtin_convertvector(v, bf16v2_t); return __builtin_bit_cast(unsigned, b); }
__device__ __forceinline__ bf16_t f2bf(float x) { const __bf16 b = (__bf16)x; return __builtin_bit_cast(bf16_t, b); }
__device__ __forceinline__ float bf2f(bf16_t h) { return __uint_as_float(((unsigned)h) << 16); }
__device__ __forceinline__ float bflo(unsigned w) { return __uint_as_float(w << 16); }
__device__ __forceinline__ float bfhi(unsigned w) { return __uint_as_float(w & 0xffff0000u); }
__device__ __forceinline__ float silu_f(float x) { return x / (1.f + __expf(-x)); }
__device__ __forceinline__ float logsigmoid_f(float z) { return fminf(z, 0.f) - __logf(1.f + __expf(-fabsf(z))); }
__device__ __forceinline__ float wave_sum(float v) {
#pragma unroll
    for (int o = 32; o >= 1; o >>= 1) v += __shfl_xor(v, o, 64);
    return v;
}
__device__ __forceinline__ void zero_acc(f32x16& a) {
#pragma unroll
    for (int r = 0; r < 16; ++r) a[r] = 0.f;
    asm volatile("" : "+v"(a));
}
__device__ __forceinline__ int crow(int r, int hi) { return (r & 3) + 8 * (r >> 2) + 4 * hi; }

struct Params { const float* in[26]; float* out; unsigned char* ws; int ph_lo, ph_hi; };
typedef const __attribute__((address_space(4))) Params* KParams;
struct Ctx {
    KParams pp;
    int tid, lane, wid;
};
__device__ __forceinline__ Ctx fresh_ctx() {
    Ctx c; unsigned long long a = (unsigned long long)__builtin_amdgcn_kernarg_segment_ptr(); asm volatile("" : "+s"(a)); c.pp = (KParams)a;
    int t = threadIdx.x; asm volatile("" : "+v"(t)); c.tid = t; c.lane = t & 63; c.wid = __builtin_amdgcn_readfirstlane(t >> 6);
    return c;
}
#define CIN(i)   (c.pp->in[i])
#define COUT     (c.pp->out)
#define CWS(off) (c.pp->ws + (off))
#define C_MODT ((float*)CWS(WS_MOD))
#define C_XC   ((float*)CWS(WS_XC))
#define C_WIN  ((bf16_t*)CWS(WS_WIN))
#define C_WOUT ((bf16_t*)CWS(WS_WOUT))
#define C_WQ   ((bf16_t*)CWS(WS_WQ))
#define C_WUQ  ((bf16_t*)CWS(WS_WUQ))
#define C_WUKV ((bf16_t*)CWS(WS_WUKV))
#define C_KEYS ((bf16_t*)CWS(WS_KEYS))
#define C_HB   ((bf16_t*)CWS(WS_HB))
#define C_QM   ((bf16_t*)CWS(WS_QM))
#define C_KVM  ((bf16_t*)CWS(WS_KVM))
#define C_P    ((bf16_t*)CWS(WS_P))
#define C_TU8  ((unsigned char*)CWS(WS_TU8))
#define C_TV8  ((unsigned char*)CWS(WS_TV8))
#define C_SU   ((float*)CWS(WS_SU))
#define C_SV   ((float*)CWS(WS_SV))
#define C_PART ((float*)CWS(WS_PART))
#define C_Q2   ((bf16_t*)CWS(WS_Q2))
#define C_SG   ((float*)CWS(WS_SG))
#define C_SH   ((float*)CWS(WS_SH))
#define C_DG   ((float*)CWS(WS_DG))
#define C_DH   ((float*)CWS(WS_DH))
#define C_EI   ((int*)CWS(WS_EI))
#define C_EG   ((float*)CWS(WS_EG))

__device__ __forceinline__ float* xrow(const Ctx& c, int r) {
    const int b = r / RPB, j = r - b * RPB;
    return j < CTX ? C_XC + ((size_t)(b * CTX + j) << 10) : COUT + ((size_t)(b * SEQ + (j - CTX)) << 10);
}
__device__ __forceinline__ const float* inrow(const Ctx& c, int r) {
    const int b = r / RPB, j = r - b * RPB;
    return j < CTX ? CIN(2) + ((size_t)(b * CTX + j) << 10) : CIN(0) + ((size_t)(b * SEQ + (j - CTX)) << 10);
}

__device__ void p0_mod_item(const Ctx& c, int item, char* lds) {
    float* sc = (float*)lds;
    float* red = sc + 5 * 1024;
    const int tid = c.tid;
    for (int i = tid; i < 5 * 1024; i += 512) { const int v = i >> 10, k = i & 1023; const float x = (v < 4) ? CIN(1)[v * 1024 + k] : CIN(3)[k]; sc[i] = silu_f(x); }
    __syncthreads();
    const int l = item / 96, n0 = (item % 96) * 64;
    const int col = tid & 63, kg = tid >> 6;
    const float* w = CIN(4) + (size_t)l * 1024 * 6144 + n0 + col;
    float a[5] = {0.f, 0.f, 0.f, 0.f, 0.f};
#pragma unroll 8
    for (int kk = 0; kk < 128; ++kk) { const int k = kg * 128 + kk; const float wv = w[(size_t)k * 6144];
#pragma unroll
        for (int v = 0; v < 5; ++v) a[v] += sc[v * 1024 + k] * wv; }
#pragma unroll
    for (int v = 0; v < 5; ++v) red[(kg * 64 + col) * 5 + v] = a[v];
    __syncthreads();
    if (tid < 320) { const int cc = tid / 5, v = tid % 5; float s = 0.f;
#pragma unroll
        for (int g = 0; g < 8; ++g) s += red[(g * 64 + cc) * 5 + v];
        C_MODT[((size_t)l * 5 + v) * 6144 + n0 + cc] = s + CIN(5)[l * 6144 + n0 + cc]; }
    __syncthreads();
}
__device__ void p0_tr_tile(const float* __restrict__ src, bf16_t* __restrict__ dst, int K, int N, int k0, int n0, int tid, char* lds) {
    float* t = (float*)lds;
#pragma unroll
    for (int i = 0; i < 2; ++i) { const int k = (tid >> 4) + 32 * i, n4 = (tid & 15) * 4;
        const f32x4 v = *(const f32x4*)(src + (size_t)(k0 + k) * N + n0 + n4);
        t[k * 65 + n4 + 0] = v[0]; t[k * 65 + n4 + 1] = v[1]; t[k * 65 + n4 + 2] = v[2]; t[k * 65 + n4 + 3] = v[3]; }
    __syncthreads();
    { const int n = tid >> 3, k8 = (tid & 7) * 8; u32x4 w;
#pragma unroll
        for (int j = 0; j < 4; ++j) w[j] = cvtpk(t[(k8 + 2 * j) * 65 + n], t[(k8 + 2 * j + 1) * 65 + n]);
        *(u32x4*)(dst + (size_t)(n0 + n) * K + k0 + k8) = w; }
    __syncthreads();
}
__device__ void ph_p0(const Ctx& c, char* lds) {
    constexpr int T_WIN = 16 * 50, T_WOUT = 16 * 16, T_WQ = 16 * 32, T_UQ = 3 * 6, T_UKV = 2 * 8;
    constexpr int PER_L = T_WIN + T_WOUT + T_WQ + T_UQ + T_UKV;
    constexpr int NITEM = 192 + 2 * PER_L;
    for (int it = blockIdx.x; it < NITEM; it += gridDim.x) {
        if (it < 192) { p0_mod_item(c, it, lds); continue; }
        int t = it - 192; const int l = t / PER_L; t -= l * PER_L;
        if (t < T_WIN) { p0_tr_tile(CIN(8) + (size_t)l * D * INC, C_WIN + (size_t)l * INC * D, D, INC, (t / 50) * 64, (t % 50) * 64, c.tid, lds); continue; } t -= T_WIN;
        if (t < T_WOUT) { p0_tr_tile(CIN(9) + (size_t)l * D * D, C_WOUT + (size_t)l * D * D, D, D, (t / 16) * 64, (t % 16) * 64, c.tid, lds); continue; } t -= T_WOUT;
        if (t < T_WQ) { p0_tr_tile(CIN(21) + (size_t)l * D * 2048, C_WQ + (size_t)l * 2048 * D, D, 2048, (t / 32) * 64, (t % 32) * 64, c.tid, lds); continue; } t -= T_WQ;
        if (t < T_UQ) { p0_tr_tile(CIN(17) + (size_t)l * 192 * 384, C_WUQ + (size_t)l * 384 * 192, 192, 384, (t / 6) * 64, (t % 6) * 64, c.tid, lds); continue; } t -= T_UQ;
        p0_tr_tile(CIN(18) + (size_t)l * 128 * 512, C_WUKV + (size_t)l * 512 * 128, 128, 512, (t / 8) * 64, (t % 8) * 64, c.tid, lds);
    }
    const size_t nk8 = (size_t)2 * 16 * 128 * 128 / 8;
    for (size_t i = (size_t)blockIdx.x * 512 + c.tid; i < nk8; i += (size_t)gridDim.x * 512) {
        const f32x4 a = *(const f32x4*)(CIN(22) + i * 8), b = *(const f32x4*)(CIN(22) + i * 8 + 4);
        u32x4 w = {cvtpk(a[0], a[1]), cvtpk(a[2], a[3]), cvtpk(b[0], b[1]), cvtpk(b[2], b[3])};
        *(u32x4*)(C_KEYS + i * 8) = w;
    }
}

template <int WHICH>
__device__ void ph_norm(const Ctx& c, int l) {
    const float* g = CIN(WHICH == 0 ? 6 : 7) + l * D;
    const bool need_ctx = (l < DEPTH - 1);
    for (int r = blockIdx.x * 8 + c.wid; r < NR; r += gridDim.x * 8) {
        const int b = r / RPB, j = r - b * RPB; const bool isctx = j < CTX;
        if (WHICH == 1 && isctx && !need_ctx) continue;
        const float* src = (WHICH == 0 && l == 0) ? inrow(c, r) : xrow(c, r);
        f32x4 x[4]; float ss = 0.f;
#pragma unroll
        for (int i = 0; i < 4; ++i) { x[i] = *(const f32x4*)(src + i * 256 + c.lane * 4); ss += x[i][0] * x[i][0] + x[i][1] * x[i][1] + x[i][2] * x[i][2] + x[i][3] * x[i][3]; }
        ss = wave_sum(ss);
        const float rstd = rsqrtf(ss * (1.f / D) + NORM_EPS);
        const float* mt = C_MODT + ((size_t)l * 5 + (isctx ? 4 : b)) * 6144;
        const float* sh = mt + (WHICH == 0 ? 0 : 3) * D; const float* scl = mt + (WHICH == 0 ? 1 : 4) * D;
        bf16_t* dst = C_HB + (size_t)r * D;
        float* xr = xrow(c, r);
#pragma unroll
        for (int i = 0; i < 4; ++i) { const int col = i * 256 + c.lane * 4;
            const f32x4 gv = *(const f32x4*)(g + col), sv = *(const f32x4*)(sh + col), cv = *(const f32x4*)(scl + col);
            float y[4];
#pragma unroll
            for (int e = 0; e < 4; ++e) y[e] = x[i][e] * rstd * gv[e] * (1.f + cv[e]) + sv[e];
            u32x2 w = {cvtpk(y[0], y[1]), cvtpk(y[2], y[3])};
            *(u32x2*)(dst + col) = w;
            if (WHICH == 0 && l == 0) *(f32x4*)(xr + col) = x[i]; }
    }
}

constexpr int GEMM_LDS = 98304;
template <class Epi>
__device__ __forceinline__ void gemm_tile(const Ctx& c, const bf16_t* __restrict__ A, int lda, const bf16_t* __restrict__ Bt, int ldb, int K, int m0, int n0, char* lds, const Epi& epi) {
    const int tid = c.tid, lane = tid & 63, wid = tid >> 6, r32 = lane & 31, hi = lane >> 5, wm = wid >> 1, wn = wid & 1;
    char* As = lds; char* Bs = lds + 65536;
    f32x16 acc[2][2];
#pragma unroll
    for (int m = 0; m < 2; ++m)
#pragma unroll
        for (int n = 0; n < 2; ++n) zero_acc(acc[m][n]);
    u32x4 ra[4], rb[2];
    const int srow = tid >> 3, sch = tid & 7;
    const bf16_t* Ag = A + (size_t)(m0 + srow) * lda + sch * 8;
    const bf16_t* Bg = Bt + (size_t)(n0 + srow) * ldb + sch * 8;
    const int swoff = srow * 128 + ((sch ^ ((srow >> 1) & 7)) << 4);
#define GLOAD(k0) do { _Pragma("unroll") for (int i = 0; i < 4; ++i) ra[i] = *(const u32x4*)(Ag + (size_t)(64 * i) * lda + (k0)); \
                       _Pragma("unroll") for (int i = 0; i < 2; ++i) rb[i] = *(const u32x4*)(Bg + (size_t)(64 * i) * ldb + (k0)); } while (0)
#define SWRITE(buf) do { _Pragma("unroll") for (int i = 0; i < 4; ++i) *(u32x4*)(As + (buf) * 32768 + swoff + i * 8192) = ra[i]; \
                         _Pragma("unroll") for (int i = 0; i < 2; ++i) *(u32x4*)(Bs + (buf) * 16384 + swoff + i * 8192) = rb[i]; } while (0)
    const int nk = K >> 6;
    GLOAD(0); SWRITE(0); __syncthreads();
    for (int kt = 0; kt < nk; ++kt) {
        const int buf = kt & 1;
        if (kt + 1 < nk) GLOAD((kt + 1) * 64);
        const char* Ab = As + buf * 32768; const char* Bb = Bs + buf * 16384;
#pragma unroll
        for (int ks = 0; ks < 4; ++ks) {
            bf16x8 a[2], b[2];
#pragma unroll
            for (int m = 0; m < 2; ++m) { const int row = wm * 64 + m * 32 + r32; a[m] = *(const bf16x8*)(Ab + row * 128 + (((ks * 2 + hi) ^ ((row >> 1) & 7)) << 4)); }
#pragma unroll
            for (int n = 0; n < 2; ++n) { const int row = wn * 64 + n * 32 + r32; b[n] = *(const bf16x8*)(Bb + row * 128 + (((ks * 2 + hi) ^ ((row >> 1) & 7)) << 4)); }
#pragma unroll
            for (int m = 0; m < 2; ++m)
#pragma unroll
                for (int n = 0; n < 2; ++n) acc[m][n] = __builtin_amdgcn_mfma_f32_32x32x16_bf16(a[m], b[n], acc[m][n], 0, 0, 0);
        }
        if (kt + 1 < nk) SWRITE(buf ^ 1);
        __syncthreads();
    }
#undef GLOAD
#undef SWRITE
    epi(acc, m0 + wm * 64, n0 + wn * 64, r32, hi);
}
struct EpiBf16 {
    bf16_t* C; int ldc;
    __device__ __forceinline__ void operator()(const f32x16 (&acc)[2][2], int row0, int col0, int r32, int hi) const {
        bf16_t* base = C + (size_t)(row0 + 4 * hi) * ldc + col0 + r32;
#pragma unroll
        for (int m = 0; m < 2; ++m)
#pragma unroll
            for (int r = 0; r < 16; ++r) { bf16_t* p = base + (size_t)(m * 32 + (r & 3) + 8 * (r >> 2)) * ldc;
                p[0] = f2bf(acc[m][0][r]); p[32] = f2bf(acc[m][1][r]);
                asm volatile("" ::: "memory"); }
    }
};
struct EpiResid {
    const Ctx* c; const float* gate_l;
    __device__ __forceinline__ void operator()(const f32x16 (&acc)[2][2], int row0, int col0, int r32, int hi) const {
        const int b = row0 / RPB, j0 = row0 - b * RPB; const bool isctx = j0 < CTX;
        const float* gt = gate_l + (size_t)(isctx ? 4 : b) * 6144;
        float* xb = xrow(*c, row0);
        const float gv0 = gt[col0 + r32], gv1 = gt[col0 + 32 + r32];
        float* xq = xb + ((size_t)(4 * hi) << 10) + col0 + r32;
#pragma unroll
        for (int m = 0; m < 2; ++m)
#pragma unroll
            for (int r = 0; r < 16; ++r) { float* p = xq + ((size_t)(m * 32 + (r & 3) + 8 * (r >> 2)) << 10);
                const float a0 = p[0], a1 = p[32];
                p[0] = a0 + gv0 * acc[m][0][r]; p[32] = a1 + gv1 * acc[m][1][r];
                asm volatile("" ::: "memory"); }
    }
};

__device__ void ph_gemm_in(const Ctx& c, int l, char* lds) {
    EpiBf16 e{C_P, INC};
    const bf16_t* Bt = C_WIN + (size_t)l * INC * D;
    for (int it = blockIdx.x; it < 132 * 25; it += gridDim.x) { const int tm = it / 25, tn = it % 25; gemm_tile(c, C_HB, D, Bt, D, D, tm * 256, tn * 128, lds, e); }
}

template <int MX> struct ScanCfg;
template <> struct ScanCfg<0> { static constexpr int DK = 32; };
template <> struct ScanCfg<1> { static constexpr int DK = 64; };

constexpr int BP = 72;
typedef float f32x4v __attribute__((ext_vector_type(4)));
__device__ __forceinline__ bf16x8 frag16(const bf16_t* tile, int row0, int k0, int lane) { return *(const bf16x8*)(tile + (row0 + (lane & 15)) * BP + k0 + 8 * (lane >> 4)); }

template <int MX, bool WANT_Q>
__device__ __forceinline__ void scan_load(const Ctx& c, int l, int b, int h, int cc, int dir, float* qt, float* kt, float* gt, bf16_t* VT, float* tmp) {
    constexpr int DK = ScanCfg<MX>::DK, PK = DK + 1;
    const int tid = c.tid;
    const int t = tid >> 3, j0 = (tid & 7) * 8;
    const bf16_t* pr = C_P + (size_t)(b * RPB + cc * 64 + (dir ? 63 - t : t)) * INC;
    const u32x4 vv = *(const u32x4*)(pr + (MX == 0 ? GLA_V : HG_I) + h * 64 + j0);
    if (MX == 0) {
        float* zt = tmp; float* wt = tmp + 64 * 16; float* bt = wt + 16 * 32;
        const int j4 = (tid & 7) * 4;
        const u32x2 kv = *(const u32x2*)(pr + GLA_K + h * 32 + j4);
        u32x2 qv = {0u, 0u}; if (WANT_Q) qv = *(const u32x2*)(pr + GLA_Q + h * 32 + j4);
        u32x4 zv = {0u, 0u, 0u, 0u};
        if (tid < 128) zv = *(const u32x4*)(C_P + (size_t)(b * RPB + cc * 64 + (dir ? 63 - (tid >> 1) : (tid >> 1))) * INC + (dir ? GLA_ZB : GLA_ZF) + (tid & 1) * 8);
        { const int k = tid >> 5, j = tid & 31; wt[tid] = CIN(10)[(((size_t)l * 2 + dir) * 16 + k) * 128 + h * 32 + j]; }
        if (tid < 32) bt[tid] = CIN(11)[((size_t)l * 2 + dir) * 128 + h * 32 + tid];
        if (tid < 128) { float* zp = zt + (tid >> 1) * 16 + (tid & 1) * 8;
#pragma unroll
            for (int q = 0; q < 4; ++q) { zp[2 * q] = bflo(zv[q]); zp[2 * q + 1] = bfhi(zv[q]); } }
        __syncthreads();
#pragma unroll
        for (int e = 0; e < 4; ++e) { const int j = j4 + e;
            float a = bt[j];
#pragma unroll
            for (int k = 0; k < 16; ++k) a += zt[t * 16 + k] * wt[k * 32 + j];
            gt[t * PK + j] = logsigmoid_f(a) * (1.f / 16.f);
            kt[t * PK + j] = (e & 1) ? bfhi(kv[e >> 1]) : bflo(kv[e >> 1]);
            if (WANT_Q) qt[t * PK + j] = ((e & 1) ? bfhi(qv[e >> 1]) : bflo(qv[e >> 1])) * 0.17677669529663687f; }
    } else {
        const u32x4 zv = *(const u32x4*)(pr + (dir ? HG_ZB : HG_ZF) + h * 64 + j0);
        u32x4 qv = {0u, 0u, 0u, 0u}; if (WANT_Q) qv = *(const u32x4*)(pr + HG_Q + h * 64 + j0);
        float lbv[8];
#pragma unroll
        for (int e = 0; e < 8; ++e) lbv[e] = 0.f;
        if (l > 0) { const f32x4 r0a = *(const f32x4*)(CIN(13) + h * 64 + j0), r0b = *(const f32x4*)(CIN(13) + h * 64 + j0 + 4);
                     const f32x4 r1a = *(const f32x4*)(CIN(13) + 256 + h * 64 + j0), r1b = *(const f32x4*)(CIN(13) + 256 + h * 64 + j0 + 4);
#pragma unroll
            for (int e = 0; e < 4; ++e) { lbv[e] = 1.f / (1.f + __expf(r0a[e] - r1a[e])); lbv[4 + e] = 1.f / (1.f + __expf(r0b[e] - r1b[e])); } }
#pragma unroll
        for (int e = 0; e < 8; ++e) { const int j = j0 + e;
            const float z = (e & 1) ? bfhi(zv[e >> 1]) : bflo(zv[e >> 1]); const float lb = lbv[e];
            const float log_lb = __logf(fmaxf(lb, 1e-30f)), log_1mlb = __logf(1.f - lb);
            const float ls = logsigmoid_f(z); const float a1 = log_lb, a2 = log_1mlb + ls;
            gt[t * PK + j] = fmaxf(a1, a2) + __logf(1.f + __expf(-fabsf(a1 - a2)));
            kt[t * PK + j] = (1.f - lb) / (1.f + __expf(z));
            if (WANT_Q) qt[t * PK + j] = silu_f((e & 1) ? bfhi(qv[e >> 1]) : bflo(qv[e >> 1])); }
    }
#pragma unroll
    for (int e = 0; e < 8; ++e) VT[(j0 + e) * BP + t] = (bf16_t)((e & 1) ? (vv[e >> 1] >> 16) : (vv[e >> 1] & 0xffffu));
    __syncthreads();
    { float x[DK / 8];
#pragma unroll
        for (int u = 0; u < DK / 8; ++u) x[u] = gt[c.lane * PK + c.wid + 8 * u];
#pragma unroll
        for (int d = 1; d < 64; d <<= 1)
#pragma unroll
            for (int u = 0; u < DK / 8; ++u) { const float y = __shfl_up(x[u], d, 64); if (c.lane >= d) x[u] += y; }
#pragma unroll
        for (int u = 0; u < DK / 8; ++u) gt[c.lane * PK + c.wid + 8 * u] = x[u]; }
    __syncthreads();
}

template <int MX>
__device__ void scanA_item(const Ctx& c, int l, int b, int h, int cc, int dir, char* lds) {
    constexpr int DK = ScanCfg<MX>::DK, PK = DK + 1;
    float* kt = (float*)lds; float* gt = kt + 64 * PK; bf16_t* VT = (bf16_t*)(gt + 64 * PK); bf16_t* KET = VT + 64 * BP; float* tmp = (float*)(KET + 64 * BP);
    scan_load<MX, false>(c, l, b, h, cc, dir, nullptr, kt, gt, VT, tmp);
    const int tid = c.tid, lane = c.lane;
    for (int i = tid; i < 64 * DK; i += 512) { const int s_ = i & 63, k = i >> 6; KET[k * BP + s_] = f2bf(kt[s_ * PK + k] * __expf(gt[63 * PK + k] - gt[s_ * PK + k])); }
    __syncthreads();
    const int ch = (b * 4 + h) * 2 + dir;
    float* S = (MX == 0 ? C_SG : C_SH) + ((size_t)ch * NCHUNK + cc) * (DK * 64);
    for (int tile = c.wid; tile < (DK / 16) * 4; tile += 8) { const int tk = tile >> 2, tj = tile & 3;
        f32x4v acc = {0.f, 0.f, 0.f, 0.f};
#pragma unroll
        for (int ks = 0; ks < 2; ++ks) acc = __builtin_amdgcn_mfma_f32_16x16x32_bf16(frag16(KET, tk * 16, ks * 32, lane), frag16(VT, tj * 16, ks * 32, lane), acc, 0, 0, 0);
#pragma unroll
        for (int i = 0; i < 4; ++i) S[(tk * 16 + 4 * (lane >> 4) + i) * 64 + tj * 16 + (lane & 15)] = acc[i]; }
    if (tid < DK) (MX == 0 ? C_DG : C_DH)[((size_t)ch * NCHUNK + cc) * DK + tid] = __expf(gt[63 * PK + tid]);
    __syncthreads();
}
__device__ void scanB_item(const Ctx& c, int item) {
    const int e = item * 512 + c.tid;
    const bool hg = e >= 65536; const int ee = hg ? e - 65536 : e;
    const int DK = hg ? 64 : 32; const int per = DK * 64;
    const int ch = ee / per, ij = ee % per, i = ij >> 6; const int dir = ch & 1;
    float* S = (hg ? C_SH : C_SG) + (size_t)ch * NCHUNK * per + ij;
    const float* Dc = (hg ? C_DH : C_DG) + (size_t)ch * NCHUNK * DK + i;
    float st = 0.f;
    for (int n0 = 0; n0 < NCHUNK; n0 += 6) {
        float sv[6], dv[6];
#pragma unroll
        for (int u = 0; u < 6; ++u) { const int n = n0 + u; const int cc = dir ? (n < 4 ? 3 - n : 135 - n) : n; sv[u] = S[(size_t)cc * per]; dv[u] = Dc[(size_t)cc * DK]; }
#pragma unroll
        for (int u = 0; u < 6; ++u) { const int n = n0 + u; const int cc = dir ? (n < 4 ? 3 - n : 135 - n) : n; S[(size_t)cc * per] = st; st = dv[u] * st + sv[u]; }
    }
}
template <int MX>
__device__ void scanC_item(const Ctx& c, int l, int b, int h, int cc, char* lds) {
    constexpr int DK = ScanCfg<MX>::DK, PK = DK + 1;
    float* qt = (float*)lds; float* kt = qt + 64 * PK; float* gt = kt + 64 * PK; float* ot = gt + 64 * PK;
    bf16_t* VT = (bf16_t*)(ot + 64 * 65); bf16_t* QS = VT + 64 * BP; bf16_t* QG = QS + 64 * BP; bf16_t* KS = QG + 64 * BP;
    bf16_t* SC = KS + 96 * BP; bf16_t* ST = SC + 64 * BP; float* tmp = (float*)(ST + 64 * BP);
    const int tid = c.tid, lane = c.lane;
    for (int dir = 0; dir < 2; ++dir) {
        scan_load<MX, true>(c, l, b, h, cc, dir, qt, kt, gt, VT, tmp);
        const int ch = (b * 4 + h) * 2 + dir;
        const float* Sg = (MX == 0 ? C_SG : C_SH) + ((size_t)ch * NCHUNK + cc) * (DK * 64);
        if (tid < DK * 8) { const int k = tid >> 3, jb = (tid & 7) * 8; const f32x4 sa = *(const f32x4*)(Sg + tid * 8), sb = *(const f32x4*)(Sg + tid * 8 + 4);
#pragma unroll
            for (int e = 0; e < 4; ++e) { ST[(jb + e) * BP + k] = f2bf(sa[e]); ST[(jb + 4 + e) * BP + k] = f2bf(sb[e]); } }
        for (int i = tid; i < 64 * DK; i += 512) { const int t = i / DK, k = i % DK; const int I = t >> 4;
            const float bt = gt[t * PK + k], qv = qt[t * PK + k], kv = kt[t * PK + k];
            const float Bi = I ? gt[(16 * I - 1) * PK + k] : 0.f;
            QS[t * BP + k] = f2bf(qv * __expf(bt - Bi));
            QG[t * BP + k] = f2bf(qv * __expf(bt));
            if (t < 16) KS[t * BP + k] = f2bf(kv * __expf(gt[15 * PK + k] - bt));
            if (t < 32) KS[(16 + t) * BP + k] = f2bf(kv * __expf(gt[31 * PK + k] - bt));
            if (t < 48) KS[(48 + t) * BP + k] = f2bf(kv * __expf(gt[47 * PK + k] - bt)); }
        { const int blk = tid >> 7, tl = (tid >> 3) & 15, s0 = (tid & 7) * 2; const int t = blk * 16 + tl;
            float a0 = 0.f, a1 = 0.f;
            if (s0 <= tl) { const int sa = blk * 16 + s0, sb = sa + 1;
                for (int k = 0; k < DK; ++k) { const float qv = qt[t * PK + k], bv = gt[t * PK + k];
                    a0 += qv * kt[sa * PK + k] * __expf(fminf(bv - gt[sa * PK + k], 0.f));
                    a1 += qv * kt[sb * PK + k] * __expf(fminf(bv - gt[sb * PK + k], 0.f)); }
                if (s0 + 1 > tl) a1 = 0.f; }
            SC[t * BP + blk * 16 + s0] = f2bf(a0); SC[t * BP + blk * 16 + s0 + 1] = f2bf(a1);
            for (int J = blk + 1; J < 4; ++J) { SC[t * BP + J * 16 + s0] = 0; SC[t * BP + J * 16 + s0 + 1] = 0; } }
        __syncthreads();
        if (c.wid < 6) { const int I = c.wid < 1 ? 1 : (c.wid < 3 ? 2 : 3), J = c.wid < 1 ? 0 : (c.wid < 3 ? c.wid - 1 : c.wid - 3);
            const bf16_t* KSI = KS + (I == 1 ? 0 : (I == 2 ? 16 : 48)) * BP;
            f32x4v acc = {0.f, 0.f, 0.f, 0.f};
#pragma unroll
            for (int ks = 0; ks < DK / 32; ++ks) acc = __builtin_amdgcn_mfma_f32_16x16x32_bf16(frag16(QS, I * 16, ks * 32, lane), frag16(KSI, J * 16, ks * 32, lane), acc, 0, 0, 0);
#pragma unroll
            for (int i = 0; i < 4; ++i) SC[(I * 16 + 4 * (lane >> 4) + i) * BP + J * 16 + (lane & 15)] = f2bf(acc[i]); }
        __syncthreads();
#pragma unroll
        for (int u = 0; u < 2; ++u) { const int tile = c.wid * 2 + u; const int ti = tile >> 2, tj = tile & 3;
            f32x4v acc = {0.f, 0.f, 0.f, 0.f};
#pragma unroll
            for (int ks = 0; ks < 2; ++ks) acc = __builtin_amdgcn_mfma_f32_16x16x32_bf16(frag16(SC, ti * 16, ks * 32, lane), frag16(VT, tj * 16, ks * 32, lane), acc, 0, 0, 0);
#pragma unroll
            for (int ks = 0; ks < DK / 32; ++ks) acc = __builtin_amdgcn_mfma_f32_16x16x32_bf16(frag16(QG, ti * 16, ks * 32, lane), frag16(ST, tj * 16, ks * 32, lane), acc, 0, 0, 0);
#pragma unroll
            for (int i = 0; i < 4; ++i) { const int t = ti * 16 + 4 * (lane >> 4) + i; const int to = dir ? 63 - t : t; float* op = ot + to * 65 + tj * 16 + (lane & 15);
                if (dir == 0) *op = acc[i]; else *op += acc[i]; } }
        __syncthreads();
    }
    { const int t = tid >> 3, j0 = (tid & 7) * 8; float o[8]; float ss = 0.f;
#pragma unroll
        for (int j = 0; j < 8; ++j) { o[j] = ot[t * 65 + j0 + j]; ss += o[j] * o[j]; }
        ss += __shfl_xor(ss, 1, 64); ss += __shfl_xor(ss, 2, 64); ss += __shfl_xor(ss, 4, 64);
        const float rstd = rsqrtf(ss * (1.f / 64.f) + NORM_EPS);
        const int r = b * RPB + cc * 64 + t;
        const float* gn = CIN(MX == 0 ? 12 : 14) + l * 64;
        const u32x4 gp = *(const u32x4*)(C_P + (size_t)r * INC + (MX == 0 ? GLA_R : HG_OG) + h * 64 + j0);
        float y[8];
#pragma unroll
        for (int j = 0; j < 8; ++j) y[j] = o[j] * rstd * gn[j0 + j] * silu_f((j & 1) ? bfhi(gp[j >> 1]) : bflo(gp[j >> 1]));
        u32x4 w = {cvtpk(y[0], y[1]), cvtpk(y[2], y[3]), cvtpk(y[4], y[5]), cvtpk(y[6], y[7])};
        *(u32x4*)(C_HB + (size_t)r * D + MX * 256 + h * 64 + j0) = w; }
    __syncthreads();
}

__device__ __forceinline__ void rope_cs(int pos, int i, float& cs, float& sn) {
    const float freq = __expf(-(float)i * (9.210340371976184f / 8.f));
    const float ang = (float)pos * freq;
    const float n = rintf(ang * 0.15915494309189535f);
    float rr = fmaf(-n, 6.2831854820251465f, ang); rr = fmaf(-n, -1.7484555e-7f, rr);
    cs = __cosf(rr); sn = __sinf(rr);
}

__device__ void ph_prep_rows(const Ctx& c, int l) {
    const float* gq = CIN(15) + l * 192; const float* gkv = CIN(16) + l * 128;
    for (int r = blockIdx.x * 8 + c.wid; r < NR; r += gridDim.x * 8) {
        const int b = r / RPB, j = r - b * RPB; bf16_t* pr = C_P + (size_t)r * INC;
        { float v[3]; float ss = 0.f;
#pragma unroll
            for (int i = 0; i < 3; ++i) { v[i] = bf2f(pr[MLA_CQ + c.lane + 64 * i]); ss += v[i] * v[i]; }
            ss = wave_sum(ss); const float rstd = rsqrtf(ss * (1.f / 192.f) + NORM_EPS);
#pragma unroll
            for (int i = 0; i < 3; ++i) pr[MLA_CQ + c.lane + 64 * i] = f2bf(v[i] * rstd * gq[c.lane + 64 * i]); }
        { float v[2]; float ss = 0.f;
#pragma unroll
            for (int i = 0; i < 2; ++i) { v[i] = bf2f(pr[MLA_CKV + c.lane + 64 * i]); ss += v[i] * v[i]; }
            ss = wave_sum(ss); const float rstd = rsqrtf(ss * (1.f / 128.f) + NORM_EPS);
#pragma unroll
            for (int i = 0; i < 2; ++i) pr[MLA_CKV + c.lane + 64 * i] = f2bf(v[i] * rstd * gkv[c.lane + 64 * i]); }
        if (j >= CTX) { const int t = j - CTX; const int prow = t >> 6, pcol = t & 63;
            for (int pp = c.lane; pp < 34 * 8; pp += 64) { const int g = pp >> 3, i = pp & 7;
                int col; if (g < 16) col = DF_Q + (g >> 1) * 32 + (g & 1) * 16; else if (g < 32) col = DF_K + ((g - 16) >> 1) * 32 + (g & 1) * 16; else col = MLA_KR + (g - 32) * 16;
                float cs, sn; rope_cs((g & 1) ? pcol : prow, i, cs, sn);
                const float x1 = bf2f(pr[col + i]), x2 = bf2f(pr[col + 8 + i]);
                pr[col + i] = f2bf(x1 * cs - x2 * sn); pr[col + 8 + i] = f2bf(x1 * sn + x2 * cs); } }
    }
}
__device__ void ph_rope_q(const Ctx& c) {
    for (int r = blockIdx.x * 8 + c.wid; r < NR; r += gridDim.x * 8) {
        const int b = r / RPB, j = r - b * RPB; if (j < CTX) continue;
        const int t = j - CTX; const int prow = t >> 6, pcol = t & 63;
        const int h = c.lane >> 4, g = (c.lane >> 3) & 1, i = c.lane & 7;
        bf16_t* q = C_QM + (size_t)r * 384 + h * 96 + 64 + g * 16;
        float cs, sn; rope_cs(g ? pcol : prow, i, cs, sn);
        const float x1 = bf2f(q[i]), x2 = bf2f(q[8 + i]);
        q[i] = f2bf(x1 * cs - x2 * sn); q[8 + i] = f2bf(x1 * sn + x2 * cs);
    }
}

__device__ __forceinline__ int v_st(int k, int cidx) { const int kk = (k & ~0xC) | ((k & 4) << 1) | ((k & 8) >> 1); return ((kk >> 3) * 2 + (cidx >> 5)) * 512 + ((kk & 7) * 32 + (cidx & 31)) * 2; }
__device__ __forceinline__ int v_rd_base(int lane) { return ((lane & 3) << 3) | (((lane >> 2) & 3) << 6) | (((lane >> 4) & 1) << 5) | (((lane >> 5) & 1) << 8); }
constexpr int v_rd_off(int d0, int ks, int half) { return d0 * 512 + ks * 2048 + half * 1024; }
template <int OFF> __device__ __forceinline__ s16x4 tr_read(int vb) { s16x4 r; asm volatile("ds_read_b64_tr_b16 %0, %1 offset:%2" : "=&v"(r) : "v"(vb), "i"(OFF) : "memory"); return r; }
template <int D0> __device__ __forceinline__ void pv_one(f32x16& od, int vb, bf16x8 pa0, bf16x8 pa1, bf16x8 pa2, bf16x8 pa3) {
    const s16x4 l0 = tr_read<v_rd_off(D0, 0, 0)>(vb), h0 = tr_read<v_rd_off(D0, 0, 1)>(vb), l1 = tr_read<v_rd_off(D0, 1, 0)>(vb), h1 = tr_read<v_rd_off(D0, 1, 1)>(vb);
    const s16x4 l2 = tr_read<v_rd_off(D0, 2, 0)>(vb), h2 = tr_read<v_rd_off(D0, 2, 1)>(vb), l3 = tr_read<v_rd_off(D0, 3, 0)>(vb), h3 = tr_read<v_rd_off(D0, 3, 1)>(vb);
    asm volatile("s_waitcnt lgkmcnt(0)" ::: "memory"); __builtin_amdgcn_sched_barrier(0);
#define PKV(L, H) (bf16x8){L[0], L[1], L[2], L[3], H[0], H[1], H[2], H[3]}
    od = __builtin_amdgcn_mfma_f32_32x32x16_bf16(pa0, PKV(l0, h0), od, 0, 0, 0);
    od = __builtin_amdgcn_mfma_f32_32x32x16_bf16(pa1, PKV(l1, h1), od, 0, 0, 0);
    od = __builtin_amdgcn_mfma_f32_32x32x16_bf16(pa2, PKV(l2, h2), od, 0, 0, 0);
    od = __builtin_amdgcn_mfma_f32_32x32x16_bf16(pa3, PKV(l3, h3), od, 0, 0, 0);
#undef PKV
}
constexpr float ATT_THR = 8.f;
__device__ __forceinline__ void softmax_tile(f32x16& p0, f32x16& p1, float& m_reg, float& l_reg, float& alpha, const float C, const float thr,
                                             bf16x8& pa0, bf16x8& pa1, bf16x8& pa2, bf16x8& pa3) {
    float pmax = p0[0];
#pragma unroll
    for (int r = 1; r < 16; ++r) pmax = fmaxf(pmax, p0[r]);
#pragma unroll
    for (int r = 0; r < 16; ++r) pmax = fmaxf(pmax, p1[r]);
    { auto rr = __builtin_amdgcn_permlane32_swap(__float_as_uint(pmax), __float_as_uint(pmax), false, false); pmax = fmaxf(__uint_as_float(rr[0]), __uint_as_float(rr[1])); }
    float mn;
    if (__builtin_expect(__all(pmax - m_reg <= thr), 1)) { mn = m_reg; alpha = 1.f; }
    else { mn = fmaxf(m_reg, pmax); alpha = __builtin_amdgcn_exp2f((m_reg - mn) * C); m_reg = mn; }
    const float mnC = -mn * C;
    float ps = 0.f;
#pragma unroll
    for (int r = 0; r < 16; ++r) { p0[r] = __builtin_amdgcn_exp2f(fmaf(p0[r], C, mnC)); ps += p0[r]; }
#pragma unroll
    for (int r = 0; r < 16; ++r) { p1[r] = __builtin_amdgcn_exp2f(fmaf(p1[r], C, mnC)); ps += p1[r]; }
    { auto rr = __builtin_amdgcn_permlane32_swap(__float_as_uint(ps), __float_as_uint(ps), false, false); ps = __uint_as_float(rr[0]) + __uint_as_float(rr[1]); }
    l_reg = l_reg * alpha + ps;
#define PK4(P, BASE, OUT) do { unsigned a0 = cvtpk(P[BASE + 0], P[BASE + 1]), a1 = cvtpk(P[BASE + 2], P[BASE + 3]);   \
    unsigned b0 = cvtpk(P[BASE + 4], P[BASE + 5]), b1 = cvtpk(P[BASE + 6], P[BASE + 7]);                              \
    auto r0 = __builtin_amdgcn_permlane32_swap(a0, b0, false, false); auto r1 = __builtin_amdgcn_permlane32_swap(a1, b1, false, false); \
    u32x4 w = {r0[0], r1[0], r0[1], r1[1]}; OUT = *reinterpret_cast<bf16x8*>(&w); } while (0)
    PK4(p0, 0, pa0); PK4(p0, 8, pa1); PK4(p1, 0, pa2); PK4(p1, 8, pa3);
#undef PK4
}

constexpr int ATT_LDS = 2 * 16384 + 2 * 8192 + 8 * 64 * 4;
template <bool DIFF>
__device__ void attn_item(const Ctx& c, int l, int b, int hd, int qrow0, int krow0, int nkeys, char* lds) {
    constexpr int DQK = DIFF ? 32 : 96, NMAP = DIFF ? 2 : 1, ND0 = DQK / 16, NU = 2 * NMAP;
    constexpr int KP = DIFF ? 64 : 256;
    constexpr int KSZ = 64 * KP;
    constexpr int NKR = DIFF ? 2 : 3;
    const int tid = c.tid, lane = c.lane, wid = c.wid, r32 = lane & 31, hi = lane >> 5;
    char* K_lds = lds; char* V_lds = lds + 2 * 16384; float* wsl = (float*)(lds + 2 * 16384 + 2 * 8192) + wid * 64;
    const float scale = DIFF ? 0.17677669529663687f : 0.10206207261596575f;
    const float C = scale * 1.4426950408889634f, thr = ATT_THR / scale;
    bf16x8 qr[NMAP][ND0];
    { const int qrow = qrow0 + wid * 32 + r32;
#pragma unroll
        for (int m = 0; m < NMAP; ++m)
#pragma unroll
            for (int d0 = 0; d0 < ND0; ++d0) {
                const bf16_t* p = DIFF ? C_P + (size_t)qrow * INC + DF_Q + (hd * 2 + m) * 32 + d0 * 16 + hi * 8
                                       : C_QM + (size_t)qrow * 384 + hd * 96 + d0 * 16 + hi * 8;
                qr[m][d0] = *(const bf16x8*)p; } }
    f32x16 o[NMAP][2]; float m_reg[NMAP], l_reg[NMAP];
#pragma unroll
    for (int m = 0; m < NMAP; ++m) { m_reg[m] = -1e30f; l_reg[m] = 0.f;
#pragma unroll
        for (int d = 0; d < 2; ++d) zero_acc(o[m][d]); }
    u32x4 kreg[NKR], vreg[2];
    int ksrc_key[NKR], ksrc_col[NKR], kdst[NKR]; bool ksrc_kvm[NKR];
#pragma unroll
    for (int i = 0; i < NKR; ++i) {
        if (DIFF) { const int key = tid >> 2, ch = tid & 3, k64 = key & 63; ksrc_key[i] = key; ksrc_kvm[i] = false; ksrc_col[i] = DF_K + (hd * 2 + i) * 32 + ch * 8;
            kdst[i] = ((key >> 6) * 2 + i) * KSZ + k64 * 64 + ((ch ^ ((k64 >> 2) & 3)) << 4); }
        else { const int id = tid + 512 * i; const int key = id / 12, ch = id % 12, k64 = key & 63; ksrc_key[i] = key; ksrc_kvm[i] = ch < 8;
            ksrc_col[i] = ch < 8 ? hd * 128 + ch * 8 : MLA_KR + (ch - 8) * 8;
            kdst[i] = (key >> 6) * KSZ + k64 * 256 + ((ch * 16) ^ ((k64 & 7) << 4)); } }
    int vdst[2];
#pragma unroll
    for (int i = 0; i < 2; ++i) { const int id = tid + 512 * i; const int key = id >> 3, ch = id & 7; vdst[i] = (key >> 6) * 8192 + v_st(key & 63, ch * 8); }
    const int vkey = tid >> 3, vch = tid & 7;
    const int vb = (int)(uintptr_t)V_lds + v_rd_base(lane);
#define ALOAD(kr) do { _Pragma("unroll") for (int i = 0; i < NKR; ++i) { const size_t rr = (size_t)((kr) + ksrc_key[i]); \
            kreg[i] = *(const u32x4*)((DIFF || !ksrc_kvm[i]) ? C_P + rr * INC + ksrc_col[i] : C_KVM + rr * 512 + ksrc_col[i]); } \
        _Pragma("unroll") for (int i = 0; i < 2; ++i) { const size_t rr = (size_t)((kr) + vkey + 64 * i); \
            vreg[i] = *(const u32x4*)(DIFF ? C_P + rr * INC + DF_V + hd * 64 + vch * 8 : C_KVM + rr * 512 + hd * 128 + 64 + vch * 8); } } while (0)
    const int NS = nkeys >> 7;
    ALOAD(krow0);
    for (int j = 0; j < NS; ++j) {
        __syncthreads();
#pragma unroll
        for (int i = 0; i < NKR; ++i) *(u32x4*)(K_lds + kdst[i]) = kreg[i];
#pragma unroll
        for (int i = 0; i < 2; ++i) *(u32x4*)(V_lds + vdst[i]) = vreg[i];
        __syncthreads();
        if (j + 1 < NS) ALOAD(krow0 + (j + 1) * 128);
        f32x16 p0[2], p1[2];
#define QKT(u) do { constexpr int tt_ = (u) / NMAP, m_ = (u) % NMAP; const char* Kb = K_lds + (tt_ * NMAP + m_) * KSZ; \
            _Pragma("unroll") for (int d0 = 0; d0 < ND0; ++d0) { bf16x8 b0, b1; \
                if (DIFF) { const int ch = d0 * 2 + hi; const int ra = r32, rb = 32 + r32; \
                    b0 = *(const bf16x8*)(Kb + ra * 64 + ((ch ^ ((ra >> 2) & 3)) << 4)); b1 = *(const bf16x8*)(Kb + rb * 64 + ((ch ^ ((rb >> 2) & 3)) << 4)); } \
                else { const int cb = d0 * 32 + hi * 16; const int ra = r32, rb = 32 + r32; \
                    b0 = *(const bf16x8*)(Kb + ra * 256 + (cb ^ ((ra & 7) << 4))); b1 = *(const bf16x8*)(Kb + rb * 256 + (cb ^ ((rb & 7) << 4))); } \
                if (d0 == 0) { const f32x16 z = {0.f,0.f,0.f,0.f,0.f,0.f,0.f,0.f,0.f,0.f,0.f,0.f,0.f,0.f,0.f,0.f}; \
                    p0[(u) & 1] = __builtin_amdgcn_mfma_f32_32x32x16_bf16(b0, qr[m_][0], z, 0, 0, 0); p1[(u) & 1] = __builtin_amdgcn_mfma_f32_32x32x16_bf16(b1, qr[m_][0], z, 0, 0, 0); \
                    asm volatile("" :: "v"(b0), "v"(b1));   } \
                else { p0[(u) & 1] = __builtin_amdgcn_mfma_f32_32x32x16_bf16(b0, qr[m_][d0], p0[(u) & 1], 0, 0, 0); p1[(u) & 1] = __builtin_amdgcn_mfma_f32_32x32x16_bf16(b1, qr[m_][d0], p1[(u) & 1], 0, 0, 0); } } } while (0)
        QKT(0);
#pragma unroll
        for (int u = 0; u < NU; ++u) {
            const int tt = u / NMAP, m = u % NMAP;
            if (u + 1 < NU) { if (u == 0) QKT(1); else if (u == 1) QKT(2); else QKT(3); }
            float alpha; bf16x8 pa0, pa1, pa2, pa3;
            softmax_tile(p0[u & 1], p1[u & 1], m_reg[m], l_reg[m], alpha, C, thr, pa0, pa1, pa2, pa3);
            if (__any(alpha < 1.f)) {
                if (hi == 0) wsl[r32] = alpha;
                asm volatile("s_waitcnt lgkmcnt(0)" ::: "memory");
#pragma unroll
                for (int r = 0; r < 16; ++r) { const float av = wsl[crow(r, hi)]; o[m][0][r] *= av; o[m][1][r] *= av; }
            }
            pv_one<0>(o[m][0], vb + tt * 8192, pa0, pa1, pa2, pa3);
            pv_one<1>(o[m][1], vb + tt * 8192, pa0, pa1, pa2, pa3);
        }
#undef QKT
    }
#undef ALOAD
    float rli[NMAP][16];
#pragma unroll
    for (int m = 0; m < NMAP; ++m) {
        asm volatile("s_waitcnt lgkmcnt(0)" ::: "memory");
        if (hi == 0) wsl[r32] = l_reg[m];
        asm volatile("s_waitcnt lgkmcnt(0)" ::: "memory");
#pragma unroll
        for (int r = 0; r < 16; ++r) rli[m][r] = __builtin_amdgcn_rcpf(wsl[crow(r, hi)]);
    }
    const int orow0 = qrow0 + wid * 32;
    if (!DIFF) {
#pragma unroll
        for (int r = 0; r < 16; ++r) { bf16_t* dst = C_HB + (size_t)(orow0 + crow(r, hi)) * D + 512 + hd * 64 + r32;
            dst[0] = f2bf(o[0][0][r] * rli[0][r]); dst[32] = f2bf(o[0][1][r] * rli[0][r]); }
    } else {
        const float* lp = CIN(19) + l * 128;
        float s1 = 0.f, s2 = 0.f;
        for (int i = 0; i < 32; ++i) { s1 += lp[i] * lp[32 + i]; s2 += lp[64 + i] * lp[96 + i]; }
        const float lam_init = 0.8f - 0.6f * __expf(-0.3f * (float)l);
        const float lam = __expf(s1) - __expf(s2) + lam_init;
        const float* gn = CIN(20) + l * 64;
        const float g0 = gn[r32] * (1.f - lam_init), g1 = gn[32 + r32] * (1.f - lam_init);
#pragma unroll
        for (int r = 0; r < 16; ++r) {
            const float v0 = o[0][0][r] * rli[0][r] - lam * o[NMAP - 1][0][r] * rli[NMAP - 1][r];
            const float v1 = o[0][1][r] * rli[0][r] - lam * o[NMAP - 1][1][r] * rli[NMAP - 1][r];
            float ss = v0 * v0 + v1 * v1;
            ss += __shfl_xor(ss, 1, 64); ss += __shfl_xor(ss, 2, 64); ss += __shfl_xor(ss, 4, 64); ss += __shfl_xor(ss, 8, 64); ss += __shfl_xor(ss, 16, 64);
            const float rstd = rsqrtf(ss * (1.f / 64.f) + NORM_EPS);
            bf16_t* dst = C_HB + (size_t)(orow0 + crow(r, hi)) * D + 768 + hd * 64 + r32;
            dst[0] = f2bf(v0 * rstd * g0); dst[32] = f2bf(v1 * rstd * g1); }
    }
    __syncthreads();
}
__device__ void ph_attn(const Ctx& c, int l, char* lds) {
    const bool need_ctx = (l < DEPTH - 1);
    const int nitem = 1024 + (need_ctx ? 32 : 0);
    for (int it = blockIdx.x; it < nitem; it += gridDim.x) {
        if (it < 512) { const int b = it >> 7, hd = (it >> 5) & 3, qt = it & 31; attn_item<true>(c, l, b, hd, b * RPB + CTX + qt * 256, b * RPB, RPB, lds); }
        else if (it < 1024) { const int u = it - 512; const int b = u >> 7, hd = (u >> 5) & 3, qt = u & 31; attn_item<false>(c, l, b, hd, b * RPB + CTX + qt * 256, b * RPB, RPB, lds); }
        else { const int u = it - 1024; const int b = u & 3, hd = (u >> 2) & 3; if (u < 16) attn_item<true>(c, l, b, hd, b * RPB, b * RPB, CTX, lds); else attn_item<false>(c, l, b, hd, b * RPB, b * RPB, CTX, lds); }
    }
}

typedef float f32v2 __attribute__((ext_vector_type(2)));
__device__ void cvt_tables(const Ctx& c, int l) {
    for (int row = blockIdx.x * 8 + c.wid; row < 2 * NEXP; row += gridDim.x * 8) {
        const bool isu = row < NEXP; const int e = isu ? row : row - NEXP;
        const float* s = CIN(isu ? 23 : 24) + ((size_t)l * NEXP + e) * D + c.lane * 16;
        f32x4 v[4]; float mx = 0.f;
#pragma unroll
        for (int i = 0; i < 4; ++i) { v[i] = *(const f32x4*)(s + 4 * i); mx = fmaxf(mx, fmaxf(fmaxf(fabsf(v[i][0]), fabsf(v[i][1])), fmaxf(fabsf(v[i][2]), fabsf(v[i][3])))); }
#pragma unroll
        for (int o = 32; o >= 1; o >>= 1) mx = fmaxf(mx, __shfl_xor(mx, o, 64));
        const float q = mx > 0.f ? 256.f / mx : 0.f;
        if (c.lane == 0) (isu ? C_SU : C_SV)[e] = mx * (1.f / 256.f);
        u32x4 w;
#pragma unroll
        for (int i = 0; i < 4; ++i) { int p = 0; p = __builtin_amdgcn_cvt_pk_fp8_f32(v[i][0] * q, v[i][1] * q, p, false); p = __builtin_amdgcn_cvt_pk_fp8_f32(v[i][2] * q, v[i][3] * q, p, true); w[i] = (unsigned)p; }
        *(u32x4*)((isu ? C_TU8 : C_TV8) + ((size_t)(c.lane >> 3) * NEXP + e) * 128 + (c.lane & 7) * 16) = w;
    }
}
__device__ __forceinline__ unsigned ford(float x) { const unsigned u = __float_as_uint(x); return (u & 0x80000000u) ? ~u : (u | 0x80000000u); }
__device__ __forceinline__ float funord(unsigned k) { const unsigned u = (k & 0x80000000u) ? (k & 0x7fffffffu) : ~k; return __uint_as_float(u); }
constexpr int TOPK_LDS = 2 * 128 * 129 * 4;
__device__ void peer_topk_item(const Ctx& c, int l, int tm, int h, char* lds) {
    float* S = (float*)lds;
    const int tid = c.tid, lane = c.lane, wid = c.wid, r32 = lane & 31, hi = lane >> 5, wm = wid >> 1, wn = wid & 1;
    const int row0 = tm * 128;
#pragma unroll
    for (int p = 0; p < 2; ++p) {
        f32x16 acc[2];
        zero_acc(acc[0]); zero_acc(acc[1]);
        const bf16_t* Ap = C_Q2 + (size_t)(row0 + wm * 32 + r32) * 2048 + h * 256 + p * 128 + hi * 8;
        const bf16_t* Bp = C_KEYS + ((((size_t)l * 8 + h) * 2 + p) * 128 + wn * 64 + r32) * 128 + hi * 8;
#pragma unroll
        for (int ks = 0; ks < 8; ++ks) {
            const bf16x8 a = *(const bf16x8*)(Ap + ks * 16);
            const bf16x8 b0 = *(const bf16x8*)(Bp + ks * 16), b1 = *(const bf16x8*)(Bp + 32 * 128 + ks * 16);
            acc[0] = __builtin_amdgcn_mfma_f32_32x32x16_bf16(a, b0, acc[0], 0, 0, 0);
            acc[1] = __builtin_amdgcn_mfma_f32_32x32x16_bf16(a, b1, acc[1], 0, 0, 0);
        }
#pragma unroll
        for (int n = 0; n < 2; ++n)
#pragma unroll
            for (int r = 0; r < 16; ++r) S[(p * 128 + wm * 32 + crow(r, hi)) * 129 + wn * 64 + n * 32 + r32] = acc[n][r];
    }
    __syncthreads();
    unsigned tk[16];
    if (tid < 256) {
        const float* sr = S + tid * 129;
#pragma unroll
        for (int i = 0; i < 16; ++i) tk[i] = 0u;
        for (int n = 0; n < 128; ++n) { unsigned key = (ford(sr[n]) & ~127u) | (unsigned)(127 - n);
#pragma unroll
            for (int i = 0; i < 16; ++i) { const unsigned hi_ = max(key, tk[i]); key = min(key, tk[i]); tk[i] = hi_; } }
    }
    __syncthreads();
    unsigned* L = (unsigned*)lds;
    if (tid < 256) {
#pragma unroll
        for (int i = 0; i < 16; ++i) L[tid * 17 + i] = tk[i];
    }
    __syncthreads();
    if (tid < 128) {
        const unsigned* l0 = L + tid * 17; const unsigned* l1 = L + (128 + tid) * 17;
        float s0[16], s1[16];
#pragma unroll
        for (int i = 0; i < 16; ++i) { s0[i] = funord(l0[i] & ~127u); s1[i] = funord(l1[i] & ~127u); }
        unsigned bk[16];
#pragma unroll
        for (int i = 0; i < 16; ++i) bk[i] = 0u;
#pragma unroll
        for (int i = 0; i < 16; ++i)
#pragma unroll
            for (int j = 0; j < 16; ++j) if ((i + 1) * (j + 1) <= 16) {
                unsigned key = (ford(s0[i] + s1[j]) & ~255u) | (unsigned)(255 - (i * 16 + j));
#pragma unroll
                for (int q = 0; q < 16; ++q) { const unsigned hi_ = max(key, bk[q]); key = min(key, bk[q]); bk[q] = hi_; } }
        float best[16]; int eid[16]; float mx = -1e30f;
#pragma unroll
        for (int q = 0; q < 16; ++q) { const int ij = 255 - (int)(bk[q] & 255u); const int i = ij >> 4, j = ij & 15;
            const unsigned k0 = l0[i], k1 = l1[j];
            best[q] = funord(k0 & ~127u) + funord(k1 & ~127u);
            eid[q] = (127 - (int)(k0 & 127u)) * 128 + (127 - (int)(k1 & 127u));
            mx = fmaxf(mx, best[q]); }
        float sum = 0.f;
#pragma unroll
        for (int q = 0; q < 16; ++q) { best[q] = __expf(best[q] - mx); sum += best[q]; }
        const float inv = 1.f / sum;
        const size_t o = (size_t)(row0 + tid) * 128 + h * 16;
#pragma unroll
        for (int q = 0; q < 16; ++q) { C_EI[o + q] = eid[q]; C_EG[o + q] = best[q] * inv; }
    }
    __syncthreads();
}
__device__ __forceinline__ float gelu_tanh(float x) { const float u = 0.7978845608028654f * (x + 0.044715f * x * x * x); const float t = 1.f - 2.f / (1.f + __expf(2.f * u)); return 0.5f * x * (1.f + t); }
__device__ __forceinline__ int tok_row(int ti, bool need_ctx) { return need_ctx ? ti : (ti >> 13) * RPB + CTX + (ti & 8191); }
__device__ void peer_u_item(const Ctx& c, int l, int j, int tb, char* lds) {
    const bool need_ctx = (l < DEPTH - 1);
    int* el = (int*)lds + c.wid * 128;
    const int lane = c.lane, sub = lane & 7, grp = lane >> 3;
    const unsigned char* t8 = C_TU8 + (size_t)j * NEXP * 128 + sub * 16;
    for (int k = 0; k < 8; ++k) {
        const int r = tok_row(tb * 64 + c.wid * 8 + k, need_ctx);
        const bf16_t* xp = C_HB + (size_t)r * D + j * 128 + sub * 16;
        const u32x4 xa = *(const u32x4*)xp, xb = *(const u32x4*)(xp + 8);
        float x[16];
#pragma unroll
        for (int q = 0; q < 4; ++q) { x[2 * q] = bflo(xa[q]); x[2 * q + 1] = bfhi(xa[q]); x[8 + 2 * q] = bflo(xb[q]); x[8 + 2 * q + 1] = bfhi(xb[q]); }
        el[lane] = C_EI[(size_t)r * 128 + lane]; el[64 + lane] = C_EI[(size_t)r * 128 + 64 + lane];
        float keep0 = 0.f, keep1 = 0.f;
        u32x4 uvall[16];
#pragma unroll
        for (int u = 0; u < 16; ++u) { const int e = el[u * 8 + grp]; uvall[u] = *(const u32x4*)(t8 + (size_t)e * 128); }
#pragma unroll
        for (int g0 = 0; g0 < 16; g0 += 4) {
            u32x4 uv[4];
#pragma unroll
            for (int u = 0; u < 4; ++u) uv[u] = uvall[g0 + u];
#pragma unroll
            for (int u = 0; u < 4; ++u) { float a = 0.f;
#pragma unroll
                for (int q = 0; q < 4; ++q) { const f32v2 lo = __builtin_amdgcn_cvt_pk_f32_fp8(uv[u][q], false), hi2 = __builtin_amdgcn_cvt_pk_f32_fp8(uv[u][q], true);
                    a = fmaf(lo[0], x[4 * q], a); a = fmaf(lo[1], x[4 * q + 1], a); a = fmaf(hi2[0], x[4 * q + 2], a); a = fmaf(hi2[1], x[4 * q + 3], a); }
                a += __shfl_xor(a, 1, 64); a += __shfl_xor(a, 2, 64); a += __shfl_xor(a, 4, 64);
                if (sub == ((g0 + u) & 7)) { if (g0 + u < 8) keep0 = a; else keep1 = a; } }
        }
        float* pp = C_PART + ((size_t)j * NR + r) * 128;
        pp[sub * 8 + grp] = keep0; pp[(8 + sub) * 8 + grp] = keep1;
    }
}
__device__ void peer_v_item(const Ctx& c, int l, int j, int tb, char* lds) {
    const bool need_ctx = (l < DEPTH - 1);
    int* el = (int*)lds + c.wid * 256; float* wl = (float*)(el + 128);
    const int lane = c.lane, sub = lane & 7, grp = lane >> 3;
    const unsigned char* t8 = C_TV8 + (size_t)j * NEXP * 128 + sub * 16;
    for (int k = 0; k < 8; ++k) {
        const int r = tok_row(tb * 64 + c.wid * 8 + k, need_ctx);
        const int b = r / RPB; const bool isctx = (r - b * RPB) < CTX;
        const int e0 = C_EI[(size_t)r * 128 + lane], e1 = C_EI[(size_t)r * 128 + 64 + lane];
        const float g0v = C_EG[(size_t)r * 128 + lane], g1v = C_EG[(size_t)r * 128 + 64 + lane];
        el[lane] = e0; el[64 + lane] = e1;
        u32x4 vvall[16];
#pragma unroll
        for (int u = 0; u < 16; ++u) { const int e = el[u * 8 + grp]; vvall[u] = *(const u32x4*)(t8 + (size_t)e * 128); }
        float s0 = 0.f, s1 = 0.f;
#pragma unroll
        for (int jj = 0; jj < 8; ++jj) { const float* pp = C_PART + ((size_t)jj * NR + r) * 128; s0 += pp[lane]; s1 += pp[64 + lane]; }
        wl[lane] = g0v * gelu_tanh(s0 * C_SU[e0]) * C_SV[e0]; wl[64 + lane] = g1v * gelu_tanh(s1 * C_SU[e1]) * C_SV[e1];
        float acc[16];
#pragma unroll
        for (int q = 0; q < 16; ++q) acc[q] = 0.f;
#pragma unroll
        for (int g0 = 0; g0 < 16; g0 += 4) {
            u32x4 vv[4]; float wv[4];
#pragma unroll
            for (int u = 0; u < 4; ++u) { const int p = (g0 + u) * 8 + grp; wv[u] = wl[p]; vv[u] = vvall[g0 + u]; }
#pragma unroll
            for (int u = 0; u < 4; ++u)
#pragma unroll
                for (int q = 0; q < 4; ++q) { const f32v2 lo = __builtin_amdgcn_cvt_pk_f32_fp8(vv[u][q], false), hi2 = __builtin_amdgcn_cvt_pk_f32_fp8(vv[u][q], true);
                    acc[4 * q] = fmaf(wv[u], lo[0], acc[4 * q]); acc[4 * q + 1] = fmaf(wv[u], lo[1], acc[4 * q + 1]); acc[4 * q + 2] = fmaf(wv[u], hi2[0], acc[4 * q + 2]); acc[4 * q + 3] = fmaf(wv[u], hi2[1], acc[4 * q + 3]); }
        }
        const bool b5 = (lane & 32) != 0, b4 = (lane & 16) != 0, b3 = (lane & 8) != 0;
        float r8[8], r4[4], r2[2];
#pragma unroll
        for (int q = 0; q < 8; ++q) { const float mine = b5 ? acc[8 + q] : acc[q], oth = b5 ? acc[q] : acc[8 + q]; r8[q] = mine + __shfl_xor(oth, 32, 64); }
#pragma unroll
        for (int q = 0; q < 4; ++q) { const float mine = b4 ? r8[4 + q] : r8[q], oth = b4 ? r8[q] : r8[4 + q]; r4[q] = mine + __shfl_xor(oth, 16, 64); }
#pragma unroll
        for (int q = 0; q < 2; ++q) { const float mine = b3 ? r4[2 + q] : r4[q], oth = b3 ? r4[q] : r4[2 + q]; r2[q] = mine + __shfl_xor(oth, 8, 64); }
        const int col = j * 128 + sub * 16 + (b5 ? 8 : 0) + (b4 ? 4 : 0) + (b3 ? 2 : 0);
        const float* gt = C_MODT + ((size_t)l * 5 + (isctx ? 4 : b)) * 6144 + 5 * D + col;
        float* xo = xrow(c, r) + col;
        f32v2 xv = *(f32v2*)xo; const f32v2 gv = *(const f32v2*)gt;
        xv[0] += gv[0] * r2[0]; xv[1] += gv[1] * r2[1];
        *(f32v2*)xo = xv;
    }
}
template <int SUB>
__device__ void ph_peer_expert(const Ctx& c, int l, char* lds) {
    const bool need_ctx = (l < DEPTH - 1);
    unsigned* cnt = (unsigned*)CWS(WS_CTL) + 4096 + ((l * 2 + SUB) * 8) * 64;
    const int nitem = (need_ctx ? NR : NB * SEQ) / 64;
    const int x = (int)(xb_xcc_id() & 7u);
    volatile int* sh = (volatile int*)(lds + 16384);
    for (int jo = 0; jo < 8; ++jo) { const int j = (x + jo) & 7;
        for (;;) {
            if (c.tid == 0) *sh = (int)__hip_atomic_fetch_add(&cnt[j * 64], 1u, __ATOMIC_RELAXED, __HIP_MEMORY_SCOPE_AGENT);
            __syncthreads(); const int it = *sh; __syncthreads();
            if (it >= nitem) break;
            if (SUB == 0) peer_u_item(c, l, j, it, lds); else peer_v_item(c, l, j, it, lds);
        }
    }
}
__device__ void ph_final(const Ctx& c) {
    const float* g = CIN(25);
    for (int r = blockIdx.x * 8 + c.wid; r < NB * SEQ; r += gridDim.x * 8) {
        float* xr = COUT + ((size_t)r << 10);
        f32x4 x[4]; float ss = 0.f;
#pragma unroll
        for (int i = 0; i < 4; ++i) { x[i] = *(const f32x4*)(xr + i * 256 + c.lane * 4); ss += x[i][0] * x[i][0] + x[i][1] * x[i][1] + x[i][2] * x[i][2] + x[i][3] * x[i][3]; }
        ss = wave_sum(ss); const float rstd = rsqrtf(ss * (1.f / D) + NORM_EPS);
#pragma unroll
        for (int i = 0; i < 4; ++i) { const int col = i * 256 + c.lane * 4; const f32x4 gv = *(const f32x4*)(g + col); f32x4 y;
#pragma unroll
            for (int e = 0; e < 4; ++e) y[e] = x[i][e] * rstd * gv[e];
            *(f32x4*)(xr + col) = y; }
    }
}

constexpr int LDS_BYTES = 144 * 1024;
static_assert(TOPK_LDS + 16 <= LDS_BYTES && GEMM_LDS + 16 <= LDS_BYTES && ATT_LDS + 16 <= LDS_BYTES, "LDS budget");
constexpr int PPL = 12;
constexpr int N_PHASES = 1 + PPL * DEPTH + 1;
extern __shared__ __attribute__((aligned(16))) char g_lds[];

#define PHASE_FN __device__ __forceinline__ void
PHASE_FN f_p0() { const Ctx c = fresh_ctx(); ph_p0(c, g_lds); }
PHASE_FN f_norm0(int l) { const Ctx c = fresh_ctx(); ph_norm<0>(c, l); }
PHASE_FN f_norm1(int l) { const Ctx c = fresh_ctx(); ph_norm<1>(c, l); }
PHASE_FN f_gemm_in(int l) { const Ctx c = fresh_ctx(); ph_gemm_in(c, l, g_lds); }
PHASE_FN f_prep(int l) {
    const Ctx c = fresh_ctx(); char* lds = g_lds;
    ph_prep_rows(c, l);
    for (int it = blockIdx.x; it < 2 * 16 * NCHUNK * 2; it += gridDim.x) {
        const int mx = it & 1; int u = it >> 1; const int dir = u & 1; u >>= 1; const int cc = u % NCHUNK; u /= NCHUNK; const int h = u & 3, b = u >> 2;
        if (mx == 0) scanA_item<0>(c, l, b, h, cc, dir, lds); else scanA_item<1>(c, l, b, h, cc, dir, lds); }
}
PHASE_FN f_upproj(int l) {
    const Ctx c = fresh_ctx(); char* lds = g_lds;
    EpiBf16 eq{C_QM, 384}, ekv{C_KVM, 512};
    for (int it = blockIdx.x; it < 132 * 7 + 384; it += gridDim.x) {
        if (it < 132 * 7) { const int tm = it / 7, tn = it % 7;
            if (tn < 3) gemm_tile(c, C_P + MLA_CQ, INC, C_WUQ + (size_t)l * 384 * 192, 192, 192, tm * 256, tn * 128, lds, eq);
            else gemm_tile(c, C_P + MLA_CKV, INC, C_WUKV + (size_t)l * 512 * 128, 128, 128, tm * 256, (tn - 3) * 128, lds, ekv); }
        else scanB_item(c, it - 132 * 7); }
}
PHASE_FN f_scanc(int l) {
    const Ctx c = fresh_ctx(); char* lds = g_lds; const bool need_ctx = (l < DEPTH - 1);
    ph_rope_q(c);
    for (int it = blockIdx.x; it < 2 * 16 * NCHUNK; it += gridDim.x) {
        const int mx = it & 1; int u = it >> 1; const int cc = u % NCHUNK; u /= NCHUNK; const int h = u & 3, b = u >> 2;
        if (cc < 4 && !need_ctx) continue;
        if (mx == 0) scanC_item<0>(c, l, b, h, cc, lds); else scanC_item<1>(c, l, b, h, cc, lds); }
}
PHASE_FN f_attn(int l) { const Ctx c = fresh_ctx(); ph_attn(c, l, g_lds); }
PHASE_FN f_gemm_out(int l) {
    const Ctx c = fresh_ctx(); char* lds = g_lds; const bool need_ctx = (l < DEPTH - 1);
    EpiResid e{&c, C_MODT + (size_t)l * 5 * 6144 + 2 * D};
    for (int it = blockIdx.x; it < 132 * 8; it += gridDim.x) { const int tm = it / 8, tn = it % 8;
        if ((tm % 33) == 0 && !need_ctx) continue;
        gemm_tile(c, C_HB, D, C_WOUT + (size_t)l * D * D, D, D, tm * 256, tn * 128, lds, e); }
    cvt_tables(c, l);
}
PHASE_FN f_peer_q(int l) {
    const Ctx c = fresh_ctx(); char* lds = g_lds; const bool need_ctx = (l < DEPTH - 1);
    EpiBf16 e{C_Q2, 2048};
    for (int it = blockIdx.x; it < 132 * 16; it += gridDim.x) { const int tm = it / 16, tn = it % 16;
        if ((tm % 33) == 0 && !need_ctx) continue;
        gemm_tile(c, C_HB, D, C_WQ + (size_t)l * 2048 * D, D, D, tm * 256, tn * 128, lds, e); }
}
PHASE_FN f_topk(int l) {
    const Ctx c = fresh_ctx(); char* lds = g_lds; const bool need_ctx = (l < DEPTH - 1);
    for (int it = blockIdx.x; it < 264 * 8; it += gridDim.x) { const int tm = it >> 3, h = it & 7;
        if ((tm % 66) < 2 && !need_ctx) continue;
        peer_topk_item(c, l, tm, h, lds); }
}
PHASE_FN f_expert_u(int l) { const Ctx c = fresh_ctx(); ph_peer_expert<0>(c, l, g_lds); }
PHASE_FN f_expert_v(int l) { const Ctx c = fresh_ctx(); ph_peer_expert<1>(c, l, g_lds); }
PHASE_FN f_final() { const Ctx c = fresh_ctx(); ph_final(c); }

__global__ void __launch_bounds__(512, 2) mk_fwd(Params p) {
    volatile LAS unsigned* bst = (volatile LAS unsigned*)(g_lds + LDS_BYTES - 16);
    if (threadIdx.x == 0) { bst[0] = 0u; bst[1] = 0u; bst[2] = 0u; bst[3] = 0u; }
    __syncthreads();
    XcdBarrier bar; bar.bar = (unsigned*)(p.ws + WS_CTL); bar.x = 0; bar.st = bst;
    const int lo = p.ph_lo, hi = p.ph_hi;
    const bool multi = (hi - lo) > 1;
    if (multi) bar = xcd_barrier_post((unsigned*)(p.ws + WS_CTL), bst);
#ifndef PHMASK
#define PHMASK 0xFFFF
#endif
#define EN(s) ((PHMASK >> (s)) & 1)
#define IN(k) (lo <= (k) && (k) < hi)
#define SEAM(k) do { if (IN(k) && IN((k) + 1)) xcd_barrier(bar); } while (0)
    if (EN(0) && IN(0)) f_p0();
    SEAM(0);
#define LAYER(l) do { constexpr int base = 1 + PPL * (l); \
        if (EN(1) && IN(base + 0)) f_norm0(l); SEAM(base + 0); \
        if (EN(2) && IN(base + 1)) f_gemm_in(l); SEAM(base + 1); \
        if (EN(3) && IN(base + 2)) f_prep(l); SEAM(base + 2); \
        if (EN(4) && IN(base + 3)) f_upproj(l); SEAM(base + 3); \
        if (EN(5) && IN(base + 4)) f_scanc(l); SEAM(base + 4); \
        if (EN(6) && IN(base + 5)) f_attn(l); SEAM(base + 5); \
        if (EN(7) && IN(base + 6)) f_gemm_out(l); SEAM(base + 6); \
        if (EN(8) && IN(base + 7)) f_norm1(l); SEAM(base + 7); \
        if (EN(9) && IN(base + 8)) f_peer_q(l); SEAM(base + 8); \
        if (EN(10) && IN(base + 9)) f_topk(l); SEAM(base + 9); \
        if (EN(11) && IN(base + 10)) f_expert_u(l); SEAM(base + 10); \
        if (EN(12) && IN(base + 11)) f_expert_v(l); SEAM(base + 11); } while (0)
    LAYER(0);
    LAYER(1);
#undef LAYER
    if (EN(13) && IN(N_PHASES - 1)) f_final();
#undef IN
#undef SEAM
}

#ifdef DBG_STOP
#ifndef DBG_LO
#define DBG_LO WS_MOD
#endif
#ifndef DBG_HI
#define DBG_HI WS_END
#endif
#ifndef DBG_X
#define DBG_X 1
#endif
__global__ void __launch_bounds__(512) mk_dump(float* out, const unsigned* ws) {
    const size_t NOUT = (size_t)NB * SEQ * D; const size_t lo = (size_t)(DBG_LO) / 4, hi = (size_t)(DBG_HI) / 4;
    for (size_t i = (size_t)blockIdx.x * 512 + threadIdx.x; i < NOUT; i += (size_t)gridDim.x * 512) {
        float a = 0.f;
        if (DBG_X) { const unsigned w = __float_as_uint(out[i]); a += (float)((w ^ (w >> 16)) & 0xFFFFu) * 1e-3f; }
        for (size_t j = lo + i; j < hi; j += NOUT) { const unsigned w = ws[j]; a += (float)((w ^ (w >> 16)) & 0xFFFFu) * 1e-3f; }
#ifdef DBG_LO2
        for (size_t j = (size_t)(DBG_LO2) / 4 + i; j < (size_t)(DBG_HI2) / 4; j += NOUT) { const unsigned w = ws[j]; a += (float)((w ^ (w >> 16)) & 0xFFFFu) * 1e-3f; }
#endif
        out[i] = a;
    }
}
#endif
extern "C" void kernel_launch(void* const* d_in, const int* in_sizes, int n_in, void* d_out, int out_size, void* d_ws, size_t ws_size, hipStream_t stream) {
    static int grid = 0;
    if (grid == 0) {
        if (n_in != 26 || in_sizes[0] != NB * SEQ * D || out_size != NB * SEQ * D || ws_size < WS_END) {
            fprintf(stderr, "kernel_launch: shape/workspace mismatch: n_in %d in0 %d out %d ws %zu (need %zu); nothing launched\n", n_in, n_in > 0 ? in_sizes[0] : -1, out_size, ws_size, (size_t)WS_END);
            grid = -1; return; }
        int dev = 0, cus = 0, per_cu = 0;
        if (hipGetDevice(&dev) != hipSuccess || hipDeviceGetAttribute(&cus, hipDeviceAttributeMultiprocessorCount, dev) != hipSuccess) { grid = -1; return; }
        if (hipFuncSetAttribute((const void*)mk_fwd, hipFuncAttributeMaxDynamicSharedMemorySize, LDS_BYTES) != hipSuccess) { fprintf(stderr, "kernel_launch: hipFuncSetAttribute failed\n"); grid = -1; return; }
        if (hipOccupancyMaxActiveBlocksPerMultiprocessor(&per_cu, (const void*)mk_fwd, 512, LDS_BYTES) != hipSuccess || per_cu < 1)
            fprintf(stderr, "kernel_launch: note: occupancy query reports %d workgroups per CU\n", per_cu);
        (void)hipGetLastError();
        grid = cus;
    }
    if (grid < 0) return;
    if (hipMemsetAsync((char*)d_ws + WS_CTL, 0, CTL_BYTES, stream) != hipSuccess) { fprintf(stderr, "kernel_launch: memset failed\n"); return; }
    Params p{};
    for (int i = 0; i < 26; ++i) p.in[i] = (const float*)d_in[i];
    p.out = (float*)d_out; p.ws = (unsigned char*)d_ws;
#ifdef DBG_STOP
    for (int k = 0; k < DBG_STOP; ++k) { p.ph_lo = k; p.ph_hi = k + 1; hipLaunchKernelGGL(mk_fwd, dim3(grid), dim3(512), LDS_BYTES, stream, p); }
    hipLaunchKernelGGL(mk_dump, dim3(1024), dim3(512), 0, stream, (float*)d_out, (const unsigned*)d_ws);
#elif MK_PER_PHASE
    for (int k = 0; k < N_PHASES; ++k) { p.ph_lo = k; p.ph_hi = k + 1; hipLaunchKernelGGL(mk_fwd, dim3(grid), dim3(512), LDS_BYTES, stream, p); }
#else
    p.ph_lo = 0; p.ph_hi = N_PHASES; hipLaunchKernelGGL(mk_fwd, dim3(grid), dim3(512), LDS_BYTES, stream, p);
#endif
    const hipError_t le = hipPeekAtLastError();
    if (le != hipSuccess) fprintf(stderr, "kernel_launch: launch failed: %s\n", hipGetErrorName(le));
}
```

```cpp
#include <hip/hip_runtime.h>
#include <cstdio>
#include <cstdint>

#ifndef MK_PER_PHASE
#define MK_PER_PHASE 0
#endif

constexpr int D = 1024, NB = 4, SEQ = 8192, CTX = 256, DEPTH = 2;
constexpr int RPB = CTX + SEQ;
constexpr int NR = NB * RPB;
constexpr int INC = 3200;
constexpr int GLA_Q = 0, GLA_K = 128, GLA_V = 256, GLA_R = 512, GLA_ZF = 768, GLA_ZB = 784;
constexpr int HG_Q = 800, HG_I = 1056, HG_OG = 1312, HG_ZF = 1568, HG_ZB = 1824;
constexpr int MLA_CQ = 2080, MLA_CKV = 2272, MLA_KR = 2400;
constexpr int DF_Q = 2432, DF_K = 2688, DF_V = 2944;
constexpr int NCHUNK = RPB / 64;
constexpr int NEXP = 16384;
constexpr float NORM_EPS = 1e-6f;

typedef unsigned short bf16_t;
typedef short bf16x8 __attribute__((ext_vector_type(8)));
typedef short s16x4 __attribute__((ext_vector_type(4)));
typedef float f32x16 __attribute__((ext_vector_type(16)));
typedef float f32x4 __attribute__((ext_vector_type(4)));
typedef unsigned u32x4 __attribute__((ext_vector_type(4)));
typedef unsigned u32x2 __attribute__((ext_vector_type(2)));

constexpr size_t al256(size_t x) { return (x + 255) / 256 * 256; }
constexpr size_t WS_CTL = 0;
constexpr size_t CTL_BYTES = 65536;
constexpr size_t WS_MOD = WS_CTL + CTL_BYTES;
constexpr size_t WS_XC = al256(WS_MOD + (size_t)2 * 5 * 6144 * 4);
constexpr size_t WS_WIN = al256(WS_XC + (size_t)NB * CTX * D * 4);
constexpr size_t WS_WOUT = al256(WS_WIN + (size_t)2 * INC * D * 2);
constexpr size_t WS_WQ = al256(WS_WOUT + (size_t)2 * D * D * 2);
constexpr size_t WS_WUQ = al256(WS_WQ + (size_t)2 * 2048 * D * 2);
constexpr size_t WS_WUKV = al256(WS_WUQ + (size_t)2 * 384 * 192 * 2);
constexpr size_t WS_KEYS = al256(WS_WUKV + (size_t)2 * 512 * 128 * 2);
constexpr size_t WS_HB = al256(WS_KEYS + (size_t)2 * 16 * 128 * 128 * 2);
constexpr size_t WS_QM = al256(WS_HB + (size_t)NR * D * 2);
constexpr size_t WS_KVM = al256(WS_QM + (size_t)NR * 384 * 2);
constexpr size_t WS_SG = al256(WS_KVM + (size_t)NR * 512 * 2);
constexpr size_t WS_SH = al256(WS_SG + (size_t)32 * NCHUNK * 2048 * 4);
constexpr size_t WS_DG = al256(WS_SH + (size_t)32 * NCHUNK * 4096 * 4);
constexpr size_t WS_DH = al256(WS_DG + (size_t)32 * NCHUNK * 32 * 4);
constexpr size_t WS_P = al256(WS_DH + (size_t)32 * NCHUNK * 64 * 4);
constexpr size_t WS_END = al256(WS_P + (size_t)NR * INC * 2);
constexpr size_t WS_TU8 = WS_P;
constexpr size_t WS_TV8 = WS_P + (size_t)NEXP * D;
constexpr size_t WS_SU = WS_TV8 + (size_t)NEXP * D;
constexpr size_t WS_SV = WS_SU + (size_t)NEXP * 4;
constexpr size_t WS_Q2 = WS_P + (size_t)64 * 1024 * 1024;
constexpr size_t WS_PART = WS_Q2;
static_assert(WS_SV + (size_t)NEXP * 4 <= WS_Q2, "alias overflow 0");
static_assert(WS_Q2 + (size_t)NR * 2048 * 2 <= WS_END, "alias overflow");
constexpr size_t WS_EI = WS_SG;
constexpr size_t WS_EG = WS_EI + (size_t)NR * 128 * 4;
static_assert(WS_EG + (size_t)NR * 128 * 4 <= WS_DG, "alias overflow 2");

#define XB_TMO      128
#define XB_XCNT(j)  (256  + 64 * (j))
#define XB_XSUB(j)  (1280 + 64 * (j))
#define XB_XGEN(j)  (2304 + 64 * (j))
#define XB_TOP      3328
#define XB_TOPGEN   3392
#define XCD_BAR_WORDS 3456
#define XB_SPIN_CAP (1u << 22)
#define LAS __attribute__((address_space(3)))

__device__ __forceinline__ unsigned xb_ld(unsigned* p)              { return __hip_atomic_load(p, __ATOMIC_RELAXED, __HIP_MEMORY_SCOPE_AGENT); }
__device__ __forceinline__ unsigned xb_add(unsigned* p, unsigned v) { return __hip_atomic_fetch_add(p, v, __ATOMIC_RELAXED, __HIP_MEMORY_SCOPE_AGENT); }
__device__ __forceinline__ unsigned xb_xcc_id() { return (unsigned)__builtin_amdgcn_s_getreg((3 << 11) | 20) & 0xFu; }
#define XB_SPIN(cond, bar) do { unsigned _sp = 0; while (cond) { __builtin_amdgcn_s_sleep(1); \
    if ((++_sp & 255u) == 0u) { if (xb_ld(&(bar)[XB_TMO])) break; if (_sp > XB_SPIN_CAP) { atomicAdd(&(bar)[XB_TMO], 1u); break; } } } } while (0)

struct XcdBarrier { unsigned* bar; unsigned x; volatile LAS unsigned* st; };

__device__ __forceinline__ XcdBarrier xcd_barrier_post(unsigned* bar, volatile LAS unsigned* st) {
    XcdBarrier b; b.bar = bar; b.x = xb_xcc_id(); b.st = st;
    if (threadIdx.x == 0) (void)xb_add(&bar[XB_XCNT(b.x)], 1u);
    return b;
}
__device__ __forceinline__ void xcd_barrier_complete(unsigned* bar, unsigned x, unsigned& nloc, unsigned& nx) {
    const unsigned G = gridDim.x * gridDim.y * gridDim.z;
    unsigned sum, cnt, mine, sp = 0u;
    for (;;) {
        sum = 0u; cnt = 0u; mine = 0u;
#pragma unroll
        for (unsigned j = 0; j < 16; ++j) { const unsigned c = xb_ld(&bar[XB_XCNT(j)]); sum += c; cnt += (c > 0u) ? 1u : 0u; mine = (j == x) ? c : mine; }
        if (sum == G) break;
        __builtin_amdgcn_s_sleep(1);
        if ((++sp & 255u) == 0u) { if (xb_ld(&bar[XB_TMO])) break; if (sp > XB_SPIN_CAP) { atomicAdd(&bar[XB_TMO], 1u); break; } }
    }
    nloc = mine > 0u ? mine : 1u; nx = cnt > 0u ? cnt : 1u;
}
__device__ __forceinline__ void xcd_barrier(const XcdBarrier& b) {
    asm volatile("s_waitcnt vmcnt(0)" ::: "memory");
    __syncthreads();
    if (threadIdx.x == 0) {
        unsigned* bar = b.bar;
        __builtin_amdgcn_s_waitcnt(0);
        unsigned nloc = b.st[0], nx = b.st[1];
        if (nloc == 0u) { xcd_barrier_complete(bar, b.x, nloc, nx); b.st[0] = nloc; b.st[1] = nx; }
        const unsigned old = xb_add(&bar[XB_XSUB(b.x)], 1u);
        const unsigned gen = old / nloc;
        if (old + 1u == (gen + 1u) * nloc) {
            __builtin_amdgcn_fence(__ATOMIC_RELEASE, "agent");
            asm volatile("s_waitcnt vmcnt(0)" ::: "memory");
            const unsigned og = xb_add(&bar[XB_TOP], 1u);
            const unsigned tg = og / nx;
            if (og + 1u == (tg + 1u) * nx) xb_add(&bar[XB_TOPGEN], 1u);
            else XB_SPIN(xb_ld(&bar[XB_TOPGEN]) == tg, bar);
            __builtin_amdgcn_fence(__ATOMIC_ACQUIRE, "agent");
            xb_add(&bar[XB_XGEN(b.x)], 1u);
            asm volatile("s_waitcnt vmcnt(0)" ::: "memory");
        } else {
            XB_SPIN(xb_ld(&bar[XB_XGEN(b.x)]) == gen, bar);
            __builtin_amdgcn_fence(__ATOMIC_ACQUIRE, "agent");
            asm volatile("s_waitcnt vmcnt(0)" ::: "memory");
        }
    }
    __syncthreads();
}

typedef __bf16 bf16v2_t __attribute__((ext_vector_type(2)));
typedef float f32v2_t __attribute__((ext_vector_type(2)));
__device__ __forceinline__ unsigned cvtpk(float lo, float hi) { const f32v2_t v = {lo, hi}; const bf16v2_t b = __builtin_convertvector(v, bf16v2_t); return __builtin_bit_cast(unsigned, b); }
__device__ __forceinline__ bf16_t f2bf(float x) { const __bf16 b = (__bf16)x; return __builtin_bit_cast(bf16_t, b); }
__device__ __forceinline__ float bf2f(bf16_t h) { return __uint_as_float(((unsigned)h) << 16); }
__device__ __forceinline__ float bflo(unsigned w) { return __uint_as_float(w << 16); }
__device__ __forceinline__ float bfhi(unsigned w) { return __uint_as_float(w & 0xffff0000u); }
__device__ __forceinline__ float silu_f(float x) { return x / (1.f + __expf(-x)); }
__device__ __forceinline__ float logsigmoid_f(float z) { return fminf(z, 0.f) - __logf(1.f + __expf(-fabsf(z))); }
__device__ __forceinline__ float wave_sum(float v) {
#pragma unroll
    for (int o = 32; o >= 1; o >>= 1) v += __shfl_xor(v, o, 64);
    return v;
}
__device__ __forceinline__ void zero_acc(f32x16& a) {
#pragma unroll
    for (int r = 0; r < 16; ++r) a[r] = 0.f;
    asm volatile("" : "+v"(a));
}
__device__ __forceinline__ int crow(int r, int hi) { return (r & 3) + 8 * (r >> 2) + 4 * hi; }

struct Params { const float* in[26]; float* out; unsigned char* ws; int ph_lo, ph_hi; };
typedef const __attribute__((address_space(4))) Params* KParams;
struct Ctx {
    KParams pp;
    int tid, lane, wid;
};
__device__ __forceinline__ Ctx fresh_ctx() {
    Ctx c; unsigned long long a = (unsigned long long)__builtin_amdgcn_kernarg_segment_ptr(); asm volatile("" : "+s"(a)); c.pp = (KParams)a;
    int t = threadIdx.x; asm volatile("" : "+v"(t)); c.tid = t; c.lane = t & 63; c.wid = __builtin_amdgcn_readfirstlane(t >> 6);
    return c;
}
#define CIN(i)   (c.pp->in[i])
#define COUT     (c.pp->out)
#define CWS(off) (c.pp->ws + (off))
#define C_MODT ((float*)CWS(WS_MOD))
#define C_XC   ((float*)CWS(WS_XC))
#define C_WIN  ((bf16_t*)CWS(WS_WIN))
#define C_WOUT ((bf16_t*)CWS(WS_WOUT))
#define C_WQ   ((bf16_t*)CWS(WS_WQ))
#define C_WUQ  ((bf16_t*)CWS(WS_WUQ))
#define C_WUKV ((bf16_t*)CWS(WS_WUKV))
#define C_KEYS ((bf16_t*)CWS(WS_KEYS))
#define C_HB   ((bf16_t*)CWS(WS_HB))
#define C_QM   ((bf16_t*)CWS(WS_QM))
#define C_KVM  ((bf16_t*)CWS(WS_KVM))
#define C_P    ((bf16_t*)CWS(WS_P))
#define C_TU8  ((unsigned char*)CWS(WS_TU8))
#define C_TV8  ((unsigned char*)CWS(WS_TV8))
#define C_SU   ((float*)CWS(WS_SU))
#define C_SV   ((float*)CWS(WS_SV))
#define C_PART ((float*)CWS(WS_PART))
#define C_Q2   ((bf16_t*)CWS(WS_Q2))
#define C_SG   ((float*)CWS(WS_SG))
#define C_SH   ((float*)CWS(WS_SH))
#define C_DG   ((float*)CWS(WS_DG))
#define C_DH   ((float*)CWS(WS_DH))
#define C_EI   ((int*)CWS(WS_EI))
#define C_EG   ((float*)CWS(WS_EG))

__device__ __forceinline__ float* xrow(const Ctx& c, int r) {
    const int b = r / RPB, j = r - b * RPB;
    return j < CTX ? C_XC + ((size_t)(b * CTX + j) << 10) : COUT + ((size_t)(b * SEQ + (j - CTX)) << 10);
}
__device__ __forceinline__ const float* inrow(const Ctx& c, int r) {
    const int b = r / RPB, j = r - b * RPB;
    return j < CTX ? CIN(2) + ((size_t)(b * CTX + j) << 10) : CIN(0) + ((size_t)(b * SEQ + (j - CTX)) << 10);
}

__device__ void p0_mod_item(const Ctx& c, int item, char* lds) {
    float* sc = (float*)lds;
    float* red = sc + 5 * 1024;
    const int tid = c.tid;
    for (int i = tid; i < 5 * 1024; i += 512) { const int v = i >> 10, k = i & 1023; const float x = (v < 4) ? CIN(1)[v * 1024 + k] : CIN(3)[k]; sc[i] = silu_f(x); }
    __syncthreads();
    const int l = item / 96, n0 = (item % 96) * 64;
    const int col = tid & 63, kg = tid >> 6;
    const float* w = CIN(4) + (size_t)l * 1024 * 6144 + n0 + col;
    float a[5] = {0.f, 0.f, 0.f, 0.f, 0.f};
#pragma unroll 8
    for (int kk = 0; kk < 128; ++kk) { const int k = kg * 128 + kk; const float wv = w[(size_t)k * 6144];
#pragma unroll
        for (int v = 0; v < 5; ++v) a[v] += sc[v * 1024 + k] * wv; }
#pragma unroll
    for (int v = 0; v < 5; ++v) red[(kg * 64 + col) * 5 + v] = a[v];
    __syncthreads();
    if (tid < 320) { const int cc = tid / 5, v = tid % 5; float s = 0.f;
#pragma unroll
        for (int g = 0; g < 8; ++g) s += red[(g * 64 + cc) * 5 + v];
        C_MODT[((size_t)l * 5 + v) * 6144 + n0 + cc] = s + CIN(5)[l * 6144 + n0 + cc]; }
    __syncthreads();
}
__device__ void p0_tr_tile(const float* __restrict__ src, bf16_t* __restrict__ dst, int K, int N, int k0, int n0, int tid, char* lds) {
    float* t = (float*)lds;
#pragma unroll
    for (int i = 0; i < 2; ++i) { const int k = (tid >> 4) + 32 * i, n4 = (tid & 15) * 4;
        const f32x4 v = *(const f32x4*)(src + (size_t)(k0 + k) * N + n0 + n4);
        t[k * 65 + n4 + 0] = v[0]; t[k * 65 + n4 + 1] = v[1]; t[k * 65 + n4 + 2] = v[2]; t[k * 65 + n4 + 3] = v[3]; }
    __syncthreads();
    { const int n = tid >> 3, k8 = (tid & 7) * 8; u32x4 w;
#pragma unroll
        for (int j = 0; j < 4; ++j) w[j] = cvtpk(t[(k8 + 2 * j) * 65 + n], t[(k8 + 2 * j + 1) * 65 + n]);
        *(u32x4*)(dst + (size_t)(n0 + n) * K + k0 + k8) = w; }
    __syncthreads();
}
__device__ void ph_p0(const Ctx& c, char* lds) {
    constexpr int T_WIN = 16 * 50, T_WOUT = 16 * 16, T_WQ = 16 * 32, T_UQ = 3 * 6, T_UKV = 2 * 8;
    constexpr int PER_L = T_WIN + T_WOUT + T_WQ + T_UQ + T_UKV;
    constexpr int NITEM = 192 + 2 * PER_L;
    for (int it = blockIdx.x; it < NITEM; it += gridDim.x) {
        if (it < 192) { p0_mod_item(c, it, lds); continue; }
        int t = it - 192; const int l = t / PER_L; t -= l * PER_L;
        if (t < T_WIN) { p0_tr_tile(CIN(8) + (size_t)l * D * INC, C_WIN + (size_t)l * INC * D, D, INC, (t / 50) * 64, (t % 50) * 64, c.tid, lds); continue; } t -= T_WIN;
        if (t < T_WOUT) { p0_tr_tile(CIN(9) + (size_t)l * D * D, C_WOUT + (size_t)l * D * D, D, D, (t / 16) * 64, (t % 16) * 64, c.tid, lds); continue; } t -= T_WOUT;
        if (t < T_WQ) { p0_tr_tile(CIN(21) + (size_t)l * D * 2048, C_WQ + (size_t)l * 2048 * D, D, 2048, (t / 32) * 64, (t % 32) * 64, c.tid, lds); continue; } t -= T_WQ;
        if (t < T_UQ) { p0_tr_tile(CIN(17) + (size_t)l * 192 * 384, C_WUQ + (size_t)l * 384 * 192, 192, 384, (t / 6) * 64, (t % 6) * 64, c.tid, lds); continue; } t -= T_UQ;
        p0_tr_tile(CIN(18) + (size_t)l * 128 * 512, C_WUKV + (size_t)l * 512 * 128, 128, 512, (t / 8) * 64, (t % 8) * 64, c.tid, lds);
    }
    const size_t nk8 = (size_t)2 * 16 * 128 * 128 / 8;
    for (size_t i = (size_t)blockIdx.x * 512 + c.tid; i < nk8; i += (size_t)gridDim.x * 512) {
        const f32x4 a = *(const f32x4*)(CIN(22) + i * 8), b = *(const f32x4*)(CIN(22) + i * 8 + 4);
        u32x4 w = {cvtpk(a[0], a[1]), cvtpk(a[2], a[3]), cvtpk(b[0], b[1]), cvtpk(b[2], b[3])};
        *(u32x4*)(C_KEYS + i * 8) = w;
    }
}

template <int WHICH>
__device__ void ph_norm(const Ctx& c, int l) {
    const float* g = CIN(WHICH == 0 ? 6 : 7) + l * D;
    const bool need_ctx = (l < DEPTH - 1);
    for (int r = blockIdx.x * 8 + c.wid; r < NR; r += gridDim.x * 8) {
        const int b = r / RPB, j = r - b * RPB; const bool isctx = j < CTX;
        if (WHICH == 1 && isctx && !need_ctx) continue;
        const float* src = (WHICH == 0 && l == 0) ? inrow(c, r) : xrow(c, r);
        f32x4 x[4]; float ss = 0.f;
#pragma unroll
        for (int i = 0; i < 4; ++i) { x[i] = *(const f32x4*)(src + i * 256 + c.lane * 4); ss += x[i][0] * x[i][0] + x[i][1] * x[i][1] + x[i][2] * x[i][2] + x[i][3] * x[i][3]; }
        ss = wave_sum(ss);
        const float rstd = rsqrtf(ss * (1.f / D) + NORM_EPS);
        const float* mt = C_MODT + ((size_t)l * 5 + (isctx ? 4 : b)) * 6144;
        const float* sh = mt + (WHICH == 0 ? 0 : 3) * D; const float* scl = mt + (WHICH == 0 ? 1 : 4) * D;
        bf16_t* dst = C_HB + (size_t)r * D;
        float* xr = xrow(c, r);
#pragma unroll
        for (int i = 0; i < 4; ++i) { const int col = i * 256 + c.lane * 4;
            const f32x4 gv = *(const f32x4*)(g + col), sv = *(const f32x4*)(sh + col), cv = *(const f32x4*)(scl + col);
            float y[4];
#pragma unroll
            for (int e = 0; e < 4; ++e) y[e] = x[i][e] * rstd * gv[e] * (1.f + cv[e]) + sv[e];
            u32x2 w = {cvtpk(y[0], y[1]), cvtpk(y[2], y[3])};
            *(u32x2*)(dst + col) = w;
            if (WHICH == 0 && l == 0) *(f32x4*)(xr + col) = x[i]; }
    }
}

constexpr int GEMM_LDS = 98304;
template <class Epi>
__device__ __forceinline__ void gemm_tile(const Ctx& c, const bf16_t* __restrict__ A, int lda, const bf16_t* __restrict__ Bt, int ldb, int K, int m0, int n0, char* lds, const Epi& epi) {
    const int tid = c.tid, lane = tid & 63, wid = tid >> 6, r32 = lane & 31, hi = lane >> 5, wm = wid >> 1, wn = wid & 1;
    char* As = lds; char* Bs = lds + 65536;
    f32x16 acc[2][2];
#pragma unroll
    for (int m = 0; m < 2; ++m)
#pragma unroll
        for (int n = 0; n < 2; ++n) zero_acc(acc[m][n]);
    u32x4 ra[4], rb[2];
    const int srow = tid >> 3, sch = tid & 7;
    const bf16_t* Ag = A + (size_t)(m0 + srow) * lda + sch * 8;
    const bf16_t* Bg = Bt + (size_t)(n0 + srow) * ldb + sch * 8;
    const int swoff = srow * 128 + ((sch ^ ((srow >> 1) & 7)) << 4);
#define GLOAD(k0) do { _Pragma("unroll") for (int i = 0; i < 4; ++i) ra[i] = *(const u32x4*)(Ag + (size_t)(64 * i) * lda + (k0)); \
                       _Pragma("unroll") for (int i = 0; i < 2; ++i) rb[i] = *(const u32x4*)(Bg + (size_t)(64 * i) * ldb + (k0)); } while (0)
#define SWRITE(buf) do { _Pragma("unroll") for (int i = 0; i < 4; ++i) *(u32x4*)(As + (buf) * 32768 + swoff + i * 8192) = ra[i]; \
                         _Pragma("unroll") for (int i = 0; i < 2; ++i) *(u32x4*)(Bs + (buf) * 16384 + swoff + i * 8192) = rb[i]; } while (0)
    const int nk = K >> 6;
    GLOAD(0); SWRITE(0); __syncthreads();
    for (int kt = 0; kt < nk; ++kt) {
        const int buf = kt & 1;
        if (kt + 1 < nk) GLOAD((kt + 1) * 64);
        const char* Ab = As + buf * 32768; const char* Bb = Bs + buf * 16384;
#pragma unroll
        for (int ks = 0; ks < 4; ++ks) {
            bf16x8 a[2], b[2];
#pragma unroll
            for (int m = 0; m < 2; ++m) { const int row = wm * 64 + m * 32 + r32; a[m] = *(const bf16x8*)(Ab + row * 128 + (((ks * 2 + hi) ^ ((row >> 1) & 7)) << 4)); }
#pragma unroll
            for (int n = 0; n < 2; ++n) { const int row = wn * 64 + n * 32 + r32; b[n] = *(const bf16x8*)(Bb + row * 128 + (((ks * 2 + hi) ^ ((row >> 1) & 7)) << 4)); }
#pragma unroll
            for (int m = 0; m < 2; ++m)
#pragma unroll
                for (int n = 0; n < 2; ++n) acc[m][n] = __builtin_amdgcn_mfma_f32_32x32x16_bf16(a[m], b[n], acc[m][n], 0, 0, 0);
        }
        if (kt + 1 < nk) SWRITE(buf ^ 1);
        __syncthreads();
    }
#undef GLOAD
#undef SWRITE
    epi(acc, m0 + wm * 64, n0 + wn * 64, r32, hi);
}
struct EpiBf16 {
    bf16_t* C; int ldc;
    __device__ __forceinline__ void operator()(const f32x16 (&acc)[2][2], int row0, int col0, int r32, int hi) const {
        bf16_t* base = C + (size_t)(row0 + 4 * hi) * ldc + col0 + r32;
#pragma unroll
        for (int m = 0; m < 2; ++m)
#pragma unroll
            for (int r = 0; r < 16; ++r) { bf16_t* p = base + (size_t)(m * 32 + (r & 3) + 8 * (r >> 2)) * ldc;
                p[0] = f2bf(acc[m][0][r]); p[32] = f2bf(acc[m][1][r]);
                asm volatile("" ::: "memory"); }
    }
};
struct EpiResid {
    const Ctx* c; const float* gate_l;
    __device__ __forceinline__ void operator()(const f32x16 (&acc)[2][2], int row0, int col0, int r32, int hi) const {
        const int b = row0 / RPB, j0 = row0 - b * RPB; const bool isctx = j0 < CTX;
        const float* gt = gate_l + (size_t)(isctx ? 4 : b) * 6144;
        float* xb = xrow(*c, row0);
        const float gv0 = gt[col0 + r32], gv1 = gt[col0 + 32 + r32];
        float* xq = xb + ((size_t)(4 * hi) << 10) + col0 + r32;
#pragma unroll
        for (int m = 0; m < 2; ++m)
#pragma unroll
            for (int r = 0; r < 16; ++r) { float* p = xq + ((size_t)(m * 32 + (r & 3) + 8 * (r >> 2)) << 10);
                const float a0 = p[0], a1 = p[32];
                p[0] = a0 + gv0 * acc[m][0][r]; p[32] = a1 + gv1 * acc[m][1][r];
                asm volatile("" ::: "memory"); }
    }
};

__device__ void ph_gemm_in(const Ctx& c, int l, char* lds) {
    EpiBf16 e{C_P, INC};
    const bf16_t* Bt = C_WIN + (size_t)l * INC * D;
    for (int it = blockIdx.x; it < 132 * 25; it += gridDim.x) { const int tm = it / 25, tn = it % 25; gemm_tile(c, C_HB, D, Bt, D, D, tm * 256, tn * 128, lds, e); }
}

template <int MX> struct ScanCfg;
template <> struct ScanCfg<0> { static constexpr int DK = 32; };
template <> struct ScanCfg<1> { static constexpr int DK = 64; };

constexpr int BP = 72;
typedef float f32x4v __attribute__((ext_vector_type(4)));
__device__ __forceinline__ bf16x8 frag16(const bf16_t* tile, int row0, int k0, int lane) { return *(const bf16x8*)(tile + (row0 + (lane & 15)) * BP + k0 + 8 * (lane >> 4)); }

template <int MX, bool WANT_Q>
__device__ __forceinline__ void scan_load(const Ctx& c, int l, int b, int h, int cc, int dir, float* qt, float* kt, float* gt, bf16_t* VT, float* tmp) {
    constexpr int DK = ScanCfg<MX>::DK, PK = DK + 1;
    const int tid = c.tid;
    const int t = tid >> 3, j0 = (tid & 7) * 8;
    const bf16_t* pr = C_P + (size_t)(b * RPB + cc * 64 + (dir ? 63 - t : t)) * INC;
    const u32x4 vv = *(const u32x4*)(pr + (MX == 0 ? GLA_V : HG_I) + h * 64 + j0);
    if (MX == 0) {
        float* zt = tmp; float* wt = tmp + 64 * 16; float* bt = wt + 16 * 32;
        const int j4 = (tid & 7) * 4;
        const u32x2 kv = *(const u32x2*)(pr + GLA_K + h * 32 + j4);
        u32x2 qv = {0u, 0u}; if (WANT_Q) qv = *(const u32x2*)(pr + GLA_Q + h * 32 + j4);
        u32x4 zv = {0u, 0u, 0u, 0u};
        if (tid < 128) zv = *(const u32x4*)(C_P + (size_t)(b * RPB + cc * 64 + (dir ? 63 - (tid >> 1) : (tid >> 1))) * INC + (dir ? GLA_ZB : GLA_ZF) + (tid & 1) * 8);
        { const int k = tid >> 5, j = tid & 31; wt[tid] = CIN(10)[(((size_t)l * 2 + dir) * 16 + k) * 128 + h * 32 + j]; }
        if (tid < 32) bt[tid] = CIN(11)[((size_t)l * 2 + dir) * 128 + h * 32 + tid];
        if (tid < 128) { float* zp = zt + (tid >> 1) * 16 + (tid & 1) * 8;
#pragma unroll
            for (int q = 0; q < 4; ++q) { zp[2 * q] = bflo(zv[q]); zp[2 * q + 1] = bfhi(zv[q]); } }
        __syncthreads();
#pragma unroll
        for (int e = 0; e < 4; ++e) { const int j = j4 + e;
            float a = bt[j];
#pragma unroll
            for (int k = 0; k < 16; ++k) a += zt[t * 16 + k] * wt[k * 32 + j];
            gt[t * PK + j] = logsigmoid_f(a) * (1.f / 16.f);
            kt[t * PK + j] = (e & 1) ? bfhi(kv[e >> 1]) : bflo(kv[e >> 1]);
            if (WANT_Q) qt[t * PK + j] = ((e & 1) ? bfhi(qv[e >> 1]) : bflo(qv[e >> 1])) * 0.17677669529663687f; }
    } else {
        const u32x4 zv = *(const u32x4*)(pr + (dir ? HG_ZB : HG_ZF) + h * 64 + j0);
        u32x4 qv = {0u, 0u, 0u, 0u}; if (WANT_Q) qv = *(const u32x4*)(pr + HG_Q + h * 64 + j0);
        float lbv[8];
#pragma unroll
        for (int e = 0; e < 8; ++e) lbv[e] = 0.f;
        if (l > 0) { const f32x4 r0a = *(const f32x4*)(CIN(13) + h * 64 + j0), r0b = *(const f32x4*)(CIN(13) + h * 64 + j0 + 4);
                     const f32x4 r1a = *(const f32x4*)(CIN(13) + 256 + h * 64 + j0), r1b = *(const f32x4*)(CIN(13) + 256 + h * 64 + j0 + 4);
#pragma unroll
            for (int e = 0; e < 4; ++e) { lbv[e] = 1.f / (1.f + __expf(r0a[e] - r1a[e])); lbv[4 + e] = 1.f / (1.f + __expf(r0b[e] - r1b[e])); } }
#pragma unroll
        for (int e = 0; e < 8; ++e) { const int j = j0 + e;
            const float z = (e & 1) ? bfhi(zv[e >> 1]) : bflo(zv[e >> 1]); const float lb = lbv[e];
            const float log_lb = __logf(fmaxf(lb, 1e-30f)), log_1mlb = __logf(1.f - lb);
            const float ls = logsigmoid_f(z); const float a1 = log_lb, a2 = log_1mlb + ls;
            gt[t * PK + j] = fmaxf(a1, a2) + __logf(1.f + __expf(-fabsf(a1 - a2)));
            kt[t * PK + j] = (1.f - lb) / (1.f + __expf(z));
            if (WANT_Q) qt[t * PK + j] = silu_f((e & 1) ? bfhi(qv[e >> 1]) : bflo(qv[e >> 1])); }
    }
#pragma unroll
    for (int e = 0; e < 8; ++e) VT[(j0 + e) * BP + t] = (bf16_t)((e & 1) ? (vv[e >> 1] >> 16) : (vv[e >> 1] & 0xffffu));
    __syncthreads();
    { float x[DK / 8];
#pragma unroll
        for (int u = 0; u < DK / 8; ++u) x[u] = gt[c.lane * PK + c.wid + 8 * u];
#pragma unroll
        for (int d = 1; d < 64; d <<= 1)
#pragma unroll
            for (int u = 0; u < DK / 8; ++u) { const float y = __shfl_up(x[u], d, 64); if (c.lane >= d) x[u] += y; }
#pragma unroll
        for (int u = 0; u < DK / 8; ++u) gt[c.lane * PK + c.wid + 8 * u] = x[u]; }
    __syncthreads();
}

template <int MX>
__device__ void scanA_item(const Ctx& c, int l, int b, int h, int cc, int dir, char* lds) {
    constexpr int DK = ScanCfg<MX>::DK, PK = DK + 1;
    float* kt = (float*)lds; float* gt = kt + 64 * PK; bf16_t* VT = (bf16_t*)(gt + 64 * PK); bf16_t* KET = VT + 64 * BP; float* tmp = (float*)(KET + 64 * BP);
    scan_load<MX, false>(c, l, b, h, cc, dir, nullptr, kt, gt, VT, tmp);
    const int tid = c.tid, lane = c.lane;
    for (int i = tid; i < 64 * DK; i += 512) { const int s_ = i & 63, k = i >> 6; KET[k * BP + s_] = f2bf(kt[s_ * PK + k] * __expf(gt[63 * PK + k] - gt[s_ * PK + k])); }
    __syncthreads();
    const int ch = (b * 4 + h) * 2 + dir;
    float* S = (MX == 0 ? C_SG : C_SH) + ((size_t)ch * NCHUNK + cc) * (DK * 64);
    for (int tile = c.wid; tile < (DK / 16) * 4; tile += 8) { const int tk = tile >> 2, tj = tile & 3;
        f32x4v acc = {0.f, 0.f, 0.f, 0.f};
#pragma unroll
        for (int ks = 0; ks < 2; ++ks) acc = __builtin_amdgcn_mfma_f32_16x16x32_bf16(frag16(KET, tk * 16, ks * 32, lane), frag16(VT, tj * 16, ks * 32, lane), acc, 0, 0, 0);
#pragma unroll
        for (int i = 0; i < 4; ++i) S[(tk * 16 + 4 * (lane >> 4) + i) * 64 + tj * 16 + (lane & 15)] = acc[i]; }
    if (tid < DK) (MX == 0 ? C_DG : C_DH)[((size_t)ch * NCHUNK + cc) * DK + tid] = __expf(gt[63 * PK + tid]);
    __syncthreads();
}
__device__ void scanB_item(const Ctx& c, int item) {
    const int e = item * 512 + c.tid;
    const bool hg = e >= 65536; const int ee = hg ? e - 65536 : e;
    const int DK = hg ? 64 : 32; const int per = DK * 64;
    const int ch = ee / per, ij = ee % per, i = ij >> 6; const int dir = ch & 1;
    float* S = (hg ? C_SH : C_SG) + (size_t)ch * NCHUNK * per + ij;
    const float* Dc = (hg ? C_DH : C_DG) + (size_t)ch * NCHUNK * DK + i;
    float st = 0.f;
    for (int n0 = 0; n0 < NCHUNK; n0 += 6) {
        float sv[6], dv[6];
#pragma unroll
        for (int u = 0; u < 6; ++u) { const int n = n0 + u; const int cc = dir ? (n < 4 ? 3 - n : 135 - n) : n; sv[u] = S[(size_t)cc * per]; dv[u] = Dc[(size_t)cc * DK]; }
#pragma unroll
        for (int u = 0; u < 6; ++u) { const int n = n0 + u; const int cc = dir ? (n < 4 ? 3 - n : 135 - n) : n; S[(size_t)cc * per] = st; st = dv[u] * st + sv[u]; }
    }
}
template <int MX>
__device__ void scanC_item(const Ctx& c, int l, int b, int h, int cc, char* lds) {
    constexpr int DK = ScanCfg<MX>::DK, PK = DK + 1;
    float* qt = (float*)lds; float* kt = qt + 64 * PK; float* gt = kt + 64 * PK; float* ot = gt + 64 * PK;
    bf16_t* VT = (bf16_t*)(ot + 64 * 65); bf16_t* QS = VT + 64 * BP; bf16_t* QG = QS + 64 * BP; bf16_t* KS = QG + 64 * BP;
    bf16_t* SC = KS + 96 * BP; bf16_t* ST = SC + 64 * BP; float* tmp = (float*)(ST + 64 * BP);
    const int tid = c.tid, lane = c.lane;
    for (int dir = 0; dir < 2; ++dir) {
        scan_load<MX, true>(c, l, b, h, cc, dir, qt, kt, gt, VT, tmp);
        const int ch = (b * 4 + h) * 2 + dir;
        const float* Sg = (MX == 0 ? C_SG : C_SH) + ((size_t)ch * NCHUNK + cc) * (DK * 64);
        if (tid < DK * 8) { const int k = tid >> 3, jb = (tid & 7) * 8; const f32x4 sa = *(const f32x4*)(Sg + tid * 8), sb = *(const f32x4*)(Sg + tid * 8 + 4);
#pragma unroll
            for (int e = 0; e < 4; ++e) { ST[(jb + e) * BP + k] = f2bf(sa[e]); ST[(jb + 4 + e) * BP + k] = f2bf(sb[e]); } }
        for (int i = tid; i < 64 * DK; i += 512) { const int t = i / DK, k = i % DK; const int I = t >> 4;
            const float bt = gt[t * PK + k], qv = qt[t * PK + k], kv = kt[t * PK + k];
            const float Bi = I ? gt[(16 * I - 1) * PK + k] : 0.f;
            QS[t * BP + k] = f2bf(qv * __expf(bt - Bi));
            QG[t * BP + k] = f2bf(qv * __expf(bt));
            if (t < 16) KS[t * BP + k] = f2bf(kv * __expf(gt[15 * PK + k] - bt));
            if (t < 32) KS[(16 + t) * BP + k] = f2bf(kv * __expf(gt[31 * PK + k] - bt));
            if (t < 48) KS[(48 + t) * BP + k] = f2bf(kv * __expf(gt[47 * PK + k] - bt)); }
        { const int blk = tid >> 7, tl = (tid >> 3) & 15, s0 = (tid & 7) * 2; const int t = blk * 16 + tl;
            float a0 = 0.f, a1 = 0.f;
            if (s0 <= tl) { const int sa = blk * 16 + s0, sb = sa + 1;
                for (int k = 0; k < DK; ++k) { const float qv = qt[t * PK + k], bv = gt[t * PK + k];
                    a0 += qv * kt[sa * PK + k] * __expf(fminf(bv - gt[sa * PK + k], 0.f));
                    a1 += qv * kt[sb * PK + k] * __expf(fminf(bv - gt[sb * PK + k], 0.f)); }
                if (s0 + 1 > tl) a1 = 0.f; }
            SC[t * BP + blk * 16 + s0] = f2bf(a0); SC[t * BP + blk * 16 + s0 + 1] = f2bf(a1);
            for (int J = blk + 1; J < 4; ++J) { SC[t * BP + J * 16 + s0] = 0; SC[t * BP + J * 16 + s0 + 1] = 0; } }
        __syncthreads();
        if (c.wid < 6) { const int I = c.wid < 1 ? 1 : (c.wid < 3 ? 2 : 3), J = c.wid < 1 ? 0 : (c.wid < 3 ? c.wid - 1 : c.wid - 3);
            const bf16_t* KSI = KS + (I == 1 ? 0 : (I == 2 ? 16 : 48)) * BP;
            f32x4v acc = {0.f, 0.f, 0.f, 0.f};
#pragma unroll
            for (int ks = 0; ks < DK / 32; ++ks) acc = __builtin_amdgcn_mfma_f32_16x16x32_bf16(frag16(QS, I * 16, ks * 32, lane), frag16(KSI, J * 16, ks * 32, lane), acc, 0, 0, 0);
#pragma unroll
            for (int i = 0; i < 4; ++i) SC[(I * 16 + 4 * (lane >> 4) + i) * BP + J * 16 + (lane & 15)] = f2bf(acc[i]); }
        __syncthreads();
#pragma unroll
        for (int u = 0; u < 2; ++u) { const int tile = c.wid * 2 + u; const int ti = tile >> 2, tj = tile & 3;
            f32x4v acc = {0.f, 0.f, 0.f, 0.f};
#pragma unroll
            for (int ks = 0; ks < 2; ++ks) acc = __builtin_amdgcn_mfma_f32_16x16x32_bf16(frag16(SC, ti * 16, ks * 32, lane), frag16(VT, tj * 16, ks * 32, lane), acc, 0, 0, 0);
#pragma unroll
            for (int ks = 0; ks < DK / 32; ++ks) acc = __builtin_amdgcn_mfma_f32_16x16x32_bf16(frag16(QG, ti * 16, ks * 32, lane), frag16(ST, tj * 16, ks * 32, lane), acc, 0, 0, 0);
#pragma unroll
            for (int i = 0; i < 4; ++i) { const int t = ti * 16 + 4 * (lane >> 4) + i; const int to = dir ? 63 - t : t; float* op = ot + to * 65 + tj * 16 + (lane & 15);
                if (dir == 0) *op = acc[i]; else *op += acc[i]; } }
        __syncthreads();
    }
    { const int t = tid >> 3, j0 = (tid & 7) * 8; float o[8]; float ss = 0.f;
#pragma unroll
        for (int j = 0; j < 8; ++j) { o[j] = ot[t * 65 + j0 + j]; ss += o[j] * o[j]; }
        ss += __shfl_xor(ss, 1, 64); ss += __shfl_xor(ss, 2, 64); ss += __shfl_xor(ss, 4, 64);
        const float rstd = rsqrtf(ss * (1.f / 64.f) + NORM_EPS);
        const int r = b * RPB + cc * 64 + t;
        const float* gn = CIN(MX == 0 ? 12 : 14) + l * 64;
        const u32x4 gp = *(const u32x4*)(C_P + (size_t)r * INC + (MX == 0 ? GLA_R : HG_OG) + h * 64 + j0);
        float y[8];
#pragma unroll
        for (int j = 0; j < 8; ++j) y[j] = o[j] * rstd * gn[j0 + j] * silu_f((j & 1) ? bfhi(gp[j >> 1]) : bflo(gp[j >> 1]));
        u32x4 w = {cvtpk(y[0], y[1]), cvtpk(y[2], y[3]), cvtpk(y[4], y[5]), cvtpk(y[6], y[7])};
        *(u32x4*)(C_HB + (size_t)r * D + MX * 256 + h * 64 + j0) = w; }
    __syncthreads();
}

__device__ __forceinline__ void rope_cs(int pos, int i, float& cs, float& sn) {
    const float freq = __expf(-(float)i * (9.210340371976184f / 8.f));
    const float ang = (float)pos * freq;
    const float n = rintf(ang * 0.15915494309189535f);
    float rr = fmaf(-n, 6.2831854820251465f, ang); rr = fmaf(-n, -1.7484555e-7f, rr);
    cs = __cosf(rr); sn = __sinf(rr);
}

__device__ void ph_prep_rows(const Ctx& c, int l) {
    const float* gq = CIN(15) + l * 192; const float* gkv = CIN(16) + l * 128;
    for (int r = blockIdx.x * 8 + c.wid; r < NR; r += gridDim.x * 8) {
        const int b = r / RPB, j = r - b * RPB; bf16_t* pr = C_P + (size_t)r * INC;
        { float v[3]; float ss = 0.f;
#pragma unroll
            for (int i = 0; i < 3; ++i) { v[i] = bf2f(pr[MLA_CQ + c.lane + 64 * i]); ss += v[i] * v[i]; }
            ss = wave_sum(ss); const float rstd = rsqrtf(ss * (1.f / 192.f) + NORM_EPS);
#pragma unroll
            for (int i = 0; i < 3; ++i) pr[MLA_CQ + c.lane + 64 * i] = f2bf(v[i] * rstd * gq[c.lane + 64 * i]); }
        { float v[2]; float ss = 0.f;
#pragma unroll
            for (int i = 0; i < 2; ++i) { v[i] = bf2f(pr[MLA_CKV + c.lane + 64 * i]); ss += v[i] * v[i]; }
            ss = wave_sum(ss); const float rstd = rsqrtf(ss * (1.f / 128.f) + NORM_EPS);
#pragma unroll
            for (int i = 0; i < 2; ++i) pr[MLA_CKV + c.lane + 64 * i] = f2bf(v[i] * rstd * gkv[c.lane + 64 * i]); }
        if (j >= CTX) { const int t = j - CTX; const int prow = t >> 6, pcol = t & 63;
            for (int pp = c.lane; pp < 34 * 8; pp += 64) { const int g = pp >> 3, i = pp & 7;
                int col; if (g < 16) col = DF_Q + (g >> 1) * 32 + (g & 1) * 16; else if (g < 32) col = DF_K + ((g - 16) >> 1) * 32 + (g & 1) * 16; else col = MLA_KR + (g - 32) * 16;
                float cs, sn; rope_cs((g & 1) ? pcol : prow, i, cs, sn);
                const float x1 = bf2f(pr[col + i]), x2 = bf2f(pr[col + 8 + i]);
                pr[col + i] = f2bf(x1 * cs - x2 * sn); pr[col + 8 + i] = f2bf(x1 * sn + x2 * cs); } }
    }
}
__device__ void ph_rope_q(const Ctx& c) {
    for (int r = blockIdx.x * 8 + c.wid; r < NR; r += gridDim.x * 8) {
        const int b = r / RPB, j = r - b * RPB; if (j < CTX) continue;
        const int t = j - CTX; const int prow = t >> 6, pcol = t & 63;
        const int h = c.lane >> 4, g = (c.lane >> 3) & 1, i = c.lane & 7;
        bf16_t* q = C_QM + (size_t)r * 384 + h * 96 + 64 + g * 16;
        float cs, sn; rope_cs(g ? pcol : prow, i, cs, sn);
        const float x1 = bf2f(q[i]), x2 = bf2f(q[8 + i]);
        q[i] = f2bf(x1 * cs - x2 * sn); q[8 + i] = f2bf(x1 * sn + x2 * cs);
    }
}

__device__ __forceinline__ int v_st(int k, int cidx) { const int kk = (k & ~0xC) | ((k & 4) << 1) | ((k & 8) >> 1); return ((kk >> 3) * 2 + (cidx >> 5)) * 512 + ((kk & 7) * 32 + (cidx & 31)) * 2; }
__device__ __forceinline__ int v_rd_base(int lane) { return ((lane & 3) << 3) | (((lane >> 2) & 3) << 6) | (((lane >> 4) & 1) << 5) | (((lane >> 5) & 1) << 8); }
constexpr int v_rd_off(int d0, int ks, int half) { return d0 * 512 + ks * 2048 + half * 1024; }
template <int OFF> __device__ __forceinline__ s16x4 tr_read(int vb) { s16x4 r; asm volatile("ds_read_b64_tr_b16 %0, %1 offset:%2" : "=&v"(r) : "v"(vb), "i"(OFF) : "memory"); return r; }
template <int D0> __device__ __forceinline__ void pv_one(f32x16& od, int vb, bf16x8 pa0, bf16x8 pa1, bf16x8 pa2, bf16x8 pa3) {
    const s16x4 l0 = tr_read<v_rd_off(D0, 0, 0)>(vb), h0 = tr_read<v_rd_off(D0, 0, 1)>(vb), l1 = tr_read<v_rd_off(D0, 1, 0)>(vb), h1 = tr_read<v_rd_off(D0, 1, 1)>(vb);
    const s16x4 l2 = tr_read<v_rd_off(D0, 2, 0)>(vb), h2 = tr_read<v_rd_off(D0, 2, 1)>(vb), l3 = tr_read<v_rd_off(D0, 3, 0)>(vb), h3 = tr_read<v_rd_off(D0, 3, 1)>(vb);
    asm volatile("s_waitcnt lgkmcnt(0)" ::: "memory"); __builtin_amdgcn_sched_barrier(0);
#define PKV(L, H) (bf16x8){L[0], L[1], L[2], L[3], H[0], H[1], H[2], H[3]}
    od = __builtin_amdgcn_mfma_f32_32x32x16_bf16(pa0, PKV(l0, h0), od, 0, 0, 0);
    od = __builtin_amdgcn_mfma_f32_32x32x16_bf16(pa1, PKV(l1, h1), od, 0, 0, 0);
    od = __builtin_amdgcn_mfma_f32_32x32x16_bf16(pa2, PKV(l2, h2), od, 0, 0, 0);
    od = __builtin_amdgcn_mfma_f32_32x32x16_bf16(pa3, PKV(l3, h3), od, 0, 0, 0);
#undef PKV
}
constexpr float ATT_THR = 8.f;
__device__ __forceinline__ void softmax_tile(f32x16& p0, f32x16& p1, float& m_reg, float& l_reg, float& alpha, const float C, const float thr,
                                             bf16x8& pa0, bf16x8& pa1, bf16x8& pa2, bf16x8& pa3) {
    float pmax = p0[0];
#pragma unroll
    for (int r = 1; r < 16; ++r) pmax = fmaxf(pmax, p0[r]);
#pragma unroll
    for (int r = 0; r < 16; ++r) pmax = fmaxf(pmax, p1[r]);
    { auto rr = __builtin_amdgcn_permlane32_swap(__float_as_uint(pmax), __float_as_uint(pmax), false, false); pmax = fmaxf(__uint_as_float(rr[0]), __uint_as_float(rr[1])); }
    float mn;
    if (__builtin_expect(__all(pmax - m_reg <= thr), 1)) { mn = m_reg; alpha = 1.f; }
    else { mn = fmaxf(m_reg, pmax); alpha = __builtin_amdgcn_exp2f((m_reg - mn) * C); m_reg = mn; }
    const float mnC = -mn * C;
    float ps = 0.f;
#pragma unroll
    for (int r = 0; r < 16; ++r) { p0[r] = __builtin_amdgcn_exp2f(fmaf(p0[r], C, mnC)); ps += p0[r]; }
#pragma unroll
    for (int r = 0; r < 16; ++r) { p1[r] = __builtin_amdgcn_exp2f(fmaf(p1[r], C, mnC)); ps += p1[r]; }
    { auto rr = __builtin_amdgcn_permlane32_swap(__float_as_uint(ps), __float_as_uint(ps), false, false); ps = __uint_as_float(rr[0]) + __uint_as_float(rr[1]); }
    l_reg = l_reg * alpha + ps;
#define PK4(P, BASE, OUT) do { unsigned a0 = cvtpk(P[BASE + 0], P[BASE + 1]), a1 = cvtpk(P[BASE + 2], P[BASE + 3]);   \
    unsigned b0 = cvtpk(P[BASE + 4], P[BASE + 5]), b1 = cvtpk(P[BASE + 6], P[BASE + 7]);                              \
    auto r0 = __builtin_amdgcn_permlane32_swap(a0, b0, false, false); auto r1 = __builtin_amdgcn_permlane32_swap(a1, b1, false, false); \
    u32x4 w = {r0[0], r1[0], r0[1], r1[1]}; OUT = *reinterpret_cast<bf16x8*>(&w); } while (0)
    PK4(p0, 0, pa0); PK4(p0, 8, pa1); PK4(p1, 0, pa2); PK4(p1, 8, pa3);
#undef PK4
}

constexpr int ATT_LDS = 2 * 16384 + 2 * 8192 + 8 * 64 * 4;
template <bool DIFF>
__device__ void attn_item(const Ctx& c, int l, int b, int hd, int qrow0, int krow0, int nkeys, char* lds) {
    constexpr int DQK = DIFF ? 32 : 96, NMAP = DIFF ? 2 : 1, ND0 = DQK / 16, NU = 2 * NMAP;
    constexpr int KP = DIFF ? 64 : 256;
    constexpr int KSZ = 64 * KP;
    constexpr int NKR = DIFF ? 2 : 3;
    const int tid = c.tid, lane = c.lane, wid = c.wid, r32 = lane & 31, hi = lane >> 5;
    char* K_lds = lds; char* V_lds = lds + 2 * 16384; float* wsl = (float*)(lds + 2 * 16384 + 2 * 8192) + wid * 64;
    const float scale = DIFF ? 0.17677669529663687f : 0.10206207261596575f;
    const float C = scale * 1.4426950408889634f, thr = ATT_THR / scale;
    bf16x8 qr[NMAP][ND0];
    { const int qrow = qrow0 + wid * 32 + r32;
#pragma unroll
        for (int m = 0; m < NMAP; ++m)
#pragma unroll
            for (int d0 = 0; d0 < ND0; ++d0) {
                const bf16_t* p = DIFF ? C_P + (size_t)qrow * INC + DF_Q + (hd * 2 + m) * 32 + d0 * 16 + hi * 8
                                       : C_QM + (size_t)qrow * 384 + hd * 96 + d0 * 16 + hi * 8;
                qr[m][d0] = *(const bf16x8*)p; } }
    f32x16 o[NMAP][2]; float m_reg[NMAP], l_reg[NMAP];
#pragma unroll
    for (int m = 0; m < NMAP; ++m) { m_reg[m] = -1e30f; l_reg[m] = 0.f;
#pragma unroll
        for (int d = 0; d < 2; ++d) zero_acc(o[m][d]); }
    u32x4 kreg[NKR], vreg[2];
    int ksrc_key[NKR], ksrc_col[NKR], kdst[NKR]; bool ksrc_kvm[NKR];
#pragma unroll
    for (int i = 0; i < NKR; ++i) {
        if (DIFF) { const int key = tid >> 2, ch = tid & 3, k64 = key & 63; ksrc_key[i] = key; ksrc_kvm[i] = false; ksrc_col[i] = DF_K + (hd * 2 + i) * 32 + ch * 8;
            kdst[i] = ((key >> 6) * 2 + i) * KSZ + k64 * 64 + ((ch ^ ((k64 >> 2) & 3)) << 4); }
        else { const int id = tid + 512 * i; const int key = id / 12, ch = id % 12, k64 = key & 63; ksrc_key[i] = key; ksrc_kvm[i] = ch < 8;
            ksrc_col[i] = ch < 8 ? hd * 128 + ch * 8 : MLA_KR + (ch - 8) * 8;
            kdst[i] = (key >> 6) * KSZ + k64 * 256 + ((ch * 16) ^ ((k64 & 7) << 4)); } }
    int vdst[2];
#pragma unroll
    for (int i = 0; i < 2; ++i) { const int id = tid + 512 * i; const int key = id >> 3, ch = id & 7; vdst[i] = (key >> 6) * 8192 + v_st(key & 63, ch * 8); }
    const int vkey = tid >> 3, vch = tid & 7;
    const int vb = (int)(uintptr_t)V_lds + v_rd_base(lane);
#define ALOAD(kr) do { _Pragma("unroll") for (int i = 0; i < NKR; ++i) { const size_t rr = (size_t)((kr) + ksrc_key[i]); \
            kreg[i] = *(const u32x4*)((DIFF || !ksrc_kvm[i]) ? C_P + rr * INC + ksrc_col[i] : C_KVM + rr * 512 + ksrc_col[i]); } \
        _Pragma("unroll") for (int i = 0; i < 2; ++i) { const size_t rr = (size_t)((kr) + vkey + 64 * i); \
            vreg[i] = *(const u32x4*)(DIFF ? C_P + rr * INC + DF_V + hd * 64 + vch * 8 : C_KVM + rr * 512 + hd * 128 + 64 + vch * 8); } } while (0)
    const int NS = nkeys >> 7;
    ALOAD(krow0);
    for (int j = 0; j < NS; ++j) {
        __syncthreads();
#pragma unroll
        for (int i = 0; i < NKR; ++i) *(u32x4*)(K_lds + kdst[i]) = kreg[i];
#pragma unroll
        for (int i = 0; i < 2; ++i) *(u32x4*)(V_lds + vdst[i]) = vreg[i];
        __syncthreads();
        if (j + 1 < NS) ALOAD(krow0 + (j + 1) * 128);
        f32x16 p0[2], p1[2];
#define QKT(u) do { constexpr int tt_ = (u) / NMAP, m_ = (u) % NMAP; const char* Kb = K_lds + (tt_ * NMAP + m_) * KSZ; \
            _Pragma("unroll") for (int d0 = 0; d0 < ND0; ++d0) { bf16x8 b0, b1; \
                if (DIFF) { const int ch = d0 * 2 + hi; const int ra = r32, rb = 32 + r32; \
                    b0 = *(const bf16x8*)(Kb + ra * 64 + ((ch ^ ((ra >> 2) & 3)) << 4)); b1 = *(const bf16x8*)(Kb + rb * 64 + ((ch ^ ((rb >> 2) & 3)) << 4)); } \
                else { const int cb = d0 * 32 + hi * 16; const int ra = r32, rb = 32 + r32; \
                    b0 = *(const bf16x8*)(Kb + ra * 256 + (cb ^ ((ra & 7) << 4))); b1 = *(const bf16x8*)(Kb + rb * 256 + (cb ^ ((rb & 7) << 4))); } \
                if (d0 == 0) { const f32x16 z = {0.f,0.f,0.f,0.f,0.f,0.f,0.f,0.f,0.f,0.f,0.f,0.f,0.f,0.f,0.f,0.f}; \
                    p0[(u) & 1] = __builtin_amdgcn_mfma_f32_32x32x16_bf16(b0, qr[m_][0], z, 0, 0, 0); p1[(u) & 1] = __builtin_amdgcn_mfma_f32_32x32x16_bf16(b1, qr[m_][0], z, 0, 0, 0); \
                    asm volatile("" :: "v"(b0), "v"(b1));   } \
                else { p0[(u) & 1] = __builtin_amdgcn_mfma_f32_32x32x16_bf16(b0, qr[m_][d0], p0[(u) & 1], 0, 0, 0); p1[(u) & 1] = __builtin_amdgcn_mfma_f32_32x32x16_bf16(b1, qr[m_][d0], p1[(u) & 1], 0, 0, 0); } } } while (0)
        QKT(0);
#pragma unroll
        for (int u = 0; u < NU; ++u) {
            const int tt = u / NMAP, m = u % NMAP;
            if (u + 1 < NU) { if (u == 0) QKT(1); else if (u == 1) QKT(2); else QKT(3); }
            float alpha; bf16x8 pa0, pa1, pa2, pa3;
            softmax_tile(p0[u & 1], p1[u & 1], m_reg[m], l_reg[m], alpha, C, thr, pa0, pa1, pa2, pa3);
            if (__any(alpha < 1.f)) {
                if (hi == 0) wsl[r32] = alpha;
                asm volatile("s_waitcnt lgkmcnt(0)" ::: "memory");
#pragma unroll
                for (int r = 0; r < 16; ++r) { const float av = wsl[crow(r, hi)]; o[m][0][r] *= av; o[m][1][r] *= av; }
            }
            pv_one<0>(o[m][0], vb + tt * 8192, pa0, pa1, pa2, pa3);
            pv_one<1>(o[m][1], vb + tt * 8192, pa0, pa1, pa2, pa3);
        }
#undef QKT
    }
#undef ALOAD
    float rli[NMAP][16];
#pragma unroll
    for (int m = 0; m < NMAP; ++m) {
        asm volatile("s_waitcnt lgkmcnt(0)" ::: "memory");
        if (hi == 0) wsl[r32] = l_reg[m];
        asm volatile("s_waitcnt lgkmcnt(0)" ::: "memory");
#pragma unroll
        for (int r = 0; r < 16; ++r) rli[m][r] = __builtin_amdgcn_rcpf(wsl[crow(r, hi)]);
    }
    const int orow0 = qrow0 + wid * 32;
    if (!DIFF) {
#pragma unroll
        for (int r = 0; r < 16; ++r) { bf16_t* dst = C_HB + (size_t)(orow0 + crow(r, hi)) * D + 512 + hd * 64 + r32;
            dst[0] = f2bf(o[0][0][r] * rli[0][r]); dst[32] = f2bf(o[0][1][r] * rli[0][r]); }
    } else {
        const float* lp = CIN(19) + l * 128;
        float s1 = 0.f, s2 = 0.f;
        for (int i = 0; i < 32; ++i) { s1 += lp[i] * lp[32 + i]; s2 += lp[64 + i] * lp[96 + i]; }
        const float lam_init = 0.8f - 0.6f * __expf(-0.3f * (float)l);
        const float lam = __expf(s1) - __expf(s2) + lam_init;
        const float* gn = CIN(20) + l * 64;
        const float g0 = gn[r32] * (1.f - lam_init), g1 = gn[32 + r32] * (1.f - lam_init);
#pragma unroll
        for (int r = 0; r < 16; ++r) {
            const float v0 = o[0][0][r] * rli[0][r] - lam * o[NMAP - 1][0][r] * rli[NMAP - 1][r];
            const float v1 = o[0][1][r] * rli[0][r] - lam * o[NMAP - 1][1][r] * rli[NMAP - 1][r];
            float ss = v0 * v0 + v1 * v1;
            ss += __shfl_xor(ss, 1, 64); ss += __shfl_xor(ss, 2, 64); ss += __shfl_xor(ss, 4, 64); ss += __shfl_xor(ss, 8, 64); ss += __shfl_xor(ss, 16, 64);
            const float rstd = rsqrtf(ss * (1.f / 64.f) + NORM_EPS);
            bf16_t* dst = C_HB + (size_t)(orow0 + crow(r, hi)) * D + 768 + hd * 64 + r32;
            dst[0] = f2bf(v0 * rstd * g0); dst[32] = f2bf(v1 * rstd * g1); }
    }
    __syncthreads();
}
__device__ void ph_attn(const Ctx& c, int l, char* lds) {
    const bool need_ctx = (l < DEPTH - 1);
    const int nitem = 1024 + (need_ctx ? 32 : 0);
    for (int it = blockIdx.x; it < nitem; it += gridDim.x) {
        if (it < 512) { const int b = it >> 7, hd = (it >> 5) & 3, qt = it & 31; attn_item<true>(c, l, b, hd, b * RPB + CTX + qt * 256, b * RPB, RPB, lds); }
        else if (it < 1024) { const int u = it - 512; const int b = u >> 7, hd = (u >> 5) & 3, qt = u & 31; attn_item<false>(c, l, b, hd, b * RPB + CTX + qt * 256, b * RPB, RPB, lds); }
        else { const int u = it - 1024; const int b = u & 3, hd = (u >> 2) & 3; if (u < 16) attn_item<true>(c, l, b, hd, b * RPB, b * RPB, CTX, lds); else attn_item<false>(c, l, b, hd, b * RPB, b * RPB, CTX, lds); }
    }
}

typedef float f32v2 __attribute__((ext_vector_type(2)));
__device__ void cvt_tables(const Ctx& c, int l) {
    for (int row = blockIdx.x * 8 + c.wid; row < 2 * NEXP; row += gridDim.x * 8) {
        const bool isu = row < NEXP; const int e = isu ? row : row - NEXP;
        const float* s = CIN(isu ? 23 : 24) + ((size_t)l * NEXP + e) * D + c.lane * 16;
        f32x4 v[4]; float mx = 0.f;
#pragma unroll
        for (int i = 0; i < 4; ++i) { v[i] = *(const f32x4*)(s + 4 * i); mx = fmaxf(mx, fmaxf(fmaxf(fabsf(v[i][0]), fabsf(v[i][1])), fmaxf(fabsf(v[i][2]), fabsf(v[i][3])))); }
#pragma unroll
        for (int o = 32; o >= 1; o >>= 1) mx = fmaxf(mx, __shfl_xor(mx, o, 64));
        const float q = mx > 0.f ? 256.f / mx : 0.f;
        if (c.lane == 0) (isu ? C_SU : C_SV)[e] = mx * (1.f / 256.f);
        u32x4 w;
#pragma unroll
        for (int i = 0; i < 4; ++i) { int p = 0; p = __builtin_amdgcn_cvt_pk_fp8_f32(v[i][0] * q, v[i][1] * q, p, false); p = __builtin_amdgcn_cvt_pk_fp8_f32(v[i][2] * q, v[i][3] * q, p, true); w[i] = (unsigned)p; }
        *(u32x4*)((isu ? C_TU8 : C_TV8) + ((size_t)(c.lane >> 3) * NEXP + e) * 128 + (c.lane & 7) * 16) = w;
    }
}
__device__ __forceinline__ unsigned ford(float x) { const unsigned u = __float_as_uint(x); return (u & 0x80000000u) ? ~u : (u | 0x80000000u); }
__device__ __forceinline__ float funord(unsigned k) { const unsigned u = (k & 0x80000000u) ? (k & 0x7fffffffu) : ~k; return __uint_as_float(u); }
constexpr int TOPK_LDS = 2 * 128 * 129 * 4;
__device__ void peer_topk_item(const Ctx& c, int l, int tm, int h, char* lds) {
    float* S = (float*)lds;
    const int tid = c.tid, lane = c.lane, wid = c.wid, r32 = lane & 31, hi = lane >> 5, wm = wid >> 1, wn = wid & 1;
    const int row0 = tm * 128;
#pragma unroll
    for (int p = 0; p < 2; ++p) {
        f32x16 acc[2];
        zero_acc(acc[0]); zero_acc(acc[1]);
        const bf16_t* Ap = C_Q2 + (size_t)(row0 + wm * 32 + r32) * 2048 + h * 256 + p * 128 + hi * 8;
        const bf16_t* Bp = C_KEYS + ((((size_t)l * 8 + h) * 2 + p) * 128 + wn * 64 + r32) * 128 + hi * 8;
#pragma unroll
        for (int ks = 0; ks < 8; ++ks) {
            const bf16x8 a = *(const bf16x8*)(Ap + ks * 16);
            const bf16x8 b0 = *(const bf16x8*)(Bp + ks * 16), b1 = *(const bf16x8*)(Bp + 32 * 128 + ks * 16);
            acc[0] = __builtin_amdgcn_mfma_f32_32x32x16_bf16(a, b0, acc[0], 0, 0, 0);
            acc[1] = __builtin_amdgcn_mfma_f32_32x32x16_bf16(a, b1, acc[1], 0, 0, 0);
        }
#pragma unroll
        for (int n = 0; n < 2; ++n)
#pragma unroll
            for (int r = 0; r < 16; ++r) S[(p * 128 + wm * 32 + crow(r, hi)) * 129 + wn * 64 + n * 32 + r32] = acc[n][r];
    }
    __syncthreads();
    unsigned tk[16];
    if (tid < 256) {
        const float* sr = S + tid * 129;
#pragma unroll
        for (int i = 0; i < 16; ++i) tk[i] = 0u;
        for (int n = 0; n < 128; ++n) { unsigned key = (ford(sr[n]) & ~127u) | (unsigned)(127 - n);
#pragma unroll
            for (int i = 0; i < 16; ++i) { const unsigned hi_ = max(key, tk[i]); key = min(key, tk[i]); tk[i] = hi_; } }
    }
    __syncthreads();
    unsigned* L = (unsigned*)lds;
    if (tid < 256) {
#pragma unroll
        for (int i = 0; i < 16; ++i) L[tid * 17 + i] = tk[i];
    }
    __syncthreads();
    if (tid < 128) {
        const unsigned* l0 = L + tid * 17; const unsigned* l1 = L + (128 + tid) * 17;
        float s0[16], s1[16];
#pragma unroll
        for (int i = 0; i < 16; ++i) { s0[i] = funord(l0[i] & ~127u); s1[i] = funord(l1[i] & ~127u); }
        unsigned bk[16];
#pragma unroll
        for (int i = 0; i < 16; ++i) bk[i] = 0u;
#pragma unroll
        for (int i = 0; i < 16; ++i)
#pragma unroll
            for (int j = 0; j < 16; ++j) if ((i + 1) * (j + 1) <= 16) {
                unsigned key = (ford(s0[i] + s1[j]) & ~255u) | (unsigned)(255 - (i * 16 + j));
#pragma unroll
                for (int q = 0; q < 16; ++q) { const unsigned hi_ = max(key, bk[q]); key = min(key, bk[q]); bk[q] = hi_; } }
        float best[16]; int eid[16]; float mx = -1e30f;
#pragma unroll
        for (int q = 0; q < 16; ++q) { const int ij = 255 - (int)(bk[q] & 255u); const int i = ij >> 4, j = ij & 15;
            const unsigned k0 = l0[i], k1 = l1[j];
            best[q] = funord(k0 & ~127u) + funord(k1 & ~127u);
            eid[q] = (127 - (int)(k0 & 127u)) * 128 + (127 - (int)(k1 & 127u));
            mx = fmaxf(mx, best[q]); }
        float sum = 0.f;
#pragma unroll
        for (int q = 0; q < 16; ++q) { best[q] = __expf(best[q] - mx); sum += best[q]; }
        const float inv = 1.f / sum;
        const size_t o = (size_t)(row0 + tid) * 128 + h * 16;
#pragma unroll
        for (int q = 0; q < 16; ++q) { C_EI[o + q] = eid[q]; C_EG[o + q] = best[q] * inv; }
    }
    __syncthreads();
}
__device__ __forceinline__ float gelu_tanh(float x) { const float u = 0.7978845608028654f * (x + 0.044715f * x * x * x); const float t = 1.f - 2.f / (1.f + __expf(2.f * u)); return 0.5f * x * (1.f + t); }
__device__ __forceinline__ int tok_row(int ti, bool need_ctx) { return need_ctx ? ti : (ti >> 13) * RPB + CTX + (ti & 8191); }
struct PeerTok { u32x4 t[16]; u32x4 xa, xb; };
__device__ __forceinline__ void peer_issue(PeerTok& T, const unsigned char* t8, const int* el, const bf16_t* xp, int grp, bool want_x) {
#pragma unroll
    for (int u = 0; u < 16; ++u) { const int e = el[u * 8 + grp]; T.t[u] = *(const u32x4*)(t8 + (size_t)e * 128); }
    if (want_x) { T.xa = *(const u32x4*)xp; T.xb = *(const u32x4*)(xp + 8); }
}
__device__ __forceinline__ void peer_u_compute(const PeerTok& T, float* pp, int sub, int grp, int lane) {
    f32v2 x2[8];
#pragma unroll
    for (int q = 0; q < 4; ++q) { x2[q] = (f32v2){bflo(T.xa[q]), bfhi(T.xa[q])}; x2[4 + q] = (f32v2){bflo(T.xb[q]), bfhi(T.xb[q])}; }
    float keep[2];
#pragma unroll
    for (int hf = 0; hf < 2; ++hf) {
        float a[8];
#pragma unroll
        for (int u = 0; u < 8; ++u) { f32v2 s2 = {0.f, 0.f};
#pragma unroll
            for (int q = 0; q < 4; ++q) { const unsigned w = T.t[hf * 8 + u][q];
                s2 = __builtin_elementwise_fma(__builtin_amdgcn_cvt_pk_f32_fp8(w, false), x2[2 * q], s2);
                s2 = __builtin_elementwise_fma(__builtin_amdgcn_cvt_pk_f32_fp8(w, true), x2[2 * q + 1], s2); }
            a[u] = s2[0] + s2[1]; }
        const bool b2 = (lane & 4) != 0, b1 = (lane & 2) != 0, b0 = (lane & 1) != 0;
        float r4[4], r2[2];
#pragma unroll
        for (int q = 0; q < 4; ++q) { const float mine = b2 ? a[4 + q] : a[q], oth = b2 ? a[q] : a[4 + q]; r4[q] = mine + __shfl_xor(oth, 4, 64); }
#pragma unroll
        for (int q = 0; q < 2; ++q) { const float mine = b1 ? r4[2 + q] : r4[q], oth = b1 ? r4[q] : r4[2 + q]; r2[q] = mine + __shfl_xor(oth, 2, 64); }
        { const float mine = b0 ? r2[1] : r2[0], oth = b0 ? r2[0] : r2[1]; keep[hf] = mine + __shfl_xor(oth, 1, 64); }
    }
    pp[sub * 8 + grp] = keep[0]; pp[(8 + sub) * 8 + grp] = keep[1];
}
__device__ void peer_u_item(const Ctx& c, int l, int j, int tb, char* lds) {
    const bool need_ctx = (l < DEPTH - 1);
    int* el = (int*)lds + c.wid * 256;
    const int lane = c.lane, sub = lane & 7, grp = lane >> 3;
    const unsigned char* t8 = C_TU8 + (size_t)j * NEXP * 128 + sub * 16;
    const int tok0 = tb * 64 + c.wid * 8;
    const int xoff = j * 128 + sub * 16;
    PeerTok A, B;
    int e0, e1;
    { const int r = tok_row(tok0, need_ctx); e0 = C_EI[(size_t)r * 128 + lane]; e1 = C_EI[(size_t)r * 128 + 64 + lane];
      el[lane] = e0; el[64 + lane] = e1;
      peer_issue(A, t8, el, C_HB + (size_t)r * D + xoff, grp, true);
      const int r1 = tok_row(tok0 + 1, need_ctx); e0 = C_EI[(size_t)r1 * 128 + lane]; e1 = C_EI[(size_t)r1 * 128 + 64 + lane]; }
#pragma unroll
    for (int k = 0; k < 8; k += 2) {
        { const int r1 = tok_row(tok0 + k + 1, need_ctx); el[128 + lane] = e0; el[192 + lane] = e1;
          peer_issue(B, t8, el + 128, C_HB + (size_t)r1 * D + xoff, grp, true);
          if (k + 2 < 8) { const int r2 = tok_row(tok0 + k + 2, need_ctx); e0 = C_EI[(size_t)r2 * 128 + lane]; e1 = C_EI[(size_t)r2 * 128 + 64 + lane]; } }
        peer_u_compute(A, C_PART + ((size_t)j * NR + tok_row(tok0 + k, need_ctx)) * 128, sub, grp, lane);
        if (k + 2 < 8) { const int r2 = tok_row(tok0 + k + 2, need_ctx); el[lane] = e0; el[64 + lane] = e1;
          peer_issue(A, t8, el, C_HB + (size_t)r2 * D + xoff, grp, true);
          if (k + 3 < 8) { const int r3 = tok_row(tok0 + k + 3, need_ctx); e0 = C_EI[(size_t)r3 * 128 + lane]; e1 = C_EI[(size_t)r3 * 128 + 64 + lane]; } }
        peer_u_compute(B, C_PART + ((size_t)j * NR + tok_row(tok0 + k + 1, need_ctx)) * 128, sub, grp, lane);
    }
}
__device__ void ph_peer_combine(const Ctx& c, int l) {
    const bool need_ctx = (l < DEPTH - 1);
    const int ntok = need_ctx ? NR : NB * SEQ;
    for (int ti = blockIdx.x * 8 + c.wid; ti < ntok; ti += gridDim.x * 8) {
        const int r = tok_row(ti, need_ctx);
#pragma unroll
        for (int hf = 0; hf < 2; ++hf) { const size_t o = (size_t)r * 128 + hf * 64 + c.lane;
            const int e = C_EI[o]; float sacc = 0.f;
#pragma unroll
            for (int jj = 0; jj < 8; ++jj) sacc += C_PART[((size_t)jj * NR + r) * 128 + hf * 64 + c.lane];
            C_EG[o] = C_EG[o] * gelu_tanh(sacc * C_SU[e]) * C_SV[e]; }
    }
}
__device__ __forceinline__ void peer_v_compute(const PeerTok& T, const float* wl, float* xo, const float* gt, int grp, int lane) {
    f32v2 acc[8];
#pragma unroll
    for (int q = 0; q < 8; ++q) acc[q] = (f32v2){0.f, 0.f};
#pragma unroll
    for (int u = 0; u < 16; ++u) { const float wv = wl[u * 8 + grp]; const f32v2 w2 = {wv, wv};
#pragma unroll
        for (int q = 0; q < 4; ++q) { const unsigned w = T.t[u][q];
            acc[2 * q] = __builtin_elementwise_fma(__builtin_amdgcn_cvt_pk_f32_fp8(w, false), w2, acc[2 * q]);
            acc[2 * q + 1] = __builtin_elementwise_fma(__builtin_amdgcn_cvt_pk_f32_fp8(w, true), w2, acc[2 * q + 1]); } }
    const bool b5 = (lane & 32) != 0, b4 = (lane & 16) != 0, b3 = (lane & 8) != 0;
    f32v2 r4[4], r2[2], r1;
#pragma unroll
    for (int q = 0; q < 4; ++q) { const f32v2 mine = b5 ? acc[4 + q] : acc[q], oth = b5 ? acc[q] : acc[4 + q];
        r4[q] = (f32v2){mine[0] + __shfl_xor(oth[0], 32, 64), mine[1] + __shfl_xor(oth[1], 32, 64)}; }
#pragma unroll
    for (int q = 0; q < 2; ++q) { const f32v2 mine = b4 ? r4[2 + q] : r4[q], oth = b4 ? r4[q] : r4[2 + q];
        r2[q] = (f32v2){mine[0] + __shfl_xor(oth[0], 16, 64), mine[1] + __shfl_xor(oth[1], 16, 64)}; }
    { const f32v2 mine = b3 ? r2[1] : r2[0], oth = b3 ? r2[0] : r2[1]; r1 = (f32v2){mine[0] + __shfl_xor(oth[0], 8, 64), mine[1] + __shfl_xor(oth[1], 8, 64)}; }
    f32v2 xv = *(f32v2*)xo; const f32v2 gv = *(const f32v2*)gt;
    xv[0] += gv[0] * r1[0]; xv[1] += gv[1] * r1[1];
    *(f32v2*)xo = xv;
}
__device__ void peer_v_item(const Ctx& c, int l, int j, int tb, char* lds) {
    const bool need_ctx = (l < DEPTH - 1);
    int* el = (int*)lds + c.wid * 512; float* wl = (float*)(el + 256);
    const int lane = c.lane, sub = lane & 7, grp = lane >> 3;
    const unsigned char* t8 = C_TV8 + (size_t)j * NEXP * 128 + sub * 16;
    const int tok0 = tb * 64 + c.wid * 8;
    const int col = j * 128 + sub * 16 + ((lane & 32) ? 8 : 0) + ((lane & 16) ? 4 : 0) + ((lane & 8) ? 2 : 0);
    PeerTok A, B;
    int e0, e1; float w0, w1;
    { const int r = tok_row(tok0, need_ctx); e0 = C_EI[(size_t)r * 128 + lane]; e1 = C_EI[(size_t)r * 128 + 64 + lane]; w0 = C_EG[(size_t)r * 128 + lane]; w1 = C_EG[(size_t)r * 128 + 64 + lane];
      el[lane] = e0; el[64 + lane] = e1; wl[lane] = w0; wl[64 + lane] = w1;
      peer_issue(A, t8, el, nullptr, grp, false);
      const int r1 = tok_row(tok0 + 1, need_ctx); e0 = C_EI[(size_t)r1 * 128 + lane]; e1 = C_EI[(size_t)r1 * 128 + 64 + lane]; w0 = C_EG[(size_t)r1 * 128 + lane]; w1 = C_EG[(size_t)r1 * 128 + 64 + lane]; }
#pragma unroll
    for (int k = 0; k < 8; k += 2) {
        { el[128 + lane] = e0; el[192 + lane] = e1; wl[128 + lane] = w0; wl[192 + lane] = w1;
          peer_issue(B, t8, el + 128, nullptr, grp, false);
          if (k + 2 < 8) { const int r2 = tok_row(tok0 + k + 2, need_ctx); e0 = C_EI[(size_t)r2 * 128 + lane]; e1 = C_EI[(size_t)r2 * 128 + 64 + lane]; w0 = C_EG[(size_t)r2 * 128 + lane]; w1 = C_EG[(size_t)r2 * 128 + 64 + lane]; } }
        { const int r = tok_row(tok0 + k, need_ctx); const int b = r / RPB; const bool isctx = (r - b * RPB) < CTX;
          peer_v_compute(A, wl, xrow(c, r) + col, C_MODT + ((size_t)l * 5 + (isctx ? 4 : b)) * 6144 + 5 * D + col, grp, lane); }
        if (k + 2 < 8) { el[lane] = e0; el[64 + lane] = e1; wl[lane] = w0; wl[64 + lane] = w1;
          peer_issue(A, t8, el, nullptr, grp, false);
          if (k + 3 < 8) { const int r3 = tok_row(tok0 + k + 3, need_ctx); e0 = C_EI[(size_t)r3 * 128 + lane]; e1 = C_EI[(size_t)r3 * 128 + 64 + lane]; w0 = C_EG[(size_t)r3 * 128 + lane]; w1 = C_EG[(size_t)r3 * 128 + 64 + lane]; } }
        { const int r = tok_row(tok0 + k + 1, need_ctx); const int b = r / RPB; const bool isctx = (r - b * RPB) < CTX;
          peer_v_compute(B, wl + 128, xrow(c, r) + col, C_MODT + ((size_t)l * 5 + (isctx ? 4 : b)) * 6144 + 5 * D + col, grp, lane); }
    }
}
template <int SUB>
__device__ void ph_peer_expert(const Ctx& c, int l, char* lds) {
    const bool need_ctx = (l < DEPTH - 1);
    unsigned* cnt = (unsigned*)CWS(WS_CTL) + 4096 + ((l * 2 + SUB) * 8) * 64;
    const int nitem = (need_ctx ? NR : NB * SEQ) / 64;
    const int x = (int)(xb_xcc_id() & 7u);
    volatile int* sh = (volatile int*)(lds + 16384);
    for (int jo = 0; jo < 8; ++jo) { const int j = (x + jo) & 7;
        for (;;) {
            if (c.tid == 0) *sh = (int)__hip_atomic_fetch_add(&cnt[j * 64], 1u, __ATOMIC_RELAXED, __HIP_MEMORY_SCOPE_AGENT);
            __syncthreads(); const int it = *sh; __syncthreads();
            if (it >= nitem) break;
            if (SUB == 0) peer_u_item(c, l, j, it, lds); else peer_v_item(c, l, j, it, lds);
        }
    }
}
__device__ void ph_final(const Ctx& c) {
    const float* g = CIN(25);
    for (int r = blockIdx.x * 8 + c.wid; r < NB * SEQ; r += gridDim.x * 8) {
        float* xr = COUT + ((size_t)r << 10);
        f32x4 x[4]; float ss = 0.f;
#pragma unroll
        for (int i = 0; i < 4; ++i) { x[i] = *(const f32x4*)(xr + i * 256 + c.lane * 4); ss += x[i][0] * x[i][0] + x[i][1] * x[i][1] + x[i][2] * x[i][2] + x[i][3] * x[i][3]; }
        ss = wave_sum(ss); const float rstd = rsqrtf(ss * (1.f / D) + NORM_EPS);
#pragma unroll
        for (int i = 0; i < 4; ++i) { const int col = i * 256 + c.lane * 4; const f32x4 gv = *(const f32x4*)(g + col); f32x4 y;
#pragma unroll
            for (int e = 0; e < 4; ++e) y[e] = x[i][e] * rstd * gv[e];
            *(f32x4*)(xr + col) = y; }
    }
}

constexpr int LDS_BYTES = 144 * 1024;
static_assert(TOPK_LDS + 16 <= LDS_BYTES && GEMM_LDS + 16 <= LDS_BYTES && ATT_LDS + 16 <= LDS_BYTES, "LDS budget");
constexpr int PPL = 13;
constexpr int N_PHASES = 1 + PPL * DEPTH + 1;
extern __shared__ __attribute__((aligned(16))) char g_lds[];

#define PHASE_FN __device__ __forceinline__ void
PHASE_FN f_p0() { const Ctx c = fresh_ctx(); ph_p0(c, g_lds); }
PHASE_FN f_norm0(int l) { const Ctx c = fresh_ctx(); ph_norm<0>(c, l); }
PHASE_FN f_norm1(int l) { const Ctx c = fresh_ctx(); ph_norm<1>(c, l); }
PHASE_FN f_gemm_in(int l) { const Ctx c = fresh_ctx(); ph_gemm_in(c, l, g_lds); }
PHASE_FN f_prep(int l) {
    const Ctx c = fresh_ctx(); char* lds = g_lds;
    ph_prep_rows(c, l);
    for (int it = blockIdx.x; it < 2 * 16 * NCHUNK * 2; it += gridDim.x) {
        const int mx = it & 1; int u = it >> 1; const int dir = u & 1; u >>= 1; const int cc = u % NCHUNK; u /= NCHUNK; const int h = u & 3, b = u >> 2;
        if (mx == 0) scanA_item<0>(c, l, b, h, cc, dir, lds); else scanA_item<1>(c, l, b, h, cc, dir, lds); }
}
PHASE_FN f_upproj(int l) {
    const Ctx c = fresh_ctx(); char* lds = g_lds;
    EpiBf16 eq{C_QM, 384}, ekv{C_KVM, 512};
    for (int it = blockIdx.x; it < 132 * 7 + 384; it += gridDim.x) {
        if (it < 132 * 7) { const int tm = it / 7, tn = it % 7;
            if (tn < 3) gemm_tile(c, C_P + MLA_CQ, INC, C_WUQ + (size_t)l * 384 * 192, 192, 192, tm * 256, tn * 128, lds, eq);
            else gemm_tile(c, C_P + MLA_CKV, INC, C_WUKV + (size_t)l * 512 * 128, 128, 128, tm * 256, (tn - 3) * 128, lds, ekv); }
        else scanB_item(c, it - 132 * 7); }
}
PHASE_FN f_scanc(int l) {
    const Ctx c = fresh_ctx(); char* lds = g_lds; const bool need_ctx = (l < DEPTH - 1);
    ph_rope_q(c);
    for (int it = blockIdx.x; it < 2 * 16 * NCHUNK; it += gridDim.x) {
        const int mx = it & 1; int u = it >> 1; const int cc = u % NCHUNK; u /= NCHUNK; const int h = u & 3, b = u >> 2;
        if (cc < 4 && !need_ctx) continue;
        if (mx == 0) scanC_item<0>(c, l, b, h, cc, lds); else scanC_item<1>(c, l, b, h, cc, lds); }
}
PHASE_FN f_attn(int l) { const Ctx c = fresh_ctx(); ph_attn(c, l, g_lds); }
PHASE_FN f_gemm_out(int l) {
    const Ctx c = fresh_ctx(); char* lds = g_lds; const bool need_ctx = (l < DEPTH - 1);
    EpiResid e{&c, C_MODT + (size_t)l * 5 * 6144 + 2 * D};
    for (int it = blockIdx.x; it < 132 * 8; it += gridDim.x) { const int tm = it / 8, tn = it % 8;
        if ((tm % 33) == 0 && !need_ctx) continue;
        gemm_tile(c, C_HB, D, C_WOUT + (size_t)l * D * D, D, D, tm * 256, tn * 128, lds, e); }
    cvt_tables(c, l);
}
PHASE_FN f_peer_q(int l) {
    const Ctx c = fresh_ctx(); char* lds = g_lds; const bool need_ctx = (l < DEPTH - 1);
    EpiBf16 e{C_Q2, 2048};
    for (int it = blockIdx.x; it < 132 * 16; it += gridDim.x) { const int tm = it / 16, tn = it % 16;
        if ((tm % 33) == 0 && !need_ctx) continue;
        gemm_tile(c, C_HB, D, C_WQ + (size_t)l * 2048 * D, D, D, tm * 256, tn * 128, lds, e); }
}
PHASE_FN f_topk(int l) {
    const Ctx c = fresh_ctx(); char* lds = g_lds; const bool need_ctx = (l < DEPTH - 1);
    for (int it = blockIdx.x; it < 264 * 8; it += gridDim.x) { const int tm = it >> 3, h = it & 7;
        if ((tm % 66) < 2 && !need_ctx) continue;
        peer_topk_item(c, l, tm, h, lds); }
}
PHASE_FN f_expert_u(int l) { const Ctx c = fresh_ctx(); ph_peer_expert<0>(c, l, g_lds); }
PHASE_FN f_expert_c(int l) { const Ctx c = fresh_ctx(); ph_peer_combine(c, l); }
PHASE_FN f_expert_v(int l) { const Ctx c = fresh_ctx(); ph_peer_expert<1>(c, l, g_lds); }
PHASE_FN f_final() { const Ctx c = fresh_ctx(); ph_final(c); }

__global__ void __launch_bounds__(512, 2) mk_fwd(Params p) {
    volatile LAS unsigned* bst = (volatile LAS unsigned*)(g_lds + LDS_BYTES - 16);
    if (threadIdx.x == 0) { bst[0] = 0u; bst[1] = 0u; bst[2] = 0u; bst[3] = 0u; }
    __syncthreads();
    XcdBarrier bar; bar.bar = (unsigned*)(p.ws + WS_CTL); bar.x = 0; bar.st = bst;
    const int lo = p.ph_lo, hi = p.ph_hi;
    const bool multi = (hi - lo) > 1;
    if (multi) bar = xcd_barrier_post((unsigned*)(p.ws + WS_CTL), bst);
#ifndef PHMASK
#define PHMASK 0xFFFF
#endif
#define EN(s) ((PHMASK >> (s)) & 1)
#define IN(k) (lo <= (k) && (k) < hi)
#define SEAM(k) do { if (IN(k) && IN((k) + 1)) xcd_barrier(bar); } while (0)
    if (EN(0) && IN(0)) f_p0();
    SEAM(0);
#define LAYER(l) do { constexpr int base = 1 + PPL * (l); \
        if (EN(1) && IN(base + 0)) f_norm0(l); SEAM(base + 0); \
        if (EN(2) && IN(base + 1)) f_gemm_in(l); SEAM(base + 1); \
        if (EN(3) && IN(base + 2)) f_prep(l); SEAM(base + 2); \
        if (EN(4) && IN(base + 3)) f_upproj(l); SEAM(base + 3); \
        if (EN(5) && IN(base + 4)) f_scanc(l); SEAM(base + 4); \
        if (EN(6) && IN(base + 5)) f_attn(l); SEAM(base + 5); \
        if (EN(7) && IN(base + 6)) f_gemm_out(l); SEAM(base + 6); \
        if (EN(8) && IN(base + 7)) f_norm1(l); SEAM(base + 7); \
        if (EN(9) && IN(base + 8)) f_peer_q(l); SEAM(base + 8); \
        if (EN(10) && IN(base + 9)) f_topk(l); SEAM(base + 9); \
        if (EN(11) && IN(base + 10)) f_expert_u(l); SEAM(base + 10); \
        if (EN(12) && IN(base + 11)) f_expert_c(l); SEAM(base + 11); \
        if (EN(13) && IN(base + 12)) f_expert_v(l); SEAM(base + 12); } while (0)
    LAYER(0);
    LAYER(1);
#undef LAYER
    if (EN(14) && IN(N_PHASES - 1)) f_final();
#undef IN
#undef SEAM
}

#ifdef DBG_STOP
#ifndef DBG_LO
#define DBG_LO WS_MOD
#endif
#ifndef DBG_HI
#define DBG_HI WS_END
#endif
#ifndef DBG_X
#define DBG_X 1
#endif
__global__ void __launch_bounds__(512) mk_dump(float* out, const unsigned* ws) {
    const size_t NOUT = (size_t)NB * SEQ * D; const size_t lo = (size_t)(DBG_LO) / 4, hi = (size_t)(DBG_HI) / 4;
    for (size_t i = (size_t)blockIdx.x * 512 + threadIdx.x; i < NOUT; i += (size_t)gridDim.x * 512) {
        float a = 0.f;
        if (DBG_X) { const unsigned w = __float_as_uint(out[i]); a += (float)((w ^ (w >> 16)) & 0xFFFFu) * 1e-3f; }
        for (size_t j = lo + i; j < hi; j += NOUT) { const unsigned w = ws[j]; a += (float)((w ^ (w >> 16)) & 0xFFFFu) * 1e-3f; }
#ifdef DBG_LO2
        for (size_t j = (size_t)(DBG_LO2) / 4 + i; j < (size_t)(DBG_HI2) / 4; j += NOUT) { const unsigned w = ws[j]; a += (float)((w ^ (w >> 16)) & 0xFFFFu) * 1e-3f; }
#endif
        out[i] = a;
    }
}
#endif
extern "C" void kernel_launch(void* const* d_in, const int* in_sizes, int n_in, void* d_out, int out_size, void* d_ws, size_t ws_size, hipStream_t stream) {
    static int grid = 0;
    if (grid == 0) {
        if (n_in != 26 || in_sizes[0] != NB * SEQ * D || out_size != NB * SEQ * D || ws_size < WS_END) {
            fprintf(stderr, "kernel_launch: shape/workspace mismatch: n_in %d in0 %d out %d ws %zu (need %zu); nothing launched\n", n_in, n_in > 0 ? in_sizes[0] : -1, out_size, ws_size, (size_t)WS_END);
            grid = -1; return; }
        int dev = 0, cus = 0, per_cu = 0;
        if (hipGetDevice(&dev) != hipSuccess || hipDeviceGetAttribute(&cus, hipDeviceAttributeMultiprocessorCount, dev) != hipSuccess) { grid = -1; return; }
        if (hipFuncSetAttribute((const void*)mk_fwd, hipFuncAttributeMaxDynamicSharedMemorySize, LDS_BYTES) != hipSuccess) { fprintf(stderr, "kernel_launch: hipFuncSetAttribute failed\n"); grid = -1; return; }
        if (hipOccupancyMaxActiveBlocksPerMultiprocessor(&per_cu, (const void*)mk_fwd, 512, LDS_BYTES) != hipSuccess || per_cu < 1)
            fprintf(stderr, "kernel_launch: note: occupancy query reports %d workgroups per CU\n", per_cu);
        (void)hipGetLastError();
        grid = cus;
    }
    if (grid < 0) return;
    if (hipMemsetAsync((char*)d_ws + WS_CTL, 0, CTL_BYTES, stream) != hipSuccess) { fprintf(stderr, "kernel_launch: memset failed\n"); return; }
    Params p{};
    for (int i = 0; i < 26; ++i) p.in[i] = (const float*)d_in[i];
    p.out = (float*)d_out; p.ws = (unsigned char*)d_ws;
#ifdef DBG_STOP
    for (int k = 0; k < DBG_STOP; ++k) { p.ph_lo = k; p.ph_hi = k + 1; hipLaunchKernelGGL(mk_fwd, dim3(grid), dim3(512), LDS_BYTES, stream, p); }
    hipLaunchKernelGGL(mk_dump, dim3(1024), dim3(512), 0, stream, (float*)d_out, (const unsigned*)d_ws);
#elif MK_PER_PHASE
    for (int k = 0; k < N_PHASES; ++k) { p.ph_lo = k; p.ph_hi = k + 1; hipLaunchKernelGGL(mk_fwd, dim3(grid), dim3(512), LDS_BYTES, stream, p); }
#else
    p.ph_lo = 0; p.ph_hi = N_PHASES; hipLaunchKernelGGL(mk_fwd, dim3(grid), dim3(512), LDS_BYTES, stream, p);
#endif
    const hipError_t le = hipPeekAtLastError();
    if (le != hipSuccess) fprintf(stderr, "kernel_launch: launch failed: %s\n", hipGetErrorName(le));
}
```

```cpp
#include <hip/hip_runtime.h>
#include <cstdio>
#include <cstdint>

#ifndef ATT_FAST_DIFF
#define ATT_FAST_DIFF 0
#endif
#ifndef MK_PER_PHASE
#define MK_PER_PHASE 0
#endif

constexpr int D = 1024, NB = 4, SEQ = 8192, CTX = 256, DEPTH = 2;
constexpr int RPB = CTX + SEQ;
constexpr int NR = NB * RPB;
constexpr int INC = 3200;
constexpr int GLA_Q = 0, GLA_K = 128, GLA_V = 256, GLA_R = 512, GLA_ZF = 768, GLA_ZB = 784;
constexpr int HG_Q = 800, HG_I = 1056, HG_OG = 1312, HG_ZF = 1568, HG_ZB = 1824;
constexpr int MLA_CQ = 2080, MLA_CKV = 2272, MLA_KR = 2400;
constexpr int DF_Q = 2432, DF_K = 2688, DF_V = 2944;
constexpr int NCHUNK = RPB / 64;
constexpr int NEXP = 16384;
constexpr float NORM_EPS = 1e-6f;

typedef unsigned short bf16_t;
typedef short bf16x8 __attribute__((ext_vector_type(8)));
typedef short s16x4 __attribute__((ext_vector_type(4)));
typedef float f32x16 __attribute__((ext_vector_type(16)));
typedef float f32x4 __attribute__((ext_vector_type(4)));
typedef unsigned u32x4 __attribute__((ext_vector_type(4)));
typedef unsigned u32x2 __attribute__((ext_vector_type(2)));

constexpr size_t al256(size_t x) { return (x + 255) / 256 * 256; }
constexpr size_t WS_CTL = 0;
constexpr size_t CTL_BYTES = 65536;
constexpr size_t WS_MOD = WS_CTL + CTL_BYTES;
constexpr size_t WS_XC = al256(WS_MOD + (size_t)2 * 5 * 6144 * 4);
constexpr size_t WS_WIN = al256(WS_XC + (size_t)NB * CTX * D * 4);
constexpr size_t WS_WOUT = al256(WS_WIN + (size_t)2 * INC * D * 2);
constexpr size_t WS_WQ = al256(WS_WOUT + (size_t)2 * D * D * 2);
constexpr size_t WS_WUQ = al256(WS_WQ + (size_t)2 * 2048 * D * 2);
constexpr size_t WS_WUKV = al256(WS_WUQ + (size_t)2 * 384 * 192 * 2);
constexpr size_t WS_KEYS = al256(WS_WUKV + (size_t)2 * 512 * 128 * 2);
constexpr size_t WS_HB = al256(WS_KEYS + (size_t)2 * 16 * 128 * 128 * 2);
constexpr size_t WS_QM = al256(WS_HB + (size_t)NR * D * 2);
constexpr size_t WS_KVM = al256(WS_QM + (size_t)NR * 384 * 2);
constexpr size_t WS_SG = al256(WS_KVM + (size_t)NR * 512 * 2);
constexpr size_t WS_SH = al256(WS_SG + (size_t)32 * NCHUNK * 2048 * 2);
constexpr size_t WS_DG = al256(WS_SH + (size_t)32 * NCHUNK * 4096 * 2);
constexpr size_t WS_DH = al256(WS_DG + (size_t)32 * NCHUNK * 32 * 4);
constexpr size_t WS_P = al256(WS_DH + (size_t)32 * NCHUNK * 64 * 4);
constexpr size_t WS_END = al256(WS_P + (size_t)NR * INC * 2);
constexpr size_t WS_TU8 = WS_P;
constexpr size_t WS_TV8 = WS_P + (size_t)NEXP * D;
constexpr size_t WS_SU = WS_TV8 + (size_t)NEXP * D;
constexpr size_t WS_SV = WS_SU + (size_t)NEXP * 4;
constexpr size_t WS_Q2 = WS_P + (size_t)64 * 1024 * 1024;
constexpr size_t WS_PART = WS_Q2;
static_assert(WS_SV + (size_t)NEXP * 4 <= WS_Q2, "alias overflow 0");
static_assert(WS_Q2 + (size_t)NR * 2048 * 2 <= WS_END, "alias overflow");
constexpr size_t WS_EI = WS_SG;
constexpr size_t WS_EG = WS_EI + (size_t)NR * 128 * 4;
static_assert(WS_EG + (size_t)NR * 128 * 4 <= WS_DG, "alias overflow 2");

#define XB_TMO      128
#define XB_XCNT(j)  (256  + 64 * (j))
#define XB_XSUB(j)  (1280 + 64 * (j))
#define XB_XGEN(j)  (2304 + 64 * (j))
#define XB_TOP      3328
#define XB_TOPGEN   3392
#define XCD_BAR_WORDS 3456
#define XB_SPIN_CAP (1u << 22)
#define LAS __attribute__((address_space(3)))

__device__ __forceinline__ unsigned xb_ld(unsigned* p)              { return __hip_atomic_load(p, __ATOMIC_RELAXED, __HIP_MEMORY_SCOPE_AGENT); }
__device__ __forceinline__ unsigned xb_add(unsigned* p, unsigned v) { return __hip_atomic_fetch_add(p, v, __ATOMIC_RELAXED, __HIP_MEMORY_SCOPE_AGENT); }
__device__ __forceinline__ unsigned xb_xcc_id() { return (unsigned)__builtin_amdgcn_s_getreg((3 << 11) | 20) & 0xFu; }
#define XB_SPIN(cond, bar) do { unsigned _sp = 0; while (cond) { __builtin_amdgcn_s_sleep(1); \
    if ((++_sp & 255u) == 0u) { if (xb_ld(&(bar)[XB_TMO])) break; if (_sp > XB_SPIN_CAP) { atomicAdd(&(bar)[XB_TMO], 1u); break; } } } } while (0)

struct XcdBarrier { unsigned* bar; unsigned x; volatile LAS unsigned* st; bool t0; };

__device__ __forceinline__ XcdBarrier xcd_barrier_post(unsigned* bar, volatile LAS unsigned* st, bool t0) {
    XcdBarrier b; b.bar = bar; b.x = xb_xcc_id(); b.st = st; b.t0 = t0;
    if (t0) (void)xb_add(&bar[XB_XCNT(b.x)], 1u);
    return b;
}
__device__ __forceinline__ void xcd_barrier_complete(unsigned* bar, unsigned x, unsigned& nloc, unsigned& nx) {
    const unsigned G = gridDim.x * gridDim.y * gridDim.z;
    unsigned sum, cnt, mine, sp = 0u;
    for (;;) {
        sum = 0u; cnt = 0u; mine = 0u;
#pragma unroll
        for (unsigned j = 0; j < 16; ++j) { const unsigned c = xb_ld(&bar[XB_XCNT(j)]); sum += c; cnt += (c > 0u) ? 1u : 0u; mine = (j == x) ? c : mine; }
        if (sum == G) break;
        __builtin_amdgcn_s_sleep(1);
        if ((++sp & 255u) == 0u) { if (xb_ld(&bar[XB_TMO])) break; if (sp > XB_SPIN_CAP) { atomicAdd(&bar[XB_TMO], 1u); break; } }
    }
    nloc = mine > 0u ? mine : 1u; nx = cnt > 0u ? cnt : 1u;
}
__device__ __forceinline__ void xcd_barrier(const XcdBarrier& b) {
    asm volatile("s_waitcnt vmcnt(0)" ::: "memory");
    __syncthreads();
    if (b.t0) {
        unsigned* bar = b.bar;
        __builtin_amdgcn_s_waitcnt(0);
        unsigned nloc = b.st[0], nx = b.st[1];
        if (nloc == 0u) { xcd_barrier_complete(bar, b.x, nloc, nx); b.st[0] = nloc; b.st[1] = nx; }
        const unsigned old = xb_add(&bar[XB_XSUB(b.x)], 1u);
        const unsigned gen = old / nloc;
        if (old + 1u == (gen + 1u) * nloc) {
            __builtin_amdgcn_fence(__ATOMIC_RELEASE, "agent");
            asm volatile("s_waitcnt vmcnt(0)" ::: "memory");
            const unsigned og = xb_add(&bar[XB_TOP], 1u);
            const unsigned tg = og / nx;
            if (og + 1u == (tg + 1u) * nx) xb_add(&bar[XB_TOPGEN], 1u);
            else XB_SPIN(xb_ld(&bar[XB_TOPGEN]) == tg, bar);
            __builtin_amdgcn_fence(__ATOMIC_ACQUIRE, "agent");
            xb_add(&bar[XB_XGEN(b.x)], 1u);
            asm volatile("s_waitcnt vmcnt(0)" ::: "memory");
        } else {
            XB_SPIN(xb_ld(&bar[XB_XGEN(b.x)]) == gen, bar);
            __builtin_amdgcn_fence(__ATOMIC_ACQUIRE, "agent");
            asm volatile("s_waitcnt vmcnt(0)" ::: "memory");
        }
    }
    __syncthreads();
}

typedef __bf16 bf16v2_t __attribute__((ext_vector_type(2)));
typedef float f32v2_t __attribute__((ext_vector_type(2)));
__device__ __forceinline__ unsigned cvtpk(float lo, float hi) { const f32v2_t v = {lo, hi}; const bf16v2_t b = __builtin_convertvector(v, bf16v2_t); return __builtin_bit_cast(unsigned, b); }
__device__ __forceinline__ bf16_t f2bf(float x) { const __bf16 b = (__bf16)x; return __builtin_bit_cast(bf16_t, b); }
__device__ __forceinline__ float bf2f(bf16_t h) { return __uint_as_float(((unsigned)h) << 16); }
__device__ __forceinline__ float bflo(unsigned w) { return __uint_as_float(w << 16); }
__device__ __forceinline__ float bfhi(unsigned w) { return __uint_as_float(w & 0xffff0000u); }
__device__ __forceinline__ float silu_f(float x) { return x / (1.f + __expf(-x)); }
__device__ __forceinline__ float logsigmoid_f(float z) { return fminf(z, 0.f) - __logf(1.f + __expf(-fabsf(z))); }
__device__ __forceinline__ float wave_sum(float v) {
#pragma unroll
    for (int o = 32; o >= 1; o >>= 1) v += __shfl_xor(v, o, 64);
    return v;
}
__device__ __forceinline__ void zero_acc(f32x16& a) {
#pragma unroll
    for (int r = 0; r < 16; ++r) a[r] = 0.f;
    asm volatile("" : "+v"(a));
}
__device__ __forceinline__ int crow(int r, int hi) { return (r & 3) + 8 * (r >> 2) + 4 * hi; }

struct Params { const float* in[26]; float* out; unsigned char* ws; int ph_lo, ph_hi; };
typedef const __attribute__((address_space(4))) Params* KParams;
struct Ctx {
    KParams pp;
    int tid, lane, wid;
};
__device__ __forceinline__ int mk_tid(int w0) { unsigned m = ~0u; asm volatile("" : "+s"(m)); return (w0 << 6) | (int)__builtin_amdgcn_mbcnt_hi(m, __builtin_amdgcn_mbcnt_lo(m, 0u)); }
__device__ __forceinline__ float shx(float v, int o, int lane) { return __int_as_float(__builtin_amdgcn_ds_bpermute((lane ^ o) << 2, __float_as_int(v))); }
__device__ __forceinline__ Ctx fresh_ctx(int w0) {
    Ctx c; unsigned long long a = (unsigned long long)__builtin_amdgcn_kernarg_segment_ptr(); asm volatile("" : "+s"(a)); c.pp = (KParams)a;
    int t = mk_tid(w0); asm volatile("" : "+v"(t)); c.tid = t; c.lane = t & 63; c.wid = w0;
    return c;
}
#define CIN(i)   (c.pp->in[i])
#define COUT     (c.pp->out)
#define CWS(off) (c.pp->ws + (off))
#define C_MODT ((float*)CWS(WS_MOD))
#define C_XC   ((float*)CWS(WS_XC))
#define C_WIN  ((bf16_t*)CWS(WS_WIN))
#define C_WOUT ((bf16_t*)CWS(WS_WOUT))
#define C_WQ   ((bf16_t*)CWS(WS_WQ))
#define C_WUQ  ((bf16_t*)CWS(WS_WUQ))
#define C_WUKV ((bf16_t*)CWS(WS_WUKV))
#define C_KEYS ((bf16_t*)CWS(WS_KEYS))
#define C_HB   ((bf16_t*)CWS(WS_HB))
#define C_QM   ((bf16_t*)CWS(WS_QM))
#define C_KVM  ((bf16_t*)CWS(WS_KVM))
#define C_P    ((bf16_t*)CWS(WS_P))
#define C_TU8  ((unsigned char*)CWS(WS_TU8))
#define C_TV8  ((unsigned char*)CWS(WS_TV8))
#define C_SU   ((float*)CWS(WS_SU))
#define C_SV   ((float*)CWS(WS_SV))
#define C_PART ((float*)CWS(WS_PART))
#define C_Q2   ((bf16_t*)CWS(WS_Q2))
#define C_SG   ((bf16_t*)CWS(WS_SG))
#define C_SH   ((bf16_t*)CWS(WS_SH))
#define C_DG   ((float*)CWS(WS_DG))
#define C_DH   ((float*)CWS(WS_DH))
#define C_EI   ((int*)CWS(WS_EI))
#define C_EG   ((float*)CWS(WS_EG))

__device__ __forceinline__ float* xrow(const Ctx& c, int r) {
    const int b = r / RPB, j = r - b * RPB;
    return j < CTX ? C_XC + ((size_t)(b * CTX + j) << 10) : COUT + ((size_t)(b * SEQ + (j - CTX)) << 10);
}
__device__ __forceinline__ const float* inrow(const Ctx& c, int r) {
    const int b = r / RPB, j = r - b * RPB;
    return j < CTX ? CIN(2) + ((size_t)(b * CTX + j) << 10) : CIN(0) + ((size_t)(b * SEQ + (j - CTX)) << 10);
}

__device__ void p0_mod_item(const Ctx& c, int item, char* lds) {
    float* sc = (float*)lds;
    float* red = sc + 5 * 1024;
    const int tid = c.tid;
    for (int i = tid; i < 5 * 1024; i += 512) { const int v = i >> 10, k = i & 1023; const float x = (v < 4) ? CIN(1)[v * 1024 + k] : CIN(3)[k]; sc[i] = silu_f(x); }
    __syncthreads();
    const int l = item / 96, n0 = (item % 96) * 64;
    const int col = tid & 63, kg = tid >> 6;
    const float* w = CIN(4) + (size_t)l * 1024 * 6144 + n0 + col;
    float a[5] = {0.f, 0.f, 0.f, 0.f, 0.f};
#pragma unroll 8
    for (int kk = 0; kk < 128; ++kk) { const int k = kg * 128 + kk; const float wv = w[(size_t)k * 6144];
#pragma unroll
        for (int v = 0; v < 5; ++v) a[v] += sc[v * 1024 + k] * wv; }
#pragma unroll
    for (int v = 0; v < 5; ++v) red[(kg * 64 + col) * 5 + v] = a[v];
    __syncthreads();
    if (tid < 320) { const int cc = tid / 5, v = tid % 5; float s = 0.f;
#pragma unroll
        for (int g = 0; g < 8; ++g) s += red[(g * 64 + cc) * 5 + v];
        C_MODT[((size_t)l * 5 + v) * 6144 + n0 + cc] = s + CIN(5)[l * 6144 + n0 + cc]; }
    __syncthreads();
}
__device__ void p0_tr_tile(const float* __restrict__ src, bf16_t* __restrict__ dst, int K, int N, int k0, int n0, int tid, char* lds) {
    float* t = (float*)lds;
#pragma unroll
    for (int i = 0; i < 2; ++i) { const int k = (tid >> 4) + 32 * i, n4 = (tid & 15) * 4;
        const f32x4 v = *(const f32x4*)(src + (size_t)(k0 + k) * N + n0 + n4);
        t[k * 65 + n4 + 0] = v[0]; t[k * 65 + n4 + 1] = v[1]; t[k * 65 + n4 + 2] = v[2]; t[k * 65 + n4 + 3] = v[3]; }
    __syncthreads();
    { const int n = tid >> 3, k8 = (tid & 7) * 8; u32x4 w;
#pragma unroll
        for (int j = 0; j < 4; ++j) w[j] = cvtpk(t[(k8 + 2 * j) * 65 + n], t[(k8 + 2 * j + 1) * 65 + n]);
        *(u32x4*)(dst + (size_t)(n0 + n) * K + k0 + k8) = w; }
    __syncthreads();
}
__device__ void ph_p0(const Ctx& c, char* lds) {
    constexpr int T_WIN = 16 * 50, T_WOUT = 16 * 16, T_WQ = 16 * 32, T_UQ = 3 * 6, T_UKV = 2 * 8;
    constexpr int PER_L = T_WIN + T_WOUT + T_WQ + T_UQ + T_UKV;
    constexpr int NITEM = 192 + 2 * PER_L;
    for (int it = blockIdx.x; it < NITEM; it += gridDim.x) {
        if (it < 192) { p0_mod_item(c, it, lds); continue; }
        int t = it - 192; const int l = t / PER_L; t -= l * PER_L;
        if (t < T_WIN) { p0_tr_tile(CIN(8) + (size_t)l * D * INC, C_WIN + (size_t)l * INC * D, D, INC, (t / 50) * 64, (t % 50) * 64, c.tid, lds); continue; } t -= T_WIN;
        if (t < T_WOUT) { p0_tr_tile(CIN(9) + (size_t)l * D * D, C_WOUT + (size_t)l * D * D, D, D, (t / 16) * 64, (t % 16) * 64, c.tid, lds); continue; } t -= T_WOUT;
        if (t < T_WQ) { p0_tr_tile(CIN(21) + (size_t)l * D * 2048, C_WQ + (size_t)l * 2048 * D, D, 2048, (t / 32) * 64, (t % 32) * 64, c.tid, lds); continue; } t -= T_WQ;
        if (t < T_UQ) { p0_tr_tile(CIN(17) + (size_t)l * 192 * 384, C_WUQ + (size_t)l * 384 * 192, 192, 384, (t / 6) * 64, (t % 6) * 64, c.tid, lds); continue; } t -= T_UQ;
        p0_tr_tile(CIN(18) + (size_t)l * 128 * 512, C_WUKV + (size_t)l * 512 * 128, 128, 512, (t / 8) * 64, (t % 8) * 64, c.tid, lds);
    }
    const size_t nk8 = (size_t)2 * 16 * 128 * 128 / 8;
    for (size_t i = (size_t)blockIdx.x * 512 + c.tid; i < nk8; i += (size_t)gridDim.x * 512) {
        const f32x4 a = *(const f32x4*)(CIN(22) + i * 8), b = *(const f32x4*)(CIN(22) + i * 8 + 4);
        u32x4 w = {cvtpk(a[0], a[1]), cvtpk(a[2], a[3]), cvtpk(b[0], b[1]), cvtpk(b[2], b[3])};
        *(u32x4*)(C_KEYS + i * 8) = w;
    }
}

template <int WHICH>
__device__ void ph_norm(const Ctx& c, int l) {
    const float* g = CIN(WHICH == 0 ? 6 : 7) + l * D;
    const bool need_ctx = (l < DEPTH - 1);
    const int stride = gridDim.x * 8;
    auto next_row = [&](int r) { for (; r < NR; r += stride) { const int j = r % RPB; if (!(WHICH == 1 && j < CTX && !need_ctx)) break; } return r; };
    auto row_src = [&](int r) { return (WHICH == 0 && l == 0) ? inrow(c, r) : (const float*)xrow(c, r); };
    int r = next_row(blockIdx.x * 8 + c.wid);
    f32x4 xn[4];
    if (r < NR) { const float* src = row_src(r);
#pragma unroll
        for (int i = 0; i < 4; ++i) xn[i] = *(const f32x4*)(src + i * 256 + c.lane * 4); }
    while (r < NR) {
        f32x4 x[4];
#pragma unroll
        for (int i = 0; i < 4; ++i) x[i] = xn[i];
        const int rn = next_row(r + stride);
        if (rn < NR) { const float* src = row_src(rn);
#pragma unroll
            for (int i = 0; i < 4; ++i) xn[i] = *(const f32x4*)(src + i * 256 + c.lane * 4); }
        const int b = r / RPB, j = r - b * RPB; const bool isctx = j < CTX;
        float ss = 0.f;
#pragma unroll
        for (int i = 0; i < 4; ++i) ss += x[i][0] * x[i][0] + x[i][1] * x[i][1] + x[i][2] * x[i][2] + x[i][3] * x[i][3];
        ss = wave_sum(ss);
        const float rstd = rsqrtf(ss * (1.f / D) + NORM_EPS);
        const float* mt = C_MODT + ((size_t)l * 5 + (isctx ? 4 : b)) * 6144;
        const float* sh = mt + (WHICH == 0 ? 0 : 3) * D; const float* scl = mt + (WHICH == 0 ? 1 : 4) * D;
        bf16_t* dst = C_HB + (size_t)r * D;
        float* xr = xrow(c, r);
#pragma unroll
        for (int i = 0; i < 4; ++i) { const int col = i * 256 + c.lane * 4;
            const f32x4 gv = *(const f32x4*)(g + col), sv = *(const f32x4*)(sh + col), cv = *(const f32x4*)(scl + col);
            float y[4];
#pragma unroll
            for (int e = 0; e < 4; ++e) y[e] = x[i][e] * rstd * gv[e] * (1.f + cv[e]) + sv[e];
            u32x2 w = {cvtpk(y[0], y[1]), cvtpk(y[2], y[3])};
            *(u32x2*)(dst + col) = w;
            if (WHICH == 0 && l == 0) *(f32x4*)(xr + col) = x[i]; }
        r = rn;
    }
}

constexpr int GEMM_LDS = 98304;
template <class Epi>
__device__ __forceinline__ void gemm_tile(const Ctx& c, const bf16_t* __restrict__ A, int lda, const bf16_t* __restrict__ Bt, int ldb, int K, int m0, int n0, char* lds, const Epi& epi) {
    const int tid = c.tid, lane = tid & 63, wid = tid >> 6, r32 = lane & 31, hi = lane >> 5, wm = wid >> 1, wn = wid & 1;
    char* As = lds; char* Bs = lds + 65536;
    f32x16 acc[2][2];
#pragma unroll
    for (int m = 0; m < 2; ++m)
#pragma unroll
        for (int n = 0; n < 2; ++n) zero_acc(acc[m][n]);
    u32x4 ra[4], rb[2];
    const int srow = tid >> 3, sch = tid & 7;
    const bf16_t* Ag = A + (size_t)(m0 + srow) * lda + sch * 8;
    const bf16_t* Bg = Bt + (size_t)(n0 + srow) * ldb + sch * 8;
    const int swoff = srow * 128 + ((sch ^ ((srow >> 1) & 7)) << 4);
#define GLOAD(k0) do { _Pragma("unroll") for (int i = 0; i < 4; ++i) ra[i] = *(const u32x4*)(Ag + (size_t)(64 * i) * lda + (k0)); \
                       _Pragma("unroll") for (int i = 0; i < 2; ++i) rb[i] = *(const u32x4*)(Bg + (size_t)(64 * i) * ldb + (k0)); } while (0)
#define SWRITE(buf) do { _Pragma("unroll") for (int i = 0; i < 4; ++i) *(u32x4*)(As + (buf) * 32768 + swoff + i * 8192) = ra[i]; \
                         _Pragma("unroll") for (int i = 0; i < 2; ++i) *(u32x4*)(Bs + (buf) * 16384 + swoff + i * 8192) = rb[i]; } while (0)
    const int nk = K >> 6;
    GLOAD(0); SWRITE(0); __syncthreads();
    for (int kt = 0; kt < nk; ++kt) {
        const int buf = kt & 1;
        if (kt + 1 < nk) GLOAD((kt + 1) * 64);
        const char* Ab = As + buf * 32768; const char* Bb = Bs + buf * 16384;
#pragma unroll
        for (int ks = 0; ks < 4; ++ks) {
            bf16x8 a[2], b[2];
#pragma unroll
            for (int m = 0; m < 2; ++m) { const int row = wm * 64 + m * 32 + r32; a[m] = *(const bf16x8*)(Ab + row * 128 + (((ks * 2 + hi) ^ ((row >> 1) & 7)) << 4)); }
#pragma unroll
            for (int n = 0; n < 2; ++n) { const int row = wn * 64 + n * 32 + r32; b[n] = *(const bf16x8*)(Bb + row * 128 + (((ks * 2 + hi) ^ ((row >> 1) & 7)) << 4)); }
#pragma unroll
            for (int m = 0; m < 2; ++m)
#pragma unroll
                for (int n = 0; n < 2; ++n) acc[m][n] = __builtin_amdgcn_mfma_f32_32x32x16_bf16(a[m], b[n], acc[m][n], 0, 0, 0);
        }
        if (kt + 1 < nk) SWRITE(buf ^ 1);
        __syncthreads();
    }
#undef GLOAD
#undef SWRITE
    epi(acc, m0 + wm * 64, n0 + wn * 64, r32, hi);
}
struct EpiBf16 {
    bf16_t* C; int ldc; float scale;
    __device__ __forceinline__ void operator()(const f32x16 (&acc)[2][2], int row0, int col0, int r32, int hi) const {
        bf16_t* base = C + (size_t)(row0 + 4 * hi) * ldc + col0 + r32;
#pragma unroll
        for (int m = 0; m < 2; ++m)
#pragma unroll
            for (int r = 0; r < 16; ++r) { bf16_t* p = base + (size_t)(m * 32 + (r & 3) + 8 * (r >> 2)) * ldc;
                p[0] = f2bf(acc[m][0][r] * scale); p[32] = f2bf(acc[m][1][r] * scale);
                asm volatile("" ::: "memory"); }
    }
};

template <int MX> struct ScanCfg;
template <> struct ScanCfg<0> { static constexpr int DK = 32; };
template <> struct ScanCfg<1> { static constexpr int DK = 64; };

constexpr int BP = 72;
typedef float f32x4v __attribute__((ext_vector_type(4)));
__device__ __forceinline__ bf16x8 frag16(const bf16_t* tile, int row0, int k0, int lane) { return *(const bf16x8*)(tile + (row0 + (lane & 15)) * BP + k0 + 8 * (lane >> 4)); }

constexpr int SCAN_TAB_OFF = 128000;
__device__ __forceinline__ void scan_tables(const Ctx& c, int l, char* lds) {
    float* wtab = (float*)(lds + SCAN_TAB_OFF); float* btab = wtab + 2 * 16 * 128; float* lbtab = btab + 2 * 128;
    for (int i = c.tid; i < 2 * 16 * 128; i += 512) wtab[i] = CIN(10)[(size_t)l * 2 * 16 * 128 + i];
    if (c.tid < 256) { btab[c.tid] = CIN(11)[(size_t)l * 256 + c.tid];
        float lb = 0.f; if (l > 0) { const float r0 = CIN(13)[c.tid], r1 = CIN(13)[256 + c.tid]; lb = 1.f / (1.f + __expf(r0 - r1)); }
        lbtab[c.tid] = lb; }
    __syncthreads();
}
template <int MX, bool WANT_Q>
__device__ __forceinline__ void scan_load(const Ctx& c, int l, int b, int h, int cc, int dir, float* qt, float* kt, float* gt, bf16_t* VT, float* tmp, const char* ldsb) {
    constexpr int DK = ScanCfg<MX>::DK, PK = DK + 1;
    const int tid = c.tid;
    const int t = tid >> 3, j0 = (tid & 7) * 8;
    const bf16_t* pr = C_P + (size_t)(b * RPB + cc * 64 + (dir ? 63 - t : t)) * INC;
    const u32x4 vv = *(const u32x4*)(pr + (MX == 0 ? GLA_V : HG_I) + h * 64 + j0);
    if (MX == 0) {
        float* zt = tmp; const float* wt = (const float*)(ldsb + SCAN_TAB_OFF) + dir * 16 * 128 + h * 32; const float* bt = (const float*)(ldsb + SCAN_TAB_OFF) + 2 * 16 * 128 + dir * 128 + h * 32;
        const int j4 = (tid & 7) * 4;
        const u32x2 kv = *(const u32x2*)(pr + GLA_K + h * 32 + j4);
        u32x2 qv = {0u, 0u}; if (WANT_Q) qv = *(const u32x2*)(pr + GLA_Q + h * 32 + j4);
        u32x4 zv = {0u, 0u, 0u, 0u};
        if (tid < 128) zv = *(const u32x4*)(C_P + (size_t)(b * RPB + cc * 64 + (dir ? 63 - (tid >> 1) : (tid >> 1))) * INC + (dir ? GLA_ZB : GLA_ZF) + (tid & 1) * 8);
        if (tid < 128) { float* zp = zt + (tid >> 1) * 16 + (tid & 1) * 8;
#pragma unroll
            for (int q = 0; q < 4; ++q) { zp[2 * q] = bflo(zv[q]); zp[2 * q + 1] = bfhi(zv[q]); } }
        __syncthreads();
#pragma unroll
        for (int e = 0; e < 4; ++e) { const int j = j4 + e;
            float a = bt[j];
#pragma unroll
            for (int k = 0; k < 16; ++k) a += zt[t * 16 + k] * wt[k * 128 + j];
            gt[t * PK + j] = logsigmoid_f(a) * (1.f / 16.f);
            kt[t * PK + j] = (e & 1) ? bfhi(kv[e >> 1]) : bflo(kv[e >> 1]);
            if (WANT_Q) qt[t * PK + j] = ((e & 1) ? bfhi(qv[e >> 1]) : bflo(qv[e >> 1])) * 0.17677669529663687f; }
    } else {
        const u32x4 zv = *(const u32x4*)(pr + (dir ? HG_ZB : HG_ZF) + h * 64 + j0);
        u32x4 qv = {0u, 0u, 0u, 0u}; if (WANT_Q) qv = *(const u32x4*)(pr + HG_Q + h * 64 + j0);
        float lbv[8];
        { const float* lbt = (const float*)(ldsb + SCAN_TAB_OFF) + 2 * 16 * 128 + 2 * 128 + h * 64 + j0;
#pragma unroll
          for (int e = 0; e < 8; ++e) lbv[e] = lbt[e]; }
#pragma unroll
        for (int e = 0; e < 8; ++e) { const int j = j0 + e;
            const float z = fminf(fmaxf((e & 1) ? bfhi(zv[e >> 1]) : bflo(zv[e >> 1]), -80.f), 80.f); const float lb = lbv[e];
            const float ez = __expf(-z), sg = __builtin_amdgcn_rcpf(1.f + ez);
            gt[t * PK + j] = fmaxf(__logf(lb + (1.f - lb) * sg), -69.07755279f);
            kt[t * PK + j] = (1.f - lb) * ez * sg;
            if (WANT_Q) { const float qz = (e & 1) ? bfhi(qv[e >> 1]) : bflo(qv[e >> 1]); qt[t * PK + j] = qz * __builtin_amdgcn_rcpf(1.f + __expf(-qz)); } }
    }
#pragma unroll
    for (int e = 0; e < 8; ++e) VT[(j0 + e) * BP + t] = (bf16_t)((e & 1) ? (vv[e >> 1] >> 16) : (vv[e >> 1] & 0xffffu));
    __syncthreads();
    { float x[DK / 8];
#pragma unroll
        for (int u = 0; u < DK / 8; ++u) x[u] = gt[c.lane * PK + c.wid + 8 * u];
#pragma unroll
        for (int d = 1; d < 64; d <<= 1)
#pragma unroll
            for (int u = 0; u < DK / 8; ++u) { const float y = __shfl_up(x[u], d, 64); if (c.lane >= d) x[u] += y; }
#pragma unroll
        for (int u = 0; u < DK / 8; ++u) gt[c.lane * PK + c.wid + 8 * u] = x[u]; }
    __syncthreads();
}

template <int MX>
__device__ void scanA_item(const Ctx& c, int l, int b, int h, int cc, int dir, char* lds) {
    constexpr int DK = ScanCfg<MX>::DK, PK = DK + 1;
    float* kt = (float*)lds; float* gt = kt + 64 * PK; bf16_t* VT = (bf16_t*)(gt + 64 * PK); bf16_t* KET = VT + 64 * BP; float* tmp = (float*)(KET + 64 * BP);
    scan_load<MX, false>(c, l, b, h, cc, dir, nullptr, kt, gt, VT, tmp, lds);
    const int tid = c.tid, lane = c.lane;
    for (int i = tid; i < 64 * DK; i += 512) { const int s_ = i & 63, k = i >> 6; KET[k * BP + s_] = f2bf(kt[s_ * PK + k] * __expf(gt[63 * PK + k] - gt[s_ * PK + k])); }
    __syncthreads();
    const int ch = (b * 4 + h) * 2 + dir;
    bf16_t* S = (MX == 0 ? C_SG : C_SH) + ((size_t)ch * NCHUNK + cc) * (DK * 64);
    for (int tile = c.wid; tile < (DK / 16) * 4; tile += 8) { const int tk = tile >> 2, tj = tile & 3;
        f32x4v acc = {0.f, 0.f, 0.f, 0.f};
#pragma unroll
        for (int ks = 0; ks < 2; ++ks) acc = __builtin_amdgcn_mfma_f32_16x16x32_bf16(frag16(KET, tk * 16, ks * 32, lane), frag16(VT, tj * 16, ks * 32, lane), acc, 0, 0, 0);
#pragma unroll
        for (int i = 0; i < 4; ++i) S[(tk * 16 + 4 * (lane >> 4) + i) * 64 + tj * 16 + (lane & 15)] = f2bf(acc[i]); }
    if (tid < DK) (MX == 0 ? C_DG : C_DH)[((size_t)ch * NCHUNK + cc) * DK + tid] = __expf(gt[63 * PK + tid]);
    __syncthreads();
}
__device__ void scanB_item(const Ctx& c, int item) {
    const int e = item * 512 + c.tid;
    const bool hg = e >= 65536; const int ee = hg ? e - 65536 : e;
    const int DK = hg ? 64 : 32; const int per = DK * 64;
    const int ch = ee / per, ij = ee % per, i = ij >> 6; const int dir = ch & 1;
    bf16_t* S = (hg ? C_SH : C_SG) + (size_t)ch * NCHUNK * per + ij;
    const float* Dc = (hg ? C_DH : C_DG) + (size_t)ch * NCHUNK * DK + i;
    float st = 0.f;
    for (int n0 = 0; n0 < NCHUNK; n0 += 6) {
        float sv[6], dv[6];
#pragma unroll
        for (int u = 0; u < 6; ++u) { const int n = n0 + u; const int cc = dir ? (n < 4 ? 3 - n : 135 - n) : n; sv[u] = bf2f(S[(size_t)cc * per]); dv[u] = Dc[(size_t)cc * DK]; }
#pragma unroll
        for (int u = 0; u < 6; ++u) { const int n = n0 + u; const int cc = dir ? (n < 4 ? 3 - n : 135 - n) : n; S[(size_t)cc * per] = f2bf(st); st = dv[u] * st + sv[u]; }
    }
}
template <int MX>
__device__ void scanC_item(const Ctx& c, int l, int b, int h, int cc, char* lds) {
    constexpr int DK = ScanCfg<MX>::DK, PK = DK + 1;
    float* qt = (float*)lds; float* kt = qt + 64 * PK; float* gt = kt + 64 * PK; float* ot = gt + 64 * PK;
    bf16_t* VT = (bf16_t*)(ot + 64 * 65); bf16_t* QS = VT + 64 * BP; bf16_t* QG = QS + 64 * BP; bf16_t* KS = QG + 64 * BP;
    bf16_t* SC = KS + 96 * BP; bf16_t* ST = SC + 64 * BP; float* tmp = (float*)(ST + 64 * BP);
    const int tid = c.tid, lane = c.lane;
    for (int dir = 0; dir < 2; ++dir) {
        scan_load<MX, true>(c, l, b, h, cc, dir, qt, kt, gt, VT, tmp, lds);
        const int ch = (b * 4 + h) * 2 + dir;
        const bf16_t* Sg = (MX == 0 ? C_SG : C_SH) + ((size_t)ch * NCHUNK + cc) * (DK * 64);
        if (tid < DK * 8) { const int k = tid >> 3, jb = (tid & 7) * 8; const u32x4 sr = *(const u32x4*)(Sg + tid * 8);
#pragma unroll
            for (int e = 0; e < 8; ++e) ST[(jb + e) * BP + k] = (bf16_t)((e & 1) ? (sr[e >> 1] >> 16) : (sr[e >> 1] & 0xffffu)); }
        for (int i = tid; i < 64 * DK; i += 512) { const int t = i / DK, k = i % DK; const int I = t >> 4;
            const float bt = gt[t * PK + k], qv = qt[t * PK + k], kv = kt[t * PK + k];
            const float Bi = I ? gt[(16 * I - 1) * PK + k] : 0.f;
            QS[t * BP + k] = f2bf(qv * __expf(bt - Bi));
            QG[t * BP + k] = f2bf(qv * __expf(bt));
            if (t < 16) KS[t * BP + k] = f2bf(kv * __expf(gt[15 * PK + k] - bt));
            if (t < 32) KS[(16 + t) * BP + k] = f2bf(kv * __expf(gt[31 * PK + k] - bt));
            if (t < 48) KS[(48 + t) * BP + k] = f2bf(kv * __expf(gt[47 * PK + k] - bt)); }
        { const int blk = tid >> 7, tl = (tid >> 3) & 15, s0 = (tid & 7) * 2; const int t = blk * 16 + tl;
            float a0 = 0.f, a1 = 0.f;
            if (s0 <= tl) { const int sa = blk * 16 + s0, sb = sa + 1;
                for (int k = 0; k < DK; ++k) { const float qv = qt[t * PK + k], bv = gt[t * PK + k];
                    a0 += qv * kt[sa * PK + k] * __expf(fminf(bv - gt[sa * PK + k], 0.f));
                    a1 += qv * kt[sb * PK + k] * __expf(fminf(bv - gt[sb * PK + k], 0.f)); }
                if (s0 + 1 > tl) a1 = 0.f; }
            SC[t * BP + blk * 16 + s0] = f2bf(a0); SC[t * BP + blk * 16 + s0 + 1] = f2bf(a1);
            for (int J = blk + 1; J < 4; ++J) { SC[t * BP + J * 16 + s0] = 0; SC[t * BP + J * 16 + s0 + 1] = 0; } }
        __syncthreads();
        if (c.wid < 6) { const int I = c.wid < 1 ? 1 : (c.wid < 3 ? 2 : 3), J = c.wid < 1 ? 0 : (c.wid < 3 ? c.wid - 1 : c.wid - 3);
            const bf16_t* KSI = KS + (I == 1 ? 0 : (I == 2 ? 16 : 48)) * BP;
            f32x4v acc = {0.f, 0.f, 0.f, 0.f};
#pragma unroll
            for (int ks = 0; ks < DK / 32; ++ks) acc = __builtin_amdgcn_mfma_f32_16x16x32_bf16(frag16(QS, I * 16, ks * 32, lane), frag16(KSI, J * 16, ks * 32, lane), acc, 0, 0, 0);
#pragma unroll
            for (int i = 0; i < 4; ++i) SC[(I * 16 + 4 * (lane >> 4) + i) * BP + J * 16 + (lane & 15)] = f2bf(acc[i]); }
        __syncthreads();
#pragma unroll
        for (int u = 0; u < 2; ++u) { const int tile = c.wid * 2 + u; const int ti = tile >> 2, tj = tile & 3;
            f32x4v acc = {0.f, 0.f, 0.f, 0.f};
#pragma unroll
            for (int ks = 0; ks < 2; ++ks) acc = __builtin_amdgcn_mfma_f32_16x16x32_bf16(frag16(SC, ti * 16, ks * 32, lane), frag16(VT, tj * 16, ks * 32, lane), acc, 0, 0, 0);
#pragma unroll
            for (int ks = 0; ks < DK / 32; ++ks) acc = __builtin_amdgcn_mfma_f32_16x16x32_bf16(frag16(QG, ti * 16, ks * 32, lane), frag16(ST, tj * 16, ks * 32, lane), acc, 0, 0, 0);
#pragma unroll
            for (int i = 0; i < 4; ++i) { const int t = ti * 16 + 4 * (lane >> 4) + i; const int to = dir ? 63 - t : t; float* op = ot + to * 65 + tj * 16 + (lane & 15);
                if (dir == 0) *op = acc[i]; else *op += acc[i]; } }
        __syncthreads();
    }
    { const int t = tid >> 3, j0 = (tid & 7) * 8; float o[8]; float ss = 0.f;
#pragma unroll
        for (int j = 0; j < 8; ++j) { o[j] = ot[t * 65 + j0 + j]; ss += o[j] * o[j]; }
        ss += __shfl_xor(ss, 1, 64); ss += __shfl_xor(ss, 2, 64); ss += __shfl_xor(ss, 4, 64);
        const float rstd = rsqrtf(ss * (1.f / 64.f) + NORM_EPS);
        const int r = b * RPB + cc * 64 + t;
        const float* gn = CIN(MX == 0 ? 12 : 14) + l * 64;
        const u32x4 gp = *(const u32x4*)(C_P + (size_t)r * INC + (MX == 0 ? GLA_R : HG_OG) + h * 64 + j0);
        float y[8];
#pragma unroll
        for (int j = 0; j < 8; ++j) y[j] = o[j] * rstd * gn[j0 + j] * silu_f((j & 1) ? bfhi(gp[j >> 1]) : bflo(gp[j >> 1]));
        u32x4 w = {cvtpk(y[0], y[1]), cvtpk(y[2], y[3]), cvtpk(y[4], y[5]), cvtpk(y[6], y[7])};
        *(u32x4*)(C_HB + (size_t)r * D + MX * 256 + h * 64 + j0) = w; }
    __syncthreads();
}

__device__ __forceinline__ void rope_cs(int pos, int i, float& cs, float& sn) {
    const float freq = __expf(-(float)i * (9.210340371976184f / 8.f));
    const float ang = (float)pos * freq;
    const float n = rintf(ang * 0.15915494309189535f);
    float rr = fmaf(-n, 6.2831854820251465f, ang); rr = fmaf(-n, -1.7484555e-7f, rr);
    cs = __cosf(rr); sn = __sinf(rr);
}

__device__ void ph_prep_rows(const Ctx& c, int l) {
    const float* gq = CIN(15) + l * 192; const float* gkv = CIN(16) + l * 128;
    for (int r = blockIdx.x * 8 + c.wid; r < NR; r += gridDim.x * 8) {
        const int b = r / RPB, j = r - b * RPB; bf16_t* pr = C_P + (size_t)r * INC;
        { float v[3]; float ss = 0.f;
#pragma unroll
            for (int i = 0; i < 3; ++i) { v[i] = bf2f(pr[MLA_CQ + c.lane + 64 * i]); ss += v[i] * v[i]; }
            ss = wave_sum(ss); const float rstd = rsqrtf(ss * (1.f / 192.f) + NORM_EPS);
#pragma unroll
            for (int i = 0; i < 3; ++i) pr[MLA_CQ + c.lane + 64 * i] = f2bf(v[i] * rstd * gq[c.lane + 64 * i]); }
        { float v[2]; float ss = 0.f;
#pragma unroll
            for (int i = 0; i < 2; ++i) { v[i] = bf2f(pr[MLA_CKV + c.lane + 64 * i]); ss += v[i] * v[i]; }
            ss = wave_sum(ss); const float rstd = rsqrtf(ss * (1.f / 128.f) + NORM_EPS);
#pragma unroll
            for (int i = 0; i < 2; ++i) pr[MLA_CKV + c.lane + 64 * i] = f2bf(v[i] * rstd * gkv[c.lane + 64 * i]); }
        if (j >= CTX) { const int t = j - CTX; const int prow = t >> 6, pcol = t & 63;
            for (int pp = c.lane; pp < 34 * 8; pp += 64) { const int g = pp >> 3, i = pp & 7;
                int col; if (g < 16) col = DF_Q + (g >> 1) * 32 + (g & 1) * 16; else if (g < 32) col = DF_K + ((g - 16) >> 1) * 32 + (g & 1) * 16; else col = MLA_KR + (g - 32) * 16;
                float cs, sn; rope_cs((g & 1) ? pcol : prow, i, cs, sn);
                const float x1 = bf2f(pr[col + i]), x2 = bf2f(pr[col + 8 + i]);
                pr[col + i] = f2bf(x1 * cs - x2 * sn); pr[col + 8 + i] = f2bf(x1 * sn + x2 * cs); } }
    }
}
__device__ void ph_rope_q(const Ctx& c) {
    for (int r = blockIdx.x * 8 + c.wid; r < NR; r += gridDim.x * 8) {
        const int b = r / RPB, j = r - b * RPB; if (j < CTX) continue;
        const int t = j - CTX; const int prow = t >> 6, pcol = t & 63;
        const int h = c.lane >> 4, g = (c.lane >> 3) & 1, i = c.lane & 7;
        bf16_t* q = C_QM + (size_t)r * 384 + h * 96 + 64 + g * 16;
        float cs, sn; rope_cs(g ? pcol : prow, i, cs, sn);
        const float x1 = bf2f(q[i]), x2 = bf2f(q[8 + i]);
        q[i] = f2bf(x1 * cs - x2 * sn); q[8 + i] = f2bf(x1 * sn + x2 * cs);
    }
}

__device__ __forceinline__ int v_st(int k, int cidx) { const int kk = (k & ~0xC) | ((k & 4) << 1) | ((k & 8) >> 1); return ((kk >> 3) * 2 + (cidx >> 5)) * 512 + ((kk & 7) * 32 + (cidx & 31)) * 2; }
__device__ __forceinline__ int v_rd_base(int lane) { return ((lane & 3) << 3) | (((lane >> 2) & 3) << 6) | (((lane >> 4) & 1) << 5) | (((lane >> 5) & 1) << 8); }
constexpr int v_rd_off(int d0, int ks, int half) { return d0 * 512 + ks * 2048 + half * 1024; }
template <int OFF> __device__ __forceinline__ s16x4 tr_read(int vb) { s16x4 r; asm volatile("ds_read_b64_tr_b16 %0, %1 offset:%2" : "=&v"(r) : "v"(vb), "i"(OFF) : "memory"); return r; }
template <int D0> __device__ __forceinline__ void pv_one(f32x16& od, int vb, bf16x8 pa0, bf16x8 pa1, bf16x8 pa2, bf16x8 pa3) {
    const s16x4 l0 = tr_read<v_rd_off(D0, 0, 0)>(vb), h0 = tr_read<v_rd_off(D0, 0, 1)>(vb), l1 = tr_read<v_rd_off(D0, 1, 0)>(vb), h1 = tr_read<v_rd_off(D0, 1, 1)>(vb);
    const s16x4 l2 = tr_read<v_rd_off(D0, 2, 0)>(vb), h2 = tr_read<v_rd_off(D0, 2, 1)>(vb), l3 = tr_read<v_rd_off(D0, 3, 0)>(vb), h3 = tr_read<v_rd_off(D0, 3, 1)>(vb);
    asm volatile("s_waitcnt lgkmcnt(0)" ::: "memory"); __builtin_amdgcn_sched_barrier(0);
#define PKV(L, H) (bf16x8){L[0], L[1], L[2], L[3], H[0], H[1], H[2], H[3]}
    od = __builtin_amdgcn_mfma_f32_32x32x16_bf16(pa0, PKV(l0, h0), od, 0, 0, 0);
    od = __builtin_amdgcn_mfma_f32_32x32x16_bf16(pa1, PKV(l1, h1), od, 0, 0, 0);
    od = __builtin_amdgcn_mfma_f32_32x32x16_bf16(pa2, PKV(l2, h2), od, 0, 0, 0);
    od = __builtin_amdgcn_mfma_f32_32x32x16_bf16(pa3, PKV(l3, h3), od, 0, 0, 0);
#undef PKV
}
constexpr float ATT_BIG = 1.0995116e12f;
constexpr float ATT_ZBIG = 1.2379400392853803e27f, ATT_ZSMALL = 8.673617379884035e-19f;
__device__ __forceinline__ float rowmax_tile(const f32x16& p0, const f32x16& p1) {
    float pmax = p0[0];
#pragma unroll
    for (int r = 1; r < 16; ++r) pmax = fmaxf(pmax, p0[r]);
#pragma unroll
    for (int r = 0; r < 16; ++r) pmax = fmaxf(pmax, p1[r]);
    auto rr = __builtin_amdgcn_permlane32_swap(__float_as_uint(pmax), __float_as_uint(pmax), false, false);
    return fmaxf(__uint_as_float(rr[0]), __uint_as_float(rr[1]));
}
__device__ __forceinline__ void softmax_tile(f32x16& p0, f32x16& p1, float& M, const float Mused, float& l_reg, const bool first,
                                             bf16x8& pa0, bf16x8& pa1, bf16x8& pa2, bf16x8& pa3, f32x16 (&o)[2], float* wsl, const int r32, const int hi) {
    if (__builtin_expect(__any(Mused != M), 0)) {
        asm volatile("" ::: "memory");
        const float dM = Mused - M;
#pragma unroll
        for (int r = 0; r < 16; ++r) { p0[r] += dM; p1[r] += dM; }
    }
    if (first) {
        float pmax = p0[0];
#pragma unroll
        for (int r = 1; r < 16; ++r) pmax = fmaxf(pmax, p0[r]);
#pragma unroll
        for (int r = 0; r < 16; ++r) pmax = fmaxf(pmax, p1[r]);
        { auto rr = __builtin_amdgcn_permlane32_swap(__float_as_uint(pmax), __float_as_uint(pmax), false, false); pmax = fmaxf(__uint_as_float(rr[0]), __uint_as_float(rr[1])); }
        M = pmax;
#pragma unroll
        for (int r = 0; r < 16; ++r) { p0[r] -= pmax; p1[r] -= pmax; }
    }
    float ps = 0.f;
#pragma unroll
    for (int r = 0; r < 16; ++r) { p0[r] = __builtin_amdgcn_exp2f(p0[r]); ps += p0[r]; }
#pragma unroll
    for (int r = 0; r < 16; ++r) { p1[r] = __builtin_amdgcn_exp2f(p1[r]); ps += p1[r]; }
    { auto rr = __builtin_amdgcn_permlane32_swap(__float_as_uint(ps), __float_as_uint(ps), false, false); ps = __uint_as_float(rr[0]) + __uint_as_float(rr[1]); }
    if (__builtin_expect(__any(ps > ATT_BIG), 0)) {
        asm volatile("" ::: "memory");
        float pm = p0[0];
#pragma unroll
        for (int r = 1; r < 16; ++r) pm = fmaxf(pm, p0[r]);
#pragma unroll
        for (int r = 0; r < 16; ++r) pm = fmaxf(pm, p1[r]);
        { auto rr = __builtin_amdgcn_permlane32_swap(__float_as_uint(pm), __float_as_uint(pm), false, false); pm = fmaxf(__uint_as_float(rr[0]), __uint_as_float(rr[1])); }
        const float alpha = pm > 1.f ? __builtin_amdgcn_rcpf(pm) : 1.f;
        M -= __builtin_amdgcn_logf(alpha);
#pragma unroll
        for (int r = 0; r < 16; ++r) { p0[r] *= alpha; p1[r] *= alpha; }
        ps *= alpha; l_reg *= alpha;
        if (hi == 0) wsl[r32] = alpha;
        asm volatile("s_waitcnt lgkmcnt(0)" ::: "memory");
#pragma unroll
        for (int r = 0; r < 16; ++r) { const float av = wsl[crow(r, hi)]; o[0][r] *= av; o[1][r] *= av; }
        asm volatile("" ::: "memory");
    }
    l_reg += ps;
#define PK4(P, BASE, OUT) do { unsigned a0 = cvtpk(P[BASE + 0], P[BASE + 1]), a1 = cvtpk(P[BASE + 2], P[BASE + 3]);   \
    unsigned b0 = cvtpk(P[BASE + 4], P[BASE + 5]), b1 = cvtpk(P[BASE + 6], P[BASE + 7]);                              \
    auto r0 = __builtin_amdgcn_permlane32_swap(a0, b0, false, false); auto r1 = __builtin_amdgcn_permlane32_swap(a1, b1, false, false); \
    u32x4 w = {r0[0], r1[0], r0[1], r1[1]}; OUT = *reinterpret_cast<bf16x8*>(&w); } while (0)
    PK4(p0, 0, pa0); PK4(p0, 8, pa1); PK4(p1, 0, pa2); PK4(p1, 8, pa3);
#undef PK4
}

constexpr int ATT_STAGE = 2 * 16384 + 2 * 8192;
constexpr int ATT_LDS = 2 * ATT_STAGE + 8 * 64 * 4 + 16;
template <bool DIFF>
__device__ void attn_item(const Ctx& c, int l, int b, int hd, int qrow0, int krow0, int nkeys, char* lds) {
    constexpr int DQK = DIFF ? 32 : 96, NMAP = DIFF ? 2 : 1, ND0 = DQK / 16, NU = 2 * NMAP;
    constexpr int KP = DIFF ? 64 : 256;
    constexpr int KSZ = 64 * KP;
    constexpr int NKR = DIFF ? 2 : 3;
    const int tid_ = mk_tid(c.wid);
    const int tid = tid_, lane = tid_ & 63, wid = c.wid, r32 = lane & 31, hi = lane >> 5;
    char* K_lds0 = lds; char* V_lds0 = lds + 2 * 16384; float* wsl = (float*)(lds + 2 * ATT_STAGE) + wid * 64;
    const float scale = DIFF ? 0.17677669529663687f : 0.10206207261596575f;
    const float C = scale * 1.4426950408889634f;
    bf16x8 qr[NMAP][ND0];
    { const int qrow = qrow0 + wid * 32 + r32;
#pragma unroll
        for (int m = 0; m < NMAP; ++m)
#pragma unroll
            for (int d0 = 0; d0 < ND0; ++d0) {
                const bf16_t* p = DIFF ? C_P + (size_t)qrow * INC + DF_Q + (hd * 2 + m) * 32 + d0 * 16 + hi * 8
                                       : C_QM + (size_t)qrow * 384 + hd * 96 + d0 * 16 + hi * 8;
                qr[m][d0] = *(const bf16x8*)p; } }
    f32x16 o[NMAP][2]; float m_reg[NMAP], l_reg[NMAP];
#pragma unroll
    for (int m = 0; m < NMAP; ++m) { m_reg[m] = 0.f; l_reg[m] = 0.f;
#pragma unroll
        for (int d = 0; d < 2; ++d) zero_acc(o[m][d]); }
    constexpr int NKP = DIFF ? 2 : 4;
    int ksrc[NKP], vsrc[2];
#pragma unroll
    for (int q = 0; q < NKP; ++q) { const int off = (wid * NKP + q) * 1024 + lane * 16;
        if (DIFF) { const int blk = off >> 12, key = (off & 4095) >> 6, slot = (off & 63) >> 4, ch = slot ^ ((key >> 2) & 3);
            ksrc[q] = ((blk >> 1) * 64 + key) * INC + DF_K + (hd * 2 + (blk & 1)) * 32 + ch * 8; }
        else { const int tile = off >> 14, key = (off & 16383) >> 8, slot = (off & 255) >> 4, ch = slot ^ (key & 7);
            ksrc[q] = ch < 8 ? -1 - ((tile * 64 + key) * 512 + hd * 128 + ch * 8) : (ch < 12 ? (tile * 64 + key) * INC + MLA_KR + (ch - 8) * 8 : (int)0x80000000); } }
#pragma unroll
    for (int q = 0; q < 2; ++q) { const int off = (wid * 2 + q) * 1024 + lane * 16; const int tile = off >> 13, w = off & 8191;
        const int sub = w >> 9, within = w & 511; const int kk = (sub >> 1) * 8 + (within >> 6); const int col = (sub & 1) * 32 + ((within & 63) >> 1);
        const int key = (kk & ~0xC) | ((kk & 4) << 1) | ((kk & 8) >> 1);
        vsrc[q] = DIFF ? (tile * 64 + key) * INC + DF_V + hd * 64 + col : (tile * 64 + key) * 512 + hd * 128 + 64 + col; }
    const int vb0 = (int)(uintptr_t)V_lds0 + v_rd_base(lane);
#define ADMA(buf, kr) do { \
        _Pragma("unroll") for (int q = 0; q < NKP; ++q) { LAS unsigned* dst_ = (LAS unsigned*)(LAS char*)(K_lds0 + (buf) * ATT_STAGE + (wid * NKP + q) * 1024); \
            if (DIFF || ksrc[q] >= 0) __builtin_amdgcn_global_load_lds((const unsigned*)(C_P + (size_t)(kr) * INC + ksrc[q]), dst_, 16, 0, 0); \
            else if (ksrc[q] != (int)0x80000000) __builtin_amdgcn_global_load_lds((const unsigned*)(C_KVM + (size_t)(kr) * 512 + (-1 - ksrc[q])), dst_, 16, 0, 0); } \
        _Pragma("unroll") for (int q = 0; q < 2; ++q) { LAS unsigned* dst_ = (LAS unsigned*)(LAS char*)(V_lds0 + (buf) * ATT_STAGE + (wid * 2 + q) * 1024); \
            __builtin_amdgcn_global_load_lds((const unsigned*)((DIFF ? C_P + (size_t)(kr) * INC : C_KVM + (size_t)(kr) * 512) + vsrc[q]), dst_, 16, 0, 0); } } while (0)
    const int NS = nkeys >> 7;
    ADMA(0, krow0);
    for (int j = 0; j < NS; ++j) {
        asm volatile("s_waitcnt vmcnt(0)" ::: "memory");
        __syncthreads();
        if (j + 1 < NS) ADMA((j + 1) & 1, krow0 + (j + 1) * 128);
        const char* K_lds = K_lds0 + (j & 1) * ATT_STAGE; const int vb = vb0 + (j & 1) * ATT_STAGE;
        f32x16 p0[2], p1[2]; float mused[2];
#define QKT(u) do { constexpr int tt_ = (u) / NMAP, m_ = (u) % NMAP; const char* Kb = K_lds + (tt_ * NMAP + m_) * KSZ; \
            _Pragma("unroll") for (int d0 = 0; d0 < ND0; ++d0) { bf16x8 b0, b1; \
                if (DIFF) { const int ch = d0 * 2 + hi; const int ra = r32, rb = 32 + r32; \
                    b0 = *(const bf16x8*)(Kb + ra * 64 + ((ch ^ ((ra >> 2) & 3)) << 4)); b1 = *(const bf16x8*)(Kb + rb * 64 + ((ch ^ ((rb >> 2) & 3)) << 4)); } \
                else { const int cb = d0 * 32 + hi * 16; const int ra = r32, rb = 32 + r32; \
                    b0 = *(const bf16x8*)(Kb + ra * 256 + (cb ^ ((ra & 7) << 4))); b1 = *(const bf16x8*)(Kb + rb * 256 + (cb ^ ((rb & 7) << 4))); } \
                if (d0 == 0) { const float nm_ = -m_reg[m_]; mused[(u) & 1] = m_reg[m_]; const f32x16 z = {nm_,nm_,nm_,nm_,nm_,nm_,nm_,nm_,nm_,nm_,nm_,nm_,nm_,nm_,nm_,nm_}; \
                    p0[(u) & 1] = __builtin_amdgcn_mfma_f32_32x32x16_bf16(b0, qr[m_][0], z, 0, 0, 0); p1[(u) & 1] = __builtin_amdgcn_mfma_f32_32x32x16_bf16(b1, qr[m_][0], z, 0, 0, 0); \
                    asm volatile("" :: "v"(b0), "v"(b1));   } \
                else { p0[(u) & 1] = __builtin_amdgcn_mfma_f32_32x32x16_bf16(b0, qr[m_][d0], p0[(u) & 1], 0, 0, 0); p1[(u) & 1] = __builtin_amdgcn_mfma_f32_32x32x16_bf16(b1, qr[m_][d0], p1[(u) & 1], 0, 0, 0); } } \
            if (!DIFF) {   \
                __builtin_amdgcn_sched_group_barrier(0x100, 4, 0); \
                _Pragma("unroll") for (int g_ = 0; g_ < 4; ++g_) { __builtin_amdgcn_sched_group_barrier(0x8, 2, 0); __builtin_amdgcn_sched_group_barrier(0x100, 2, 0); } \
                __builtin_amdgcn_sched_group_barrier(0x8, 4, 0); } } while (0)
        QKT(0);
#pragma unroll
        for (int u = 0; u < NU; ++u) {
            const int tt = u / NMAP, m = u % NMAP;
            if (u + 1 < NU) { if (u == 0) QKT(1); else if (u == 1) QKT(2); else QKT(3); }
            bf16x8 pa0, pa1, pa2, pa3;
            softmax_tile(p0[u & 1], p1[u & 1], m_reg[m], mused[u & 1], l_reg[m], (j == 0) && (tt == 0), pa0, pa1, pa2, pa3, o[m], wsl, r32, hi);
            pv_one<0>(o[m][0], vb + tt * 8192, pa0, pa1, pa2, pa3);
            pv_one<1>(o[m][1], vb + tt * 8192, pa0, pa1, pa2, pa3);
        }
#undef QKT
    }
#undef ADMA
    float rli[NMAP][16];
#pragma unroll
    for (int m = 0; m < NMAP; ++m) {
        asm volatile("s_waitcnt lgkmcnt(0)" ::: "memory");
        if (hi == 0) wsl[r32] = l_reg[m];
        asm volatile("s_waitcnt lgkmcnt(0)" ::: "memory");
#pragma unroll
        for (int r = 0; r < 16; ++r) rli[m][r] = __builtin_amdgcn_rcpf(wsl[crow(r, hi)]);
    }
    const int orow0 = qrow0 + wid * 32;
    if (!DIFF) {
#pragma unroll
        for (int r = 0; r < 16; ++r) { bf16_t* dst = C_HB + (size_t)(orow0 + crow(r, hi)) * D + 512 + hd * 64 + r32;
            dst[0] = f2bf(o[0][0][r] * rli[0][r]); dst[32] = f2bf(o[0][1][r] * rli[0][r]); }
    } else {
        const float* lp = CIN(19) + l * 128; const float* gn = CIN(20) + l * 64; asm volatile("" : "+s"(lp), "+s"(gn));
        float s1 = 0.f, s2 = 0.f;
        for (int i = 0; i < 32; ++i) { s1 += lp[i] * lp[32 + i]; s2 += lp[64 + i] * lp[96 + i]; }
        const float lam_init = (l == 0) ? 0.2f : 0.35550906759097f;
        const float lam = __expf(s1) - __expf(s2) + lam_init;
        const float g0 = gn[r32] * (1.f - lam_init), g1 = gn[32 + r32] * (1.f - lam_init);
#pragma unroll
        for (int r = 0; r < 16; ++r) {
            const float v0 = o[0][0][r] * rli[0][r] - lam * o[NMAP - 1][0][r] * rli[NMAP - 1][r];
            const float v1 = o[0][1][r] * rli[0][r] - lam * o[NMAP - 1][1][r] * rli[NMAP - 1][r];
            float ss = v0 * v0 + v1 * v1;
            ss += shx(ss, 1, lane); ss += shx(ss, 2, lane); ss += shx(ss, 4, lane); ss += shx(ss, 8, lane); ss += shx(ss, 16, lane);
            const float rstd = rsqrtf(ss * (1.f / 64.f) + NORM_EPS);
            bf16_t* dst = C_HB + (size_t)(orow0 + crow(r, hi)) * D + 768 + hd * 64 + r32;
            dst[0] = f2bf(v0 * rstd * g0); dst[32] = f2bf(v1 * rstd * g1); }
    }
    __syncthreads();
}
template <bool DIFF>
__device__ bool attn_item_pair(const Ctx& c, int l, int b, int hd, int qrow0, int krow0, int nkeys, char* lds) {
    constexpr int DQK = DIFF ? 32 : 96, NMAP = DIFF ? 2 : 1, ND0 = DQK / 16, NU = 2 * NMAP;
    constexpr int KP = DIFF ? 64 : 256;
    constexpr int KSZ = 64 * KP;
    constexpr int NKR = DIFF ? 2 : 3;
    const int tid_ = mk_tid(c.wid);
    const int tid = tid_, lane = tid_ & 63, wid = c.wid, r32 = lane & 31, hi = lane >> 5;
    char* K_lds0 = lds; char* V_lds0 = lds + 2 * 16384; float* wsl = (float*)(lds + 2 * ATT_STAGE) + wid * 64;
    const float scale = DIFF ? 0.17677669529663687f : 0.10206207261596575f;
    const float C = scale * 1.4426950408889634f;
    bf16x8 qr[NMAP][ND0];
    { const int qrow = qrow0 + wid * 32 + r32;
#pragma unroll
        for (int m = 0; m < NMAP; ++m)
#pragma unroll
            for (int d0 = 0; d0 < ND0; ++d0) {
                const bf16_t* p = DIFF ? C_P + (size_t)qrow * INC + DF_Q + (hd * 2 + m) * 32 + d0 * 16 + hi * 8
                                       : C_QM + (size_t)qrow * 384 + hd * 96 + d0 * 16 + hi * 8;
                qr[m][d0] = *(const bf16x8*)p; } }
    f32x16 o[NMAP][2]; float m_reg[NMAP], l_reg[NMAP];
#pragma unroll
    for (int m = 0; m < NMAP; ++m) { m_reg[m] = 0.f; l_reg[m] = 0.f;
#pragma unroll
        for (int d = 0; d < 2; ++d) zero_acc(o[m][d]); }
    constexpr int NKP = DIFF ? 2 : 4;
    int ksrc[NKP], vsrc[2];
#pragma unroll
    for (int q = 0; q < NKP; ++q) { const int off = (wid * NKP + q) * 1024 + lane * 16;
        if (DIFF) { const int blk = off >> 12, key = (off & 4095) >> 6, slot = (off & 63) >> 4, ch = slot ^ ((key >> 2) & 3);
            ksrc[q] = ((blk >> 1) * 64 + key) * INC + DF_K + (hd * 2 + (blk & 1)) * 32 + ch * 8; }
        else { const int tile = off >> 14, key = (off & 16383) >> 8, slot = (off & 255) >> 4, ch = slot ^ (key & 7);
            ksrc[q] = ch < 8 ? -1 - ((tile * 64 + key) * 512 + hd * 128 + ch * 8) : (ch < 12 ? (tile * 64 + key) * INC + MLA_KR + (ch - 8) * 8 : (int)0x80000000); } }
#pragma unroll
    for (int q = 0; q < 2; ++q) { const int off = (wid * 2 + q) * 1024 + lane * 16; const int tile = off >> 13, w = off & 8191;
        const int sub = w >> 9, within = w & 511; const int kk = (sub >> 1) * 8 + (within >> 6); const int col = (sub & 1) * 32 + ((within & 63) >> 1);
        const int key = (kk & ~0xC) | ((kk & 4) << 1) | ((kk & 8) >> 1);
        vsrc[q] = DIFF ? (tile * 64 + key) * INC + DF_V + hd * 64 + col : (tile * 64 + key) * 512 + hd * 128 + 64 + col; }
    const int vb0 = (int)(uintptr_t)V_lds0 + v_rd_base(lane);
    unsigned kbo[NKP], vbo[2];
#pragma unroll
    for (int q = 0; q < NKP; ++q) kbo[q] = (DIFF || ksrc[q] >= 0) ? (unsigned)ksrc[q] * 2u : (unsigned)(-1 - ksrc[q]) * 2u;
#pragma unroll
    for (int q = 0; q < 2; ++q) vbo[q] = (unsigned)vsrc[q] * 2u;
#define ADMA(buf, kr) do { const char* pb_ = (const char*)C_P + (size_t)(kr) * (INC * 2); const char* kb_ = (const char*)C_KVM + (size_t)(kr) * 1024; asm volatile("" : "+s"(pb_), "+s"(kb_)); \
        _Pragma("unroll") for (int q = 0; q < NKP; ++q) { LAS unsigned* dst_ = (LAS unsigned*)(LAS char*)(K_lds0 + (buf) * ATT_STAGE + (wid * NKP + q) * 1024); \
            unsigned o_ = kbo[q]; asm volatile("" : "+v"(o_));     \
            if (DIFF || ksrc[q] >= 0) __builtin_amdgcn_global_load_lds((const unsigned*)(pb_ + (size_t)o_), dst_, 16, 0, 0); \
            else if (ksrc[q] != (int)0x80000000) __builtin_amdgcn_global_load_lds((const unsigned*)(kb_ + (size_t)o_), dst_, 16, 0, 0); } \
        _Pragma("unroll") for (int q = 0; q < 2; ++q) { LAS unsigned* dst_ = (LAS unsigned*)(LAS char*)(V_lds0 + (buf) * ATT_STAGE + (wid * 2 + q) * 1024); \
            unsigned o_ = vbo[q]; asm volatile("" : "+v"(o_)); \
            __builtin_amdgcn_global_load_lds((const unsigned*)((DIFF ? pb_ : kb_) + (size_t)o_), dst_, 16, 0, 0); } } while (0)
    f32x16 oB[2];
    if (!DIFF) { zero_acc(oB[0]); zero_acc(oB[1]); }
    float lB = 0.f;
    const int NS = nkeys >> 7;
    ADMA(0, krow0);
    for (int j = 0; j < NS; ++j) {
        asm volatile("s_waitcnt vmcnt(0)" ::: "memory");
        __syncthreads();
        if (j + 1 < NS) ADMA((j + 1) & 1, krow0 + (j + 1) * 128);
        const char* K_lds = K_lds0 + (j & 1) * ATT_STAGE; const int vb = vb0 + (j & 1) * ATT_STAGE;
#define KFR(tt, m, d0, h) (*(const bf16x8*)(K_lds + ((tt) * NMAP + (m)) * KSZ + \
            (DIFF ? (((h) * 32 + r32) * 64 + ((((d0) * 2 + hi) ^ ((((h) * 32 + r32) >> 2) & 3)) << 4)) : (((h) * 32 + r32) * 256 + (((d0) * 32 + hi * 16) ^ ((((h) * 32 + r32) & 7) << 4))))))
#pragma unroll
        for (int pi = 0; pi < (DIFF ? 2 : 1); ++pi) {
            const int tA = DIFF ? pi : 0, tB = DIFF ? pi : 1; constexpr int mA = 0, mB = NMAP - 1;
            f32x16 a0, a1, b0, b1;
            __builtin_amdgcn_sched_barrier(0);
            { const f32x16 zA = {0.f,0.f,0.f,0.f,0.f,0.f,0.f,0.f,0.f,0.f,0.f,0.f,0.f,0.f,0.f,0.f}; const f32x16 zB = zA;
#pragma unroll
              for (int d0 = 0; d0 < ND0; ++d0) {
                  const bf16x8 fa0 = KFR(tA, mA, d0, 0), fa1 = KFR(tA, mA, d0, 1), fb0 = KFR(tB, mB, d0, 0), fb1 = KFR(tB, mB, d0, 1);
                  if (d0 == 0) { a0 = __builtin_amdgcn_mfma_f32_32x32x16_bf16(fa0, qr[mA][0], zA, 0, 0, 0); b0 = __builtin_amdgcn_mfma_f32_32x32x16_bf16(fb0, qr[mB][0], zB, 0, 0, 0);
                                 a1 = __builtin_amdgcn_mfma_f32_32x32x16_bf16(fa1, qr[mA][0], zA, 0, 0, 0); b1 = __builtin_amdgcn_mfma_f32_32x32x16_bf16(fb1, qr[mB][0], zB, 0, 0, 0); }
                  else { a0 = __builtin_amdgcn_mfma_f32_32x32x16_bf16(fa0, qr[mA][d0], a0, 0, 0, 0); b0 = __builtin_amdgcn_mfma_f32_32x32x16_bf16(fb0, qr[mB][d0], b0, 0, 0, 0);
                         a1 = __builtin_amdgcn_mfma_f32_32x32x16_bf16(fa1, qr[mA][d0], a1, 0, 0, 0); b1 = __builtin_amdgcn_mfma_f32_32x32x16_bf16(fb1, qr[mB][d0], b1, 0, 0, 0); } } }
            float psA = 0.f, psB = 0.f;
#pragma unroll
            for (int r = 0; r < 16; ++r) { a0[r] = __builtin_amdgcn_exp2f(a0[r]); b0[r] = __builtin_amdgcn_exp2f(b0[r]); psA += a0[r]; psB += b0[r]; }
#pragma unroll
            for (int r = 0; r < 16; ++r) { a1[r] = __builtin_amdgcn_exp2f(a1[r]); b1[r] = __builtin_amdgcn_exp2f(b1[r]); psA += a1[r]; psB += b1[r]; }
            { auto rr = __builtin_amdgcn_permlane32_swap(__float_as_uint(psA), __float_as_uint(psA), false, false); psA = __uint_as_float(rr[0]) + __uint_as_float(rr[1]); }
            { auto rr = __builtin_amdgcn_permlane32_swap(__float_as_uint(psB), __float_as_uint(psB), false, false); psB = __uint_as_float(rr[0]) + __uint_as_float(rr[1]); }
            l_reg[mA] += psA; if (DIFF) l_reg[mB] += psB; else lB += psB;
            bf16x8 pa[4], pb[4];
#define PK4(P, BASE, OUT) do { unsigned a0_ = cvtpk(P[BASE + 0], P[BASE + 1]), a1_ = cvtpk(P[BASE + 2], P[BASE + 3]);   \
    unsigned b0_ = cvtpk(P[BASE + 4], P[BASE + 5]), b1_ = cvtpk(P[BASE + 6], P[BASE + 7]);                              \
    auto r0 = __builtin_amdgcn_permlane32_swap(a0_, b0_, false, false); auto r1 = __builtin_amdgcn_permlane32_swap(a1_, b1_, false, false); \
    u32x4 w = {r0[0], r1[0], r0[1], r1[1]}; OUT = *reinterpret_cast<bf16x8*>(&w); } while (0)
            PK4(a0, 0, pa[0]); PK4(b0, 0, pb[0]); PK4(a0, 8, pa[1]); PK4(b0, 8, pb[1]); PK4(a1, 0, pa[2]); PK4(b1, 0, pb[2]); PK4(a1, 8, pa[3]); PK4(b1, 8, pb[3]);
#undef PK4
#define PKV(L, H) (bf16x8){L[0], L[1], L[2], L[3], H[0], H[1], H[2], H[3]}
#define PVB(D0B) { const int va_ = vb + tA * 8192, vbb_ = vb + tB * 8192; f32x16& accA = o[mA][D0B]; f32x16& accB = DIFF ? o[mB][D0B] : oB[D0B]; \
              const s16x4 l0 = tr_read<v_rd_off(D0B, 0, 0)>(va_), h0 = tr_read<v_rd_off(D0B, 0, 1)>(va_), l1 = tr_read<v_rd_off(D0B, 1, 0)>(va_), h1 = tr_read<v_rd_off(D0B, 1, 1)>(va_); \
              const s16x4 l2 = tr_read<v_rd_off(D0B, 2, 0)>(va_), h2 = tr_read<v_rd_off(D0B, 2, 1)>(va_), l3 = tr_read<v_rd_off(D0B, 3, 0)>(va_), h3 = tr_read<v_rd_off(D0B, 3, 1)>(va_); \
              if (DIFF) { asm volatile("s_waitcnt lgkmcnt(0)" ::: "memory"); __builtin_amdgcn_sched_barrier(0); \
                  accA = __builtin_amdgcn_mfma_f32_32x32x16_bf16(pa[0], PKV(l0, h0), accA, 0, 0, 0); accB = __builtin_amdgcn_mfma_f32_32x32x16_bf16(pb[0], PKV(l0, h0), accB, 0, 0, 0); \
                  accA = __builtin_amdgcn_mfma_f32_32x32x16_bf16(pa[1], PKV(l1, h1), accA, 0, 0, 0); accB = __builtin_amdgcn_mfma_f32_32x32x16_bf16(pb[1], PKV(l1, h1), accB, 0, 0, 0); \
                  accA = __builtin_amdgcn_mfma_f32_32x32x16_bf16(pa[2], PKV(l2, h2), accA, 0, 0, 0); accB = __builtin_amdgcn_mfma_f32_32x32x16_bf16(pb[2], PKV(l2, h2), accB, 0, 0, 0); \
                  accA = __builtin_amdgcn_mfma_f32_32x32x16_bf16(pa[3], PKV(l3, h3), accA, 0, 0, 0); accB = __builtin_amdgcn_mfma_f32_32x32x16_bf16(pb[3], PKV(l3, h3), accB, 0, 0, 0); } \
              else { const s16x4 m0 = tr_read<v_rd_off(D0B, 0, 0)>(vbb_), n0 = tr_read<v_rd_off(D0B, 0, 1)>(vbb_), m1 = tr_read<v_rd_off(D0B, 1, 0)>(vbb_), n1 = tr_read<v_rd_off(D0B, 1, 1)>(vbb_); \
                  const s16x4 m2 = tr_read<v_rd_off(D0B, 2, 0)>(vbb_), n2 = tr_read<v_rd_off(D0B, 2, 1)>(vbb_), m3 = tr_read<v_rd_off(D0B, 3, 0)>(vbb_), n3 = tr_read<v_rd_off(D0B, 3, 1)>(vbb_); \
                  asm volatile("s_waitcnt lgkmcnt(0)" ::: "memory"); __builtin_amdgcn_sched_barrier(0); \
                  accA = __builtin_amdgcn_mfma_f32_32x32x16_bf16(pa[0], PKV(l0, h0), accA, 0, 0, 0); accB = __builtin_amdgcn_mfma_f32_32x32x16_bf16(pb[0], PKV(m0, n0), accB, 0, 0, 0); \
                  accA = __builtin_amdgcn_mfma_f32_32x32x16_bf16(pa[1], PKV(l1, h1), accA, 0, 0, 0); accB = __builtin_amdgcn_mfma_f32_32x32x16_bf16(pb[1], PKV(m1, n1), accB, 0, 0, 0); \
                  accA = __builtin_amdgcn_mfma_f32_32x32x16_bf16(pa[2], PKV(l2, h2), accA, 0, 0, 0); accB = __builtin_amdgcn_mfma_f32_32x32x16_bf16(pb[2], PKV(m2, n2), accB, 0, 0, 0); \
                  accA = __builtin_amdgcn_mfma_f32_32x32x16_bf16(pa[3], PKV(l3, h3), accA, 0, 0, 0); accB = __builtin_amdgcn_mfma_f32_32x32x16_bf16(pb[3], PKV(m3, n3), accB, 0, 0, 0); } }
            PVB(0) PVB(1)
#undef PVB
#undef PKV
        }
#undef KFR
    }
#undef ADMA
    if (!DIFF) {
#pragma unroll
        for (int d = 0; d < 2; ++d)
#pragma unroll
            for (int r = 0; r < 16; ++r) o[0][d][r] += oB[d][r];
        l_reg[0] += lB; }
    float rli[NMAP][16];
#pragma unroll
    for (int m = 0; m < NMAP; ++m) {
        asm volatile("s_waitcnt lgkmcnt(0)" ::: "memory");
        if (hi == 0) wsl[r32] = l_reg[m];
        asm volatile("s_waitcnt lgkmcnt(0)" ::: "memory");
#pragma unroll
        for (int r = 0; r < 16; ++r) rli[m][r] = __builtin_amdgcn_rcpf(wsl[crow(r, hi)]);
    }
    const int orow0 = qrow0 + wid * 32;
    if (!DIFF) {
#pragma unroll
        for (int r = 0; r < 16; ++r) { bf16_t* dst = C_HB + (size_t)(orow0 + crow(r, hi)) * D + 512 + hd * 64 + r32;
            dst[0] = f2bf(o[0][0][r] * rli[0][r]); dst[32] = f2bf(o[0][1][r] * rli[0][r]); }
    } else {
        const float* lp = CIN(19) + l * 128; const float* gn = CIN(20) + l * 64; asm volatile("" : "+s"(lp), "+s"(gn));
        float s1 = 0.f, s2 = 0.f;
        for (int i = 0; i < 32; ++i) { s1 += lp[i] * lp[32 + i]; s2 += lp[64 + i] * lp[96 + i]; }
        const float lam_init = (l == 0) ? 0.2f : 0.35550906759097f;
        const float lam = __expf(s1) - __expf(s2) + lam_init;
        const float g0 = gn[r32] * (1.f - lam_init), g1 = gn[32 + r32] * (1.f - lam_init);
#pragma unroll
        for (int r = 0; r < 16; ++r) {
            const float v0 = o[0][0][r] * rli[0][r] - lam * o[NMAP - 1][0][r] * rli[NMAP - 1][r];
            const float v1 = o[0][1][r] * rli[0][r] - lam * o[NMAP - 1][1][r] * rli[NMAP - 1][r];
            float ss = v0 * v0 + v1 * v1;
            ss += shx(ss, 1, lane); ss += shx(ss, 2, lane); ss += shx(ss, 4, lane); ss += shx(ss, 8, lane); ss += shx(ss, 16, lane);
            const float rstd = rsqrtf(ss * (1.f / 64.f) + NORM_EPS);
            bf16_t* dst = C_HB + (size_t)(orow0 + crow(r, hi)) * D + 768 + hd * 64 + r32;
            dst[0] = f2bf(v0 * rstd * g0); dst[32] = f2bf(v1 * rstd * g1); }
    }
    int* flag = (int*)(lds + 2 * ATT_STAGE + 8 * 64 * 4);
    __syncthreads();
    if (tid == 0) *flag = 0;
    __syncthreads();
    if (!(l_reg[0] <= ATT_ZBIG && l_reg[0] >= ATT_ZSMALL) || !(l_reg[NMAP - 1] <= ATT_ZBIG && l_reg[NMAP - 1] >= ATT_ZSMALL)) *flag = 1;
    __syncthreads();
    const bool redo = *flag != 0;
    __syncthreads();
    return redo;
}
template <int G, int I>
__device__ __forceinline__ void att_microop(f32x16& p0, f32x16& p1, float& ps, bf16x8 (&pa)[4]) {
    f32x16& P = (G < 2) ? p0 : p1; constexpr int B = (G & 1) * 8;
    if constexpr (I < 4) { constexpr int r = B + 2 * I;
        P[r] = __builtin_amdgcn_exp2f(P[r]); P[r + 1] = __builtin_amdgcn_exp2f(P[r + 1]); ps += P[r]; ps += P[r + 1]; }
    else { const unsigned a0 = cvtpk(P[B + 0], P[B + 1]), a1 = cvtpk(P[B + 2], P[B + 3]), b0 = cvtpk(P[B + 4], P[B + 5]), b1 = cvtpk(P[B + 6], P[B + 7]);
        auto r0 = __builtin_amdgcn_permlane32_swap(a0, b0, false, false); auto r1 = __builtin_amdgcn_permlane32_swap(a1, b1, false, false);
        u32x4 w = {r0[0], r1[0], r0[1], r1[1]}; pa[G] = *reinterpret_cast<bf16x8*>(&w); }
}
template <int GB, int S, int NSL>
__device__ __forceinline__ void att_slot_ops(f32x16& p0, f32x16& p1, float& ps, bf16x8 (&pa)[4]) {
#define MOP(m) if constexpr (((m) * NSL) / 10 == S) att_microop<GB + (m) / 5, (m) % 5>(p0, p1, ps, pa);
    MOP(0) MOP(1) MOP(2) MOP(3) MOP(4) MOP(5) MOP(6) MOP(7) MOP(8) MOP(9)
#undef MOP
}
template <bool DIFF>
__device__ bool attn_item_fast(const Ctx& c, int l, int b, int hd, int qrow0, int krow0, int nkeys, char* lds) {
    constexpr int DQK = DIFF ? 32 : 96, NMAP = DIFF ? 2 : 1, ND0 = DQK / 16, NU = 2 * NMAP, NA = 2 * ND0;
    constexpr int KP = DIFF ? 64 : 256, KSZ = 64 * KP;
    const int tid_ = mk_tid(c.wid);
    const int tid = tid_, lane = tid_ & 63, wid = c.wid, r32 = lane & 31, hi = lane >> 5;
    char* K_lds0 = lds; char* V_lds0 = lds + 2 * 16384; float* wsl = (float*)(lds + 2 * ATT_STAGE) + wid * 64;
    bf16x8 qr[NMAP][ND0];
    { const int qrow = qrow0 + wid * 32 + r32;
#pragma unroll
        for (int m = 0; m < NMAP; ++m)
#pragma unroll
            for (int d0 = 0; d0 < ND0; ++d0) {
                const bf16_t* p = DIFF ? C_P + (size_t)qrow * INC + DF_Q + (hd * 2 + m) * 32 + d0 * 16 + hi * 8
                                       : C_QM + (size_t)qrow * 384 + hd * 96 + d0 * 16 + hi * 8;
                qr[m][d0] = *(const bf16x8*)p; } }
    f32x16 o[NMAP][2]; float m_reg[NMAP], l_reg[NMAP];
#pragma unroll
    for (int m = 0; m < NMAP; ++m) { m_reg[m] = 0.f; l_reg[m] = 0.f;
#pragma unroll
        for (int d = 0; d < 2; ++d) zero_acc(o[m][d]); }
    constexpr int NKP = DIFF ? 2 : 4;
    int ksrc[NKP], vsrc[2];
#pragma unroll
    for (int q = 0; q < NKP; ++q) { const int off = (wid * NKP + q) * 1024 + lane * 16;
        if (DIFF) { const int blk = off >> 12, key = (off & 4095) >> 6, slot = (off & 63) >> 4, ch = slot ^ ((key >> 2) & 3);
            ksrc[q] = ((blk >> 1) * 64 + key) * INC + DF_K + (hd * 2 + (blk & 1)) * 32 + ch * 8; }
        else { const int tile = off >> 14, key = (off & 16383) >> 8, slot = (off & 255) >> 4, ch = slot ^ (key & 7);
            ksrc[q] = ch < 8 ? -1 - ((tile * 64 + key) * 512 + hd * 128 + ch * 8) : (ch < 12 ? (tile * 64 + key) * INC + MLA_KR + (ch - 8) * 8 : (int)0x80000000); } }
#pragma unroll
    for (int q = 0; q < 2; ++q) { const int off = (wid * 2 + q) * 1024 + lane * 16; const int tile = off >> 13, w = off & 8191;
        const int sub = w >> 9, within = w & 511; const int kk = (sub >> 1) * 8 + (within >> 6); const int col = (sub & 1) * 32 + ((within & 63) >> 1);
        const int key = (kk & ~0xC) | ((kk & 4) << 1) | ((kk & 8) >> 1);
        vsrc[q] = DIFF ? (tile * 64 + key) * INC + DF_V + hd * 64 + col : (tile * 64 + key) * 512 + hd * 128 + 64 + col; }
    const int vb0 = (int)(uintptr_t)V_lds0 + v_rd_base(lane);
#define ADMA(buf, kr) do { \
        _Pragma("unroll") for (int q = 0; q < NKP; ++q) { LAS unsigned* dst_ = (LAS unsigned*)(LAS char*)(K_lds0 + (buf) * ATT_STAGE + (wid * NKP + q) * 1024); \
            if (DIFF || ksrc[q] >= 0) __builtin_amdgcn_global_load_lds((const unsigned*)(C_P + (size_t)(kr) * INC + ksrc[q]), dst_, 16, 0, 0); \
            else if (ksrc[q] != (int)0x80000000) __builtin_amdgcn_global_load_lds((const unsigned*)(C_KVM + (size_t)(kr) * 512 + (-1 - ksrc[q])), dst_, 16, 0, 0); } \
        _Pragma("unroll") for (int q = 0; q < 2; ++q) { LAS unsigned* dst_ = (LAS unsigned*)(LAS char*)(V_lds0 + (buf) * ATT_STAGE + (wid * 2 + q) * 1024); \
            __builtin_amdgcn_global_load_lds((const unsigned*)((DIFF ? C_P + (size_t)(kr) * INC : C_KVM + (size_t)(kr) * 512) + vsrc[q]), dst_, 16, 0, 0); } } while (0)
#define SB() __builtin_amdgcn_sched_barrier(0)
    const int NS = nkeys >> 7;
    ADMA(0, krow0);
    float bad = 0.f;
    for (int j = 0; j < NS; ++j) {
        asm volatile("s_waitcnt vmcnt(0)" ::: "memory");
        __syncthreads();
        if (j + 1 < NS) ADMA((j + 1) & 1, krow0 + (j + 1) * 128);
        const char* K_lds = K_lds0 + (j & 1) * ATT_STAGE; const int vb = vb0 + (j & 1) * ATT_STAGE;
        f32x16 p0[2], p1[2]; bf16x8 pa[2][4]; float ps[2]; bf16x8 kfw[3];
#define KFRAG(u, d0, h) (*(const bf16x8*)(K_lds + (((u) / NMAP) * NMAP + ((u) % NMAP)) * KSZ + \
            (DIFF ? (((h) * 32 + r32) * 64 + ((((d0) * 2 + hi) ^ ((((h) * 32 + r32) >> 2) & 3)) << 4)) : (((h) * 32 + r32) * 256 + (((d0) * 32 + hi * 16) ^ ((((h) * 32 + r32) & 7) << 4))))))
#define QMFMA(u, s, frag) do { constexpr int d0_ = (s) >> 1, m_ = (u) % NMAP; f32x16& acc_ = ((s) & 1) ? p1[(u) & 1] : p0[(u) & 1]; \
            if (d0_ == 0) { const float nm_ = -m_reg[m_]; const f32x16 z = {nm_,nm_,nm_,nm_,nm_,nm_,nm_,nm_,nm_,nm_,nm_,nm_,nm_,nm_,nm_,nm_}; acc_ = __builtin_amdgcn_mfma_f32_32x32x16_bf16(frag, qr[m_][0], z, 0, 0, 0); } \
            else acc_ = __builtin_amdgcn_mfma_f32_32x32x16_bf16(frag, qr[m_][d0_], acc_, 0, 0, 0); } while (0)
        if (j == 0) {
#pragma unroll
            for (int m = 0; m < NMAP; ++m) {
#pragma unroll
                for (int d0 = 0; d0 < ND0; ++d0) { const bf16x8 f0 = KFRAG(m, d0, 0), f1 = KFRAG(m, d0, 1);
                    if (d0 == 0) { const f32x16 z = {0.f,0.f,0.f,0.f,0.f,0.f,0.f,0.f,0.f,0.f,0.f,0.f,0.f,0.f,0.f,0.f};
                        p0[0] = __builtin_amdgcn_mfma_f32_32x32x16_bf16(f0, qr[m][0], z, 0, 0, 0); p1[0] = __builtin_amdgcn_mfma_f32_32x32x16_bf16(f1, qr[m][0], z, 0, 0, 0); }
                    else { p0[0] = __builtin_amdgcn_mfma_f32_32x32x16_bf16(f0, qr[m][d0], p0[0], 0, 0, 0); p1[0] = __builtin_amdgcn_mfma_f32_32x32x16_bf16(f1, qr[m][d0], p1[0], 0, 0, 0); } }
                m_reg[m] = rowmax_tile(p0[0], p1[0]); }
        }
        {
#pragma unroll
            for (int sidx = 0; sidx < NA; ++sidx) { const bf16x8 f = (sidx & 1) ? KFRAG(0, sidx >> 1, 1) : KFRAG(0, sidx >> 1, 0);
                if (sidx == 0) QMFMA(0, 0, f); else if (sidx == 1) QMFMA(0, 1, f); else if (sidx == 2) QMFMA(0, 2, f); else if (sidx == 3) QMFMA(0, 3, f);
                else if (sidx == 4) QMFMA(0, 4, f); else if (sidx == 5) QMFMA(0, 5, f); else if (sidx == 6) QMFMA(0, 6, f); else if (sidx == 7) QMFMA(0, 7, f);
                else if (sidx == 8) QMFMA(0, 8, f); else if (sidx == 9) QMFMA(0, 9, f); else if (sidx == 10) QMFMA(0, 10, f); else QMFMA(0, 11, f); }
            ps[0] = 0.f;
            att_slot_ops<0, 0, 1>(p0[0], p1[0], ps[0], pa[0]);
            SB();
        }
#define STEP(u) do { constexpr int m_ = (u) % NMAP, tt_ = (u) / NMAP; constexpr bool nxt_ = ((u) + 1 < NU); \
              \
            if (nxt_) { ps[((u) + 1) & 1] = 0.f; kfw[0] = KFRAG((u) + 1, 0, 0); kfw[1] = KFRAG((u) + 1, 0, 1); \
                PHA(u, 0) PHA(u, 1) PHA(u, 2) PHA(u, 3) if (NA > 4) { PHA(u, 4) PHA(u, 5) PHA(u, 6) PHA(u, 7) PHA(u, 8) PHA(u, 9) PHA(u, 10) PHA(u, 11) } } \
            else { att_slot_ops<2, 0, 1>(p0[(u) & 1], p1[(u) & 1], ps[(u) & 1], pa[(u) & 1]); SB(); } \
            { float t_ = ps[(u) & 1]; auto rr = __builtin_amdgcn_permlane32_swap(__float_as_uint(t_), __float_as_uint(t_), false, false); t_ = __uint_as_float(rr[0]) + __uint_as_float(rr[1]); \
              l_reg[m_] += t_; bad = fmaxf(bad, t_); } \
              \
            PHB(u, 0) PHB(u, 1) } while (0)
#define PHA(u, s) { if ((s) < NA) { if ((s) + 2 < NA) kfw[((s) + 2) % 3] = (((s) + 2) & 1) ? KFRAG((u) + 1, ((s) + 2) >> 1, 1) : KFRAG((u) + 1, ((s) + 2) >> 1, 0); \
              QMFMA((u) + 1, (s), kfw[(s) % 3]); \
              att_slot_ops<2, (s), NA>(p0[(u) & 1], p1[(u) & 1], ps[(u) & 1], pa[(u) & 1]); SB(); } }
#define PHB(u, d0b) { const int vbb_ = vb + ((u) / NMAP) * 8192; \
              const s16x4 l0 = tr_read<v_rd_off(d0b, 0, 0)>(vbb_), h0 = tr_read<v_rd_off(d0b, 0, 1)>(vbb_), l1 = tr_read<v_rd_off(d0b, 1, 0)>(vbb_), h1 = tr_read<v_rd_off(d0b, 1, 1)>(vbb_); \
              const s16x4 l2 = tr_read<v_rd_off(d0b, 2, 0)>(vbb_), h2 = tr_read<v_rd_off(d0b, 2, 1)>(vbb_), l3 = tr_read<v_rd_off(d0b, 3, 0)>(vbb_), h3 = tr_read<v_rd_off(d0b, 3, 1)>(vbb_); \
              asm volatile("s_waitcnt lgkmcnt(0)" ::: "memory"); SB(); \
              f32x16& od_ = o[(u) % NMAP][d0b]; \
              od_ = __builtin_amdgcn_mfma_f32_32x32x16_bf16(pa[(u) & 1][0], PKV(l0, h0), od_, 0, 0, 0); if ((u) + 1 < NU) att_slot_ops<0, (d0b) * 4 + 0, 8>(p0[((u) + 1) & 1], p1[((u) + 1) & 1], ps[((u) + 1) & 1], pa[((u) + 1) & 1]); SB(); \
              od_ = __builtin_amdgcn_mfma_f32_32x32x16_bf16(pa[(u) & 1][1], PKV(l1, h1), od_, 0, 0, 0); if ((u) + 1 < NU) att_slot_ops<0, (d0b) * 4 + 1, 8>(p0[((u) + 1) & 1], p1[((u) + 1) & 1], ps[((u) + 1) & 1], pa[((u) + 1) & 1]); SB(); \
              od_ = __builtin_amdgcn_mfma_f32_32x32x16_bf16(pa[(u) & 1][2], PKV(l2, h2), od_, 0, 0, 0); if ((u) + 1 < NU) att_slot_ops<0, (d0b) * 4 + 2, 8>(p0[((u) + 1) & 1], p1[((u) + 1) & 1], ps[((u) + 1) & 1], pa[((u) + 1) & 1]); SB(); \
              od_ = __builtin_amdgcn_mfma_f32_32x32x16_bf16(pa[(u) & 1][3], PKV(l3, h3), od_, 0, 0, 0); if ((u) + 1 < NU) att_slot_ops<0, (d0b) * 4 + 3, 8>(p0[((u) + 1) & 1], p1[((u) + 1) & 1], ps[((u) + 1) & 1], pa[((u) + 1) & 1]); SB(); }
#define PKV(L, H) (bf16x8){L[0], L[1], L[2], L[3], H[0], H[1], H[2], H[3]}
        STEP(0); STEP(1);
        if (NU > 2) { STEP(2 % NU); STEP(3 % NU); }
#undef PKV
#undef PHB
#undef PHA
#undef STEP
#undef QMFMA
#undef KFRAG
    }
#undef SB
#undef ADMA
    float rli[NMAP][16];
#pragma unroll
    for (int m = 0; m < NMAP; ++m) {
        asm volatile("s_waitcnt lgkmcnt(0)" ::: "memory");
        if (hi == 0) wsl[r32] = l_reg[m];
        asm volatile("s_waitcnt lgkmcnt(0)" ::: "memory");
#pragma unroll
        for (int r = 0; r < 16; ++r) rli[m][r] = __builtin_amdgcn_rcpf(wsl[crow(r, hi)]);
    }
    const int orow0 = qrow0 + wid * 32;
    if (!DIFF) {
#pragma unroll
        for (int r = 0; r < 16; ++r) { bf16_t* dst = C_HB + (size_t)(orow0 + crow(r, hi)) * D + 512 + hd * 64 + r32;
            dst[0] = f2bf(o[0][0][r] * rli[0][r]); dst[32] = f2bf(o[0][1][r] * rli[0][r]); }
    } else {
        const float* lp = CIN(19) + l * 128; const float* gn = CIN(20) + l * 64; asm volatile("" : "+s"(lp), "+s"(gn));
        float s1 = 0.f, s2 = 0.f;
        for (int i = 0; i < 32; ++i) { s1 += lp[i] * lp[32 + i]; s2 += lp[64 + i] * lp[96 + i]; }
        const float lam_init = (l == 0) ? 0.2f : 0.35550906759097f;
        const float lam = __expf(s1) - __expf(s2) + lam_init;
        const float g0 = gn[r32] * (1.f - lam_init), g1 = gn[32 + r32] * (1.f - lam_init);
#pragma unroll
        for (int r = 0; r < 16; ++r) {
            const float v0 = o[0][0][r] * rli[0][r] - lam * o[NMAP - 1][0][r] * rli[NMAP - 1][r];
            const float v1 = o[0][1][r] * rli[0][r] - lam * o[NMAP - 1][1][r] * rli[NMAP - 1][r];
            float ss = v0 * v0 + v1 * v1;
            ss += shx(ss, 1, lane); ss += shx(ss, 2, lane); ss += shx(ss, 4, lane); ss += shx(ss, 8, lane); ss += shx(ss, 16, lane);
            const float rstd = rsqrtf(ss * (1.f / 64.f) + NORM_EPS);
            bf16_t* dst = C_HB + (size_t)(orow0 + crow(r, hi)) * D + 768 + hd * 64 + r32;
            dst[0] = f2bf(v0 * rstd * g0); dst[32] = f2bf(v1 * rstd * g1); }
    }
    int* flag = (int*)(lds + 2 * ATT_STAGE + 8 * 64 * 4);
    __syncthreads();
    if (tid == 0) *flag = 0;
    __syncthreads();
    if (!(bad <= ATT_BIG)) *flag = 1;
    __syncthreads();
    const bool redo = *flag != 0;
    __syncthreads();
    return redo;
}
#ifndef PAIR_DIFF
#define PAIR_DIFF 1
#endif
#ifndef PAIR_MLA
#define PAIR_MLA 1
#endif
__device__ void ph_attn(const Ctx& c, int l, char* lds) {
    const bool need_ctx = (l < DEPTH - 1);
    const int nitem = 1024 + (need_ctx ? 32 : 0);
    for (int it = blockIdx.x; it < nitem; it += gridDim.x) {
        bool diff; int b, hd, q0, k0, nk;
        if (it < 1024) { const int u = it & 511; diff = it < 512; b = u >> 7; hd = (u >> 5) & 3; q0 = b * RPB + CTX + (u & 31) * 256; k0 = b * RPB; nk = RPB; }
        else { const int u = it - 1024; diff = u < 16; b = u & 3; hd = (u >> 2) & 3; q0 = b * RPB; k0 = b * RPB; nk = CTX; }
#if PAIR_DIFF
        if (diff) { if (attn_item_pair<true>(c, l, b, hd, q0, k0, nk, lds)) attn_item<true>(c, l, b, hd, q0, k0, nk, lds); }
#else
        if (diff) attn_item<true>(c, l, b, hd, q0, k0, nk, lds);
#endif
#if PAIR_MLA
        else { if (attn_item_pair<false>(c, l, b, hd, q0, k0, nk, lds)) attn_item<false>(c, l, b, hd, q0, k0, nk, lds); }
#else
        else { if (attn_item_fast<false>(c, l, b, hd, q0, k0, nk, lds)) attn_item<false>(c, l, b, hd, q0, k0, nk, lds); }
#endif
    }
}

typedef float f32v2 __attribute__((ext_vector_type(2)));
__device__ void cvt_tables(const Ctx& c, int l) {
    for (int row = blockIdx.x * 8 + c.wid; row < 2 * NEXP; row += gridDim.x * 8) {
        const bool isu = row < NEXP; const int e = isu ? row : row - NEXP;
        const float* s = CIN(isu ? 23 : 24) + ((size_t)l * NEXP + e) * D + c.lane * 16;
        f32x4 v[4]; float mx = 0.f;
#pragma unroll
        for (int i = 0; i < 4; ++i) { v[i] = *(const f32x4*)(s + 4 * i); mx = fmaxf(mx, fmaxf(fmaxf(fabsf(v[i][0]), fabsf(v[i][1])), fmaxf(fabsf(v[i][2]), fabsf(v[i][3])))); }
#pragma unroll
        for (int o = 32; o >= 1; o >>= 1) mx = fmaxf(mx, __shfl_xor(mx, o, 64));
        const float q = mx > 0.f ? 256.f / mx : 0.f;
        if (c.lane == 0) (isu ? C_SU : C_SV)[e] = mx * (1.f / 256.f);
        u32x4 w;
#pragma unroll
        for (int i = 0; i < 4; ++i) { int p = 0; p = __builtin_amdgcn_cvt_pk_fp8_f32(v[i][0] * q, v[i][1] * q, p, false); p = __builtin_amdgcn_cvt_pk_fp8_f32(v[i][2] * q, v[i][3] * q, p, true); w[i] = (unsigned)p; }
        *(u32x4*)((isu ? C_TU8 : C_TV8) + ((size_t)(c.lane >> 3) * NEXP + e) * 128 + (c.lane & 7) * 16) = w;
    }
}
__device__ __forceinline__ unsigned ford(float x) { const unsigned u = __float_as_uint(x); return (u & 0x80000000u) ? ~u : (u | 0x80000000u); }
__device__ __forceinline__ float funord(unsigned k) { const unsigned u = (k & 0x80000000u) ? (k & 0x7fffffffu) : ~k; return __uint_as_float(u); }
__device__ __forceinline__ void sort16_desc(unsigned (&v)[16]) {
#pragma unroll
    for (int k = 2; k <= 16; k <<= 1)
#pragma unroll
        for (int j = k >> 1; j > 0; j >>= 1)
#pragma unroll
            for (int i = 0; i < 16; ++i) { const int l = i ^ j; if (l > i) { const unsigned a = v[i], b = v[l]; const unsigned hi = max(a, b), lo = min(a, b);
                if ((i & k) == 0) { v[i] = hi; v[l] = lo; } else { v[i] = lo; v[l] = hi; } } }
}
__device__ __forceinline__ void merge16_desc(unsigned (&t)[16], const unsigned (&v)[16]) {
#pragma unroll
    for (int i = 0; i < 16; ++i) t[i] = max(t[i], v[15 - i]);
#pragma unroll
    for (int j = 8; j > 0; j >>= 1)
#pragma unroll
        for (int i = 0; i < 16; ++i) { const int l = i ^ j; if (l > i) { const unsigned a = t[i], b = t[l]; t[i] = max(a, b); t[l] = min(a, b); } }
}
constexpr int TOPK_LDS = 2 * 128 * 129 * 4;
__device__ void peer_topk_item(const Ctx& c, int l, int tm, int h, char* lds) {
    float* S = (float*)lds;
    const int tid = c.tid, lane = c.lane, wid = c.wid, r32 = lane & 31, hi = lane >> 5, wm = wid >> 1, wn = wid & 1;
    const int row0 = tm * 128;
    bf16x8 fa[2][8];
#pragma unroll
    for (int p = 0; p < 2; ++p) { const bf16_t* Ap = C_Q2 + (size_t)(row0 + wm * 32 + r32) * 2048 + h * 256 + p * 128 + hi * 8;
#pragma unroll
        for (int ks = 0; ks < 8; ++ks) fa[p][ks] = *(const bf16x8*)(Ap + ks * 16); }
#pragma unroll
    for (int p = 0; p < 2; ++p) {
        f32x16 acc[2];
        zero_acc(acc[0]); zero_acc(acc[1]);
        const bf16_t* Bp = C_KEYS + ((((size_t)l * 8 + h) * 2 + p) * 128 + wn * 64 + r32) * 128 + hi * 8;
        bf16x8 fb0[8], fb1[8];
#pragma unroll
        for (int ks = 0; ks < 8; ++ks) { fb0[ks] = *(const bf16x8*)(Bp + ks * 16); fb1[ks] = *(const bf16x8*)(Bp + 32 * 128 + ks * 16); }
        asm volatile("" : "+v"(fa[p][0]), "+v"(fa[p][1]), "+v"(fa[p][2]), "+v"(fa[p][3]), "+v"(fa[p][4]), "+v"(fa[p][5]), "+v"(fa[p][6]), "+v"(fa[p][7]));
        asm volatile("" : "+v"(fb0[0]), "+v"(fb0[1]), "+v"(fb0[2]), "+v"(fb0[3]), "+v"(fb0[4]), "+v"(fb0[5]), "+v"(fb0[6]), "+v"(fb0[7]));
        asm volatile("" : "+v"(fb1[0]), "+v"(fb1[1]), "+v"(fb1[2]), "+v"(fb1[3]), "+v"(fb1[4]), "+v"(fb1[5]), "+v"(fb1[6]), "+v"(fb1[7]));
#pragma unroll
        for (int ks = 0; ks < 8; ++ks) {
            acc[0] = __builtin_amdgcn_mfma_f32_32x32x16_bf16(fa[p][ks], fb0[ks], acc[0], 0, 0, 0);
            acc[1] = __builtin_amdgcn_mfma_f32_32x32x16_bf16(fa[p][ks], fb1[ks], acc[1], 0, 0, 0);
        }
#pragma unroll
        for (int n = 0; n < 2; ++n)
#pragma unroll
            for (int r = 0; r < 16; ++r) S[(p * 128 + wm * 32 + crow(r, hi)) * 129 + wn * 64 + n * 32 + r32] = acc[n][r];
    }
    __syncthreads();
    unsigned tk[16];
    { const int list = tid >> 1, half = tid & 1; const float* sr = S + list * 129 + half * 64;
#pragma unroll
        for (int g = 0; g < 4; ++g) { unsigned v[16];
#pragma unroll
            for (int i = 0; i < 16; ++i) { const int n = half * 64 + g * 16 + i; v[i] = (ford(sr[g * 16 + i]) & ~127u) | (unsigned)(127 - n); }
            sort16_desc(v);
            if (g == 0) {
#pragma unroll
                for (int i = 0; i < 16; ++i) tk[i] = v[i]; }
            else merge16_desc(tk, v); } }
    __syncthreads();
    unsigned* X = (unsigned*)lds;
    unsigned* L = X + 256 * 17;
    if (tid & 1) {
#pragma unroll
        for (int i = 0; i < 16; ++i) X[(tid >> 1) * 17 + i] = tk[i]; }
    __syncthreads();
    if (!(tid & 1)) { unsigned v[16];
#pragma unroll
        for (int i = 0; i < 16; ++i) v[i] = X[(tid >> 1) * 17 + i];
        merge16_desc(tk, v);
#pragma unroll
        for (int i = 0; i < 16; ++i) L[(tid >> 1) * 17 + i] = tk[i]; }
    __syncthreads();
    unsigned bk[16];
    const int row = (tid >> 1) & 127, hh = tid & 1;
    const unsigned* l0 = L + row * 17; const unsigned* l1 = L + (128 + row) * 17;
    if (tid < 256) {
        float s0[8], s1[16];
#pragma unroll
        for (int ii = 0; ii < 8; ++ii) s0[ii] = funord(l0[2 * ii + hh] & ~127u);
#pragma unroll
        for (int j = 0; j < 16; ++j) s1[j] = funord(l1[j] & ~127u);
        unsigned ck[32];
        { int slot = 0;
#pragma unroll
            for (int ii = 0; ii < 8; ++ii)
#pragma unroll
                for (int j = 0; j < 16; ++j) if ((2 * ii + 1) * (j + 1) <= 16) {
                    const int i = 2 * ii + hh; const bool ok = (i + 1) * (j + 1) <= 16;
                    const unsigned key = (ford(s0[ii] + s1[j]) & ~255u) | (unsigned)(255 - (i * 16 + j));
                    ck[slot] = ok ? key : 0u; ++slot; }
#pragma unroll
            for (; slot < 32; ++slot) ck[slot] = 0u; }
        unsigned v0[16], v1[16];
#pragma unroll
        for (int i = 0; i < 16; ++i) { v0[i] = ck[i]; v1[i] = ck[16 + i]; }
        sort16_desc(v0); sort16_desc(v1);
        merge16_desc(v0, v1);
#pragma unroll
        for (int i = 0; i < 16; ++i) bk[i] = v0[i];
    }
    __syncthreads();
    if (tid < 256 && hh) {
#pragma unroll
        for (int i = 0; i < 16; ++i) X[row * 17 + i] = bk[i]; }
    __syncthreads();
    if (tid < 256 && !hh) { unsigned v[16];
#pragma unroll
        for (int i = 0; i < 16; ++i) v[i] = X[row * 17 + i];
        merge16_desc(bk, v);
        float best[16]; int eid[16]; float mx = -1e30f;
#pragma unroll
        for (int q = 0; q < 16; ++q) { const int ij = 255 - (int)(bk[q] & 255u); const int i = ij >> 4, j = ij & 15;
            const unsigned k0 = l0[i], k1 = l1[j];
            best[q] = funord(k0 & ~127u) + funord(k1 & ~127u);
            eid[q] = (127 - (int)(k0 & 127u)) * 128 + (127 - (int)(k1 & 127u));
            mx = fmaxf(mx, best[q]); }
        float sum = 0.f;
#pragma unroll
        for (int q = 0; q < 16; ++q) { best[q] = __expf(best[q] - mx); sum += best[q]; }
        const float inv = 1.f / sum;
        const size_t o = (size_t)(row0 + row) * 128 + h * 16;
#pragma unroll
        for (int q = 0; q < 16; q += 4) { *(u32x4*)(C_EI + o + q) = (u32x4){(unsigned)eid[q], (unsigned)eid[q + 1], (unsigned)eid[q + 2], (unsigned)eid[q + 3]};
            *(f32x4*)(C_EG + o + q) = (f32x4){best[q] * inv, best[q + 1] * inv, best[q + 2] * inv, best[q + 3] * inv}; }
    }
    __syncthreads();
}
__device__ __forceinline__ float gelu_tanh(float x) { const float u = 0.7978845608028654f * (x + 0.044715f * x * x * x); const float t = 1.f - 2.f / (1.f + __expf(2.f * u)); return 0.5f * x * (1.f + t); }
__device__ __forceinline__ int tok_row(int ti, bool need_ctx) { return need_ctx ? ti : (ti >> 13) * RPB + CTX + (ti & 8191); }
struct PeerTok { u32x4 t[16]; u32x4 xa, xb; f32v2 xv, gv; };
__device__ __forceinline__ void peer_issue(PeerTok& T, const unsigned char* t8, const int* el, const bf16_t* xp, int grp, bool want_x) {
#pragma unroll
    for (int u = 0; u < 16; ++u) { const int e = el[u * 8 + grp]; T.t[u] = *(const u32x4*)(t8 + (size_t)e * 128); }
    if (want_x) { T.xa = *(const u32x4*)xp; T.xb = *(const u32x4*)(xp + 8); }
}
__device__ __forceinline__ void peer_u_compute(const PeerTok& T, float* pp, int sub, int grp, int lane) {
    f32v2 x2[8];
#pragma unroll
    for (int q = 0; q < 4; ++q) { x2[q] = (f32v2){bflo(T.xa[q]), bfhi(T.xa[q])}; x2[4 + q] = (f32v2){bflo(T.xb[q]), bfhi(T.xb[q])}; }
    float keep[2];
#pragma unroll
    for (int hf = 0; hf < 2; ++hf) {
        float a[8];
#pragma unroll
        for (int u = 0; u < 8; ++u) { f32v2 s2 = {0.f, 0.f};
#pragma unroll
            for (int q = 0; q < 4; ++q) { const unsigned w = T.t[hf * 8 + u][q];
                s2 = __builtin_elementwise_fma(__builtin_amdgcn_cvt_pk_f32_fp8(w, false), x2[2 * q], s2);
                s2 = __builtin_elementwise_fma(__builtin_amdgcn_cvt_pk_f32_fp8(w, true), x2[2 * q + 1], s2); }
            a[u] = s2[0] + s2[1]; }
        const bool b2 = (lane & 4) != 0, b1 = (lane & 2) != 0, b0 = (lane & 1) != 0;
        float r4[4], r2[2];
#pragma unroll
        for (int q = 0; q < 4; ++q) { const float mine = b2 ? a[4 + q] : a[q], oth = b2 ? a[q] : a[4 + q]; r4[q] = mine + __shfl_xor(oth, 4, 64); }
#pragma unroll
        for (int q = 0; q < 2; ++q) { const float mine = b1 ? r4[2 + q] : r4[q], oth = b1 ? r4[q] : r4[2 + q]; r2[q] = mine + __shfl_xor(oth, 2, 64); }
        { const float mine = b0 ? r2[1] : r2[0], oth = b0 ? r2[0] : r2[1]; keep[hf] = mine + __shfl_xor(oth, 1, 64); }
    }
    pp[sub * 8 + grp] = keep[0]; pp[(8 + sub) * 8 + grp] = keep[1];
}
__device__ void peer_u_item(const Ctx& c, int l, int j, int tb, char* lds) {
    const bool need_ctx = (l < DEPTH - 1);
    int* el = (int*)lds + c.wid * 256;
    const int lane = c.lane, sub = lane & 7, grp = lane >> 3;
    const unsigned char* t8 = C_TU8 + (size_t)j * NEXP * 128 + sub * 16;
    const int tok0 = tb * 128 + c.wid * 16;
    const int xoff = j * 128 + sub * 16;
    PeerTok A, B;
    int e0, e1;
    { const int r = tok_row(tok0, need_ctx); e0 = C_EI[(size_t)r * 128 + lane]; e1 = C_EI[(size_t)r * 128 + 64 + lane];
      el[lane] = e0; el[64 + lane] = e1;
      peer_issue(A, t8, el, C_HB + (size_t)r * D + xoff, grp, true);
      const int r1 = tok_row(tok0 + 1, need_ctx); e0 = C_EI[(size_t)r1 * 128 + lane]; e1 = C_EI[(size_t)r1 * 128 + 64 + lane]; }
#pragma unroll 1
    for (int k = 0; k < 16; k += 2) {
        { const int r1 = tok_row(tok0 + k + 1, need_ctx); el[128 + lane] = e0; el[192 + lane] = e1;
          peer_issue(B, t8, el + 128, C_HB + (size_t)r1 * D + xoff, grp, true);
          if (k + 2 < 16) { const int r2 = tok_row(tok0 + k + 2, need_ctx); e0 = C_EI[(size_t)r2 * 128 + lane]; e1 = C_EI[(size_t)r2 * 128 + 64 + lane]; } }
        peer_u_compute(A, C_PART + ((size_t)j * NR + tok_row(tok0 + k, need_ctx)) * 128, sub, grp, lane);
        if (k + 2 < 16) { const int r2 = tok_row(tok0 + k + 2, need_ctx); el[lane] = e0; el[64 + lane] = e1;
          peer_issue(A, t8, el, C_HB + (size_t)r2 * D + xoff, grp, true);
          if (k + 3 < 16) { const int r3 = tok_row(tok0 + k + 3, need_ctx); e0 = C_EI[(size_t)r3 * 128 + lane]; e1 = C_EI[(size_t)r3 * 128 + 64 + lane]; } }
        peer_u_compute(B, C_PART + ((size_t)j * NR + tok_row(tok0 + k + 1, need_ctx)) * 128, sub, grp, lane);
    }
}
__device__ void ph_peer_combine(const Ctx& c, int l) {
    const bool need_ctx = (l < DEPTH - 1);
    const int ntok = need_ctx ? NR : NB * SEQ;
    for (int ti = blockIdx.x * 8 + c.wid; ti < ntok; ti += gridDim.x * 8) {
        const int r = tok_row(ti, need_ctx);
#pragma unroll
        for (int hf = 0; hf < 2; ++hf) { const size_t o = (size_t)r * 128 + hf * 64 + c.lane;
            const int e = C_EI[o]; float sacc = 0.f;
#pragma unroll
            for (int jj = 0; jj < 8; ++jj) sacc += C_PART[((size_t)jj * NR + r) * 128 + hf * 64 + c.lane];
            C_EG[o] = C_EG[o] * gelu_tanh(sacc * C_SU[e]) * C_SV[e]; }
    }
}
__device__ __forceinline__ void peer_v_compute(const PeerTok& T, const float* wl, float* xo, int grp, int lane) {
    f32v2 acc[8];
#pragma unroll
    for (int q = 0; q < 8; ++q) acc[q] = (f32v2){0.f, 0.f};
#pragma unroll
    for (int u = 0; u < 16; ++u) { const float wv = wl[u * 8 + grp]; const f32v2 w2 = {wv, wv};
#pragma unroll
        for (int q = 0; q < 4; ++q) { const unsigned w = T.t[u][q];
            acc[2 * q] = __builtin_elementwise_fma(__builtin_amdgcn_cvt_pk_f32_fp8(w, false), w2, acc[2 * q]);
            acc[2 * q + 1] = __builtin_elementwise_fma(__builtin_amdgcn_cvt_pk_f32_fp8(w, true), w2, acc[2 * q + 1]); } }
    const bool b5 = (lane & 32) != 0, b4 = (lane & 16) != 0, b3 = (lane & 8) != 0;
    f32v2 r4[4], r2[2], r1;
#pragma unroll
    for (int q = 0; q < 4; ++q) { const f32v2 mine = b5 ? acc[4 + q] : acc[q], oth = b5 ? acc[q] : acc[4 + q];
        r4[q] = (f32v2){mine[0] + __shfl_xor(oth[0], 32, 64), mine[1] + __shfl_xor(oth[1], 32, 64)}; }
#pragma unroll
    for (int q = 0; q < 2; ++q) { const f32v2 mine = b4 ? r4[2 + q] : r4[q], oth = b4 ? r4[q] : r4[2 + q];
        r2[q] = (f32v2){mine[0] + __shfl_xor(oth[0], 16, 64), mine[1] + __shfl_xor(oth[1], 16, 64)}; }
    { const f32v2 mine = b3 ? r2[1] : r2[0], oth = b3 ? r2[0] : r2[1]; r1 = (f32v2){mine[0] + __shfl_xor(oth[0], 8, 64), mine[1] + __shfl_xor(oth[1], 8, 64)}; }
    f32v2 xv = T.xv; const f32v2 gv = T.gv;
    xv[0] += gv[0] * r1[0]; xv[1] += gv[1] * r1[1];
    *(f32v2*)xo = xv;
}
__device__ void peer_v_item(const Ctx& c, int l, int j, int tb, char* lds) {
    const bool need_ctx = (l < DEPTH - 1);
    int* el = (int*)lds + c.wid * 512; float* wl = (float*)(el + 256);
    const int lane = c.lane, sub = lane & 7, grp = lane >> 3;
    const unsigned char* t8 = C_TV8 + (size_t)j * NEXP * 128 + sub * 16;
    const int tok0 = tb * 128 + c.wid * 16;
    const int col = j * 128 + sub * 16 + ((lane & 32) ? 8 : 0) + ((lane & 16) ? 4 : 0) + ((lane & 8) ? 2 : 0);
    const float* gate5 = C_MODT + (size_t)l * 5 * 6144 + 5 * D + col;
    PeerTok A, B;
    int e0, e1; float w0, w1;
#define VISSUE(T, tok, eoff) do { const int r_ = tok_row((tok), need_ctx); const int b_ = r_ / RPB; const bool ctx_ = (r_ - b_ * RPB) < CTX; \
        peer_issue(T, t8, el + (eoff), nullptr, grp, false); T.xv = *(const f32v2*)(xrow(c, r_) + col); T.gv = *(const f32v2*)(gate5 + (size_t)(ctx_ ? 4 : b_) * 6144); } while (0)
#define VFETCH(tok) do { const int r_ = tok_row((tok), need_ctx); e0 = C_EI[(size_t)r_ * 128 + lane]; e1 = C_EI[(size_t)r_ * 128 + 64 + lane]; w0 = C_EG[(size_t)r_ * 128 + lane]; w1 = C_EG[(size_t)r_ * 128 + 64 + lane]; } while (0)
    VFETCH(tok0);
    el[lane] = e0; el[64 + lane] = e1; wl[lane] = w0; wl[64 + lane] = w1;
    VISSUE(A, tok0, 0);
    VFETCH(tok0 + 1);
#pragma unroll 1
    for (int k = 0; k < 16; k += 2) {
        el[128 + lane] = e0; el[192 + lane] = e1; wl[128 + lane] = w0; wl[192 + lane] = w1;
        VISSUE(B, tok0 + k + 1, 128);
        if (k + 2 < 16) VFETCH(tok0 + k + 2);
        peer_v_compute(A, wl, xrow(c, tok_row(tok0 + k, need_ctx)) + col, grp, lane);
        if (k + 2 < 16) { el[lane] = e0; el[64 + lane] = e1; wl[lane] = w0; wl[64 + lane] = w1;
          VISSUE(A, tok0 + k + 2, 0);
          if (k + 3 < 16) VFETCH(tok0 + k + 3); }
        peer_v_compute(B, wl + 128, xrow(c, tok_row(tok0 + k + 1, need_ctx)) + col, grp, lane);
    }
#undef VISSUE
#undef VFETCH
}
template <int SUB>
__device__ void ph_peer_expert(const Ctx& c, int l, char* lds) {
    const bool need_ctx = (l < DEPTH - 1);
    unsigned* cnt = (unsigned*)CWS(WS_CTL) + 4096 + ((l * 2 + SUB) * 8) * 64;
    const int nitem = (need_ctx ? NR : NB * SEQ) / 128;
    const int x = (int)(xb_xcc_id() & 7u);
    volatile int* sh = (volatile int*)(lds + 16384);
    for (int jo = 0; jo < 8; ++jo) { const int j = (x + jo) & 7;
        int nxt = 0;
        if (c.tid == 0) nxt = (int)__hip_atomic_fetch_add(&cnt[j * 64], 1u, __ATOMIC_RELAXED, __HIP_MEMORY_SCOPE_AGENT);
        for (;;) {
            if (c.tid == 0) *sh = nxt;
            __syncthreads(); const int it = *sh; __syncthreads();
            if (it >= nitem) break;
            if (c.tid == 0) nxt = (int)__hip_atomic_fetch_add(&cnt[j * 64], 1u, __ATOMIC_RELAXED, __HIP_MEMORY_SCOPE_AGENT);
            if (SUB == 0) peer_u_item(c, l, j, it, lds); else peer_v_item(c, l, j, it, lds);
        }
    }
}
__device__ void ph_final(const Ctx& c) {
    const float* g = CIN(25);
    const int stride = gridDim.x * 8;
    int r = blockIdx.x * 8 + c.wid;
    f32x4 xn[4];
    if (r < NB * SEQ) { const float* src = COUT + ((size_t)r << 10);
#pragma unroll
        for (int i = 0; i < 4; ++i) xn[i] = *(const f32x4*)(src + i * 256 + c.lane * 4); }
    for (; r < NB * SEQ; r += stride) {
        float* xr = COUT + ((size_t)r << 10);
        f32x4 x[4]; float ss = 0.f;
#pragma unroll
        for (int i = 0; i < 4; ++i) { x[i] = xn[i]; ss += x[i][0] * x[i][0] + x[i][1] * x[i][1] + x[i][2] * x[i][2] + x[i][3] * x[i][3]; }
        if (r + stride < NB * SEQ) { const float* src = COUT + ((size_t)(r + stride) << 10);
#pragma unroll
            for (int i = 0; i < 4; ++i) xn[i] = *(const f32x4*)(src + i * 256 + c.lane * 4); }
        ss = wave_sum(ss); const float rstd = rsqrtf(ss * (1.f / D) + NORM_EPS);
#pragma unroll
        for (int i = 0; i < 4; ++i) { const int col = i * 256 + c.lane * 4; const f32x4 gv = *(const f32x4*)(g + col); f32x4 y;
#pragma unroll
            for (int e = 0; e < 4; ++e) y[e] = x[i][e] * rstd * gv[e];
            *(f32x4*)(xr + col) = y; }
    }
}

namespace pg8 {
#define PG8_LAS __attribute__((address_space(3)))
typedef unsigned short bf16_t;
typedef short bf16x8 __attribute__((ext_vector_type(8)));
typedef float f32x4 __attribute__((ext_vector_type(4)));
typedef unsigned u32x4 __attribute__((ext_vector_type(4)));
constexpr int BM = 256, BK = 64, HALF = 128, HTB = HALF * BK * 2  , STAGE_BYTES = 8 * HTB, NXCD = 8, WGM = 8;

__host__ __device__ __forceinline__ int lds_byte(int r, int c) { const int st = (r >> 4) * 2 + (c >> 5), rr = r & 15, cc = c & 31, ob = rr * 64 + cc * 2; return st * 1024 + (ob ^ (((ob >> 9) & 1) << 5)); }
__host__ __device__ __forceinline__ void stage_rc(int b, int& R, int& C) { const int st = b / 1024, sb = b % 1024, swz = sb ^ (((sb >> 9) & 1) << 5); R = (st >> 1) * 16 + swz / 64; C = (st & 1) * 32 + (swz % 64) / 2; }
__host__ __device__ __forceinline__ int perm32(int rho) { const int n = rho >> 4, i = rho & 15; return 8 * (i >> 2) + 4 * n + (i & 3); }

struct Unit { int pm, pn; };
struct Gemm { const bf16_t* A; const bf16_t* Bt; int M, N, K; };
struct TileOrder {
    int nM, nN, nwg, G, c; bool skip_ctx;
    __device__ void init(int nM_, int nN_, int G_, int c_, bool skip) { nM = nM_; nN = nN_; nwg = nM_ * nN_; G = G_; c = c_; skip_ctx = skip; }
    __device__ bool next(int i, Unit& u) const {
        const long L = (long)i * G + c; if (L >= nwg) return false;
        int wgid = (int)L; { const int q = nwg / NXCD, r = nwg % NXCD, xcd = wgid % NXCD, off = wgid / NXCD; wgid = (xcd < r ? xcd * (q + 1) : r * (q + 1) + (xcd - r) * q) + off; }
        const int nig = WGM * nN, gid = wgid / nig, fm = gid * WGM, gsz = (nM - fm) < WGM ? (nM - fm) : WGM;
        int pm = fm + ((wgid % nig) % gsz); u.pn = (wgid % nig) / gsz;
        if (skip_ctx) pm = 33 * (pm >> 5) + 1 + (pm & 31);
        u.pm = pm; return true;
    }
    __device__ __forceinline__ void a_ready(const Unit&) const {}
    __device__ __forceinline__ void done(const Unit&) const {}
};
template <class Epi, class Sched, bool STAMP = false>
__device__ __forceinline__ void gemm_phase(PG8_LAS unsigned char* lds, const Gemm g, const Sched& S, const Epi& E, unsigned long long* stamps, int w0) {
    const int tid = mk_tid(w0), wid = w0, lane = tid & 63, wr = wid >> 2, wc = wid & 3, fr = lane & 15, fq = lane >> 4;
    const int K = g.K, nt = K / BK;
    int ts_lo = 0, ts_hi = 0, nts = 0; const unsigned long long rt_entry = STAMP ? (unsigned long long)wall_clock64() : 0ull;
#define PG8_STAMP() do { if (STAMP && wid == 0 && nts < 64) { const unsigned long long _c = (unsigned long long)clock64(); \
        ts_lo = (lane == nts) ? (int)(unsigned)_c : ts_lo; ts_hi = (lane == nts) ? (int)(unsigned)(_c >> 32) : ts_hi; ++nts; } } while (0)
    PG8_STAMP();
    unsigned voffA[2], voffB[2];
#pragma unroll
    for (int i = 0; i < 2; ++i) { int R, C; stage_rc(tid * 16 + i * 8192, R, C); const int Rb = Epi::PERM ? ((R & ~31) + perm32(R & 31)) : R;
        voffA[i] = (unsigned)(R * K + C) * 2u; voffB[i] = (unsigned)(Rb * K + C) * 2u; }
    const size_t kstep = (size_t)(BK * 2);
    const size_t hstep = (size_t)HALF * K * 2;
    const size_t tstep = 2 * hstep;
    const unsigned ldsw = (unsigned)wid * 1024u;
    const int aoff = lds_byte(wr * 64 + fr, fq * 8), boff = lds_byte(wc * 32 + fr, fq * 8);
#define PG8_SA(b, h) (((b) * 2 + (h)) * HTB)
#define PG8_SB(b, h) ((4 + (b) * 2 + (h)) * HTB)
#define PG8_STAGE(bufoff, gbase, voff) do { _Pragma("unroll") for (int _i = 0; _i < 2; ++_i) \
        __builtin_amdgcn_global_load_lds((const unsigned*)((const char*)(gbase) + (voff)[_i]), (PG8_LAS unsigned*)(lds + (bufoff) + ldsw + _i * 8192), 16, 0, 0); } while (0)
#define PG8_LDA(dst, b, h) do { _Pragma("unroll") for (int m = 0; m < 4; ++m) _Pragma("unroll") for (int k = 0; k < 2; ++k) dst[m][k] = *(const PG8_LAS bf16x8*)(lds + PG8_SA(b, h) + aoff + m * 2048 + k * 1024); } while (0)
#define PG8_LDB(dst, b, h) do { _Pragma("unroll") for (int n = 0; n < 2; ++n) _Pragma("unroll") for (int k = 0; k < 2; ++k) dst[n][k] = *(const PG8_LAS bf16x8*)(lds + PG8_SB(b, h) + boff + n * 2048 + k * 1024); } while (0)
#define PG8_MMA(ai, bj, At, Bt) do { __builtin_amdgcn_s_setprio(1); _Pragma("unroll") for (int m = 0; m < 4; ++m) _Pragma("unroll") for (int n = 0; n < 2; ++n) _Pragma("unroll") for (int k = 0; k < 2; ++k) \
        acc[ai][bj][m][n] = __builtin_amdgcn_mfma_f32_16x16x32_bf16(Bt[n][k], At[m][k], acc[ai][bj][m][n], 0, 0, 0); __builtin_amdgcn_s_setprio(0); } while (0)
#define PG8_WAIT_V(n) asm volatile("s_waitcnt vmcnt(" #n ")" ::: "memory")
#define PG8_WAIT_L(n) asm volatile("s_waitcnt lgkmcnt(" #n ")" ::: "memory")
#define PG8_BAR __builtin_amdgcn_s_barrier()
#define PG8_SCHED __builtin_amdgcn_sched_barrier(0)
    Unit cur, nxt; int ui = 0;
    if (!S.next(0, cur)) return;
    f32x4 acc[2][2][4][2];
#pragma unroll
    for (int a = 0; a < 2; ++a)
#pragma unroll
        for (int b = 0; b < 2; ++b)
#pragma unroll
            for (int m = 0; m < 4; ++m)
#pragma unroll
                for (int n = 0; n < 2; ++n) acc[a][b][m][n] = (f32x4){0.f, 0.f, 0.f, 0.f};
    bf16x8 At[4][2], B0[2][2], B1[2][2];
    const char* cA = (const char*)g.A + (size_t)cur.pm * tstep; const char* cB = (const char*)g.Bt + (size_t)cur.pn * tstep;
    S.a_ready(cur);
    PG8_STAGE(PG8_SB(0, 0), cB, voffB); PG8_STAGE(PG8_SA(0, 0), cA, voffA); PG8_STAGE(PG8_SB(0, 1), cB + hstep, voffB); PG8_STAGE(PG8_SA(0, 1), cA + hstep, voffA);
    if (wr == 1) PG8_BAR;
    PG8_WAIT_V(4); PG8_BAR;
    PG8_STAGE(PG8_SB(1, 0), cB + kstep, voffB); PG8_STAGE(PG8_SA(1, 0), cA + kstep, voffA); PG8_STAGE(PG8_SB(1, 1), cB + hstep + kstep, voffB);
    PG8_WAIT_V(6); PG8_BAR;
    PG8_STAMP();
    for (;;) {
        const bool has_next = S.next(ui + 1, nxt);
        const char* nA = has_next ? (const char*)g.A + (size_t)nxt.pm * tstep : cA; const char* nB = has_next ? (const char*)g.Bt + (size_t)nxt.pn * tstep : cB;
        for (int t = 0; t < nt; t += 2) {
            const bool last = (t == nt - 2);
            const char* a1 = cA + (size_t)(t + 1) * kstep;
            const char* a2 = last ? nA : cA + (size_t)(t + 2) * kstep; const char* b2 = last ? nB : cB + (size_t)(t + 2) * kstep;
            const char* a3 = a2 + kstep; const char* b3 = b2 + kstep;
            if (last && has_next) S.a_ready(nxt);
            PG8_LDB(B0, 0, 0); PG8_SCHED; PG8_LDA(At, 0, 0); PG8_STAGE(PG8_SA(1, 1), a1 + hstep, voffA);
            PG8_WAIT_L(8); PG8_BAR; PG8_WAIT_L(0); PG8_MMA(0, 0, At, B0); PG8_BAR; PG8_SCHED;
            PG8_LDB(B1, 0, 1); PG8_STAGE(PG8_SB(0, 0), b2, voffB);
            PG8_BAR; PG8_WAIT_L(0); PG8_MMA(0, 1, At, B1); PG8_BAR;
            PG8_LDA(At, 0, 1); PG8_STAGE(PG8_SA(0, 0), a2, voffA);
            PG8_BAR; PG8_WAIT_L(0); PG8_MMA(1, 0, At, B0); PG8_BAR; PG8_SCHED;
            PG8_STAGE(PG8_SB(0, 1), b2 + hstep, voffB);
            PG8_WAIT_V(6); PG8_BAR; PG8_MMA(1, 1, At, B1); PG8_BAR;
            PG8_LDB(B0, 1, 0); PG8_SCHED; PG8_LDA(At, 1, 0); PG8_STAGE(PG8_SA(0, 1), a2 + hstep, voffA);
            PG8_WAIT_L(8); PG8_BAR; PG8_WAIT_L(0); PG8_MMA(0, 0, At, B0); PG8_BAR; PG8_SCHED;
            PG8_LDB(B1, 1, 1); PG8_STAGE(PG8_SB(1, 0), b3, voffB);
            PG8_BAR; PG8_WAIT_L(0); PG8_MMA(0, 1, At, B1); PG8_BAR;
            PG8_LDA(At, 1, 1); PG8_STAGE(PG8_SA(1, 0), a3, voffA);
            PG8_BAR; PG8_WAIT_L(0); PG8_MMA(1, 0, At, B0); PG8_BAR; PG8_SCHED;
            PG8_STAGE(PG8_SB(1, 1), b3 + hstep, voffB);
            PG8_WAIT_V(6); PG8_BAR; PG8_MMA(1, 1, At, B1); PG8_BAR;
        }
        PG8_STAMP();
        if constexpr (!Epi::AFTER_DRAIN) { E(acc, cur, wr, wc, fr, fq); S.done(cur); }
        PG8_STAMP();
        if (!has_next) break;
#pragma unroll
        for (int a = 0; a < 2; ++a)
#pragma unroll
            for (int b = 0; b < 2; ++b)
#pragma unroll
                for (int m = 0; m < 4; ++m)
#pragma unroll
                    for (int n = 0; n < 2; ++n) acc[a][b][m][n] = (f32x4){0.f, 0.f, 0.f, 0.f};
        cur = nxt; cA = nA; cB = nB; ++ui;
    }
    PG8_WAIT_V(0);
    if (wr == 0) PG8_BAR;
    PG8_BAR;
    if constexpr (Epi::AFTER_DRAIN) { E.fused(acc, cur, wr, wc, fr, fq, lds, wid, lane); S.done(cur); }
    PG8_STAMP();
    if (STAMP && wid == 0) { stamps[lane] = lane < nts ? (((unsigned long long)(unsigned)ts_hi << 32) | (unsigned)ts_lo) : 0ull;
        if (lane == 62) stamps[62] = rt_entry; if (lane == 63) stamps[63] = (unsigned long long)wall_clock64(); }
#undef PG8_STAMP
#undef PG8_SA
#undef PG8_SB
#undef PG8_STAGE
#undef PG8_LDA
#undef PG8_LDB
#undef PG8_MMA
#undef PG8_WAIT_V
#undef PG8_WAIT_L
#undef PG8_BAR
#undef PG8_SCHED
}

struct EpiStoreBf16 {
    static constexpr bool PERM = true, AFTER_DRAIN = false;
    bf16_t* O; int ldc; int ncols; int slo, shi; float scale;
    __device__ __forceinline__ void operator()(const f32x4 (&acc)[2][2][4][2], const Unit& u, int wr, int wc, int fr, int fq) const {
        const int row0 = u.pm * BM + wr * 64 + fr, col0 = u.pn * BM + wc * 32 + 8 * fq;
        float sc[2];
#pragma unroll
        for (int bj = 0; bj < 2; ++bj) { const int cb = u.pn * BM + bj * HALF; sc[bj] = (cb >= slo && cb < shi) ? scale : 1.f; }
#pragma unroll
        for (int ai = 0; ai < 2; ++ai)
#pragma unroll
            for (int m = 0; m < 4; ++m) { bf16_t* rowp = O + (size_t)(row0 + ai * HALF + m * 16) * ldc + col0;
#pragma unroll
                for (int bj = 0; bj < 2; ++bj) if (col0 + bj * HALF < ncols) { const f32x4 v0 = acc[ai][bj][m][0] * sc[bj], v1 = acc[ai][bj][m][1] * sc[bj];
                    u32x4 w; w.x = ::cvtpk(v0[0], v0[1]); w.y = ::cvtpk(v0[2], v0[3]); w.z = ::cvtpk(v1[0], v1[1]); w.w = ::cvtpk(v1[2], v1[3]);
                    *(u32x4*)(rowp + bj * HALF) = w; }
                asm volatile("" ::: "memory"); }
    }
};
struct EpiResidX {
    static constexpr bool PERM = false, AFTER_DRAIN = false;
    float* xc; float* xout; const float* gate_l;
    __device__ __forceinline__ void operator()(const f32x4 (&acc)[2][2][4][2], const Unit& u, int wr, int wc, int fr, int fq) const {
        const int rowt = u.pm * BM; const int b = rowt / RPB, j0 = rowt - b * RPB; const bool isctx = j0 < CTX;
        float* xb = isctx ? xc + ((size_t)(b * CTX + j0) << 10) : xout + ((size_t)(b * SEQ + j0 - CTX) << 10);
        const float* gt = gate_l + (size_t)(isctx ? 4 : b) * 6144;
        const int r0 = wr * 64 + fr, col0 = u.pn * BM + wc * 32 + 4 * fq;
        f32x4 gv[2][2];
#pragma unroll
        for (int bj = 0; bj < 2; ++bj)
#pragma unroll
            for (int n = 0; n < 2; ++n) gv[bj][n] = *(const f32x4*)(gt + col0 + bj * HALF + n * 16);
#pragma unroll
        for (int ai = 0; ai < 2; ++ai)
#pragma unroll
            for (int m = 0; m < 4; ++m) { float* rowp = xb + ((size_t)(r0 + ai * HALF + m * 16) << 10) + col0;
#pragma unroll
                for (int bj = 0; bj < 2; ++bj)
#pragma unroll
                    for (int n = 0; n < 2; ++n) { f32x4* p = (f32x4*)(rowp + bj * HALF + n * 16); *p = *p + gv[bj][n] * acc[ai][bj][m][n]; }
                asm volatile("" ::: "memory"); }
    }
};
}

constexpr int LDS_BYTES = 144 * 1024;
static_assert(TOPK_LDS + 16 <= LDS_BYTES && GEMM_LDS + 16 <= LDS_BYTES && ATT_LDS + 16 <= LDS_BYTES, "LDS budget");
constexpr int PPL = 13;
constexpr int N_PHASES = 1 + PPL * DEPTH + 1;
extern __shared__ __attribute__((aligned(16))) char g_lds[];

#define PHASE_FN __device__ __forceinline__ void
PHASE_FN f_p0(int w0) { const Ctx c = fresh_ctx(w0); ph_p0(c, g_lds); }
PHASE_FN f_norm0(int w0, int l) { const Ctx c = fresh_ctx(w0); ph_norm<0>(c, l); }
PHASE_FN f_norm1(int w0, int l) { const Ctx c = fresh_ctx(w0); ph_norm<1>(c, l); }
PHASE_FN f_gemm_in(int w0, int l) { const Ctx c = fresh_ctx(w0);
    pg8::Gemm g{C_HB, C_WIN + (size_t)l * INC * D, NR, 3328, D};
    pg8::TileOrder S; S.init(132, 13, (int)gridDim.x, (int)blockIdx.x, false);
    pg8::EpiStoreBf16 E{C_P, INC, INC, DF_Q, DF_Q + 256, 0.17677669529663687f * 1.4426950408889634f};
    pg8::gemm_phase<pg8::EpiStoreBf16, pg8::TileOrder>((PG8_LAS unsigned char*)g_lds, g, S, E, nullptr, w0); }
PHASE_FN f_prep(int w0, int l) {
    const Ctx c = fresh_ctx(w0); char* lds = g_lds;
    ph_prep_rows(c, l);
    scan_tables(c, l, lds);
    { const int G = (int)gridDim.x, N = 16 * NCHUNK * 2, R = (N + G - 1) / G;
      for (int q = 0; q < 2 * R; ++q) { const int mx = q & 1; int u = (q >> 1) * G + (int)blockIdx.x; if (u >= N) continue;
        const int dir = u & 1; u >>= 1; const int cc = u % NCHUNK; u /= NCHUNK; const int h = u & 3, b = u >> 2;
        if (mx == 0) scanA_item<0>(c, l, b, h, cc, dir, lds); else scanA_item<1>(c, l, b, h, cc, dir, lds); } }
}
PHASE_FN f_upproj(int w0, int l) {
    const Ctx c = fresh_ctx(w0); char* lds = g_lds;
    EpiBf16 eq{C_QM, 384, 0.10206207261596575f * 1.4426950408889634f}, ekv{C_KVM, 512, 1.f};
    for (int it = blockIdx.x; it < 132 * 7 + 384; it += gridDim.x) {
        if (it < 132 * 7) { const int tm = it / 7, tn = it % 7;
            if (tn < 3) gemm_tile(c, C_P + MLA_CQ, INC, C_WUQ + (size_t)l * 384 * 192, 192, 192, tm * 256, tn * 128, lds, eq);
            else gemm_tile(c, C_P + MLA_CKV, INC, C_WUKV + (size_t)l * 512 * 128, 128, 128, tm * 256, (tn - 3) * 128, lds, ekv); }
        else scanB_item(c, it - 132 * 7); }
}
PHASE_FN f_scanc(int w0, int l) {
    const Ctx c = fresh_ctx(w0); char* lds = g_lds; const bool need_ctx = (l < DEPTH - 1);
    ph_rope_q(c);
    scan_tables(c, l, lds);
    { const int G = (int)gridDim.x, N = 16 * NCHUNK, R = (N + G - 1) / G;
      for (int q = 0; q < 2 * R; ++q) { const int mx = q & 1; int u = (q >> 1) * G + (int)blockIdx.x; if (u >= N) continue;
        const int cc = u % NCHUNK; u /= NCHUNK; const int h = u & 3, b = u >> 2;
        if (cc < 4 && !need_ctx) continue;
        if (mx == 0) scanC_item<0>(c, l, b, h, cc, lds); else scanC_item<1>(c, l, b, h, cc, lds); } }
}
PHASE_FN f_attn(int w0, int l) { const Ctx c = fresh_ctx(w0); ph_attn(c, l, g_lds); }
PHASE_FN f_gemm_out(int w0, int l) {
    const Ctx c = fresh_ctx(w0); const bool need_ctx = (l < DEPTH - 1);
    { pg8::Gemm g{C_HB, C_WOUT + (size_t)l * D * D, NR, D, D};
      pg8::TileOrder S; S.init(need_ctx ? 132 : 128, 4, (int)gridDim.x, (int)blockIdx.x, !need_ctx);
      pg8::EpiResidX E{C_XC, COUT, C_MODT + (size_t)l * 5 * 6144 + 2 * D};
      pg8::gemm_phase<pg8::EpiResidX, pg8::TileOrder>((PG8_LAS unsigned char*)g_lds, g, S, E, nullptr, w0); }
    cvt_tables(c, l);
}
PHASE_FN f_peer_q(int w0, int l) {
    const Ctx c = fresh_ctx(w0); const bool need_ctx = (l < DEPTH - 1);
    pg8::Gemm g{C_HB, C_WQ + (size_t)l * 2048 * D, NR, 2048, D};
    pg8::TileOrder S; S.init(need_ctx ? 132 : 128, 8, (int)gridDim.x, (int)blockIdx.x, !need_ctx);
    pg8::EpiStoreBf16 E{C_Q2, 2048, 2048, 0, 0, 1.f};
    pg8::gemm_phase<pg8::EpiStoreBf16, pg8::TileOrder>((PG8_LAS unsigned char*)g_lds, g, S, E, nullptr, w0);
}
PHASE_FN f_topk(int w0, int l) {
    const Ctx c = fresh_ctx(w0); char* lds = g_lds; const bool need_ctx = (l < DEPTH - 1);
    for (int it = blockIdx.x; it < 264 * 8; it += gridDim.x) { const int tm = it >> 3, h = it & 7;
        if ((tm % 66) < 2 && !need_ctx) continue;
        peer_topk_item(c, l, tm, h, lds); }
}
PHASE_FN f_expert_u(int w0, int l) { const Ctx c = fresh_ctx(w0); ph_peer_expert<0>(c, l, g_lds); }
PHASE_FN f_expert_c(int w0, int l) { const Ctx c = fresh_ctx(w0); ph_peer_combine(c, l); }
PHASE_FN f_expert_v(int w0, int l) { const Ctx c = fresh_ctx(w0); ph_peer_expert<1>(c, l, g_lds); }
PHASE_FN f_final(int w0) { const Ctx c = fresh_ctx(w0); ph_final(c); }

__global__ void __launch_bounds__(512, 2) mk_fwd(Params p) {
    volatile LAS unsigned* bst = (volatile LAS unsigned*)(g_lds + LDS_BYTES - 16);
    const bool t0 = threadIdx.x == 0; const int w0 = __builtin_amdgcn_readfirstlane((int)threadIdx.x >> 6);
    if (t0) { bst[0] = 0u; bst[1] = 0u; bst[2] = 0u; bst[3] = 0u; }
    __syncthreads();
    XcdBarrier bar; bar.bar = (unsigned*)(p.ws + WS_CTL); bar.x = 0; bar.st = bst; bar.t0 = t0;
    const int lo = p.ph_lo, hi = p.ph_hi;
    const bool multi = (hi - lo) > 1;
    if (multi) bar = xcd_barrier_post((unsigned*)(p.ws + WS_CTL), bst, t0);
#ifndef PHMASK
#define PHMASK 0xFFFF
#endif
#define EN(s) ((PHMASK >> (s)) & 1)
#define IN(k) (lo <= (k) && (k) < hi)
#define SEAM(k) do { if (IN(k) && IN((k) + 1)) xcd_barrier(bar); } while (0)
    if (EN(0) && IN(0)) f_p0(w0);
    SEAM(0);
#define LAYER(l) do { constexpr int base = 1 + PPL * (l); \
        if (EN(1) && IN(base + 0)) f_norm0(w0, l); SEAM(base + 0); \
        if (EN(2) && IN(base + 1)) f_gemm_in(w0, l); SEAM(base + 1); \
        if (EN(3) && IN(base + 2)) f_prep(w0, l); SEAM(base + 2); \
        if (EN(4) && IN(base + 3)) f_upproj(w0, l); SEAM(base + 3); \
        if (EN(5) && IN(base + 4)) f_scanc(w0, l); SEAM(base + 4); \
        if (EN(6) && IN(base + 5)) f_attn(w0, l); SEAM(base + 5); \
        if (EN(7) && IN(base + 6)) f_gemm_out(w0, l); SEAM(base + 6); \
        if (EN(8) && IN(base + 7)) f_norm1(w0, l); SEAM(base + 7); \
        if (EN(9) && IN(base + 8)) f_peer_q(w0, l); SEAM(base + 8); \
        if (EN(10) && IN(base + 9)) f_topk(w0, l); SEAM(base + 9); \
        if (EN(11) && IN(base + 10)) f_expert_u(w0, l); SEAM(base + 10); \
        if (EN(12) && IN(base + 11)) f_expert_c(w0, l); SEAM(base + 11); \
        if (EN(13) && IN(base + 12)) f_expert_v(w0, l); SEAM(base + 12); } while (0)
    LAYER(0);
    LAYER(1);
#undef LAYER
    if (EN(14) && IN(N_PHASES - 1)) f_final(w0);
#undef IN
#undef SEAM
}

extern "C" void kernel_launch(void* const* d_in, const int* in_sizes, int n_in, void* d_out, int out_size, void* d_ws, size_t ws_size, hipStream_t stream) {
    static int grid = 0;
    if (grid == 0) {
        if (n_in != 26 || in_sizes[0] != NB * SEQ * D || out_size != NB * SEQ * D || ws_size < WS_END) {
            fprintf(stderr, "kernel_launch: shape/workspace mismatch: n_in %d in0 %d out %d ws %zu (need %zu); nothing launched\n", n_in, n_in > 0 ? in_sizes[0] : -1, out_size, ws_size, (size_t)WS_END);
            grid = -1; return; }
        int dev = 0, cus = 0, per_cu = 0;
        if (hipGetDevice(&dev) != hipSuccess || hipDeviceGetAttribute(&cus, hipDeviceAttributeMultiprocessorCount, dev) != hipSuccess) { grid = -1; return; }
        if (hipFuncSetAttribute((const void*)mk_fwd, hipFuncAttributeMaxDynamicSharedMemorySize, LDS_BYTES) != hipSuccess) { fprintf(stderr, "kernel_launch: hipFuncSetAttribute failed\n"); grid = -1; return; }
        if (hipOccupancyMaxActiveBlocksPerMultiprocessor(&per_cu, (const void*)mk_fwd, 512, LDS_BYTES) != hipSuccess || per_cu < 1)
            fprintf(stderr, "kernel_launch: note: occupancy query reports %d workgroups per CU\n", per_cu);
        (void)hipGetLastError();
        grid = cus;
    }
    if (grid < 0) return;
    if (hipMemsetAsync((char*)d_ws + WS_CTL, 0, CTL_BYTES, stream) != hipSuccess) { fprintf(stderr, "kernel_launch: memset failed\n"); return; }
    Params p{};
    for (int i = 0; i < 26; ++i) p.in[i] = (const float*)d_in[i];
    p.out = (float*)d_out; p.ws = (unsigned char*)d_ws;
#if MK_PER_PHASE
    for (int k = 0; k < N_PHASES; ++k) { p.ph_lo = k; p.ph_hi = k + 1; hipLaunchKernelGGL(mk_fwd, dim3(grid), dim3(512), LDS_BYTES, stream, p); }
#else
    p.ph_lo = 0; p.ph_hi = N_PHASES; hipLaunchKernelGGL(mk_fwd, dim3(grid), dim3(512), LDS_BYTES, stream, p);
#endif
    const hipError_t le = hipPeekAtLastError();
    if (le != hipSuccess) fprintf(stderr, "kernel_launch: launch failed: %s\n", hipGetErrorName(le));
}
```

```cpp
#include <hip/hip_runtime.h>
#include <cstdio>
#include <cstdint>

#ifndef ATT_FAST_DIFF
#define ATT_FAST_DIFF 0
#endif
#ifndef MK_PER_PHASE
#define MK_PER_PHASE 0
#endif

constexpr int D = 1024, NB = 4, SEQ = 8192, CTX = 256, DEPTH = 2;
constexpr int RPB = CTX + SEQ;
constexpr int NR = NB * RPB;
constexpr int INC = 3200;
constexpr int GLA_Q = 0, GLA_K = 128, GLA_V = 256, GLA_R = 512, GLA_ZF = 768, GLA_ZB = 784;
constexpr int HG_Q = 800, HG_I = 1056, HG_OG = 1312, HG_ZF = 1568, HG_ZB = 1824;
constexpr int MLA_CQ = 2080, MLA_CKV = 2272, MLA_KR = 2400;
constexpr int DF_Q = 2432, DF_K = 2688, DF_V = 2944;
constexpr int NCHUNK = RPB / 64;
constexpr int NEXP = 16384;
constexpr float NORM_EPS = 1e-6f;

typedef unsigned short bf16_t;
typedef short bf16x8 __attribute__((ext_vector_type(8)));
typedef short s16x4 __attribute__((ext_vector_type(4)));
typedef float f32x16 __attribute__((ext_vector_type(16)));
typedef float f32x4 __attribute__((ext_vector_type(4)));
typedef unsigned u32x4 __attribute__((ext_vector_type(4)));
typedef unsigned u32x2 __attribute__((ext_vector_type(2)));

constexpr size_t al256(size_t x) { return (x + 255) / 256 * 256; }
constexpr size_t WS_CTL = 0;
constexpr size_t CTL_BYTES = 65536;
constexpr size_t WS_MOD = WS_CTL + CTL_BYTES;
constexpr size_t WS_XC = al256(WS_MOD + (size_t)2 * 5 * 6144 * 4);
constexpr size_t WS_WIN = al256(WS_XC + (size_t)NB * CTX * D * 4);
constexpr size_t WS_WOUT = al256(WS_WIN + (size_t)2 * INC * D * 2);
constexpr size_t WS_WQ = al256(WS_WOUT + (size_t)2 * D * D * 2);
constexpr size_t WS_WUQ = al256(WS_WQ + (size_t)2 * 2048 * D * 2);
constexpr size_t WS_WUKV = al256(WS_WUQ + (size_t)2 * 384 * 192 * 2);
constexpr size_t WS_KEYS = al256(WS_WUKV + (size_t)2 * 512 * 128 * 2);
constexpr size_t WS_HB = al256(WS_KEYS + (size_t)2 * 16 * 128 * 128 * 2);
constexpr size_t WS_QM = al256(WS_HB + (size_t)NR * D * 2);
constexpr size_t WS_KVM = al256(WS_QM + (size_t)NR * 384 * 2);
constexpr size_t WS_SG = al256(WS_KVM + (size_t)NR * 512 * 2);
constexpr size_t WS_SH = al256(WS_SG + (size_t)32 * NCHUNK * 2048 * 2);
constexpr size_t WS_DG = al256(WS_SH + (size_t)32 * NCHUNK * 4096 * 2);
constexpr size_t WS_DH = al256(WS_DG + (size_t)32 * NCHUNK * 32 * 4);
constexpr size_t WS_P = al256(WS_DH + (size_t)32 * NCHUNK * 64 * 4);
constexpr size_t WS_END = al256(WS_P + (size_t)NR * INC * 2);
constexpr size_t WS_TU8 = WS_P;
constexpr size_t WS_TV8 = WS_P + (size_t)NEXP * D;
constexpr size_t WS_SU = WS_TV8 + (size_t)NEXP * D;
constexpr size_t WS_SV = WS_SU + (size_t)NEXP * 4;
constexpr size_t WS_Q2 = WS_P + (size_t)64 * 1024 * 1024;
constexpr size_t WS_PART = WS_Q2;
static_assert(WS_SV + (size_t)NEXP * 4 <= WS_Q2, "alias overflow 0");
static_assert(WS_Q2 + (size_t)NR * 2048 * 2 <= WS_END, "alias overflow");
constexpr size_t WS_EI = WS_SG;
constexpr size_t WS_EG = WS_EI + (size_t)NR * 128 * 4;
static_assert(WS_EG + (size_t)NR * 128 * 4 <= WS_DG, "alias overflow 2");

#define XB_TMO      128
#define XB_XCNT(j)  (256  + 64 * (j))
#define XB_XSUB(j)  (1280 + 64 * (j))
#define XB_XGEN(j)  (2304 + 64 * (j))
#define XB_TOP      3328
#define XB_TOPGEN   3392
#define XCD_BAR_WORDS 3456
#define XB_SPIN_CAP (1u << 22)
#define LAS __attribute__((address_space(3)))

__device__ __forceinline__ unsigned xb_ld(unsigned* p)              { return __hip_atomic_load(p, __ATOMIC_RELAXED, __HIP_MEMORY_SCOPE_AGENT); }
__device__ __forceinline__ unsigned xb_add(unsigned* p, unsigned v) { return __hip_atomic_fetch_add(p, v, __ATOMIC_RELAXED, __HIP_MEMORY_SCOPE_AGENT); }
__device__ __forceinline__ unsigned xb_xcc_id() { return (unsigned)__builtin_amdgcn_s_getreg((3 << 11) | 20) & 0xFu; }
#define XB_SPIN(cond, bar) do { unsigned _sp = 0; while (cond) { __builtin_amdgcn_s_sleep(1); \
    if ((++_sp & 255u) == 0u) { if (xb_ld(&(bar)[XB_TMO])) break; if (_sp > XB_SPIN_CAP) { atomicAdd(&(bar)[XB_TMO], 1u); break; } } } } while (0)

struct XcdBarrier { unsigned* bar; unsigned x; volatile LAS unsigned* st; bool t0; };

__device__ __forceinline__ XcdBarrier xcd_barrier_post(unsigned* bar, volatile LAS unsigned* st, bool t0) {
    XcdBarrier b; b.bar = bar; b.x = xb_xcc_id(); b.st = st; b.t0 = t0;
    if (t0) (void)xb_add(&bar[XB_XCNT(b.x)], 1u);
    return b;
}
__device__ __forceinline__ void xcd_barrier_complete(unsigned* bar, unsigned x, unsigned& nloc, unsigned& nx) {
    const unsigned G = gridDim.x * gridDim.y * gridDim.z;
    unsigned sum, cnt, mine, sp = 0u;
    for (;;) {
        sum = 0u; cnt = 0u; mine = 0u;
#pragma unroll
        for (unsigned j = 0; j < 16; ++j) { const unsigned c = xb_ld(&bar[XB_XCNT(j)]); sum += c; cnt += (c > 0u) ? 1u : 0u; mine = (j == x) ? c : mine; }
        if (sum == G) break;
        __builtin_amdgcn_s_sleep(1);
        if ((++sp & 255u) == 0u) { if (xb_ld(&bar[XB_TMO])) break; if (sp > XB_SPIN_CAP) { atomicAdd(&bar[XB_TMO], 1u); break; } }
    }
    nloc = mine > 0u ? mine : 1u; nx = cnt > 0u ? cnt : 1u;
}
__device__ __forceinline__ void xcd_barrier(const XcdBarrier& b) {
    asm volatile("s_waitcnt vmcnt(0)" ::: "memory");
    __syncthreads();
    if (b.t0) {
        unsigned* bar = b.bar;
        __builtin_amdgcn_s_waitcnt(0);
        unsigned nloc = b.st[0], nx = b.st[1];
        if (nloc == 0u) { xcd_barrier_complete(bar, b.x, nloc, nx); b.st[0] = nloc; b.st[1] = nx; }
        const unsigned old = xb_add(&bar[XB_XSUB(b.x)], 1u);
        const unsigned gen = old / nloc;
        if (old + 1u == (gen + 1u) * nloc) {
            __builtin_amdgcn_fence(__ATOMIC_RELEASE, "agent");
            asm volatile("s_waitcnt vmcnt(0)" ::: "memory");
            const unsigned og = xb_add(&bar[XB_TOP], 1u);
            const unsigned tg = og / nx;
            if (og + 1u == (tg + 1u) * nx) xb_add(&bar[XB_TOPGEN], 1u);
            else XB_SPIN(xb_ld(&bar[XB_TOPGEN]) == tg, bar);
            __builtin_amdgcn_fence(__ATOMIC_ACQUIRE, "agent");
            xb_add(&bar[XB_XGEN(b.x)], 1u);
            asm volatile("s_waitcnt vmcnt(0)" ::: "memory");
        } else {
            XB_SPIN(xb_ld(&bar[XB_XGEN(b.x)]) == gen, bar);
            __builtin_amdgcn_fence(__ATOMIC_ACQUIRE, "agent");
            asm volatile("s_waitcnt vmcnt(0)" ::: "memory");
        }
    }
    __syncthreads();
}

typedef __bf16 bf16v2_t __attribute__((ext_vector_type(2)));
typedef float f32v2_t __attribute__((ext_vector_type(2)));
__device__ __forceinline__ unsigned cvtpk(float lo, float hi) { const f32v2_t v = {lo, hi}; const bf16v2_t b = __builtin_convertvector(v, bf16v2_t); return __builtin_bit_cast(unsigned, b); }
__device__ __forceinline__ bf16_t f2bf(float x) { const __bf16 b = (__bf16)x; return __builtin_bit_cast(bf16_t, b); }
__device__ __forceinline__ float bf2f(bf16_t h) { return __uint_as_float(((unsigned)h) << 16); }
__device__ __forceinline__ float bflo(unsigned w) { return __uint_as_float(w << 16); }
__device__ __forceinline__ float bfhi(unsigned w) { return __uint_as_float(w & 0xffff0000u); }
__device__ __forceinline__ float silu_f(float x) { return x / (1.f + __expf(-x)); }
__device__ __forceinline__ float logsigmoid_f(float z) { return fminf(z, 0.f) - __logf(1.f + __expf(-fabsf(z))); }
__device__ __forceinline__ float wave_sum(float v) {
#pragma unroll
    for (int o = 32; o >= 1; o >>= 1) v += __shfl_xor(v, o, 64);
    return v;
}
__device__ __forceinline__ void zero_acc(f32x16& a) {
#pragma unroll
    for (int r = 0; r < 16; ++r) a[r] = 0.f;
    asm volatile("" : "+v"(a));
}
__device__ __forceinline__ int crow(int r, int hi) { return (r & 3) + 8 * (r >> 2) + 4 * hi; }

struct Params { const float* in[26]; float* out; unsigned char* ws; int ph_lo, ph_hi; };
typedef const __attribute__((address_space(4))) Params* KParams;
struct Ctx {
    KParams pp;
    int tid, lane, wid;
};
__device__ __forceinline__ int mk_tid(int w0) { unsigned m = ~0u; asm volatile("" : "+s"(m)); return (w0 << 6) | (int)__builtin_amdgcn_mbcnt_hi(m, __builtin_amdgcn_mbcnt_lo(m, 0u)); }
__device__ __forceinline__ float shx(float v, int o, int lane) { return __int_as_float(__builtin_amdgcn_ds_bpermute((lane ^ o) << 2, __float_as_int(v))); }
__device__ __forceinline__ Ctx fresh_ctx(int w0) {
    Ctx c; unsigned long long a = (unsigned long long)__builtin_amdgcn_kernarg_segment_ptr(); asm volatile("" : "+s"(a)); c.pp = (KParams)a;
    int t = mk_tid(w0); asm volatile("" : "+v"(t)); c.tid = t; c.lane = t & 63; c.wid = w0;
    return c;
}
#define CIN(i)   (c.pp->in[i])
#define COUT     (c.pp->out)
#define CWS(off) (c.pp->ws + (off))
#define C_MODT ((float*)CWS(WS_MOD))
#define C_XC   ((float*)CWS(WS_XC))
#define C_WIN  ((bf16_t*)CWS(WS_WIN))
#define C_WOUT ((bf16_t*)CWS(WS_WOUT))
#define C_WQ   ((bf16_t*)CWS(WS_WQ))
#define C_WUQ  ((bf16_t*)CWS(WS_WUQ))
#define C_WUKV ((bf16_t*)CWS(WS_WUKV))
#define C_KEYS ((bf16_t*)CWS(WS_KEYS))
#define C_HB   ((bf16_t*)CWS(WS_HB))
#define C_QM   ((bf16_t*)CWS(WS_QM))
#define C_KVM  ((bf16_t*)CWS(WS_KVM))
#define C_P    ((bf16_t*)CWS(WS_P))
#define C_TU8  ((unsigned char*)CWS(WS_TU8))
#define C_TV8  ((unsigned char*)CWS(WS_TV8))
#define C_SU   ((float*)CWS(WS_SU))
#define C_SV   ((float*)CWS(WS_SV))
#define C_PART ((float*)CWS(WS_PART))
#define C_Q2   ((bf16_t*)CWS(WS_Q2))
#define C_SG   ((bf16_t*)CWS(WS_SG))
#define C_SH   ((bf16_t*)CWS(WS_SH))
#define C_DG   ((float*)CWS(WS_DG))
#define C_DH   ((float*)CWS(WS_DH))
#define C_EI   ((int*)CWS(WS_EI))
#define C_EG   ((float*)CWS(WS_EG))

__device__ __forceinline__ float* xrow(const Ctx& c, int r) {
    const int b = r / RPB, j = r - b * RPB;
    return j < CTX ? C_XC + ((size_t)(b * CTX + j) << 10) : COUT + ((size_t)(b * SEQ + (j - CTX)) << 10);
}
__device__ __forceinline__ const float* inrow(const Ctx& c, int r) {
    const int b = r / RPB, j = r - b * RPB;
    return j < CTX ? CIN(2) + ((size_t)(b * CTX + j) << 10) : CIN(0) + ((size_t)(b * SEQ + (j - CTX)) << 10);
}

__device__ void p0_mod_item(const Ctx& c, int item, char* lds) {
    float* sc = (float*)lds;
    float* red = sc + 5 * 1024;
    const int tid = c.tid;
    for (int i = tid; i < 5 * 1024; i += 512) { const int v = i >> 10, k = i & 1023; const float x = (v < 4) ? CIN(1)[v * 1024 + k] : CIN(3)[k]; sc[i] = silu_f(x); }
    __syncthreads();
    const int l = item / 96, n0 = (item % 96) * 64;
    const int col = tid & 63, kg = tid >> 6;
    const float* w = CIN(4) + (size_t)l * 1024 * 6144 + n0 + col;
    float a[5] = {0.f, 0.f, 0.f, 0.f, 0.f};
#pragma unroll 8
    for (int kk = 0; kk < 128; ++kk) { const int k = kg * 128 + kk; const float wv = w[(size_t)k * 6144];
#pragma unroll
        for (int v = 0; v < 5; ++v) a[v] += sc[v * 1024 + k] * wv; }
#pragma unroll
    for (int v = 0; v < 5; ++v) red[(kg * 64 + col) * 5 + v] = a[v];
    __syncthreads();
    if (tid < 320) { const int cc = tid / 5, v = tid % 5; float s = 0.f;
#pragma unroll
        for (int g = 0; g < 8; ++g) s += red[(g * 64 + cc) * 5 + v];
        C_MODT[((size_t)l * 5 + v) * 6144 + n0 + cc] = s + CIN(5)[l * 6144 + n0 + cc]; }
    __syncthreads();
}
__device__ void p0_tr_tile(const float* __restrict__ src, bf16_t* __restrict__ dst, int K, int N, int k0, int n0, int tid, char* lds) {
    float* t = (float*)lds;
#pragma unroll
    for (int i = 0; i < 2; ++i) { const int k = (tid >> 4) + 32 * i, n4 = (tid & 15) * 4;
        const f32x4 v = *(const f32x4*)(src + (size_t)(k0 + k) * N + n0 + n4);
        t[k * 65 + n4 + 0] = v[0]; t[k * 65 + n4 + 1] = v[1]; t[k * 65 + n4 + 2] = v[2]; t[k * 65 + n4 + 3] = v[3]; }
    __syncthreads();
    { const int n = tid >> 3, k8 = (tid & 7) * 8; u32x4 w;
#pragma unroll
        for (int j = 0; j < 4; ++j) w[j] = cvtpk(t[(k8 + 2 * j) * 65 + n], t[(k8 + 2 * j + 1) * 65 + n]);
        *(u32x4*)(dst + (size_t)(n0 + n) * K + k0 + k8) = w; }
    __syncthreads();
}
__device__ void ph_p0(const Ctx& c, char* lds) {
    constexpr int T_WIN = 16 * 50, T_WOUT = 16 * 16, T_WQ = 16 * 32, T_UQ = 3 * 6, T_UKV = 2 * 8;
    constexpr int PER_L = T_WIN + T_WOUT + T_WQ + T_UQ + T_UKV;
    constexpr int NITEM = 192 + 2 * PER_L;
    for (int it = blockIdx.x; it < NITEM; it += gridDim.x) {
        if (it < 192) { p0_mod_item(c, it, lds); continue; }
        int t = it - 192; const int l = t / PER_L; t -= l * PER_L;
        if (t < T_WIN) { p0_tr_tile(CIN(8) + (size_t)l * D * INC, C_WIN + (size_t)l * INC * D, D, INC, (t / 50) * 64, (t % 50) * 64, c.tid, lds); continue; } t -= T_WIN;
        if (t < T_WOUT) { p0_tr_tile(CIN(9) + (size_t)l * D * D, C_WOUT + (size_t)l * D * D, D, D, (t / 16) * 64, (t % 16) * 64, c.tid, lds); continue; } t -= T_WOUT;
        if (t < T_WQ) { p0_tr_tile(CIN(21) + (size_t)l * D * 2048, C_WQ + (size_t)l * 2048 * D, D, 2048, (t / 32) * 64, (t % 32) * 64, c.tid, lds); continue; } t -= T_WQ;
        if (t < T_UQ) { p0_tr_tile(CIN(17) + (size_t)l * 192 * 384, C_WUQ + (size_t)l * 384 * 192, 192, 384, (t / 6) * 64, (t % 6) * 64, c.tid, lds); continue; } t -= T_UQ;
        p0_tr_tile(CIN(18) + (size_t)l * 128 * 512, C_WUKV + (size_t)l * 512 * 128, 128, 512, (t / 8) * 64, (t % 8) * 64, c.tid, lds);
    }
    const size_t nk8 = (size_t)2 * 16 * 128 * 128 / 8;
    for (size_t i = (size_t)blockIdx.x * 512 + c.tid; i < nk8; i += (size_t)gridDim.x * 512) {
        const f32x4 a = *(const f32x4*)(CIN(22) + i * 8), b = *(const f32x4*)(CIN(22) + i * 8 + 4);
        u32x4 w = {cvtpk(a[0], a[1]), cvtpk(a[2], a[3]), cvtpk(b[0], b[1]), cvtpk(b[2], b[3])};
        *(u32x4*)(C_KEYS + i * 8) = w;
    }
}

template <int WHICH>
__device__ void ph_norm(const Ctx& c, int l) {
    const float* g = CIN(WHICH == 0 ? 6 : 7) + l * D;
    const bool need_ctx = (l < DEPTH - 1);
    const int stride = gridDim.x * 8;
    auto next_row = [&](int r) { for (; r < NR; r += stride) { const int j = r % RPB; if (!(WHICH == 1 && j < CTX && !need_ctx)) break; } return r; };
    auto row_src = [&](int r) { return (WHICH == 0 && l == 0) ? inrow(c, r) : (const float*)xrow(c, r); };
    int r = next_row(blockIdx.x * 8 + c.wid);
    f32x4 xn[4];
    if (r < NR) { const float* src = row_src(r);
#pragma unroll
        for (int i = 0; i < 4; ++i) xn[i] = *(const f32x4*)(src + i * 256 + c.lane * 4); }
    while (r < NR) {
        f32x4 x[4];
#pragma unroll
        for (int i = 0; i < 4; ++i) x[i] = xn[i];
        const int rn = next_row(r + stride);
        if (rn < NR) { const float* src = row_src(rn);
#pragma unroll
            for (int i = 0; i < 4; ++i) xn[i] = *(const f32x4*)(src + i * 256 + c.lane * 4); }
        const int b = r / RPB, j = r - b * RPB; const bool isctx = j < CTX;
        float ss = 0.f;
#pragma unroll
        for (int i = 0; i < 4; ++i) ss += x[i][0] * x[i][0] + x[i][1] * x[i][1] + x[i][2] * x[i][2] + x[i][3] * x[i][3];
        ss = wave_sum(ss);
        const float rstd = rsqrtf(ss * (1.f / D) + NORM_EPS);
        const float* mt = C_MODT + ((size_t)l * 5 + (isctx ? 4 : b)) * 6144;
        const float* sh = mt + (WHICH == 0 ? 0 : 3) * D; const float* scl = mt + (WHICH == 0 ? 1 : 4) * D;
        bf16_t* dst = C_HB + (size_t)r * D;
        float* xr = xrow(c, r);
#pragma unroll
        for (int i = 0; i < 4; ++i) { const int col = i * 256 + c.lane * 4;
            const f32x4 gv = *(const f32x4*)(g + col), sv = *(const f32x4*)(sh + col), cv = *(const f32x4*)(scl + col);
            float y[4];
#pragma unroll
            for (int e = 0; e < 4; ++e) y[e] = x[i][e] * rstd * gv[e] * (1.f + cv[e]) + sv[e];
            u32x2 w = {cvtpk(y[0], y[1]), cvtpk(y[2], y[3])};
            *(u32x2*)(dst + col) = w;
            if (WHICH == 0 && l == 0) *(f32x4*)(xr + col) = x[i]; }
        r = rn;
    }
}

constexpr int GEMM_LDS = 98304;
template <class Epi>
__device__ __forceinline__ void gemm_tile(const Ctx& c, const bf16_t* __restrict__ A, int lda, const bf16_t* __restrict__ Bt, int ldb, int K, int m0, int n0, char* lds, const Epi& epi) {
    const int tid = c.tid, lane = tid & 63, wid = tid >> 6, r32 = lane & 31, hi = lane >> 5, wm = wid >> 1, wn = wid & 1;
    char* As = lds; char* Bs = lds + 65536;
    f32x16 acc[2][2];
#pragma unroll
    for (int m = 0; m < 2; ++m)
#pragma unroll
        for (int n = 0; n < 2; ++n) zero_acc(acc[m][n]);
    u32x4 ra[4], rb[2];
    const int srow = tid >> 3, sch = tid & 7;
    const bf16_t* Ag = A + (size_t)(m0 + srow) * lda + sch * 8;
    const bf16_t* Bg = Bt + (size_t)(n0 + srow) * ldb + sch * 8;
    const int swoff = srow * 128 + ((sch ^ ((srow >> 1) & 7)) << 4);
#define GLOAD(k0) do { _Pragma("unroll") for (int i = 0; i < 4; ++i) ra[i] = *(const u32x4*)(Ag + (size_t)(64 * i) * lda + (k0)); \
                       _Pragma("unroll") for (int i = 0; i < 2; ++i) rb[i] = *(const u32x4*)(Bg + (size_t)(64 * i) * ldb + (k0)); } while (0)
#define SWRITE(buf) do { _Pragma("unroll") for (int i = 0; i < 4; ++i) *(u32x4*)(As + (buf) * 32768 + swoff + i * 8192) = ra[i]; \
                         _Pragma("unroll") for (int i = 0; i < 2; ++i) *(u32x4*)(Bs + (buf) * 16384 + swoff + i * 8192) = rb[i]; } while (0)
    const int nk = K >> 6;
    GLOAD(0); SWRITE(0); __syncthreads();
    for (int kt = 0; kt < nk; ++kt) {
        const int buf = kt & 1;
        if (kt + 1 < nk) GLOAD((kt + 1) * 64);
        const char* Ab = As + buf * 32768; const char* Bb = Bs + buf * 16384;
#pragma unroll
        for (int ks = 0; ks < 4; ++ks) {
            bf16x8 a[2], b[2];
#pragma unroll
            for (int m = 0; m < 2; ++m) { const int row = wm * 64 + m * 32 + r32; a[m] = *(const bf16x8*)(Ab + row * 128 + (((ks * 2 + hi) ^ ((row >> 1) & 7)) << 4)); }
#pragma unroll
            for (int n = 0; n < 2; ++n) { const int row = wn * 64 + n * 32 + r32; b[n] = *(const bf16x8*)(Bb + row * 128 + (((ks * 2 + hi) ^ ((row >> 1) & 7)) << 4)); }
#pragma unroll
            for (int m = 0; m < 2; ++m)
#pragma unroll
                for (int n = 0; n < 2; ++n) acc[m][n] = __builtin_amdgcn_mfma_f32_32x32x16_bf16(a[m], b[n], acc[m][n], 0, 0, 0);
        }
        if (kt + 1 < nk) SWRITE(buf ^ 1);
        __syncthreads();
    }
#undef GLOAD
#undef SWRITE
    epi(acc, m0 + wm * 64, n0 + wn * 64, r32, hi);
}
struct EpiBf16 {
    bf16_t* C; int ldc; float scale;
    __device__ __forceinline__ void operator()(const f32x16 (&acc)[2][2], int row0, int col0, int r32, int hi) const {
        bf16_t* base = C + (size_t)(row0 + 4 * hi) * ldc + col0 + r32;
#pragma unroll
        for (int m = 0; m < 2; ++m)
#pragma unroll
            for (int r = 0; r < 16; ++r) { bf16_t* p = base + (size_t)(m * 32 + (r & 3) + 8 * (r >> 2)) * ldc;
                p[0] = f2bf(acc[m][0][r] * scale); p[32] = f2bf(acc[m][1][r] * scale);
                asm volatile("" ::: "memory"); }
    }
};

template <int MX> struct ScanCfg;
template <> struct ScanCfg<0> { static constexpr int DK = 32; };
template <> struct ScanCfg<1> { static constexpr int DK = 64; };

constexpr int BP = 72;
typedef float f32x4v __attribute__((ext_vector_type(4)));
__device__ __forceinline__ bf16x8 frag16(const bf16_t* tile, int row0, int k0, int lane) { return *(const bf16x8*)(tile + (row0 + (lane & 15)) * BP + k0 + 8 * (lane >> 4)); }

constexpr int SCAN_TAB_OFF = 128000;
__device__ __forceinline__ void scan_tables(const Ctx& c, int l, char* lds) {
    float* wtab = (float*)(lds + SCAN_TAB_OFF); float* btab = wtab + 2 * 16 * 128; float* lbtab = btab + 2 * 128;
    for (int i = c.tid; i < 2 * 16 * 128; i += 512) wtab[i] = CIN(10)[(size_t)l * 2 * 16 * 128 + i];
    if (c.tid < 256) { btab[c.tid] = CIN(11)[(size_t)l * 256 + c.tid];
        float lb = 0.f; if (l > 0) { const float r0 = CIN(13)[c.tid], r1 = CIN(13)[256 + c.tid]; lb = 1.f / (1.f + __expf(r0 - r1)); }
        lbtab[c.tid] = lb; }
    __syncthreads();
}
template <int MX, bool WANT_Q>
__device__ __forceinline__ void scan_load(const Ctx& c, int l, int b, int h, int cc, int dir, float* qt, float* kt, float* gt, bf16_t* VT, float* tmp, const char* ldsb) {
    constexpr int DK = ScanCfg<MX>::DK, PK = DK + 1;
    const int tid = c.tid;
    const int t = tid >> 3, j0 = (tid & 7) * 8;
    const bf16_t* pr = C_P + (size_t)(b * RPB + cc * 64 + (dir ? 63 - t : t)) * INC;
    const u32x4 vv = *(const u32x4*)(pr + (MX == 0 ? GLA_V : HG_I) + h * 64 + j0);
    if (MX == 0) {
        float* zt = tmp; const float* wt = (const float*)(ldsb + SCAN_TAB_OFF) + dir * 16 * 128 + h * 32; const float* bt = (const float*)(ldsb + SCAN_TAB_OFF) + 2 * 16 * 128 + dir * 128 + h * 32;
        const int j4 = (tid & 7) * 4;
        const u32x2 kv = *(const u32x2*)(pr + GLA_K + h * 32 + j4);
        u32x2 qv = {0u, 0u}; if (WANT_Q) qv = *(const u32x2*)(pr + GLA_Q + h * 32 + j4);
        u32x4 zv = {0u, 0u, 0u, 0u};
        if (tid < 128) zv = *(const u32x4*)(C_P + (size_t)(b * RPB + cc * 64 + (dir ? 63 - (tid >> 1) : (tid >> 1))) * INC + (dir ? GLA_ZB : GLA_ZF) + (tid & 1) * 8);
        if (tid < 128) { float* zp = zt + (tid >> 1) * 16 + (tid & 1) * 8;
#pragma unroll
            for (int q = 0; q < 4; ++q) { zp[2 * q] = bflo(zv[q]); zp[2 * q + 1] = bfhi(zv[q]); } }
        __syncthreads();
#pragma unroll
        for (int e = 0; e < 4; ++e) { const int j = j4 + e;
            float a = bt[j];
#pragma unroll
            for (int k = 0; k < 16; ++k) a += zt[t * 16 + k] * wt[k * 128 + j];
            gt[t * PK + j] = logsigmoid_f(a) * (1.f / 16.f);
            kt[t * PK + j] = (e & 1) ? bfhi(kv[e >> 1]) : bflo(kv[e >> 1]);
            if (WANT_Q) qt[t * PK + j] = ((e & 1) ? bfhi(qv[e >> 1]) : bflo(qv[e >> 1])) * 0.17677669529663687f; }
    } else {
        const u32x4 zv = *(const u32x4*)(pr + (dir ? HG_ZB : HG_ZF) + h * 64 + j0);
        u32x4 qv = {0u, 0u, 0u, 0u}; if (WANT_Q) qv = *(const u32x4*)(pr + HG_Q + h * 64 + j0);
        float lbv[8];
        { const float* lbt = (const float*)(ldsb + SCAN_TAB_OFF) + 2 * 16 * 128 + 2 * 128 + h * 64 + j0;
#pragma unroll
          for (int e = 0; e < 8; ++e) lbv[e] = lbt[e]; }
#pragma unroll
        for (int e = 0; e < 8; ++e) { const int j = j0 + e;
            const float z = fminf(fmaxf((e & 1) ? bfhi(zv[e >> 1]) : bflo(zv[e >> 1]), -80.f), 80.f); const float lb = lbv[e];
            const float ez = __expf(-z), sg = __builtin_amdgcn_rcpf(1.f + ez);
            gt[t * PK + j] = fmaxf(__logf(lb + (1.f - lb) * sg), -69.07755279f);
            kt[t * PK + j] = (1.f - lb) * ez * sg;
            if (WANT_Q) { const float qz = (e & 1) ? bfhi(qv[e >> 1]) : bflo(qv[e >> 1]); qt[t * PK + j] = qz * __builtin_amdgcn_rcpf(1.f + __expf(-qz)); } }
    }
#pragma unroll
    for (int e = 0; e < 8; ++e) VT[(j0 + e) * BP + t] = (bf16_t)((e & 1) ? (vv[e >> 1] >> 16) : (vv[e >> 1] & 0xffffu));
    __syncthreads();
    { float x[DK / 8];
#pragma unroll
        for (int u = 0; u < DK / 8; ++u) x[u] = gt[c.lane * PK + c.wid + 8 * u];
#pragma unroll
        for (int d = 1; d < 64; d <<= 1)
#pragma unroll
            for (int u = 0; u < DK / 8; ++u) { const float y = __shfl_up(x[u], d, 64); if (c.lane >= d) x[u] += y; }
#pragma unroll
        for (int u = 0; u < DK / 8; ++u) gt[c.lane * PK + c.wid + 8 * u] = x[u]; }
    __syncthreads();
}

template <int MX>
__device__ void scanA_item(const Ctx& c, int l, int b, int h, int cc, int dir, char* lds) {
    constexpr int DK = ScanCfg<MX>::DK, PK = DK + 1;
    float* kt = (float*)lds; float* gt = kt + 64 * PK; bf16_t* VT = (bf16_t*)(gt + 64 * PK); bf16_t* KET = VT + 64 * BP; float* tmp = (float*)(KET + 64 * BP);
    scan_load<MX, false>(c, l, b, h, cc, dir, nullptr, kt, gt, VT, tmp, lds);
    const int tid = c.tid, lane = c.lane;
    for (int i = tid; i < 64 * DK; i += 512) { const int s_ = i & 63, k = i >> 6; KET[k * BP + s_] = f2bf(kt[s_ * PK + k] * __expf(gt[63 * PK + k] - gt[s_ * PK + k])); }
    __syncthreads();
    const int ch = (b * 4 + h) * 2 + dir;
    bf16_t* S = (MX == 0 ? C_SG : C_SH) + ((size_t)ch * NCHUNK + cc) * (DK * 64);
    for (int tile = c.wid; tile < (DK / 16) * 4; tile += 8) { const int tk = tile >> 2, tj = tile & 3;
        f32x4v acc = {0.f, 0.f, 0.f, 0.f};
#pragma unroll
        for (int ks = 0; ks < 2; ++ks) acc = __builtin_amdgcn_mfma_f32_16x16x32_bf16(frag16(KET, tk * 16, ks * 32, lane), frag16(VT, tj * 16, ks * 32, lane), acc, 0, 0, 0);
#pragma unroll
        for (int i = 0; i < 4; ++i) S[(tk * 16 + 4 * (lane >> 4) + i) * 64 + tj * 16 + (lane & 15)] = f2bf(acc[i]); }
    if (tid < DK) (MX == 0 ? C_DG : C_DH)[((size_t)ch * NCHUNK + cc) * DK + tid] = __expf(gt[63 * PK + tid]);
    __syncthreads();
}
__device__ void scanB_item(const Ctx& c, int item) {
    const int e = item * 512 + c.tid;
    const bool hg = e >= 65536; const int ee = hg ? e - 65536 : e;
    const int DK = hg ? 64 : 32; const int per = DK * 64;
    const int ch = ee / per, ij = ee % per, i = ij >> 6; const int dir = ch & 1;
    bf16_t* S = (hg ? C_SH : C_SG) + (size_t)ch * NCHUNK * per + ij;
    const float* Dc = (hg ? C_DH : C_DG) + (size_t)ch * NCHUNK * DK + i;
    float st = 0.f;
    for (int n0 = 0; n0 < NCHUNK; n0 += 6) {
        float sv[6], dv[6];
#pragma unroll
        for (int u = 0; u < 6; ++u) { const int n = n0 + u; const int cc = dir ? (n < 4 ? 3 - n : 135 - n) : n; sv[u] = bf2f(S[(size_t)cc * per]); dv[u] = Dc[(size_t)cc * DK]; }
#pragma unroll
        for (int u = 0; u < 6; ++u) { const int n = n0 + u; const int cc = dir ? (n < 4 ? 3 - n : 135 - n) : n; S[(size_t)cc * per] = f2bf(st); st = dv[u] * st + sv[u]; }
    }
}
template <int MX>
__device__ void scanC_item(const Ctx& c, int l, int b, int h, int cc, char* lds) {
    constexpr int DK = ScanCfg<MX>::DK, PK = DK + 1;
    float* qt = (float*)lds; float* kt = qt + 64 * PK; float* gt = kt + 64 * PK; float* ot = gt + 64 * PK;
    bf16_t* VT = (bf16_t*)(ot + 64 * 65); bf16_t* QS = VT + 64 * BP; bf16_t* QG = QS + 64 * BP; bf16_t* KS = QG + 64 * BP;
    bf16_t* SC = KS + 96 * BP; bf16_t* ST = SC + 64 * BP; float* tmp = (float*)(ST + 64 * BP);
    const int tid = c.tid, lane = c.lane;
    for (int dir = 0; dir < 2; ++dir) {
        scan_load<MX, true>(c, l, b, h, cc, dir, qt, kt, gt, VT, tmp, lds);
        const int ch = (b * 4 + h) * 2 + dir;
        const bf16_t* Sg = (MX == 0 ? C_SG : C_SH) + ((size_t)ch * NCHUNK + cc) * (DK * 64);
        if (tid < DK * 8) { const int k = tid >> 3, jb = (tid & 7) * 8; const u32x4 sr = *(const u32x4*)(Sg + tid * 8);
#pragma unroll
            for (int e = 0; e < 8; ++e) ST[(jb + e) * BP + k] = (bf16_t)((e & 1) ? (sr[e >> 1] >> 16) : (sr[e >> 1] & 0xffffu)); }
        for (int i = tid; i < 64 * DK; i += 512) { const int t = i / DK, k = i % DK; const int I = t >> 4;
            const float bt = gt[t * PK + k], qv = qt[t * PK + k], kv = kt[t * PK + k];
            const float Bi = I ? gt[(16 * I - 1) * PK + k] : 0.f;
            QS[t * BP + k] = f2bf(qv * __expf(bt - Bi));
            QG[t * BP + k] = f2bf(qv * __expf(bt));
            if (t < 16) KS[t * BP + k] = f2bf(kv * __expf(gt[15 * PK + k] - bt));
            if (t < 32) KS[(16 + t) * BP + k] = f2bf(kv * __expf(gt[31 * PK + k] - bt));
            if (t < 48) KS[(48 + t) * BP + k] = f2bf(kv * __expf(gt[47 * PK + k] - bt)); }
        { const int blk = tid >> 7, tl = (tid >> 3) & 15, s0 = (tid & 7) * 2; const int t = blk * 16 + tl;
            float a0 = 0.f, a1 = 0.f;
            if (s0 <= tl) { const int sa = blk * 16 + s0, sb = sa + 1;
                for (int k = 0; k < DK; ++k) { const float qv = qt[t * PK + k], bv = gt[t * PK + k];
                    a0 += qv * kt[sa * PK + k] * __expf(fminf(bv - gt[sa * PK + k], 0.f));
                    a1 += qv * kt[sb * PK + k] * __expf(fminf(bv - gt[sb * PK + k], 0.f)); }
                if (s0 + 1 > tl) a1 = 0.f; }
            SC[t * BP + blk * 16 + s0] = f2bf(a0); SC[t * BP + blk * 16 + s0 + 1] = f2bf(a1);
            for (int J = blk + 1; J < 4; ++J) { SC[t * BP + J * 16 + s0] = 0; SC[t * BP + J * 16 + s0 + 1] = 0; } }
        __syncthreads();
        if (c.wid < 6) { const int I = c.wid < 1 ? 1 : (c.wid < 3 ? 2 : 3), J = c.wid < 1 ? 0 : (c.wid < 3 ? c.wid - 1 : c.wid - 3);
            const bf16_t* KSI = KS + (I == 1 ? 0 : (I == 2 ? 16 : 48)) * BP;
            f32x4v acc = {0.f, 0.f, 0.f, 0.f};
#pragma unroll
            for (int ks = 0; ks < DK / 32; ++ks) acc = __builtin_amdgcn_mfma_f32_16x16x32_bf16(frag16(QS, I * 16, ks * 32, lane), frag16(KSI, J * 16, ks * 32, lane), acc, 0, 0, 0);
#pragma unroll
            for (int i = 0; i < 4; ++i) SC[(I * 16 + 4 * (lane >> 4) + i) * BP + J * 16 + (lane & 15)] = f2bf(acc[i]); }
        __syncthreads();
#pragma unroll
        for (int u = 0; u < 2; ++u) { const int tile = c.wid * 2 + u; const int ti = tile >> 2, tj = tile & 3;
            f32x4v acc = {0.f, 0.f, 0.f, 0.f};
#pragma unroll
            for (int ks = 0; ks < 2; ++ks) acc = __builtin_amdgcn_mfma_f32_16x16x32_bf16(frag16(SC, ti * 16, ks * 32, lane), frag16(VT, tj * 16, ks * 32, lane), acc, 0, 0, 0);
#pragma unroll
            for (int ks = 0; ks < DK / 32; ++ks) acc = __builtin_amdgcn_mfma_f32_16x16x32_bf16(frag16(QG, ti * 16, ks * 32, lane), frag16(ST, tj * 16, ks * 32, lane), acc, 0, 0, 0);
#pragma unroll
            for (int i = 0; i < 4; ++i) { const int t = ti * 16 + 4 * (lane >> 4) + i; const int to = dir ? 63 - t : t; float* op = ot + to * 65 + tj * 16 + (lane & 15);
                if (dir == 0) *op = acc[i]; else *op += acc[i]; } }
        __syncthreads();
    }
    { const int t = tid >> 3, j0 = (tid & 7) * 8; float o[8]; float ss = 0.f;
#pragma unroll
        for (int j = 0; j < 8; ++j) { o[j] = ot[t * 65 + j0 + j]; ss += o[j] * o[j]; }
        ss += __shfl_xor(ss, 1, 64); ss += __shfl_xor(ss, 2, 64); ss += __shfl_xor(ss, 4, 64);
        const float rstd = rsqrtf(ss * (1.f / 64.f) + NORM_EPS);
        const int r = b * RPB + cc * 64 + t;
        const float* gn = CIN(MX == 0 ? 12 : 14) + l * 64;
        const u32x4 gp = *(const u32x4*)(C_P + (size_t)r * INC + (MX == 0 ? GLA_R : HG_OG) + h * 64 + j0);
        float y[8];
#pragma unroll
        for (int j = 0; j < 8; ++j) y[j] = o[j] * rstd * gn[j0 + j] * silu_f((j & 1) ? bfhi(gp[j >> 1]) : bflo(gp[j >> 1]));
        u32x4 w = {cvtpk(y[0], y[1]), cvtpk(y[2], y[3]), cvtpk(y[4], y[5]), cvtpk(y[6], y[7])};
        *(u32x4*)(C_HB + (size_t)r * D + MX * 256 + h * 64 + j0) = w; }
    __syncthreads();
}

__device__ __forceinline__ void rope_cs(int pos, int i, float& cs, float& sn) {
    const float freq = __expf(-(float)i * (9.210340371976184f / 8.f));
    const float ang = (float)pos * freq;
    const float n = rintf(ang * 0.15915494309189535f);
    float rr = fmaf(-n, 6.2831854820251465f, ang); rr = fmaf(-n, -1.7484555e-7f, rr);
    cs = __cosf(rr); sn = __sinf(rr);
}

__device__ void ph_prep_rows(const Ctx& c, int l) {
    const float* gq = CIN(15) + l * 192; const float* gkv = CIN(16) + l * 128;
    for (int r = blockIdx.x * 8 + c.wid; r < NR; r += gridDim.x * 8) {
        const int b = r / RPB, j = r - b * RPB; bf16_t* pr = C_P + (size_t)r * INC;
        { float v[3]; float ss = 0.f;
#pragma unroll
            for (int i = 0; i < 3; ++i) { v[i] = bf2f(pr[MLA_CQ + c.lane + 64 * i]); ss += v[i] * v[i]; }
            ss = wave_sum(ss); const float rstd = rsqrtf(ss * (1.f / 192.f) + NORM_EPS);
#pragma unroll
            for (int i = 0; i < 3; ++i) pr[MLA_CQ + c.lane + 64 * i] = f2bf(v[i] * rstd * gq[c.lane + 64 * i]); }
        { float v[2]; float ss = 0.f;
#pragma unroll
            for (int i = 0; i < 2; ++i) { v[i] = bf2f(pr[MLA_CKV + c.lane + 64 * i]); ss += v[i] * v[i]; }
            ss = wave_sum(ss); const float rstd = rsqrtf(ss * (1.f / 128.f) + NORM_EPS);
#pragma unroll
            for (int i = 0; i < 2; ++i) pr[MLA_CKV + c.lane + 64 * i] = f2bf(v[i] * rstd * gkv[c.lane + 64 * i]); }
        if (j >= CTX) { const int t = j - CTX; const int prow = t >> 6, pcol = t & 63;
            for (int pp = c.lane; pp < 34 * 8; pp += 64) { const int g = pp >> 3, i = pp & 7;
                int col; if (g < 16) col = DF_Q + (g >> 1) * 32 + (g & 1) * 16; else if (g < 32) col = DF_K + ((g - 16) >> 1) * 32 + (g & 1) * 16; else col = MLA_KR + (g - 32) * 16;
                float cs, sn; rope_cs((g & 1) ? pcol : prow, i, cs, sn);
                const float x1 = bf2f(pr[col + i]), x2 = bf2f(pr[col + 8 + i]);
                pr[col + i] = f2bf(x1 * cs - x2 * sn); pr[col + 8 + i] = f2bf(x1 * sn + x2 * cs); } }
    }
}
__device__ void ph_rope_q(const Ctx& c) {
    for (int r = blockIdx.x * 8 + c.wid; r < NR; r += gridDim.x * 8) {
        const int b = r / RPB, j = r - b * RPB; if (j < CTX) continue;
        const int t = j - CTX; const int prow = t >> 6, pcol = t & 63;
        const int h = c.lane >> 4, g = (c.lane >> 3) & 1, i = c.lane & 7;
        bf16_t* q = C_QM + (size_t)r * 384 + h * 96 + 64 + g * 16;
        float cs, sn; rope_cs(g ? pcol : prow, i, cs, sn);
        const float x1 = bf2f(q[i]), x2 = bf2f(q[8 + i]);
        q[i] = f2bf(x1 * cs - x2 * sn); q[8 + i] = f2bf(x1 * sn + x2 * cs);
    }
}

__device__ __forceinline__ int v_st(int k, int cidx) { const int kk = (k & ~0xC) | ((k & 4) << 1) | ((k & 8) >> 1); return ((kk >> 3) * 2 + (cidx >> 5)) * 512 + ((kk & 7) * 32 + (cidx & 31)) * 2; }
__device__ __forceinline__ int v_rd_base(int lane) { return ((lane & 3) << 3) | (((lane >> 2) & 3) << 6) | (((lane >> 4) & 1) << 5) | (((lane >> 5) & 1) << 8); }
constexpr int v_rd_off(int d0, int ks, int half) { return d0 * 512 + ks * 2048 + half * 1024; }
template <int OFF> __device__ __forceinline__ s16x4 tr_read(int vb) { s16x4 r; asm volatile("ds_read_b64_tr_b16 %0, %1 offset:%2" : "=&v"(r) : "v"(vb), "i"(OFF) : "memory"); return r; }
template <int D0> __device__ __forceinline__ void pv_one(f32x16& od, int vb, bf16x8 pa0, bf16x8 pa1, bf16x8 pa2, bf16x8 pa3) {
    const s16x4 l0 = tr_read<v_rd_off(D0, 0, 0)>(vb), h0 = tr_read<v_rd_off(D0, 0, 1)>(vb), l1 = tr_read<v_rd_off(D0, 1, 0)>(vb), h1 = tr_read<v_rd_off(D0, 1, 1)>(vb);
    const s16x4 l2 = tr_read<v_rd_off(D0, 2, 0)>(vb), h2 = tr_read<v_rd_off(D0, 2, 1)>(vb), l3 = tr_read<v_rd_off(D0, 3, 0)>(vb), h3 = tr_read<v_rd_off(D0, 3, 1)>(vb);
    asm volatile("s_waitcnt lgkmcnt(0)" ::: "memory"); __builtin_amdgcn_sched_barrier(0);
#define PKV(L, H) (bf16x8){L[0], L[1], L[2], L[3], H[0], H[1], H[2], H[3]}
    od = __builtin_amdgcn_mfma_f32_32x32x16_bf16(pa0, PKV(l0, h0), od, 0, 0, 0);
    od = __builtin_amdgcn_mfma_f32_32x32x16_bf16(pa1, PKV(l1, h1), od, 0, 0, 0);
    od = __builtin_amdgcn_mfma_f32_32x32x16_bf16(pa2, PKV(l2, h2), od, 0, 0, 0);
    od = __builtin_amdgcn_mfma_f32_32x32x16_bf16(pa3, PKV(l3, h3), od, 0, 0, 0);
#undef PKV
}
constexpr float ATT_BIG = 1.0995116e12f;
constexpr float ATT_ZBIG = 1.2379400392853803e27f, ATT_ZSMALL = 8.673617379884035e-19f;
__device__ __forceinline__ float rowmax_tile(const f32x16& p0, const f32x16& p1) {
    float pmax = p0[0];
#pragma unroll
    for (int r = 1; r < 16; ++r) pmax = fmaxf(pmax, p0[r]);
#pragma unroll
    for (int r = 0; r < 16; ++r) pmax = fmaxf(pmax, p1[r]);
    auto rr = __builtin_amdgcn_permlane32_swap(__float_as_uint(pmax), __float_as_uint(pmax), false, false);
    return fmaxf(__uint_as_float(rr[0]), __uint_as_float(rr[1]));
}
__device__ __forceinline__ void softmax_tile(f32x16& p0, f32x16& p1, float& M, const float Mused, float& l_reg, const bool first,
                                             bf16x8& pa0, bf16x8& pa1, bf16x8& pa2, bf16x8& pa3, f32x16 (&o)[2], float* wsl, const int r32, const int hi) {
    if (__builtin_expect(__any(Mused != M), 0)) {
        asm volatile("" ::: "memory");
        const float dM = Mused - M;
#pragma unroll
        for (int r = 0; r < 16; ++r) { p0[r] += dM; p1[r] += dM; }
    }
    if (first) {
        float pmax = p0[0];
#pragma unroll
        for (int r = 1; r < 16; ++r) pmax = fmaxf(pmax, p0[r]);
#pragma unroll
        for (int r = 0; r < 16; ++r) pmax = fmaxf(pmax, p1[r]);
        { auto rr = __builtin_amdgcn_permlane32_swap(__float_as_uint(pmax), __float_as_uint(pmax), false, false); pmax = fmaxf(__uint_as_float(rr[0]), __uint_as_float(rr[1])); }
        M = pmax;
#pragma unroll
        for (int r = 0; r < 16; ++r) { p0[r] -= pmax; p1[r] -= pmax; }
    }
    float ps = 0.f;
#pragma unroll
    for (int r = 0; r < 16; ++r) { p0[r] = __builtin_amdgcn_exp2f(p0[r]); ps += p0[r]; }
#pragma unroll
    for (int r = 0; r < 16; ++r) { p1[r] = __builtin_amdgcn_exp2f(p1[r]); ps += p1[r]; }
    { auto rr = __builtin_amdgcn_permlane32_swap(__float_as_uint(ps), __float_as_uint(ps), false, false); ps = __uint_as_float(rr[0]) + __uint_as_float(rr[1]); }
    if (__builtin_expect(__any(ps > ATT_BIG), 0)) {
        asm volatile("" ::: "memory");
        float pm = p0[0];
#pragma unroll
        for (int r = 1; r < 16; ++r) pm = fmaxf(pm, p0[r]);
#pragma unroll
        for (int r = 0; r < 16; ++r) pm = fmaxf(pm, p1[r]);
        { auto rr = __builtin_amdgcn_permlane32_swap(__float_as_uint(pm), __float_as_uint(pm), false, false); pm = fmaxf(__uint_as_float(rr[0]), __uint_as_float(rr[1])); }
        const float alpha = pm > 1.f ? __builtin_amdgcn_rcpf(pm) : 1.f;
        M -= __builtin_amdgcn_logf(alpha);
#pragma unroll
        for (int r = 0; r < 16; ++r) { p0[r] *= alpha; p1[r] *= alpha; }
        ps *= alpha; l_reg *= alpha;
        if (hi == 0) wsl[r32] = alpha;
        asm volatile("s_waitcnt lgkmcnt(0)" ::: "memory");
#pragma unroll
        for (int r = 0; r < 16; ++r) { const float av = wsl[crow(r, hi)]; o[0][r] *= av; o[1][r] *= av; }
        asm volatile("" ::: "memory");
    }
    l_reg += ps;
#define PK4(P, BASE, OUT) do { unsigned a0 = cvtpk(P[BASE + 0], P[BASE + 1]), a1 = cvtpk(P[BASE + 2], P[BASE + 3]);   \
    unsigned b0 = cvtpk(P[BASE + 4], P[BASE + 5]), b1 = cvtpk(P[BASE + 6], P[BASE + 7]);                              \
    auto r0 = __builtin_amdgcn_permlane32_swap(a0, b0, false, false); auto r1 = __builtin_amdgcn_permlane32_swap(a1, b1, false, false); \
    u32x4 w = {r0[0], r1[0], r0[1], r1[1]}; OUT = *reinterpret_cast<bf16x8*>(&w); } while (0)
    PK4(p0, 0, pa0); PK4(p0, 8, pa1); PK4(p1, 0, pa2); PK4(p1, 8, pa3);
#undef PK4
}

constexpr int ATT_STAGE = 2 * 16384 + 2 * 8192;
constexpr int ATT_LDS = 2 * ATT_STAGE + 8 * 64 * 4 + 16;
template <bool DIFF>
__device__ void attn_item(const Ctx& c, int l, int b, int hd, int qrow0, int krow0, int nkeys, char* lds) {
    constexpr int DQK = DIFF ? 32 : 96, NMAP = DIFF ? 2 : 1, ND0 = DQK / 16, NU = 2 * NMAP;
    constexpr int KP = DIFF ? 64 : 256;
    constexpr int KSZ = 64 * KP;
    constexpr int NKR = DIFF ? 2 : 3;
    const int tid_ = mk_tid(c.wid);
    const int tid = tid_, lane = tid_ & 63, wid = c.wid, r32 = lane & 31, hi = lane >> 5;
    char* K_lds0 = lds; char* V_lds0 = lds + 2 * 16384; float* wsl = (float*)(lds + 2 * ATT_STAGE) + wid * 64;
    const float scale = DIFF ? 0.17677669529663687f : 0.10206207261596575f;
    const float C = scale * 1.4426950408889634f;
    bf16x8 qr[NMAP][ND0];
    { const int qrow = qrow0 + wid * 32 + r32;
#pragma unroll
        for (int m = 0; m < NMAP; ++m)
#pragma unroll
            for (int d0 = 0; d0 < ND0; ++d0) {
                const bf16_t* p = DIFF ? C_P + (size_t)qrow * INC + DF_Q + (hd * 2 + m) * 32 + d0 * 16 + hi * 8
                                       : C_QM + (size_t)qrow * 384 + hd * 96 + d0 * 16 + hi * 8;
                qr[m][d0] = *(const bf16x8*)p; } }
    f32x16 o[NMAP][2]; float m_reg[NMAP], l_reg[NMAP];
#pragma unroll
    for (int m = 0; m < NMAP; ++m) { m_reg[m] = 0.f; l_reg[m] = 0.f;
#pragma unroll
        for (int d = 0; d < 2; ++d) zero_acc(o[m][d]); }
    constexpr int NKP = DIFF ? 2 : 4;
    int ksrc[NKP], vsrc[2];
#pragma unroll
    for (int q = 0; q < NKP; ++q) { const int off = (wid * NKP + q) * 1024 + lane * 16;
        if (DIFF) { const int blk = off >> 12, key = (off & 4095) >> 6, slot = (off & 63) >> 4, ch = slot ^ ((key >> 2) & 3);
            ksrc[q] = ((blk >> 1) * 64 + key) * INC + DF_K + (hd * 2 + (blk & 1)) * 32 + ch * 8; }
        else { const int tile = off >> 14, key = (off & 16383) >> 8, slot = (off & 255) >> 4, ch = slot ^ (key & 7);
            ksrc[q] = ch < 8 ? -1 - ((tile * 64 + key) * 512 + hd * 128 + ch * 8) : (ch < 12 ? (tile * 64 + key) * INC + MLA_KR + (ch - 8) * 8 : (int)0x80000000); } }
#pragma unroll
    for (int q = 0; q < 2; ++q) { const int off = (wid * 2 + q) * 1024 + lane * 16; const int tile = off >> 13, w = off & 8191;
        const int sub = w >> 9, within = w & 511; const int kk = (sub >> 1) * 8 + (within >> 6); const int col = (sub & 1) * 32 + ((within & 63) >> 1);
        const int key = (kk & ~0xC) | ((kk & 4) << 1) | ((kk & 8) >> 1);
        vsrc[q] = DIFF ? (tile * 64 + key) * INC + DF_V + hd * 64 + col : (tile * 64 + key) * 512 + hd * 128 + 64 + col; }
    const int vb0 = (int)(uintptr_t)V_lds0 + v_rd_base(lane);
#define ADMA(buf, kr) do { \
        _Pragma("unroll") for (int q = 0; q < NKP; ++q) { LAS unsigned* dst_ = (LAS unsigned*)(LAS char*)(K_lds0 + (buf) * ATT_STAGE + (wid * NKP + q) * 1024); \
            if (DIFF || ksrc[q] >= 0) __builtin_amdgcn_global_load_lds((const unsigned*)(C_P + (size_t)(kr) * INC + ksrc[q]), dst_, 16, 0, 0); \
            else if (ksrc[q] != (int)0x80000000) __builtin_amdgcn_global_load_lds((const unsigned*)(C_KVM + (size_t)(kr) * 512 + (-1 - ksrc[q])), dst_, 16, 0, 0); } \
        _Pragma("unroll") for (int q = 0; q < 2; ++q) { LAS unsigned* dst_ = (LAS unsigned*)(LAS char*)(V_lds0 + (buf) * ATT_STAGE + (wid * 2 + q) * 1024); \
            __builtin_amdgcn_global_load_lds((const unsigned*)((DIFF ? C_P + (size_t)(kr) * INC : C_KVM + (size_t)(kr) * 512) + vsrc[q]), dst_, 16, 0, 0); } } while (0)
    const int NS = nkeys >> 7;
    ADMA(0, krow0);
    for (int j = 0; j < NS; ++j) {
        asm volatile("s_waitcnt vmcnt(0)" ::: "memory");
        __syncthreads();
        if (j + 1 < NS) ADMA((j + 1) & 1, krow0 + (j + 1) * 128);
        const char* K_lds = K_lds0 + (j & 1) * ATT_STAGE; const int vb = vb0 + (j & 1) * ATT_STAGE;
        f32x16 p0[2], p1[2]; float mused[2];
#define QKT(u) do { constexpr int tt_ = (u) / NMAP, m_ = (u) % NMAP; const char* Kb = K_lds + (tt_ * NMAP + m_) * KSZ; \
            _Pragma("unroll") for (int d0 = 0; d0 < ND0; ++d0) { bf16x8 b0, b1; \
                if (DIFF) { const int ch = d0 * 2 + hi; const int ra = r32, rb = 32 + r32; \
                    b0 = *(const bf16x8*)(Kb + ra * 64 + ((ch ^ ((ra >> 2) & 3)) << 4)); b1 = *(const bf16x8*)(Kb + rb * 64 + ((ch ^ ((rb >> 2) & 3)) << 4)); } \
                else { const int cb = d0 * 32 + hi * 16; const int ra = r32, rb = 32 + r32; \
                    b0 = *(const bf16x8*)(Kb + ra * 256 + (cb ^ ((ra & 7) << 4))); b1 = *(const bf16x8*)(Kb + rb * 256 + (cb ^ ((rb & 7) << 4))); } \
                if (d0 == 0) { const float nm_ = -m_reg[m_]; mused[(u) & 1] = m_reg[m_]; const f32x16 z = {nm_,nm_,nm_,nm_,nm_,nm_,nm_,nm_,nm_,nm_,nm_,nm_,nm_,nm_,nm_,nm_}; \
                    p0[(u) & 1] = __builtin_amdgcn_mfma_f32_32x32x16_bf16(b0, qr[m_][0], z, 0, 0, 0); p1[(u) & 1] = __builtin_amdgcn_mfma_f32_32x32x16_bf16(b1, qr[m_][0], z, 0, 0, 0); \
                    asm volatile("" :: "v"(b0), "v"(b1));   } \
                else { p0[(u) & 1] = __builtin_amdgcn_mfma_f32_32x32x16_bf16(b0, qr[m_][d0], p0[(u) & 1], 0, 0, 0); p1[(u) & 1] = __builtin_amdgcn_mfma_f32_32x32x16_bf16(b1, qr[m_][d0], p1[(u) & 1], 0, 0, 0); } } \
            if (!DIFF) {   \
                __builtin_amdgcn_sched_group_barrier(0x100, 4, 0); \
                _Pragma("unroll") for (int g_ = 0; g_ < 4; ++g_) { __builtin_amdgcn_sched_group_barrier(0x8, 2, 0); __builtin_amdgcn_sched_group_barrier(0x100, 2, 0); } \
                __builtin_amdgcn_sched_group_barrier(0x8, 4, 0); } } while (0)
        QKT(0);
#pragma unroll
        for (int u = 0; u < NU; ++u) {
            const int tt = u / NMAP, m = u % NMAP;
            if (u + 1 < NU) { if (u == 0) QKT(1); else if (u == 1) QKT(2); else QKT(3); }
            bf16x8 pa0, pa1, pa2, pa3;
            softmax_tile(p0[u & 1], p1[u & 1], m_reg[m], mused[u & 1], l_reg[m], (j == 0) && (tt == 0), pa0, pa1, pa2, pa3, o[m], wsl, r32, hi);
            pv_one<0>(o[m][0], vb + tt * 8192, pa0, pa1, pa2, pa3);
            pv_one<1>(o[m][1], vb + tt * 8192, pa0, pa1, pa2, pa3);
        }
#undef QKT
    }
#undef ADMA
    float rli[NMAP][16];
#pragma unroll
    for (int m = 0; m < NMAP; ++m) {
        asm volatile("s_waitcnt lgkmcnt(0)" ::: "memory");
        if (hi == 0) wsl[r32] = l_reg[m];
        asm volatile("s_waitcnt lgkmcnt(0)" ::: "memory");
#pragma unroll
        for (int r = 0; r < 16; ++r) rli[m][r] = __builtin_amdgcn_rcpf(wsl[crow(r, hi)]);
    }
    const int orow0 = qrow0 + wid * 32;
    if (!DIFF) {
#pragma unroll
        for (int r = 0; r < 16; ++r) { bf16_t* dst = C_HB + (size_t)(orow0 + crow(r, hi)) * D + 512 + hd * 64 + r32;
            dst[0] = f2bf(o[0][0][r] * rli[0][r]); dst[32] = f2bf(o[0][1][r] * rli[0][r]); }
    } else {
        const float* lp = CIN(19) + l * 128; const float* gn = CIN(20) + l * 64; asm volatile("" : "+s"(lp), "+s"(gn));
        float s1 = lp[r32] * lp[32 + r32], s2 = lp[64 + r32] * lp[96 + r32];
#pragma unroll
        for (int o = 1; o < 32; o <<= 1) { s1 += shx(s1, o, lane); s2 += shx(s2, o, lane); }
        const float lam_init = (l == 0) ? 0.2f : 0.35550906759097f;
        const float lam = __expf(s1) - __expf(s2) + lam_init;
        const float g0 = gn[r32] * (1.f - lam_init), g1 = gn[32 + r32] * (1.f - lam_init);
#pragma unroll
        for (int r = 0; r < 16; ++r) {
            const float v0 = o[0][0][r] * rli[0][r] - lam * o[NMAP - 1][0][r] * rli[NMAP - 1][r];
            const float v1 = o[0][1][r] * rli[0][r] - lam * o[NMAP - 1][1][r] * rli[NMAP - 1][r];
            float ss = v0 * v0 + v1 * v1;
            ss += shx(ss, 1, lane); ss += shx(ss, 2, lane); ss += shx(ss, 4, lane); ss += shx(ss, 8, lane); ss += shx(ss, 16, lane);
            const float rstd = rsqrtf(ss * (1.f / 64.f) + NORM_EPS);
            bf16_t* dst = C_HB + (size_t)(orow0 + crow(r, hi)) * D + 768 + hd * 64 + r32;
            dst[0] = f2bf(v0 * rstd * g0); dst[32] = f2bf(v1 * rstd * g1); }
    }
    __syncthreads();
}
template <bool DIFF>
__device__ bool attn_item_pair(const Ctx& c, int l, int b, int hd, int qrow0, int krow0, int nkeys, char* lds) {
    constexpr int DQK = DIFF ? 32 : 96, NMAP = DIFF ? 2 : 1, ND0 = DQK / 16, NU = 2 * NMAP;
    constexpr int KP = DIFF ? 64 : 256;
    constexpr int KSZ = 64 * KP;
    constexpr int NKR = DIFF ? 2 : 3;
    const int tid_ = mk_tid(c.wid);
    const int tid = tid_, lane = tid_ & 63, wid = c.wid, r32 = lane & 31, hi = lane >> 5;
    char* K_lds0 = lds; char* V_lds0 = lds + 2 * 16384; float* wsl = (float*)(lds + 2 * ATT_STAGE) + wid * 64;
    const float scale = DIFF ? 0.17677669529663687f : 0.10206207261596575f;
    const float C = scale * 1.4426950408889634f;
    bf16x8 qr[NMAP][ND0];
    { const int qrow = qrow0 + wid * 32 + r32;
#pragma unroll
        for (int m = 0; m < NMAP; ++m)
#pragma unroll
            for (int d0 = 0; d0 < ND0; ++d0) {
                const bf16_t* p = DIFF ? C_P + (size_t)qrow * INC + DF_Q + (hd * 2 + m) * 32 + d0 * 16 + hi * 8
                                       : C_QM + (size_t)qrow * 384 + hd * 96 + d0 * 16 + hi * 8;
                qr[m][d0] = *(const bf16x8*)p; } }
    f32x16 o[NMAP][2]; float m_reg[NMAP], l_reg[NMAP];
#pragma unroll
    for (int m = 0; m < NMAP; ++m) { m_reg[m] = 0.f; l_reg[m] = 0.f;
#pragma unroll
        for (int d = 0; d < 2; ++d) zero_acc(o[m][d]); }
    constexpr int NKP = DIFF ? 2 : 4;
    int ksrc[NKP], vsrc[2];
#pragma unroll
    for (int q = 0; q < NKP; ++q) { const int off = (wid * NKP + q) * 1024 + lane * 16;
        if (DIFF) { const int blk = off >> 12, key = (off & 4095) >> 6, slot = (off & 63) >> 4, ch = slot ^ ((key >> 2) & 3);
            ksrc[q] = ((blk >> 1) * 64 + key) * INC + DF_K + (hd * 2 + (blk & 1)) * 32 + ch * 8; }
        else { const int tile = off >> 14, key = (off & 16383) >> 8, slot = (off & 255) >> 4, ch = slot ^ (key & 7);
            ksrc[q] = ch < 8 ? -1 - ((tile * 64 + key) * 512 + hd * 128 + ch * 8) : (ch < 12 ? (tile * 64 + key) * INC + MLA_KR + (ch - 8) * 8 : (int)0x80000000); } }
#pragma unroll
    for (int q = 0; q < 2; ++q) { const int off = (wid * 2 + q) * 1024 + lane * 16; const int tile = off >> 13, w = off & 8191;
        const int sub = w >> 9, within = w & 511; const int kk = (sub >> 1) * 8 + (within >> 6); const int col = (sub & 1) * 32 + ((within & 63) >> 1);
        const int key = (kk & ~0xC) | ((kk & 4) << 1) | ((kk & 8) >> 1);
        vsrc[q] = DIFF ? (tile * 64 + key) * INC + DF_V + hd * 64 + col : (tile * 64 + key) * 512 + hd * 128 + 64 + col; }
    const int vb0 = (int)(uintptr_t)V_lds0 + v_rd_base(lane);
    unsigned kbo[NKP], vbo[2];
#pragma unroll
    for (int q = 0; q < NKP; ++q) kbo[q] = (DIFF || ksrc[q] >= 0) ? (unsigned)ksrc[q] * 2u : (unsigned)(-1 - ksrc[q]) * 2u;
#pragma unroll
    for (int q = 0; q < 2; ++q) vbo[q] = (unsigned)vsrc[q] * 2u;
#define ADMA(buf, kr) do { const char* pb_ = (const char*)C_P + (size_t)(kr) * (INC * 2); const char* kb_ = (const char*)C_KVM + (size_t)(kr) * 1024; asm volatile("" : "+s"(pb_), "+s"(kb_)); \
        _Pragma("unroll") for (int q = 0; q < NKP; ++q) { LAS unsigned* dst_ = (LAS unsigned*)(LAS char*)(K_lds0 + (buf) * ATT_STAGE + (wid * NKP + q) * 1024); \
            unsigned o_ = kbo[q]; asm volatile("" : "+v"(o_));     \
            if (DIFF || ksrc[q] >= 0) __builtin_amdgcn_global_load_lds((const unsigned*)(pb_ + (size_t)o_), dst_, 16, 0, 0); \
            else if (ksrc[q] != (int)0x80000000) __builtin_amdgcn_global_load_lds((const unsigned*)(kb_ + (size_t)o_), dst_, 16, 0, 0); } \
        _Pragma("unroll") for (int q = 0; q < 2; ++q) { LAS unsigned* dst_ = (LAS unsigned*)(LAS char*)(V_lds0 + (buf) * ATT_STAGE + (wid * 2 + q) * 1024); \
            unsigned o_ = vbo[q]; asm volatile("" : "+v"(o_)); \
            __builtin_amdgcn_global_load_lds((const unsigned*)((DIFF ? pb_ : kb_) + (size_t)o_), dst_, 16, 0, 0); } } while (0)
    f32x16 oB[2];
    if (!DIFF) { zero_acc(oB[0]); zero_acc(oB[1]); }
    float lB = 0.f;
    const int NS = nkeys >> 7;
    ADMA(0, krow0);
    for (int j = 0; j < NS; ++j) {
        asm volatile("s_waitcnt vmcnt(0)" ::: "memory");
        __syncthreads();
        if (j + 1 < NS) ADMA((j + 1) & 1, krow0 + (j + 1) * 128);
        const char* K_lds = K_lds0 + (j & 1) * ATT_STAGE; const int vb = vb0 + (j & 1) * ATT_STAGE;
#define KFR(tt, m, d0, h) (*(const bf16x8*)(K_lds + ((tt) * NMAP + (m)) * KSZ + \
            (DIFF ? (((h) * 32 + r32) * 64 + ((((d0) * 2 + hi) ^ ((((h) * 32 + r32) >> 2) & 3)) << 4)) : (((h) * 32 + r32) * 256 + (((d0) * 32 + hi * 16) ^ ((((h) * 32 + r32) & 7) << 4))))))
#pragma unroll
        for (int pi = 0; pi < (DIFF ? 2 : 1); ++pi) {
            const int tA = DIFF ? pi : 0, tB = DIFF ? pi : 1; constexpr int mA = 0, mB = NMAP - 1;
            f32x16 a0, a1, b0, b1;
            __builtin_amdgcn_sched_barrier(0);
            { const f32x16 zA = {0.f,0.f,0.f,0.f,0.f,0.f,0.f,0.f,0.f,0.f,0.f,0.f,0.f,0.f,0.f,0.f}; const f32x16 zB = zA;
#pragma unroll
              for (int d0 = 0; d0 < ND0; ++d0) {
                  const bf16x8 fa0 = KFR(tA, mA, d0, 0), fa1 = KFR(tA, mA, d0, 1), fb0 = KFR(tB, mB, d0, 0), fb1 = KFR(tB, mB, d0, 1);
                  if (d0 == 0) { a0 = __builtin_amdgcn_mfma_f32_32x32x16_bf16(fa0, qr[mA][0], zA, 0, 0, 0); b0 = __builtin_amdgcn_mfma_f32_32x32x16_bf16(fb0, qr[mB][0], zB, 0, 0, 0);
                                 a1 = __builtin_amdgcn_mfma_f32_32x32x16_bf16(fa1, qr[mA][0], zA, 0, 0, 0); b1 = __builtin_amdgcn_mfma_f32_32x32x16_bf16(fb1, qr[mB][0], zB, 0, 0, 0); }
                  else { a0 = __builtin_amdgcn_mfma_f32_32x32x16_bf16(fa0, qr[mA][d0], a0, 0, 0, 0); b0 = __builtin_amdgcn_mfma_f32_32x32x16_bf16(fb0, qr[mB][d0], b0, 0, 0, 0);
                         a1 = __builtin_amdgcn_mfma_f32_32x32x16_bf16(fa1, qr[mA][d0], a1, 0, 0, 0); b1 = __builtin_amdgcn_mfma_f32_32x32x16_bf16(fb1, qr[mB][d0], b1, 0, 0, 0); } } }
            float psA = 0.f, psB = 0.f;
#pragma unroll
            for (int r = 0; r < 16; ++r) { a0[r] = __builtin_amdgcn_exp2f(a0[r]); b0[r] = __builtin_amdgcn_exp2f(b0[r]); psA += a0[r]; psB += b0[r]; }
#pragma unroll
            for (int r = 0; r < 16; ++r) { a1[r] = __builtin_amdgcn_exp2f(a1[r]); b1[r] = __builtin_amdgcn_exp2f(b1[r]); psA += a1[r]; psB += b1[r]; }
            { auto rr = __builtin_amdgcn_permlane32_swap(__float_as_uint(psA), __float_as_uint(psA), false, false); psA = __uint_as_float(rr[0]) + __uint_as_float(rr[1]); }
            { auto rr = __builtin_amdgcn_permlane32_swap(__float_as_uint(psB), __float_as_uint(psB), false, false); psB = __uint_as_float(rr[0]) + __uint_as_float(rr[1]); }
            l_reg[mA] += psA; if (DIFF) l_reg[mB] += psB; else lB += psB;
            bf16x8 pa[4], pb[4];
#define PK4(P, BASE, OUT) do { unsigned a0_ = cvtpk(P[BASE + 0], P[BASE + 1]), a1_ = cvtpk(P[BASE + 2], P[BASE + 3]);   \
    unsigned b0_ = cvtpk(P[BASE + 4], P[BASE + 5]), b1_ = cvtpk(P[BASE + 6], P[BASE + 7]);                              \
    auto r0 = __builtin_amdgcn_permlane32_swap(a0_, b0_, false, false); auto r1 = __builtin_amdgcn_permlane32_swap(a1_, b1_, false, false); \
    u32x4 w = {r0[0], r1[0], r0[1], r1[1]}; OUT = *reinterpret_cast<bf16x8*>(&w); } while (0)
            PK4(a0, 0, pa[0]); PK4(b0, 0, pb[0]); PK4(a0, 8, pa[1]); PK4(b0, 8, pb[1]); PK4(a1, 0, pa[2]); PK4(b1, 0, pb[2]); PK4(a1, 8, pa[3]); PK4(b1, 8, pb[3]);
#undef PK4
#define PKV(L, H) (bf16x8){L[0], L[1], L[2], L[3], H[0], H[1], H[2], H[3]}
#define PVB(D0B) { const int va_ = vb + tA * 8192, vbb_ = vb + tB * 8192; f32x16& accA = o[mA][D0B]; f32x16& accB = DIFF ? o[mB][D0B] : oB[D0B]; \
              const s16x4 l0 = tr_read<v_rd_off(D0B, 0, 0)>(va_), h0 = tr_read<v_rd_off(D0B, 0, 1)>(va_), l1 = tr_read<v_rd_off(D0B, 1, 0)>(va_), h1 = tr_read<v_rd_off(D0B, 1, 1)>(va_); \
              const s16x4 l2 = tr_read<v_rd_off(D0B, 2, 0)>(va_), h2 = tr_read<v_rd_off(D0B, 2, 1)>(va_), l3 = tr_read<v_rd_off(D0B, 3, 0)>(va_), h3 = tr_read<v_rd_off(D0B, 3, 1)>(va_); \
              if (DIFF) { asm volatile("s_waitcnt lgkmcnt(0)" ::: "memory"); __builtin_amdgcn_sched_barrier(0); \
                  accA = __builtin_amdgcn_mfma_f32_32x32x16_bf16(pa[0], PKV(l0, h0), accA, 0, 0, 0); accB = __builtin_amdgcn_mfma_f32_32x32x16_bf16(pb[0], PKV(l0, h0), accB, 0, 0, 0); \
                  accA = __builtin_amdgcn_mfma_f32_32x32x16_bf16(pa[1], PKV(l1, h1), accA, 0, 0, 0); accB = __builtin_amdgcn_mfma_f32_32x32x16_bf16(pb[1], PKV(l1, h1), accB, 0, 0, 0); \
                  accA = __builtin_amdgcn_mfma_f32_32x32x16_bf16(pa[2], PKV(l2, h2), accA, 0, 0, 0); accB = __builtin_amdgcn_mfma_f32_32x32x16_bf16(pb[2], PKV(l2, h2), accB, 0, 0, 0); \
                  accA = __builtin_amdgcn_mfma_f32_32x32x16_bf16(pa[3], PKV(l3, h3), accA, 0, 0, 0); accB = __builtin_amdgcn_mfma_f32_32x32x16_bf16(pb[3], PKV(l3, h3), accB, 0, 0, 0); } \
              else { const s16x4 m0 = tr_read<v_rd_off(D0B, 0, 0)>(vbb_), n0 = tr_read<v_rd_off(D0B, 0, 1)>(vbb_), m1 = tr_read<v_rd_off(D0B, 1, 0)>(vbb_), n1 = tr_read<v_rd_off(D0B, 1, 1)>(vbb_); \
                  const s16x4 m2 = tr_read<v_rd_off(D0B, 2, 0)>(vbb_), n2 = tr_read<v_rd_off(D0B, 2, 1)>(vbb_), m3 = tr_read<v_rd_off(D0B, 3, 0)>(vbb_), n3 = tr_read<v_rd_off(D0B, 3, 1)>(vbb_); \
                  asm volatile("s_waitcnt lgkmcnt(0)" ::: "memory"); __builtin_amdgcn_sched_barrier(0); \
                  accA = __builtin_amdgcn_mfma_f32_32x32x16_bf16(pa[0], PKV(l0, h0), accA, 0, 0, 0); accB = __builtin_amdgcn_mfma_f32_32x32x16_bf16(pb[0], PKV(m0, n0), accB, 0, 0, 0); \
                  accA = __builtin_amdgcn_mfma_f32_32x32x16_bf16(pa[1], PKV(l1, h1), accA, 0, 0, 0); accB = __builtin_amdgcn_mfma_f32_32x32x16_bf16(pb[1], PKV(m1, n1), accB, 0, 0, 0); \
                  accA = __builtin_amdgcn_mfma_f32_32x32x16_bf16(pa[2], PKV(l2, h2), accA, 0, 0, 0); accB = __builtin_amdgcn_mfma_f32_32x32x16_bf16(pb[2], PKV(m2, n2), accB, 0, 0, 0); \
                  accA = __builtin_amdgcn_mfma_f32_32x32x16_bf16(pa[3], PKV(l3, h3), accA, 0, 0, 0); accB = __builtin_amdgcn_mfma_f32_32x32x16_bf16(pb[3], PKV(m3, n3), accB, 0, 0, 0); } }
            PVB(0) PVB(1)
#undef PVB
#undef PKV
        }
#undef KFR
    }
#undef ADMA
    if (!DIFF) {
#pragma unroll
        for (int d = 0; d < 2; ++d)
#pragma unroll
            for (int r = 0; r < 16; ++r) o[0][d][r] += oB[d][r];
        l_reg[0] += lB; }
    float rli[NMAP][16];
#pragma unroll
    for (int m = 0; m < NMAP; ++m) {
        asm volatile("s_waitcnt lgkmcnt(0)" ::: "memory");
        if (hi == 0) wsl[r32] = l_reg[m];
        asm volatile("s_waitcnt lgkmcnt(0)" ::: "memory");
#pragma unroll
        for (int r = 0; r < 16; ++r) rli[m][r] = __builtin_amdgcn_rcpf(wsl[crow(r, hi)]);
    }
    const int orow0 = qrow0 + wid * 32;
    if (!DIFF) {
#pragma unroll
        for (int r = 0; r < 16; ++r) { bf16_t* dst = C_HB + (size_t)(orow0 + crow(r, hi)) * D + 512 + hd * 64 + r32;
            dst[0] = f2bf(o[0][0][r] * rli[0][r]); dst[32] = f2bf(o[0][1][r] * rli[0][r]); }
    } else {
        const float* lp = CIN(19) + l * 128; const float* gn = CIN(20) + l * 64; asm volatile("" : "+s"(lp), "+s"(gn));
        float s1 = lp[r32] * lp[32 + r32], s2 = lp[64 + r32] * lp[96 + r32];
#pragma unroll
        for (int o = 1; o < 32; o <<= 1) { s1 += shx(s1, o, lane); s2 += shx(s2, o, lane); }
        const float lam_init = (l == 0) ? 0.2f : 0.35550906759097f;
        const float lam = __expf(s1) - __expf(s2) + lam_init;
        const float g0 = gn[r32] * (1.f - lam_init), g1 = gn[32 + r32] * (1.f - lam_init);
#pragma unroll
        for (int r = 0; r < 16; ++r) {
            const float v0 = o[0][0][r] * rli[0][r] - lam * o[NMAP - 1][0][r] * rli[NMAP - 1][r];
            const float v1 = o[0][1][r] * rli[0][r] - lam * o[NMAP - 1][1][r] * rli[NMAP - 1][r];
            float ss = v0 * v0 + v1 * v1;
            ss += shx(ss, 1, lane); ss += shx(ss, 2, lane); ss += shx(ss, 4, lane); ss += shx(ss, 8, lane); ss += shx(ss, 16, lane);
            const float rstd = rsqrtf(ss * (1.f / 64.f) + NORM_EPS);
            bf16_t* dst = C_HB + (size_t)(orow0 + crow(r, hi)) * D + 768 + hd * 64 + r32;
            dst[0] = f2bf(v0 * rstd * g0); dst[32] = f2bf(v1 * rstd * g1); }
    }
    int* flag = (int*)(lds + 2 * ATT_STAGE + 8 * 64 * 4);
    __syncthreads();
    if (tid == 0) *flag = 0;
    __syncthreads();
    if (!(l_reg[0] <= ATT_ZBIG && l_reg[0] >= ATT_ZSMALL) || !(l_reg[NMAP - 1] <= ATT_ZBIG && l_reg[NMAP - 1] >= ATT_ZSMALL)) *flag = 1;
    __syncthreads();
    const bool redo = *flag != 0;
    __syncthreads();
    return redo;
}
template <int G, int I>
__device__ __forceinline__ void att_microop(f32x16& p0, f32x16& p1, float& ps, bf16x8 (&pa)[4]) {
    f32x16& P = (G < 2) ? p0 : p1; constexpr int B = (G & 1) * 8;
    if constexpr (I < 4) { constexpr int r = B + 2 * I;
        P[r] = __builtin_amdgcn_exp2f(P[r]); P[r + 1] = __builtin_amdgcn_exp2f(P[r + 1]); ps += P[r]; ps += P[r + 1]; }
    else { const unsigned a0 = cvtpk(P[B + 0], P[B + 1]), a1 = cvtpk(P[B + 2], P[B + 3]), b0 = cvtpk(P[B + 4], P[B + 5]), b1 = cvtpk(P[B + 6], P[B + 7]);
        auto r0 = __builtin_amdgcn_permlane32_swap(a0, b0, false, false); auto r1 = __builtin_amdgcn_permlane32_swap(a1, b1, false, false);
        u32x4 w = {r0[0], r1[0], r0[1], r1[1]}; pa[G] = *reinterpret_cast<bf16x8*>(&w); }
}
template <int GB, int S, int NSL>
__device__ __forceinline__ void att_slot_ops(f32x16& p0, f32x16& p1, float& ps, bf16x8 (&pa)[4]) {
#define MOP(m) if constexpr (((m) * NSL) / 10 == S) att_microop<GB + (m) / 5, (m) % 5>(p0, p1, ps, pa);
    MOP(0) MOP(1) MOP(2) MOP(3) MOP(4) MOP(5) MOP(6) MOP(7) MOP(8) MOP(9)
#undef MOP
}
template <bool DIFF>
__device__ bool attn_item_fast(const Ctx& c, int l, int b, int hd, int qrow0, int krow0, int nkeys, char* lds) {
    constexpr int DQK = DIFF ? 32 : 96, NMAP = DIFF ? 2 : 1, ND0 = DQK / 16, NU = 2 * NMAP, NA = 2 * ND0;
    constexpr int KP = DIFF ? 64 : 256, KSZ = 64 * KP;
    const int tid_ = mk_tid(c.wid);
    const int tid = tid_, lane = tid_ & 63, wid = c.wid, r32 = lane & 31, hi = lane >> 5;
    char* K_lds0 = lds; char* V_lds0 = lds + 2 * 16384; float* wsl = (float*)(lds + 2 * ATT_STAGE) + wid * 64;
    bf16x8 qr[NMAP][ND0];
    { const int qrow = qrow0 + wid * 32 + r32;
#pragma unroll
        for (int m = 0; m < NMAP; ++m)
#pragma unroll
            for (int d0 = 0; d0 < ND0; ++d0) {
                const bf16_t* p = DIFF ? C_P + (size_t)qrow * INC + DF_Q + (hd * 2 + m) * 32 + d0 * 16 + hi * 8
                                       : C_QM + (size_t)qrow * 384 + hd * 96 + d0 * 16 + hi * 8;
                qr[m][d0] = *(const bf16x8*)p; } }
    f32x16 o[NMAP][2]; float m_reg[NMAP], l_reg[NMAP];
#pragma unroll
    for (int m = 0; m < NMAP; ++m) { m_reg[m] = 0.f; l_reg[m] = 0.f;
#pragma unroll
        for (int d = 0; d < 2; ++d) zero_acc(o[m][d]); }
    constexpr int NKP = DIFF ? 2 : 4;
    int ksrc[NKP], vsrc[2];
#pragma unroll
    for (int q = 0; q < NKP; ++q) { const int off = (wid * NKP + q) * 1024 + lane * 16;
        if (DIFF) { const int blk = off >> 12, key = (off & 4095) >> 6, slot = (off & 63) >> 4, ch = slot ^ ((key >> 2) & 3);
            ksrc[q] = ((blk >> 1) * 64 + key) * INC + DF_K + (hd * 2 + (blk & 1)) * 32 + ch * 8; }
        else { const int tile = off >> 14, key = (off & 16383) >> 8, slot = (off & 255) >> 4, ch = slot ^ (key & 7);
            ksrc[q] = ch < 8 ? -1 - ((tile * 64 + key) * 512 + hd * 128 + ch * 8) : (ch < 12 ? (tile * 64 + key) * INC + MLA_KR + (ch - 8) * 8 : (int)0x80000000); } }
#pragma unroll
    for (int q = 0; q < 2; ++q) { const int off = (wid * 2 + q) * 1024 + lane * 16; const int tile = off >> 13, w = off & 8191;
        const int sub = w >> 9, within = w & 511; const int kk = (sub >> 1) * 8 + (within >> 6); const int col = (sub & 1) * 32 + ((within & 63) >> 1);
        const int key = (kk & ~0xC) | ((kk & 4) << 1) | ((kk & 8) >> 1);
        vsrc[q] = DIFF ? (tile * 64 + key) * INC + DF_V + hd * 64 + col : (tile * 64 + key) * 512 + hd * 128 + 64 + col; }
    const int vb0 = (int)(uintptr_t)V_lds0 + v_rd_base(lane);
#define ADMA(buf, kr) do { \
        _Pragma("unroll") for (int q = 0; q < NKP; ++q) { LAS unsigned* dst_ = (LAS unsigned*)(LAS char*)(K_lds0 + (buf) * ATT_STAGE + (wid * NKP + q) * 1024); \
            if (DIFF || ksrc[q] >= 0) __builtin_amdgcn_global_load_lds((const unsigned*)(C_P + (size_t)(kr) * INC + ksrc[q]), dst_, 16, 0, 0); \
            else if (ksrc[q] != (int)0x80000000) __builtin_amdgcn_global_load_lds((const unsigned*)(C_KVM + (size_t)(kr) * 512 + (-1 - ksrc[q])), dst_, 16, 0, 0); } \
        _Pragma("unroll") for (int q = 0; q < 2; ++q) { LAS unsigned* dst_ = (LAS unsigned*)(LAS char*)(V_lds0 + (buf) * ATT_STAGE + (wid * 2 + q) * 1024); \
            __builtin_amdgcn_global_load_lds((const unsigned*)((DIFF ? C_P + (size_t)(kr) * INC : C_KVM + (size_t)(kr) * 512) + vsrc[q]), dst_, 16, 0, 0); } } while (0)
#define SB() __builtin_amdgcn_sched_barrier(0)
    const int NS = nkeys >> 7;
    ADMA(0, krow0);
    float bad = 0.f;
    for (int j = 0; j < NS; ++j) {
        asm volatile("s_waitcnt vmcnt(0)" ::: "memory");
        __syncthreads();
        if (j + 1 < NS) ADMA((j + 1) & 1, krow0 + (j + 1) * 128);
        const char* K_lds = K_lds0 + (j & 1) * ATT_STAGE; const int vb = vb0 + (j & 1) * ATT_STAGE;
        f32x16 p0[2], p1[2]; bf16x8 pa[2][4]; float ps[2]; bf16x8 kfw[3];
#define KFRAG(u, d0, h) (*(const bf16x8*)(K_lds + (((u) / NMAP) * NMAP + ((u) % NMAP)) * KSZ + \
            (DIFF ? (((h) * 32 + r32) * 64 + ((((d0) * 2 + hi) ^ ((((h) * 32 + r32) >> 2) & 3)) << 4)) : (((h) * 32 + r32) * 256 + (((d0) * 32 + hi * 16) ^ ((((h) * 32 + r32) & 7) << 4))))))
#define QMFMA(u, s, frag) do { constexpr int d0_ = (s) >> 1, m_ = (u) % NMAP; f32x16& acc_ = ((s) & 1) ? p1[(u) & 1] : p0[(u) & 1]; \
            if (d0_ == 0) { const float nm_ = -m_reg[m_]; const f32x16 z = {nm_,nm_,nm_,nm_,nm_,nm_,nm_,nm_,nm_,nm_,nm_,nm_,nm_,nm_,nm_,nm_}; acc_ = __builtin_amdgcn_mfma_f32_32x32x16_bf16(frag, qr[m_][0], z, 0, 0, 0); } \
            else acc_ = __builtin_amdgcn_mfma_f32_32x32x16_bf16(frag, qr[m_][d0_], acc_, 0, 0, 0); } while (0)
        if (j == 0) {
#pragma unroll
            for (int m = 0; m < NMAP; ++m) {
#pragma unroll
                for (int d0 = 0; d0 < ND0; ++d0) { const bf16x8 f0 = KFRAG(m, d0, 0), f1 = KFRAG(m, d0, 1);
                    if (d0 == 0) { const f32x16 z = {0.f,0.f,0.f,0.f,0.f,0.f,0.f,0.f,0.f,0.f,0.f,0.f,0.f,0.f,0.f,0.f};
                        p0[0] = __builtin_amdgcn_mfma_f32_32x32x16_bf16(f0, qr[m][0], z, 0, 0, 0); p1[0] = __builtin_amdgcn_mfma_f32_32x32x16_bf16(f1, qr[m][0], z, 0, 0, 0); }
                    else { p0[0] = __builtin_amdgcn_mfma_f32_32x32x16_bf16(f0, qr[m][d0], p0[0], 0, 0, 0); p1[0] = __builtin_amdgcn_mfma_f32_32x32x16_bf16(f1, qr[m][d0], p1[0], 0, 0, 0); } }
                m_reg[m] = rowmax_tile(p0[0], p1[0]); }
        }
        {
#pragma unroll
            for (int sidx = 0; sidx < NA; ++sidx) { const bf16x8 f = (sidx & 1) ? KFRAG(0, sidx >> 1, 1) : KFRAG(0, sidx >> 1, 0);
                if (sidx == 0) QMFMA(0, 0, f); else if (sidx == 1) QMFMA(0, 1, f); else if (sidx == 2) QMFMA(0, 2, f); else if (sidx == 3) QMFMA(0, 3, f);
                else if (sidx == 4) QMFMA(0, 4, f); else if (sidx == 5) QMFMA(0, 5, f); else if (sidx == 6) QMFMA(0, 6, f); else if (sidx == 7) QMFMA(0, 7, f);
                else if (sidx == 8) QMFMA(0, 8, f); else if (sidx == 9) QMFMA(0, 9, f); else if (sidx == 10) QMFMA(0, 10, f); else QMFMA(0, 11, f); }
            ps[0] = 0.f;
            att_slot_ops<0, 0, 1>(p0[0], p1[0], ps[0], pa[0]);
            SB();
        }
#define STEP(u) do { constexpr int m_ = (u) % NMAP, tt_ = (u) / NMAP; constexpr bool nxt_ = ((u) + 1 < NU); \
              \
            if (nxt_) { ps[((u) + 1) & 1] = 0.f; kfw[0] = KFRAG((u) + 1, 0, 0); kfw[1] = KFRAG((u) + 1, 0, 1); \
                PHA(u, 0) PHA(u, 1) PHA(u, 2) PHA(u, 3) if (NA > 4) { PHA(u, 4) PHA(u, 5) PHA(u, 6) PHA(u, 7) PHA(u, 8) PHA(u, 9) PHA(u, 10) PHA(u, 11) } } \
            else { att_slot_ops<2, 0, 1>(p0[(u) & 1], p1[(u) & 1], ps[(u) & 1], pa[(u) & 1]); SB(); } \
            { float t_ = ps[(u) & 1]; auto rr = __builtin_amdgcn_permlane32_swap(__float_as_uint(t_), __float_as_uint(t_), false, false); t_ = __uint_as_float(rr[0]) + __uint_as_float(rr[1]); \
              l_reg[m_] += t_; bad = fmaxf(bad, t_); } \
              \
            PHB(u, 0) PHB(u, 1) } while (0)
#define PHA(u, s) { if ((s) < NA) { if ((s) + 2 < NA) kfw[((s) + 2) % 3] = (((s) + 2) & 1) ? KFRAG((u) + 1, ((s) + 2) >> 1, 1) : KFRAG((u) + 1, ((s) + 2) >> 1, 0); \
              QMFMA((u) + 1, (s), kfw[(s) % 3]); \
              att_slot_ops<2, (s), NA>(p0[(u) & 1], p1[(u) & 1], ps[(u) & 1], pa[(u) & 1]); SB(); } }
#define PHB(u, d0b) { const int vbb_ = vb + ((u) / NMAP) * 8192; \
              const s16x4 l0 = tr_read<v_rd_off(d0b, 0, 0)>(vbb_), h0 = tr_read<v_rd_off(d0b, 0, 1)>(vbb_), l1 = tr_read<v_rd_off(d0b, 1, 0)>(vbb_), h1 = tr_read<v_rd_off(d0b, 1, 1)>(vbb_); \
              const s16x4 l2 = tr_read<v_rd_off(d0b, 2, 0)>(vbb_), h2 = tr_read<v_rd_off(d0b, 2, 1)>(vbb_), l3 = tr_read<v_rd_off(d0b, 3, 0)>(vbb_), h3 = tr_read<v_rd_off(d0b, 3, 1)>(vbb_); \
              asm volatile("s_waitcnt lgkmcnt(0)" ::: "memory"); SB(); \
              f32x16& od_ = o[(u) % NMAP][d0b]; \
              od_ = __builtin_amdgcn_mfma_f32_32x32x16_bf16(pa[(u) & 1][0], PKV(l0, h0), od_, 0, 0, 0); if ((u) + 1 < NU) att_slot_ops<0, (d0b) * 4 + 0, 8>(p0[((u) + 1) & 1], p1[((u) + 1) & 1], ps[((u) + 1) & 1], pa[((u) + 1) & 1]); SB(); \
              od_ = __builtin_amdgcn_mfma_f32_32x32x16_bf16(pa[(u) & 1][1], PKV(l1, h1), od_, 0, 0, 0); if ((u) + 1 < NU) att_slot_ops<0, (d0b) * 4 + 1, 8>(p0[((u) + 1) & 1], p1[((u) + 1) & 1], ps[((u) + 1) & 1], pa[((u) + 1) & 1]); SB(); \
              od_ = __builtin_amdgcn_mfma_f32_32x32x16_bf16(pa[(u) & 1][2], PKV(l2, h2), od_, 0, 0, 0); if ((u) + 1 < NU) att_slot_ops<0, (d0b) * 4 + 2, 8>(p0[((u) + 1) & 1], p1[((u) + 1) & 1], ps[((u) + 1) & 1], pa[((u) + 1) & 1]); SB(); \
              od_ = __builtin_amdgcn_mfma_f32_32x32x16_bf16(pa[(u) & 1][3], PKV(l3, h3), od_, 0, 0, 0); if ((u) + 1 < NU) att_slot_ops<0, (d0b) * 4 + 3, 8>(p0[((u) + 1) & 1], p1[((u) + 1) & 1], ps[((u) + 1) & 1], pa[((u) + 1) & 1]); SB(); }
#define PKV(L, H) (bf16x8){L[0], L[1], L[2], L[3], H[0], H[1], H[2], H[3]}
        STEP(0); STEP(1);
        if (NU > 2) { STEP(2 % NU); STEP(3 % NU); }
#undef PKV
#undef PHB
#undef PHA
#undef STEP
#undef QMFMA
#undef KFRAG
    }
#undef SB
#undef ADMA
    float rli[NMAP][16];
#pragma unroll
    for (int m = 0; m < NMAP; ++m) {
        asm volatile("s_waitcnt lgkmcnt(0)" ::: "memory");
        if (hi == 0) wsl[r32] = l_reg[m];
        asm volatile("s_waitcnt lgkmcnt(0)" ::: "memory");
#pragma unroll
        for (int r = 0; r < 16; ++r) rli[m][r] = __builtin_amdgcn_rcpf(wsl[crow(r, hi)]);
    }
    const int orow0 = qrow0 + wid * 32;
    if (!DIFF) {
#pragma unroll
        for (int r = 0; r < 16; ++r) { bf16_t* dst = C_HB + (size_t)(orow0 + crow(r, hi)) * D + 512 + hd * 64 + r32;
            dst[0] = f2bf(o[0][0][r] * rli[0][r]); dst[32] = f2bf(o[0][1][r] * rli[0][r]); }
    } else {
        const float* lp = CIN(19) + l * 128; const float* gn = CIN(20) + l * 64; asm volatile("" : "+s"(lp), "+s"(gn));
        float s1 = lp[r32] * lp[32 + r32], s2 = lp[64 + r32] * lp[96 + r32];
#pragma unroll
        for (int o = 1; o < 32; o <<= 1) { s1 += shx(s1, o, lane); s2 += shx(s2, o, lane); }
        const float lam_init = (l == 0) ? 0.2f : 0.35550906759097f;
        const float lam = __expf(s1) - __expf(s2) + lam_init;
        const float g0 = gn[r32] * (1.f - lam_init), g1 = gn[32 + r32] * (1.f - lam_init);
#pragma unroll
        for (int r = 0; r < 16; ++r) {
            const float v0 = o[0][0][r] * rli[0][r] - lam * o[NMAP - 1][0][r] * rli[NMAP - 1][r];
            const float v1 = o[0][1][r] * rli[0][r] - lam * o[NMAP - 1][1][r] * rli[NMAP - 1][r];
            float ss = v0 * v0 + v1 * v1;
            ss += shx(ss, 1, lane); ss += shx(ss, 2, lane); ss += shx(ss, 4, lane); ss += shx(ss, 8, lane); ss += shx(ss, 16, lane);
            const float rstd = rsqrtf(ss * (1.f / 64.f) + NORM_EPS);
            bf16_t* dst = C_HB + (size_t)(orow0 + crow(r, hi)) * D + 768 + hd * 64 + r32;
            dst[0] = f2bf(v0 * rstd * g0); dst[32] = f2bf(v1 * rstd * g1); }
    }
    int* flag = (int*)(lds + 2 * ATT_STAGE + 8 * 64 * 4);
    __syncthreads();
    if (tid == 0) *flag = 0;
    __syncthreads();
    if (!(bad <= ATT_BIG)) *flag = 1;
    __syncthreads();
    const bool redo = *flag != 0;
    __syncthreads();
    return redo;
}
#ifndef PAIR_DIFF
#define PAIR_DIFF 1
#endif
#ifndef PAIR_MLA
#define PAIR_MLA 1
#endif
__device__ void ph_attn(const Ctx& c, int l, char* lds) {
    const bool need_ctx = (l < DEPTH - 1);
    const int nitem = 1024 + (need_ctx ? 32 : 0);
    for (int it = blockIdx.x; it < nitem; it += gridDim.x) {
        bool diff; int b, hd, q0, k0, nk;
        if (it < 1024) { const int u = it & 511; diff = it < 512; b = u >> 7; hd = (u >> 5) & 3; q0 = b * RPB + CTX + (u & 31) * 256; k0 = b * RPB; nk = RPB; }
        else { const int u = it - 1024; diff = u < 16; b = u & 3; hd = (u >> 2) & 3; q0 = b * RPB; k0 = b * RPB; nk = CTX; }
#if PAIR_DIFF
        if (diff) { if (attn_item_pair<true>(c, l, b, hd, q0, k0, nk, lds)) attn_item<true>(c, l, b, hd, q0, k0, nk, lds); }
#else
        if (diff) attn_item<true>(c, l, b, hd, q0, k0, nk, lds);
#endif
#if PAIR_MLA
        else { if (attn_item_pair<false>(c, l, b, hd, q0, k0, nk, lds)) attn_item<false>(c, l, b, hd, q0, k0, nk, lds); }
#else
        else { if (attn_item_fast<false>(c, l, b, hd, q0, k0, nk, lds)) attn_item<false>(c, l, b, hd, q0, k0, nk, lds); }
#endif
    }
}

typedef float f32v2 __attribute__((ext_vector_type(2)));
__device__ void cvt_tables(const Ctx& c, int l) {
    for (int row = blockIdx.x * 8 + c.wid; row < 2 * NEXP; row += gridDim.x * 8) {
        const bool isu = row < NEXP; const int e = isu ? row : row - NEXP;
        const float* s = CIN(isu ? 23 : 24) + ((size_t)l * NEXP + e) * D + c.lane * 16;
        f32x4 v[4]; float mx = 0.f;
#pragma unroll
        for (int i = 0; i < 4; ++i) { v[i] = *(const f32x4*)(s + 4 * i); mx = fmaxf(mx, fmaxf(fmaxf(fabsf(v[i][0]), fabsf(v[i][1])), fmaxf(fabsf(v[i][2]), fabsf(v[i][3])))); }
#pragma unroll
        for (int o = 32; o >= 1; o >>= 1) mx = fmaxf(mx, __shfl_xor(mx, o, 64));
        const float q = mx > 0.f ? 256.f / mx : 0.f;
        if (c.lane == 0) (isu ? C_SU : C_SV)[e] = mx * (1.f / 256.f);
        u32x4 w;
#pragma unroll
        for (int i = 0; i < 4; ++i) { int p = 0; p = __builtin_amdgcn_cvt_pk_fp8_f32(v[i][0] * q, v[i][1] * q, p, false); p = __builtin_amdgcn_cvt_pk_fp8_f32(v[i][2] * q, v[i][3] * q, p, true); w[i] = (unsigned)p; }
        *(u32x4*)((isu ? C_TU8 : C_TV8) + ((size_t)(c.lane >> 3) * NEXP + e) * 128 + (c.lane & 7) * 16) = w;
    }
}
__device__ __forceinline__ unsigned ford(float x) { const unsigned u = __float_as_uint(x); return (u & 0x80000000u) ? ~u : (u | 0x80000000u); }
__device__ __forceinline__ float funord(unsigned k) { const unsigned u = (k & 0x80000000u) ? (k & 0x7fffffffu) : ~k; return __uint_as_float(u); }
__device__ __forceinline__ void sort16_desc(unsigned (&v)[16]) {
#pragma unroll
    for (int k = 2; k <= 16; k <<= 1)
#pragma unroll
        for (int j = k >> 1; j > 0; j >>= 1)
#pragma unroll
            for (int i = 0; i < 16; ++i) { const int l = i ^ j; if (l > i) { const unsigned a = v[i], b = v[l]; const unsigned hi = max(a, b), lo = min(a, b);
                if ((i & k) == 0) { v[i] = hi; v[l] = lo; } else { v[i] = lo; v[l] = hi; } } }
}
__device__ __forceinline__ void merge16_desc(unsigned (&t)[16], const unsigned (&v)[16]) {
#pragma unroll
    for (int i = 0; i < 16; ++i) t[i] = max(t[i], v[15 - i]);
#pragma unroll
    for (int j = 8; j > 0; j >>= 1)
#pragma unroll
        for (int i = 0; i < 16; ++i) { const int l = i ^ j; if (l > i) { const unsigned a = t[i], b = t[l]; t[i] = max(a, b); t[l] = min(a, b); } }
}
constexpr int TOPK_LDS = 2 * 128 * 129 * 4;
__device__ void peer_topk_item(const Ctx& c, int l, int tm, int h, char* lds) {
    float* S = (float*)lds;
    const int tid = c.tid, lane = c.lane, wid = c.wid, r32 = lane & 31, hi = lane >> 5, wm = wid >> 1, wn = wid & 1;
    const int row0 = tm * 128;
    bf16x8 fa[2][8];
#pragma unroll
    for (int p = 0; p < 2; ++p) { const bf16_t* Ap = C_Q2 + (size_t)(row0 + wm * 32 + r32) * 2048 + h * 256 + p * 128 + hi * 8;
#pragma unroll
        for (int ks = 0; ks < 8; ++ks) fa[p][ks] = *(const bf16x8*)(Ap + ks * 16); }
#pragma unroll
    for (int p = 0; p < 2; ++p) {
        f32x16 acc[2];
        zero_acc(acc[0]); zero_acc(acc[1]);
        const bf16_t* Bp = C_KEYS + ((((size_t)l * 8 + h) * 2 + p) * 128 + wn * 64 + r32) * 128 + hi * 8;
        bf16x8 fb0[8], fb1[8];
#pragma unroll
        for (int ks = 0; ks < 8; ++ks) { fb0[ks] = *(const bf16x8*)(Bp + ks * 16); fb1[ks] = *(const bf16x8*)(Bp + 32 * 128 + ks * 16); }
        asm volatile("" : "+v"(fa[p][0]), "+v"(fa[p][1]), "+v"(fa[p][2]), "+v"(fa[p][3]), "+v"(fa[p][4]), "+v"(fa[p][5]), "+v"(fa[p][6]), "+v"(fa[p][7]));
        asm volatile("" : "+v"(fb0[0]), "+v"(fb0[1]), "+v"(fb0[2]), "+v"(fb0[3]), "+v"(fb0[4]), "+v"(fb0[5]), "+v"(fb0[6]), "+v"(fb0[7]));
        asm volatile("" : "+v"(fb1[0]), "+v"(fb1[1]), "+v"(fb1[2]), "+v"(fb1[3]), "+v"(fb1[4]), "+v"(fb1[5]), "+v"(fb1[6]), "+v"(fb1[7]));
#pragma unroll
        for (int ks = 0; ks < 8; ++ks) {
            acc[0] = __builtin_amdgcn_mfma_f32_32x32x16_bf16(fa[p][ks], fb0[ks], acc[0], 0, 0, 0);
            acc[1] = __builtin_amdgcn_mfma_f32_32x32x16_bf16(fa[p][ks], fb1[ks], acc[1], 0, 0, 0);
        }
#pragma unroll
        for (int n = 0; n < 2; ++n)
#pragma unroll
            for (int r = 0; r < 16; ++r) S[(p * 128 + wm * 32 + crow(r, hi)) * 129 + wn * 64 + n * 32 + r32] = acc[n][r];
    }
    __syncthreads();
    unsigned tk[16];
    { const int list = tid >> 1, half = tid & 1; const float* sr = S + list * 129 + half * 64;
#pragma unroll
        for (int g = 0; g < 4; ++g) { unsigned v[16];
#pragma unroll
            for (int i = 0; i < 16; ++i) { const int n = half * 64 + g * 16 + i; v[i] = (ford(sr[g * 16 + i]) & ~127u) | (unsigned)(127 - n); }
            sort16_desc(v);
            if (g == 0) {
#pragma unroll
                for (int i = 0; i < 16; ++i) tk[i] = v[i]; }
            else merge16_desc(tk, v); } }
    __syncthreads();
    unsigned* X = (unsigned*)lds;
    unsigned* L = X + 256 * 17;
    if (tid & 1) {
#pragma unroll
        for (int i = 0; i < 16; ++i) X[(tid >> 1) * 17 + i] = tk[i]; }
    __syncthreads();
    if (!(tid & 1)) { unsigned v[16];
#pragma unroll
        for (int i = 0; i < 16; ++i) v[i] = X[(tid >> 1) * 17 + i];
        merge16_desc(tk, v);
#pragma unroll
        for (int i = 0; i < 16; ++i) L[(tid >> 1) * 17 + i] = tk[i]; }
    __syncthreads();
    unsigned bk[16];
    const int row = (tid >> 1) & 127, hh = tid & 1;
    const unsigned* l0 = L + row * 17; const unsigned* l1 = L + (128 + row) * 17;
    if (tid < 256) {
        float s0[8], s1[16];
#pragma unroll
        for (int ii = 0; ii < 8; ++ii) s0[ii] = funord(l0[2 * ii + hh] & ~127u);
#pragma unroll
        for (int j = 0; j < 16; ++j) s1[j] = funord(l1[j] & ~127u);
        unsigned ck[32];
        { int slot = 0;
#pragma unroll
            for (int ii = 0; ii < 8; ++ii)
#pragma unroll
                for (int j = 0; j < 16; ++j) if ((2 * ii + 1) * (j + 1) <= 16) {
                    const int i = 2 * ii + hh; const bool ok = (i + 1) * (j + 1) <= 16;
                    const unsigned key = (ford(s0[ii] + s1[j]) & ~255u) | (unsigned)(255 - (i * 16 + j));
                    ck[slot] = ok ? key : 0u; ++slot; }
#pragma unroll
            for (; slot < 32; ++slot) ck[slot] = 0u; }
        unsigned v0[16], v1[16];
#pragma unroll
        for (int i = 0; i < 16; ++i) { v0[i] = ck[i]; v1[i] = ck[16 + i]; }
        sort16_desc(v0); sort16_desc(v1);
        merge16_desc(v0, v1);
#pragma unroll
        for (int i = 0; i < 16; ++i) bk[i] = v0[i];
    }
    __syncthreads();
    if (tid < 256 && hh) {
#pragma unroll
        for (int i = 0; i < 16; ++i) X[row * 17 + i] = bk[i]; }
    __syncthreads();
    if (tid < 256 && !hh) { unsigned v[16];
#pragma unroll
        for (int i = 0; i < 16; ++i) v[i] = X[row * 17 + i];
        merge16_desc(bk, v);
        float best[16]; int eid[16]; float mx = -1e30f;
#pragma unroll
        for (int q = 0; q < 16; ++q) { const int ij = 255 - (int)(bk[q] & 255u); const int i = ij >> 4, j = ij & 15;
            const unsigned k0 = l0[i], k1 = l1[j];
            best[q] = funord(k0 & ~127u) + funord(k1 & ~127u);
            eid[q] = (127 - (int)(k0 & 127u)) * 128 + (127 - (int)(k1 & 127u));
            mx = fmaxf(mx, best[q]); }
        float sum = 0.f;
#pragma unroll
        for (int q = 0; q < 16; ++q) { best[q] = __expf(best[q] - mx); sum += best[q]; }
        const float inv = 1.f / sum;
        const size_t o = (size_t)(row0 + row) * 128 + h * 16;
#pragma unroll
        for (int q = 0; q < 16; q += 4) { *(u32x4*)(C_EI + o + q) = (u32x4){(unsigned)eid[q], (unsigned)eid[q + 1], (unsigned)eid[q + 2], (unsigned)eid[q + 3]};
            *(f32x4*)(C_EG + o + q) = (f32x4){best[q] * inv, best[q + 1] * inv, best[q + 2] * inv, best[q + 3] * inv}; }
    }
    __syncthreads();
}
__device__ __forceinline__ float gelu_tanh(float x) { const float u = 0.7978845608028654f * (x + 0.044715f * x * x * x); const float t = 1.f - 2.f / (1.f + __expf(2.f * u)); return 0.5f * x * (1.f + t); }
__device__ __forceinline__ int tok_row(int ti, bool need_ctx) { return need_ctx ? ti : (ti >> 13) * RPB + CTX + (ti & 8191); }
struct PeerTok { u32x4 t[16]; u32x4 xa, xb; f32v2 xv, gv; };
__device__ __forceinline__ void peer_issue(PeerTok& T, const unsigned char* t8, const int* el, const bf16_t* xp, int grp, bool want_x) {
#pragma unroll
    for (int u = 0; u < 16; ++u) { const int e = el[u * 8 + grp]; T.t[u] = *(const u32x4*)(t8 + (size_t)e * 128); }
    if (want_x) { T.xa = *(const u32x4*)xp; T.xb = *(const u32x4*)(xp + 8); }
}
__device__ __forceinline__ void peer_u_compute(const PeerTok& T, float* pp, int sub, int grp, int lane) {
    f32v2 x2[8];
#pragma unroll
    for (int q = 0; q < 4; ++q) { x2[q] = (f32v2){bflo(T.xa[q]), bfhi(T.xa[q])}; x2[4 + q] = (f32v2){bflo(T.xb[q]), bfhi(T.xb[q])}; }
    float keep[2];
#pragma unroll
    for (int hf = 0; hf < 2; ++hf) {
        float a[8];
#pragma unroll
        for (int u = 0; u < 8; ++u) { f32v2 s2 = {0.f, 0.f};
#pragma unroll
            for (int q = 0; q < 4; ++q) { const unsigned w = T.t[hf * 8 + u][q];
                s2 = __builtin_elementwise_fma(__builtin_amdgcn_cvt_pk_f32_fp8(w, false), x2[2 * q], s2);
                s2 = __builtin_elementwise_fma(__builtin_amdgcn_cvt_pk_f32_fp8(w, true), x2[2 * q + 1], s2); }
            a[u] = s2[0] + s2[1]; }
        const bool b2 = (lane & 4) != 0, b1 = (lane & 2) != 0, b0 = (lane & 1) != 0;
        float r4[4], r2[2];
#pragma unroll
        for (int q = 0; q < 4; ++q) { const float mine = b2 ? a[4 + q] : a[q], oth = b2 ? a[q] : a[4 + q]; r4[q] = mine + __shfl_xor(oth, 4, 64); }
#pragma unroll
        for (int q = 0; q < 2; ++q) { const float mine = b1 ? r4[2 + q] : r4[q], oth = b1 ? r4[q] : r4[2 + q]; r2[q] = mine + __shfl_xor(oth, 2, 64); }
        { const float mine = b0 ? r2[1] : r2[0], oth = b0 ? r2[0] : r2[1]; keep[hf] = mine + __shfl_xor(oth, 1, 64); }
    }
    pp[sub * 8 + grp] = keep[0]; pp[(8 + sub) * 8 + grp] = keep[1];
}
__device__ void peer_u_item(const Ctx& c, int l, int j, int tb, char* lds) {
    const bool need_ctx = (l < DEPTH - 1);
    int* el = (int*)lds + c.wid * 256;
    const int lane = c.lane, sub = lane & 7, grp = lane >> 3;
    const unsigned char* t8 = C_TU8 + (size_t)j * NEXP * 128 + sub * 16;
    const int tok0 = tb * 128 + c.wid * 16;
    const int xoff = j * 128 + sub * 16;
    PeerTok A, B;
    int e0, e1;
    { const int r = tok_row(tok0, need_ctx); e0 = C_EI[(size_t)r * 128 + lane]; e1 = C_EI[(size_t)r * 128 + 64 + lane];
      el[lane] = e0; el[64 + lane] = e1;
      peer_issue(A, t8, el, C_HB + (size_t)r * D + xoff, grp, true);
      const int r1 = tok_row(tok0 + 1, need_ctx); e0 = C_EI[(size_t)r1 * 128 + lane]; e1 = C_EI[(size_t)r1 * 128 + 64 + lane]; }
#pragma unroll 1
    for (int k = 0; k < 16; k += 2) {
        { const int r1 = tok_row(tok0 + k + 1, need_ctx); el[128 + lane] = e0; el[192 + lane] = e1;
          peer_issue(B, t8, el + 128, C_HB + (size_t)r1 * D + xoff, grp, true);
          if (k + 2 < 16) { const int r2 = tok_row(tok0 + k + 2, need_ctx); e0 = C_EI[(size_t)r2 * 128 + lane]; e1 = C_EI[(size_t)r2 * 128 + 64 + lane]; } }
        peer_u_compute(A, C_PART + ((size_t)j * NR + tok_row(tok0 + k, need_ctx)) * 128, sub, grp, lane);
        if (k + 2 < 16) { const int r2 = tok_row(tok0 + k + 2, need_ctx); el[lane] = e0; el[64 + lane] = e1;
          peer_issue(A, t8, el, C_HB + (size_t)r2 * D + xoff, grp, true);
          if (k + 3 < 16) { const int r3 = tok_row(tok0 + k + 3, need_ctx); e0 = C_EI[(size_t)r3 * 128 + lane]; e1 = C_EI[(size_t)r3 * 128 + 64 + lane]; } }
        peer_u_compute(B, C_PART + ((size_t)j * NR + tok_row(tok0 + k + 1, need_ctx)) * 128, sub, grp, lane);
    }
}
__device__ void ph_peer_combine(const Ctx& c, int l) {
    const bool need_ctx = (l < DEPTH - 1);
    const int ntok = need_ctx ? NR : NB * SEQ;
    for (int ti = blockIdx.x * 8 + c.wid; ti < ntok; ti += gridDim.x * 8) {
        const int r = tok_row(ti, need_ctx);
#pragma unroll
        for (int hf = 0; hf < 2; ++hf) { const size_t o = (size_t)r * 128 + hf * 64 + c.lane;
            const int e = C_EI[o]; float sacc = 0.f;
#pragma unroll
            for (int jj = 0; jj < 8; ++jj) sacc += C_PART[((size_t)jj * NR + r) * 128 + hf * 64 + c.lane];
            C_EG[o] = C_EG[o] * gelu_tanh(sacc * C_SU[e]) * C_SV[e]; }
    }
}
__device__ __forceinline__ void peer_v_compute(const PeerTok& T, const float* wl, float* xo, int grp, int lane) {
    f32v2 acc[8];
#pragma unroll
    for (int q = 0; q < 8; ++q) acc[q] = (f32v2){0.f, 0.f};
#pragma unroll
    for (int u = 0; u < 16; ++u) { const float wv = wl[u * 8 + grp]; const f32v2 w2 = {wv, wv};
#pragma unroll
        for (int q = 0; q < 4; ++q) { const unsigned w = T.t[u][q];
            acc[2 * q] = __builtin_elementwise_fma(__builtin_amdgcn_cvt_pk_f32_fp8(w, false), w2, acc[2 * q]);
            acc[2 * q + 1] = __builtin_elementwise_fma(__builtin_amdgcn_cvt_pk_f32_fp8(w, true), w2, acc[2 * q + 1]); } }
    const bool b5 = (lane & 32) != 0, b4 = (lane & 16) != 0, b3 = (lane & 8) != 0;
    f32v2 r4[4], r2[2], r1;
#pragma unroll
    for (int q = 0; q < 4; ++q) { const f32v2 mine = b5 ? acc[4 + q] : acc[q], oth = b5 ? acc[q] : acc[4 + q];
        r4[q] = (f32v2){mine[0] + __shfl_xor(oth[0], 32, 64), mine[1] + __shfl_xor(oth[1], 32, 64)}; }
#pragma unroll
    for (int q = 0; q < 2; ++q) { const f32v2 mine = b4 ? r4[2 + q] : r4[q], oth = b4 ? r4[q] : r4[2 + q];
        r2[q] = (f32v2){mine[0] + __shfl_xor(oth[0], 16, 64), mine[1] + __shfl_xor(oth[1], 16, 64)}; }
    { const f32v2 mine = b3 ? r2[1] : r2[0], oth = b3 ? r2[0] : r2[1]; r1 = (f32v2){mine[0] + __shfl_xor(oth[0], 8, 64), mine[1] + __shfl_xor(oth[1], 8, 64)}; }
    f32v2 xv = T.xv; const f32v2 gv = T.gv;
    xv[0] += gv[0] * r1[0]; xv[1] += gv[1] * r1[1];
    *(f32v2*)xo = xv;
}
__device__ void peer_v_item(const Ctx& c, int l, int j, int tb, char* lds) {
    const bool need_ctx = (l < DEPTH - 1);
    int* el = (int*)lds + c.wid * 512; float* wl = (float*)(el + 256);
    const int lane = c.lane, sub = lane & 7, grp = lane >> 3;
    const unsigned char* t8 = C_TV8 + (size_t)j * NEXP * 128 + sub * 16;
    const int tok0 = tb * 128 + c.wid * 16;
    const int col = j * 128 + sub * 16 + ((lane & 32) ? 8 : 0) + ((lane & 16) ? 4 : 0) + ((lane & 8) ? 2 : 0);
    const float* gate5 = C_MODT + (size_t)l * 5 * 6144 + 5 * D + col;
    PeerTok A, B;
    int e0, e1; float w0, w1;
#define VISSUE(T, tok, eoff) do { const int r_ = tok_row((tok), need_ctx); const int b_ = r_ / RPB; const bool ctx_ = (r_ - b_ * RPB) < CTX; \
        peer_issue(T, t8, el + (eoff), nullptr, grp, false); T.xv = *(const f32v2*)(xrow(c, r_) + col); T.gv = *(const f32v2*)(gate5 + (size_t)(ctx_ ? 4 : b_) * 6144); } while (0)
#define VFETCH(tok) do { const int r_ = tok_row((tok), need_ctx); e0 = C_EI[(size_t)r_ * 128 + lane]; e1 = C_EI[(size_t)r_ * 128 + 64 + lane]; w0 = C_EG[(size_t)r_ * 128 + lane]; w1 = C_EG[(size_t)r_ * 128 + 64 + lane]; } while (0)
    VFETCH(tok0);
    el[lane] = e0; el[64 + lane] = e1; wl[lane] = w0; wl[64 + lane] = w1;
    VISSUE(A, tok0, 0);
    VFETCH(tok0 + 1);
#pragma unroll 1
    for (int k = 0; k < 16; k += 2) {
        el[128 + lane] = e0; el[192 + lane] = e1; wl[128 + lane] = w0; wl[192 + lane] = w1;
        VISSUE(B, tok0 + k + 1, 128);
        if (k + 2 < 16) VFETCH(tok0 + k + 2);
        peer_v_compute(A, wl, xrow(c, tok_row(tok0 + k, need_ctx)) + col, grp, lane);
        if (k + 2 < 16) { el[lane] = e0; el[64 + lane] = e1; wl[lane] = w0; wl[64 + lane] = w1;
          VISSUE(A, tok0 + k + 2, 0);
          if (k + 3 < 16) VFETCH(tok0 + k + 3); }
        peer_v_compute(B, wl + 128, xrow(c, tok_row(tok0 + k + 1, need_ctx)) + col, grp, lane);
    }
#undef VISSUE
#undef VFETCH
}
template <int SUB>
__device__ void ph_peer_expert(const Ctx& c, int l, char* lds) {
    const bool need_ctx = (l < DEPTH - 1);
    unsigned* cnt = (unsigned*)CWS(WS_CTL) + 4096 + ((l * 2 + SUB) * 8) * 64;
    const int nitem = (need_ctx ? NR : NB * SEQ) / 128;
    const int x = (int)(xb_xcc_id() & 7u);
    volatile int* sh = (volatile int*)(lds + 16384);
    for (int jo = 0; jo < 8; ++jo) { const int j = (x + jo) & 7;
        int nxt = 0;
        if (c.tid == 0) nxt = (int)__hip_atomic_fetch_add(&cnt[j * 64], 1u, __ATOMIC_RELAXED, __HIP_MEMORY_SCOPE_AGENT);
        for (;;) {
            if (c.tid == 0) *sh = nxt;
            __syncthreads(); const int it = *sh; __syncthreads();
            if (it >= nitem) break;
            if (c.tid == 0) nxt = (int)__hip_atomic_fetch_add(&cnt[j * 64], 1u, __ATOMIC_RELAXED, __HIP_MEMORY_SCOPE_AGENT);
            if (SUB == 0) peer_u_item(c, l, j, it, lds); else peer_v_item(c, l, j, it, lds);
        }
    }
}
__device__ void ph_final(const Ctx& c) {
    const float* g = CIN(25);
    const int stride = gridDim.x * 8;
    int r = blockIdx.x * 8 + c.wid;
    f32x4 xn[4];
    if (r < NB * SEQ) { const float* src = COUT + ((size_t)r << 10);
#pragma unroll
        for (int i = 0; i < 4; ++i) xn[i] = *(const f32x4*)(src + i * 256 + c.lane * 4); }
    for (; r < NB * SEQ; r += stride) {
        float* xr = COUT + ((size_t)r << 10);
        f32x4 x[4]; float ss = 0.f;
#pragma unroll
        for (int i = 0; i < 4; ++i) { x[i] = xn[i]; ss += x[i][0] * x[i][0] + x[i][1] * x[i][1] + x[i][2] * x[i][2] + x[i][3] * x[i][3]; }
        if (r + stride < NB * SEQ) { const float* src = COUT + ((size_t)(r + stride) << 10);
#pragma unroll
            for (int i = 0; i < 4; ++i) xn[i] = *(const f32x4*)(src + i * 256 + c.lane * 4); }
        ss = wave_sum(ss); const float rstd = rsqrtf(ss * (1.f / D) + NORM_EPS);
#pragma unroll
        for (int i = 0; i < 4; ++i) { const int col = i * 256 + c.lane * 4; const f32x4 gv = *(const f32x4*)(g + col); f32x4 y;
#pragma unroll
            for (int e = 0; e < 4; ++e) y[e] = x[i][e] * rstd * gv[e];
            *(f32x4*)(xr + col) = y; }
    }
}

namespace pg8 {
#define PG8_LAS __attribute__((address_space(3)))
typedef unsigned short bf16_t;
typedef short bf16x8 __attribute__((ext_vector_type(8)));
typedef float f32x4 __attribute__((ext_vector_type(4)));
typedef unsigned u32x4 __attribute__((ext_vector_type(4)));
constexpr int BM = 256, BK = 64, HALF = 128, HTB = HALF * BK * 2  , STAGE_BYTES = 8 * HTB, NXCD = 8, WGM = 8;

__host__ __device__ __forceinline__ int lds_byte(int r, int c) { const int st = (r >> 4) * 2 + (c >> 5), rr = r & 15, cc = c & 31, ob = rr * 64 + cc * 2; return st * 1024 + (ob ^ (((ob >> 9) & 1) << 5)); }
__host__ __device__ __forceinline__ void stage_rc(int b, int& R, int& C) { const int st = b / 1024, sb = b % 1024, swz = sb ^ (((sb >> 9) & 1) << 5); R = (st >> 1) * 16 + swz / 64; C = (st & 1) * 32 + (swz % 64) / 2; }
__host__ __device__ __forceinline__ int perm32(int rho) { const int n = rho >> 4, i = rho & 15; return 8 * (i >> 2) + 4 * n + (i & 3); }

struct Unit { int pm, pn; };
struct Gemm { const bf16_t* A; const bf16_t* Bt; int M, N, K; };
struct TileOrder {
    int nM, nN, nwg, G, c; bool skip_ctx;
    __device__ void init(int nM_, int nN_, int G_, int c_, bool skip) { nM = nM_; nN = nN_; nwg = nM_ * nN_; G = G_; c = c_; skip_ctx = skip; }
    __device__ bool next(int i, Unit& u) const {
        const long L = (long)i * G + c; if (L >= nwg) return false;
        int wgid = (int)L; { const int q = nwg / NXCD, r = nwg % NXCD, xcd = wgid % NXCD, off = wgid / NXCD; wgid = (xcd < r ? xcd * (q + 1) : r * (q + 1) + (xcd - r) * q) + off; }
        const int nig = WGM * nN, gid = wgid / nig, fm = gid * WGM, gsz = (nM - fm) < WGM ? (nM - fm) : WGM;
        int pm = fm + ((wgid % nig) % gsz); u.pn = (wgid % nig) / gsz;
        if (skip_ctx) pm = 33 * (pm >> 5) + 1 + (pm & 31);
        u.pm = pm; return true;
    }
    __device__ __forceinline__ void a_ready(const Unit&) const {}
    __device__ __forceinline__ void done(const Unit&) const {}
};
template <class Epi, class Sched, bool STAMP = false>
__device__ __forceinline__ void gemm_phase(PG8_LAS unsigned char* lds, const Gemm g, const Sched& S, const Epi& E, unsigned long long* stamps, int w0) {
    const int tid = mk_tid(w0), wid = w0, lane = tid & 63, wr = wid >> 2, wc = wid & 3, fr = lane & 15, fq = lane >> 4;
    const int K = g.K, nt = K / BK;
    int ts_lo = 0, ts_hi = 0, nts = 0; const unsigned long long rt_entry = STAMP ? (unsigned long long)wall_clock64() : 0ull;
#define PG8_STAMP() do { if (STAMP && wid == 0 && nts < 64) { const unsigned long long _c = (unsigned long long)clock64(); \
        ts_lo = (lane == nts) ? (int)(unsigned)_c : ts_lo; ts_hi = (lane == nts) ? (int)(unsigned)(_c >> 32) : ts_hi; ++nts; } } while (0)
    PG8_STAMP();
    unsigned voffA[2], voffB[2];
#pragma unroll
    for (int i = 0; i < 2; ++i) { int R, C; stage_rc(tid * 16 + i * 8192, R, C); const int Rb = Epi::PERM ? ((R & ~31) + perm32(R & 31)) : R;
        voffA[i] = (unsigned)(R * K + C) * 2u; voffB[i] = (unsigned)(Rb * K + C) * 2u; }
    const size_t kstep = (size_t)(BK * 2);
    const size_t hstep = (size_t)HALF * K * 2;
    const size_t tstep = 2 * hstep;
    const unsigned ldsw = (unsigned)wid * 1024u;
    const int aoff = lds_byte(wr * 64 + fr, fq * 8), boff = lds_byte(wc * 32 + fr, fq * 8);
#define PG8_SA(b, h) (((b) * 2 + (h)) * HTB)
#define PG8_SB(b, h) ((4 + (b) * 2 + (h)) * HTB)
#define PG8_STAGE(bufoff, gbase, voff) do { _Pragma("unroll") for (int _i = 0; _i < 2; ++_i) \
        __builtin_amdgcn_global_load_lds((const unsigned*)((const char*)(gbase) + (voff)[_i]), (PG8_LAS unsigned*)(lds + (bufoff) + ldsw + _i * 8192), 16, 0, 0); } while (0)
#define PG8_LDA(dst, b, h) do { _Pragma("unroll") for (int m = 0; m < 4; ++m) _Pragma("unroll") for (int k = 0; k < 2; ++k) dst[m][k] = *(const PG8_LAS bf16x8*)(lds + PG8_SA(b, h) + aoff + m * 2048 + k * 1024); } while (0)
#define PG8_LDB(dst, b, h) do { _Pragma("unroll") for (int n = 0; n < 2; ++n) _Pragma("unroll") for (int k = 0; k < 2; ++k) dst[n][k] = *(const PG8_LAS bf16x8*)(lds + PG8_SB(b, h) + boff + n * 2048 + k * 1024); } while (0)
#define PG8_MMA(ai, bj, At, Bt) do { __builtin_amdgcn_s_setprio(1); _Pragma("unroll") for (int m = 0; m < 4; ++m) _Pragma("unroll") for (int n = 0; n < 2; ++n) _Pragma("unroll") for (int k = 0; k < 2; ++k) \
        acc[ai][bj][m][n] = __builtin_amdgcn_mfma_f32_16x16x32_bf16(Bt[n][k], At[m][k], acc[ai][bj][m][n], 0, 0, 0); __builtin_amdgcn_s_setprio(0); } while (0)
#define PG8_WAIT_V(n) asm volatile("s_waitcnt vmcnt(" #n ")" ::: "memory")
#define PG8_WAIT_L(n) asm volatile("s_waitcnt lgkmcnt(" #n ")" ::: "memory")
#define PG8_BAR __builtin_amdgcn_s_barrier()
#define PG8_SCHED __builtin_amdgcn_sched_barrier(0)
    Unit cur, nxt; int ui = 0;
    if (!S.next(0, cur)) return;
    f32x4 acc[2][2][4][2];
#pragma unroll
    for (int a = 0; a < 2; ++a)
#pragma unroll
        for (int b = 0; b < 2; ++b)
#pragma unroll
            for (int m = 0; m < 4; ++m)
#pragma unroll
                for (int n = 0; n < 2; ++n) acc[a][b][m][n] = (f32x4){0.f, 0.f, 0.f, 0.f};
    bf16x8 At[4][2], B0[2][2], B1[2][2];
    const char* cA = (const char*)g.A + (size_t)cur.pm * tstep; const char* cB = (const char*)g.Bt + (size_t)cur.pn * tstep;
    S.a_ready(cur);
    PG8_STAGE(PG8_SB(0, 0), cB, voffB); PG8_STAGE(PG8_SA(0, 0), cA, voffA); PG8_STAGE(PG8_SB(0, 1), cB + hstep, voffB); PG8_STAGE(PG8_SA(0, 1), cA + hstep, voffA);
    if (wr == 1) PG8_BAR;
    PG8_WAIT_V(4); PG8_BAR;
    PG8_STAGE(PG8_SB(1, 0), cB + kstep, voffB); PG8_STAGE(PG8_SA(1, 0), cA + kstep, voffA); PG8_STAGE(PG8_SB(1, 1), cB + hstep + kstep, voffB);
    PG8_WAIT_V(6); PG8_BAR;
    PG8_STAMP();
    for (;;) {
        const bool has_next = S.next(ui + 1, nxt);
        const char* nA = has_next ? (const char*)g.A + (size_t)nxt.pm * tstep : cA; const char* nB = has_next ? (const char*)g.Bt + (size_t)nxt.pn * tstep : cB;
        for (int t = 0; t < nt; t += 2) {
            const bool last = (t == nt - 2);
            const char* a1 = cA + (size_t)(t + 1) * kstep;
            const char* a2 = last ? nA : cA + (size_t)(t + 2) * kstep; const char* b2 = last ? nB : cB + (size_t)(t + 2) * kstep;
            const char* a3 = a2 + kstep; const char* b3 = b2 + kstep;
            if (last && has_next) S.a_ready(nxt);
            PG8_LDB(B0, 0, 0); PG8_SCHED; PG8_LDA(At, 0, 0); PG8_STAGE(PG8_SA(1, 1), a1 + hstep, voffA);
            PG8_WAIT_L(8); PG8_BAR; PG8_WAIT_L(0); PG8_MMA(0, 0, At, B0); PG8_BAR; PG8_SCHED;
            PG8_LDB(B1, 0, 1); PG8_STAGE(PG8_SB(0, 0), b2, voffB);
            PG8_BAR; PG8_WAIT_L(0); PG8_MMA(0, 1, At, B1); PG8_BAR;
            PG8_LDA(At, 0, 1); PG8_STAGE(PG8_SA(0, 0), a2, voffA);
            PG8_BAR; PG8_WAIT_L(0); PG8_MMA(1, 0, At, B0); PG8_BAR; PG8_SCHED;
            PG8_STAGE(PG8_SB(0, 1), b2 + hstep, voffB);
            PG8_WAIT_V(6); PG8_BAR; PG8_MMA(1, 1, At, B1); PG8_BAR;
            PG8_LDB(B0, 1, 0); PG8_SCHED; PG8_LDA(At, 1, 0); PG8_STAGE(PG8_SA(0, 1), a2 + hstep, voffA);
            PG8_WAIT_L(8); PG8_BAR; PG8_WAIT_L(0); PG8_MMA(0, 0, At, B0); PG8_BAR; PG8_SCHED;
            PG8_LDB(B1, 1, 1); PG8_STAGE(PG8_SB(1, 0), b3, voffB);
            PG8_BAR; PG8_WAIT_L(0); PG8_MMA(0, 1, At, B1); PG8_BAR;
            PG8_LDA(At, 1, 1); PG8_STAGE(PG8_SA(1, 0), a3, voffA);
            PG8_BAR; PG8_WAIT_L(0); PG8_MMA(1, 0, At, B0); PG8_BAR; PG8_SCHED;
            PG8_STAGE(PG8_SB(1, 1), b3 + hstep, voffB);
            PG8_WAIT_V(6); PG8_BAR; PG8_MMA(1, 1, At, B1); PG8_BAR;
        }
        PG8_STAMP();
        if constexpr (!Epi::AFTER_DRAIN) { E(acc, cur, wr, wc, fr, fq); S.done(cur); }
        PG8_STAMP();
        if (!has_next) break;
#pragma unroll
        for (int a = 0; a < 2; ++a)
#pragma unroll
            for (int b = 0; b < 2; ++b)
#pragma unroll
                for (int m = 0; m < 4; ++m)
#pragma unroll
                    for (int n = 0; n < 2; ++n) acc[a][b][m][n] = (f32x4){0.f, 0.f, 0.f, 0.f};
        cur = nxt; cA = nA; cB = nB; ++ui;
    }
    PG8_WAIT_V(0);
    if (wr == 0) PG8_BAR;
    PG8_BAR;
    if constexpr (Epi::AFTER_DRAIN) { E.fused(acc, cur, wr, wc, fr, fq, lds, wid, lane); S.done(cur); }
    PG8_STAMP();
    if (STAMP && wid == 0) { stamps[lane] = lane < nts ? (((unsigned long long)(unsigned)ts_hi << 32) | (unsigned)ts_lo) : 0ull;
        if (lane == 62) stamps[62] = rt_entry; if (lane == 63) stamps[63] = (unsigned long long)wall_clock64(); }
#undef PG8_STAMP
#undef PG8_SA
#undef PG8_SB
#undef PG8_STAGE
#undef PG8_LDA
#undef PG8_LDB
#undef PG8_MMA
#undef PG8_WAIT_V
#undef PG8_WAIT_L
#undef PG8_BAR
#undef PG8_SCHED
}

struct EpiStoreBf16 {
    static constexpr bool PERM = true, AFTER_DRAIN = false;
    bf16_t* O; int ldc; int ncols; int slo, shi; float scale;
    __device__ __forceinline__ void operator()(const f32x4 (&acc)[2][2][4][2], const Unit& u, int wr, int wc, int fr, int fq) const {
        const int row0 = u.pm * BM + wr * 64 + fr, col0 = u.pn * BM + wc * 32 + 8 * fq;
        float sc[2];
#pragma unroll
        for (int bj = 0; bj < 2; ++bj) { const int cb = u.pn * BM + bj * HALF; sc[bj] = (cb >= slo && cb < shi) ? scale : 1.f; }
#pragma unroll
        for (int ai = 0; ai < 2; ++ai)
#pragma unroll
            for (int m = 0; m < 4; ++m) { bf16_t* rowp = O + (size_t)(row0 + ai * HALF + m * 16) * ldc + col0;
#pragma unroll
                for (int bj = 0; bj < 2; ++bj) if (col0 + bj * HALF < ncols) { const f32x4 v0 = acc[ai][bj][m][0] * sc[bj], v1 = acc[ai][bj][m][1] * sc[bj];
                    u32x4 w; w.x = ::cvtpk(v0[0], v0[1]); w.y = ::cvtpk(v0[2], v0[3]); w.z = ::cvtpk(v1[0], v1[1]); w.w = ::cvtpk(v1[2], v1[3]);
                    *(u32x4*)(rowp + bj * HALF) = w; }
                asm volatile("" ::: "memory"); }
    }
};
struct EpiResidX {
    static constexpr bool PERM = false, AFTER_DRAIN = false;
    float* xc; float* xout; const float* gate_l;
    __device__ __forceinline__ void operator()(const f32x4 (&acc)[2][2][4][2], const Unit& u, int wr, int wc, int fr, int fq) const {
        const int rowt = u.pm * BM; const int b = rowt / RPB, j0 = rowt - b * RPB; const bool isctx = j0 < CTX;
        float* xb = isctx ? xc + ((size_t)(b * CTX + j0) << 10) : xout + ((size_t)(b * SEQ + j0 - CTX) << 10);
        const float* gt = gate_l + (size_t)(isctx ? 4 : b) * 6144;
        const int r0 = wr * 64 + fr, col0 = u.pn * BM + wc * 32 + 4 * fq;
        f32x4 gv[2][2];
#pragma unroll
        for (int bj = 0; bj < 2; ++bj)
#pragma unroll
            for (int n = 0; n < 2; ++n) gv[bj][n] = *(const f32x4*)(gt + col0 + bj * HALF + n * 16);
#pragma unroll
        for (int ai = 0; ai < 2; ++ai)
#pragma unroll
            for (int m = 0; m < 4; ++m) { float* rowp = xb + ((size_t)(r0 + ai * HALF + m * 16) << 10) + col0;
#pragma unroll
                for (int bj = 0; bj < 2; ++bj)
#pragma unroll
                    for (int n = 0; n < 2; ++n) { f32x4* p = (f32x4*)(rowp + bj * HALF + n * 16); *p = *p + gv[bj][n] * acc[ai][bj][m][n]; }
                asm volatile("" ::: "memory"); }
    }
};
}

constexpr int LDS_BYTES = 144 * 1024;
static_assert(TOPK_LDS + 16 <= LDS_BYTES && GEMM_LDS + 16 <= LDS_BYTES && ATT_LDS + 16 <= LDS_BYTES, "LDS budget");
constexpr int PPL = 13;
constexpr int N_PHASES = 1 + PPL * DEPTH + 1;
extern __shared__ __attribute__((aligned(16))) char g_lds[];

#define PHASE_FN __device__ __forceinline__ void
PHASE_FN f_p0(int w0) { const Ctx c = fresh_ctx(w0); ph_p0(c, g_lds); }
PHASE_FN f_norm0(int w0, int l) { const Ctx c = fresh_ctx(w0); ph_norm<0>(c, l); }
PHASE_FN f_norm1(int w0, int l) { const Ctx c = fresh_ctx(w0); ph_norm<1>(c, l); }
PHASE_FN f_gemm_in(int w0, int l) { const Ctx c = fresh_ctx(w0);
    pg8::Gemm g{C_HB, C_WIN + (size_t)l * INC * D, NR, 3328, D};
    pg8::TileOrder S; S.init(132, 13, (int)gridDim.x, (int)blockIdx.x, false);
    pg8::EpiStoreBf16 E{C_P, INC, INC, DF_Q, DF_Q + 256, 0.17677669529663687f * 1.4426950408889634f};
    pg8::gemm_phase<pg8::EpiStoreBf16, pg8::TileOrder>((PG8_LAS unsigned char*)g_lds, g, S, E, nullptr, w0); }
PHASE_FN f_prep(int w0, int l) {
    const Ctx c = fresh_ctx(w0); char* lds = g_lds;
    ph_prep_rows(c, l);
    scan_tables(c, l, lds);
    { const int G = (int)gridDim.x, N = 16 * NCHUNK * 2, R = (N + G - 1) / G;
      for (int q = 0; q < 2 * R; ++q) { const int mx = q & 1; int u = (q >> 1) * G + (int)blockIdx.x; if (u >= N) continue;
        const int dir = u & 1; u >>= 1; const int cc = u % NCHUNK; u /= NCHUNK; const int h = u & 3, b = u >> 2;
        if (mx == 0) scanA_item<0>(c, l, b, h, cc, dir, lds); else scanA_item<1>(c, l, b, h, cc, dir, lds); } }
}
PHASE_FN f_upproj(int w0, int l) {
    const Ctx c = fresh_ctx(w0); char* lds = g_lds;
    EpiBf16 eq{C_QM, 384, 0.10206207261596575f * 1.4426950408889634f}, ekv{C_KVM, 512, 1.f};
    for (int it = blockIdx.x; it < 132 * 7 + 384; it += gridDim.x) {
        if (it < 132 * 7) { const int tm = it / 7, tn = it % 7;
            if (tn < 3) gemm_tile(c, C_P + MLA_CQ, INC, C_WUQ + (size_t)l * 384 * 192, 192, 192, tm * 256, tn * 128, lds, eq);
            else gemm_tile(c, C_P + MLA_CKV, INC, C_WUKV + (size_t)l * 512 * 128, 128, 128, tm * 256, (tn - 3) * 128, lds, ekv); }
        else scanB_item(c, it - 132 * 7); }
}
PHASE_FN f_scanc(int w0, int l) {
    const Ctx c = fresh_ctx(w0); char* lds = g_lds; const bool need_ctx = (l < DEPTH - 1);
    ph_rope_q(c);
    scan_tables(c, l, lds);
    { const int G = (int)gridDim.x, N = 16 * NCHUNK, R = (N + G - 1) / G;
      for (int q = 0; q < 2 * R; ++q) { const int mx = q & 1; int u = (q >> 1) * G + (int)blockIdx.x; if (u >= N) continue;
        const int cc = u % NCHUNK; u /= NCHUNK; const int h = u & 3, b = u >> 2;
        if (cc < 4 && !need_ctx) continue;
        if (mx == 0) scanC_item<0>(c, l, b, h, cc, lds); else scanC_item<1>(c, l, b, h, cc, lds); } }
}
PHASE_FN f_attn(int w0, int l) { const Ctx c = fresh_ctx(w0); ph_attn(c, l, g_lds); }
PHASE_FN f_gemm_out(int w0, int l) {
    const Ctx c = fresh_ctx(w0); const bool need_ctx = (l < DEPTH - 1);
    { pg8::Gemm g{C_HB, C_WOUT + (size_t)l * D * D, NR, D, D};
      pg8::TileOrder S; S.init(need_ctx ? 132 : 128, 4, (int)gridDim.x, (int)blockIdx.x, !need_ctx);
      pg8::EpiResidX E{C_XC, COUT, C_MODT + (size_t)l * 5 * 6144 + 2 * D};
      pg8::gemm_phase<pg8::EpiResidX, pg8::TileOrder>((PG8_LAS unsigned char*)g_lds, g, S, E, nullptr, w0); }
    cvt_tables(c, l);
}
PHASE_FN f_peer_q(int w0, int l) {
    const Ctx c = fresh_ctx(w0); const bool need_ctx = (l < DEPTH - 1);
    pg8::Gemm g{C_HB, C_WQ + (size_t)l * 2048 * D, NR, 2048, D};
    pg8::TileOrder S; S.init(need_ctx ? 132 : 128, 8, (int)gridDim.x, (int)blockIdx.x, !need_ctx);
    pg8::EpiStoreBf16 E{C_Q2, 2048, 2048, 0, 0, 1.f};
    pg8::gemm_phase<pg8::EpiStoreBf16, pg8::TileOrder>((PG8_LAS unsigned char*)g_lds, g, S, E, nullptr, w0);
}
PHASE_FN f_topk(int w0, int l) {
    const Ctx c = fresh_ctx(w0); char* lds = g_lds; const bool need_ctx = (l < DEPTH - 1);
    for (int it = blockIdx.x; it < 264 * 8; it += gridDim.x) { const int tm = it >> 3, h = it & 7;
        if ((tm % 66) < 2 && !need_ctx) continue;
        peer_topk_item(c, l, tm, h, lds); }
}
PHASE_FN f_expert_u(int w0, int l) { const Ctx c = fresh_ctx(w0); ph_peer_expert<0>(c, l, g_lds); }
PHASE_FN f_expert_c(int w0, int l) { const Ctx c = fresh_ctx(w0); ph_peer_combine(c, l); }
PHASE_FN f_expert_v(int w0, int l) { const Ctx c = fresh_ctx(w0); ph_peer_expert<1>(c, l, g_lds); }
PHASE_FN f_final(int w0) { const Ctx c = fresh_ctx(w0); ph_final(c); }

__global__ void __launch_bounds__(512, 2) mk_fwd(Params p) {
    volatile LAS unsigned* bst = (volatile LAS unsigned*)(g_lds + LDS_BYTES - 16);
    const bool t0 = threadIdx.x == 0; const int w0 = __builtin_amdgcn_readfirstlane((int)threadIdx.x >> 6);
    if (t0) { bst[0] = 0u; bst[1] = 0u; bst[2] = 0u; bst[3] = 0u; }
    __syncthreads();
    XcdBarrier bar; bar.bar = (unsigned*)(p.ws + WS_CTL); bar.x = 0; bar.st = bst; bar.t0 = t0;
    const int lo = p.ph_lo, hi = p.ph_hi;
    const bool multi = (hi - lo) > 1;
    if (multi) bar = xcd_barrier_post((unsigned*)(p.ws + WS_CTL), bst, t0);
#ifndef PHMASK
#define PHMASK 0xFFFF
#endif
#define EN(s) ((PHMASK >> (s)) & 1)
#define IN(k) (lo <= (k) && (k) < hi)
#define SEAM(k) do { if (IN(k) && IN((k) + 1)) xcd_barrier(bar); } while (0)
    if (EN(0) && IN(0)) f_p0(w0);
    SEAM(0);
#define LAYER(l) do { constexpr int base = 1 + PPL * (l); \
        if (EN(1) && IN(base + 0)) f_norm0(w0, l); SEAM(base + 0); \
        if (EN(2) && IN(base + 1)) f_gemm_in(w0, l); SEAM(base + 1); \
        if (EN(3) && IN(base + 2)) f_prep(w0, l); SEAM(base + 2); \
        if (EN(4) && IN(base + 3)) f_upproj(w0, l); SEAM(base + 3); \
        if (EN(5) && IN(base + 4)) f_scanc(w0, l); SEAM(base + 4); \
        if (EN(6) && IN(base + 5)) f_attn(w0, l); SEAM(base + 5); \
        if (EN(7) && IN(base + 6)) f_gemm_out(w0, l); SEAM(base + 6); \
        if (EN(8) && IN(base + 7)) f_norm1(w0, l); SEAM(base + 7); \
        if (EN(9) && IN(base + 8)) f_peer_q(w0, l); SEAM(base + 8); \
        if (EN(10) && IN(base + 9)) f_topk(w0, l); SEAM(base + 9); \
        if (EN(11) && IN(base + 10)) f_expert_u(w0, l); SEAM(base + 10); \
        if (EN(12) && IN(base + 11)) f_expert_c(w0, l); SEAM(base + 11); \
        if (EN(13) && IN(base + 12)) f_expert_v(w0, l); SEAM(base + 12); } while (0)
    LAYER(0);
    LAYER(1);
#undef LAYER
    if (EN(14) && IN(N_PHASES - 1)) f_final(w0);
#undef IN
#undef SEAM
}

extern "C" void kernel_launch(void* const* d_in, const int* in_sizes, int n_in, void* d_out, int out_size, void* d_ws, size_t ws_size, hipStream_t stream) {
    static int grid = 0;
    if (grid == 0) {
        if (n_in != 26 || in_sizes[0] != NB * SEQ * D || out_size != NB * SEQ * D || ws_size < WS_END) {
            fprintf(stderr, "kernel_launch: shape/workspace mismatch: n_in %d in0 %d out %d ws %zu (need %zu); nothing launched\n", n_in, n_in > 0 ? in_sizes[0] : -1, out_size, ws_size, (size_t)WS_END);
            grid = -1; return; }
        int dev = 0, cus = 0, per_cu = 0;
        if (hipGetDevice(&dev) != hipSuccess || hipDeviceGetAttribute(&cus, hipDeviceAttributeMultiprocessorCount, dev) != hipSuccess) { grid = -1; return; }
        if (hipFuncSetAttribute((const void*)mk_fwd, hipFuncAttributeMaxDynamicSharedMemorySize, LDS_BYTES) != hipSuccess) { fprintf(stderr, "kernel_launch: hipFuncSetAttribute failed\n"); grid = -1; return; }
        if (hipOccupancyMaxActiveBlocksPerMultiprocessor(&per_cu, (const void*)mk_fwd, 512, LDS_BYTES) != hipSuccess || per_cu < 1)
            fprintf(stderr, "kernel_launch: note: occupancy query reports %d workgroups per CU\n", per_cu);
        (void)hipGetLastError();
        grid = cus;
    }
    if (grid < 0) return;
    if (hipMemsetAsync((char*)d_ws + WS_CTL, 0, CTL_BYTES, stream) != hipSuccess) { fprintf(stderr, "kernel_launch: memset failed\n"); return; }
    Params p{};
    for (int i = 0; i < 26; ++i) p.in[i] = (const float*)d_in[i];
    p.out = (float*)d_out; p.ws = (unsigned char*)d_ws;
#if MK_PER_PHASE
    for (int k = 0; k < N_PHASES; ++k) { p.ph_lo = k; p.ph_hi = k + 1; hipLaunchKernelGGL(mk_fwd, dim3(grid), dim3(512), LDS_BYTES, stream, p); }
#else
    p.ph_lo = 0; p.ph_hi = N_PHASES; hipLaunchKernelGGL(mk_fwd, dim3(grid), dim3(512), LDS_BYTES, stream, p);
#endif
    const hipError_t le = hipPeekAtLastError();
    if (le != hipSuccess) fprintf(stderr, "kernel_launch: launch failed: %s\n", hipGetErrorName(le));
}
```

```cpp
#include <hip/hip_runtime.h>
#include <cstdio>
#include <cstdint>

#ifndef ATT_FAST_DIFF
#define ATT_FAST_DIFF 0
#endif
#ifndef MK_PER_PHASE
#define MK_PER_PHASE 0
#endif

constexpr int D = 1024, NB = 4, SEQ = 8192, CTX = 256, DEPTH = 2;
constexpr int RPB = CTX + SEQ;
constexpr int NR = NB * RPB;
constexpr int INC = 3200;
constexpr int GLA_Q = 0, GLA_K = 128, GLA_V = 256, GLA_R = 512, GLA_ZF = 768, GLA_ZB = 784;
constexpr int HG_Q = 800, HG_I = 1056, HG_OG = 1312, HG_ZF = 1568, HG_ZB = 1824;
constexpr int MLA_CQ = 2080, MLA_CKV = 2272, MLA_KR = 2400;
constexpr int DF_Q = 2432, DF_K = 2688, DF_V = 2944;
constexpr int NCHUNK = RPB / 64;
constexpr int NEXP = 16384;
constexpr float NORM_EPS = 1e-6f;

typedef unsigned short bf16_t;
typedef short bf16x8 __attribute__((ext_vector_type(8)));
typedef short s16x4 __attribute__((ext_vector_type(4)));
typedef float f32x16 __attribute__((ext_vector_type(16)));
typedef float f32x4 __attribute__((ext_vector_type(4)));
typedef unsigned u32x4 __attribute__((ext_vector_type(4)));
typedef unsigned u32x2 __attribute__((ext_vector_type(2)));

constexpr size_t al256(size_t x) { return (x + 255) / 256 * 256; }
constexpr size_t WS_CTL = 0;
constexpr size_t CTL_BYTES = 65536;
constexpr size_t WS_MOD = WS_CTL + CTL_BYTES;
constexpr size_t WS_XC = al256(WS_MOD + (size_t)2 * 5 * 6144 * 4);
constexpr size_t WS_WIN = al256(WS_XC + (size_t)NB * CTX * D * 4);
constexpr size_t WS_WOUT = al256(WS_WIN + (size_t)2 * INC * D * 2);
constexpr size_t WS_WQ = al256(WS_WOUT + (size_t)2 * D * D * 2);
constexpr size_t WS_WUQ = al256(WS_WQ + (size_t)2 * 2048 * D * 2);
constexpr size_t WS_WUKV = al256(WS_WUQ + (size_t)2 * 384 * 192 * 2);
constexpr size_t WS_KEYS = al256(WS_WUKV + (size_t)2 * 512 * 128 * 2);
constexpr size_t WS_HB = al256(WS_KEYS + (size_t)2 * 16 * 128 * 128 * 2);
constexpr size_t WS_QM = al256(WS_HB + (size_t)NR * D * 2);
constexpr size_t WS_KVM = al256(WS_QM + (size_t)NR * 384 * 2);
constexpr size_t WS_SG = al256(WS_KVM + (size_t)NR * 512 * 2);
constexpr size_t WS_SH = al256(WS_SG + (size_t)32 * NCHUNK * 2048 * 2);
constexpr size_t WS_DG = al256(WS_SH + (size_t)32 * NCHUNK * 4096 * 2);
constexpr size_t WS_DH = al256(WS_DG + (size_t)32 * NCHUNK * 32 * 4);
constexpr size_t WS_P = al256(WS_DH + (size_t)32 * NCHUNK * 64 * 4);
constexpr size_t WS_END = al256(WS_P + (size_t)NR * INC * 2);
constexpr size_t WS_TU8 = WS_P;
constexpr size_t WS_TV8 = WS_P + (size_t)NEXP * D;
constexpr size_t WS_SU = WS_TV8 + (size_t)NEXP * D;
constexpr size_t WS_SV = WS_SU + (size_t)NEXP * 4;
constexpr size_t WS_Q2 = WS_P + (size_t)64 * 1024 * 1024;
constexpr size_t WS_PART = WS_Q2;
static_assert(WS_SV + (size_t)NEXP * 4 <= WS_Q2, "alias overflow 0");
static_assert(WS_Q2 + (size_t)NR * 2048 * 2 <= WS_END, "alias overflow");
constexpr size_t WS_EI = WS_SG;
constexpr size_t WS_EG = WS_EI + (size_t)NR * 128 * 4;
static_assert(WS_EG + (size_t)NR * 128 * 4 <= WS_DG, "alias overflow 2");

#define XB_TMO      128
#define XB_XCNT(j)  (256  + 64 * (j))
#define XB_XSUB(j)  (1280 + 64 * (j))
#define XB_XGEN(j)  (2304 + 64 * (j))
#define XB_TOP      3328
#define XB_TOPGEN   3392
#define XCD_BAR_WORDS 3456
#define XB_SPIN_CAP (1u << 22)
#define LAS __attribute__((address_space(3)))

__device__ __forceinline__ unsigned xb_ld(unsigned* p)              { return __hip_atomic_load(p, __ATOMIC_RELAXED, __HIP_MEMORY_SCOPE_AGENT); }
__device__ __forceinline__ unsigned xb_add(unsigned* p, unsigned v) { return __hip_atomic_fetch_add(p, v, __ATOMIC_RELAXED, __HIP_MEMORY_SCOPE_AGENT); }
__device__ __forceinline__ unsigned xb_xcc_id() { return (unsigned)__builtin_amdgcn_s_getreg((3 << 11) | 20) & 0xFu; }
#define XB_SPIN(cond, bar) do { unsigned _sp = 0; while (cond) { __builtin_amdgcn_s_sleep(1); \
    if ((++_sp & 255u) == 0u) { if (xb_ld(&(bar)[XB_TMO])) break; if (_sp > XB_SPIN_CAP) { atomicAdd(&(bar)[XB_TMO], 1u); break; } } } } while (0)

struct XcdBarrier { unsigned* bar; unsigned x; volatile LAS unsigned* st; bool t0; };

__device__ __forceinline__ XcdBarrier xcd_barrier_post(unsigned* bar, volatile LAS unsigned* st, bool t0) {
    XcdBarrier b; b.bar = bar; b.x = xb_xcc_id(); b.st = st; b.t0 = t0;
    if (t0) (void)xb_add(&bar[XB_XCNT(b.x)], 1u);
    return b;
}
__device__ __forceinline__ void xcd_barrier_complete(unsigned* bar, unsigned x, unsigned& nloc, unsigned& nx) {
    const unsigned G = gridDim.x * gridDim.y * gridDim.z;
    unsigned sum, cnt, mine, sp = 0u;
    for (;;) {
        sum = 0u; cnt = 0u; mine = 0u;
#pragma unroll
        for (unsigned j = 0; j < 16; ++j) { const unsigned c = xb_ld(&bar[XB_XCNT(j)]); sum += c; cnt += (c > 0u) ? 1u : 0u; mine = (j == x) ? c : mine; }
        if (sum == G) break;
        __builtin_amdgcn_s_sleep(1);
        if ((++sp & 255u) == 0u) { if (xb_ld(&bar[XB_TMO])) break; if (sp > XB_SPIN_CAP) { atomicAdd(&bar[XB_TMO], 1u); break; } }
    }
    nloc = mine > 0u ? mine : 1u; nx = cnt > 0u ? cnt : 1u;
}
__device__ __forceinline__ void xcd_barrier(const XcdBarrier& b) {
    asm volatile("s_waitcnt vmcnt(0)" ::: "memory");
    __syncthreads();
    if (b.t0) {
        unsigned* bar = b.bar;
        __builtin_amdgcn_s_waitcnt(0);
        unsigned nloc = b.st[0], nx = b.st[1];
        if (nloc == 0u) { xcd_barrier_complete(bar, b.x, nloc, nx); b.st[0] = nloc; b.st[1] = nx; }
        const unsigned old = xb_add(&bar[XB_XSUB(b.x)], 1u);
        const unsigned gen = old / nloc;
        if (old + 1u == (gen + 1u) * nloc) {
            __builtin_amdgcn_fence(__ATOMIC_RELEASE, "agent");
            asm volatile("s_waitcnt vmcnt(0)" ::: "memory");
            const unsigned og = xb_add(&bar[XB_TOP], 1u);
            const unsigned tg = og / nx;
            if (og + 1u == (tg + 1u) * nx) xb_add(&bar[XB_TOPGEN], 1u);
            else XB_SPIN(xb_ld(&bar[XB_TOPGEN]) == tg, bar);
            __builtin_amdgcn_fence(__ATOMIC_ACQUIRE, "agent");
            xb_add(&bar[XB_XGEN(b.x)], 1u);
            asm volatile("s_waitcnt vmcnt(0)" ::: "memory");
        } else {
            XB_SPIN(xb_ld(&bar[XB_XGEN(b.x)]) == gen, bar);
            __builtin_amdgcn_fence(__ATOMIC_ACQUIRE, "agent");
            asm volatile("s_waitcnt vmcnt(0)" ::: "memory");
        }
    }
    __syncthreads();
}

typedef __bf16 bf16v2_t __attribute__((ext_vector_type(2)));
typedef float f32v2_t __attribute__((ext_vector_type(2)));
__device__ __forceinline__ unsigned cvtpk(float lo, float hi) { const f32v2_t v = {lo, hi}; const bf16v2_t b = __builtin_convertvector(v, bf16v2_t); return __builtin_bit_cast(unsigned, b); }
__device__ __forceinline__ bf16_t f2bf(float x) { const __bf16 b = (__bf16)x; return __builtin_bit_cast(bf16_t, b); }
__device__ __forceinline__ float bf2f(bf16_t h) { return __uint_as_float(((unsigned)h) << 16); }
__device__ __forceinline__ float bflo(unsigned w) { return __uint_as_float(w << 16); }
__device__ __forceinline__ float bfhi(unsigned w) { return __uint_as_float(w & 0xffff0000u); }
__device__ __forceinline__ float silu_f(float x) { return x / (1.f + __expf(-x)); }
__device__ __forceinline__ float logsigmoid_f(float z) { return fminf(z, 0.f) - __logf(1.f + __expf(-fabsf(z))); }
__device__ __forceinline__ float wave_sum(float v) {
#pragma unroll
    for (int o = 32; o >= 1; o >>= 1) v += __shfl_xor(v, o, 64);
    return v;
}
__device__ __forceinline__ void zero_acc(f32x16& a) {
#pragma unroll
    for (int r = 0; r < 16; ++r) a[r] = 0.f;
    asm volatile("" : "+v"(a));
}
__device__ __forceinline__ int crow(int r, int hi) { return (r & 3) + 8 * (r >> 2) + 4 * hi; }

struct Params { const float* in[26]; float* out; unsigned char* ws; int ph_lo, ph_hi; };
typedef const __attribute__((address_space(4))) Params* KParams;
struct Ctx {
    KParams pp;
    int tid, lane, wid;
};
__device__ __forceinline__ int mk_tid(int w0) { unsigned m = ~0u; asm volatile("" : "+s"(m)); return (w0 << 6) | (int)__builtin_amdgcn_mbcnt_hi(m, __builtin_amdgcn_mbcnt_lo(m, 0u)); }
__device__ __forceinline__ float shx(float v, int o, int lane) { return __int_as_float(__builtin_amdgcn_ds_bpermute((lane ^ o) << 2, __float_as_int(v))); }
__device__ __forceinline__ Ctx fresh_ctx(int w0) {
    Ctx c; unsigned long long a = (unsigned long long)__builtin_amdgcn_kernarg_segment_ptr(); asm volatile("" : "+s"(a)); c.pp = (KParams)a;
    int t = mk_tid(w0); asm volatile("" : "+v"(t)); c.tid = t; c.lane = t & 63; c.wid = w0;
    return c;
}
#define CIN(i)   (c.pp->in[i])
#define COUT     (c.pp->out)
#define CWS(off) (c.pp->ws + (off))
#define C_MODT ((float*)CWS(WS_MOD))
#define C_XC   ((float*)CWS(WS_XC))
#define C_WIN  ((bf16_t*)CWS(WS_WIN))
#define C_WOUT ((bf16_t*)CWS(WS_WOUT))
#define C_WQ   ((bf16_t*)CWS(WS_WQ))
#define C_WUQ  ((bf16_t*)CWS(WS_WUQ))
#define C_WUKV ((bf16_t*)CWS(WS_WUKV))
#define C_KEYS ((bf16_t*)CWS(WS_KEYS))
#define C_HB   ((bf16_t*)CWS(WS_HB))
#define C_QM   ((bf16_t*)CWS(WS_QM))
#define C_KVM  ((bf16_t*)CWS(WS_KVM))
#define C_P    ((bf16_t*)CWS(WS_P))
#define C_TU8  ((unsigned char*)CWS(WS_TU8))
#define C_TV8  ((unsigned char*)CWS(WS_TV8))
#define C_SU   ((float*)CWS(WS_SU))
#define C_SV   ((float*)CWS(WS_SV))
#define C_PART ((float*)CWS(WS_PART))
#define C_Q2   ((bf16_t*)CWS(WS_Q2))
#define C_SG   ((bf16_t*)CWS(WS_SG))
#define C_SH   ((bf16_t*)CWS(WS_SH))
#define C_DG   ((float*)CWS(WS_DG))
#define C_DH   ((float*)CWS(WS_DH))
#define C_EI   ((int*)CWS(WS_EI))
#define C_EG   ((float*)CWS(WS_EG))

__device__ __forceinline__ float* xrow(const Ctx& c, int r) {
    const int b = r / RPB, j = r - b * RPB;
    return j < CTX ? C_XC + ((size_t)(b * CTX + j) << 10) : COUT + ((size_t)(b * SEQ + (j - CTX)) << 10);
}
__device__ __forceinline__ const float* inrow(const Ctx& c, int r) {
    const int b = r / RPB, j = r - b * RPB;
    return j < CTX ? CIN(2) + ((size_t)(b * CTX + j) << 10) : CIN(0) + ((size_t)(b * SEQ + (j - CTX)) << 10);
}

__device__ void p0_mod_item(const Ctx& c, int item, char* lds) {
    float* sc = (float*)lds;
    float* red = sc + 5 * 1024;
    const int tid = c.tid;
    for (int i = tid; i < 5 * 1024; i += 512) { const int v = i >> 10, k = i & 1023; const float x = (v < 4) ? CIN(1)[v * 1024 + k] : CIN(3)[k]; sc[i] = silu_f(x); }
    __syncthreads();
    const int l = item / 96, n0 = (item % 96) * 64;
    const int col = tid & 63, kg = tid >> 6;
    const float* w = CIN(4) + (size_t)l * 1024 * 6144 + n0 + col;
    float a[5] = {0.f, 0.f, 0.f, 0.f, 0.f};
#pragma unroll 8
    for (int kk = 0; kk < 128; ++kk) { const int k = kg * 128 + kk; const float wv = w[(size_t)k * 6144];
#pragma unroll
        for (int v = 0; v < 5; ++v) a[v] += sc[v * 1024 + k] * wv; }
#pragma unroll
    for (int v = 0; v < 5; ++v) red[(kg * 64 + col) * 5 + v] = a[v];
    __syncthreads();
    if (tid < 320) { const int cc = tid / 5, v = tid % 5; float s = 0.f;
#pragma unroll
        for (int g = 0; g < 8; ++g) s += red[(g * 64 + cc) * 5 + v];
        C_MODT[((size_t)l * 5 + v) * 6144 + n0 + cc] = s + CIN(5)[l * 6144 + n0 + cc]; }
    __syncthreads();
}
__device__ void p0_tr_tile(const float* __restrict__ src, bf16_t* __restrict__ dst, int K, int N, int k0, int n0, int tid, char* lds) {
    float* t = (float*)lds;
#pragma unroll
    for (int i = 0; i < 2; ++i) { const int k = (tid >> 4) + 32 * i, n4 = (tid & 15) * 4;
        const f32x4 v = *(const f32x4*)(src + (size_t)(k0 + k) * N + n0 + n4);
        t[k * 65 + n4 + 0] = v[0]; t[k * 65 + n4 + 1] = v[1]; t[k * 65 + n4 + 2] = v[2]; t[k * 65 + n4 + 3] = v[3]; }
    __syncthreads();
    { const int n = tid >> 3, k8 = (tid & 7) * 8; u32x4 w;
#pragma unroll
        for (int j = 0; j < 4; ++j) w[j] = cvtpk(t[(k8 + 2 * j) * 65 + n], t[(k8 + 2 * j + 1) * 65 + n]);
        *(u32x4*)(dst + (size_t)(n0 + n) * K + k0 + k8) = w; }
    __syncthreads();
}
__device__ void ph_p0(const Ctx& c, char* lds) {
    constexpr int T_WIN = 16 * 50, T_WOUT = 16 * 16, T_WQ = 16 * 32, T_UQ = 3 * 6, T_UKV = 2 * 8;
    constexpr int PER_L = T_WIN + T_WOUT + T_WQ + T_UQ + T_UKV;
    constexpr int NITEM = 192 + 2 * PER_L;
    for (int it = blockIdx.x; it < NITEM; it += gridDim.x) {
        if (it < 192) { p0_mod_item(c, it, lds); continue; }
        int t = it - 192; const int l = t / PER_L; t -= l * PER_L;
        if (t < T_WIN) { p0_tr_tile(CIN(8) + (size_t)l * D * INC, C_WIN + (size_t)l * INC * D, D, INC, (t / 50) * 64, (t % 50) * 64, c.tid, lds); continue; } t -= T_WIN;
        if (t < T_WOUT) { p0_tr_tile(CIN(9) + (size_t)l * D * D, C_WOUT + (size_t)l * D * D, D, D, (t / 16) * 64, (t % 16) * 64, c.tid, lds); continue; } t -= T_WOUT;
        if (t < T_WQ) { p0_tr_tile(CIN(21) + (size_t)l * D * 2048, C_WQ + (size_t)l * 2048 * D, D, 2048, (t / 32) * 64, (t % 32) * 64, c.tid, lds); continue; } t -= T_WQ;
        if (t < T_UQ) { p0_tr_tile(CIN(17) + (size_t)l * 192 * 384, C_WUQ + (size_t)l * 384 * 192, 192, 384, (t / 6) * 64, (t % 6) * 64, c.tid, lds); continue; } t -= T_UQ;
        p0_tr_tile(CIN(18) + (size_t)l * 128 * 512, C_WUKV + (size_t)l * 512 * 128, 128, 512, (t / 8) * 64, (t % 8) * 64, c.tid, lds);
    }
    const size_t nk8 = (size_t)2 * 16 * 128 * 128 / 8;
    for (size_t i = (size_t)blockIdx.x * 512 + c.tid; i < nk8; i += (size_t)gridDim.x * 512) {
        const f32x4 a = *(const f32x4*)(CIN(22) + i * 8), b = *(const f32x4*)(CIN(22) + i * 8 + 4);
        u32x4 w = {cvtpk(a[0], a[1]), cvtpk(a[2], a[3]), cvtpk(b[0], b[1]), cvtpk(b[2], b[3])};
        *(u32x4*)(C_KEYS + i * 8) = w;
    }
}

template <int WHICH>
__device__ void ph_norm(const Ctx& c, int l) {
    const float* g = CIN(WHICH == 0 ? 6 : 7) + l * D;
    const bool need_ctx = (l < DEPTH - 1);
    const int stride = gridDim.x * 8;
    auto next_row = [&](int r) { for (; r < NR; r += stride) { const int j = r % RPB; if (!(WHICH == 1 && j < CTX && !need_ctx)) break; } return r; };
    auto row_src = [&](int r) { return (WHICH == 0 && l == 0) ? inrow(c, r) : (const float*)xrow(c, r); };
    int r = next_row(blockIdx.x * 8 + c.wid);
    f32x4 xn[4];
    if (r < NR) { const float* src = row_src(r);
#pragma unroll
        for (int i = 0; i < 4; ++i) xn[i] = *(const f32x4*)(src + i * 256 + c.lane * 4); }
    while (r < NR) {
        f32x4 x[4];
#pragma unroll
        for (int i = 0; i < 4; ++i) x[i] = xn[i];
        const int rn = next_row(r + stride);
        if (rn < NR) { const float* src = row_src(rn);
#pragma unroll
            for (int i = 0; i < 4; ++i) xn[i] = *(const f32x4*)(src + i * 256 + c.lane * 4); }
        const int b = r / RPB, j = r - b * RPB; const bool isctx = j < CTX;
        float ss = 0.f;
#pragma unroll
        for (int i = 0; i < 4; ++i) ss += x[i][0] * x[i][0] + x[i][1] * x[i][1] + x[i][2] * x[i][2] + x[i][3] * x[i][3];
        ss = wave_sum(ss);
        const float rstd = rsqrtf(ss * (1.f / D) + NORM_EPS);
        const float* mt = C_MODT + ((size_t)l * 5 + (isctx ? 4 : b)) * 6144;
        const float* sh = mt + (WHICH == 0 ? 0 : 3) * D; const float* scl = mt + (WHICH == 0 ? 1 : 4) * D;
        bf16_t* dst = C_HB + (size_t)r * D;
        float* xr = xrow(c, r);
#pragma unroll
        for (int i = 0; i < 4; ++i) { const int col = i * 256 + c.lane * 4;
            const f32x4 gv = *(const f32x4*)(g + col), sv = *(const f32x4*)(sh + col), cv = *(const f32x4*)(scl + col);
            float y[4];
#pragma unroll
            for (int e = 0; e < 4; ++e) y[e] = x[i][e] * rstd * gv[e] * (1.f + cv[e]) + sv[e];
            u32x2 w = {cvtpk(y[0], y[1]), cvtpk(y[2], y[3])};
            *(u32x2*)(dst + col) = w;
            if (WHICH == 0 && l == 0) *(f32x4*)(xr + col) = x[i]; }
        r = rn;
    }
}

constexpr int GEMM_LDS = 98304;
template <class Epi>
__device__ __forceinline__ void gemm_tile(const Ctx& c, const bf16_t* __restrict__ A, int lda, const bf16_t* __restrict__ Bt, int ldb, int K, int m0, int n0, char* lds, const Epi& epi) {
    const int tid = c.tid, lane = tid & 63, wid = tid >> 6, r32 = lane & 31, hi = lane >> 5, wm = wid >> 1, wn = wid & 1;
    char* As = lds; char* Bs = lds + 65536;
    f32x16 acc[2][2];
#pragma unroll
    for (int m = 0; m < 2; ++m)
#pragma unroll
        for (int n = 0; n < 2; ++n) zero_acc(acc[m][n]);
    u32x4 ra[4], rb[2];
    const int srow = tid >> 3, sch = tid & 7;
    const bf16_t* Ag = A + (size_t)(m0 + srow) * lda + sch * 8;
    const bf16_t* Bg = Bt + (size_t)(n0 + srow) * ldb + sch * 8;
    const int swoff = srow * 128 + ((sch ^ ((srow >> 1) & 7)) << 4);
#define GLOAD(k0) do { _Pragma("unroll") for (int i = 0; i < 4; ++i) ra[i] = *(const u32x4*)(Ag + (size_t)(64 * i) * lda + (k0)); \
                       _Pragma("unroll") for (int i = 0; i < 2; ++i) rb[i] = *(const u32x4*)(Bg + (size_t)(64 * i) * ldb + (k0)); } while (0)
#define SWRITE(buf) do { _Pragma("unroll") for (int i = 0; i < 4; ++i) *(u32x4*)(As + (buf) * 32768 + swoff + i * 8192) = ra[i]; \
                         _Pragma("unroll") for (int i = 0; i < 2; ++i) *(u32x4*)(Bs + (buf) * 16384 + swoff + i * 8192) = rb[i]; } while (0)
    const int nk = K >> 6;
    GLOAD(0); SWRITE(0); __syncthreads();
    for (int kt = 0; kt < nk; ++kt) {
        const int buf = kt & 1;
        if (kt + 1 < nk) GLOAD((kt + 1) * 64);
        const char* Ab = As + buf * 32768; const char* Bb = Bs + buf * 16384;
#pragma unroll
        for (int ks = 0; ks < 4; ++ks) {
            bf16x8 a[2], b[2];
#pragma unroll
            for (int m = 0; m < 2; ++m) { const int row = wm * 64 + m * 32 + r32; a[m] = *(const bf16x8*)(Ab + row * 128 + (((ks * 2 + hi) ^ ((row >> 1) & 7)) << 4)); }
#pragma unroll
            for (int n = 0; n < 2; ++n) { const int row = wn * 64 + n * 32 + r32; b[n] = *(const bf16x8*)(Bb + row * 128 + (((ks * 2 + hi) ^ ((row >> 1) & 7)) << 4)); }
#pragma unroll
            for (int m = 0; m < 2; ++m)
#pragma unroll
                for (int n = 0; n < 2; ++n) acc[m][n] = __builtin_amdgcn_mfma_f32_32x32x16_bf16(a[m], b[n], acc[m][n], 0, 0, 0);
        }
        if (kt + 1 < nk) SWRITE(buf ^ 1);
        __syncthreads();
    }
#undef GLOAD
#undef SWRITE
    epi(acc, m0 + wm * 64, n0 + wn * 64, r32, hi);
}
struct EpiBf16 {
    bf16_t* C; int ldc; float scale;
    __device__ __forceinline__ void operator()(const f32x16 (&acc)[2][2], int row0, int col0, int r32, int hi) const {
        bf16_t* base = C + (size_t)(row0 + 4 * hi) * ldc + col0 + r32;
#pragma unroll
        for (int m = 0; m < 2; ++m)
#pragma unroll
            for (int r = 0; r < 16; ++r) { bf16_t* p = base + (size_t)(m * 32 + (r & 3) + 8 * (r >> 2)) * ldc;
                p[0] = f2bf(acc[m][0][r] * scale); p[32] = f2bf(acc[m][1][r] * scale);
                asm volatile("" ::: "memory"); }
    }
};

template <int MX> struct ScanCfg;
template <> struct ScanCfg<0> { static constexpr int DK = 32; };
template <> struct ScanCfg<1> { static constexpr int DK = 64; };

constexpr int BP = 72;
typedef float f32x4v __attribute__((ext_vector_type(4)));
__device__ __forceinline__ bf16x8 frag16(const bf16_t* tile, int row0, int k0, int lane) { return *(const bf16x8*)(tile + (row0 + (lane & 15)) * BP + k0 + 8 * (lane >> 4)); }

constexpr int SCAN_TAB_OFF = 128000;
__device__ __forceinline__ void scan_tables(const Ctx& c, int l, char* lds) {
    float* wtab = (float*)(lds + SCAN_TAB_OFF); float* btab = wtab + 2 * 16 * 128; float* lbtab = btab + 2 * 128;
    for (int i = c.tid; i < 2 * 16 * 128; i += 512) wtab[i] = CIN(10)[(size_t)l * 2 * 16 * 128 + i];
    if (c.tid < 256) { btab[c.tid] = CIN(11)[(size_t)l * 256 + c.tid];
        float lb = 0.f; if (l > 0) { const float r0 = CIN(13)[c.tid], r1 = CIN(13)[256 + c.tid]; lb = 1.f / (1.f + __expf(r0 - r1)); }
        lbtab[c.tid] = lb; }
    __syncthreads();
}
template <int MX, bool WANT_Q>
__device__ __forceinline__ void scan_load(const Ctx& c, int l, int b, int h, int cc, int dir, float* qt, float* kt, float* gt, bf16_t* VT, float* tmp, const char* ldsb) {
    constexpr int DK = ScanCfg<MX>::DK, PK = DK + 1;
    const int tid = c.tid;
    const int t = tid >> 3, j0 = (tid & 7) * 8;
    const bf16_t* pr = C_P + (size_t)(b * RPB + cc * 64 + (dir ? 63 - t : t)) * INC;
    const u32x4 vv = *(const u32x4*)(pr + (MX == 0 ? GLA_V : HG_I) + h * 64 + j0);
    if (MX == 0) {
        float* zt = tmp; const float* wt = (const float*)(ldsb + SCAN_TAB_OFF) + dir * 16 * 128 + h * 32; const float* bt = (const float*)(ldsb + SCAN_TAB_OFF) + 2 * 16 * 128 + dir * 128 + h * 32;
        const int j4 = (tid & 7) * 4;
        const u32x2 kv = *(const u32x2*)(pr + GLA_K + h * 32 + j4);
        u32x2 qv = {0u, 0u}; if (WANT_Q) qv = *(const u32x2*)(pr + GLA_Q + h * 32 + j4);
        u32x4 zv = {0u, 0u, 0u, 0u};
        if (tid < 128) zv = *(const u32x4*)(C_P + (size_t)(b * RPB + cc * 64 + (dir ? 63 - (tid >> 1) : (tid >> 1))) * INC + (dir ? GLA_ZB : GLA_ZF) + (tid & 1) * 8);
        if (tid < 128) { float* zp = zt + (tid >> 1) * 16 + (tid & 1) * 8;
#pragma unroll
            for (int q = 0; q < 4; ++q) { zp[2 * q] = bflo(zv[q]); zp[2 * q + 1] = bfhi(zv[q]); } }
        __syncthreads();
#pragma unroll
        for (int e = 0; e < 4; ++e) { const int j = j4 + e;
            float a = bt[j];
#pragma unroll
            for (int k = 0; k < 16; ++k) a += zt[t * 16 + k] * wt[k * 128 + j];
            gt[t * PK + j] = logsigmoid_f(a) * (1.f / 16.f);
            kt[t * PK + j] = (e & 1) ? bfhi(kv[e >> 1]) : bflo(kv[e >> 1]);
            if (WANT_Q) qt[t * PK + j] = ((e & 1) ? bfhi(qv[e >> 1]) : bflo(qv[e >> 1])) * 0.17677669529663687f; }
    } else {
        const u32x4 zv = *(const u32x4*)(pr + (dir ? HG_ZB : HG_ZF) + h * 64 + j0);
        u32x4 qv = {0u, 0u, 0u, 0u}; if (WANT_Q) qv = *(const u32x4*)(pr + HG_Q + h * 64 + j0);
        float lbv[8];
        { const float* lbt = (const float*)(ldsb + SCAN_TAB_OFF) + 2 * 16 * 128 + 2 * 128 + h * 64 + j0;
#pragma unroll
          for (int e = 0; e < 8; ++e) lbv[e] = lbt[e]; }
#pragma unroll
        for (int e = 0; e < 8; ++e) { const int j = j0 + e;
            const float z = fminf(fmaxf((e & 1) ? bfhi(zv[e >> 1]) : bflo(zv[e >> 1]), -80.f), 80.f); const float lb = lbv[e];
            const float ez = __expf(-z), sg = __builtin_amdgcn_rcpf(1.f + ez);
            gt[t * PK + j] = fmaxf(__logf(lb + (1.f - lb) * sg), -69.07755279f);
            kt[t * PK + j] = (1.f - lb) * ez * sg;
            if (WANT_Q) { const float qz = (e & 1) ? bfhi(qv[e >> 1]) : bflo(qv[e >> 1]); qt[t * PK + j] = qz * __builtin_amdgcn_rcpf(1.f + __expf(-qz)); } }
    }
#pragma unroll
    for (int e = 0; e < 8; ++e) VT[(j0 + e) * BP + t] = (bf16_t)((e & 1) ? (vv[e >> 1] >> 16) : (vv[e >> 1] & 0xffffu));
    __syncthreads();
    { float x[DK / 8];
#pragma unroll
        for (int u = 0; u < DK / 8; ++u) x[u] = gt[c.lane * PK + c.wid + 8 * u];
#pragma unroll
        for (int d = 1; d < 64; d <<= 1)
#pragma unroll
            for (int u = 0; u < DK / 8; ++u) { const float y = __shfl_up(x[u], d, 64); if (c.lane >= d) x[u] += y; }
#pragma unroll
        for (int u = 0; u < DK / 8; ++u) gt[c.lane * PK + c.wid + 8 * u] = x[u]; }
    __syncthreads();
}

template <int MX>
__device__ void scanA_item(const Ctx& c, int l, int b, int h, int cc, int dir, char* lds) {
    constexpr int DK = ScanCfg<MX>::DK, PK = DK + 1;
    float* kt = (float*)lds; float* gt = kt + 64 * PK; bf16_t* VT = (bf16_t*)(gt + 64 * PK); bf16_t* KET = VT + 64 * BP; float* tmp = (float*)(KET + 64 * BP);
    scan_load<MX, false>(c, l, b, h, cc, dir, nullptr, kt, gt, VT, tmp, lds);
    const int tid = c.tid, lane = c.lane;
    for (int i = tid; i < 64 * DK; i += 512) { const int s_ = i & 63, k = i >> 6; KET[k * BP + s_] = f2bf(kt[s_ * PK + k] * __expf(gt[63 * PK + k] - gt[s_ * PK + k])); }
    __syncthreads();
    const int ch = (b * 4 + h) * 2 + dir;
    bf16_t* S = (MX == 0 ? C_SG : C_SH) + ((size_t)ch * NCHUNK + cc) * (DK * 64);
    for (int tile = c.wid; tile < (DK / 16) * 4; tile += 8) { const int tk = tile >> 2, tj = tile & 3;
        f32x4v acc = {0.f, 0.f, 0.f, 0.f};
#pragma unroll
        for (int ks = 0; ks < 2; ++ks) acc = __builtin_amdgcn_mfma_f32_16x16x32_bf16(frag16(KET, tk * 16, ks * 32, lane), frag16(VT, tj * 16, ks * 32, lane), acc, 0, 0, 0);
#pragma unroll
        for (int i = 0; i < 4; ++i) S[(tk * 16 + 4 * (lane >> 4) + i) * 64 + tj * 16 + (lane & 15)] = f2bf(acc[i]); }
    if (tid < DK) (MX == 0 ? C_DG : C_DH)[((size_t)ch * NCHUNK + cc) * DK + tid] = __expf(gt[63 * PK + tid]);
    __syncthreads();
}
__device__ void scanB_item(const Ctx& c, int item) {
    const int e = item * 512 + c.tid;
    const bool hg = e >= 65536; const int ee = hg ? e - 65536 : e;
    const int DK = hg ? 64 : 32; const int per = DK * 64;
    const int ch = ee / per, ij = ee % per, i = ij >> 6; const int dir = ch & 1;
    bf16_t* S = (hg ? C_SH : C_SG) + (size_t)ch * NCHUNK * per + ij;
    const float* Dc = (hg ? C_DH : C_DG) + (size_t)ch * NCHUNK * DK + i;
    float st = 0.f;
    for (int n0 = 0; n0 < NCHUNK; n0 += 6) {
        float sv[6], dv[6];
#pragma unroll
        for (int u = 0; u < 6; ++u) { const int n = n0 + u; const int cc = dir ? (n < 4 ? 3 - n : 135 - n) : n; sv[u] = bf2f(S[(size_t)cc * per]); dv[u] = Dc[(size_t)cc * DK]; }
#pragma unroll
        for (int u = 0; u < 6; ++u) { const int n = n0 + u; const int cc = dir ? (n < 4 ? 3 - n : 135 - n) : n; S[(size_t)cc * per] = f2bf(st); st = dv[u] * st + sv[u]; }
    }
}
template <int MX>
__device__ void scanC_item(const Ctx& c, int l, int b, int h, int cc, char* lds) {
    constexpr int DK = ScanCfg<MX>::DK, PK = DK + 1;
    float* qt = (float*)lds; float* kt = qt + 64 * PK; float* gt = kt + 64 * PK; float* ot = gt + 64 * PK;
    bf16_t* VT = (bf16_t*)(ot + 64 * 65); bf16_t* QS = VT + 64 * BP; bf16_t* QG = QS + 64 * BP; bf16_t* KS = QG + 64 * BP;
    bf16_t* SC = KS + 96 * BP; bf16_t* ST = SC + 64 * BP; float* tmp = (float*)(ST + 64 * BP);
    const int tid = c.tid, lane = c.lane;
    for (int dir = 0; dir < 2; ++dir) {
        scan_load<MX, true>(c, l, b, h, cc, dir, qt, kt, gt, VT, tmp, lds);
        const int ch = (b * 4 + h) * 2 + dir;
        const bf16_t* Sg = (MX == 0 ? C_SG : C_SH) + ((size_t)ch * NCHUNK + cc) * (DK * 64);
        if (tid < DK * 8) { const int k = tid >> 3, jb = (tid & 7) * 8; const u32x4 sr = *(const u32x4*)(Sg + tid * 8);
#pragma unroll
            for (int e = 0; e < 8; ++e) ST[(jb + e) * BP + k] = (bf16_t)((e & 1) ? (sr[e >> 1] >> 16) : (sr[e >> 1] & 0xffffu)); }
        for (int i = tid; i < 64 * DK; i += 512) { const int t = i / DK, k = i % DK; const int I = t >> 4;
            const float bt = gt[t * PK + k], qv = qt[t * PK + k], kv = kt[t * PK + k];
            const float Bi = I ? gt[(16 * I - 1) * PK + k] : 0.f;
            QS[t * BP + k] = f2bf(qv * __expf(bt - Bi));
            QG[t * BP + k] = f2bf(qv * __expf(bt));
            if (t < 16) KS[t * BP + k] = f2bf(kv * __expf(gt[15 * PK + k] - bt));
            if (t < 32) KS[(16 + t) * BP + k] = f2bf(kv * __expf(gt[31 * PK + k] - bt));
            if (t < 48) KS[(48 + t) * BP + k] = f2bf(kv * __expf(gt[47 * PK + k] - bt)); }
        { const int blk = tid >> 7, tl = (tid >> 3) & 15, s0 = (tid & 7) * 2; const int t = blk * 16 + tl;
            float a0 = 0.f, a1 = 0.f;
            if (s0 <= tl) { const int sa = blk * 16 + s0, sb = sa + 1;
                for (int k = 0; k < DK; ++k) { const float qv = qt[t * PK + k], bv = gt[t * PK + k];
                    a0 += qv * kt[sa * PK + k] * __expf(fminf(bv - gt[sa * PK + k], 0.f));
                    a1 += qv * kt[sb * PK + k] * __expf(fminf(bv - gt[sb * PK + k], 0.f)); }
                if (s0 + 1 > tl) a1 = 0.f; }
            SC[t * BP + blk * 16 + s0] = f2bf(a0); SC[t * BP + blk * 16 + s0 + 1] = f2bf(a1);
            for (int J = blk + 1; J < 4; ++J) { SC[t * BP + J * 16 + s0] = 0; SC[t * BP + J * 16 + s0 + 1] = 0; } }
        __syncthreads();
        if (c.wid < 6) { const int I = c.wid < 1 ? 1 : (c.wid < 3 ? 2 : 3), J = c.wid < 1 ? 0 : (c.wid < 3 ? c.wid - 1 : c.wid - 3);
            const bf16_t* KSI = KS + (I == 1 ? 0 : (I == 2 ? 16 : 48)) * BP;
            f32x4v acc = {0.f, 0.f, 0.f, 0.f};
#pragma unroll
            for (int ks = 0; ks < DK / 32; ++ks) acc = __builtin_amdgcn_mfma_f32_16x16x32_bf16(frag16(QS, I * 16, ks * 32, lane), frag16(KSI, J * 16, ks * 32, lane), acc, 0, 0, 0);
#pragma unroll
            for (int i = 0; i < 4; ++i) SC[(I * 16 + 4 * (lane >> 4) + i) * BP + J * 16 + (lane & 15)] = f2bf(acc[i]); }
        __syncthreads();
#pragma unroll
        for (int u = 0; u < 2; ++u) { const int tile = c.wid * 2 + u; const int ti = tile >> 2, tj = tile & 3;
            f32x4v acc = {0.f, 0.f, 0.f, 0.f};
#pragma unroll
            for (int ks = 0; ks < 2; ++ks) acc = __builtin_amdgcn_mfma_f32_16x16x32_bf16(frag16(SC, ti * 16, ks * 32, lane), frag16(VT, tj * 16, ks * 32, lane), acc, 0, 0, 0);
#pragma unroll
            for (int ks = 0; ks < DK / 32; ++ks) acc = __builtin_amdgcn_mfma_f32_16x16x32_bf16(frag16(QG, ti * 16, ks * 32, lane), frag16(ST, tj * 16, ks * 32, lane), acc, 0, 0, 0);
#pragma unroll
            for (int i = 0; i < 4; ++i) { const int t = ti * 16 + 4 * (lane >> 4) + i; const int to = dir ? 63 - t : t; float* op = ot + to * 65 + tj * 16 + (lane & 15);
                if (dir == 0) *op = acc[i]; else *op += acc[i]; } }
        __syncthreads();
    }
    { const int t = tid >> 3, j0 = (tid & 7) * 8; float o[8]; float ss = 0.f;
#pragma unroll
        for (int j = 0; j < 8; ++j) { o[j] = ot[t * 65 + j0 + j]; ss += o[j] * o[j]; }
        ss += __shfl_xor(ss, 1, 64); ss += __shfl_xor(ss, 2, 64); ss += __shfl_xor(ss, 4, 64);
        const float rstd = rsqrtf(ss * (1.f / 64.f) + NORM_EPS);
        const int r = b * RPB + cc * 64 + t;
        const float* gn = CIN(MX == 0 ? 12 : 14) + l * 64;
        const u32x4 gp = *(const u32x4*)(C_P + (size_t)r * INC + (MX == 0 ? GLA_R : HG_OG) + h * 64 + j0);
        float y[8];
#pragma unroll
        for (int j = 0; j < 8; ++j) y[j] = o[j] * rstd * gn[j0 + j] * silu_f((j & 1) ? bfhi(gp[j >> 1]) : bflo(gp[j >> 1]));
        u32x4 w = {cvtpk(y[0], y[1]), cvtpk(y[2], y[3]), cvtpk(y[4], y[5]), cvtpk(y[6], y[7])};
        *(u32x4*)(C_HB + (size_t)r * D + MX * 256 + h * 64 + j0) = w; }
    __syncthreads();
}

__device__ __forceinline__ void rope_cs(int pos, int i, float& cs, float& sn) {
    const float freq = __expf(-(float)i * (9.210340371976184f / 8.f));
    const float ang = (float)pos * freq;
    const float n = rintf(ang * 0.15915494309189535f);
    float rr = fmaf(-n, 6.2831854820251465f, ang); rr = fmaf(-n, -1.7484555e-7f, rr);
    cs = __cosf(rr); sn = __sinf(rr);
}

__device__ void ph_prep_rows(const Ctx& c, int l) {
    const float* gq = CIN(15) + l * 192; const float* gkv = CIN(16) + l * 128;
    for (int r = blockIdx.x * 8 + c.wid; r < NR; r += gridDim.x * 8) {
        const int b = r / RPB, j = r - b * RPB; bf16_t* pr = C_P + (size_t)r * INC;
        { float v[3]; float ss = 0.f;
#pragma unroll
            for (int i = 0; i < 3; ++i) { v[i] = bf2f(pr[MLA_CQ + c.lane + 64 * i]); ss += v[i] * v[i]; }
            ss = wave_sum(ss); const float rstd = rsqrtf(ss * (1.f / 192.f) + NORM_EPS);
#pragma unroll
            for (int i = 0; i < 3; ++i) pr[MLA_CQ + c.lane + 64 * i] = f2bf(v[i] * rstd * gq[c.lane + 64 * i]); }
        { float v[2]; float ss = 0.f;
#pragma unroll
            for (int i = 0; i < 2; ++i) { v[i] = bf2f(pr[MLA_CKV + c.lane + 64 * i]); ss += v[i] * v[i]; }
            ss = wave_sum(ss); const float rstd = rsqrtf(ss * (1.f / 128.f) + NORM_EPS);
#pragma unroll
            for (int i = 0; i < 2; ++i) pr[MLA_CKV + c.lane + 64 * i] = f2bf(v[i] * rstd * gkv[c.lane + 64 * i]); }
        if (j >= CTX) { const int t = j - CTX; const int prow = t >> 6, pcol = t & 63;
            for (int pp = c.lane; pp < 34 * 8; pp += 64) { const int g = pp >> 3, i = pp & 7;
                int col; if (g < 16) col = DF_Q + (g >> 1) * 32 + (g & 1) * 16; else if (g < 32) col = DF_K + ((g - 16) >> 1) * 32 + (g & 1) * 16; else col = MLA_KR + (g - 32) * 16;
                float cs, sn; rope_cs((g & 1) ? pcol : prow, i, cs, sn);
                const float x1 = bf2f(pr[col + i]), x2 = bf2f(pr[col + 8 + i]);
                pr[col + i] = f2bf(x1 * cs - x2 * sn); pr[col + 8 + i] = f2bf(x1 * sn + x2 * cs); } }
    }
}
__device__ void ph_rope_q(const Ctx& c) {
    for (int r = blockIdx.x * 8 + c.wid; r < NR; r += gridDim.x * 8) {
        const int b = r / RPB, j = r - b * RPB; if (j < CTX) continue;
        const int t = j - CTX; const int prow = t >> 6, pcol = t & 63;
        const int h = c.lane >> 4, g = (c.lane >> 3) & 1, i = c.lane & 7;
        bf16_t* q = C_QM + (size_t)r * 384 + h * 96 + 64 + g * 16;
        float cs, sn; rope_cs(g ? pcol : prow, i, cs, sn);
        const float x1 = bf2f(q[i]), x2 = bf2f(q[8 + i]);
        q[i] = f2bf(x1 * cs - x2 * sn); q[8 + i] = f2bf(x1 * sn + x2 * cs);
    }
}

__device__ __forceinline__ int v_st(int k, int cidx) { const int kk = (k & ~0xC) | ((k & 4) << 1) | ((k & 8) >> 1); return ((kk >> 3) * 2 + (cidx >> 5)) * 512 + ((kk & 7) * 32 + (cidx & 31)) * 2; }
__device__ __forceinline__ int v_rd_base(int lane) { return ((lane & 3) << 3) | (((lane >> 2) & 3) << 6) | (((lane >> 4) & 1) << 5) | (((lane >> 5) & 1) << 8); }
constexpr int v_rd_off(int d0, int ks, int half) { return d0 * 512 + ks * 2048 + half * 1024; }
template <int OFF> __device__ __forceinline__ s16x4 tr_read(int vb) { s16x4 r; asm volatile("ds_read_b64_tr_b16 %0, %1 offset:%2" : "=&v"(r) : "v"(vb), "i"(OFF) : "memory"); return r; }
template <int D0> __device__ __forceinline__ void pv_one(f32x16& od, int vb, bf16x8 pa0, bf16x8 pa1, bf16x8 pa2, bf16x8 pa3) {
    const s16x4 l0 = tr_read<v_rd_off(D0, 0, 0)>(vb), h0 = tr_read<v_rd_off(D0, 0, 1)>(vb), l1 = tr_read<v_rd_off(D0, 1, 0)>(vb), h1 = tr_read<v_rd_off(D0, 1, 1)>(vb);
    const s16x4 l2 = tr_read<v_rd_off(D0, 2, 0)>(vb), h2 = tr_read<v_rd_off(D0, 2, 1)>(vb), l3 = tr_read<v_rd_off(D0, 3, 0)>(vb), h3 = tr_read<v_rd_off(D0, 3, 1)>(vb);
    asm volatile("s_waitcnt lgkmcnt(0)" ::: "memory"); __builtin_amdgcn_sched_barrier(0);
#define PKV(L, H) (bf16x8){L[0], L[1], L[2], L[3], H[0], H[1], H[2], H[3]}
    od = __builtin_amdgcn_mfma_f32_32x32x16_bf16(pa0, PKV(l0, h0), od, 0, 0, 0);
    od = __builtin_amdgcn_mfma_f32_32x32x16_bf16(pa1, PKV(l1, h1), od, 0, 0, 0);
    od = __builtin_amdgcn_mfma_f32_32x32x16_bf16(pa2, PKV(l2, h2), od, 0, 0, 0);
    od = __builtin_amdgcn_mfma_f32_32x32x16_bf16(pa3, PKV(l3, h3), od, 0, 0, 0);
#undef PKV
}
constexpr float ATT_BIG = 1.0995116e12f;
constexpr float ATT_ZBIG = 1.2379400392853803e27f, ATT_ZSMALL = 8.673617379884035e-19f;
__device__ __forceinline__ float rowmax_tile(const f32x16& p0, const f32x16& p1) {
    float pmax = p0[0];
#pragma unroll
    for (int r = 1; r < 16; ++r) pmax = fmaxf(pmax, p0[r]);
#pragma unroll
    for (int r = 0; r < 16; ++r) pmax = fmaxf(pmax, p1[r]);
    auto rr = __builtin_amdgcn_permlane32_swap(__float_as_uint(pmax), __float_as_uint(pmax), false, false);
    return fmaxf(__uint_as_float(rr[0]), __uint_as_float(rr[1]));
}
__device__ __forceinline__ void softmax_tile(f32x16& p0, f32x16& p1, float& M, const float Mused, float& l_reg, const bool first,
                                             bf16x8& pa0, bf16x8& pa1, bf16x8& pa2, bf16x8& pa3, f32x16 (&o)[2], float* wsl, const int r32, const int hi) {
    if (__builtin_expect(__any(Mused != M), 0)) {
        asm volatile("" ::: "memory");
        const float dM = Mused - M;
#pragma unroll
        for (int r = 0; r < 16; ++r) { p0[r] += dM; p1[r] += dM; }
    }
    if (first) {
        float pmax = p0[0];
#pragma unroll
        for (int r = 1; r < 16; ++r) pmax = fmaxf(pmax, p0[r]);
#pragma unroll
        for (int r = 0; r < 16; ++r) pmax = fmaxf(pmax, p1[r]);
        { auto rr = __builtin_amdgcn_permlane32_swap(__float_as_uint(pmax), __float_as_uint(pmax), false, false); pmax = fmaxf(__uint_as_float(rr[0]), __uint_as_float(rr[1])); }
        M = pmax;
#pragma unroll
        for (int r = 0; r < 16; ++r) { p0[r] -= pmax; p1[r] -= pmax; }
    }
    float ps = 0.f;
#pragma unroll
    for (int r = 0; r < 16; ++r) { p0[r] = __builtin_amdgcn_exp2f(p0[r]); ps += p0[r]; }
#pragma unroll
    for (int r = 0; r < 16; ++r) { p1[r] = __builtin_amdgcn_exp2f(p1[r]); ps += p1[r]; }
    { auto rr = __builtin_amdgcn_permlane32_swap(__float_as_uint(ps), __float_as_uint(ps), false, false); ps = __uint_as_float(rr[0]) + __uint_as_float(rr[1]); }
    if (__builtin_expect(__any(ps > ATT_BIG), 0)) {
        asm volatile("" ::: "memory");
        float pm = p0[0];
#pragma unroll
        for (int r = 1; r < 16; ++r) pm = fmaxf(pm, p0[r]);
#pragma unroll
        for (int r = 0; r < 16; ++r) pm = fmaxf(pm, p1[r]);
        { auto rr = __builtin_amdgcn_permlane32_swap(__float_as_uint(pm), __float_as_uint(pm), false, false); pm = fmaxf(__uint_as_float(rr[0]), __uint_as_float(rr[1])); }
        const float alpha = pm > 1.f ? __builtin_amdgcn_rcpf(pm) : 1.f;
        M -= __builtin_amdgcn_logf(alpha);
#pragma unroll
        for (int r = 0; r < 16; ++r) { p0[r] *= alpha; p1[r] *= alpha; }
        ps *= alpha; l_reg *= alpha;
        if (hi == 0) wsl[r32] = alpha;
        asm volatile("s_waitcnt lgkmcnt(0)" ::: "memory");
#pragma unroll
        for (int r = 0; r < 16; ++r) { const float av = wsl[crow(r, hi)]; o[0][r] *= av; o[1][r] *= av; }
        asm volatile("" ::: "memory");
    }
    l_reg += ps;
#define PK4(P, BASE, OUT) do { unsigned a0 = cvtpk(P[BASE + 0], P[BASE + 1]), a1 = cvtpk(P[BASE + 2], P[BASE + 3]);   \
    unsigned b0 = cvtpk(P[BASE + 4], P[BASE + 5]), b1 = cvtpk(P[BASE + 6], P[BASE + 7]);                              \
    auto r0 = __builtin_amdgcn_permlane32_swap(a0, b0, false, false); auto r1 = __builtin_amdgcn_permlane32_swap(a1, b1, false, false); \
    u32x4 w = {r0[0], r1[0], r0[1], r1[1]}; OUT = *reinterpret_cast<bf16x8*>(&w); } while (0)
    PK4(p0, 0, pa0); PK4(p0, 8, pa1); PK4(p1, 0, pa2); PK4(p1, 8, pa3);
#undef PK4
}

constexpr int ATT_STAGE = 2 * 16384 + 2 * 8192;
constexpr int ATT_LDS = 65536 + 49152 + 8 * 64 * 4 + 16;
template <bool DIFF>
__device__ void attn_item(const Ctx& c, int l, int b, int hd, int qrow0, int krow0, int nkeys, char* lds) {
    constexpr int DQK = DIFF ? 32 : 96, NMAP = DIFF ? 2 : 1, ND0 = DQK / 16, NU = 2 * NMAP;
    constexpr int KP = DIFF ? 64 : 256;
    constexpr int KSZ = 64 * KP;
    constexpr int NKR = DIFF ? 2 : 3;
    const int tid_ = mk_tid(c.wid);
    const int tid = tid_, lane = tid_ & 63, wid = c.wid, r32 = lane & 31, hi = lane >> 5;
    char* K_lds0 = lds; char* V_lds0 = lds + 2 * 16384; float* wsl = (float*)(lds + 2 * ATT_STAGE) + wid * 64;
    const float scale = DIFF ? 0.17677669529663687f : 0.10206207261596575f;
    const float C = scale * 1.4426950408889634f;
    bf16x8 qr[NMAP][ND0];
    { const int qrow = qrow0 + wid * 32 + r32;
#pragma unroll
        for (int m = 0; m < NMAP; ++m)
#pragma unroll
            for (int d0 = 0; d0 < ND0; ++d0) {
                const bf16_t* p = DIFF ? C_P + (size_t)qrow * INC + DF_Q + (hd * 2 + m) * 32 + d0 * 16 + hi * 8
                                       : C_QM + (size_t)qrow * 384 + hd * 96 + d0 * 16 + hi * 8;
                qr[m][d0] = *(const bf16x8*)p; } }
    f32x16 o[NMAP][2]; float m_reg[NMAP], l_reg[NMAP];
#pragma unroll
    for (int m = 0; m < NMAP; ++m) { m_reg[m] = 0.f; l_reg[m] = 0.f;
#pragma unroll
        for (int d = 0; d < 2; ++d) zero_acc(o[m][d]); }
    constexpr int NKP = DIFF ? 2 : 4;
    int ksrc[NKP], vsrc[2];
#pragma unroll
    for (int q = 0; q < NKP; ++q) { const int off = (wid * NKP + q) * 1024 + lane * 16;
        if (DIFF) { const int blk = off >> 12, key = (off & 4095) >> 6, slot = (off & 63) >> 4, ch = slot ^ ((key >> 2) & 3);
            ksrc[q] = ((blk >> 1) * 64 + key) * INC + DF_K + (hd * 2 + (blk & 1)) * 32 + ch * 8; }
        else { const int tile = off >> 14, key = (off & 16383) >> 8, slot = (off & 255) >> 4, ch = slot ^ (key & 15);
            ksrc[q] = ch < 8 ? -1 - ((tile * 64 + key) * 512 + hd * 128 + ch * 8) : (ch < 12 ? (tile * 64 + key) * INC + MLA_KR + (ch - 8) * 8 : (int)0x80000000); } }
#pragma unroll
    for (int q = 0; q < 2; ++q) { const int off = (wid * 2 + q) * 1024 + lane * 16; const int tile = off >> 13, w = off & 8191;
        const int sub = w >> 9, within = w & 511; const int kk = (sub >> 1) * 8 + (within >> 6); const int col = (sub & 1) * 32 + ((within & 63) >> 1);
        const int key = (kk & ~0xC) | ((kk & 4) << 1) | ((kk & 8) >> 1);
        vsrc[q] = DIFF ? (tile * 64 + key) * INC + DF_V + hd * 64 + col : (tile * 64 + key) * 512 + hd * 128 + 64 + col; }
    const int vb0 = (int)(uintptr_t)V_lds0 + v_rd_base(lane);
#define ADMA(buf, kr) do { \
        _Pragma("unroll") for (int q = 0; q < NKP; ++q) { LAS unsigned* dst_ = (LAS unsigned*)(LAS char*)(K_lds0 + (buf) * ATT_STAGE + (wid * NKP + q) * 1024); \
            if (DIFF || ksrc[q] >= 0) __builtin_amdgcn_global_load_lds((const unsigned*)(C_P + (size_t)(kr) * INC + ksrc[q]), dst_, 16, 0, 0); \
            else if (ksrc[q] != (int)0x80000000) __builtin_amdgcn_global_load_lds((const unsigned*)(C_KVM + (size_t)(kr) * 512 + (-1 - ksrc[q])), dst_, 16, 0, 0); } \
        _Pragma("unroll") for (int q = 0; q < 2; ++q) { LAS unsigned* dst_ = (LAS unsigned*)(LAS char*)(V_lds0 + (buf) * ATT_STAGE + (wid * 2 + q) * 1024); \
            __builtin_amdgcn_global_load_lds((const unsigned*)((DIFF ? C_P + (size_t)(kr) * INC : C_KVM + (size_t)(kr) * 512) + vsrc[q]), dst_, 16, 0, 0); } } while (0)
    const int NS = nkeys >> 7;
    ADMA(0, krow0);
    for (int j = 0; j < NS; ++j) {
        asm volatile("s_waitcnt vmcnt(0)" ::: "memory");
        __syncthreads();
        if (j + 1 < NS) ADMA((j + 1) & 1, krow0 + (j + 1) * 128);
        const char* K_lds = K_lds0 + (j & 1) * ATT_STAGE; const int vb = vb0 + (j & 1) * ATT_STAGE;
        f32x16 p0[2], p1[2]; float mused[2];
#define QKT(u) do { constexpr int tt_ = (u) / NMAP, m_ = (u) % NMAP; const char* Kb = K_lds + (tt_ * NMAP + m_) * KSZ; \
            _Pragma("unroll") for (int d0 = 0; d0 < ND0; ++d0) { bf16x8 b0, b1; \
                if (DIFF) { const int ch = d0 * 2 + hi; const int ra = r32, rb = 32 + r32; \
                    b0 = *(const bf16x8*)(Kb + ra * 64 + ((ch ^ ((ra >> 2) & 3)) << 4)); b1 = *(const bf16x8*)(Kb + rb * 64 + ((ch ^ ((rb >> 2) & 3)) << 4)); } \
                else { const int cb = d0 * 32 + hi * 16; const int ra = r32, rb = 32 + r32; \
                    b0 = *(const bf16x8*)(Kb + ra * 256 + (cb ^ ((ra & 15) << 4))); b1 = *(const bf16x8*)(Kb + rb * 256 + (cb ^ ((rb & 15) << 4))); } \
                if (d0 == 0) { const float nm_ = -m_reg[m_]; mused[(u) & 1] = m_reg[m_]; const f32x16 z = {nm_,nm_,nm_,nm_,nm_,nm_,nm_,nm_,nm_,nm_,nm_,nm_,nm_,nm_,nm_,nm_}; \
                    p0[(u) & 1] = __builtin_amdgcn_mfma_f32_32x32x16_bf16(b0, qr[m_][0], z, 0, 0, 0); p1[(u) & 1] = __builtin_amdgcn_mfma_f32_32x32x16_bf16(b1, qr[m_][0], z, 0, 0, 0); \
                    asm volatile("" :: "v"(b0), "v"(b1));   } \
                else { p0[(u) & 1] = __builtin_amdgcn_mfma_f32_32x32x16_bf16(b0, qr[m_][d0], p0[(u) & 1], 0, 0, 0); p1[(u) & 1] = __builtin_amdgcn_mfma_f32_32x32x16_bf16(b1, qr[m_][d0], p1[(u) & 1], 0, 0, 0); } } \
            if (!DIFF) {   \
                __builtin_amdgcn_sched_group_barrier(0x100, 4, 0); \
                _Pragma("unroll") for (int g_ = 0; g_ < 4; ++g_) { __builtin_amdgcn_sched_group_barrier(0x8, 2, 0); __builtin_amdgcn_sched_group_barrier(0x100, 2, 0); } \
                __builtin_amdgcn_sched_group_barrier(0x8, 4, 0); } } while (0)
        QKT(0);
#pragma unroll
        for (int u = 0; u < NU; ++u) {
            const int tt = u / NMAP, m = u % NMAP;
            if (u + 1 < NU) { if (u == 0) QKT(1); else if (u == 1) QKT(2); else QKT(3); }
            bf16x8 pa0, pa1, pa2, pa3;
            softmax_tile(p0[u & 1], p1[u & 1], m_reg[m], mused[u & 1], l_reg[m], (j == 0) && (tt == 0), pa0, pa1, pa2, pa3, o[m], wsl, r32, hi);
            pv_one<0>(o[m][0], vb + tt * 8192, pa0, pa1, pa2, pa3);
            pv_one<1>(o[m][1], vb + tt * 8192, pa0, pa1, pa2, pa3);
        }
#undef QKT
    }
#undef ADMA
    float rli[NMAP][16];
#pragma unroll
    for (int m = 0; m < NMAP; ++m) {
        asm volatile("s_waitcnt lgkmcnt(0)" ::: "memory");
        if (hi == 0) wsl[r32] = l_reg[m];
        asm volatile("s_waitcnt lgkmcnt(0)" ::: "memory");
#pragma unroll
        for (int r = 0; r < 16; ++r) rli[m][r] = __builtin_amdgcn_rcpf(wsl[crow(r, hi)]);
    }
    const int orow0 = qrow0 + wid * 32;
    if (!DIFF) {
#pragma unroll
        for (int r = 0; r < 16; ++r) { bf16_t* dst = C_HB + (size_t)(orow0 + crow(r, hi)) * D + 512 + hd * 64 + r32;
            dst[0] = f2bf(o[0][0][r] * rli[0][r]); dst[32] = f2bf(o[0][1][r] * rli[0][r]); }
    } else {
        const float* lp = CIN(19) + l * 128; const float* gn = CIN(20) + l * 64; asm volatile("" : "+s"(lp), "+s"(gn));
        float s1 = lp[r32] * lp[32 + r32], s2 = lp[64 + r32] * lp[96 + r32];
#pragma unroll
        for (int o = 1; o < 32; o <<= 1) { s1 += shx(s1, o, lane); s2 += shx(s2, o, lane); }
        const float lam_init = (l == 0) ? 0.2f : 0.35550906759097f;
        const float lam = __expf(s1) - __expf(s2) + lam_init;
        const float g0 = gn[r32] * (1.f - lam_init), g1 = gn[32 + r32] * (1.f - lam_init);
#pragma unroll
        for (int r = 0; r < 16; ++r) {
            const float v0 = o[0][0][r] * rli[0][r] - lam * o[NMAP - 1][0][r] * rli[NMAP - 1][r];
            const float v1 = o[0][1][r] * rli[0][r] - lam * o[NMAP - 1][1][r] * rli[NMAP - 1][r];
            float ss = v0 * v0 + v1 * v1;
            ss += shx(ss, 1, lane); ss += shx(ss, 2, lane); ss += shx(ss, 4, lane); ss += shx(ss, 8, lane); ss += shx(ss, 16, lane);
            const float rstd = rsqrtf(ss * (1.f / 64.f) + NORM_EPS);
            bf16_t* dst = C_HB + (size_t)(orow0 + crow(r, hi)) * D + 768 + hd * 64 + r32;
            dst[0] = f2bf(v0 * rstd * g0); dst[32] = f2bf(v1 * rstd * g1); }
    }
    __syncthreads();
}
template <bool DIFF>
__device__ bool attn_item_pair(const Ctx& c, int l, int b, int hd, int qrow0, int krow0, int nkeys, char* lds) {
    constexpr int DQK = DIFF ? 32 : 96, NMAP = DIFF ? 2 : 1, ND0 = DQK / 16, NU = 2 * NMAP;
    constexpr int KP = DIFF ? 64 : 256;
    constexpr int KSZ = 64 * KP;
    constexpr int NKR = DIFF ? 2 : 3;
    const int tid_ = mk_tid(c.wid);
    const int tid = tid_, lane = tid_ & 63, wid = c.wid, r32 = lane & 31, hi = lane >> 5;
    char* K_lds0 = lds; char* V_lds0 = lds + 65536; float* wsl = (float*)(lds + 65536 + 49152) + wid * 64;
    const float scale = DIFF ? 0.17677669529663687f : 0.10206207261596575f;
    const float C = scale * 1.4426950408889634f;
    bf16x8 qr[NMAP][ND0];
    { const int qrow = qrow0 + wid * 32 + r32;
#pragma unroll
        for (int m = 0; m < NMAP; ++m)
#pragma unroll
            for (int d0 = 0; d0 < ND0; ++d0) {
                const bf16_t* p = DIFF ? C_P + (size_t)qrow * INC + DF_Q + (hd * 2 + m) * 32 + d0 * 16 + hi * 8
                                       : C_QM + (size_t)qrow * 384 + hd * 96 + d0 * 16 + hi * 8;
                qr[m][d0] = *(const bf16x8*)p; } }
    f32x16 o[NMAP][2]; float m_reg[NMAP], l_reg[NMAP];
#pragma unroll
    for (int m = 0; m < NMAP; ++m) { m_reg[m] = 0.f; l_reg[m] = 0.f;
#pragma unroll
        for (int d = 0; d < 2; ++d) zero_acc(o[m][d]); }
    constexpr int NKP = DIFF ? 2 : 4;
    int ksrc[NKP], vsrc[2];
#pragma unroll
    for (int q = 0; q < NKP; ++q) { const int off = (wid * NKP + q) * 1024 + lane * 16;
        if (DIFF) { const int blk = off >> 12, key = (off & 4095) >> 6, slot = (off & 63) >> 4, ch = slot ^ ((key >> 2) & 3);
            ksrc[q] = ((blk >> 1) * 64 + key) * INC + DF_K + (hd * 2 + (blk & 1)) * 32 + ch * 8; }
        else { const int tile = off >> 14, key = (off & 16383) >> 8, slot = (off & 255) >> 4, ch = slot ^ (key & 15);
            ksrc[q] = ch < 8 ? -1 - ((tile * 64 + key) * 512 + hd * 128 + ch * 8) : (ch < 12 ? (tile * 64 + key) * INC + MLA_KR + (ch - 8) * 8 : (int)0x80000000); } }
#pragma unroll
    for (int q = 0; q < 2; ++q) { const int off = (wid * 2 + q) * 1024 + lane * 16; const int tile = off >> 13, w = off & 8191;
        const int sub = w >> 9, within = w & 511; const int kk = (sub >> 1) * 8 + (within >> 6); const int col = (sub & 1) * 32 + ((within & 63) >> 1);
        const int key = kk;
        vsrc[q] = DIFF ? (tile * 64 + key) * INC + DF_V + hd * 64 + col : (tile * 64 + key) * 512 + hd * 128 + 64 + col; }
    const int vb0 = (int)(uintptr_t)V_lds0 + v_rd_base(lane);
    unsigned kbo[NKP], vbo[2];
#pragma unroll
    for (int q = 0; q < NKP; ++q) kbo[q] = (DIFF || ksrc[q] >= 0) ? (unsigned)ksrc[q] * 2u : (unsigned)(-1 - ksrc[q]) * 2u;
#pragma unroll
    for (int q = 0; q < 2; ++q) vbo[q] = (unsigned)vsrc[q] * 2u;
#define ADMA(kbuf, vbuf, kr) do { const char* pb_ = (const char*)C_P + (size_t)(kr) * (INC * 2); const char* kb_ = (const char*)C_KVM + (size_t)(kr) * 1024; asm volatile("" : "+s"(pb_), "+s"(kb_)); \
        _Pragma("unroll") for (int q = 0; q < NKP; ++q) { LAS unsigned* dst_ = (LAS unsigned*)(LAS char*)(K_lds0 + (kbuf) * 32768 + (wid * NKP + q) * 1024); \
            unsigned o_ = kbo[q]; asm volatile("" : "+v"(o_));     \
            if (DIFF || ksrc[q] >= 0) __builtin_amdgcn_global_load_lds((const unsigned*)(pb_ + (size_t)o_), dst_, 16, 0, 0); \
            else if (ksrc[q] != (int)0x80000000) __builtin_amdgcn_global_load_lds((const unsigned*)(kb_ + (size_t)o_), dst_, 16, 0, 0); } \
        _Pragma("unroll") for (int q = 0; q < 2; ++q) { LAS unsigned* dst_ = (LAS unsigned*)(LAS char*)(V_lds0 + (vbuf) * 16384 + (wid * 2 + q) * 1024); \
            unsigned o_ = vbo[q]; asm volatile("" : "+v"(o_)); \
            __builtin_amdgcn_global_load_lds((const unsigned*)((DIFF ? pb_ : kb_) + (size_t)o_), dst_, 16, 0, 0); } } while (0)
    f32x16 oB[2];
    if (!DIFF) { zero_acc(oB[0]); zero_acc(oB[1]); }
    float lB = 0.f;
    const int NS = nkeys >> 7;
    ADMA(0, 0, krow0);
    const bool late = wid >= 4;
    bf16x8 pa[4], pb[4];
    int vslot = 0, vbp = 0;
    for (int j = 0; j < NS; ++j) {
        asm volatile("s_waitcnt vmcnt(0)" ::: "memory");
        __syncthreads();
        const int vnext = (vslot == 2) ? 0 : vslot + 1;
        if (j + 1 < NS) ADMA((j + 1) & 1, vnext, krow0 + (j + 1) * 128);
        const char* K_lds = K_lds0 + (j & 1) * 32768; const int vb = vb0 + vslot * 16384;
#define KFR(tt, m, d0, h) (*(const bf16x8*)(K_lds + ((tt) * NMAP + (m)) * KSZ + \
            (DIFF ? (((h) * 32 + r32) * 64 + ((((d0) * 2 + hi) ^ ((((h) * 32 + r32) >> 2) & 3)) << 4)) : (((h) * 32 + r32) * 256 + (((d0) * 32 + hi * 16) ^ ((((h) * 32 + r32) & 15) << 4))))))
#define PKV(L, H) (bf16x8){L[0], L[1], L[2], L[3], H[0], H[1], H[2], H[3]}
#define PVB(D0B, VB, TA, TB) { const int va_ = (VB) + (TA) * 8192, vbb_ = (VB) + (TB) * 8192; f32x16& accA = o[0][D0B]; f32x16& accB = DIFF ? o[NMAP - 1][D0B] : oB[D0B]; \
              const s16x4 l0 = tr_read<v_rd_off(D0B, 0, 0)>(va_), h0 = tr_read<v_rd_off(D0B, 0, 1)>(va_), l1 = tr_read<v_rd_off(D0B, 1, 0)>(va_), h1 = tr_read<v_rd_off(D0B, 1, 1)>(va_); \
              const s16x4 l2 = tr_read<v_rd_off(D0B, 2, 0)>(va_), h2 = tr_read<v_rd_off(D0B, 2, 1)>(va_), l3 = tr_read<v_rd_off(D0B, 3, 0)>(va_), h3 = tr_read<v_rd_off(D0B, 3, 1)>(va_); \
              if (DIFF) { asm volatile("s_waitcnt lgkmcnt(0)" ::: "memory"); __builtin_amdgcn_sched_barrier(0); \
                  accA = __builtin_amdgcn_mfma_f32_32x32x16_bf16(pa[0], PKV(l0, h0), accA, 0, 0, 0); accB = __builtin_amdgcn_mfma_f32_32x32x16_bf16(pb[0], PKV(l0, h0), accB, 0, 0, 0); \
                  accA = __builtin_amdgcn_mfma_f32_32x32x16_bf16(pa[1], PKV(l1, h1), accA, 0, 0, 0); accB = __builtin_amdgcn_mfma_f32_32x32x16_bf16(pb[1], PKV(l1, h1), accB, 0, 0, 0); \
                  accA = __builtin_amdgcn_mfma_f32_32x32x16_bf16(pa[2], PKV(l2, h2), accA, 0, 0, 0); accB = __builtin_amdgcn_mfma_f32_32x32x16_bf16(pb[2], PKV(l2, h2), accB, 0, 0, 0); \
                  accA = __builtin_amdgcn_mfma_f32_32x32x16_bf16(pa[3], PKV(l3, h3), accA, 0, 0, 0); accB = __builtin_amdgcn_mfma_f32_32x32x16_bf16(pb[3], PKV(l3, h3), accB, 0, 0, 0); } \
              else { const s16x4 m0 = tr_read<v_rd_off(D0B, 0, 0)>(vbb_), n0 = tr_read<v_rd_off(D0B, 0, 1)>(vbb_), m1 = tr_read<v_rd_off(D0B, 1, 0)>(vbb_), n1 = tr_read<v_rd_off(D0B, 1, 1)>(vbb_); \
                  const s16x4 m2 = tr_read<v_rd_off(D0B, 2, 0)>(vbb_), n2 = tr_read<v_rd_off(D0B, 2, 1)>(vbb_), m3 = tr_read<v_rd_off(D0B, 3, 0)>(vbb_), n3 = tr_read<v_rd_off(D0B, 3, 1)>(vbb_); \
                  asm volatile("s_waitcnt lgkmcnt(0)" ::: "memory"); __builtin_amdgcn_sched_barrier(0); \
                  accA = __builtin_amdgcn_mfma_f32_32x32x16_bf16(pa[0], PKV(l0, h0), accA, 0, 0, 0); accB = __builtin_amdgcn_mfma_f32_32x32x16_bf16(pb[0], PKV(m0, n0), accB, 0, 0, 0); \
                  accA = __builtin_amdgcn_mfma_f32_32x32x16_bf16(pa[1], PKV(l1, h1), accA, 0, 0, 0); accB = __builtin_amdgcn_mfma_f32_32x32x16_bf16(pb[1], PKV(m1, n1), accB, 0, 0, 0); \
                  accA = __builtin_amdgcn_mfma_f32_32x32x16_bf16(pa[2], PKV(l2, h2), accA, 0, 0, 0); accB = __builtin_amdgcn_mfma_f32_32x32x16_bf16(pb[2], PKV(m2, n2), accB, 0, 0, 0); \
                  accA = __builtin_amdgcn_mfma_f32_32x32x16_bf16(pa[3], PKV(l3, h3), accA, 0, 0, 0); accB = __builtin_amdgcn_mfma_f32_32x32x16_bf16(pb[3], PKV(m3, n3), accB, 0, 0, 0); } }
        constexpr int NPI = DIFF ? 2 : 1, TLA = DIFF ? 1 : 0, TLB = 1;
        constexpr int NG = ND0 / 2;
#define KGRP(F, g, TA, TB) do { F[0] = KFR(TA, 0, 2 * (g), 0); F[1] = KFR(TB, NMAP - 1, 2 * (g), 0); F[2] = KFR(TA, 0, 2 * (g), 1); F[3] = KFR(TB, NMAP - 1, 2 * (g), 1); \
            F[4] = KFR(TA, 0, 2 * (g) + 1, 0); F[5] = KFR(TB, NMAP - 1, 2 * (g) + 1, 0); F[6] = KFR(TA, 0, 2 * (g) + 1, 1); F[7] = KFR(TB, NMAP - 1, 2 * (g) + 1, 1); } while (0)
#define QGRP(F, g) do { \
            if ((g) == 0) { const f32x16 z_ = {0.f,0.f,0.f,0.f,0.f,0.f,0.f,0.f,0.f,0.f,0.f,0.f,0.f,0.f,0.f,0.f};     \
                a0 = __builtin_amdgcn_mfma_f32_32x32x16_bf16(F[0], qr[0][0], z_, 0, 0, 0); b0 = __builtin_amdgcn_mfma_f32_32x32x16_bf16(F[1], qr[NMAP - 1][0], z_, 0, 0, 0); \
                a1 = __builtin_amdgcn_mfma_f32_32x32x16_bf16(F[2], qr[0][0], z_, 0, 0, 0); b1 = __builtin_amdgcn_mfma_f32_32x32x16_bf16(F[3], qr[NMAP - 1][0], z_, 0, 0, 0); } \
            else { a0 = __builtin_amdgcn_mfma_f32_32x32x16_bf16(F[0], qr[0][2 * (g)], a0, 0, 0, 0); b0 = __builtin_amdgcn_mfma_f32_32x32x16_bf16(F[1], qr[NMAP - 1][2 * (g)], b0, 0, 0, 0); \
                a1 = __builtin_amdgcn_mfma_f32_32x32x16_bf16(F[2], qr[0][2 * (g)], a1, 0, 0, 0); b1 = __builtin_amdgcn_mfma_f32_32x32x16_bf16(F[3], qr[NMAP - 1][2 * (g)], b1, 0, 0, 0); } \
            a0 = __builtin_amdgcn_mfma_f32_32x32x16_bf16(F[4], qr[0][2 * (g) + 1], a0, 0, 0, 0); b0 = __builtin_amdgcn_mfma_f32_32x32x16_bf16(F[5], qr[NMAP - 1][2 * (g) + 1], b0, 0, 0, 0); \
            a1 = __builtin_amdgcn_mfma_f32_32x32x16_bf16(F[6], qr[0][2 * (g) + 1], a1, 0, 0, 0); b1 = __builtin_amdgcn_mfma_f32_32x32x16_bf16(F[7], qr[NMAP - 1][2 * (g) + 1], b1, 0, 0, 0); } while (0)
        bf16x8 kf0[8], kf1[8];
        KGRP(kf0, 0, 0, (DIFF ? 0 : 1)); if (NG > 1) KGRP(kf1, 1, 0, (DIFF ? 0 : 1));
        __builtin_amdgcn_sched_barrier(0);
        if (late && j > 0) { PVB(0, vbp, TLA, TLB) PVB(1, vbp, TLA, TLB) }
#pragma unroll
        for (int pi = 0; pi < NPI; ++pi) {
            const int tA = DIFF ? pi : 0, tB = DIFF ? pi : 1; constexpr int mA = 0, mB = NMAP - 1;
            f32x16 a0, a1, b0, b1;
            __builtin_amdgcn_sched_barrier(0);
            QGRP(kf0, 0);
            if (NG > 1) { __builtin_amdgcn_sched_barrier(0); KGRP(kf0, 2, tA, tB); __builtin_amdgcn_sched_barrier(0); QGRP(kf1, 1); QGRP(kf0, 2); }
            float psA = 0.f, psB = 0.f;
#pragma unroll
            for (int r = 0; r < 16; ++r) { a0[r] = __builtin_amdgcn_exp2f(a0[r]); b0[r] = __builtin_amdgcn_exp2f(b0[r]); psA += a0[r]; psB += b0[r]; }
#pragma unroll
            for (int r = 0; r < 16; ++r) { a1[r] = __builtin_amdgcn_exp2f(a1[r]); b1[r] = __builtin_amdgcn_exp2f(b1[r]); psA += a1[r]; psB += b1[r]; }
            { auto rr = __builtin_amdgcn_permlane32_swap(__float_as_uint(psA), __float_as_uint(psA), false, false); psA = __uint_as_float(rr[0]) + __uint_as_float(rr[1]); }
            { auto rr = __builtin_amdgcn_permlane32_swap(__float_as_uint(psB), __float_as_uint(psB), false, false); psB = __uint_as_float(rr[0]) + __uint_as_float(rr[1]); }
            l_reg[mA] += psA; if (DIFF) l_reg[mB] += psB; else lB += psB;
#define PK4(P, BASE, OUT) do { u32x4 w = {cvtpk(P[BASE + 0], P[BASE + 1]), cvtpk(P[BASE + 2], P[BASE + 3]), cvtpk(P[BASE + 4], P[BASE + 5]), cvtpk(P[BASE + 6], P[BASE + 7])}; \
    OUT = *reinterpret_cast<bf16x8*>(&w); } while (0)
            PK4(a0, 0, pa[0]); PK4(b0, 0, pb[0]); PK4(a0, 8, pa[1]); PK4(b0, 8, pb[1]); PK4(a1, 0, pa[2]); PK4(b1, 0, pb[2]); PK4(a1, 8, pa[3]); PK4(b1, 8, pb[3]);
#undef PK4
            if (pi + 1 < NPI) { KGRP(kf0, 0, pi + 1, pi + 1); }
            if (!(late && pi == NPI - 1)) { PVB(0, vb, tA, tB) PVB(1, vb, tA, tB) }
        }
#undef KFR
#undef KGRP
#undef QGRP
        vbp = vb; vslot = vnext;
        if (j + 1 == NS && late) { PVB(0, vbp, TLA, TLB) PVB(1, vbp, TLA, TLB) }
    }
#undef PVB
#undef PKV
#undef ADMA
    if (!DIFF) {
#pragma unroll
        for (int d = 0; d < 2; ++d)
#pragma unroll
            for (int r = 0; r < 16; ++r) o[0][d][r] += oB[d][r];
        l_reg[0] += lB; }
    float rli[NMAP][16];
#pragma unroll
    for (int m = 0; m < NMAP; ++m) {
        asm volatile("s_waitcnt lgkmcnt(0)" ::: "memory");
        if (hi == 0) wsl[r32] = l_reg[m];
        asm volatile("s_waitcnt lgkmcnt(0)" ::: "memory");
#pragma unroll
        for (int r = 0; r < 16; ++r) rli[m][r] = __builtin_amdgcn_rcpf(wsl[crow(r, hi)]);
    }
    const int orow0 = qrow0 + wid * 32;
    if (!DIFF) {
#pragma unroll
        for (int r = 0; r < 16; ++r) { bf16_t* dst = C_HB + (size_t)(orow0 + crow(r, hi)) * D + 512 + hd * 64 + r32;
            dst[0] = f2bf(o[0][0][r] * rli[0][r]); dst[32] = f2bf(o[0][1][r] * rli[0][r]); }
    } else {
        const float* lp = CIN(19) + l * 128; const float* gn = CIN(20) + l * 64; asm volatile("" : "+s"(lp), "+s"(gn));
        float s1 = lp[r32] * lp[32 + r32], s2 = lp[64 + r32] * lp[96 + r32];
#pragma unroll
        for (int o = 1; o < 32; o <<= 1) { s1 += shx(s1, o, lane); s2 += shx(s2, o, lane); }
        const float lam_init = (l == 0) ? 0.2f : 0.35550906759097f;
        const float lam = __expf(s1) - __expf(s2) + lam_init;
        const float g0 = gn[r32] * (1.f - lam_init), g1 = gn[32 + r32] * (1.f - lam_init);
#pragma unroll
        for (int r = 0; r < 16; ++r) {
            const float v0 = o[0][0][r] * rli[0][r] - lam * o[NMAP - 1][0][r] * rli[NMAP - 1][r];
            const float v1 = o[0][1][r] * rli[0][r] - lam * o[NMAP - 1][1][r] * rli[NMAP - 1][r];
            float ss = v0 * v0 + v1 * v1;
            ss += shx(ss, 1, lane); ss += shx(ss, 2, lane); ss += shx(ss, 4, lane); ss += shx(ss, 8, lane); ss += shx(ss, 16, lane);
            const float rstd = rsqrtf(ss * (1.f / 64.f) + NORM_EPS);
            bf16_t* dst = C_HB + (size_t)(orow0 + crow(r, hi)) * D + 768 + hd * 64 + r32;
            dst[0] = f2bf(v0 * rstd * g0); dst[32] = f2bf(v1 * rstd * g1); }
    }
    int* flag = (int*)(lds + 65536 + 49152 + 8 * 64 * 4);
    __syncthreads();
    if (tid == 0) *flag = 0;
    __syncthreads();
    if (!(l_reg[0] <= ATT_ZBIG && l_reg[0] >= ATT_ZSMALL) || !(l_reg[NMAP - 1] <= ATT_ZBIG && l_reg[NMAP - 1] >= ATT_ZSMALL)) *flag = 1;
    __syncthreads();
    const bool redo = *flag != 0;
    __syncthreads();
    return redo;
}
template <int G, int I>
__device__ __forceinline__ void att_microop(f32x16& p0, f32x16& p1, float& ps, bf16x8 (&pa)[4]) {
    f32x16& P = (G < 2) ? p0 : p1; constexpr int B = (G & 1) * 8;
    if constexpr (I < 4) { constexpr int r = B + 2 * I;
        P[r] = __builtin_amdgcn_exp2f(P[r]); P[r + 1] = __builtin_amdgcn_exp2f(P[r + 1]); ps += P[r]; ps += P[r + 1]; }
    else { const unsigned a0 = cvtpk(P[B + 0], P[B + 1]), a1 = cvtpk(P[B + 2], P[B + 3]), b0 = cvtpk(P[B + 4], P[B + 5]), b1 = cvtpk(P[B + 6], P[B + 7]);
        auto r0 = __builtin_amdgcn_permlane32_swap(a0, b0, false, false); auto r1 = __builtin_amdgcn_permlane32_swap(a1, b1, false, false);
        u32x4 w = {r0[0], r1[0], r0[1], r1[1]}; pa[G] = *reinterpret_cast<bf16x8*>(&w); }
}
template <int GB, int S, int NSL>
__device__ __forceinline__ void att_slot_ops(f32x16& p0, f32x16& p1, float& ps, bf16x8 (&pa)[4]) {
#define MOP(m) if constexpr (((m) * NSL) / 10 == S) att_microop<GB + (m) / 5, (m) % 5>(p0, p1, ps, pa);
    MOP(0) MOP(1) MOP(2) MOP(3) MOP(4) MOP(5) MOP(6) MOP(7) MOP(8) MOP(9)
#undef MOP
}
template <bool DIFF>
__device__ bool attn_item_fast(const Ctx& c, int l, int b, int hd, int qrow0, int krow0, int nkeys, char* lds) {
    constexpr int DQK = DIFF ? 32 : 96, NMAP = DIFF ? 2 : 1, ND0 = DQK / 16, NU = 2 * NMAP, NA = 2 * ND0;
    constexpr int KP = DIFF ? 64 : 256, KSZ = 64 * KP;
    const int tid_ = mk_tid(c.wid);
    const int tid = tid_, lane = tid_ & 63, wid = c.wid, r32 = lane & 31, hi = lane >> 5;
    char* K_lds0 = lds; char* V_lds0 = lds + 2 * 16384; float* wsl = (float*)(lds + 2 * ATT_STAGE) + wid * 64;
    bf16x8 qr[NMAP][ND0];
    { const int qrow = qrow0 + wid * 32 + r32;
#pragma unroll
        for (int m = 0; m < NMAP; ++m)
#pragma unroll
            for (int d0 = 0; d0 < ND0; ++d0) {
                const bf16_t* p = DIFF ? C_P + (size_t)qrow * INC + DF_Q + (hd * 2 + m) * 32 + d0 * 16 + hi * 8
                                       : C_QM + (size_t)qrow * 384 + hd * 96 + d0 * 16 + hi * 8;
                qr[m][d0] = *(const bf16x8*)p; } }
    f32x16 o[NMAP][2]; float m_reg[NMAP], l_reg[NMAP];
#pragma unroll
    for (int m = 0; m < NMAP; ++m) { m_reg[m] = 0.f; l_reg[m] = 0.f;
#pragma unroll
        for (int d = 0; d < 2; ++d) zero_acc(o[m][d]); }
    constexpr int NKP = DIFF ? 2 : 4;
    int ksrc[NKP], vsrc[2];
#pragma unroll
    for (int q = 0; q < NKP; ++q) { const int off = (wid * NKP + q) * 1024 + lane * 16;
        if (DIFF) { const int blk = off >> 12, key = (off & 4095) >> 6, slot = (off & 63) >> 4, ch = slot ^ ((key >> 2) & 3);
            ksrc[q] = ((blk >> 1) * 64 + key) * INC + DF_K + (hd * 2 + (blk & 1)) * 32 + ch * 8; }
        else { const int tile = off >> 14, key = (off & 16383) >> 8, slot = (off & 255) >> 4, ch = slot ^ (key & 15);
            ksrc[q] = ch < 8 ? -1 - ((tile * 64 + key) * 512 + hd * 128 + ch * 8) : (ch < 12 ? (tile * 64 + key) * INC + MLA_KR + (ch - 8) * 8 : (int)0x80000000); } }
#pragma unroll
    for (int q = 0; q < 2; ++q) { const int off = (wid * 2 + q) * 1024 + lane * 16; const int tile = off >> 13, w = off & 8191;
        const int sub = w >> 9, within = w & 511; const int kk = (sub >> 1) * 8 + (within >> 6); const int col = (sub & 1) * 32 + ((within & 63) >> 1);
        const int key = (kk & ~0xC) | ((kk & 4) << 1) | ((kk & 8) >> 1);
        vsrc[q] = DIFF ? (tile * 64 + key) * INC + DF_V + hd * 64 + col : (tile * 64 + key) * 512 + hd * 128 + 64 + col; }
    const int vb0 = (int)(uintptr_t)V_lds0 + v_rd_base(lane);
#define ADMA(buf, kr) do { \
        _Pragma("unroll") for (int q = 0; q < NKP; ++q) { LAS unsigned* dst_ = (LAS unsigned*)(LAS char*)(K_lds0 + (buf) * ATT_STAGE + (wid * NKP + q) * 1024); \
            if (DIFF || ksrc[q] >= 0) __builtin_amdgcn_global_load_lds((const unsigned*)(C_P + (size_t)(kr) * INC + ksrc[q]), dst_, 16, 0, 0); \
            else if (ksrc[q] != (int)0x80000000) __builtin_amdgcn_global_load_lds((const unsigned*)(C_KVM + (size_t)(kr) * 512 + (-1 - ksrc[q])), dst_, 16, 0, 0); } \
        _Pragma("unroll") for (int q = 0; q < 2; ++q) { LAS unsigned* dst_ = (LAS unsigned*)(LAS char*)(V_lds0 + (buf) * ATT_STAGE + (wid * 2 + q) * 1024); \
            __builtin_amdgcn_global_load_lds((const unsigned*)((DIFF ? C_P + (size_t)(kr) * INC : C_KVM + (size_t)(kr) * 512) + vsrc[q]), dst_, 16, 0, 0); } } while (0)
#define SB() __builtin_amdgcn_sched_barrier(0)
    const int NS = nkeys >> 7;
    ADMA(0, krow0);
    float bad = 0.f;
    for (int j = 0; j < NS; ++j) {
        asm volatile("s_waitcnt vmcnt(0)" ::: "memory");
        __syncthreads();
        if (j + 1 < NS) ADMA((j + 1) & 1, krow0 + (j + 1) * 128);
        const char* K_lds = K_lds0 + (j & 1) * ATT_STAGE; const int vb = vb0 + (j & 1) * ATT_STAGE;
        f32x16 p0[2], p1[2]; bf16x8 pa[2][4]; float ps[2]; bf16x8 kfw[3];
#define KFRAG(u, d0, h) (*(const bf16x8*)(K_lds + (((u) / NMAP) * NMAP + ((u) % NMAP)) * KSZ + \
            (DIFF ? (((h) * 32 + r32) * 64 + ((((d0) * 2 + hi) ^ ((((h) * 32 + r32) >> 2) & 3)) << 4)) : (((h) * 32 + r32) * 256 + (((d0) * 32 + hi * 16) ^ ((((h) * 32 + r32) & 15) << 4))))))
#define QMFMA(u, s, frag) do { constexpr int d0_ = (s) >> 1, m_ = (u) % NMAP; f32x16& acc_ = ((s) & 1) ? p1[(u) & 1] : p0[(u) & 1]; \
            if (d0_ == 0) { const float nm_ = -m_reg[m_]; const f32x16 z = {nm_,nm_,nm_,nm_,nm_,nm_,nm_,nm_,nm_,nm_,nm_,nm_,nm_,nm_,nm_,nm_}; acc_ = __builtin_amdgcn_mfma_f32_32x32x16_bf16(frag, qr[m_][0], z, 0, 0, 0); } \
            else acc_ = __builtin_amdgcn_mfma_f32_32x32x16_bf16(frag, qr[m_][d0_], acc_, 0, 0, 0); } while (0)
        if (j == 0) {
#pragma unroll
            for (int m = 0; m < NMAP; ++m) {
#pragma unroll
                for (int d0 = 0; d0 < ND0; ++d0) { const bf16x8 f0 = KFRAG(m, d0, 0), f1 = KFRAG(m, d0, 1);
                    if (d0 == 0) { const f32x16 z = {0.f,0.f,0.f,0.f,0.f,0.f,0.f,0.f,0.f,0.f,0.f,0.f,0.f,0.f,0.f,0.f};
                        p0[0] = __builtin_amdgcn_mfma_f32_32x32x16_bf16(f0, qr[m][0], z, 0, 0, 0); p1[0] = __builtin_amdgcn_mfma_f32_32x32x16_bf16(f1, qr[m][0], z, 0, 0, 0); }
                    else { p0[0] = __builtin_amdgcn_mfma_f32_32x32x16_bf16(f0, qr[m][d0], p0[0], 0, 0, 0); p1[0] = __builtin_amdgcn_mfma_f32_32x32x16_bf16(f1, qr[m][d0], p1[0], 0, 0, 0); } }
                m_reg[m] = rowmax_tile(p0[0], p1[0]); }
        }
        {
#pragma unroll
            for (int sidx = 0; sidx < NA; ++sidx) { const bf16x8 f = (sidx & 1) ? KFRAG(0, sidx >> 1, 1) : KFRAG(0, sidx >> 1, 0);
                if (sidx == 0) QMFMA(0, 0, f); else if (sidx == 1) QMFMA(0, 1, f); else if (sidx == 2) QMFMA(0, 2, f); else if (sidx == 3) QMFMA(0, 3, f);
                else if (sidx == 4) QMFMA(0, 4, f); else if (sidx == 5) QMFMA(0, 5, f); else if (sidx == 6) QMFMA(0, 6, f); else if (sidx == 7) QMFMA(0, 7, f);
                else if (sidx == 8) QMFMA(0, 8, f); else if (sidx == 9) QMFMA(0, 9, f); else if (sidx == 10) QMFMA(0, 10, f); else QMFMA(0, 11, f); }
            ps[0] = 0.f;
            att_slot_ops<0, 0, 1>(p0[0], p1[0], ps[0], pa[0]);
            SB();
        }
#define STEP(u) do { constexpr int m_ = (u) % NMAP, tt_ = (u) / NMAP; constexpr bool nxt_ = ((u) + 1 < NU); \
              \
            if (nxt_) { ps[((u) + 1) & 1] = 0.f; kfw[0] = KFRAG((u) + 1, 0, 0); kfw[1] = KFRAG((u) + 1, 0, 1); \
                PHA(u, 0) PHA(u, 1) PHA(u, 2) PHA(u, 3) if (NA > 4) { PHA(u, 4) PHA(u, 5) PHA(u, 6) PHA(u, 7) PHA(u, 8) PHA(u, 9) PHA(u, 10) PHA(u, 11) } } \
            else { att_slot_ops<2, 0, 1>(p0[(u) & 1], p1[(u) & 1], ps[(u) & 1], pa[(u) & 1]); SB(); } \
            { float t_ = ps[(u) & 1]; auto rr = __builtin_amdgcn_permlane32_swap(__float_as_uint(t_), __float_as_uint(t_), false, false); t_ = __uint_as_float(rr[0]) + __uint_as_float(rr[1]); \
              l_reg[m_] += t_; bad = fmaxf(bad, t_); } \
              \
            PHB(u, 0) PHB(u, 1) } while (0)
#define PHA(u, s) { if ((s) < NA) { if ((s) + 2 < NA) kfw[((s) + 2) % 3] = (((s) + 2) & 1) ? KFRAG((u) + 1, ((s) + 2) >> 1, 1) : KFRAG((u) + 1, ((s) + 2) >> 1, 0); \
              QMFMA((u) + 1, (s), kfw[(s) % 3]); \
              att_slot_ops<2, (s), NA>(p0[(u) & 1], p1[(u) & 1], ps[(u) & 1], pa[(u) & 1]); SB(); } }
#define PHB(u, d0b) { const int vbb_ = vb + ((u) / NMAP) * 8192; \
              const s16x4 l0 = tr_read<v_rd_off(d0b, 0, 0)>(vbb_), h0 = tr_read<v_rd_off(d0b, 0, 1)>(vbb_), l1 = tr_read<v_rd_off(d0b, 1, 0)>(vbb_), h1 = tr_read<v_rd_off(d0b, 1, 1)>(vbb_); \
              const s16x4 l2 = tr_read<v_rd_off(d0b, 2, 0)>(vbb_), h2 = tr_read<v_rd_off(d0b, 2, 1)>(vbb_), l3 = tr_read<v_rd_off(d0b, 3, 0)>(vbb_), h3 = tr_read<v_rd_off(d0b, 3, 1)>(vbb_); \
              asm volatile("s_waitcnt lgkmcnt(0)" ::: "memory"); SB(); \
              f32x16& od_ = o[(u) % NMAP][d0b]; \
              od_ = __builtin_amdgcn_mfma_f32_32x32x16_bf16(pa[(u) & 1][0], PKV(l0, h0), od_, 0, 0, 0); if ((u) + 1 < NU) att_slot_ops<0, (d0b) * 4 + 0, 8>(p0[((u) + 1) & 1], p1[((u) + 1) & 1], ps[((u) + 1) & 1], pa[((u) + 1) & 1]); SB(); \
              od_ = __builtin_amdgcn_mfma_f32_32x32x16_bf16(pa[(u) & 1][1], PKV(l1, h1), od_, 0, 0, 0); if ((u) + 1 < NU) att_slot_ops<0, (d0b) * 4 + 1, 8>(p0[((u) + 1) & 1], p1[((u) + 1) & 1], ps[((u) + 1) & 1], pa[((u) + 1) & 1]); SB(); \
              od_ = __builtin_amdgcn_mfma_f32_32x32x16_bf16(pa[(u) & 1][2], PKV(l2, h2), od_, 0, 0, 0); if ((u) + 1 < NU) att_slot_ops<0, (d0b) * 4 + 2, 8>(p0[((u) + 1) & 1], p1[((u) + 1) & 1], ps[((u) + 1) & 1], pa[((u) + 1) & 1]); SB(); \
              od_ = __builtin_amdgcn_mfma_f32_32x32x16_bf16(pa[(u) & 1][3], PKV(l3, h3), od_, 0, 0, 0); if ((u) + 1 < NU) att_slot_ops<0, (d0b) * 4 + 3, 8>(p0[((u) + 1) & 1], p1[((u) + 1) & 1], ps[((u) + 1) & 1], pa[((u) + 1) & 1]); SB(); }
#define PKV(L, H) (bf16x8){L[0], L[1], L[2], L[3], H[0], H[1], H[2], H[3]}
        STEP(0); STEP(1);
        if (NU > 2) { STEP(2 % NU); STEP(3 % NU); }
#undef PKV
#undef PHB
#undef PHA
#undef STEP
#undef QMFMA
#undef KFRAG
    }
#undef SB
#undef ADMA
    float rli[NMAP][16];
#pragma unroll
    for (int m = 0; m < NMAP; ++m) {
        asm volatile("s_waitcnt lgkmcnt(0)" ::: "memory");
        if (hi == 0) wsl[r32] = l_reg[m];
        asm volatile("s_waitcnt lgkmcnt(0)" ::: "memory");
#pragma unroll
        for (int r = 0; r < 16; ++r) rli[m][r] = __builtin_amdgcn_rcpf(wsl[crow(r, hi)]);
    }
    const int orow0 = qrow0 + wid * 32;
    if (!DIFF) {
#pragma unroll
        for (int r = 0; r < 16; ++r) { bf16_t* dst = C_HB + (size_t)(orow0 + crow(r, hi)) * D + 512 + hd * 64 + r32;
            dst[0] = f2bf(o[0][0][r] * rli[0][r]); dst[32] = f2bf(o[0][1][r] * rli[0][r]); }
    } else {
        const float* lp = CIN(19) + l * 128; const float* gn = CIN(20) + l * 64; asm volatile("" : "+s"(lp), "+s"(gn));
        float s1 = lp[r32] * lp[32 + r32], s2 = lp[64 + r32] * lp[96 + r32];
#pragma unroll
        for (int o = 1; o < 32; o <<= 1) { s1 += shx(s1, o, lane); s2 += shx(s2, o, lane); }
        const float lam_init = (l == 0) ? 0.2f : 0.35550906759097f;
        const float lam = __expf(s1) - __expf(s2) + lam_init;
        const float g0 = gn[r32] * (1.f - lam_init), g1 = gn[32 + r32] * (1.f - lam_init);
#pragma unroll
        for (int r = 0; r < 16; ++r) {
            const float v0 = o[0][0][r] * rli[0][r] - lam * o[NMAP - 1][0][r] * rli[NMAP - 1][r];
            const float v1 = o[0][1][r] * rli[0][r] - lam * o[NMAP - 1][1][r] * rli[NMAP - 1][r];
            float ss = v0 * v0 + v1 * v1;
            ss += shx(ss, 1, lane); ss += shx(ss, 2, lane); ss += shx(ss, 4, lane); ss += shx(ss, 8, lane); ss += shx(ss, 16, lane);
            const float rstd = rsqrtf(ss * (1.f / 64.f) + NORM_EPS);
            bf16_t* dst = C_HB + (size_t)(orow0 + crow(r, hi)) * D + 768 + hd * 64 + r32;
            dst[0] = f2bf(v0 * rstd * g0); dst[32] = f2bf(v1 * rstd * g1); }
    }
    int* flag = (int*)(lds + 2 * ATT_STAGE + 8 * 64 * 4);
    __syncthreads();
    if (tid == 0) *flag = 0;
    __syncthreads();
    if (!(bad <= ATT_BIG)) *flag = 1;
    __syncthreads();
    const bool redo = *flag != 0;
    __syncthreads();
    return redo;
}
#ifndef PAIR_DIFF
#define PAIR_DIFF 1
#endif
#ifndef PAIR_MLA
#define PAIR_MLA 1
#endif
__device__ void ph_attn(const Ctx& c, int l, char* lds) {
    const bool need_ctx = (l < DEPTH - 1);
    const int nitem = 1024 + (need_ctx ? 32 : 0);
    for (int it = blockIdx.x; it < nitem; it += gridDim.x) {
        bool diff; int b, hd, q0, k0, nk;
        if (it < 1024) { const int u = it & 511; diff = it < 512; b = u >> 7; hd = (u >> 5) & 3; q0 = b * RPB + CTX + (u & 31) * 256; k0 = b * RPB; nk = RPB; }
        else { const int u = it - 1024; diff = u < 16; b = u & 3; hd = (u >> 2) & 3; q0 = b * RPB; k0 = b * RPB; nk = CTX; }
#if PAIR_DIFF
        if (diff) { if (attn_item_pair<true>(c, l, b, hd, q0, k0, nk, lds)) attn_item<true>(c, l, b, hd, q0, k0, nk, lds); }
#else
        if (diff) attn_item<true>(c, l, b, hd, q0, k0, nk, lds);
#endif
#if PAIR_MLA
        else { if (attn_item_pair<false>(c, l, b, hd, q0, k0, nk, lds)) attn_item<false>(c, l, b, hd, q0, k0, nk, lds); }
#else
        else { if (attn_item_fast<false>(c, l, b, hd, q0, k0, nk, lds)) attn_item<false>(c, l, b, hd, q0, k0, nk, lds); }
#endif
    }
}

typedef float f32v2 __attribute__((ext_vector_type(2)));
__device__ void cvt_tables(const Ctx& c, int l) {
    for (int row = blockIdx.x * 8 + c.wid; row < 2 * NEXP; row += gridDim.x * 8) {
        const bool isu = row < NEXP; const int e = isu ? row : row - NEXP;
        const float* s = CIN(isu ? 23 : 24) + ((size_t)l * NEXP + e) * D + c.lane * 16;
        f32x4 v[4]; float mx = 0.f;
#pragma unroll
        for (int i = 0; i < 4; ++i) { v[i] = *(const f32x4*)(s + 4 * i); mx = fmaxf(mx, fmaxf(fmaxf(fabsf(v[i][0]), fabsf(v[i][1])), fmaxf(fabsf(v[i][2]), fabsf(v[i][3])))); }
#pragma unroll
        for (int o = 32; o >= 1; o >>= 1) mx = fmaxf(mx, __shfl_xor(mx, o, 64));
        const float q = mx > 0.f ? 256.f / mx : 0.f;
        if (c.lane == 0) (isu ? C_SU : C_SV)[e] = mx * (1.f / 256.f);
        u32x4 w;
#pragma unroll
        for (int i = 0; i < 4; ++i) { int p = 0; p = __builtin_amdgcn_cvt_pk_fp8_f32(v[i][0] * q, v[i][1] * q, p, false); p = __builtin_amdgcn_cvt_pk_fp8_f32(v[i][2] * q, v[i][3] * q, p, true); w[i] = (unsigned)p; }
        *(u32x4*)((isu ? C_TU8 : C_TV8) + ((size_t)(c.lane >> 3) * NEXP + e) * 128 + (c.lane & 7) * 16) = w;
    }
}
__device__ __forceinline__ unsigned ford(float x) { const unsigned u = __float_as_uint(x); return (u & 0x80000000u) ? ~u : (u | 0x80000000u); }
__device__ __forceinline__ float funord(unsigned k) { const unsigned u = (k & 0x80000000u) ? (k & 0x7fffffffu) : ~k; return __uint_as_float(u); }
__device__ __forceinline__ void sort16_desc(unsigned (&v)[16]) {
#pragma unroll
    for (int k = 2; k <= 16; k <<= 1)
#pragma unroll
        for (int j = k >> 1; j > 0; j >>= 1)
#pragma unroll
            for (int i = 0; i < 16; ++i) { const int l = i ^ j; if (l > i) { const unsigned a = v[i], b = v[l]; const unsigned hi = max(a, b), lo = min(a, b);
                if ((i & k) == 0) { v[i] = hi; v[l] = lo; } else { v[i] = lo; v[l] = hi; } } }
}
__device__ __forceinline__ void merge16_desc(unsigned (&t)[16], const unsigned (&v)[16]) {
#pragma unroll
    for (int i = 0; i < 16; ++i) t[i] = max(t[i], v[15 - i]);
#pragma unroll
    for (int j = 8; j > 0; j >>= 1)
#pragma unroll
        for (int i = 0; i < 16; ++i) { const int l = i ^ j; if (l > i) { const unsigned a = t[i], b = t[l]; t[i] = max(a, b); t[l] = min(a, b); } }
}
constexpr int TOPK_LDS = 2 * 128 * 129 * 4;
__device__ void peer_topk_item(const Ctx& c, int l, int tm, int h, char* lds) {
    float* S = (float*)lds;
    const int tid = c.tid, lane = c.lane, wid = c.wid, r32 = lane & 31, hi = lane >> 5, wm = wid >> 1, wn = wid & 1;
    const int row0 = tm * 128;
    bf16x8 fa[2][8];
#pragma unroll
    for (int p = 0; p < 2; ++p) { const bf16_t* Ap = C_Q2 + (size_t)(row0 + wm * 32 + r32) * 2048 + h * 256 + p * 128 + hi * 8;
#pragma unroll
        for (int ks = 0; ks < 8; ++ks) fa[p][ks] = *(const bf16x8*)(Ap + ks * 16); }
#pragma unroll
    for (int p = 0; p < 2; ++p) {
        f32x16 acc[2];
        zero_acc(acc[0]); zero_acc(acc[1]);
        const bf16_t* Bp = C_KEYS + ((((size_t)l * 8 + h) * 2 + p) * 128 + wn * 64 + r32) * 128 + hi * 8;
        bf16x8 fb0[8], fb1[8];
#pragma unroll
        for (int ks = 0; ks < 8; ++ks) { fb0[ks] = *(const bf16x8*)(Bp + ks * 16); fb1[ks] = *(const bf16x8*)(Bp + 32 * 128 + ks * 16); }
        asm volatile("" : "+v"(fa[p][0]), "+v"(fa[p][1]), "+v"(fa[p][2]), "+v"(fa[p][3]), "+v"(fa[p][4]), "+v"(fa[p][5]), "+v"(fa[p][6]), "+v"(fa[p][7]));
        asm volatile("" : "+v"(fb0[0]), "+v"(fb0[1]), "+v"(fb0[2]), "+v"(fb0[3]), "+v"(fb0[4]), "+v"(fb0[5]), "+v"(fb0[6]), "+v"(fb0[7]));
        asm volatile("" : "+v"(fb1[0]), "+v"(fb1[1]), "+v"(fb1[2]), "+v"(fb1[3]), "+v"(fb1[4]), "+v"(fb1[5]), "+v"(fb1[6]), "+v"(fb1[7]));
#pragma unroll
        for (int ks = 0; ks < 8; ++ks) {
            acc[0] = __builtin_amdgcn_mfma_f32_32x32x16_bf16(fa[p][ks], fb0[ks], acc[0], 0, 0, 0);
            acc[1] = __builtin_amdgcn_mfma_f32_32x32x16_bf16(fa[p][ks], fb1[ks], acc[1], 0, 0, 0);
        }
#pragma unroll
        for (int n = 0; n < 2; ++n)
#pragma unroll
            for (int r = 0; r < 16; ++r) S[(p * 128 + wm * 32 + crow(r, hi)) * 129 + wn * 64 + n * 32 + r32] = acc[n][r];
    }
    __syncthreads();
    unsigned tk[16];
    { const int list = tid >> 1, half = tid & 1; const float* sr = S + list * 129 + half * 64;
#pragma unroll
        for (int g = 0; g < 4; ++g) { unsigned v[16];
#pragma unroll
            for (int i = 0; i < 16; ++i) { const int n = half * 64 + g * 16 + i; v[i] = (ford(sr[g * 16 + i]) & ~127u) | (unsigned)(127 - n); }
            sort16_desc(v);
            if (g == 0) {
#pragma unroll
                for (int i = 0; i < 16; ++i) tk[i] = v[i]; }
            else merge16_desc(tk, v); } }
    __syncthreads();
    unsigned* X = (unsigned*)lds;
    unsigned* L = X + 256 * 17;
    if (tid & 1) {
#pragma unroll
        for (int i = 0; i < 16; ++i) X[(tid >> 1) * 17 + i] = tk[i]; }
    __syncthreads();
    if (!(tid & 1)) { unsigned v[16];
#pragma unroll
        for (int i = 0; i < 16; ++i) v[i] = X[(tid >> 1) * 17 + i];
        merge16_desc(tk, v);
#pragma unroll
        for (int i = 0; i < 16; ++i) L[(tid >> 1) * 17 + i] = tk[i]; }
    __syncthreads();
    unsigned bk[16];
    const int row = (tid >> 1) & 127, hh = tid & 1;
    const unsigned* l0 = L + row * 17; const unsigned* l1 = L + (128 + row) * 17;
    if (tid < 256) {
        float s0[8], s1[16];
#pragma unroll
        for (int ii = 0; ii < 8; ++ii) s0[ii] = funord(l0[2 * ii + hh] & ~127u);
#pragma unroll
        for (int j = 0; j < 16; ++j) s1[j] = funord(l1[j] & ~127u);
        unsigned ck[32];
        { int slot = 0;
#pragma unroll
            for (int ii = 0; ii < 8; ++ii)
#pragma unroll
                for (int j = 0; j < 16; ++j) if ((2 * ii + 1) * (j + 1) <= 16) {
                    const int i = 2 * ii + hh; const bool ok = (i + 1) * (j + 1) <= 16;
                    const unsigned key = (ford(s0[ii] + s1[j]) & ~255u) | (unsigned)(255 - (i * 16 + j));
                    ck[slot] = ok ? key : 0u; ++slot; }
#pragma unroll
            for (; slot < 32; ++slot) ck[slot] = 0u; }
        unsigned v0[16], v1[16];
#pragma unroll
        for (int i = 0; i < 16; ++i) { v0[i] = ck[i]; v1[i] = ck[16 + i]; }
        sort16_desc(v0); sort16_desc(v1);
        merge16_desc(v0, v1);
#pragma unroll
        for (int i = 0; i < 16; ++i) bk[i] = v0[i];
    }
    __syncthreads();
    if (tid < 256 && hh) {
#pragma unroll
        for (int i = 0; i < 16; ++i) X[row * 17 + i] = bk[i]; }
    __syncthreads();
    if (tid < 256 && !hh) { unsigned v[16];
#pragma unroll
        for (int i = 0; i < 16; ++i) v[i] = X[row * 17 + i];
        merge16_desc(bk, v);
        float best[16]; int eid[16]; float mx = -1e30f;
#pragma unroll
        for (int q = 0; q < 16; ++q) { const int ij = 255 - (int)(bk[q] & 255u); const int i = ij >> 4, j = ij & 15;
            const unsigned k0 = l0[i], k1 = l1[j];
            best[q] = funord(k0 & ~127u) + funord(k1 & ~127u);
            eid[q] = (127 - (int)(k0 & 127u)) * 128 + (127 - (int)(k1 & 127u));
            mx = fmaxf(mx, best[q]); }
        float sum = 0.f;
#pragma unroll
        for (int q = 0; q < 16; ++q) { best[q] = __expf(best[q] - mx); sum += best[q]; }
        const float inv = 1.f / sum;
        const size_t o = (size_t)(row0 + row) * 128 + h * 16;
#pragma unroll
        for (int q = 0; q < 16; q += 4) { *(u32x4*)(C_EI + o + q) = (u32x4){(unsigned)eid[q], (unsigned)eid[q + 1], (unsigned)eid[q + 2], (unsigned)eid[q + 3]};
            *(f32x4*)(C_EG + o + q) = (f32x4){best[q] * inv, best[q + 1] * inv, best[q + 2] * inv, best[q + 3] * inv}; }
    }
    __syncthreads();
}
__device__ __forceinline__ float gelu_tanh(float x) { const float u = 0.7978845608028654f * (x + 0.044715f * x * x * x); const float t = 1.f - 2.f / (1.f + __expf(2.f * u)); return 0.5f * x * (1.f + t); }
__device__ __forceinline__ int tok_row(int ti, bool need_ctx) { return need_ctx ? ti : (ti >> 13) * RPB + CTX + (ti & 8191); }
struct PeerTok { u32x4 t[16]; u32x4 xa, xb; f32v2 xv, gv; };
__device__ __forceinline__ void peer_issue(PeerTok& T, const unsigned char* t8, const int* el, const bf16_t* xp, int grp, bool want_x) {
#pragma unroll
    for (int u = 0; u < 16; ++u) { const int e = el[u * 8 + grp]; T.t[u] = *(const u32x4*)(t8 + (size_t)e * 128); }
    if (want_x) { T.xa = *(const u32x4*)xp; T.xb = *(const u32x4*)(xp + 8); }
}
__device__ __forceinline__ void peer_u_compute(const PeerTok& T, float* pp, int sub, int grp, int lane) {
    f32v2 x2[8];
#pragma unroll
    for (int q = 0; q < 4; ++q) { x2[q] = (f32v2){bflo(T.xa[q]), bfhi(T.xa[q])}; x2[4 + q] = (f32v2){bflo(T.xb[q]), bfhi(T.xb[q])}; }
    float keep[2];
#pragma unroll
    for (int hf = 0; hf < 2; ++hf) {
        float a[8];
#pragma unroll
        for (int u = 0; u < 8; ++u) { f32v2 s2 = {0.f, 0.f};
#pragma unroll
            for (int q = 0; q < 4; ++q) { const unsigned w = T.t[hf * 8 + u][q];
                s2 = __builtin_elementwise_fma(__builtin_amdgcn_cvt_pk_f32_fp8(w, false), x2[2 * q], s2);
                s2 = __builtin_elementwise_fma(__builtin_amdgcn_cvt_pk_f32_fp8(w, true), x2[2 * q + 1], s2); }
            a[u] = s2[0] + s2[1]; }
        const bool b2 = (lane & 4) != 0, b1 = (lane & 2) != 0, b0 = (lane & 1) != 0;
        float r4[4], r2[2];
#pragma unroll
        for (int q = 0; q < 4; ++q) { const float mine = b2 ? a[4 + q] : a[q], oth = b2 ? a[q] : a[4 + q]; r4[q] = mine + __shfl_xor(oth, 4, 64); }
#pragma unroll
        for (int q = 0; q < 2; ++q) { const float mine = b1 ? r4[2 + q] : r4[q], oth = b1 ? r4[q] : r4[2 + q]; r2[q] = mine + __shfl_xor(oth, 2, 64); }
        { const float mine = b0 ? r2[1] : r2[0], oth = b0 ? r2[0] : r2[1]; keep[hf] = mine + __shfl_xor(oth, 1, 64); }
    }
    pp[sub * 8 + grp] = keep[0]; pp[(8 + sub) * 8 + grp] = keep[1];
}
__device__ void peer_u_item(const Ctx& c, int l, int j, int tb, char* lds) {
    const bool need_ctx = (l < DEPTH - 1);
    int* el = (int*)lds + c.wid * 256;
    const int lane = c.lane, sub = lane & 7, grp = lane >> 3;
    const unsigned char* t8 = C_TU8 + (size_t)j * NEXP * 128 + sub * 16;
    const int tok0 = tb * 128 + c.wid * 16;
    const int xoff = j * 128 + sub * 16;
    PeerTok A, B;
    int e0, e1;
    { const int r = tok_row(tok0, need_ctx); e0 = C_EI[(size_t)r * 128 + lane]; e1 = C_EI[(size_t)r * 128 + 64 + lane];
      el[lane] = e0; el[64 + lane] = e1;
      peer_issue(A, t8, el, C_HB + (size_t)r * D + xoff, grp, true);
      const int r1 = tok_row(tok0 + 1, need_ctx); e0 = C_EI[(size_t)r1 * 128 + lane]; e1 = C_EI[(size_t)r1 * 128 + 64 + lane]; }
#pragma unroll 1
    for (int k = 0; k < 16; k += 2) {
        { const int r1 = tok_row(tok0 + k + 1, need_ctx); el[128 + lane] = e0; el[192 + lane] = e1;
          peer_issue(B, t8, el + 128, C_HB + (size_t)r1 * D + xoff, grp, true);
          if (k + 2 < 16) { const int r2 = tok_row(tok0 + k + 2, need_ctx); e0 = C_EI[(size_t)r2 * 128 + lane]; e1 = C_EI[(size_t)r2 * 128 + 64 + lane]; } }
        peer_u_compute(A, C_PART + ((size_t)j * NR + tok_row(tok0 + k, need_ctx)) * 128, sub, grp, lane);
        if (k + 2 < 16) { const int r2 = tok_row(tok0 + k + 2, need_ctx); el[lane] = e0; el[64 + lane] = e1;
          peer_issue(A, t8, el, C_HB + (size_t)r2 * D + xoff, grp, true);
          if (k + 3 < 16) { const int r3 = tok_row(tok0 + k + 3, need_ctx); e0 = C_EI[(size_t)r3 * 128 + lane]; e1 = C_EI[(size_t)r3 * 128 + 64 + lane]; } }
        peer_u_compute(B, C_PART + ((size_t)j * NR + tok_row(tok0 + k + 1, need_ctx)) * 128, sub, grp, lane);
    }
}
__device__ void ph_peer_combine(const Ctx& c, int l) {
    const bool need_ctx = (l < DEPTH - 1);
    const int ntok = need_ctx ? NR : NB * SEQ;
    for (int ti = blockIdx.x * 8 + c.wid; ti < ntok; ti += gridDim.x * 8) {
        const int r = tok_row(ti, need_ctx);
#pragma unroll
        for (int hf = 0; hf < 2; ++hf) { const size_t o = (size_t)r * 128 + hf * 64 + c.lane;
            const int e = C_EI[o]; float sacc = 0.f;
#pragma unroll
            for (int jj = 0; jj < 8; ++jj) sacc += C_PART[((size_t)jj * NR + r) * 128 + hf * 64 + c.lane];
            C_EG[o] = C_EG[o] * gelu_tanh(sacc * C_SU[e]) * C_SV[e]; }
    }
}
__device__ __forceinline__ void peer_v_compute(const PeerTok& T, const float* wl, float* xo, int grp, int lane) {
    f32v2 acc[8];
#pragma unroll
    for (int q = 0; q < 8; ++q) acc[q] = (f32v2){0.f, 0.f};
#pragma unroll
    for (int u = 0; u < 16; ++u) { const float wv = wl[u * 8 + grp]; const f32v2 w2 = {wv, wv};
#pragma unroll
        for (int q = 0; q < 4; ++q) { const unsigned w = T.t[u][q];
            acc[2 * q] = __builtin_elementwise_fma(__builtin_amdgcn_cvt_pk_f32_fp8(w, false), w2, acc[2 * q]);
            acc[2 * q + 1] = __builtin_elementwise_fma(__builtin_amdgcn_cvt_pk_f32_fp8(w, true), w2, acc[2 * q + 1]); } }
    const bool b5 = (lane & 32) != 0, b4 = (lane & 16) != 0, b3 = (lane & 8) != 0;
    f32v2 r4[4], r2[2], r1;
#pragma unroll
    for (int q = 0; q < 4; ++q) { const f32v2 mine = b5 ? acc[4 + q] : acc[q], oth = b5 ? acc[q] : acc[4 + q];
        r4[q] = (f32v2){mine[0] + __shfl_xor(oth[0], 32, 64), mine[1] + __shfl_xor(oth[1], 32, 64)}; }
#pragma unroll
    for (int q = 0; q < 2; ++q) { const f32v2 mine = b4 ? r4[2 + q] : r4[q], oth = b4 ? r4[q] : r4[2 + q];
        r2[q] = (f32v2){mine[0] + __shfl_xor(oth[0], 16, 64), mine[1] + __shfl_xor(oth[1], 16, 64)}; }
    { const f32v2 mine = b3 ? r2[1] : r2[0], oth = b3 ? r2[0] : r2[1]; r1 = (f32v2){mine[0] + __shfl_xor(oth[0], 8, 64), mine[1] + __shfl_xor(oth[1], 8, 64)}; }
    f32v2 xv = T.xv; const f32v2 gv = T.gv;
    xv[0] += gv[0] * r1[0]; xv[1] += gv[1] * r1[1];
    *(f32v2*)xo = xv;
}
__device__ void peer_v_item(const Ctx& c, int l, int j, int tb, char* lds) {
    const bool need_ctx = (l < DEPTH - 1);
    int* el = (int*)lds + c.wid * 512; float* wl = (float*)(el + 256);
    const int lane = c.lane, sub = lane & 7, grp = lane >> 3;
    const unsigned char* t8 = C_TV8 + (size_t)j * NEXP * 128 + sub * 16;
    const int tok0 = tb * 128 + c.wid * 16;
    const int col = j * 128 + sub * 16 + ((lane & 32) ? 8 : 0) + ((lane & 16) ? 4 : 0) + ((lane & 8) ? 2 : 0);
    const float* gate5 = C_MODT + (size_t)l * 5 * 6144 + 5 * D + col;
    PeerTok A, B;
    int e0, e1; float w0, w1;
#define VISSUE(T, tok, eoff) do { const int r_ = tok_row((tok), need_ctx); const int b_ = r_ / RPB; const bool ctx_ = (r_ - b_ * RPB) < CTX; \
        peer_issue(T, t8, el + (eoff), nullptr, grp, false); T.xv = *(const f32v2*)(xrow(c, r_) + col); T.gv = *(const f32v2*)(gate5 + (size_t)(ctx_ ? 4 : b_) * 6144); } while (0)
#define VFETCH(tok) do { const int r_ = tok_row((tok), need_ctx); e0 = C_EI[(size_t)r_ * 128 + lane]; e1 = C_EI[(size_t)r_ * 128 + 64 + lane]; w0 = C_EG[(size_t)r_ * 128 + lane]; w1 = C_EG[(size_t)r_ * 128 + 64 + lane]; } while (0)
    VFETCH(tok0);
    el[lane] = e0; el[64 + lane] = e1; wl[lane] = w0; wl[64 + lane] = w1;
    VISSUE(A, tok0, 0);
    VFETCH(tok0 + 1);
#pragma unroll 1
    for (int k = 0; k < 16; k += 2) {
        el[128 + lane] = e0; el[192 + lane] = e1; wl[128 + lane] = w0; wl[192 + lane] = w1;
        VISSUE(B, tok0 + k + 1, 128);
        if (k + 2 < 16) VFETCH(tok0 + k + 2);
        peer_v_compute(A, wl, xrow(c, tok_row(tok0 + k, need_ctx)) + col, grp, lane);
        if (k + 2 < 16) { el[lane] = e0; el[64 + lane] = e1; wl[lane] = w0; wl[64 + lane] = w1;
          VISSUE(A, tok0 + k + 2, 0);
          if (k + 3 < 16) VFETCH(tok0 + k + 3); }
        peer_v_compute(B, wl + 128, xrow(c, tok_row(tok0 + k + 1, need_ctx)) + col, grp, lane);
    }
#undef VISSUE
#undef VFETCH
}
template <int SUB>
__device__ void ph_peer_expert(const Ctx& c, int l, char* lds) {
    const bool need_ctx = (l < DEPTH - 1);
    unsigned* cnt = (unsigned*)CWS(WS_CTL) + 4096 + ((l * 2 + SUB) * 8) * 64;
    const int nitem = (need_ctx ? NR : NB * SEQ) / 128;
    const int x = (int)(xb_xcc_id() & 7u);
    volatile int* sh = (volatile int*)(lds + 16384);
    for (int jo = 0; jo < 8; ++jo) { const int j = (x + jo) & 7;
        int nxt = 0;
        if (c.tid == 0) nxt = (int)__hip_atomic_fetch_add(&cnt[j * 64], 1u, __ATOMIC_RELAXED, __HIP_MEMORY_SCOPE_AGENT);
        for (;;) {
            if (c.tid == 0) *sh = nxt;
            __syncthreads(); const int it = *sh; __syncthreads();
            if (it >= nitem) break;
            if (c.tid == 0) nxt = (int)__hip_atomic_fetch_add(&cnt[j * 64], 1u, __ATOMIC_RELAXED, __HIP_MEMORY_SCOPE_AGENT);
            if (SUB == 0) peer_u_item(c, l, j, it, lds); else peer_v_item(c, l, j, it, lds);
        }
    }
}
__device__ void ph_final(const Ctx& c) {
    const float* g = CIN(25);
    const int stride = gridDim.x * 8;
    int r = blockIdx.x * 8 + c.wid;
    f32x4 xn[4];
    if (r < NB * SEQ) { const float* src = COUT + ((size_t)r << 10);
#pragma unroll
        for (int i = 0; i < 4; ++i) xn[i] = *(const f32x4*)(src + i * 256 + c.lane * 4); }
    for (; r < NB * SEQ; r += stride) {
        float* xr = COUT + ((size_t)r << 10);
        f32x4 x[4]; float ss = 0.f;
#pragma unroll
        for (int i = 0; i < 4; ++i) { x[i] = xn[i]; ss += x[i][0] * x[i][0] + x[i][1] * x[i][1] + x[i][2] * x[i][2] + x[i][3] * x[i][3]; }
        if (r + stride < NB * SEQ) { const float* src = COUT + ((size_t)(r + stride) << 10);
#pragma unroll
            for (int i = 0; i < 4; ++i) xn[i] = *(const f32x4*)(src + i * 256 + c.lane * 4); }
        ss = wave_sum(ss); const float rstd = rsqrtf(ss * (1.f / D) + NORM_EPS);
#pragma unroll
        for (int i = 0; i < 4; ++i) { const int col = i * 256 + c.lane * 4; const f32x4 gv = *(const f32x4*)(g + col); f32x4 y;
#pragma unroll
            for (int e = 0; e < 4; ++e) y[e] = x[i][e] * rstd * gv[e];
            *(f32x4*)(xr + col) = y; }
    }
}

namespace pg8 {
#define PG8_LAS __attribute__((address_space(3)))
typedef unsigned short bf16_t;
typedef short bf16x8 __attribute__((ext_vector_type(8)));
typedef float f32x4 __attribute__((ext_vector_type(4)));
typedef unsigned u32x4 __attribute__((ext_vector_type(4)));
constexpr int BM = 256, BK = 64, HALF = 128, HTB = HALF * BK * 2  , STAGE_BYTES = 8 * HTB, NXCD = 8, WGM = 8;

__host__ __device__ __forceinline__ int lds_byte(int r, int c) { const int st = (r >> 4) * 2 + (c >> 5), rr = r & 15, cc = c & 31, ob = rr * 64 + cc * 2; return st * 1024 + (ob ^ (((ob >> 9) & 1) << 5)); }
__host__ __device__ __forceinline__ void stage_rc(int b, int& R, int& C) { const int st = b / 1024, sb = b % 1024, swz = sb ^ (((sb >> 9) & 1) << 5); R = (st >> 1) * 16 + swz / 64; C = (st & 1) * 32 + (swz % 64) / 2; }
__host__ __device__ __forceinline__ int perm32(int rho) { const int n = rho >> 4, i = rho & 15; return 8 * (i >> 2) + 4 * n + (i & 3); }

struct Unit { int pm, pn; };
struct Gemm { const bf16_t* A; const bf16_t* Bt; int M, N, K; };
struct TileOrder {
    int nM, nN, nwg, G, c; bool skip_ctx;
    __device__ void init(int nM_, int nN_, int G_, int c_, bool skip) { nM = nM_; nN = nN_; nwg = nM_ * nN_; G = G_; c = c_; skip_ctx = skip; }
    __device__ bool next(int i, Unit& u) const {
        const long L = (long)i * G + c; if (L >= nwg) return false;
        int wgid = (int)L; { const int q = nwg / NXCD, r = nwg % NXCD, xcd = wgid % NXCD, off = wgid / NXCD; wgid = (xcd < r ? xcd * (q + 1) : r * (q + 1) + (xcd - r) * q) + off; }
        const int nig = WGM * nN, gid = wgid / nig, fm = gid * WGM, gsz = (nM - fm) < WGM ? (nM - fm) : WGM;
        int pm = fm + ((wgid % nig) % gsz); u.pn = (wgid % nig) / gsz;
        if (skip_ctx) pm = 33 * (pm >> 5) + 1 + (pm & 31);
        u.pm = pm; return true;
    }
    __device__ __forceinline__ void a_ready(const Unit&) const {}
    __device__ __forceinline__ void done(const Unit&) const {}
};
template <class Epi, class Sched, bool STAMP = false>
__device__ __forceinline__ void gemm_phase(PG8_LAS unsigned char* lds, const Gemm g, const Sched& S, const Epi& E, unsigned long long* stamps, int w0) {
    const int tid = mk_tid(w0), wid = w0, lane = tid & 63, wr = wid >> 2, wc = wid & 3, fr = lane & 15, fq = lane >> 4;
    const int K = g.K, nt = K / BK;
    int ts_lo = 0, ts_hi = 0, nts = 0; const unsigned long long rt_entry = STAMP ? (unsigned long long)wall_clock64() : 0ull;
#define PG8_STAMP() do { if (STAMP && wid == 0 && nts < 64) { const unsigned long long _c = (unsigned long long)clock64(); \
        ts_lo = (lane == nts) ? (int)(unsigned)_c : ts_lo; ts_hi = (lane == nts) ? (int)(unsigned)(_c >> 32) : ts_hi; ++nts; } } while (0)
    PG8_STAMP();
    unsigned voffA[2], voffB[2];
#pragma unroll
    for (int i = 0; i < 2; ++i) { int R, C; stage_rc(tid * 16 + i * 8192, R, C); const int Rb = Epi::PERM ? ((R & ~31) + perm32(R & 31)) : R;
        voffA[i] = (unsigned)(R * K + C) * 2u; voffB[i] = (unsigned)(Rb * K + C) * 2u; }
    const size_t kstep = (size_t)(BK * 2);
    const size_t hstep = (size_t)HALF * K * 2;
    const size_t tstep = 2 * hstep;
    const unsigned ldsw = (unsigned)wid * 1024u;
    const int aoff = lds_byte(wr * 64 + fr, fq * 8), boff = lds_byte(wc * 32 + fr, fq * 8);
#define PG8_SA(b, h) (((b) * 2 + (h)) * HTB)
#define PG8_SB(b, h) ((4 + (b) * 2 + (h)) * HTB)
#define PG8_STAGE(bufoff, gbase, voff) do { _Pragma("unroll") for (int _i = 0; _i < 2; ++_i) \
        __builtin_amdgcn_global_load_lds((const unsigned*)((const char*)(gbase) + (voff)[_i]), (PG8_LAS unsigned*)(lds + (bufoff) + ldsw + _i * 8192), 16, 0, 0); } while (0)
#define PG8_LDA(dst, b, h) do { _Pragma("unroll") for (int m = 0; m < 4; ++m) _Pragma("unroll") for (int k = 0; k < 2; ++k) dst[m][k] = *(const PG8_LAS bf16x8*)(lds + PG8_SA(b, h) + aoff + m * 2048 + k * 1024); } while (0)
#define PG8_LDB(dst, b, h) do { _Pragma("unroll") for (int n = 0; n < 2; ++n) _Pragma("unroll") for (int k = 0; k < 2; ++k) dst[n][k] = *(const PG8_LAS bf16x8*)(lds + PG8_SB(b, h) + boff + n * 2048 + k * 1024); } while (0)
#define PG8_MMA(ai, bj, At, Bt) do { __builtin_amdgcn_s_setprio(1); _Pragma("unroll") for (int m = 0; m < 4; ++m) _Pragma("unroll") for (int n = 0; n < 2; ++n) _Pragma("unroll") for (int k = 0; k < 2; ++k) \
        acc[ai][bj][m][n] = __builtin_amdgcn_mfma_f32_16x16x32_bf16(Bt[n][k], At[m][k], acc[ai][bj][m][n], 0, 0, 0); __builtin_amdgcn_s_setprio(0); } while (0)
#define PG8_WAIT_V(n) asm volatile("s_waitcnt vmcnt(" #n ")" ::: "memory")
#define PG8_WAIT_L(n) asm volatile("s_waitcnt lgkmcnt(" #n ")" ::: "memory")
#define PG8_BAR __builtin_amdgcn_s_barrier()
#define PG8_SCHED __builtin_amdgcn_sched_barrier(0)
    Unit cur, nxt; int ui = 0;
    if (!S.next(0, cur)) return;
    f32x4 acc[2][2][4][2];
#pragma unroll
    for (int a = 0; a < 2; ++a)
#pragma unroll
        for (int b = 0; b < 2; ++b)
#pragma unroll
            for (int m = 0; m < 4; ++m)
#pragma unroll
                for (int n = 0; n < 2; ++n) acc[a][b][m][n] = (f32x4){0.f, 0.f, 0.f, 0.f};
    bf16x8 At[4][2], B0[2][2], B1[2][2];
    const char* cA = (const char*)g.A + (size_t)cur.pm * tstep; const char* cB = (const char*)g.Bt + (size_t)cur.pn * tstep;
    S.a_ready(cur);
    PG8_STAGE(PG8_SB(0, 0), cB, voffB); PG8_STAGE(PG8_SA(0, 0), cA, voffA); PG8_STAGE(PG8_SB(0, 1), cB + hstep, voffB); PG8_STAGE(PG8_SA(0, 1), cA + hstep, voffA);
    if (wr == 1) PG8_BAR;
    PG8_WAIT_V(4); PG8_BAR;
    PG8_STAGE(PG8_SB(1, 0), cB + kstep, voffB); PG8_STAGE(PG8_SA(1, 0), cA + kstep, voffA); PG8_STAGE(PG8_SB(1, 1), cB + hstep + kstep, voffB);
    PG8_WAIT_V(6); PG8_BAR;
    PG8_STAMP();
    for (;;) {
        const bool has_next = S.next(ui + 1, nxt);
        const char* nA = has_next ? (const char*)g.A + (size_t)nxt.pm * tstep : cA; const char* nB = has_next ? (const char*)g.Bt + (size_t)nxt.pn * tstep : cB;
        for (int t = 0; t < nt; t += 2) {
            const bool last = (t == nt - 2);
            const char* a1 = cA + (size_t)(t + 1) * kstep;
            const char* a2 = last ? nA : cA + (size_t)(t + 2) * kstep; const char* b2 = last ? nB : cB + (size_t)(t + 2) * kstep;
            const char* a3 = a2 + kstep; const char* b3 = b2 + kstep;
            if (last && has_next) S.a_ready(nxt);
            PG8_LDB(B0, 0, 0); PG8_SCHED; PG8_LDA(At, 0, 0); PG8_STAGE(PG8_SA(1, 1), a1 + hstep, voffA);
            PG8_WAIT_L(8); PG8_BAR; PG8_WAIT_L(0); PG8_MMA(0, 0, At, B0); PG8_BAR; PG8_SCHED;
            PG8_LDB(B1, 0, 1); PG8_STAGE(PG8_SB(0, 0), b2, voffB);
            PG8_BAR; PG8_WAIT_L(0); PG8_MMA(0, 1, At, B1); PG8_BAR;
            PG8_LDA(At, 0, 1); PG8_STAGE(PG8_SA(0, 0), a2, voffA);
            PG8_BAR; PG8_WAIT_L(0); PG8_MMA(1, 0, At, B0); PG8_BAR; PG8_SCHED;
            PG8_STAGE(PG8_SB(0, 1), b2 + hstep, voffB);
            PG8_WAIT_V(6); PG8_BAR; PG8_MMA(1, 1, At, B1); PG8_BAR;
            PG8_LDB(B0, 1, 0); PG8_SCHED; PG8_LDA(At, 1, 0); PG8_STAGE(PG8_SA(0, 1), a2 + hstep, voffA);
            PG8_WAIT_L(8); PG8_BAR; PG8_WAIT_L(0); PG8_MMA(0, 0, At, B0); PG8_BAR; PG8_SCHED;
            PG8_LDB(B1, 1, 1); PG8_STAGE(PG8_SB(1, 0), b3, voffB);
            PG8_BAR; PG8_WAIT_L(0); PG8_MMA(0, 1, At, B1); PG8_BAR;
            PG8_LDA(At, 1, 1); PG8_STAGE(PG8_SA(1, 0), a3, voffA);
            PG8_BAR; PG8_WAIT_L(0); PG8_MMA(1, 0, At, B0); PG8_BAR; PG8_SCHED;
            PG8_STAGE(PG8_SB(1, 1), b3 + hstep, voffB);
            PG8_WAIT_V(6); PG8_BAR; PG8_MMA(1, 1, At, B1); PG8_BAR;
        }
        PG8_STAMP();
        if constexpr (!Epi::AFTER_DRAIN) { E(acc, cur, wr, wc, fr, fq); S.done(cur); }
        PG8_STAMP();
        if (!has_next) break;
#pragma unroll
        for (int a = 0; a < 2; ++a)
#pragma unroll
            for (int b = 0; b < 2; ++b)
#pragma unroll
                for (int m = 0; m < 4; ++m)
#pragma unroll
                    for (int n = 0; n < 2; ++n) acc[a][b][m][n] = (f32x4){0.f, 0.f, 0.f, 0.f};
        cur = nxt; cA = nA; cB = nB; ++ui;
    }
    PG8_WAIT_V(0);
    if (wr == 0) PG8_BAR;
    PG8_BAR;
    if constexpr (Epi::AFTER_DRAIN) { E.fused(acc, cur, wr, wc, fr, fq, lds, wid, lane); S.done(cur); }
    PG8_STAMP();
    if (STAMP && wid == 0) { stamps[lane] = lane < nts ? (((unsigned long long)(unsigned)ts_hi << 32) | (unsigned)ts_lo) : 0ull;
        if (lane == 62) stamps[62] = rt_entry; if (lane == 63) stamps[63] = (unsigned long long)wall_clock64(); }
#undef PG8_STAMP
#undef PG8_SA
#undef PG8_SB
#undef PG8_STAGE
#undef PG8_LDA
#undef PG8_LDB
#undef PG8_MMA
#undef PG8_WAIT_V
#undef PG8_WAIT_L
#undef PG8_BAR
#undef PG8_SCHED
}

struct EpiStoreBf16 {
    static constexpr bool PERM = true, AFTER_DRAIN = false;
    bf16_t* O; int ldc; int ncols; int slo, shi; float scale;
    __device__ __forceinline__ void operator()(const f32x4 (&acc)[2][2][4][2], const Unit& u, int wr, int wc, int fr, int fq) const {
        const int row0 = u.pm * BM + wr * 64 + fr, col0 = u.pn * BM + wc * 32 + 8 * fq;
        float sc[2];
#pragma unroll
        for (int bj = 0; bj < 2; ++bj) { const int cb = u.pn * BM + bj * HALF; sc[bj] = (cb >= slo && cb < shi) ? scale : 1.f; }
#pragma unroll
        for (int ai = 0; ai < 2; ++ai)
#pragma unroll
            for (int m = 0; m < 4; ++m) { bf16_t* rowp = O + (size_t)(row0 + ai * HALF + m * 16) * ldc + col0;
#pragma unroll
                for (int bj = 0; bj < 2; ++bj) if (col0 + bj * HALF < ncols) { const f32x4 v0 = acc[ai][bj][m][0] * sc[bj], v1 = acc[ai][bj][m][1] * sc[bj];
                    u32x4 w; w.x = ::cvtpk(v0[0], v0[1]); w.y = ::cvtpk(v0[2], v0[3]); w.z = ::cvtpk(v1[0], v1[1]); w.w = ::cvtpk(v1[2], v1[3]);
                    *(u32x4*)(rowp + bj * HALF) = w; }
                asm volatile("" ::: "memory"); }
    }
};
struct EpiResidX {
    static constexpr bool PERM = false, AFTER_DRAIN = false;
    float* xc; float* xout; const float* gate_l;
    __device__ __forceinline__ void operator()(const f32x4 (&acc)[2][2][4][2], const Unit& u, int wr, int wc, int fr, int fq) const {
        const int rowt = u.pm * BM; const int b = rowt / RPB, j0 = rowt - b * RPB; const bool isctx = j0 < CTX;
        float* xb = isctx ? xc + ((size_t)(b * CTX + j0) << 10) : xout + ((size_t)(b * SEQ + j0 - CTX) << 10);
        const float* gt = gate_l + (size_t)(isctx ? 4 : b) * 6144;
        const int r0 = wr * 64 + fr, col0 = u.pn * BM + wc * 32 + 4 * fq;
        f32x4 gv[2][2];
#pragma unroll
        for (int bj = 0; bj < 2; ++bj)
#pragma unroll
            for (int n = 0; n < 2; ++n) gv[bj][n] = *(const f32x4*)(gt + col0 + bj * HALF + n * 16);
#pragma unroll
        for (int ai = 0; ai < 2; ++ai)
#pragma unroll
            for (int m = 0; m < 4; ++m) { float* rowp = xb + ((size_t)(r0 + ai * HALF + m * 16) << 10) + col0;
#pragma unroll
                for (int bj = 0; bj < 2; ++bj)
#pragma unroll
                    for (int n = 0; n < 2; ++n) { f32x4* p = (f32x4*)(rowp + bj * HALF + n * 16); *p = *p + gv[bj][n] * acc[ai][bj][m][n]; }
                asm volatile("" ::: "memory"); }
    }
};
}

constexpr int LDS_BYTES = 144 * 1024;
static_assert(TOPK_LDS + 16 <= LDS_BYTES && GEMM_LDS + 16 <= LDS_BYTES && ATT_LDS + 16 <= LDS_BYTES, "LDS budget");
constexpr int PPL = 13;
constexpr int N_PHASES = 1 + PPL * DEPTH + 1;
extern __shared__ __attribute__((aligned(16))) char g_lds[];

#define PHASE_FN __device__ __forceinline__ void
PHASE_FN f_p0(int w0) { const Ctx c = fresh_ctx(w0); ph_p0(c, g_lds); }
PHASE_FN f_norm0(int w0, int l) { const Ctx c = fresh_ctx(w0); ph_norm<0>(c, l); }
PHASE_FN f_norm1(int w0, int l) { const Ctx c = fresh_ctx(w0); ph_norm<1>(c, l); }
PHASE_FN f_gemm_in(int w0, int l) { const Ctx c = fresh_ctx(w0);
    pg8::Gemm g{C_HB, C_WIN + (size_t)l * INC * D, NR, 3328, D};
    pg8::TileOrder S; S.init(132, 13, (int)gridDim.x, (int)blockIdx.x, false);
    pg8::EpiStoreBf16 E{C_P, INC, INC, DF_Q, DF_Q + 256, 0.17677669529663687f * 1.4426950408889634f};
    pg8::gemm_phase<pg8::EpiStoreBf16, pg8::TileOrder>((PG8_LAS unsigned char*)g_lds, g, S, E, nullptr, w0); }
PHASE_FN f_prep(int w0, int l) {
    const Ctx c = fresh_ctx(w0); char* lds = g_lds;
    ph_prep_rows(c, l);
    scan_tables(c, l, lds);
    { const int G = (int)gridDim.x, N = 16 * NCHUNK * 2, R = (N + G - 1) / G;
      for (int q = 0; q < 2 * R; ++q) { const int mx = q & 1; int u = (q >> 1) * G + (int)blockIdx.x; if (u >= N) continue;
        const int dir = u & 1; u >>= 1; const int cc = u % NCHUNK; u /= NCHUNK; const int h = u & 3, b = u >> 2;
        if (mx == 0) scanA_item<0>(c, l, b, h, cc, dir, lds); else scanA_item<1>(c, l, b, h, cc, dir, lds); } }
}
PHASE_FN f_upproj(int w0, int l) {
    const Ctx c = fresh_ctx(w0); char* lds = g_lds;
    EpiBf16 eq{C_QM, 384, 0.10206207261596575f * 1.4426950408889634f}, ekv{C_KVM, 512, 1.f};
    for (int it = blockIdx.x; it < 132 * 7 + 384; it += gridDim.x) {
        if (it < 132 * 7) { const int tm = it / 7, tn = it % 7;
            if (tn < 3) gemm_tile(c, C_P + MLA_CQ, INC, C_WUQ + (size_t)l * 384 * 192, 192, 192, tm * 256, tn * 128, lds, eq);
            else gemm_tile(c, C_P + MLA_CKV, INC, C_WUKV + (size_t)l * 512 * 128, 128, 128, tm * 256, (tn - 3) * 128, lds, ekv); }
        else scanB_item(c, it - 132 * 7); }
}
PHASE_FN f_scanc(int w0, int l) {
    const Ctx c = fresh_ctx(w0); char* lds = g_lds; const bool need_ctx = (l < DEPTH - 1);
    ph_rope_q(c);
    scan_tables(c, l, lds);
    { const int G = (int)gridDim.x, N = 16 * NCHUNK, R = (N + G - 1) / G;
      for (int q = 0; q < 2 * R; ++q) { const int mx = q & 1; int u = (q >> 1) * G + (int)blockIdx.x; if (u >= N) continue;
        const int cc = u % NCHUNK; u /= NCHUNK; const int h = u & 3, b = u >> 2;
        if (cc < 4 && !need_ctx) continue;
        if (mx == 0) scanC_item<0>(c, l, b, h, cc, lds); else scanC_item<1>(c, l, b, h, cc, lds); } }
}
PHASE_FN f_attn(int w0, int l) { const Ctx c = fresh_ctx(w0); ph_attn(c, l, g_lds); }
PHASE_FN f_gemm_out(int w0, int l) {
    const Ctx c = fresh_ctx(w0); const bool need_ctx = (l < DEPTH - 1);
    { pg8::Gemm g{C_HB, C_WOUT + (size_t)l * D * D, NR, D, D};
      pg8::TileOrder S; S.init(need_ctx ? 132 : 128, 4, (int)gridDim.x, (int)blockIdx.x, !need_ctx);
      pg8::EpiResidX E{C_XC, COUT, C_MODT + (size_t)l * 5 * 6144 + 2 * D};
      pg8::gemm_phase<pg8::EpiResidX, pg8::TileOrder>((PG8_LAS unsigned char*)g_lds, g, S, E, nullptr, w0); }
    cvt_tables(c, l);
}
PHASE_FN f_peer_q(int w0, int l) {
    const Ctx c = fresh_ctx(w0); const bool need_ctx = (l < DEPTH - 1);
    pg8::Gemm g{C_HB, C_WQ + (size_t)l * 2048 * D, NR, 2048, D};
    pg8::TileOrder S; S.init(need_ctx ? 132 : 128, 8, (int)gridDim.x, (int)blockIdx.x, !need_ctx);
    pg8::EpiStoreBf16 E{C_Q2, 2048, 2048, 0, 0, 1.f};
    pg8::gemm_phase<pg8::EpiStoreBf16, pg8::TileOrder>((PG8_LAS unsigned char*)g_lds, g, S, E, nullptr, w0);
}
PHASE_FN f_topk(int w0, int l) {
    const Ctx c = fresh_ctx(w0); char* lds = g_lds; const bool need_ctx = (l < DEPTH - 1);
    for (int it = blockIdx.x; it < 264 * 8; it += gridDim.x) { const int tm = it >> 3, h = it & 7;
        if ((tm % 66) < 2 && !need_ctx) continue;
        peer_topk_item(c, l, tm, h, lds); }
}
PHASE_FN f_expert_u(int w0, int l) { const Ctx c = fresh_ctx(w0); ph_peer_expert<0>(c, l, g_lds); }
PHASE_FN f_expert_c(int w0, int l) { const Ctx c = fresh_ctx(w0); ph_peer_combine(c, l); }
PHASE_FN f_expert_v(int w0, int l) { const Ctx c = fresh_ctx(w0); ph_peer_expert<1>(c, l, g_lds); }
PHASE_FN f_final(int w0) { const Ctx c = fresh_ctx(w0); ph_final(c); }

__global__ void __launch_bounds__(512, 2) mk_fwd(Params p) {
    volatile LAS unsigned* bst = (volatile LAS unsigned*)(g_lds + LDS_BYTES - 16);
    const bool t0 = threadIdx.x == 0; const int w0 = __builtin_amdgcn_readfirstlane((int)threadIdx.x >> 6);
    if (t0) { bst[0] = 0u; bst[1] = 0u; bst[2] = 0u; bst[3] = 0u; }
    __syncthreads();
    XcdBarrier bar; bar.bar = (unsigned*)(p.ws + WS_CTL); bar.x = 0; bar.st = bst; bar.t0 = t0;
    const int lo = p.ph_lo, hi = p.ph_hi;
    const bool multi = (hi - lo) > 1;
    if (multi) bar = xcd_barrier_post((unsigned*)(p.ws + WS_CTL), bst, t0);
#ifndef PHMASK
#define PHMASK 0xFFFF
#endif
#define EN(s) ((PHMASK >> (s)) & 1)
#define IN(k) (lo <= (k) && (k) < hi)
#define SEAM(k) do { if (IN(k) && IN((k) + 1)) xcd_barrier(bar); } while (0)
    if (EN(0) && IN(0)) f_p0(w0);
    SEAM(0);
#define LAYER(l) do { constexpr int base = 1 + PPL * (l); \
        if (EN(1) && IN(base + 0)) f_norm0(w0, l); SEAM(base + 0); \
        if (EN(2) && IN(base + 1)) f_gemm_in(w0, l); SEAM(base + 1); \
        if (EN(3) && IN(base + 2)) f_prep(w0, l); SEAM(base + 2); \
        if (EN(4) && IN(base + 3)) f_upproj(w0, l); SEAM(base + 3); \
        if (EN(5) && IN(base + 4)) f_scanc(w0, l); SEAM(base + 4); \
        if (EN(6) && IN(base + 5)) f_attn(w0, l); SEAM(base + 5); \
        if (EN(7) && IN(base + 6)) f_gemm_out(w0, l); SEAM(base + 6); \
        if (EN(8) && IN(base + 7)) f_norm1(w0, l); SEAM(base + 7); \
        if (EN(9) && IN(base + 8)) f_peer_q(w0, l); SEAM(base + 8); \
        if (EN(10) && IN(base + 9)) f_topk(w0, l); SEAM(base + 9); \
        if (EN(11) && IN(base + 10)) f_expert_u(w0, l); SEAM(base + 10); \
        if (EN(12) && IN(base + 11)) f_expert_c(w0, l); SEAM(base + 11); \
        if (EN(13) && IN(base + 12)) f_expert_v(w0, l); SEAM(base + 12); } while (0)
    LAYER(0);
    LAYER(1);
#undef LAYER
    if (EN(14) && IN(N_PHASES - 1)) f_final(w0);
#undef IN
#undef SEAM
}

extern "C" void kernel_launch(void* const* d_in, const int* in_sizes, int n_in, void* d_out, int out_size, void* d_ws, size_t ws_size, hipStream_t stream) {
    static int grid = 0;
    if (grid == 0) {
        if (n_in != 26 || in_sizes[0] != NB * SEQ * D || out_size != NB * SEQ * D || ws_size < WS_END) {
            fprintf(stderr, "kernel_launch: shape/workspace mismatch: n_in %d in0 %d out %d ws %zu (need %zu); nothing launched\n", n_in, n_in > 0 ? in_sizes[0] : -1, out_size, ws_size, (size_t)WS_END);
            grid = -1; return; }
        int dev = 0, cus = 0, per_cu = 0;
        if (hipGetDevice(&dev) != hipSuccess || hipDeviceGetAttribute(&cus, hipDeviceAttributeMultiprocessorCount, dev) != hipSuccess) { grid = -1; return; }
        if (hipFuncSetAttribute((const void*)mk_fwd, hipFuncAttributeMaxDynamicSharedMemorySize, LDS_BYTES) != hipSuccess) { fprintf(stderr, "kernel_launch: hipFuncSetAttribute failed\n"); grid = -1; return; }
        if (hipOccupancyMaxActiveBlocksPerMultiprocessor(&per_cu, (const void*)mk_fwd, 512, LDS_BYTES) != hipSuccess || per_cu < 1)
            fprintf(stderr, "kernel_launch: note: occupancy query reports %d workgroups per CU\n", per_cu);
        (void)hipGetLastError();
        grid = cus;
    }
    if (grid < 0) return;
    if (hipMemsetAsync((char*)d_ws + WS_CTL, 0, CTL_BYTES, stream) != hipSuccess) { fprintf(stderr, "kernel_launch: memset failed\n"); return; }
    Params p{};
    for (int i = 0; i < 26; ++i) p.in[i] = (const float*)d_in[i];
    p.out = (float*)d_out; p.ws = (unsigned char*)d_ws;
#if MK_PER_PHASE
    for (int k = 0; k < N_PHASES; ++k) { p.ph_lo = k; p.ph_hi = k + 1; hipLaunchKernelGGL(mk_fwd, dim3(grid), dim3(512), LDS_BYTES, stream, p); }
#else
    p.ph_lo = 0; p.ph_hi = N_PHASES; hipLaunchKernelGGL(mk_fwd, dim3(grid), dim3(512), LDS_BYTES, stream, p);
#endif
    const hipError_t le = hipPeekAtLastError();
    if (le != hipSuccess) fprintf(stderr, "kernel_launch: launch failed: %s\n", hipGetErrorName(le));
}
```

```cpp
#include <hip/hip_runtime.h>
#include <cstdio>
#include <cstdint>

#ifndef ATT_FAST_DIFF
#define ATT_FAST_DIFF 0
#endif
#ifndef MK_PER_PHASE
#define MK_PER_PHASE 0
#endif

constexpr int D = 1024, NB = 4, SEQ = 8192, CTX = 256, DEPTH = 2;
constexpr int RPB = CTX + SEQ;
constexpr int NR = NB * RPB;
constexpr int INC = 3200;
constexpr int GLA_Q = 0, GLA_K = 128, GLA_V = 256, GLA_R = 512, GLA_ZF = 768, GLA_ZB = 784;
constexpr int HG_Q = 800, HG_I = 1056, HG_OG = 1312, HG_ZF = 1568, HG_ZB = 1824;
constexpr int MLA_CQ = 2080, MLA_CKV = 2272, MLA_KR = 2400;
constexpr int DF_Q = 2432, DF_K = 2688, DF_V = 2944;
constexpr int NCHUNK = RPB / 64;
constexpr int NEXP = 16384;
constexpr float NORM_EPS = 1e-6f;

typedef unsigned short bf16_t;
typedef short bf16x8 __attribute__((ext_vector_type(8)));
typedef short s16x4 __attribute__((ext_vector_type(4)));
typedef float f32x16 __attribute__((ext_vector_type(16)));
typedef float f32x4 __attribute__((ext_vector_type(4)));
typedef unsigned u32x4 __attribute__((ext_vector_type(4)));
typedef unsigned u32x2 __attribute__((ext_vector_type(2)));

constexpr size_t al256(size_t x) { return (x + 255) / 256 * 256; }
constexpr size_t WS_CTL = 0;
constexpr size_t CTL_BYTES = 65536;
constexpr size_t WS_MOD = WS_CTL + CTL_BYTES;
constexpr size_t WS_XC = al256(WS_MOD + (size_t)2 * 5 * 6144 * 4);
constexpr size_t WS_WIN = al256(WS_XC + (size_t)NB * CTX * D * 4);
constexpr size_t WS_WOUT = al256(WS_WIN + (size_t)2 * INC * D * 2);
constexpr size_t WS_WQ = al256(WS_WOUT + (size_t)2 * D * D * 2);
constexpr size_t WS_WUQ = al256(WS_WQ + (size_t)2 * 2048 * D * 2);
constexpr size_t WS_WUKV = al256(WS_WUQ + (size_t)2 * 384 * 192 * 2);
constexpr size_t WS_KEYS = al256(WS_WUKV + (size_t)2 * 512 * 128 * 2);
constexpr size_t WS_HB = al256(WS_KEYS + (size_t)2 * 16 * 128 * 128 * 2);
constexpr size_t WS_QM = al256(WS_HB + (size_t)NR * D * 2);
constexpr size_t WS_KVM = al256(WS_QM + (size_t)NR * 384 * 2);
constexpr size_t WS_SG = al256(WS_KVM + (size_t)NR * 512 * 2);
constexpr size_t WS_SH = al256(WS_SG + (size_t)32 * NCHUNK * 2048 * 2);
constexpr size_t WS_DG = al256(WS_SH + (size_t)32 * NCHUNK * 4096 * 2);
constexpr size_t WS_DH = al256(WS_DG + (size_t)32 * NCHUNK * 32 * 4);
constexpr size_t WS_P = al256(WS_DH + (size_t)32 * NCHUNK * 64 * 4);
constexpr size_t WS_END = al256(WS_P + (size_t)NR * INC * 2);
constexpr size_t WS_TU8 = WS_P;
constexpr size_t WS_TV8 = WS_P + (size_t)NEXP * D;
constexpr size_t WS_SU = WS_TV8 + (size_t)NEXP * D;
constexpr size_t WS_SV = WS_SU + (size_t)NEXP * 4;
constexpr size_t WS_Q2 = WS_P + (size_t)64 * 1024 * 1024;
constexpr size_t WS_PART = WS_Q2;
static_assert(WS_SV + (size_t)NEXP * 4 <= WS_Q2, "alias overflow 0");
static_assert(WS_Q2 + (size_t)NR * 2048 * 2 <= WS_END, "alias overflow");
constexpr size_t WS_EI = WS_SG;
constexpr size_t WS_EG = WS_EI + (size_t)NR * 128 * 4;
static_assert(WS_EG + (size_t)NR * 128 * 4 <= WS_DG, "alias overflow 2");

#define XB_TMO      128
#define XB_XCNT(j)  (256  + 64 * (j))
#define XB_XSUB(j)  (1280 + 64 * (j))
#define XB_XGEN(j)  (2304 + 64 * (j))
#define XB_TOP      3328
#define XB_TOPGEN   3392
#define XCD_BAR_WORDS 3456
#define XB_SPIN_CAP (1u << 22)
#define LAS __attribute__((address_space(3)))

__device__ __forceinline__ unsigned xb_ld(unsigned* p)              { return __hip_atomic_load(p, __ATOMIC_RELAXED, __HIP_MEMORY_SCOPE_AGENT); }
__device__ __forceinline__ unsigned xb_add(unsigned* p, unsigned v) { return __hip_atomic_fetch_add(p, v, __ATOMIC_RELAXED, __HIP_MEMORY_SCOPE_AGENT); }
__device__ __forceinline__ unsigned xb_xcc_id() { return (unsigned)__builtin_amdgcn_s_getreg((3 << 11) | 20) & 0xFu; }
#define XB_SPIN(cond, bar) do { unsigned _sp = 0; while (cond) { __builtin_amdgcn_s_sleep(1); \
    if ((++_sp & 255u) == 0u) { if (xb_ld(&(bar)[XB_TMO])) break; if (_sp > XB_SPIN_CAP) { atomicAdd(&(bar)[XB_TMO], 1u); break; } } } } while (0)

struct XcdBarrier { unsigned* bar; unsigned x; volatile LAS unsigned* st; bool t0; };

__device__ __forceinline__ XcdBarrier xcd_barrier_post(unsigned* bar, volatile LAS unsigned* st, bool t0) {
    XcdBarrier b; b.bar = bar; b.x = xb_xcc_id(); b.st = st; b.t0 = t0;
    if (t0) (void)xb_add(&bar[XB_XCNT(b.x)], 1u);
    return b;
}
__device__ __forceinline__ void xcd_barrier_complete(unsigned* bar, unsigned x, unsigned& nloc, unsigned& nx) {
    const unsigned G = gridDim.x * gridDim.y * gridDim.z;
    unsigned sum, cnt, mine, sp = 0u;
    for (;;) {
        sum = 0u; cnt = 0u; mine = 0u;
#pragma unroll
        for (unsigned j = 0; j < 16; ++j) { const unsigned c = xb_ld(&bar[XB_XCNT(j)]); sum += c; cnt += (c > 0u) ? 1u : 0u; mine = (j == x) ? c : mine; }
        if (sum == G) break;
        __builtin_amdgcn_s_sleep(1);
        if ((++sp & 255u) == 0u) { if (xb_ld(&bar[XB_TMO])) break; if (sp > XB_SPIN_CAP) { atomicAdd(&bar[XB_TMO], 1u); break; } }
    }
    nloc = mine > 0u ? mine : 1u; nx = cnt > 0u ? cnt : 1u;
}
__device__ __forceinline__ void xcd_barrier(const XcdBarrier& b) {
    asm volatile("s_waitcnt vmcnt(0)" ::: "memory");
    __syncthreads();
    if (b.t0) {
        unsigned* bar = b.bar;
        __builtin_amdgcn_s_waitcnt(0);
        unsigned nloc = b.st[0], nx = b.st[1];
        if (nloc == 0u) { xcd_barrier_complete(bar, b.x, nloc, nx); b.st[0] = nloc; b.st[1] = nx; }
        const unsigned old = xb_add(&bar[XB_XSUB(b.x)], 1u);
        const unsigned gen = old / nloc;
        if (old + 1u == (gen + 1u) * nloc) {
            __builtin_amdgcn_fence(__ATOMIC_RELEASE, "agent");
            asm volatile("s_waitcnt vmcnt(0)" ::: "memory");
            const unsigned og = xb_add(&bar[XB_TOP], 1u);
            const unsigned tg = og / nx;
            if (og + 1u == (tg + 1u) * nx) xb_add(&bar[XB_TOPGEN], 1u);
            else XB_SPIN(xb_ld(&bar[XB_TOPGEN]) == tg, bar);
            __builtin_amdgcn_fence(__ATOMIC_ACQUIRE, "agent");
            xb_add(&bar[XB_XGEN(b.x)], 1u);
            asm volatile("s_waitcnt vmcnt(0)" ::: "memory");
        } else {
            XB_SPIN(xb_ld(&bar[XB_XGEN(b.x)]) == gen, bar);
            __builtin_amdgcn_fence(__ATOMIC_ACQUIRE, "agent");
            asm volatile("s_waitcnt vmcnt(0)" ::: "memory");
        }
    }
    __syncthreads();
}

typedef __bf16 bf16v2_t __attribute__((ext_vector_type(2)));
typedef float f32v2_t __attribute__((ext_vector_type(2)));
__device__ __forceinline__ unsigned cvtpk(float lo, float hi) { const f32v2_t v = {lo, hi}; const bf16v2_t b = __builtin_convertvector(v, bf16v2_t); return __builtin_bit_cast(unsigned, b); }
__device__ __forceinline__ bf16_t f2bf(float x) { const __bf16 b = (__bf16)x; return __builtin_bit_cast(bf16_t, b); }
__device__ __forceinline__ float bf2f(bf16_t h) { return __uint_as_float(((unsigned)h) << 16); }
__device__ __forceinline__ float bflo(unsigned w) { return __uint_as_float(w << 16); }
__device__ __forceinline__ float bfhi(unsigned w) { return __uint_as_float(w & 0xffff0000u); }
__device__ __forceinline__ float silu_f(float x) { return x / (1.f + __expf(-x)); }
__device__ __forceinline__ float logsigmoid_f(float z) { return fminf(z, 0.f) - __logf(1.f + __expf(-fabsf(z))); }
__device__ __forceinline__ float wave_sum(float v) {
#pragma unroll
    for (int o = 32; o >= 1; o >>= 1) v += __shfl_xor(v, o, 64);
    return v;
}
__device__ __forceinline__ void zero_acc(f32x16& a) {
#pragma unroll
    for (int r = 0; r < 16; ++r) a[r] = 0.f;
    asm volatile("" : "+v"(a));
}
__device__ __forceinline__ int crow(int r, int hi) { return (r & 3) + 8 * (r >> 2) + 4 * hi; }

struct Params { const float* in[26]; float* out; unsigned char* ws; int ph_lo, ph_hi; };
typedef const __attribute__((address_space(4))) Params* KParams;
struct Ctx {
    KParams pp;
    int tid, lane, wid;
};
__device__ __forceinline__ int mk_tid(int w0) { unsigned m = ~0u; asm volatile("" : "+s"(m)); return (w0 << 6) | (int)__builtin_amdgcn_mbcnt_hi(m, __builtin_amdgcn_mbcnt_lo(m, 0u)); }
__device__ __forceinline__ float shx(float v, int o, int lane) { return __int_as_float(__builtin_amdgcn_ds_bpermute((lane ^ o) << 2, __float_as_int(v))); }
__device__ __forceinline__ Ctx fresh_ctx(int w0) {
    Ctx c; unsigned long long a = (unsigned long long)__builtin_amdgcn_kernarg_segment_ptr(); asm volatile("" : "+s"(a)); c.pp = (KParams)a;
    int t = mk_tid(w0); asm volatile("" : "+v"(t)); c.tid = t; c.lane = t & 63; c.wid = w0;
    return c;
}
#define CIN(i)   (c.pp->in[i])
#define COUT     (c.pp->out)
#define CWS(off) (c.pp->ws + (off))
#define C_MODT ((float*)CWS(WS_MOD))
#define C_XC   ((float*)CWS(WS_XC))
#define C_WIN  ((bf16_t*)CWS(WS_WIN))
#define C_WOUT ((bf16_t*)CWS(WS_WOUT))
#define C_WQ   ((bf16_t*)CWS(WS_WQ))
#define C_WUQ  ((bf16_t*)CWS(WS_WUQ))
#define C_WUKV ((bf16_t*)CWS(WS_WUKV))
#define C_KEYS ((bf16_t*)CWS(WS_KEYS))
#define C_HB   ((bf16_t*)CWS(WS_HB))
#define C_QM   ((bf16_t*)CWS(WS_QM))
#define C_KVM  ((bf16_t*)CWS(WS_KVM))
#define C_P    ((bf16_t*)CWS(WS_P))
#define C_TU8  ((unsigned char*)CWS(WS_TU8))
#define C_TV8  ((unsigned char*)CWS(WS_TV8))
#define C_SU   ((float*)CWS(WS_SU))
#define C_SV   ((float*)CWS(WS_SV))
#define C_PART ((float*)CWS(WS_PART))
#define C_Q2   ((bf16_t*)CWS(WS_Q2))
#define C_SG   ((bf16_t*)CWS(WS_SG))
#define C_SH   ((bf16_t*)CWS(WS_SH))
#define C_DG   ((float*)CWS(WS_DG))
#define C_DH   ((float*)CWS(WS_DH))
#define C_EI   ((int*)CWS(WS_EI))
#define C_EG   ((float*)CWS(WS_EG))

__device__ __forceinline__ float* xrow(const Ctx& c, int r) {
    const int b = r / RPB, j = r - b * RPB;
    return j < CTX ? C_XC + ((size_t)(b * CTX + j) << 10) : COUT + ((size_t)(b * SEQ + (j - CTX)) << 10);
}
__device__ __forceinline__ const float* inrow(const Ctx& c, int r) {
    const int b = r / RPB, j = r - b * RPB;
    return j < CTX ? CIN(2) + ((size_t)(b * CTX + j) << 10) : CIN(0) + ((size_t)(b * SEQ + (j - CTX)) << 10);
}

__device__ void p0_mod_item(const Ctx& c, int item, char* lds) {
    float* sc = (float*)lds;
    float* red = sc + 5 * 1024;
    const int tid = c.tid;
    for (int i = tid; i < 5 * 1024; i += 512) { const int v = i >> 10, k = i & 1023; const float x = (v < 4) ? CIN(1)[v * 1024 + k] : CIN(3)[k]; sc[i] = silu_f(x); }
    __syncthreads();
    const int l = item / 96, n0 = (item % 96) * 64;
    const int col = tid & 63, kg = tid >> 6;
    const float* w = CIN(4) + (size_t)l * 1024 * 6144 + n0 + col;
    float a[5] = {0.f, 0.f, 0.f, 0.f, 0.f};
#pragma unroll 8
    for (int kk = 0; kk < 128; ++kk) { const int k = kg * 128 + kk; const float wv = w[(size_t)k * 6144];
#pragma unroll
        for (int v = 0; v < 5; ++v) a[v] += sc[v * 1024 + k] * wv; }
#pragma unroll
    for (int v = 0; v < 5; ++v) red[(kg * 64 + col) * 5 + v] = a[v];
    __syncthreads();
    if (tid < 320) { const int cc = tid / 5, v = tid % 5; float s = 0.f;
#pragma unroll
        for (int g = 0; g < 8; ++g) s += red[(g * 64 + cc) * 5 + v];
        C_MODT[((size_t)l * 5 + v) * 6144 + n0 + cc] = s + CIN(5)[l * 6144 + n0 + cc]; }
    __syncthreads();
}
__device__ void p0_tr_tile(const float* __restrict__ src, bf16_t* __restrict__ dst, int K, int N, int k0, int n0, int tid, char* lds) {
    float* t = (float*)lds;
#pragma unroll
    for (int i = 0; i < 2; ++i) { const int k = (tid >> 4) + 32 * i, n4 = (tid & 15) * 4;
        const f32x4 v = *(const f32x4*)(src + (size_t)(k0 + k) * N + n0 + n4);
        t[k * 65 + n4 + 0] = v[0]; t[k * 65 + n4 + 1] = v[1]; t[k * 65 + n4 + 2] = v[2]; t[k * 65 + n4 + 3] = v[3]; }
    __syncthreads();
    { const int n = tid >> 3, k8 = (tid & 7) * 8; u32x4 w;
#pragma unroll
        for (int j = 0; j < 4; ++j) w[j] = cvtpk(t[(k8 + 2 * j) * 65 + n], t[(k8 + 2 * j + 1) * 65 + n]);
        *(u32x4*)(dst + (size_t)(n0 + n) * K + k0 + k8) = w; }
    __syncthreads();
}
__device__ void ph_p0(const Ctx& c, char* lds) {
    constexpr int T_WIN = 16 * 50, T_WOUT = 16 * 16, T_WQ = 16 * 32, T_UQ = 3 * 6, T_UKV = 2 * 8;
    constexpr int PER_L = T_WIN + T_WOUT + T_WQ + T_UQ + T_UKV;
    constexpr int NITEM = 192 + 2 * PER_L;
    for (int it = blockIdx.x; it < NITEM; it += gridDim.x) {
        if (it < 192) { p0_mod_item(c, it, lds); continue; }
        int t = it - 192; const int l = t / PER_L; t -= l * PER_L;
        if (t < T_WIN) { p0_tr_tile(CIN(8) + (size_t)l * D * INC, C_WIN + (size_t)l * INC * D, D, INC, (t / 50) * 64, (t % 50) * 64, c.tid, lds); continue; } t -= T_WIN;
        if (t < T_WOUT) { p0_tr_tile(CIN(9) + (size_t)l * D * D, C_WOUT + (size_t)l * D * D, D, D, (t / 16) * 64, (t % 16) * 64, c.tid, lds); continue; } t -= T_WOUT;
        if (t < T_WQ) { p0_tr_tile(CIN(21) + (size_t)l * D * 2048, C_WQ + (size_t)l * 2048 * D, D, 2048, (t / 32) * 64, (t % 32) * 64, c.tid, lds); continue; } t -= T_WQ;
        if (t < T_UQ) { p0_tr_tile(CIN(17) + (size_t)l * 192 * 384, C_WUQ + (size_t)l * 384 * 192, 192, 384, (t / 6) * 64, (t % 6) * 64, c.tid, lds); continue; } t -= T_UQ;
        p0_tr_tile(CIN(18) + (size_t)l * 128 * 512, C_WUKV + (size_t)l * 512 * 128, 128, 512, (t / 8) * 64, (t % 8) * 64, c.tid, lds);
    }
    const size_t nk8 = (size_t)2 * 16 * 128 * 128 / 8;
    for (size_t i = (size_t)blockIdx.x * 512 + c.tid; i < nk8; i += (size_t)gridDim.x * 512) {
        const f32x4 a = *(const f32x4*)(CIN(22) + i * 8), b = *(const f32x4*)(CIN(22) + i * 8 + 4);
        u32x4 w = {cvtpk(a[0], a[1]), cvtpk(a[2], a[3]), cvtpk(b[0], b[1]), cvtpk(b[2], b[3])};
        *(u32x4*)(C_KEYS + i * 8) = w;
    }
}

template <int WHICH>
__device__ void ph_norm(const Ctx& c, int l) {
    const float* g = CIN(WHICH == 0 ? 6 : 7) + l * D;
    const bool need_ctx = (l < DEPTH - 1);
    const int stride = gridDim.x * 8;
    auto next_row = [&](int r) { for (; r < NR; r += stride) { const int j = r % RPB; if (!(WHICH == 1 && j < CTX && !need_ctx)) break; } return r; };
    auto row_src = [&](int r) { return (WHICH == 0 && l == 0) ? inrow(c, r) : (const float*)xrow(c, r); };
    int r = next_row(blockIdx.x * 8 + c.wid);
    f32x4 xn[4];
    if (r < NR) { const float* src = row_src(r);
#pragma unroll
        for (int i = 0; i < 4; ++i) xn[i] = *(const f32x4*)(src + i * 256 + c.lane * 4); }
    while (r < NR) {
        f32x4 x[4];
#pragma unroll
        for (int i = 0; i < 4; ++i) x[i] = xn[i];
        const int rn = next_row(r + stride);
        if (rn < NR) { const float* src = row_src(rn);
#pragma unroll
            for (int i = 0; i < 4; ++i) xn[i] = *(const f32x4*)(src + i * 256 + c.lane * 4); }
        const int b = r / RPB, j = r - b * RPB; const bool isctx = j < CTX;
        float ss = 0.f;
#pragma unroll
        for (int i = 0; i < 4; ++i) ss += x[i][0] * x[i][0] + x[i][1] * x[i][1] + x[i][2] * x[i][2] + x[i][3] * x[i][3];
        ss = wave_sum(ss);
        const float rstd = rsqrtf(ss * (1.f / D) + NORM_EPS);
        const float* mt = C_MODT + ((size_t)l * 5 + (isctx ? 4 : b)) * 6144;
        const float* sh = mt + (WHICH == 0 ? 0 : 3) * D; const float* scl = mt + (WHICH == 0 ? 1 : 4) * D;
        bf16_t* dst = C_HB + (size_t)r * D;
        float* xr = xrow(c, r);
#pragma unroll
        for (int i = 0; i < 4; ++i) { const int col = i * 256 + c.lane * 4;
            const f32x4 gv = *(const f32x4*)(g + col), sv = *(const f32x4*)(sh + col), cv = *(const f32x4*)(scl + col);
            float y[4];
#pragma unroll
            for (int e = 0; e < 4; ++e) y[e] = x[i][e] * rstd * gv[e] * (1.f + cv[e]) + sv[e];
            u32x2 w = {cvtpk(y[0], y[1]), cvtpk(y[2], y[3])};
            *(u32x2*)(dst + col) = w;
            if (WHICH == 0 && l == 0) *(f32x4*)(xr + col) = x[i]; }
        r = rn;
    }
}

constexpr int GEMM_LDS = 98304;
template <class Epi>
__device__ __forceinline__ void gemm_tile(const Ctx& c, const bf16_t* __restrict__ A, int lda, const bf16_t* __restrict__ Bt, int ldb, int K, int m0, int n0, char* lds, const Epi& epi) {
    const int tid = c.tid, lane = tid & 63, wid = tid >> 6, r32 = lane & 31, hi = lane >> 5, wm = wid >> 1, wn = wid & 1;
    char* As = lds; char* Bs = lds + 65536;
    f32x16 acc[2][2];
#pragma unroll
    for (int m = 0; m < 2; ++m)
#pragma unroll
        for (int n = 0; n < 2; ++n) zero_acc(acc[m][n]);
    u32x4 ra[4], rb[2];
    const int srow = tid >> 3, sch = tid & 7;
    const bf16_t* Ag = A + (size_t)(m0 + srow) * lda + sch * 8;
    const bf16_t* Bg = Bt + (size_t)(n0 + srow) * ldb + sch * 8;
    const int swoff = srow * 128 + ((sch ^ ((srow >> 1) & 7)) << 4);
#define GLOAD(k0) do { _Pragma("unroll") for (int i = 0; i < 4; ++i) ra[i] = *(const u32x4*)(Ag + (size_t)(64 * i) * lda + (k0)); \
                       _Pragma("unroll") for (int i = 0; i < 2; ++i) rb[i] = *(const u32x4*)(Bg + (size_t)(64 * i) * ldb + (k0)); } while (0)
#define SWRITE(buf) do { _Pragma("unroll") for (int i = 0; i < 4; ++i) *(u32x4*)(As + (buf) * 32768 + swoff + i * 8192) = ra[i]; \
                         _Pragma("unroll") for (int i = 0; i < 2; ++i) *(u32x4*)(Bs + (buf) * 16384 + swoff + i * 8192) = rb[i]; } while (0)
    const int nk = K >> 6;
    GLOAD(0); SWRITE(0); __syncthreads();
    for (int kt = 0; kt < nk; ++kt) {
        const int buf = kt & 1;
        if (kt + 1 < nk) GLOAD((kt + 1) * 64);
        const char* Ab = As + buf * 32768; const char* Bb = Bs + buf * 16384;
#pragma unroll
        for (int ks = 0; ks < 4; ++ks) {
            bf16x8 a[2], b[2];
#pragma unroll
            for (int m = 0; m < 2; ++m) { const int row = wm * 64 + m * 32 + r32; a[m] = *(const bf16x8*)(Ab + row * 128 + (((ks * 2 + hi) ^ ((row >> 1) & 7)) << 4)); }
#pragma unroll
            for (int n = 0; n < 2; ++n) { const int row = wn * 64 + n * 32 + r32; b[n] = *(const bf16x8*)(Bb + row * 128 + (((ks * 2 + hi) ^ ((row >> 1) & 7)) << 4)); }
#pragma unroll
            for (int m = 0; m < 2; ++m)
#pragma unroll
                for (int n = 0; n < 2; ++n) acc[m][n] = __builtin_amdgcn_mfma_f32_32x32x16_bf16(a[m], b[n], acc[m][n], 0, 0, 0);
        }
        if (kt + 1 < nk) SWRITE(buf ^ 1);
        __syncthreads();
    }
#undef GLOAD
#undef SWRITE
    epi(acc, m0 + wm * 64, n0 + wn * 64, r32, hi);
}
struct EpiBf16 {
    bf16_t* C; int ldc; float scale;
    __device__ __forceinline__ void operator()(const f32x16 (&acc)[2][2], int row0, int col0, int r32, int hi) const {
        bf16_t* base = C + (size_t)(row0 + 4 * hi) * ldc + col0 + r32;
#pragma unroll
        for (int m = 0; m < 2; ++m)
#pragma unroll
            for (int r = 0; r < 16; ++r) { bf16_t* p = base + (size_t)(m * 32 + (r & 3) + 8 * (r >> 2)) * ldc;
                p[0] = f2bf(acc[m][0][r] * scale); p[32] = f2bf(acc[m][1][r] * scale);
                asm volatile("" ::: "memory"); }
    }
};

template <int MX> struct ScanCfg;
template <> struct ScanCfg<0> { static constexpr int DK = 32; };
template <> struct ScanCfg<1> { static constexpr int DK = 64; };

constexpr int BP = 72;
typedef float f32x4v __attribute__((ext_vector_type(4)));
__device__ __forceinline__ bf16x8 frag16(const bf16_t* tile, int row0, int k0, int lane) { return *(const bf16x8*)(tile + (row0 + (lane & 15)) * BP + k0 + 8 * (lane >> 4)); }

constexpr int SCAN_TAB_OFF = 128000;
__device__ __forceinline__ void scan_tables(const Ctx& c, int l, char* lds) {
    float* wtab = (float*)(lds + SCAN_TAB_OFF); float* btab = wtab + 2 * 16 * 128; float* lbtab = btab + 2 * 128;
    for (int i = c.tid; i < 2 * 16 * 128; i += 512) wtab[i] = CIN(10)[(size_t)l * 2 * 16 * 128 + i];
    if (c.tid < 256) { btab[c.tid] = CIN(11)[(size_t)l * 256 + c.tid];
        float lb = 0.f; if (l > 0) { const float r0 = CIN(13)[c.tid], r1 = CIN(13)[256 + c.tid]; lb = 1.f / (1.f + __expf(r0 - r1)); }
        lbtab[c.tid] = lb; }
    __syncthreads();
}
template <int MX, bool WANT_Q>
__device__ __forceinline__ void scan_load(const Ctx& c, int l, int b, int h, int cc, int dir, float* qt, float* kt, float* gt, bf16_t* VT, float* tmp, const char* ldsb) {
    constexpr int DK = ScanCfg<MX>::DK, PK = DK + 1;
    const int tid = c.tid;
    const int t = tid >> 3, j0 = (tid & 7) * 8;
    const bf16_t* pr = C_P + (size_t)(b * RPB + cc * 64 + (dir ? 63 - t : t)) * INC;
    const u32x4 vv = *(const u32x4*)(pr + (MX == 0 ? GLA_V : HG_I) + h * 64 + j0);
    if (MX == 0) {
        float* zt = tmp; const float* wt = (const float*)(ldsb + SCAN_TAB_OFF) + dir * 16 * 128 + h * 32; const float* bt = (const float*)(ldsb + SCAN_TAB_OFF) + 2 * 16 * 128 + dir * 128 + h * 32;
        const int j4 = (tid & 7) * 4;
        const u32x2 kv = *(const u32x2*)(pr + GLA_K + h * 32 + j4);
        u32x2 qv = {0u, 0u}; if (WANT_Q) qv = *(const u32x2*)(pr + GLA_Q + h * 32 + j4);
        u32x4 zv = {0u, 0u, 0u, 0u};
        if (tid < 128) zv = *(const u32x4*)(C_P + (size_t)(b * RPB + cc * 64 + (dir ? 63 - (tid >> 1) : (tid >> 1))) * INC + (dir ? GLA_ZB : GLA_ZF) + (tid & 1) * 8);
        if (tid < 128) { float* zp = zt + (tid >> 1) * 16 + (tid & 1) * 8;
#pragma unroll
            for (int q = 0; q < 4; ++q) { zp[2 * q] = bflo(zv[q]); zp[2 * q + 1] = bfhi(zv[q]); } }
        __syncthreads();
#pragma unroll
        for (int e = 0; e < 4; ++e) { const int j = j4 + e;
            float a = bt[j];
#pragma unroll
            for (int k = 0; k < 16; ++k) a += zt[t * 16 + k] * wt[k * 128 + j];
            gt[t * PK + j] = logsigmoid_f(a) * (1.f / 16.f);
            kt[t * PK + j] = (e & 1) ? bfhi(kv[e >> 1]) : bflo(kv[e >> 1]);
            if (WANT_Q) qt[t * PK + j] = ((e & 1) ? bfhi(qv[e >> 1]) : bflo(qv[e >> 1])) * 0.17677669529663687f; }
    } else {
        const u32x4 zv = *(const u32x4*)(pr + (dir ? HG_ZB : HG_ZF) + h * 64 + j0);
        u32x4 qv = {0u, 0u, 0u, 0u}; if (WANT_Q) qv = *(const u32x4*)(pr + HG_Q + h * 64 + j0);
        float lbv[8];
        { const float* lbt = (const float*)(ldsb + SCAN_TAB_OFF) + 2 * 16 * 128 + 2 * 128 + h * 64 + j0;
#pragma unroll
          for (int e = 0; e < 8; ++e) lbv[e] = lbt[e]; }
#pragma unroll
        for (int e = 0; e < 8; ++e) { const int j = j0 + e;
            const float z = fminf(fmaxf((e & 1) ? bfhi(zv[e >> 1]) : bflo(zv[e >> 1]), -80.f), 80.f); const float lb = lbv[e];
            const float ez = __expf(-z), sg = __builtin_amdgcn_rcpf(1.f + ez);
            gt[t * PK + j] = fmaxf(__logf(lb + (1.f - lb) * sg), -69.07755279f);
            kt[t * PK + j] = (1.f - lb) * ez * sg;
            if (WANT_Q) { const float qz = (e & 1) ? bfhi(qv[e >> 1]) : bflo(qv[e >> 1]); qt[t * PK + j] = qz * __builtin_amdgcn_rcpf(1.f + __expf(-qz)); } }
    }
#pragma unroll
    for (int e = 0; e < 8; ++e) VT[(j0 + e) * BP + t] = (bf16_t)((e & 1) ? (vv[e >> 1] >> 16) : (vv[e >> 1] & 0xffffu));
    __syncthreads();
    { float x[DK / 8];
#pragma unroll
        for (int u = 0; u < DK / 8; ++u) x[u] = gt[c.lane * PK + c.wid + 8 * u];
#pragma unroll
        for (int d = 1; d < 64; d <<= 1)
#pragma unroll
            for (int u = 0; u < DK / 8; ++u) { const float y = __shfl_up(x[u], d, 64); if (c.lane >= d) x[u] += y; }
#pragma unroll
        for (int u = 0; u < DK / 8; ++u) gt[c.lane * PK + c.wid + 8 * u] = x[u]; }
    __syncthreads();
}

template <int MX>
__device__ void scanA_item(const Ctx& c, int l, int b, int h, int cc, int dir, char* lds) {
    constexpr int DK = ScanCfg<MX>::DK, PK = DK + 1;
    float* kt = (float*)lds; float* gt = kt + 64 * PK; bf16_t* VT = (bf16_t*)(gt + 64 * PK); bf16_t* KET = VT + 64 * BP; float* tmp = (float*)(KET + 64 * BP);
    scan_load<MX, false>(c, l, b, h, cc, dir, nullptr, kt, gt, VT, tmp, lds);
    const int tid = c.tid, lane = c.lane;
    for (int i = tid; i < 64 * DK; i += 512) { const int s_ = i & 63, k = i >> 6; KET[k * BP + s_] = f2bf(kt[s_ * PK + k] * __expf(gt[63 * PK + k] - gt[s_ * PK + k])); }
    __syncthreads();
    const int ch = (b * 4 + h) * 2 + dir;
    bf16_t* S = (MX == 0 ? C_SG : C_SH) + ((size_t)ch * NCHUNK + cc) * (DK * 64);
    for (int tile = c.wid; tile < (DK / 16) * 4; tile += 8) { const int tk = tile >> 2, tj = tile & 3;
        f32x4v acc = {0.f, 0.f, 0.f, 0.f};
#pragma unroll
        for (int ks = 0; ks < 2; ++ks) acc = __builtin_amdgcn_mfma_f32_16x16x32_bf16(frag16(KET, tk * 16, ks * 32, lane), frag16(VT, tj * 16, ks * 32, lane), acc, 0, 0, 0);
#pragma unroll
        for (int i = 0; i < 4; ++i) S[(tk * 16 + 4 * (lane >> 4) + i) * 64 + tj * 16 + (lane & 15)] = f2bf(acc[i]); }
    if (tid < DK) (MX == 0 ? C_DG : C_DH)[((size_t)ch * NCHUNK + cc) * DK + tid] = __expf(gt[63 * PK + tid]);
    __syncthreads();
}
__device__ void scanB_item(const Ctx& c, int item) {
    const int e = item * 512 + c.tid;
    const bool hg = e >= 65536; const int ee = hg ? e - 65536 : e;
    const int DK = hg ? 64 : 32; const int per = DK * 64;
    const int ch = ee / per, ij = ee % per, i = ij >> 6; const int dir = ch & 1;
    bf16_t* S = (hg ? C_SH : C_SG) + (size_t)ch * NCHUNK * per + ij;
    const float* Dc = (hg ? C_DH : C_DG) + (size_t)ch * NCHUNK * DK + i;
    float st = 0.f;
    for (int n0 = 0; n0 < NCHUNK; n0 += 6) {
        float sv[6], dv[6];
#pragma unroll
        for (int u = 0; u < 6; ++u) { const int n = n0 + u; const int cc = dir ? (n < 4 ? 3 - n : 135 - n) : n; sv[u] = bf2f(S[(size_t)cc * per]); dv[u] = Dc[(size_t)cc * DK]; }
#pragma unroll
        for (int u = 0; u < 6; ++u) { const int n = n0 + u; const int cc = dir ? (n < 4 ? 3 - n : 135 - n) : n; S[(size_t)cc * per] = f2bf(st); st = dv[u] * st + sv[u]; }
    }
}
template <int MX>
__device__ void scanC_item(const Ctx& c, int l, int b, int h, int cc, char* lds) {
    constexpr int DK = ScanCfg<MX>::DK, PK = DK + 1;
    float* qt = (float*)lds; float* kt = qt + 64 * PK; float* gt = kt + 64 * PK; float* ot = gt + 64 * PK;
    bf16_t* VT = (bf16_t*)(ot + 64 * 65); bf16_t* QS = VT + 64 * BP; bf16_t* QG = QS + 64 * BP; bf16_t* KS = QG + 64 * BP;
    bf16_t* SC = KS + 96 * BP; bf16_t* ST = SC + 64 * BP; float* tmp = (float*)(ST + 64 * BP);
    const int tid = c.tid, lane = c.lane;
    for (int dir = 0; dir < 2; ++dir) {
        scan_load<MX, true>(c, l, b, h, cc, dir, qt, kt, gt, VT, tmp, lds);
        const int ch = (b * 4 + h) * 2 + dir;
        const bf16_t* Sg = (MX == 0 ? C_SG : C_SH) + ((size_t)ch * NCHUNK + cc) * (DK * 64);
        if (tid < DK * 8) { const int k = tid >> 3, jb = (tid & 7) * 8; const u32x4 sr = *(const u32x4*)(Sg + tid * 8);
#pragma unroll
            for (int e = 0; e < 8; ++e) ST[(jb + e) * BP + k] = (bf16_t)((e & 1) ? (sr[e >> 1] >> 16) : (sr[e >> 1] & 0xffffu)); }
        for (int i = tid; i < 64 * DK; i += 512) { const int t = i / DK, k = i % DK; const int I = t >> 4;
            const float bt = gt[t * PK + k], qv = qt[t * PK + k], kv = kt[t * PK + k];
            const float Bi = I ? gt[(16 * I - 1) * PK + k] : 0.f;
            QS[t * BP + k] = f2bf(qv * __expf(bt - Bi));
            QG[t * BP + k] = f2bf(qv * __expf(bt));
            if (t < 16) KS[t * BP + k] = f2bf(kv * __expf(gt[15 * PK + k] - bt));
            if (t < 32) KS[(16 + t) * BP + k] = f2bf(kv * __expf(gt[31 * PK + k] - bt));
            if (t < 48) KS[(48 + t) * BP + k] = f2bf(kv * __expf(gt[47 * PK + k] - bt)); }
        { const int blk = tid >> 7, tl = (tid >> 3) & 15, s0 = (tid & 7) * 2; const int t = blk * 16 + tl;
            float a0 = 0.f, a1 = 0.f;
            if (s0 <= tl) { const int sa = blk * 16 + s0, sb = sa + 1;
                for (int k = 0; k < DK; ++k) { const float qv = qt[t * PK + k], bv = gt[t * PK + k];
                    a0 += qv * kt[sa * PK + k] * __expf(fminf(bv - gt[sa * PK + k], 0.f));
                    a1 += qv * kt[sb * PK + k] * __expf(fminf(bv - gt[sb * PK + k], 0.f)); }
                if (s0 + 1 > tl) a1 = 0.f; }
            SC[t * BP + blk * 16 + s0] = f2bf(a0); SC[t * BP + blk * 16 + s0 + 1] = f2bf(a1);
            for (int J = blk + 1; J < 4; ++J) { SC[t * BP + J * 16 + s0] = 0; SC[t * BP + J * 16 + s0 + 1] = 0; } }
        __syncthreads();
        if (c.wid < 6) { const int I = c.wid < 1 ? 1 : (c.wid < 3 ? 2 : 3), J = c.wid < 1 ? 0 : (c.wid < 3 ? c.wid - 1 : c.wid - 3);
            const bf16_t* KSI = KS + (I == 1 ? 0 : (I == 2 ? 16 : 48)) * BP;
            f32x4v acc = {0.f, 0.f, 0.f, 0.f};
#pragma unroll
            for (int ks = 0; ks < DK / 32; ++ks) acc = __builtin_amdgcn_mfma_f32_16x16x32_bf16(frag16(QS, I * 16, ks * 32, lane), frag16(KSI, J * 16, ks * 32, lane), acc, 0, 0, 0);
#pragma unroll
            for (int i = 0; i < 4; ++i) SC[(I * 16 + 4 * (lane >> 4) + i) * BP + J * 16 + (lane & 15)] = f2bf(acc[i]); }
        __syncthreads();
#pragma unroll
        for (int u = 0; u < 2; ++u) { const int tile = c.wid * 2 + u; const int ti = tile >> 2, tj = tile & 3;
            f32x4v acc = {0.f, 0.f, 0.f, 0.f};
#pragma unroll
            for (int ks = 0; ks < 2; ++ks) acc = __builtin_amdgcn_mfma_f32_16x16x32_bf16(frag16(SC, ti * 16, ks * 32, lane), frag16(VT, tj * 16, ks * 32, lane), acc, 0, 0, 0);
#pragma unroll
            for (int ks = 0; ks < DK / 32; ++ks) acc = __builtin_amdgcn_mfma_f32_16x16x32_bf16(frag16(QG, ti * 16, ks * 32, lane), frag16(ST, tj * 16, ks * 32, lane), acc, 0, 0, 0);
#pragma unroll
            for (int i = 0; i < 4; ++i) { const int t = ti * 16 + 4 * (lane >> 4) + i; const int to = dir ? 63 - t : t; float* op = ot + to * 65 + tj * 16 + (lane & 15);
                if (dir == 0) *op = acc[i]; else *op += acc[i]; } }
        __syncthreads();
    }
    { const int t = tid >> 3, j0 = (tid & 7) * 8; float o[8]; float ss = 0.f;
#pragma unroll
        for (int j = 0; j < 8; ++j) { o[j] = ot[t * 65 + j0 + j]; ss += o[j] * o[j]; }
        ss += __shfl_xor(ss, 1, 64); ss += __shfl_xor(ss, 2, 64); ss += __shfl_xor(ss, 4, 64);
        const float rstd = rsqrtf(ss * (1.f / 64.f) + NORM_EPS);
        const int r = b * RPB + cc * 64 + t;
        const float* gn = CIN(MX == 0 ? 12 : 14) + l * 64;
        const u32x4 gp = *(const u32x4*)(C_P + (size_t)r * INC + (MX == 0 ? GLA_R : HG_OG) + h * 64 + j0);
        float y[8];
#pragma unroll
        for (int j = 0; j < 8; ++j) y[j] = o[j] * rstd * gn[j0 + j] * silu_f((j & 1) ? bfhi(gp[j >> 1]) : bflo(gp[j >> 1]));
        u32x4 w = {cvtpk(y[0], y[1]), cvtpk(y[2], y[3]), cvtpk(y[4], y[5]), cvtpk(y[6], y[7])};
        *(u32x4*)(C_HB + (size_t)r * D + MX * 256 + h * 64 + j0) = w; }
    __syncthreads();
}

__device__ __forceinline__ void rope_cs(int pos, int i, float& cs, float& sn) {
    const float freq = __expf(-(float)i * (9.210340371976184f / 8.f));
    const float ang = (float)pos * freq;
    const float n = rintf(ang * 0.15915494309189535f);
    float rr = fmaf(-n, 6.2831854820251465f, ang); rr = fmaf(-n, -1.7484555e-7f, rr);
    cs = __cosf(rr); sn = __sinf(rr);
}

__device__ void ph_prep_rows(const Ctx& c, int l) {
    const float* gq = CIN(15) + l * 192; const float* gkv = CIN(16) + l * 128;
    for (int r = blockIdx.x * 8 + c.wid; r < NR; r += gridDim.x * 8) {
        const int b = r / RPB, j = r - b * RPB; bf16_t* pr = C_P + (size_t)r * INC;
        { float v[3]; float ss = 0.f;
#pragma unroll
            for (int i = 0; i < 3; ++i) { v[i] = bf2f(pr[MLA_CQ + c.lane + 64 * i]); ss += v[i] * v[i]; }
            ss = wave_sum(ss); const float rstd = rsqrtf(ss * (1.f / 192.f) + NORM_EPS);
#pragma unroll
            for (int i = 0; i < 3; ++i) pr[MLA_CQ + c.lane + 64 * i] = f2bf(v[i] * rstd * gq[c.lane + 64 * i]); }
        { float v[2]; float ss = 0.f;
#pragma unroll
            for (int i = 0; i < 2; ++i) { v[i] = bf2f(pr[MLA_CKV + c.lane + 64 * i]); ss += v[i] * v[i]; }
            ss = wave_sum(ss); const float rstd = rsqrtf(ss * (1.f / 128.f) + NORM_EPS);
#pragma unroll
            for (int i = 0; i < 2; ++i) pr[MLA_CKV + c.lane + 64 * i] = f2bf(v[i] * rstd * gkv[c.lane + 64 * i]); }
        if (j >= CTX) { const int t = j - CTX; const int prow = t >> 6, pcol = t & 63;
            for (int pp = c.lane; pp < 34 * 8; pp += 64) { const int g = pp >> 3, i = pp & 7;
                int col; if (g < 16) col = DF_Q + (g >> 1) * 32 + (g & 1) * 16; else if (g < 32) col = DF_K + ((g - 16) >> 1) * 32 + (g & 1) * 16; else col = MLA_KR + (g - 32) * 16;
                float cs, sn; rope_cs((g & 1) ? pcol : prow, i, cs, sn);
                const float x1 = bf2f(pr[col + i]), x2 = bf2f(pr[col + 8 + i]);
                pr[col + i] = f2bf(x1 * cs - x2 * sn); pr[col + 8 + i] = f2bf(x1 * sn + x2 * cs); } }
    }
}
__device__ void ph_rope_q(const Ctx& c) {
    for (int r = blockIdx.x * 8 + c.wid; r < NR; r += gridDim.x * 8) {
        const int b = r / RPB, j = r - b * RPB; if (j < CTX) continue;
        const int t = j - CTX; const int prow = t >> 6, pcol = t & 63;
        const int h = c.lane >> 4, g = (c.lane >> 3) & 1, i = c.lane & 7;
        bf16_t* q = C_QM + (size_t)r * 384 + h * 96 + 64 + g * 16;
        float cs, sn; rope_cs(g ? pcol : prow, i, cs, sn);
        const float x1 = bf2f(q[i]), x2 = bf2f(q[8 + i]);
        q[i] = f2bf(x1 * cs - x2 * sn); q[8 + i] = f2bf(x1 * sn + x2 * cs);
    }
}

__device__ __forceinline__ int v_st(int k, int cidx) { const int kk = (k & ~0xC) | ((k & 4) << 1) | ((k & 8) >> 1); return ((kk >> 3) * 2 + (cidx >> 5)) * 512 + ((kk & 7) * 32 + (cidx & 31)) * 2; }
__device__ __forceinline__ int v_rd_base(int lane) { return ((lane & 3) << 3) | (((lane >> 2) & 3) << 6) | (((lane >> 4) & 1) << 5) | (((lane >> 5) & 1) << 8); }
constexpr int v_rd_off(int d0, int ks, int half) { return d0 * 512 + ks * 2048 + half * 1024; }
template <int OFF> __device__ __forceinline__ s16x4 tr_read(int vb) { s16x4 r; asm volatile("ds_read_b64_tr_b16 %0, %1 offset:%2" : "=&v"(r) : "v"(vb), "i"(OFF) : "memory"); return r; }
template <int D0> __device__ __forceinline__ void pv_one(f32x16& od, int vb, bf16x8 pa0, bf16x8 pa1, bf16x8 pa2, bf16x8 pa3) {
    const s16x4 l0 = tr_read<v_rd_off(D0, 0, 0)>(vb), h0 = tr_read<v_rd_off(D0, 0, 1)>(vb), l1 = tr_read<v_rd_off(D0, 1, 0)>(vb), h1 = tr_read<v_rd_off(D0, 1, 1)>(vb);
    const s16x4 l2 = tr_read<v_rd_off(D0, 2, 0)>(vb), h2 = tr_read<v_rd_off(D0, 2, 1)>(vb), l3 = tr_read<v_rd_off(D0, 3, 0)>(vb), h3 = tr_read<v_rd_off(D0, 3, 1)>(vb);
    asm volatile("s_waitcnt lgkmcnt(0)" ::: "memory"); __builtin_amdgcn_sched_barrier(0);
#define PKV(L, H) (bf16x8){L[0], L[1], L[2], L[3], H[0], H[1], H[2], H[3]}
    od = __builtin_amdgcn_mfma_f32_32x32x16_bf16(pa0, PKV(l0, h0), od, 0, 0, 0);
    od = __builtin_amdgcn_mfma_f32_32x32x16_bf16(pa1, PKV(l1, h1), od, 0, 0, 0);
    od = __builtin_amdgcn_mfma_f32_32x32x16_bf16(pa2, PKV(l2, h2), od, 0, 0, 0);
    od = __builtin_amdgcn_mfma_f32_32x32x16_bf16(pa3, PKV(l3, h3), od, 0, 0, 0);
#undef PKV
}
constexpr float ATT_BIG = 1.0995116e12f;
constexpr float ATT_ZBIG = 1.2379400392853803e27f, ATT_ZSMALL = 8.673617379884035e-19f;
__device__ __forceinline__ float rowmax_tile(const f32x16& p0, const f32x16& p1) {
    float pmax = p0[0];
#pragma unroll
    for (int r = 1; r < 16; ++r) pmax = fmaxf(pmax, p0[r]);
#pragma unroll
    for (int r = 0; r < 16; ++r) pmax = fmaxf(pmax, p1[r]);
    auto rr = __builtin_amdgcn_permlane32_swap(__float_as_uint(pmax), __float_as_uint(pmax), false, false);
    return fmaxf(__uint_as_float(rr[0]), __uint_as_float(rr[1]));
}
__device__ __forceinline__ void softmax_tile(f32x16& p0, f32x16& p1, float& M, const float Mused, float& l_reg, const bool first,
                                             bf16x8& pa0, bf16x8& pa1, bf16x8& pa2, bf16x8& pa3, f32x16 (&o)[2], float* wsl, const int r32, const int hi) {
    if (__builtin_expect(__any(Mused != M), 0)) {
        asm volatile("" ::: "memory");
        const float dM = Mused - M;
#pragma unroll
        for (int r = 0; r < 16; ++r) { p0[r] += dM; p1[r] += dM; }
    }
    if (first) {
        float pmax = p0[0];
#pragma unroll
        for (int r = 1; r < 16; ++r) pmax = fmaxf(pmax, p0[r]);
#pragma unroll
        for (int r = 0; r < 16; ++r) pmax = fmaxf(pmax, p1[r]);
        { auto rr = __builtin_amdgcn_permlane32_swap(__float_as_uint(pmax), __float_as_uint(pmax), false, false); pmax = fmaxf(__uint_as_float(rr[0]), __uint_as_float(rr[1])); }
        M = pmax;
#pragma unroll
        for (int r = 0; r < 16; ++r) { p0[r] -= pmax; p1[r] -= pmax; }
    }
    float ps = 0.f;
#pragma unroll
    for (int r = 0; r < 16; ++r) { p0[r] = __builtin_amdgcn_exp2f(p0[r]); ps += p0[r]; }
#pragma unroll
    for (int r = 0; r < 16; ++r) { p1[r] = __builtin_amdgcn_exp2f(p1[r]); ps += p1[r]; }
    { auto rr = __builtin_amdgcn_permlane32_swap(__float_as_uint(ps), __float_as_uint(ps), false, false); ps = __uint_as_float(rr[0]) + __uint_as_float(rr[1]); }
    if (__builtin_expect(__any(ps > ATT_BIG), 0)) {
        asm volatile("" ::: "memory");
        float pm = p0[0];
#pragma unroll
        for (int r = 1; r < 16; ++r) pm = fmaxf(pm, p0[r]);
#pragma unroll
        for (int r = 0; r < 16; ++r) pm = fmaxf(pm, p1[r]);
        { auto rr = __builtin_amdgcn_permlane32_swap(__float_as_uint(pm), __float_as_uint(pm), false, false); pm = fmaxf(__uint_as_float(rr[0]), __uint_as_float(rr[1])); }
        const float alpha = pm > 1.f ? __builtin_amdgcn_rcpf(pm) : 1.f;
        M -= __builtin_amdgcn_logf(alpha);
#pragma unroll
        for (int r = 0; r < 16; ++r) { p0[r] *= alpha; p1[r] *= alpha; }
        ps *= alpha; l_reg *= alpha;
        if (hi == 0) wsl[r32] = alpha;
        asm volatile("s_waitcnt lgkmcnt(0)" ::: "memory");
#pragma unroll
        for (int r = 0; r < 16; ++r) { const float av = wsl[crow(r, hi)]; o[0][r] *= av; o[1][r] *= av; }
        asm volatile("" ::: "memory");
    }
    l_reg += ps;
#define PK4(P, BASE, OUT) do { unsigned a0 = cvtpk(P[BASE + 0], P[BASE + 1]), a1 = cvtpk(P[BASE + 2], P[BASE + 3]);   \
    unsigned b0 = cvtpk(P[BASE + 4], P[BASE + 5]), b1 = cvtpk(P[BASE + 6], P[BASE + 7]);                              \
    auto r0 = __builtin_amdgcn_permlane32_swap(a0, b0, false, false); auto r1 = __builtin_amdgcn_permlane32_swap(a1, b1, false, false); \
    u32x4 w = {r0[0], r1[0], r0[1], r1[1]}; OUT = *reinterpret_cast<bf16x8*>(&w); } while (0)
    PK4(p0, 0, pa0); PK4(p0, 8, pa1); PK4(p1, 0, pa2); PK4(p1, 8, pa3);
#undef PK4
}

constexpr int ATT_STAGE = 2 * 16384 + 2 * 8192;
constexpr int ATT_LDS = 65536 + 49152 + 8 * 64 * 4 + 16;
template <bool DIFF>
__device__ void attn_item(const Ctx& c, int l, int b, int hd, int qrow0, int krow0, int nkeys, char* lds) {
    constexpr int DQK = DIFF ? 32 : 96, NMAP = DIFF ? 2 : 1, ND0 = DQK / 16, NU = 2 * NMAP;
    constexpr int KP = DIFF ? 64 : 256;
    constexpr int KSZ = 64 * KP;
    constexpr int NKR = DIFF ? 2 : 3;
    const int tid_ = mk_tid(c.wid);
    const int tid = tid_, lane = tid_ & 63, wid = c.wid, r32 = lane & 31, hi = lane >> 5;
    char* K_lds0 = lds; char* V_lds0 = lds + 2 * 16384; float* wsl = (float*)(lds + 2 * ATT_STAGE) + wid * 64;
    const float scale = DIFF ? 0.17677669529663687f : 0.10206207261596575f;
    const float C = scale * 1.4426950408889634f;
    bf16x8 qr[NMAP][ND0];
    { const int qrow = qrow0 + wid * 32 + r32;
#pragma unroll
        for (int m = 0; m < NMAP; ++m)
#pragma unroll
            for (int d0 = 0; d0 < ND0; ++d0) {
                const bf16_t* p = DIFF ? C_P + (size_t)qrow * INC + DF_Q + (hd * 2 + m) * 32 + d0 * 16 + hi * 8
                                       : C_QM + (size_t)qrow * 384 + hd * 96 + d0 * 16 + hi * 8;
                qr[m][d0] = *(const bf16x8*)p; } }
    f32x16 o[NMAP][2]; float m_reg[NMAP], l_reg[NMAP];
#pragma unroll
    for (int m = 0; m < NMAP; ++m) { m_reg[m] = 0.f; l_reg[m] = 0.f;
#pragma unroll
        for (int d = 0; d < 2; ++d) zero_acc(o[m][d]); }
    constexpr int NKP = DIFF ? 2 : 4;
    int ksrc[NKP], vsrc[2];
#pragma unroll
    for (int q = 0; q < NKP; ++q) { const int off = (wid * NKP + q) * 1024 + lane * 16;
        if (DIFF) { const int blk = off >> 12, key = (off & 4095) >> 6, slot = (off & 63) >> 4, ch = slot ^ ((key >> 2) & 3);
            ksrc[q] = ((blk >> 1) * 64 + key) * INC + DF_K + (hd * 2 + (blk & 1)) * 32 + ch * 8; }
        else { const int tile = off >> 14, key = (off & 16383) >> 8, slot = (off & 255) >> 4, ch = slot ^ (key & 15);
            ksrc[q] = ch < 8 ? -1 - ((tile * 64 + key) * 512 + hd * 128 + ch * 8) : (ch < 12 ? (tile * 64 + key) * INC + MLA_KR + (ch - 8) * 8 : (int)0x80000000); } }
#pragma unroll
    for (int q = 0; q < 2; ++q) { const int off = (wid * 2 + q) * 1024 + lane * 16; const int tile = off >> 13, w = off & 8191;
        const int sub = w >> 9, within = w & 511; const int kk = (sub >> 1) * 8 + (within >> 6); const int col = (sub & 1) * 32 + ((within & 63) >> 1);
        const int key = (kk & ~0xC) | ((kk & 4) << 1) | ((kk & 8) >> 1);
        vsrc[q] = DIFF ? (tile * 64 + key) * INC + DF_V + hd * 64 + col : (tile * 64 + key) * 512 + hd * 128 + 64 + col; }
    const int vb0 = (int)(uintptr_t)V_lds0 + v_rd_base(lane);
#define ADMA(buf, kr) do { \
        _Pragma("unroll") for (int q = 0; q < NKP; ++q) { LAS unsigned* dst_ = (LAS unsigned*)(LAS char*)(K_lds0 + (buf) * ATT_STAGE + (wid * NKP + q) * 1024); \
            if (DIFF || ksrc[q] >= 0) __builtin_amdgcn_global_load_lds((const unsigned*)(C_P + (size_t)(kr) * INC + ksrc[q]), dst_, 16, 0, 0); \
            else if (ksrc[q] != (int)0x80000000) __builtin_amdgcn_global_load_lds((const unsigned*)(C_KVM + (size_t)(kr) * 512 + (-1 - ksrc[q])), dst_, 16, 0, 0); } \
        _Pragma("unroll") for (int q = 0; q < 2; ++q) { LAS unsigned* dst_ = (LAS unsigned*)(LAS char*)(V_lds0 + (buf) * ATT_STAGE + (wid * 2 + q) * 1024); \
            __builtin_amdgcn_global_load_lds((const unsigned*)((DIFF ? C_P + (size_t)(kr) * INC : C_KVM + (size_t)(kr) * 512) + vsrc[q]), dst_, 16, 0, 0); } } while (0)
    const int NS = nkeys >> 7;
    ADMA(0, krow0);
    for (int j = 0; j < NS; ++j) {
        asm volatile("s_waitcnt vmcnt(0)" ::: "memory");
        __syncthreads();
        if (j + 1 < NS) ADMA((j + 1) & 1, krow0 + (j + 1) * 128);
        const char* K_lds = K_lds0 + (j & 1) * ATT_STAGE; const int vb = vb0 + (j & 1) * ATT_STAGE;
        f32x16 p0[2], p1[2]; float mused[2];
#define QKT(u) do { constexpr int tt_ = (u) / NMAP, m_ = (u) % NMAP; const char* Kb = K_lds + (tt_ * NMAP + m_) * KSZ; \
            _Pragma("unroll") for (int d0 = 0; d0 < ND0; ++d0) { bf16x8 b0, b1; \
                if (DIFF) { const int ch = d0 * 2 + hi; const int ra = r32, rb = 32 + r32; \
                    b0 = *(const bf16x8*)(Kb + ra * 64 + ((ch ^ ((ra >> 2) & 3)) << 4)); b1 = *(const bf16x8*)(Kb + rb * 64 + ((ch ^ ((rb >> 2) & 3)) << 4)); } \
                else { const int cb = d0 * 32 + hi * 16; const int ra = r32, rb = 32 + r32; \
                    b0 = *(const bf16x8*)(Kb + ra * 256 + (cb ^ ((ra & 15) << 4))); b1 = *(const bf16x8*)(Kb + rb * 256 + (cb ^ ((rb & 15) << 4))); } \
                if (d0 == 0) { const float nm_ = -m_reg[m_]; mused[(u) & 1] = m_reg[m_]; const f32x16 z = {nm_,nm_,nm_,nm_,nm_,nm_,nm_,nm_,nm_,nm_,nm_,nm_,nm_,nm_,nm_,nm_}; \
                    p0[(u) & 1] = __builtin_amdgcn_mfma_f32_32x32x16_bf16(b0, qr[m_][0], z, 0, 0, 0); p1[(u) & 1] = __builtin_amdgcn_mfma_f32_32x32x16_bf16(b1, qr[m_][0], z, 0, 0, 0); \
                    asm volatile("" :: "v"(b0), "v"(b1));   } \
                else { p0[(u) & 1] = __builtin_amdgcn_mfma_f32_32x32x16_bf16(b0, qr[m_][d0], p0[(u) & 1], 0, 0, 0); p1[(u) & 1] = __builtin_amdgcn_mfma_f32_32x32x16_bf16(b1, qr[m_][d0], p1[(u) & 1], 0, 0, 0); } } \
            if (!DIFF) {   \
                __builtin_amdgcn_sched_group_barrier(0x100, 4, 0); \
                _Pragma("unroll") for (int g_ = 0; g_ < 4; ++g_) { __builtin_amdgcn_sched_group_barrier(0x8, 2, 0); __builtin_amdgcn_sched_group_barrier(0x100, 2, 0); } \
                __builtin_amdgcn_sched_group_barrier(0x8, 4, 0); } } while (0)
        QKT(0);
#pragma unroll
        for (int u = 0; u < NU; ++u) {
            const int tt = u / NMAP, m = u % NMAP;
            if (u + 1 < NU) { if (u == 0) QKT(1); else if (u == 1) QKT(2); else QKT(3); }
            bf16x8 pa0, pa1, pa2, pa3;
            softmax_tile(p0[u & 1], p1[u & 1], m_reg[m], mused[u & 1], l_reg[m], (j == 0) && (tt == 0), pa0, pa1, pa2, pa3, o[m], wsl, r32, hi);
            pv_one<0>(o[m][0], vb + tt * 8192, pa0, pa1, pa2, pa3);
            pv_one<1>(o[m][1], vb + tt * 8192, pa0, pa1, pa2, pa3);
        }
#undef QKT
    }
#undef ADMA
    float rli[NMAP][16];
#pragma unroll
    for (int m = 0; m < NMAP; ++m) {
        asm volatile("s_waitcnt lgkmcnt(0)" ::: "memory");
        if (hi == 0) wsl[r32] = l_reg[m];
        asm volatile("s_waitcnt lgkmcnt(0)" ::: "memory");
#pragma unroll
        for (int r = 0; r < 16; ++r) rli[m][r] = __builtin_amdgcn_rcpf(wsl[crow(r, hi)]);
    }
    const int orow0 = qrow0 + wid * 32;
    if (!DIFF) {
#pragma unroll
        for (int r = 0; r < 16; ++r) { bf16_t* dst = C_HB + (size_t)(orow0 + crow(r, hi)) * D + 512 + hd * 64 + r32;
            dst[0] = f2bf(o[0][0][r] * rli[0][r]); dst[32] = f2bf(o[0][1][r] * rli[0][r]); }
    } else {
        const float* lp = CIN(19) + l * 128; const float* gn = CIN(20) + l * 64; asm volatile("" : "+s"(lp), "+s"(gn));
        float s1 = lp[r32] * lp[32 + r32], s2 = lp[64 + r32] * lp[96 + r32];
#pragma unroll
        for (int o = 1; o < 32; o <<= 1) { s1 += shx(s1, o, lane); s2 += shx(s2, o, lane); }
        const float lam_init = (l == 0) ? 0.2f : 0.35550906759097f;
        const float lam = __expf(s1) - __expf(s2) + lam_init;
        const float g0 = gn[r32] * (1.f - lam_init), g1 = gn[32 + r32] * (1.f - lam_init);
#pragma unroll
        for (int r = 0; r < 16; ++r) {
            const float v0 = o[0][0][r] * rli[0][r] - lam * o[NMAP - 1][0][r] * rli[NMAP - 1][r];
            const float v1 = o[0][1][r] * rli[0][r] - lam * o[NMAP - 1][1][r] * rli[NMAP - 1][r];
            float ss = v0 * v0 + v1 * v1;
            ss += shx(ss, 1, lane); ss += shx(ss, 2, lane); ss += shx(ss, 4, lane); ss += shx(ss, 8, lane); ss += shx(ss, 16, lane);
            const float rstd = rsqrtf(ss * (1.f / 64.f) + NORM_EPS);
            bf16_t* dst = C_HB + (size_t)(orow0 + crow(r, hi)) * D + 768 + hd * 64 + r32;
            dst[0] = f2bf(v0 * rstd * g0); dst[32] = f2bf(v1 * rstd * g1); }
    }
    __syncthreads();
}
template <bool DIFF>
__device__ bool attn_item_pair(const Ctx& c, int l, int b, int hd, int qrow0, int krow0, int nkeys, char* lds) {
    constexpr int DQK = DIFF ? 32 : 96, NMAP = DIFF ? 2 : 1, ND0 = DQK / 16, NU = 2 * NMAP;
    constexpr int KP = DIFF ? 64 : 256;
    constexpr int KSZ = 64 * KP;
    constexpr int NKR = DIFF ? 2 : 3;
    const int tid_ = mk_tid(c.wid);
    const int tid = tid_, lane = tid_ & 63, wid = c.wid, r32 = lane & 31, hi = lane >> 5;
    char* K_lds0 = lds; char* V_lds0 = lds + 65536; float* wsl = (float*)(lds + 65536 + 49152) + wid * 64;
    const float scale = DIFF ? 0.17677669529663687f : 0.10206207261596575f;
    const float C = scale * 1.4426950408889634f;
    bf16x8 qr[NMAP][ND0];
    { const int qrow = qrow0 + wid * 32 + r32;
#pragma unroll
        for (int m = 0; m < NMAP; ++m)
#pragma unroll
            for (int d0 = 0; d0 < ND0; ++d0) {
                const bf16_t* p = DIFF ? C_P + (size_t)qrow * INC + DF_Q + (hd * 2 + m) * 32 + d0 * 16 + hi * 8
                                       : C_QM + (size_t)qrow * 384 + hd * 96 + d0 * 16 + hi * 8;
                qr[m][d0] = *(const bf16x8*)p; } }
    f32x16 o[NMAP][2]; float m_reg[NMAP], l_reg[NMAP];
#pragma unroll
    for (int m = 0; m < NMAP; ++m) { m_reg[m] = 0.f; l_reg[m] = 0.f;
#pragma unroll
        for (int d = 0; d < 2; ++d) zero_acc(o[m][d]); }
    constexpr int NKP = DIFF ? 2 : 4;
    int ksrc[NKP], vsrc[2];
#pragma unroll
    for (int q = 0; q < NKP; ++q) { const int off = (wid * NKP + q) * 1024 + lane * 16;
        if (DIFF) { const int blk = off >> 12, key = (off & 4095) >> 6, slot = (off & 63) >> 4, ch = slot ^ ((key >> 2) & 3);
            ksrc[q] = ((blk >> 1) * 64 + key) * INC + DF_K + (hd * 2 + (blk & 1)) * 32 + ch * 8; }
        else { const int tile = off >> 14, key = (off & 16383) >> 8, slot = (off & 255) >> 4, ch = slot ^ (key & 15);
            ksrc[q] = ch < 8 ? -1 - ((tile * 64 + key) * 512 + hd * 128 + ch * 8) : (ch < 12 ? (tile * 64 + key) * INC + MLA_KR + (ch - 8) * 8 : (int)0x80000000); } }
#pragma unroll
    for (int q = 0; q < 2; ++q) { const int off = (wid * 2 + q) * 1024 + lane * 16; const int tile = off >> 13, w = off & 8191;
        const int sub = w >> 9, within = w & 511; const int kk = (sub >> 1) * 8 + (within >> 6); const int col = (sub & 1) * 32 + ((within & 63) >> 1);
        const int key = kk;
        vsrc[q] = DIFF ? (tile * 64 + key) * INC + DF_V + hd * 64 + col : (tile * 64 + key) * 512 + hd * 128 + 64 + col; }
    const int vb0 = (int)(uintptr_t)V_lds0 + v_rd_base(lane);
    unsigned kbo[NKP], vbo[2];
#pragma unroll
    for (int q = 0; q < NKP; ++q) kbo[q] = (DIFF || ksrc[q] >= 0) ? (unsigned)ksrc[q] * 2u : (unsigned)(-1 - ksrc[q]) * 2u;
#pragma unroll
    for (int q = 0; q < 2; ++q) vbo[q] = (unsigned)vsrc[q] * 2u;
#define ADMA(kbuf, vbuf, kr) do { const char* pb_ = (const char*)C_P + (size_t)(kr) * (INC * 2); const char* kb_ = (const char*)C_KVM + (size_t)(kr) * 1024; asm volatile("" : "+s"(pb_), "+s"(kb_)); \
        _Pragma("unroll") for (int q = 0; q < NKP; ++q) { LAS unsigned* dst_ = (LAS unsigned*)(LAS char*)(K_lds0 + (kbuf) * 32768 + (wid * NKP + q) * 1024); \
            unsigned o_ = kbo[q]; asm volatile("" : "+v"(o_));     \
            if (DIFF || ksrc[q] >= 0) __builtin_amdgcn_global_load_lds((const unsigned*)(pb_ + (size_t)o_), dst_, 16, 0, 0); \
            else if (ksrc[q] != (int)0x80000000) __builtin_amdgcn_global_load_lds((const unsigned*)(kb_ + (size_t)o_), dst_, 16, 0, 0); } \
        _Pragma("unroll") for (int q = 0; q < 2; ++q) { LAS unsigned* dst_ = (LAS unsigned*)(LAS char*)(V_lds0 + (vbuf) * 16384 + (wid * 2 + q) * 1024); \
            unsigned o_ = vbo[q]; asm volatile("" : "+v"(o_)); \
            __builtin_amdgcn_global_load_lds((const unsigned*)((DIFF ? pb_ : kb_) + (size_t)o_), dst_, 16, 0, 0); } } while (0)
    f32x16 oB[2];
    if (!DIFF) { zero_acc(oB[0]); zero_acc(oB[1]); }
    float lB = 0.f;
    const int NS = nkeys >> 7;
    ADMA(0, 0, krow0);
    const bool late = wid >= 4;
    if (!late) __builtin_amdgcn_s_setprio(1);
    bf16x8 pa[4], pb[4];
    int vslot = 0, vbp = 0;
    for (int j = 0; j < NS; ++j) {
        asm volatile("s_waitcnt vmcnt(0)" ::: "memory");
        __syncthreads();
        const int vnext = (vslot == 2) ? 0 : vslot + 1;
        if (j + 1 < NS) ADMA((j + 1) & 1, vnext, krow0 + (j + 1) * 128);
        const char* K_lds = K_lds0 + (j & 1) * 32768; const int vb = vb0 + vslot * 16384;
#define KFR(tt, m, d0, h) (*(const bf16x8*)(K_lds + ((tt) * NMAP + (m)) * KSZ + \
            (DIFF ? (((h) * 32 + r32) * 64 + ((((d0) * 2 + hi) ^ ((((h) * 32 + r32) >> 2) & 3)) << 4)) : (((h) * 32 + r32) * 256 + (((d0) * 32 + hi * 16) ^ ((((h) * 32 + r32) & 15) << 4))))))
#define PKV(L, H) (bf16x8){L[0], L[1], L[2], L[3], H[0], H[1], H[2], H[3]}
#define PVB(D0B, VB, TA, TB) { const int va_ = (VB) + (TA) * 8192, vbb_ = (VB) + (TB) * 8192; f32x16& accA = o[0][D0B]; f32x16& accB = DIFF ? o[NMAP - 1][D0B] : oB[D0B]; \
              const s16x4 l0 = tr_read<v_rd_off(D0B, 0, 0)>(va_), h0 = tr_read<v_rd_off(D0B, 0, 1)>(va_), l1 = tr_read<v_rd_off(D0B, 1, 0)>(va_), h1 = tr_read<v_rd_off(D0B, 1, 1)>(va_); \
              const s16x4 l2 = tr_read<v_rd_off(D0B, 2, 0)>(va_), h2 = tr_read<v_rd_off(D0B, 2, 1)>(va_), l3 = tr_read<v_rd_off(D0B, 3, 0)>(va_), h3 = tr_read<v_rd_off(D0B, 3, 1)>(va_); \
              if (DIFF) { asm volatile("s_waitcnt lgkmcnt(0)" ::: "memory"); __builtin_amdgcn_sched_barrier(0); \
                  accA = __builtin_amdgcn_mfma_f32_32x32x16_bf16(pa[0], PKV(l0, h0), accA, 0, 0, 0); accB = __builtin_amdgcn_mfma_f32_32x32x16_bf16(pb[0], PKV(l0, h0), accB, 0, 0, 0); \
                  accA = __builtin_amdgcn_mfma_f32_32x32x16_bf16(pa[1], PKV(l1, h1), accA, 0, 0, 0); accB = __builtin_amdgcn_mfma_f32_32x32x16_bf16(pb[1], PKV(l1, h1), accB, 0, 0, 0); \
                  accA = __builtin_amdgcn_mfma_f32_32x32x16_bf16(pa[2], PKV(l2, h2), accA, 0, 0, 0); accB = __builtin_amdgcn_mfma_f32_32x32x16_bf16(pb[2], PKV(l2, h2), accB, 0, 0, 0); \
                  accA = __builtin_amdgcn_mfma_f32_32x32x16_bf16(pa[3], PKV(l3, h3), accA, 0, 0, 0); accB = __builtin_amdgcn_mfma_f32_32x32x16_bf16(pb[3], PKV(l3, h3), accB, 0, 0, 0); } \
              else { const s16x4 m0 = tr_read<v_rd_off(D0B, 0, 0)>(vbb_), n0 = tr_read<v_rd_off(D0B, 0, 1)>(vbb_), m1 = tr_read<v_rd_off(D0B, 1, 0)>(vbb_), n1 = tr_read<v_rd_off(D0B, 1, 1)>(vbb_); \
                  const s16x4 m2 = tr_read<v_rd_off(D0B, 2, 0)>(vbb_), n2 = tr_read<v_rd_off(D0B, 2, 1)>(vbb_), m3 = tr_read<v_rd_off(D0B, 3, 0)>(vbb_), n3 = tr_read<v_rd_off(D0B, 3, 1)>(vbb_); \
                  asm volatile("s_waitcnt lgkmcnt(0)" ::: "memory"); __builtin_amdgcn_sched_barrier(0); \
                  accA = __builtin_amdgcn_mfma_f32_32x32x16_bf16(pa[0], PKV(l0, h0), accA, 0, 0, 0); accB = __builtin_amdgcn_mfma_f32_32x32x16_bf16(pb[0], PKV(m0, n0), accB, 0, 0, 0); \
                  accA = __builtin_amdgcn_mfma_f32_32x32x16_bf16(pa[1], PKV(l1, h1), accA, 0, 0, 0); accB = __builtin_amdgcn_mfma_f32_32x32x16_bf16(pb[1], PKV(m1, n1), accB, 0, 0, 0); \
                  accA = __builtin_amdgcn_mfma_f32_32x32x16_bf16(pa[2], PKV(l2, h2), accA, 0, 0, 0); accB = __builtin_amdgcn_mfma_f32_32x32x16_bf16(pb[2], PKV(m2, n2), accB, 0, 0, 0); \
                  accA = __builtin_amdgcn_mfma_f32_32x32x16_bf16(pa[3], PKV(l3, h3), accA, 0, 0, 0); accB = __builtin_amdgcn_mfma_f32_32x32x16_bf16(pb[3], PKV(m3, n3), accB, 0, 0, 0); } }
        constexpr int NPI = DIFF ? 2 : 1, TLA = DIFF ? 1 : 0, TLB = 1;
        constexpr int NG = ND0 / 2;
#define KGRP(F, g, TA, TB) do { F[0] = KFR(TA, 0, 2 * (g), 0); F[1] = KFR(TB, NMAP - 1, 2 * (g), 0); F[2] = KFR(TA, 0, 2 * (g), 1); F[3] = KFR(TB, NMAP - 1, 2 * (g), 1); \
            F[4] = KFR(TA, 0, 2 * (g) + 1, 0); F[5] = KFR(TB, NMAP - 1, 2 * (g) + 1, 0); F[6] = KFR(TA, 0, 2 * (g) + 1, 1); F[7] = KFR(TB, NMAP - 1, 2 * (g) + 1, 1); } while (0)
#define QGRP(F, g) do { \
            if ((g) == 0) { const f32x16 z_ = {0.f,0.f,0.f,0.f,0.f,0.f,0.f,0.f,0.f,0.f,0.f,0.f,0.f,0.f,0.f,0.f};     \
                a0 = __builtin_amdgcn_mfma_f32_32x32x16_bf16(F[0], qr[0][0], z_, 0, 0, 0); b0 = __builtin_amdgcn_mfma_f32_32x32x16_bf16(F[1], qr[NMAP - 1][0], z_, 0, 0, 0); \
                a1 = __builtin_amdgcn_mfma_f32_32x32x16_bf16(F[2], qr[0][0], z_, 0, 0, 0); b1 = __builtin_amdgcn_mfma_f32_32x32x16_bf16(F[3], qr[NMAP - 1][0], z_, 0, 0, 0); } \
            else { a0 = __builtin_amdgcn_mfma_f32_32x32x16_bf16(F[0], qr[0][2 * (g)], a0, 0, 0, 0); b0 = __builtin_amdgcn_mfma_f32_32x32x16_bf16(F[1], qr[NMAP - 1][2 * (g)], b0, 0, 0, 0); \
                a1 = __builtin_amdgcn_mfma_f32_32x32x16_bf16(F[2], qr[0][2 * (g)], a1, 0, 0, 0); b1 = __builtin_amdgcn_mfma_f32_32x32x16_bf16(F[3], qr[NMAP - 1][2 * (g)], b1, 0, 0, 0); } \
            a0 = __builtin_amdgcn_mfma_f32_32x32x16_bf16(F[4], qr[0][2 * (g) + 1], a0, 0, 0, 0); b0 = __builtin_amdgcn_mfma_f32_32x32x16_bf16(F[5], qr[NMAP - 1][2 * (g) + 1], b0, 0, 0, 0); \
            a1 = __builtin_amdgcn_mfma_f32_32x32x16_bf16(F[6], qr[0][2 * (g) + 1], a1, 0, 0, 0); b1 = __builtin_amdgcn_mfma_f32_32x32x16_bf16(F[7], qr[NMAP - 1][2 * (g) + 1], b1, 0, 0, 0); } while (0)
        bf16x8 kf0[8], kf1[8];
        KGRP(kf0, 0, 0, (DIFF ? 0 : 1)); if (NG > 1) KGRP(kf1, 1, 0, (DIFF ? 0 : 1));
        __builtin_amdgcn_sched_barrier(0);
        if (late && j > 0) { PVB(0, vbp, TLA, TLB) PVB(1, vbp, TLA, TLB) }
#pragma unroll
        for (int pi = 0; pi < NPI; ++pi) {
            const int tA = DIFF ? pi : 0, tB = DIFF ? pi : 1; constexpr int mA = 0, mB = NMAP - 1;
            f32x16 a0, a1, b0, b1;
            __builtin_amdgcn_sched_barrier(0);
            QGRP(kf0, 0);
            if (NG > 1) { __builtin_amdgcn_sched_barrier(0); KGRP(kf0, 2, tA, tB); __builtin_amdgcn_sched_barrier(0); QGRP(kf1, 1); QGRP(kf0, 2); }
            float psA = 0.f, psB = 0.f;
#pragma unroll
            for (int r = 0; r < 16; ++r) { a0[r] = __builtin_amdgcn_exp2f(a0[r]); b0[r] = __builtin_amdgcn_exp2f(b0[r]); psA += a0[r]; psB += b0[r]; }
#pragma unroll
            for (int r = 0; r < 16; ++r) { a1[r] = __builtin_amdgcn_exp2f(a1[r]); b1[r] = __builtin_amdgcn_exp2f(b1[r]); psA += a1[r]; psB += b1[r]; }
            { auto rr = __builtin_amdgcn_permlane32_swap(__float_as_uint(psA), __float_as_uint(psA), false, false); psA = __uint_as_float(rr[0]) + __uint_as_float(rr[1]); }
            { auto rr = __builtin_amdgcn_permlane32_swap(__float_as_uint(psB), __float_as_uint(psB), false, false); psB = __uint_as_float(rr[0]) + __uint_as_float(rr[1]); }
            l_reg[mA] += psA; if (DIFF) l_reg[mB] += psB; else lB += psB;
#define PK4(P, BASE, OUT) do { u32x4 w = {cvtpk(P[BASE + 0], P[BASE + 1]), cvtpk(P[BASE + 2], P[BASE + 3]), cvtpk(P[BASE + 4], P[BASE + 5]), cvtpk(P[BASE + 6], P[BASE + 7])}; \
    OUT = *reinterpret_cast<bf16x8*>(&w); } while (0)
            PK4(a0, 0, pa[0]); PK4(b0, 0, pb[0]); PK4(a0, 8, pa[1]); PK4(b0, 8, pb[1]); PK4(a1, 0, pa[2]); PK4(b1, 0, pb[2]); PK4(a1, 8, pa[3]); PK4(b1, 8, pb[3]);
#undef PK4
            if (pi + 1 < NPI) { KGRP(kf0, 0, pi + 1, pi + 1); }
            if (!(late && pi == NPI - 1)) { PVB(0, vb, tA, tB) PVB(1, vb, tA, tB) }
        }
#undef KFR
#undef KGRP
#undef QGRP
        vbp = vb; vslot = vnext;
        if (j + 1 == NS && late) { PVB(0, vbp, TLA, TLB) PVB(1, vbp, TLA, TLB) }
    }
#undef PVB
#undef PKV
#undef ADMA
    __builtin_amdgcn_s_setprio(0);
    if (!DIFF) {
#pragma unroll
        for (int d = 0; d < 2; ++d)
#pragma unroll
            for (int r = 0; r < 16; ++r) o[0][d][r] += oB[d][r];
        l_reg[0] += lB; }
    float rli[NMAP][16];
#pragma unroll
    for (int m = 0; m < NMAP; ++m) {
        asm volatile("s_waitcnt lgkmcnt(0)" ::: "memory");
        if (hi == 0) wsl[r32] = l_reg[m];
        asm volatile("s_waitcnt lgkmcnt(0)" ::: "memory");
#pragma unroll
        for (int r = 0; r < 16; ++r) rli[m][r] = __builtin_amdgcn_rcpf(wsl[crow(r, hi)]);
    }
    const int orow0 = qrow0 + wid * 32;
    if (!DIFF) {
#pragma unroll
        for (int r = 0; r < 16; ++r) { bf16_t* dst = C_HB + (size_t)(orow0 + crow(r, hi)) * D + 512 + hd * 64 + r32;
            dst[0] = f2bf(o[0][0][r] * rli[0][r]); dst[32] = f2bf(o[0][1][r] * rli[0][r]); }
    } else {
        const float* lp = CIN(19) + l * 128; const float* gn = CIN(20) + l * 64; asm volatile("" : "+s"(lp), "+s"(gn));
        float s1 = lp[r32] * lp[32 + r32], s2 = lp[64 + r32] * lp[96 + r32];
#pragma unroll
        for (int o = 1; o < 32; o <<= 1) { s1 += shx(s1, o, lane); s2 += shx(s2, o, lane); }
        const float lam_init = (l == 0) ? 0.2f : 0.35550906759097f;
        const float lam = __expf(s1) - __expf(s2) + lam_init;
        const float g0 = gn[r32] * (1.f - lam_init), g1 = gn[32 + r32] * (1.f - lam_init);
#pragma unroll
        for (int r = 0; r < 16; ++r) {
            const float v0 = o[0][0][r] * rli[0][r] - lam * o[NMAP - 1][0][r] * rli[NMAP - 1][r];
            const float v1 = o[0][1][r] * rli[0][r] - lam * o[NMAP - 1][1][r] * rli[NMAP - 1][r];
            float ss = v0 * v0 + v1 * v1;
            ss += shx(ss, 1, lane); ss += shx(ss, 2, lane); ss += shx(ss, 4, lane); ss += shx(ss, 8, lane); ss += shx(ss, 16, lane);
            const float rstd = rsqrtf(ss * (1.f / 64.f) + NORM_EPS);
            bf16_t* dst = C_HB + (size_t)(orow0 + crow(r, hi)) * D + 768 + hd * 64 + r32;
            dst[0] = f2bf(v0 * rstd * g0); dst[32] = f2bf(v1 * rstd * g1); }
    }
    int* flag = (int*)(lds + 65536 + 49152 + 8 * 64 * 4);
    __syncthreads();
    if (tid == 0) *flag = 0;
    __syncthreads();
    if (!(l_reg[0] <= ATT_ZBIG && l_reg[0] >= ATT_ZSMALL) || !(l_reg[NMAP - 1] <= ATT_ZBIG && l_reg[NMAP - 1] >= ATT_ZSMALL)) *flag = 1;
    __syncthreads();
    const bool redo = *flag != 0;
    __syncthreads();
    return redo;
}
template <int G, int I>
__device__ __forceinline__ void att_microop(f32x16& p0, f32x16& p1, float& ps, bf16x8 (&pa)[4]) {
    f32x16& P = (G < 2) ? p0 : p1; constexpr int B = (G & 1) * 8;
    if constexpr (I < 4) { constexpr int r = B + 2 * I;
        P[r] = __builtin_amdgcn_exp2f(P[r]); P[r + 1] = __builtin_amdgcn_exp2f(P[r + 1]); ps += P[r]; ps += P[r + 1]; }
    else { const unsigned a0 = cvtpk(P[B + 0], P[B + 1]), a1 = cvtpk(P[B + 2], P[B + 3]), b0 = cvtpk(P[B + 4], P[B + 5]), b1 = cvtpk(P[B + 6], P[B + 7]);
        auto r0 = __builtin_amdgcn_permlane32_swap(a0, b0, false, false); auto r1 = __builtin_amdgcn_permlane32_swap(a1, b1, false, false);
        u32x4 w = {r0[0], r1[0], r0[1], r1[1]}; pa[G] = *reinterpret_cast<bf16x8*>(&w); }
}
template <int GB, int S, int NSL>
__device__ __forceinline__ void att_slot_ops(f32x16& p0, f32x16& p1, float& ps, bf16x8 (&pa)[4]) {
#define MOP(m) if constexpr (((m) * NSL) / 10 == S) att_microop<GB + (m) / 5, (m) % 5>(p0, p1, ps, pa);
    MOP(0) MOP(1) MOP(2) MOP(3) MOP(4) MOP(5) MOP(6) MOP(7) MOP(8) MOP(9)
#undef MOP
}
template <bool DIFF>
__device__ bool attn_item_fast(const Ctx& c, int l, int b, int hd, int qrow0, int krow0, int nkeys, char* lds) {
    constexpr int DQK = DIFF ? 32 : 96, NMAP = DIFF ? 2 : 1, ND0 = DQK / 16, NU = 2 * NMAP, NA = 2 * ND0;
    constexpr int KP = DIFF ? 64 : 256, KSZ = 64 * KP;
    const int tid_ = mk_tid(c.wid);
    const int tid = tid_, lane = tid_ & 63, wid = c.wid, r32 = lane & 31, hi = lane >> 5;
    char* K_lds0 = lds; char* V_lds0 = lds + 2 * 16384; float* wsl = (float*)(lds + 2 * ATT_STAGE) + wid * 64;
    bf16x8 qr[NMAP][ND0];
    { const int qrow = qrow0 + wid * 32 + r32;
#pragma unroll
        for (int m = 0; m < NMAP; ++m)
#pragma unroll
            for (int d0 = 0; d0 < ND0; ++d0) {
                const bf16_t* p = DIFF ? C_P + (size_t)qrow * INC + DF_Q + (hd * 2 + m) * 32 + d0 * 16 + hi * 8
                                       : C_QM + (size_t)qrow * 384 + hd * 96 + d0 * 16 + hi * 8;
                qr[m][d0] = *(const bf16x8*)p; } }
    f32x16 o[NMAP][2]; float m_reg[NMAP], l_reg[NMAP];
#pragma unroll
    for (int m = 0; m < NMAP; ++m) { m_reg[m] = 0.f; l_reg[m] = 0.f;
#pragma unroll
        for (int d = 0; d < 2; ++d) zero_acc(o[m][d]); }
    constexpr int NKP = DIFF ? 2 : 4;
    int ksrc[NKP], vsrc[2];
#pragma unroll
    for (int q = 0; q < NKP; ++q) { const int off = (wid * NKP + q) * 1024 + lane * 16;
        if (DIFF) { const int blk = off >> 12, key = (off & 4095) >> 6, slot = (off & 63) >> 4, ch = slot ^ ((key >> 2) & 3);
            ksrc[q] = ((blk >> 1) * 64 + key) * INC + DF_K + (hd * 2 + (blk & 1)) * 32 + ch * 8; }
        else { const int tile = off >> 14, key = (off & 16383) >> 8, slot = (off & 255) >> 4, ch = slot ^ (key & 15);
            ksrc[q] = ch < 8 ? -1 - ((tile * 64 + key) * 512 + hd * 128 + ch * 8) : (ch < 12 ? (tile * 64 + key) * INC + MLA_KR + (ch - 8) * 8 : (int)0x80000000); } }
#pragma unroll
    for (int q = 0; q < 2; ++q) { const int off = (wid * 2 + q) * 1024 + lane * 16; const int tile = off >> 13, w = off & 8191;
        const int sub = w >> 9, within = w & 511; const int kk = (sub >> 1) * 8 + (within >> 6); const int col = (sub & 1) * 32 + ((within & 63) >> 1);
        const int key = (kk & ~0xC) | ((kk & 4) << 1) | ((kk & 8) >> 1);
        vsrc[q] = DIFF ? (tile * 64 + key) * INC + DF_V + hd * 64 + col : (tile * 64 + key) * 512 + hd * 128 + 64 + col; }
    const int vb0 = (int)(uintptr_t)V_lds0 + v_rd_base(lane);
#define ADMA(buf, kr) do { \
        _Pragma("unroll") for (int q = 0; q < NKP; ++q) { LAS unsigned* dst_ = (LAS unsigned*)(LAS char*)(K_lds0 + (buf) * ATT_STAGE + (wid * NKP + q) * 1024); \
            if (DIFF || ksrc[q] >= 0) __builtin_amdgcn_global_load_lds((const unsigned*)(C_P + (size_t)(kr) * INC + ksrc[q]), dst_, 16, 0, 0); \
            else if (ksrc[q] != (int)0x80000000) __builtin_amdgcn_global_load_lds((const unsigned*)(C_KVM + (size_t)(kr) * 512 + (-1 - ksrc[q])), dst_, 16, 0, 0); } \
        _Pragma("unroll") for (int q = 0; q < 2; ++q) { LAS unsigned* dst_ = (LAS unsigned*)(LAS char*)(V_lds0 + (buf) * ATT_STAGE + (wid * 2 + q) * 1024); \
            __builtin_amdgcn_global_load_lds((const unsigned*)((DIFF ? C_P + (size_t)(kr) * INC : C_KVM + (size_t)(kr) * 512) + vsrc[q]), dst_, 16, 0, 0); } } while (0)
#define SB() __builtin_amdgcn_sched_barrier(0)
    const int NS = nkeys >> 7;
    ADMA(0, krow0);
    float bad = 0.f;
    for (int j = 0; j < NS; ++j) {
        asm volatile("s_waitcnt vmcnt(0)" ::: "memory");
        __syncthreads();
        if (j + 1 < NS) ADMA((j + 1) & 1, krow0 + (j + 1) * 128);
        const char* K_lds = K_lds0 + (j & 1) * ATT_STAGE; const int vb = vb0 + (j & 1) * ATT_STAGE;
        f32x16 p0[2], p1[2]; bf16x8 pa[2][4]; float ps[2]; bf16x8 kfw[3];
#define KFRAG(u, d0, h) (*(const bf16x8*)(K_lds + (((u) / NMAP) * NMAP + ((u) % NMAP)) * KSZ + \
            (DIFF ? (((h) * 32 + r32) * 64 + ((((d0) * 2 + hi) ^ ((((h) * 32 + r32) >> 2) & 3)) << 4)) : (((h) * 32 + r32) * 256 + (((d0) * 32 + hi * 16) ^ ((((h) * 32 + r32) & 15) << 4))))))
#define QMFMA(u, s, frag) do { constexpr int d0_ = (s) >> 1, m_ = (u) % NMAP; f32x16& acc_ = ((s) & 1) ? p1[(u) & 1] : p0[(u) & 1]; \
            if (d0_ == 0) { const float nm_ = -m_reg[m_]; const f32x16 z = {nm_,nm_,nm_,nm_,nm_,nm_,nm_,nm_,nm_,nm_,nm_,nm_,nm_,nm_,nm_,nm_}; acc_ = __builtin_amdgcn_mfma_f32_32x32x16_bf16(frag, qr[m_][0], z, 0, 0, 0); } \
            else acc_ = __builtin_amdgcn_mfma_f32_32x32x16_bf16(frag, qr[m_][d0_], acc_, 0, 0, 0); } while (0)
        if (j == 0) {
#pragma unroll
            for (int m = 0; m < NMAP; ++m) {
#pragma unroll
                for (int d0 = 0; d0 < ND0; ++d0) { const bf16x8 f0 = KFRAG(m, d0, 0), f1 = KFRAG(m, d0, 1);
                    if (d0 == 0) { const f32x16 z = {0.f,0.f,0.f,0.f,0.f,0.f,0.f,0.f,0.f,0.f,0.f,0.f,0.f,0.f,0.f,0.f};
                        p0[0] = __builtin_amdgcn_mfma_f32_32x32x16_bf16(f0, qr[m][0], z, 0, 0, 0); p1[0] = __builtin_amdgcn_mfma_f32_32x32x16_bf16(f1, qr[m][0], z, 0, 0, 0); }
                    else { p0[0] = __builtin_amdgcn_mfma_f32_32x32x16_bf16(f0, qr[m][d0], p0[0], 0, 0, 0); p1[0] = __builtin_amdgcn_mfma_f32_32x32x16_bf16(f1, qr[m][d0], p1[0], 0, 0, 0); } }
                m_reg[m] = rowmax_tile(p0[0], p1[0]); }
        }
        {
#pragma unroll
            for (int sidx = 0; sidx < NA; ++sidx) { const bf16x8 f = (sidx & 1) ? KFRAG(0, sidx >> 1, 1) : KFRAG(0, sidx >> 1, 0);
                if (sidx == 0) QMFMA(0, 0, f); else if (sidx == 1) QMFMA(0, 1, f); else if (sidx == 2) QMFMA(0, 2, f); else if (sidx == 3) QMFMA(0, 3, f);
                else if (sidx == 4) QMFMA(0, 4, f); else if (sidx == 5) QMFMA(0, 5, f); else if (sidx == 6) QMFMA(0, 6, f); else if (sidx == 7) QMFMA(0, 7, f);
                else if (sidx == 8) QMFMA(0, 8, f); else if (sidx == 9) QMFMA(0, 9, f); else if (sidx == 10) QMFMA(0, 10, f); else QMFMA(0, 11, f); }
            ps[0] = 0.f;
            att_slot_ops<0, 0, 1>(p0[0], p1[0], ps[0], pa[0]);
            SB();
        }
#define STEP(u) do { constexpr int m_ = (u) % NMAP, tt_ = (u) / NMAP; constexpr bool nxt_ = ((u) + 1 < NU); \
              \
            if (nxt_) { ps[((u) + 1) & 1] = 0.f; kfw[0] = KFRAG((u) + 1, 0, 0); kfw[1] = KFRAG((u) + 1, 0, 1); \
                PHA(u, 0) PHA(u, 1) PHA(u, 2) PHA(u, 3) if (NA > 4) { PHA(u, 4) PHA(u, 5) PHA(u, 6) PHA(u, 7) PHA(u, 8) PHA(u, 9) PHA(u, 10) PHA(u, 11) } } \
            else { att_slot_ops<2, 0, 1>(p0[(u) & 1], p1[(u) & 1], ps[(u) & 1], pa[(u) & 1]); SB(); } \
            { float t_ = ps[(u) & 1]; auto rr = __builtin_amdgcn_permlane32_swap(__float_as_uint(t_), __float_as_uint(t_), false, false); t_ = __uint_as_float(rr[0]) + __uint_as_float(rr[1]); \
              l_reg[m_] += t_; bad = fmaxf(bad, t_); } \
              \
            PHB(u, 0) PHB(u, 1) } while (0)
#define PHA(u, s) { if ((s) < NA) { if ((s) + 2 < NA) kfw[((s) + 2) % 3] = (((s) + 2) & 1) ? KFRAG((u) + 1, ((s) + 2) >> 1, 1) : KFRAG((u) + 1, ((s) + 2) >> 1, 0); \
              QMFMA((u) + 1, (s), kfw[(s) % 3]); \
              att_slot_ops<2, (s), NA>(p0[(u) & 1], p1[(u) & 1], ps[(u) & 1], pa[(u) & 1]); SB(); } }
#define PHB(u, d0b) { const int vbb_ = vb + ((u) / NMAP) * 8192; \
              const s16x4 l0 = tr_read<v_rd_off(d0b, 0, 0)>(vbb_), h0 = tr_read<v_rd_off(d0b, 0, 1)>(vbb_), l1 = tr_read<v_rd_off(d0b, 1, 0)>(vbb_), h1 = tr_read<v_rd_off(d0b, 1, 1)>(vbb_); \
              const s16x4 l2 = tr_read<v_rd_off(d0b, 2, 0)>(vbb_), h2 = tr_read<v_rd_off(d0b, 2, 1)>(vbb_), l3 = tr_read<v_rd_off(d0b, 3, 0)>(vbb_), h3 = tr_read<v_rd_off(d0b, 3, 1)>(vbb_); \
              asm volatile("s_waitcnt lgkmcnt(0)" ::: "memory"); SB(); \
              f32x16& od_ = o[(u) % NMAP][d0b]; \
              od_ = __builtin_amdgcn_mfma_f32_32x32x16_bf16(pa[(u) & 1][0], PKV(l0, h0), od_, 0, 0, 0); if ((u) + 1 < NU) att_slot_ops<0, (d0b) * 4 + 0, 8>(p0[((u) + 1) & 1], p1[((u) + 1) & 1], ps[((u) + 1) & 1], pa[((u) + 1) & 1]); SB(); \
              od_ = __builtin_amdgcn_mfma_f32_32x32x16_bf16(pa[(u) & 1][1], PKV(l1, h1), od_, 0, 0, 0); if ((u) + 1 < NU) att_slot_ops<0, (d0b) * 4 + 1, 8>(p0[((u) + 1) & 1], p1[((u) + 1) & 1], ps[((u) + 1) & 1], pa[((u) + 1) & 1]); SB(); \
              od_ = __builtin_amdgcn_mfma_f32_32x32x16_bf16(pa[(u) & 1][2], PKV(l2, h2), od_, 0, 0, 0); if ((u) + 1 < NU) att_slot_ops<0, (d0b) * 4 + 2, 8>(p0[((u) + 1) & 1], p1[((u) + 1) & 1], ps[((u) + 1) & 1], pa[((u) + 1) & 1]); SB(); \
              od_ = __builtin_amdgcn_mfma_f32_32x32x16_bf16(pa[(u) & 1][3], PKV(l3, h3), od_, 0, 0, 0); if ((u) + 1 < NU) att_slot_ops<0, (d0b) * 4 + 3, 8>(p0[((u) + 1) & 1], p1[((u) + 1) & 1], ps[((u) + 1) & 1], pa[((u) + 1) & 1]); SB(); }
#define PKV(L, H) (bf16x8){L[0], L[1], L[2], L[3], H[0], H[1], H[2], H[3]}
        STEP(0); STEP(1);
        if (NU > 2) { STEP(2 % NU); STEP(3 % NU); }
#undef PKV
#undef PHB
#undef PHA
#undef STEP
#undef QMFMA
#undef KFRAG
    }
#undef SB
#undef ADMA
    float rli[NMAP][16];
#pragma unroll
    for (int m = 0; m < NMAP; ++m) {
        asm volatile("s_waitcnt lgkmcnt(0)" ::: "memory");
        if (hi == 0) wsl[r32] = l_reg[m];
        asm volatile("s_waitcnt lgkmcnt(0)" ::: "memory");
#pragma unroll
        for (int r = 0; r < 16; ++r) rli[m][r] = __builtin_amdgcn_rcpf(wsl[crow(r, hi)]);
    }
    const int orow0 = qrow0 + wid * 32;
    if (!DIFF) {
#pragma unroll
        for (int r = 0; r < 16; ++r) { bf16_t* dst = C_HB + (size_t)(orow0 + crow(r, hi)) * D + 512 + hd * 64 + r32;
            dst[0] = f2bf(o[0][0][r] * rli[0][r]); dst[32] = f2bf(o[0][1][r] * rli[0][r]); }
    } else {
        const float* lp = CIN(19) + l * 128; const float* gn = CIN(20) + l * 64; asm volatile("" : "+s"(lp), "+s"(gn));
        float s1 = lp[r32] * lp[32 + r32], s2 = lp[64 + r32] * lp[96 + r32];
#pragma unroll
        for (int o = 1; o < 32; o <<= 1) { s1 += shx(s1, o, lane); s2 += shx(s2, o, lane); }
        const float lam_init = (l == 0) ? 0.2f : 0.35550906759097f;
        const float lam = __expf(s1) - __expf(s2) + lam_init;
        const float g0 = gn[r32] * (1.f - lam_init), g1 = gn[32 + r32] * (1.f - lam_init);
#pragma unroll
        for (int r = 0; r < 16; ++r) {
            const float v0 = o[0][0][r] * rli[0][r] - lam * o[NMAP - 1][0][r] * rli[NMAP - 1][r];
            const float v1 = o[0][1][r] * rli[0][r] - lam * o[NMAP - 1][1][r] * rli[NMAP - 1][r];
            float ss = v0 * v0 + v1 * v1;
            ss += shx(ss, 1, lane); ss += shx(ss, 2, lane); ss += shx(ss, 4, lane); ss += shx(ss, 8, lane); ss += shx(ss, 16, lane);
            const float rstd = rsqrtf(ss * (1.f / 64.f) + NORM_EPS);
            bf16_t* dst = C_HB + (size_t)(orow0 + crow(r, hi)) * D + 768 + hd * 64 + r32;
            dst[0] = f2bf(v0 * rstd * g0); dst[32] = f2bf(v1 * rstd * g1); }
    }
    int* flag = (int*)(lds + 2 * ATT_STAGE + 8 * 64 * 4);
    __syncthreads();
    if (tid == 0) *flag = 0;
    __syncthreads();
    if (!(bad <= ATT_BIG)) *flag = 1;
    __syncthreads();
    const bool redo = *flag != 0;
    __syncthreads();
    return redo;
}
#ifndef PAIR_DIFF
#define PAIR_DIFF 1
#endif
#ifndef PAIR_MLA
#define PAIR_MLA 1
#endif
__device__ void ph_attn(const Ctx& c, int l, char* lds) {
    const bool need_ctx = (l < DEPTH - 1);
    const int nitem = 1024 + (need_ctx ? 32 : 0);
    for (int it = blockIdx.x; it < nitem; it += gridDim.x) {
        bool diff; int b, hd, q0, k0, nk;
        if (it < 1024) { const int combo = ((it >> 8) << 3) | (it & 7), qt = (it >> 3) & 31; diff = combo < 16; b = (combo >> 2) & 3; hd = combo & 3; q0 = b * RPB + CTX + qt * 256; k0 = b * RPB; nk = RPB; }
        else { const int u = it - 1024; diff = u < 16; b = u & 3; hd = (u >> 2) & 3; q0 = b * RPB; k0 = b * RPB; nk = CTX; }
#if PAIR_DIFF
        if (diff) { if (attn_item_pair<true>(c, l, b, hd, q0, k0, nk, lds)) attn_item<true>(c, l, b, hd, q0, k0, nk, lds); }
#else
        if (diff) attn_item<true>(c, l, b, hd, q0, k0, nk, lds);
#endif
#if PAIR_MLA
        else { if (attn_item_pair<false>(c, l, b, hd, q0, k0, nk, lds)) attn_item<false>(c, l, b, hd, q0, k0, nk, lds); }
#else
        else { if (attn_item_fast<false>(c, l, b, hd, q0, k0, nk, lds)) attn_item<false>(c, l, b, hd, q0, k0, nk, lds); }
#endif
    }
}

typedef float f32v2 __attribute__((ext_vector_type(2)));
__device__ void cvt_tables(const Ctx& c, int l) {
    for (int row = blockIdx.x * 8 + c.wid; row < 2 * NEXP; row += gridDim.x * 8) {
        const bool isu = row < NEXP; const int e = isu ? row : row - NEXP;
        const float* s = CIN(isu ? 23 : 24) + ((size_t)l * NEXP + e) * D + c.lane * 16;
        f32x4 v[4]; float mx = 0.f;
#pragma unroll
        for (int i = 0; i < 4; ++i) { v[i] = *(const f32x4*)(s + 4 * i); mx = fmaxf(mx, fmaxf(fmaxf(fabsf(v[i][0]), fabsf(v[i][1])), fmaxf(fabsf(v[i][2]), fabsf(v[i][3])))); }
#pragma unroll
        for (int o = 32; o >= 1; o >>= 1) mx = fmaxf(mx, __shfl_xor(mx, o, 64));
        const float q = mx > 0.f ? 256.f / mx : 0.f;
        if (c.lane == 0) (isu ? C_SU : C_SV)[e] = mx * (1.f / 256.f);
        u32x4 w;
#pragma unroll
        for (int i = 0; i < 4; ++i) { int p = 0; p = __builtin_amdgcn_cvt_pk_fp8_f32(v[i][0] * q, v[i][1] * q, p, false); p = __builtin_amdgcn_cvt_pk_fp8_f32(v[i][2] * q, v[i][3] * q, p, true); w[i] = (unsigned)p; }
        *(u32x4*)((isu ? C_TU8 : C_TV8) + ((size_t)(c.lane >> 3) * NEXP + e) * 128 + (c.lane & 7) * 16) = w;
    }
}
__device__ __forceinline__ unsigned ford(float x) { const unsigned u = __float_as_uint(x); return (u & 0x80000000u) ? ~u : (u | 0x80000000u); }
__device__ __forceinline__ float funord(unsigned k) { const unsigned u = (k & 0x80000000u) ? (k & 0x7fffffffu) : ~k; return __uint_as_float(u); }
__device__ __forceinline__ void sort16_desc(unsigned (&v)[16]) {
#pragma unroll
    for (int k = 2; k <= 16; k <<= 1)
#pragma unroll
        for (int j = k >> 1; j > 0; j >>= 1)
#pragma unroll
            for (int i = 0; i < 16; ++i) { const int l = i ^ j; if (l > i) { const unsigned a = v[i], b = v[l]; const unsigned hi = max(a, b), lo = min(a, b);
                if ((i & k) == 0) { v[i] = hi; v[l] = lo; } else { v[i] = lo; v[l] = hi; } } }
}
__device__ __forceinline__ void merge16_desc(unsigned (&t)[16], const unsigned (&v)[16]) {
#pragma unroll
    for (int i = 0; i < 16; ++i) t[i] = max(t[i], v[15 - i]);
#pragma unroll
    for (int j = 8; j > 0; j >>= 1)
#pragma unroll
        for (int i = 0; i < 16; ++i) { const int l = i ^ j; if (l > i) { const unsigned a = t[i], b = t[l]; t[i] = max(a, b); t[l] = min(a, b); } }
}
constexpr int TOPK_LDS = 2 * 128 * 129 * 4;
__device__ void peer_topk_item(const Ctx& c, int l, int tm, int h, char* lds) {
    float* S = (float*)lds;
    const int tid = c.tid, lane = c.lane, wid = c.wid, r32 = lane & 31, hi = lane >> 5, wm = wid >> 1, wn = wid & 1;
    const int row0 = tm * 128;
    bf16x8 fa[2][8];
#pragma unroll
    for (int p = 0; p < 2; ++p) { const bf16_t* Ap = C_Q2 + (size_t)(row0 + wm * 32 + r32) * 2048 + h * 256 + p * 128 + hi * 8;
#pragma unroll
        for (int ks = 0; ks < 8; ++ks) fa[p][ks] = *(const bf16x8*)(Ap + ks * 16); }
#pragma unroll
    for (int p = 0; p < 2; ++p) {
        f32x16 acc[2];
        zero_acc(acc[0]); zero_acc(acc[1]);
        const bf16_t* Bp = C_KEYS + ((((size_t)l * 8 + h) * 2 + p) * 128 + wn * 64 + r32) * 128 + hi * 8;
        bf16x8 fb0[8], fb1[8];
#pragma unroll
        for (int ks = 0; ks < 8; ++ks) { fb0[ks] = *(const bf16x8*)(Bp + ks * 16); fb1[ks] = *(const bf16x8*)(Bp + 32 * 128 + ks * 16); }
        asm volatile("" : "+v"(fa[p][0]), "+v"(fa[p][1]), "+v"(fa[p][2]), "+v"(fa[p][3]), "+v"(fa[p][4]), "+v"(fa[p][5]), "+v"(fa[p][6]), "+v"(fa[p][7]));
        asm volatile("" : "+v"(fb0[0]), "+v"(fb0[1]), "+v"(fb0[2]), "+v"(fb0[3]), "+v"(fb0[4]), "+v"(fb0[5]), "+v"(fb0[6]), "+v"(fb0[7]));
        asm volatile("" : "+v"(fb1[0]), "+v"(fb1[1]), "+v"(fb1[2]), "+v"(fb1[3]), "+v"(fb1[4]), "+v"(fb1[5]), "+v"(fb1[6]), "+v"(fb1[7]));
#pragma unroll
        for (int ks = 0; ks < 8; ++ks) {
            acc[0] = __builtin_amdgcn_mfma_f32_32x32x16_bf16(fa[p][ks], fb0[ks], acc[0], 0, 0, 0);
            acc[1] = __builtin_amdgcn_mfma_f32_32x32x16_bf16(fa[p][ks], fb1[ks], acc[1], 0, 0, 0);
        }
#pragma unroll
        for (int n = 0; n < 2; ++n)
#pragma unroll
            for (int r = 0; r < 16; ++r) S[(p * 128 + wm * 32 + crow(r, hi)) * 129 + wn * 64 + n * 32 + r32] = acc[n][r];
    }
    __syncthreads();
    unsigned tk[16];
    { const int list = tid >> 1, half = tid & 1; const float* sr = S + list * 129 + half * 64;
#pragma unroll
        for (int g = 0; g < 4; ++g) { unsigned v[16];
#pragma unroll
            for (int i = 0; i < 16; ++i) { const int n = half * 64 + g * 16 + i; v[i] = (ford(sr[g * 16 + i]) & ~127u) | (unsigned)(127 - n); }
            sort16_desc(v);
            if (g == 0) {
#pragma unroll
                for (int i = 0; i < 16; ++i) tk[i] = v[i]; }
            else merge16_desc(tk, v); } }
    __syncthreads();
    unsigned* X = (unsigned*)lds;
    unsigned* L = X + 256 * 17;
    if (tid & 1) {
#pragma unroll
        for (int i = 0; i < 16; ++i) X[(tid >> 1) * 17 + i] = tk[i]; }
    __syncthreads();
    if (!(tid & 1)) { unsigned v[16];
#pragma unroll
        for (int i = 0; i < 16; ++i) v[i] = X[(tid >> 1) * 17 + i];
        merge16_desc(tk, v);
#pragma unroll
        for (int i = 0; i < 16; ++i) L[(tid >> 1) * 17 + i] = tk[i]; }
    __syncthreads();
    unsigned bk[16];
    const int row = (tid >> 1) & 127, hh = tid & 1;
    const unsigned* l0 = L + row * 17; const unsigned* l1 = L + (128 + row) * 17;
    if (tid < 256) {
        float s0[8], s1[16];
#pragma unroll
        for (int ii = 0; ii < 8; ++ii) s0[ii] = funord(l0[2 * ii + hh] & ~127u);
#pragma unroll
        for (int j = 0; j < 16; ++j) s1[j] = funord(l1[j] & ~127u);
        unsigned ck[32];
        { int slot = 0;
#pragma unroll
            for (int ii = 0; ii < 8; ++ii)
#pragma unroll
                for (int j = 0; j < 16; ++j) if ((2 * ii + 1) * (j + 1) <= 16) {
                    const int i = 2 * ii + hh; const bool ok = (i + 1) * (j + 1) <= 16;
                    const unsigned key = (ford(s0[ii] + s1[j]) & ~255u) | (unsigned)(255 - (i * 16 + j));
                    ck[slot] = ok ? key : 0u; ++slot; }
#pragma unroll
            for (; slot < 32; ++slot) ck[slot] = 0u; }
        unsigned v0[16], v1[16];
#pragma unroll
        for (int i = 0; i < 16; ++i) { v0[i] = ck[i]; v1[i] = ck[16 + i]; }
        sort16_desc(v0); sort16_desc(v1);
        merge16_desc(v0, v1);
#pragma unroll
        for (int i = 0; i < 16; ++i) bk[i] = v0[i];
    }
    __syncthreads();
    if (tid < 256 && hh) {
#pragma unroll
        for (int i = 0; i < 16; ++i) X[row * 17 + i] = bk[i]; }
    __syncthreads();
    if (tid < 256 && !hh) { unsigned v[16];
#pragma unroll
        for (int i = 0; i < 16; ++i) v[i] = X[row * 17 + i];
        merge16_desc(bk, v);
        float best[16]; int eid[16]; float mx = -1e30f;
#pragma unroll
        for (int q = 0; q < 16; ++q) { const int ij = 255 - (int)(bk[q] & 255u); const int i = ij >> 4, j = ij & 15;
            const unsigned k0 = l0[i], k1 = l1[j];
            best[q] = funord(k0 & ~127u) + funord(k1 & ~127u);
            eid[q] = (127 - (int)(k0 & 127u)) * 128 + (127 - (int)(k1 & 127u));
            mx = fmaxf(mx, best[q]); }
        float sum = 0.f;
#pragma unroll
        for (int q = 0; q < 16; ++q) { best[q] = __expf(best[q] - mx); sum += best[q]; }
        const float inv = 1.f / sum;
        const size_t o = (size_t)(row0 + row) * 128 + h * 16;
#pragma unroll
        for (int q = 0; q < 16; q += 4) { *(u32x4*)(C_EI + o + q) = (u32x4){(unsigned)eid[q], (unsigned)eid[q + 1], (unsigned)eid[q + 2], (unsigned)eid[q + 3]};
            *(f32x4*)(C_EG + o + q) = (f32x4){best[q] * inv, best[q + 1] * inv, best[q + 2] * inv, best[q + 3] * inv}; }
    }
    __syncthreads();
}
__device__ __forceinline__ float gelu_tanh(float x) { const float u = 0.7978845608028654f * (x + 0.044715f * x * x * x); const float t = 1.f - 2.f / (1.f + __expf(2.f * u)); return 0.5f * x * (1.f + t); }
__device__ __forceinline__ int tok_row(int ti, bool need_ctx) { return need_ctx ? ti : (ti >> 13) * RPB + CTX + (ti & 8191); }
struct PeerTok { u32x4 t[16]; u32x4 xa, xb; f32v2 xv, gv; };
__device__ __forceinline__ void peer_issue(PeerTok& T, const unsigned char* t8, const int* el, const bf16_t* xp, int grp, bool want_x) {
#pragma unroll
    for (int u = 0; u < 16; ++u) { const int e = el[u * 8 + grp]; T.t[u] = *(const u32x4*)(t8 + (size_t)e * 128); }
    if (want_x) { T.xa = *(const u32x4*)xp; T.xb = *(const u32x4*)(xp + 8); }
}
__device__ __forceinline__ void peer_u_compute(const PeerTok& T, float* pp, int sub, int grp, int lane) {
    f32v2 x2[8];
#pragma unroll
    for (int q = 0; q < 4; ++q) { x2[q] = (f32v2){bflo(T.xa[q]), bfhi(T.xa[q])}; x2[4 + q] = (f32v2){bflo(T.xb[q]), bfhi(T.xb[q])}; }
    float keep[2];
#pragma unroll
    for (int hf = 0; hf < 2; ++hf) {
        float a[8];
#pragma unroll
        for (int u = 0; u < 8; ++u) { f32v2 s2 = {0.f, 0.f};
#pragma unroll
            for (int q = 0; q < 4; ++q) { const unsigned w = T.t[hf * 8 + u][q];
                s2 = __builtin_elementwise_fma(__builtin_amdgcn_cvt_pk_f32_fp8(w, false), x2[2 * q], s2);
                s2 = __builtin_elementwise_fma(__builtin_amdgcn_cvt_pk_f32_fp8(w, true), x2[2 * q + 1], s2); }
            a[u] = s2[0] + s2[1]; }
        const bool b2 = (lane & 4) != 0, b1 = (lane & 2) != 0, b0 = (lane & 1) != 0;
        float r4[4], r2[2];
#pragma unroll
        for (int q = 0; q < 4; ++q) { const float mine = b2 ? a[4 + q] : a[q], oth = b2 ? a[q] : a[4 + q]; r4[q] = mine + __shfl_xor(oth, 4, 64); }
#pragma unroll
        for (int q = 0; q < 2; ++q) { const float mine = b1 ? r4[2 + q] : r4[q], oth = b1 ? r4[q] : r4[2 + q]; r2[q] = mine + __shfl_xor(oth, 2, 64); }
        { const float mine = b0 ? r2[1] : r2[0], oth = b0 ? r2[0] : r2[1]; keep[hf] = mine + __shfl_xor(oth, 1, 64); }
    }
    pp[sub * 8 + grp] = keep[0]; pp[(8 + sub) * 8 + grp] = keep[1];
}
__device__ void peer_u_item(const Ctx& c, int l, int j, int tb, char* lds) {
    const bool need_ctx = (l < DEPTH - 1);
    int* el = (int*)lds + c.wid * 256;
    const int lane = c.lane, sub = lane & 7, grp = lane >> 3;
    const unsigned char* t8 = C_TU8 + (size_t)j * NEXP * 128 + sub * 16;
    const int tok0 = tb * 128 + c.wid * 16;
    const int xoff = j * 128 + sub * 16;
    PeerTok A, B;
    int e0, e1;
    { const int r = tok_row(tok0, need_ctx); e0 = C_EI[(size_t)r * 128 + lane]; e1 = C_EI[(size_t)r * 128 + 64 + lane];
      el[lane] = e0; el[64 + lane] = e1;
      peer_issue(A, t8, el, C_HB + (size_t)r * D + xoff, grp, true);
      const int r1 = tok_row(tok0 + 1, need_ctx); e0 = C_EI[(size_t)r1 * 128 + lane]; e1 = C_EI[(size_t)r1 * 128 + 64 + lane]; }
#pragma unroll 1
    for (int k = 0; k < 16; k += 2) {
        { const int r1 = tok_row(tok0 + k + 1, need_ctx); el[128 + lane] = e0; el[192 + lane] = e1;
          peer_issue(B, t8, el + 128, C_HB + (size_t)r1 * D + xoff, grp, true);
          if (k + 2 < 16) { const int r2 = tok_row(tok0 + k + 2, need_ctx); e0 = C_EI[(size_t)r2 * 128 + lane]; e1 = C_EI[(size_t)r2 * 128 + 64 + lane]; } }
        peer_u_compute(A, C_PART + ((size_t)j * NR + tok_row(tok0 + k, need_ctx)) * 128, sub, grp, lane);
        if (k + 2 < 16) { const int r2 = tok_row(tok0 + k + 2, need_ctx); el[lane] = e0; el[64 + lane] = e1;
          peer_issue(A, t8, el, C_HB + (size_t)r2 * D + xoff, grp, true);
          if (k + 3 < 16) { const int r3 = tok_row(tok0 + k + 3, need_ctx); e0 = C_EI[(size_t)r3 * 128 + lane]; e1 = C_EI[(size_t)r3 * 128 + 64 + lane]; } }
        peer_u_compute(B, C_PART + ((size_t)j * NR + tok_row(tok0 + k + 1, need_ctx)) * 128, sub, grp, lane);
    }
}
__device__ void ph_peer_combine(const Ctx& c, int l) {
    const bool need_ctx = (l < DEPTH - 1);
    const int ntok = need_ctx ? NR : NB * SEQ;
    for (int ti = blockIdx.x * 8 + c.wid; ti < ntok; ti += gridDim.x * 8) {
        const int r = tok_row(ti, need_ctx);
#pragma unroll
        for (int hf = 0; hf < 2; ++hf) { const size_t o = (size_t)r * 128 + hf * 64 + c.lane;
            const int e = C_EI[o]; float sacc = 0.f;
#pragma unroll
            for (int jj = 0; jj < 8; ++jj) sacc += C_PART[((size_t)jj * NR + r) * 128 + hf * 64 + c.lane];
            C_EG[o] = C_EG[o] * gelu_tanh(sacc * C_SU[e]) * C_SV[e]; }
    }
}
__device__ __forceinline__ void peer_v_compute(const PeerTok& T, const float* wl, float* xo, int grp, int lane) {
    f32v2 acc[8];
#pragma unroll
    for (int q = 0; q < 8; ++q) acc[q] = (f32v2){0.f, 0.f};
#pragma unroll
    for (int u = 0; u < 16; ++u) { const float wv = wl[u * 8 + grp]; const f32v2 w2 = {wv, wv};
#pragma unroll
        for (int q = 0; q < 4; ++q) { const unsigned w = T.t[u][q];
            acc[2 * q] = __builtin_elementwise_fma(__builtin_amdgcn_cvt_pk_f32_fp8(w, false), w2, acc[2 * q]);
            acc[2 * q + 1] = __builtin_elementwise_fma(__builtin_amdgcn_cvt_pk_f32_fp8(w, true), w2, acc[2 * q + 1]); } }
    const bool b5 = (lane & 32) != 0, b4 = (lane & 16) != 0, b3 = (lane & 8) != 0;
    f32v2 r4[4], r2[2], r1;
#pragma unroll
    for (int q = 0; q < 4; ++q) { const f32v2 mine = b5 ? acc[4 + q] : acc[q], oth = b5 ? acc[q] : acc[4 + q];
        r4[q] = (f32v2){mine[0] + __shfl_xor(oth[0], 32, 64), mine[1] + __shfl_xor(oth[1], 32, 64)}; }
#pragma unroll
    for (int q = 0; q < 2; ++q) { const f32v2 mine = b4 ? r4[2 + q] : r4[q], oth = b4 ? r4[q] : r4[2 + q];
        r2[q] = (f32v2){mine[0] + __shfl_xor(oth[0], 16, 64), mine[1] + __shfl_xor(oth[1], 16, 64)}; }
    { const f32v2 mine = b3 ? r2[1] : r2[0], oth = b3 ? r2[0] : r2[1]; r1 = (f32v2){mine[0] + __shfl_xor(oth[0], 8, 64), mine[1] + __shfl_xor(oth[1], 8, 64)}; }
    f32v2 xv = T.xv; const f32v2 gv = T.gv;
    xv[0] += gv[0] * r1[0]; xv[1] += gv[1] * r1[1];
    *(f32v2*)xo = xv;
}
__device__ void peer_v_item(const Ctx& c, int l, int j, int tb, char* lds) {
    const bool need_ctx = (l < DEPTH - 1);
    int* el = (int*)lds + c.wid * 512; float* wl = (float*)(el + 256);
    const int lane = c.lane, sub = lane & 7, grp = lane >> 3;
    const unsigned char* t8 = C_TV8 + (size_t)j * NEXP * 128 + sub * 16;
    const int tok0 = tb * 128 + c.wid * 16;
    const int col = j * 128 + sub * 16 + ((lane & 32) ? 8 : 0) + ((lane & 16) ? 4 : 0) + ((lane & 8) ? 2 : 0);
    const float* gate5 = C_MODT + (size_t)l * 5 * 6144 + 5 * D + col;
    PeerTok A, B;
    int e0, e1; float w0, w1;
#define VISSUE(T, tok, eoff) do { const int r_ = tok_row((tok), need_ctx); const int b_ = r_ / RPB; const bool ctx_ = (r_ - b_ * RPB) < CTX; \
        peer_issue(T, t8, el + (eoff), nullptr, grp, false); T.xv = *(const f32v2*)(xrow(c, r_) + col); T.gv = *(const f32v2*)(gate5 + (size_t)(ctx_ ? 4 : b_) * 6144); } while (0)
#define VFETCH(tok) do { const int r_ = tok_row((tok), need_ctx); e0 = C_EI[(size_t)r_ * 128 + lane]; e1 = C_EI[(size_t)r_ * 128 + 64 + lane]; w0 = C_EG[(size_t)r_ * 128 + lane]; w1 = C_EG[(size_t)r_ * 128 + 64 + lane]; } while (0)
    VFETCH(tok0);
    el[lane] = e0; el[64 + lane] = e1; wl[lane] = w0; wl[64 + lane] = w1;
    VISSUE(A, tok0, 0);
    VFETCH(tok0 + 1);
#pragma unroll 1
    for (int k = 0; k < 16; k += 2) {
        el[128 + lane] = e0; el[192 + lane] = e1; wl[128 + lane] = w0; wl[192 + lane] = w1;
        VISSUE(B, tok0 + k + 1, 128);
        if (k + 2 < 16) VFETCH(tok0 + k + 2);
        peer_v_compute(A, wl, xrow(c, tok_row(tok0 + k, need_ctx)) + col, grp, lane);
        if (k + 2 < 16) { el[lane] = e0; el[64 + lane] = e1; wl[lane] = w0; wl[64 + lane] = w1;
          VISSUE(A, tok0 + k + 2, 0);
          if (k + 3 < 16) VFETCH(tok0 + k + 3); }
        peer_v_compute(B, wl + 128, xrow(c, tok_row(tok0 + k + 1, need_ctx)) + col, grp, lane);
    }
#undef VISSUE
#undef VFETCH
}
template <int SUB>
__device__ void ph_peer_expert(const Ctx& c, int l, char* lds) {
    const bool need_ctx = (l < DEPTH - 1);
    unsigned* cnt = (unsigned*)CWS(WS_CTL) + 4096 + ((l * 2 + SUB) * 8) * 64;
    const int nitem = (need_ctx ? NR : NB * SEQ) / 128;
    const int x = (int)(xb_xcc_id() & 7u);
    volatile int* sh = (volatile int*)(lds + 16384);
    for (int jo = 0; jo < 8; ++jo) { const int j = (x + jo) & 7;
        int nxt = 0;
        if (c.tid == 0) nxt = (int)__hip_atomic_fetch_add(&cnt[j * 64], 1u, __ATOMIC_RELAXED, __HIP_MEMORY_SCOPE_AGENT);
        for (;;) {
            if (c.tid == 0) *sh = nxt;
            __syncthreads(); const int it = *sh; __syncthreads();
            if (it >= nitem) break;
            if (c.tid == 0) nxt = (int)__hip_atomic_fetch_add(&cnt[j * 64], 1u, __ATOMIC_RELAXED, __HIP_MEMORY_SCOPE_AGENT);
            if (SUB == 0) peer_u_item(c, l, j, it, lds); else peer_v_item(c, l, j, it, lds);
        }
    }
}
__device__ void ph_final(const Ctx& c) {
    const float* g = CIN(25);
    const int stride = gridDim.x * 8;
    int r = blockIdx.x * 8 + c.wid;
    f32x4 xn[4];
    if (r < NB * SEQ) { const float* src = COUT + ((size_t)r << 10);
#pragma unroll
        for (int i = 0; i < 4; ++i) xn[i] = *(const f32x4*)(src + i * 256 + c.lane * 4); }
    for (; r < NB * SEQ; r += stride) {
        float* xr = COUT + ((size_t)r << 10);
        f32x4 x[4]; float ss = 0.f;
#pragma unroll
        for (int i = 0; i < 4; ++i) { x[i] = xn[i]; ss += x[i][0] * x[i][0] + x[i][1] * x[i][1] + x[i][2] * x[i][2] + x[i][3] * x[i][3]; }
        if (r + stride < NB * SEQ) { const float* src = COUT + ((size_t)(r + stride) << 10);
#pragma unroll
            for (int i = 0; i < 4; ++i) xn[i] = *(const f32x4*)(src + i * 256 + c.lane * 4); }
        ss = wave_sum(ss); const float rstd = rsqrtf(ss * (1.f / D) + NORM_EPS);
#pragma unroll
        for (int i = 0; i < 4; ++i) { const int col = i * 256 + c.lane * 4; const f32x4 gv = *(const f32x4*)(g + col); f32x4 y;
#pragma unroll
            for (int e = 0; e < 4; ++e) y[e] = x[i][e] * rstd * gv[e];
            *(f32x4*)(xr + col) = y; }
    }
}

namespace pg8 {
#define PG8_LAS __attribute__((address_space(3)))
typedef unsigned short bf16_t;
typedef short bf16x8 __attribute__((ext_vector_type(8)));
typedef float f32x4 __attribute__((ext_vector_type(4)));
typedef unsigned u32x4 __attribute__((ext_vector_type(4)));
constexpr int BM = 256, BK = 64, HALF = 128, HTB = HALF * BK * 2  , STAGE_BYTES = 8 * HTB, NXCD = 8, WGM = 8;

__host__ __device__ __forceinline__ int lds_byte(int r, int c) { const int st = (r >> 4) * 2 + (c >> 5), rr = r & 15, cc = c & 31, ob = rr * 64 + cc * 2; return st * 1024 + (ob ^ (((ob >> 9) & 1) << 5)); }
__host__ __device__ __forceinline__ void stage_rc(int b, int& R, int& C) { const int st = b / 1024, sb = b % 1024, swz = sb ^ (((sb >> 9) & 1) << 5); R = (st >> 1) * 16 + swz / 64; C = (st & 1) * 32 + (swz % 64) / 2; }
__host__ __device__ __forceinline__ int perm32(int rho) { const int n = rho >> 4, i = rho & 15; return 8 * (i >> 2) + 4 * n + (i & 3); }

struct Unit { int pm, pn; };
struct Gemm { const bf16_t* A; const bf16_t* Bt; int M, N, K; };
struct TileOrder {
    int nM, nN, nwg, G, c; bool skip_ctx;
    __device__ void init(int nM_, int nN_, int G_, int c_, bool skip) { nM = nM_; nN = nN_; nwg = nM_ * nN_; G = G_; c = c_; skip_ctx = skip; }
    __device__ bool next(int i, Unit& u) const {
        const long L = (long)i * G + c; if (L >= nwg) return false;
        int wgid = (int)L; { const int q = nwg / NXCD, r = nwg % NXCD, xcd = wgid % NXCD, off = wgid / NXCD; wgid = (xcd < r ? xcd * (q + 1) : r * (q + 1) + (xcd - r) * q) + off; }
        const int nig = WGM * nN, gid = wgid / nig, fm = gid * WGM, gsz = (nM - fm) < WGM ? (nM - fm) : WGM;
        int pm = fm + ((wgid % nig) % gsz); u.pn = (wgid % nig) / gsz;
        if (skip_ctx) pm = 33 * (pm >> 5) + 1 + (pm & 31);
        u.pm = pm; return true;
    }
    __device__ __forceinline__ void a_ready(const Unit&) const {}
    __device__ __forceinline__ void done(const Unit&) const {}
};
template <class Epi, class Sched, bool STAMP = false>
__device__ __forceinline__ void gemm_phase(PG8_LAS unsigned char* lds, const Gemm g, const Sched& S, const Epi& E, unsigned long long* stamps, int w0) {
    const int tid = mk_tid(w0), wid = w0, lane = tid & 63, wr = wid >> 2, wc = wid & 3, fr = lane & 15, fq = lane >> 4;
    const int K = g.K, nt = K / BK;
    int ts_lo = 0, ts_hi = 0, nts = 0; const unsigned long long rt_entry = STAMP ? (unsigned long long)wall_clock64() : 0ull;
#define PG8_STAMP() do { if (STAMP && wid == 0 && nts < 64) { const unsigned long long _c = (unsigned long long)clock64(); \
        ts_lo = (lane == nts) ? (int)(unsigned)_c : ts_lo; ts_hi = (lane == nts) ? (int)(unsigned)(_c >> 32) : ts_hi; ++nts; } } while (0)
    PG8_STAMP();
    unsigned voffA[2], voffB[2];
#pragma unroll
    for (int i = 0; i < 2; ++i) { int R, C; stage_rc(tid * 16 + i * 8192, R, C); const int Rb = Epi::PERM ? ((R & ~31) + perm32(R & 31)) : R;
        voffA[i] = (unsigned)(R * K + C) * 2u; voffB[i] = (unsigned)(Rb * K + C) * 2u; }
    const size_t kstep = (size_t)(BK * 2);
    const size_t hstep = (size_t)HALF * K * 2;
    const size_t tstep = 2 * hstep;
    const unsigned ldsw = (unsigned)wid * 1024u;
    const int aoff = lds_byte(wr * 64 + fr, fq * 8), boff = lds_byte(wc * 32 + fr, fq * 8);
#define PG8_SA(b, h) (((b) * 2 + (h)) * HTB)
#define PG8_SB(b, h) ((4 + (b) * 2 + (h)) * HTB)
#define PG8_STAGE(bufoff, gbase, voff) do { _Pragma("unroll") for (int _i = 0; _i < 2; ++_i) \
        __builtin_amdgcn_global_load_lds((const unsigned*)((const char*)(gbase) + (voff)[_i]), (PG8_LAS unsigned*)(lds + (bufoff) + ldsw + _i * 8192), 16, 0, 0); } while (0)
#define PG8_LDA(dst, b, h) do { _Pragma("unroll") for (int m = 0; m < 4; ++m) _Pragma("unroll") for (int k = 0; k < 2; ++k) dst[m][k] = *(const PG8_LAS bf16x8*)(lds + PG8_SA(b, h) + aoff + m * 2048 + k * 1024); } while (0)
#define PG8_LDB(dst, b, h) do { _Pragma("unroll") for (int n = 0; n < 2; ++n) _Pragma("unroll") for (int k = 0; k < 2; ++k) dst[n][k] = *(const PG8_LAS bf16x8*)(lds + PG8_SB(b, h) + boff + n * 2048 + k * 1024); } while (0)
#define PG8_MMA(ai, bj, At, Bt) do { __builtin_amdgcn_s_setprio(1); _Pragma("unroll") for (int m = 0; m < 4; ++m) _Pragma("unroll") for (int n = 0; n < 2; ++n) _Pragma("unroll") for (int k = 0; k < 2; ++k) \
        acc[ai][bj][m][n] = __builtin_amdgcn_mfma_f32_16x16x32_bf16(Bt[n][k], At[m][k], acc[ai][bj][m][n], 0, 0, 0); __builtin_amdgcn_s_setprio(0); } while (0)
#define PG8_WAIT_V(n) asm volatile("s_waitcnt vmcnt(" #n ")" ::: "memory")
#define PG8_WAIT_L(n) asm volatile("s_waitcnt lgkmcnt(" #n ")" ::: "memory")
#define PG8_BAR __builtin_amdgcn_s_barrier()
#define PG8_SCHED __builtin_amdgcn_sched_barrier(0)
    Unit cur, nxt; int ui = 0;
    if (!S.next(0, cur)) return;
    f32x4 acc[2][2][4][2];
#pragma unroll
    for (int a = 0; a < 2; ++a)
#pragma unroll
        for (int b = 0; b < 2; ++b)
#pragma unroll
            for (int m = 0; m < 4; ++m)
#pragma unroll
                for (int n = 0; n < 2; ++n) acc[a][b][m][n] = (f32x4){0.f, 0.f, 0.f, 0.f};
    bf16x8 At[4][2], B0[2][2], B1[2][2];
    const char* cA = (const char*)g.A + (size_t)cur.pm * tstep; const char* cB = (const char*)g.Bt + (size_t)cur.pn * tstep;
    S.a_ready(cur);
    PG8_STAGE(PG8_SB(0, 0), cB, voffB); PG8_STAGE(PG8_SA(0, 0), cA, voffA); PG8_STAGE(PG8_SB(0, 1), cB + hstep, voffB); PG8_STAGE(PG8_SA(0, 1), cA + hstep, voffA);
    if (wr == 1) PG8_BAR;
    PG8_WAIT_V(4); PG8_BAR;
    PG8_STAGE(PG8_SB(1, 0), cB + kstep, voffB); PG8_STAGE(PG8_SA(1, 0), cA + kstep, voffA); PG8_STAGE(PG8_SB(1, 1), cB + hstep + kstep, voffB);
    PG8_WAIT_V(6); PG8_BAR;
    PG8_STAMP();
    for (;;) {
        const bool has_next = S.next(ui + 1, nxt);
        const char* nA = has_next ? (const char*)g.A + (size_t)nxt.pm * tstep : cA; const char* nB = has_next ? (const char*)g.Bt + (size_t)nxt.pn * tstep : cB;
        for (int t = 0; t < nt; t += 2) {
            const bool last = (t == nt - 2);
            const char* a1 = cA + (size_t)(t + 1) * kstep;
            const char* a2 = last ? nA : cA + (size_t)(t + 2) * kstep; const char* b2 = last ? nB : cB + (size_t)(t + 2) * kstep;
            const char* a3 = a2 + kstep; const char* b3 = b2 + kstep;
            if (last && has_next) S.a_ready(nxt);
            PG8_LDB(B0, 0, 0); PG8_SCHED; PG8_LDA(At, 0, 0); PG8_STAGE(PG8_SA(1, 1), a1 + hstep, voffA);
            PG8_WAIT_L(8); PG8_BAR; PG8_WAIT_L(0); PG8_MMA(0, 0, At, B0); PG8_BAR; PG8_SCHED;
            PG8_LDB(B1, 0, 1); PG8_STAGE(PG8_SB(0, 0), b2, voffB);
            PG8_BAR; PG8_WAIT_L(0); PG8_MMA(0, 1, At, B1); PG8_BAR;
            PG8_LDA(At, 0, 1); PG8_STAGE(PG8_SA(0, 0), a2, voffA);
            PG8_BAR; PG8_WAIT_L(0); PG8_MMA(1, 0, At, B0); PG8_BAR; PG8_SCHED;
            PG8_STAGE(PG8_SB(0, 1), b2 + hstep, voffB);
            PG8_WAIT_V(6); PG8_BAR; PG8_MMA(1, 1, At, B1); PG8_BAR;
            PG8_LDB(B0, 1, 0); PG8_SCHED; PG8_LDA(At, 1, 0); PG8_STAGE(PG8_SA(0, 1), a2 + hstep, voffA);
            PG8_WAIT_L(8); PG8_BAR; PG8_WAIT_L(0); PG8_MMA(0, 0, At, B0); PG8_BAR; PG8_SCHED;
            PG8_LDB(B1, 1, 1); PG8_STAGE(PG8_SB(1, 0), b3, voffB);
            PG8_BAR; PG8_WAIT_L(0); PG8_MMA(0, 1, At, B1); PG8_BAR;
            PG8_LDA(At, 1, 1); PG8_STAGE(PG8_SA(1, 0), a3, voffA);
            PG8_BAR; PG8_WAIT_L(0); PG8_MMA(1, 0, At, B0); PG8_BAR; PG8_SCHED;
            PG8_STAGE(PG8_SB(1, 1), b3 + hstep, voffB);
            PG8_WAIT_V(6); PG8_BAR; PG8_MMA(1, 1, At, B1); PG8_BAR;
        }
        PG8_STAMP();
        if constexpr (!Epi::AFTER_DRAIN) { E(acc, cur, wr, wc, fr, fq); S.done(cur); }
        PG8_STAMP();
        if (!has_next) break;
#pragma unroll
        for (int a = 0; a < 2; ++a)
#pragma unroll
            for (int b = 0; b < 2; ++b)
#pragma unroll
                for (int m = 0; m < 4; ++m)
#pragma unroll
                    for (int n = 0; n < 2; ++n) acc[a][b][m][n] = (f32x4){0.f, 0.f, 0.f, 0.f};
        cur = nxt; cA = nA; cB = nB; ++ui;
    }
    PG8_WAIT_V(0);
    if (wr == 0) PG8_BAR;
    PG8_BAR;
    if constexpr (Epi::AFTER_DRAIN) { E.fused(acc, cur, wr, wc, fr, fq, lds, wid, lane); S.done(cur); }
    PG8_STAMP();
    if (STAMP && wid == 0) { stamps[lane] = lane < nts ? (((unsigned long long)(unsigned)ts_hi << 32) | (unsigned)ts_lo) : 0ull;
        if (lane == 62) stamps[62] = rt_entry; if (lane == 63) stamps[63] = (unsigned long long)wall_clock64(); }
#undef PG8_STAMP
#undef PG8_SA
#undef PG8_SB
#undef PG8_STAGE
#undef PG8_LDA
#undef PG8_LDB
#undef PG8_MMA
#undef PG8_WAIT_V
#undef PG8_WAIT_L
#undef PG8_BAR
#undef PG8_SCHED
}

struct EpiStoreBf16 {
    static constexpr bool PERM = true, AFTER_DRAIN = false;
    bf16_t* O; int ldc; int ncols; int slo, shi; float scale;
    __device__ __forceinline__ void operator()(const f32x4 (&acc)[2][2][4][2], const Unit& u, int wr, int wc, int fr, int fq) const {
        const int row0 = u.pm * BM + wr * 64 + fr, col0 = u.pn * BM + wc * 32 + 8 * fq;
        float sc[2];
#pragma unroll
        for (int bj = 0; bj < 2; ++bj) { const int cb = u.pn * BM + bj * HALF; sc[bj] = (cb >= slo && cb < shi) ? scale : 1.f; }
#pragma unroll
        for (int ai = 0; ai < 2; ++ai)
#pragma unroll
            for (int m = 0; m < 4; ++m) { bf16_t* rowp = O + (size_t)(row0 + ai * HALF + m * 16) * ldc + col0;
#pragma unroll
                for (int bj = 0; bj < 2; ++bj) if (col0 + bj * HALF < ncols) { const f32x4 v0 = acc[ai][bj][m][0] * sc[bj], v1 = acc[ai][bj][m][1] * sc[bj];
                    u32x4 w; w.x = ::cvtpk(v0[0], v0[1]); w.y = ::cvtpk(v0[2], v0[3]); w.z = ::cvtpk(v1[0], v1[1]); w.w = ::cvtpk(v1[2], v1[3]);
                    *(u32x4*)(rowp + bj * HALF) = w; }
                asm volatile("" ::: "memory"); }
    }
};
struct EpiResidX {
    static constexpr bool PERM = false, AFTER_DRAIN = false;
    float* xc; float* xout; const float* gate_l;
    __device__ __forceinline__ void operator()(const f32x4 (&acc)[2][2][4][2], const Unit& u, int wr, int wc, int fr, int fq) const {
        const int rowt = u.pm * BM; const int b = rowt / RPB, j0 = rowt - b * RPB; const bool isctx = j0 < CTX;
        float* xb = isctx ? xc + ((size_t)(b * CTX + j0) << 10) : xout + ((size_t)(b * SEQ + j0 - CTX) << 10);
        const float* gt = gate_l + (size_t)(isctx ? 4 : b) * 6144;
        const int r0 = wr * 64 + fr, col0 = u.pn * BM + wc * 32 + 4 * fq;
        f32x4 gv[2][2];
#pragma unroll
        for (int bj = 0; bj < 2; ++bj)
#pragma unroll
            for (int n = 0; n < 2; ++n) gv[bj][n] = *(const f32x4*)(gt + col0 + bj * HALF + n * 16);
#pragma unroll
        for (int ai = 0; ai < 2; ++ai)
#pragma unroll
            for (int m = 0; m < 4; ++m) { float* rowp = xb + ((size_t)(r0 + ai * HALF + m * 16) << 10) + col0;
#pragma unroll
                for (int bj = 0; bj < 2; ++bj)
#pragma unroll
                    for (int n = 0; n < 2; ++n) { f32x4* p = (f32x4*)(rowp + bj * HALF + n * 16); *p = *p + gv[bj][n] * acc[ai][bj][m][n]; }
                asm volatile("" ::: "memory"); }
    }
};
}

constexpr int LDS_BYTES = 144 * 1024;
static_assert(TOPK_LDS + 16 <= LDS_BYTES && GEMM_LDS + 16 <= LDS_BYTES && ATT_LDS + 16 <= LDS_BYTES, "LDS budget");
constexpr int PPL = 13;
constexpr int N_PHASES = 1 + PPL * DEPTH + 1;
extern __shared__ __attribute__((aligned(16))) char g_lds[];

#define PHASE_FN __device__ __forceinline__ void
PHASE_FN f_p0(int w0) { const Ctx c = fresh_ctx(w0); ph_p0(c, g_lds); }
PHASE_FN f_norm0(int w0, int l) { const Ctx c = fresh_ctx(w0); ph_norm<0>(c, l); }
PHASE_FN f_norm1(int w0, int l) { const Ctx c = fresh_ctx(w0); ph_norm<1>(c, l); }
PHASE_FN f_gemm_in(int w0, int l) { const Ctx c = fresh_ctx(w0);
    pg8::Gemm g{C_HB, C_WIN + (size_t)l * INC * D, NR, 3328, D};
    pg8::TileOrder S; S.init(132, 13, (int)gridDim.x, (int)blockIdx.x, false);
    pg8::EpiStoreBf16 E{C_P, INC, INC, DF_Q, DF_Q + 256, 0.17677669529663687f * 1.4426950408889634f};
    pg8::gemm_phase<pg8::EpiStoreBf16, pg8::TileOrder>((PG8_LAS unsigned char*)g_lds, g, S, E, nullptr, w0); }
PHASE_FN f_prep(int w0, int l) {
    const Ctx c = fresh_ctx(w0); char* lds = g_lds;
    ph_prep_rows(c, l);
    scan_tables(c, l, lds);
    { const int G = (int)gridDim.x, N = 16 * NCHUNK * 2, R = (N + G - 1) / G;
      for (int q = 0; q < 2 * R; ++q) { const int mx = q & 1; int u = (q >> 1) * G + (int)blockIdx.x; if (u >= N) continue;
        const int dir = u & 1; u >>= 1; const int cc = u % NCHUNK; u /= NCHUNK; const int h = u & 3, b = u >> 2;
        if (mx == 0) scanA_item<0>(c, l, b, h, cc, dir, lds); else scanA_item<1>(c, l, b, h, cc, dir, lds); } }
}
PHASE_FN f_upproj(int w0, int l) {
    const Ctx c = fresh_ctx(w0); char* lds = g_lds;
    EpiBf16 eq{C_QM, 384, 0.10206207261596575f * 1.4426950408889634f}, ekv{C_KVM, 512, 1.f};
    for (int it = blockIdx.x; it < 132 * 7 + 384; it += gridDim.x) {
        if (it < 132 * 7) { const int tm = it / 7, tn = it % 7;
            if (tn < 3) gemm_tile(c, C_P + MLA_CQ, INC, C_WUQ + (size_t)l * 384 * 192, 192, 192, tm * 256, tn * 128, lds, eq);
            else gemm_tile(c, C_P + MLA_CKV, INC, C_WUKV + (size_t)l * 512 * 128, 128, 128, tm * 256, (tn - 3) * 128, lds, ekv); }
        else scanB_item(c, it - 132 * 7); }
}
PHASE_FN f_scanc(int w0, int l) {
    const Ctx c = fresh_ctx(w0); char* lds = g_lds; const bool need_ctx = (l < DEPTH - 1);
    ph_rope_q(c);
    scan_tables(c, l, lds);
    { const int G = (int)gridDim.x, N = 16 * NCHUNK, R = (N + G - 1) / G;
      for (int q = 0; q < 2 * R; ++q) { const int mx = q & 1; int u = (q >> 1) * G + (int)blockIdx.x; if (u >= N) continue;
        const int cc = u % NCHUNK; u /= NCHUNK; const int h = u & 3, b = u >> 2;
        if (cc < 4 && !need_ctx) continue;
        if (mx == 0) scanC_item<0>(c, l, b, h, cc, lds); else scanC_item<1>(c, l, b, h, cc, lds); } }
}
PHASE_FN f_attn(int w0, int l) { const Ctx c = fresh_ctx(w0); ph_attn(c, l, g_lds); }
PHASE_FN f_gemm_out(int w0, int l) {
    const Ctx c = fresh_ctx(w0); const bool need_ctx = (l < DEPTH - 1);
    { pg8::Gemm g{C_HB, C_WOUT + (size_t)l * D * D, NR, D, D};
      pg8::TileOrder S; S.init(need_ctx ? 132 : 128, 4, (int)gridDim.x, (int)blockIdx.x, !need_ctx);
      pg8::EpiResidX E{C_XC, COUT, C_MODT + (size_t)l * 5 * 6144 + 2 * D};
      pg8::gemm_phase<pg8::EpiResidX, pg8::TileOrder>((PG8_LAS unsigned char*)g_lds, g, S, E, nullptr, w0); }
    cvt_tables(c, l);
}
PHASE_FN f_peer_q(int w0, int l) {
    const Ctx c = fresh_ctx(w0); const bool need_ctx = (l < DEPTH - 1);
    pg8::Gemm g{C_HB, C_WQ + (size_t)l * 2048 * D, NR, 2048, D};
    pg8::TileOrder S; S.init(need_ctx ? 132 : 128, 8, (int)gridDim.x, (int)blockIdx.x, !need_ctx);
    pg8::EpiStoreBf16 E{C_Q2, 2048, 2048, 0, 0, 1.f};
    pg8::gemm_phase<pg8::EpiStoreBf16, pg8::TileOrder>((PG8_LAS unsigned char*)g_lds, g, S, E, nullptr, w0);
}
PHASE_FN f_topk(int w0, int l) {
    const Ctx c = fresh_ctx(w0); char* lds = g_lds; const bool need_ctx = (l < DEPTH - 1);
    for (int it = blockIdx.x; it < 264 * 8; it += gridDim.x) { const int tm = it >> 3, h = it & 7;
        if ((tm % 66) < 2 && !need_ctx) continue;
        peer_topk_item(c, l, tm, h, lds); }
}
PHASE_FN f_expert_u(int w0, int l) { const Ctx c = fresh_ctx(w0); ph_peer_expert<0>(c, l, g_lds); }
PHASE_FN f_expert_c(int w0, int l) { const Ctx c = fresh_ctx(w0); ph_peer_combine(c, l); }
PHASE_FN f_expert_v(int w0, int l) { const Ctx c = fresh_ctx(w0); ph_peer_expert<1>(c, l, g_lds); }
PHASE_FN f_final(int w0) { const Ctx c = fresh_ctx(w0); ph_final(c); }

__global__ void __launch_bounds__(512, 2) mk_fwd(Params p) {
    volatile LAS unsigned* bst = (volatile LAS unsigned*)(g_lds + LDS_BYTES - 16);
    const bool t0 = threadIdx.x == 0; const int w0 = __builtin_amdgcn_readfirstlane((int)threadIdx.x >> 6);
    if (t0) { bst[0] = 0u; bst[1] = 0u; bst[2] = 0u; bst[3] = 0u; }
    __syncthreads();
    XcdBarrier bar; bar.bar = (unsigned*)(p.ws + WS_CTL); bar.x = 0; bar.st = bst; bar.t0 = t0;
    const int lo = p.ph_lo, hi = p.ph_hi;
    const bool multi = (hi - lo) > 1;
    if (multi) bar = xcd_barrier_post((unsigned*)(p.ws + WS_CTL), bst, t0);
#ifndef PHMASK
#define PHMASK 0xFFFF
#endif
#define EN(s) ((PHMASK >> (s)) & 1)
#define IN(k) (lo <= (k) && (k) < hi)
#define SEAM(k) do { if (IN(k) && IN((k) + 1)) xcd_barrier(bar); } while (0)
    if (EN(0) && IN(0)) f_p0(w0);
    SEAM(0);
#define LAYER(l) do { constexpr int base = 1 + PPL * (l); \
        if (EN(1) && IN(base + 0)) f_norm0(w0, l); SEAM(base + 0); \
        if (EN(2) && IN(base + 1)) f_gemm_in(w0, l); SEAM(base + 1); \
        if (EN(3) && IN(base + 2)) f_prep(w0, l); SEAM(base + 2); \
        if (EN(4) && IN(base + 3)) f_upproj(w0, l); SEAM(base + 3); \
        if (EN(5) && IN(base + 4)) f_scanc(w0, l); SEAM(base + 4); \
        if (EN(6) && IN(base + 5)) f_attn(w0, l); SEAM(base + 5); \
        if (EN(7) && IN(base + 6)) f_gemm_out(w0, l); SEAM(base + 6); \
        if (EN(8) && IN(base + 7)) f_norm1(w0, l); SEAM(base + 7); \
        if (EN(9) && IN(base + 8)) f_peer_q(w0, l); SEAM(base + 8); \
        if (EN(10) && IN(base + 9)) f_topk(w0, l); SEAM(base + 9); \
        if (EN(11) && IN(base + 10)) f_expert_u(w0, l); SEAM(base + 10); \
        if (EN(12) && IN(base + 11)) f_expert_c(w0, l); SEAM(base + 11); \
        if (EN(13) && IN(base + 12)) f_expert_v(w0, l); SEAM(base + 12); } while (0)
    LAYER(0);
    LAYER(1);
#undef LAYER
    if (EN(14) && IN(N_PHASES - 1)) f_final(w0);
#undef IN
#undef SEAM
}

extern "C" void kernel_launch(void* const* d_in, const int* in_sizes, int n_in, void* d_out, int out_size, void* d_ws, size_t ws_size, hipStream_t stream) {
    static int grid = 0;
    if (grid == 0) {
        if (n_in != 26 || in_sizes[0] != NB * SEQ * D || out_size != NB * SEQ * D || ws_size < WS_END) {
            fprintf(stderr, "kernel_launch: shape/workspace mismatch: n_in %d in0 %d out %d ws %zu (need %zu); nothing launched\n", n_in, n_in > 0 ? in_sizes[0] : -1, out_size, ws_size, (size_t)WS_END);
            grid = -1; return; }
        int dev = 0, cus = 0, per_cu = 0;
        if (hipGetDevice(&dev) != hipSuccess || hipDeviceGetAttribute(&cus, hipDeviceAttributeMultiprocessorCount, dev) != hipSuccess) { grid = -1; return; }
        if (hipFuncSetAttribute((const void*)mk_fwd, hipFuncAttributeMaxDynamicSharedMemorySize, LDS_BYTES) != hipSuccess) { fprintf(stderr, "kernel_launch: hipFuncSetAttribute failed\n"); grid = -1; return; }
        if (hipOccupancyMaxActiveBlocksPerMultiprocessor(&per_cu, (const void*)mk_fwd, 512, LDS_BYTES) != hipSuccess || per_cu < 1)
            fprintf(stderr, "kernel_launch: note: occupancy query reports %d workgroups per CU\n", per_cu);
        (void)hipGetLastError();
        grid = cus;
    }
    if (grid < 0) return;
    if (hipMemsetAsync((char*)d_ws + WS_CTL, 0, CTL_BYTES, stream) != hipSuccess) { fprintf(stderr, "kernel_launch: memset failed\n"); return; }
    Params p{};
    for (int i = 0; i < 26; ++i) p.in[i] = (const float*)d_in[i];
    p.out = (float*)d_out; p.ws = (unsigned char*)d_ws;
#if MK_PER_PHASE
    for (int k = 0; k < N_PHASES; ++k) { p.ph_lo = k; p.ph_hi = k + 1; hipLaunchKernelGGL(mk_fwd, dim3(grid), dim3(512), LDS_BYTES, stream, p); }
#else
    p.ph_lo = 0; p.ph_hi = N_PHASES; hipLaunchKernelGGL(mk_fwd, dim3(grid), dim3(512), LDS_BYTES, stream, p);
#endif
    const hipError_t le = hipPeekAtLastError();
    if (le != hipSuccess) fprintf(stderr, "kernel_launch: launch failed: %s\n", hipGetErrorName(le));
}
```

```cpp
#include <hip/hip_runtime.h>
#include <cstdio>
#include <cstdint>

#ifndef ATT_FAST_DIFF
#define ATT_FAST_DIFF 0
#endif
#ifndef MK_PER_PHASE
#define MK_PER_PHASE 0
#endif

constexpr int D = 1024, NB = 4, SEQ = 8192, CTX = 256, DEPTH = 2;
constexpr int RPB = CTX + SEQ;
constexpr int NR = NB * RPB;
constexpr int INC = 3200;
constexpr int GLA_Q = 0, GLA_K = 128, GLA_V = 256, GLA_R = 512, GLA_ZF = 768, GLA_ZB = 784;
constexpr int HG_Q = 800, HG_I = 1056, HG_OG = 1312, HG_ZF = 1568, HG_ZB = 1824;
constexpr int MLA_CQ = 2080, MLA_CKV = 2272, MLA_KR = 2400;
constexpr int DF_Q = 2432, DF_K = 2688, DF_V = 2944;
constexpr int NCHUNK = RPB / 64;
constexpr int NEXP = 16384;
constexpr float NORM_EPS = 1e-6f;

typedef unsigned short bf16_t;
typedef short bf16x8 __attribute__((ext_vector_type(8)));
typedef short s16x4 __attribute__((ext_vector_type(4)));
typedef float f32x16 __attribute__((ext_vector_type(16)));
typedef float f32x4 __attribute__((ext_vector_type(4)));
typedef unsigned u32x4 __attribute__((ext_vector_type(4)));
typedef unsigned u32x2 __attribute__((ext_vector_type(2)));

constexpr size_t al256(size_t x) { return (x + 255) / 256 * 256; }
constexpr size_t WS_CTL = 0;
constexpr size_t CTL_BYTES = 65536;
constexpr size_t WS_MOD = WS_CTL + CTL_BYTES;
constexpr size_t WS_XC = al256(WS_MOD + (size_t)2 * 5 * 6144 * 4);
constexpr size_t WS_WIN = al256(WS_XC + (size_t)NB * CTX * D * 4);
constexpr size_t WS_WOUT = al256(WS_WIN + (size_t)2 * INC * D * 2);
constexpr size_t WS_WQ = al256(WS_WOUT + (size_t)2 * D * D * 2);
constexpr size_t WS_WUQ = al256(WS_WQ + (size_t)2 * 2048 * D * 2);
constexpr size_t WS_WUKV = al256(WS_WUQ + (size_t)2 * 384 * 192 * 2);
constexpr size_t WS_KEYS = al256(WS_WUKV + (size_t)2 * 512 * 128 * 2);
constexpr size_t WS_HB = al256(WS_KEYS + (size_t)2 * 16 * 128 * 128 * 2);
constexpr size_t WS_QM = al256(WS_HB + (size_t)NR * D * 2);
constexpr size_t WS_KVM = al256(WS_QM + (size_t)NR * 384 * 2);
constexpr size_t WS_SG = al256(WS_KVM + (size_t)NR * 512 * 2);
constexpr size_t WS_SH = al256(WS_SG + (size_t)32 * NCHUNK * 2048 * 2);
constexpr size_t WS_DG = al256(WS_SH + (size_t)32 * NCHUNK * 4096 * 2);
constexpr size_t WS_DH = al256(WS_DG + (size_t)32 * NCHUNK * 32 * 4);
constexpr size_t WS_P = al256(WS_DH + (size_t)32 * NCHUNK * 64 * 4);
constexpr size_t WS_END = al256(WS_P + (size_t)NR * INC * 2);
constexpr size_t WS_TU8 = WS_P;
constexpr size_t WS_TV8 = WS_P + (size_t)NEXP * D;
constexpr size_t WS_SU = WS_TV8 + (size_t)NEXP * D;
constexpr size_t WS_SV = WS_SU + (size_t)NEXP * 4;
constexpr size_t WS_Q2 = WS_P + (size_t)64 * 1024 * 1024;
constexpr size_t WS_PART = WS_Q2;
static_assert(WS_SV + (size_t)NEXP * 4 <= WS_Q2, "alias overflow 0");
static_assert(WS_Q2 + (size_t)NR * 2048 * 2 <= WS_END, "alias overflow");
constexpr size_t WS_EI = WS_SG;
constexpr size_t WS_EG = WS_EI + (size_t)NR * 128 * 4;
static_assert(WS_EG + (size_t)NR * 128 * 4 <= WS_DG, "alias overflow 2");

#define XB_TMO      128
#define XB_XCNT(j)  (256  + 64 * (j))
#define XB_XSUB(j)  (1280 + 64 * (j))
#define XB_XGEN(j)  (2304 + 64 * (j))
#define XB_TOP      3328
#define XB_TOPGEN   3392
#define XCD_BAR_WORDS 3456
#define XB_SPIN_CAP (1u << 22)
#define LAS __attribute__((address_space(3)))

__device__ __forceinline__ unsigned xb_ld(unsigned* p)              { return __hip_atomic_load(p, __ATOMIC_RELAXED, __HIP_MEMORY_SCOPE_AGENT); }
__device__ __forceinline__ unsigned xb_add(unsigned* p, unsigned v) { return __hip_atomic_fetch_add(p, v, __ATOMIC_RELAXED, __HIP_MEMORY_SCOPE_AGENT); }
__device__ __forceinline__ unsigned xb_xcc_id() { return (unsigned)__builtin_amdgcn_s_getreg((3 << 11) | 20) & 0xFu; }
#define XB_SPIN(cond, bar) do { unsigned _sp = 0; while (cond) { __builtin_amdgcn_s_sleep(1); \
    if ((++_sp & 255u) == 0u) { if (xb_ld(&(bar)[XB_TMO])) break; if (_sp > XB_SPIN_CAP) { atomicAdd(&(bar)[XB_TMO], 1u); break; } } } } while (0)

struct XcdBarrier { unsigned* bar; unsigned x; volatile LAS unsigned* st; bool t0; };

__device__ __forceinline__ XcdBarrier xcd_barrier_post(unsigned* bar, volatile LAS unsigned* st, bool t0) {
    XcdBarrier b; b.bar = bar; b.x = xb_xcc_id(); b.st = st; b.t0 = t0;
    if (t0) (void)xb_add(&bar[XB_XCNT(b.x)], 1u);
    return b;
}
__device__ __forceinline__ void xcd_barrier_complete(unsigned* bar, unsigned x, unsigned& nloc, unsigned& nx) {
    const unsigned G = gridDim.x * gridDim.y * gridDim.z;
    unsigned sum, cnt, mine, sp = 0u;
    for (;;) {
        sum = 0u; cnt = 0u; mine = 0u;
#pragma unroll
        for (unsigned j = 0; j < 16; ++j) { const unsigned c = xb_ld(&bar[XB_XCNT(j)]); sum += c; cnt += (c > 0u) ? 1u : 0u; mine = (j == x) ? c : mine; }
        if (sum == G) break;
        __builtin_amdgcn_s_sleep(1);
        if ((++sp & 255u) == 0u) { if (xb_ld(&bar[XB_TMO])) break; if (sp > XB_SPIN_CAP) { atomicAdd(&bar[XB_TMO], 1u); break; } }
    }
    nloc = mine > 0u ? mine : 1u; nx = cnt > 0u ? cnt : 1u;
}
__device__ __forceinline__ void xcd_barrier(const XcdBarrier& b) {
    asm volatile("s_waitcnt vmcnt(0)" ::: "memory");
    __syncthreads();
    if (b.t0) {
        unsigned* bar = b.bar;
        __builtin_amdgcn_s_waitcnt(0);
        unsigned nloc = b.st[0], nx = b.st[1];
        if (nloc == 0u) { xcd_barrier_complete(bar, b.x, nloc, nx); b.st[0] = nloc; b.st[1] = nx; }
        const unsigned old = xb_add(&bar[XB_XSUB(b.x)], 1u);
        const unsigned gen = old / nloc;
        if (old + 1u == (gen + 1u) * nloc) {
            __builtin_amdgcn_fence(__ATOMIC_RELEASE, "agent");
            asm volatile("s_waitcnt vmcnt(0)" ::: "memory");
            const unsigned og = xb_add(&bar[XB_TOP], 1u);
            const unsigned tg = og / nx;
            if (og + 1u == (tg + 1u) * nx) xb_add(&bar[XB_TOPGEN], 1u);
            else XB_SPIN(xb_ld(&bar[XB_TOPGEN]) == tg, bar);
            __builtin_amdgcn_fence(__ATOMIC_ACQUIRE, "agent");
            xb_add(&bar[XB_XGEN(b.x)], 1u);
            asm volatile("s_waitcnt vmcnt(0)" ::: "memory");
        } else {
            XB_SPIN(xb_ld(&bar[XB_XGEN(b.x)]) == gen, bar);
            __builtin_amdgcn_fence(__ATOMIC_ACQUIRE, "agent");
            asm volatile("s_waitcnt vmcnt(0)" ::: "memory");
        }
    }
    __syncthreads();
}

typedef __bf16 bf16v2_t __attribute__((ext_vector_type(2)));
typedef float f32v2_t __attribute__((ext_vector_type(2)));
__device__ __forceinline__ unsigned cvtpk(float lo, float hi) { const f32v2_t v = {lo, hi}; const bf16v2_t b = __builtin_convertvector(v, bf16v2_t); return __builtin_bit_cast(unsigned, b); }
__device__ __forceinline__ bf16_t f2bf(float x) { const __bf16 b = (__bf16)x; return __builtin_bit_cast(bf16_t, b); }
__device__ __forceinline__ float bf2f(bf16_t h) { return __uint_as_float(((unsigned)h) << 16); }
__device__ __forceinline__ float bflo(unsigned w) { return __uint_as_float(w << 16); }
__device__ __forceinline__ float bfhi(unsigned w) { return __uint_as_float(w & 0xffff0000u); }
__device__ __forceinline__ float silu_f(float x) { return x / (1.f + __expf(-x)); }
__device__ __forceinline__ float logsigmoid_f(float z) { return fminf(z, 0.f) - __logf(1.f + __expf(-fabsf(z))); }
__device__ __forceinline__ float wave_sum(float v) {
#pragma unroll
    for (int o = 32; o >= 1; o >>= 1) v += __shfl_xor(v, o, 64);
    return v;
}
__device__ __forceinline__ void zero_acc(f32x16& a) {
#pragma unroll
    for (int r = 0; r < 16; ++r) a[r] = 0.f;
    asm volatile("" : "+v"(a));
}
__device__ __forceinline__ int crow(int r, int hi) { return (r & 3) + 8 * (r >> 2) + 4 * hi; }

struct Params { const float* in[26]; float* out; unsigned char* ws; int ph_lo, ph_hi; };
typedef const __attribute__((address_space(4))) Params* KParams;
struct Ctx {
    KParams pp;
    int tid, lane, wid;
};
__device__ __forceinline__ int mk_tid(int w0) { unsigned m = ~0u; asm volatile("" : "+s"(m)); return (w0 << 6) | (int)__builtin_amdgcn_mbcnt_hi(m, __builtin_amdgcn_mbcnt_lo(m, 0u)); }
__device__ __forceinline__ float shx(float v, int o, int lane) { return __int_as_float(__builtin_amdgcn_ds_bpermute((lane ^ o) << 2, __float_as_int(v))); }
__device__ __forceinline__ Ctx fresh_ctx(int w0) {
    Ctx c; unsigned long long a = (unsigned long long)__builtin_amdgcn_kernarg_segment_ptr(); asm volatile("" : "+s"(a)); c.pp = (KParams)a;
    int t = mk_tid(w0); asm volatile("" : "+v"(t)); c.tid = t; c.lane = t & 63; c.wid = w0;
    return c;
}
#define CIN(i)   (c.pp->in[i])
#define COUT     (c.pp->out)
#define CWS(off) (c.pp->ws + (off))
#define C_MODT ((float*)CWS(WS_MOD))
#define C_XC   ((float*)CWS(WS_XC))
#define C_WIN  ((bf16_t*)CWS(WS_WIN))
#define C_WOUT ((bf16_t*)CWS(WS_WOUT))
#define C_WQ   ((bf16_t*)CWS(WS_WQ))
#define C_WUQ  ((bf16_t*)CWS(WS_WUQ))
#define C_WUKV ((bf16_t*)CWS(WS_WUKV))
#define C_KEYS ((bf16_t*)CWS(WS_KEYS))
#define C_HB   ((bf16_t*)CWS(WS_HB))
#define C_QM   ((bf16_t*)CWS(WS_QM))
#define C_KVM  ((bf16_t*)CWS(WS_KVM))
#define C_P    ((bf16_t*)CWS(WS_P))
#define C_TU8  ((unsigned char*)CWS(WS_TU8))
#define C_TV8  ((unsigned char*)CWS(WS_TV8))
#define C_SU   ((float*)CWS(WS_SU))
#define C_SV   ((float*)CWS(WS_SV))
#define C_PART ((float*)CWS(WS_PART))
#define C_Q2   ((bf16_t*)CWS(WS_Q2))
#define C_SG   ((bf16_t*)CWS(WS_SG))
#define C_SH   ((bf16_t*)CWS(WS_SH))
#define C_DG   ((float*)CWS(WS_DG))
#define C_DH   ((float*)CWS(WS_DH))
#define C_EI   ((int*)CWS(WS_EI))
#define C_EG   ((float*)CWS(WS_EG))

__device__ __forceinline__ float* xrow(const Ctx& c, int r) {
    const int b = r / RPB, j = r - b * RPB;
    return j < CTX ? C_XC + ((size_t)(b * CTX + j) << 10) : COUT + ((size_t)(b * SEQ + (j - CTX)) << 10);
}
__device__ __forceinline__ const float* inrow(const Ctx& c, int r) {
    const int b = r / RPB, j = r - b * RPB;
    return j < CTX ? CIN(2) + ((size_t)(b * CTX + j) << 10) : CIN(0) + ((size_t)(b * SEQ + (j - CTX)) << 10);
}

__device__ void p0_mod_item(const Ctx& c, int item, char* lds) {
    float* sc = (float*)lds;
    float* red = sc + 5 * 1024;
    const int tid = c.tid;
    for (int i = tid; i < 5 * 1024; i += 512) { const int v = i >> 10, k = i & 1023; const float x = (v < 4) ? CIN(1)[v * 1024 + k] : CIN(3)[k]; sc[i] = silu_f(x); }
    __syncthreads();
    const int l = item / 96, n0 = (item % 96) * 64;
    const int col = tid & 63, kg = tid >> 6;
    const float* w = CIN(4) + (size_t)l * 1024 * 6144 + n0 + col;
    float a[5] = {0.f, 0.f, 0.f, 0.f, 0.f};
#pragma unroll 8
    for (int kk = 0; kk < 128; ++kk) { const int k = kg * 128 + kk; const float wv = w[(size_t)k * 6144];
#pragma unroll
        for (int v = 0; v < 5; ++v) a[v] += sc[v * 1024 + k] * wv; }
#pragma unroll
    for (int v = 0; v < 5; ++v) red[(kg * 64 + col) * 5 + v] = a[v];
    __syncthreads();
    if (tid < 320) { const int cc = tid / 5, v = tid % 5; float s = 0.f;
#pragma unroll
        for (int g = 0; g < 8; ++g) s += red[(g * 64 + cc) * 5 + v];
        C_MODT[((size_t)l * 5 + v) * 6144 + n0 + cc] = s + CIN(5)[l * 6144 + n0 + cc]; }
    __syncthreads();
}
__device__ void p0_tr_tile(const float* __restrict__ src, bf16_t* __restrict__ dst, int K, int N, int k0, int n0, int tid, char* lds) {
    float* t = (float*)lds;
#pragma unroll
    for (int i = 0; i < 2; ++i) { const int k = (tid >> 4) + 32 * i, n4 = (tid & 15) * 4;
        const f32x4 v = *(const f32x4*)(src + (size_t)(k0 + k) * N + n0 + n4);
        t[k * 65 + n4 + 0] = v[0]; t[k * 65 + n4 + 1] = v[1]; t[k * 65 + n4 + 2] = v[2]; t[k * 65 + n4 + 3] = v[3]; }
    __syncthreads();
    { const int n = tid >> 3, k8 = (tid & 7) * 8; u32x4 w;
#pragma unroll
        for (int j = 0; j < 4; ++j) w[j] = cvtpk(t[(k8 + 2 * j) * 65 + n], t[(k8 + 2 * j + 1) * 65 + n]);
        *(u32x4*)(dst + (size_t)(n0 + n) * K + k0 + k8) = w; }
    __syncthreads();
}
__device__ void ph_p0(const Ctx& c, char* lds) {
    constexpr int T_WIN = 16 * 50, T_WOUT = 16 * 16, T_WQ = 16 * 32, T_UQ = 3 * 6, T_UKV = 2 * 8;
    constexpr int PER_L = T_WIN + T_WOUT + T_WQ + T_UQ + T_UKV;
    constexpr int NITEM = 192 + 2 * PER_L;
    for (int it = blockIdx.x; it < NITEM; it += gridDim.x) {
        if (it < 192) { p0_mod_item(c, it, lds); continue; }
        int t = it - 192; const int l = t / PER_L; t -= l * PER_L;
        if (t < T_WIN) { p0_tr_tile(CIN(8) + (size_t)l * D * INC, C_WIN + (size_t)l * INC * D, D, INC, (t / 50) * 64, (t % 50) * 64, c.tid, lds); continue; } t -= T_WIN;
        if (t < T_WOUT) { p0_tr_tile(CIN(9) + (size_t)l * D * D, C_WOUT + (size_t)l * D * D, D, D, (t / 16) * 64, (t % 16) * 64, c.tid, lds); continue; } t -= T_WOUT;
        if (t < T_WQ) { p0_tr_tile(CIN(21) + (size_t)l * D * 2048, C_WQ + (size_t)l * 2048 * D, D, 2048, (t / 32) * 64, (t % 32) * 64, c.tid, lds); continue; } t -= T_WQ;
        if (t < T_UQ) { p0_tr_tile(CIN(17) + (size_t)l * 192 * 384, C_WUQ + (size_t)l * 384 * 192, 192, 384, (t / 6) * 64, (t % 6) * 64, c.tid, lds); continue; } t -= T_UQ;
        p0_tr_tile(CIN(18) + (size_t)l * 128 * 512, C_WUKV + (size_t)l * 512 * 128, 128, 512, (t / 8) * 64, (t % 8) * 64, c.tid, lds);
    }
    const size_t nk8 = (size_t)2 * 16 * 128 * 128 / 8;
    for (size_t i = (size_t)blockIdx.x * 512 + c.tid; i < nk8; i += (size_t)gridDim.x * 512) {
        const f32x4 a = *(const f32x4*)(CIN(22) + i * 8), b = *(const f32x4*)(CIN(22) + i * 8 + 4);
        u32x4 w = {cvtpk(a[0], a[1]), cvtpk(a[2], a[3]), cvtpk(b[0], b[1]), cvtpk(b[2], b[3])};
        *(u32x4*)(C_KEYS + i * 8) = w;
    }
}

template <int WHICH>
__device__ void ph_norm(const Ctx& c, int l) {
    const float* g = CIN(WHICH == 0 ? 6 : 7) + l * D;
    const bool need_ctx = (l < DEPTH - 1);
    const int stride = gridDim.x * 8;
    auto next_row = [&](int r) { for (; r < NR; r += stride) { const int j = r % RPB; if (!(WHICH == 1 && j < CTX && !need_ctx)) break; } return r; };
    auto row_src = [&](int r) { return (WHICH == 0 && l == 0) ? inrow(c, r) : (const float*)xrow(c, r); };
    int r = next_row(blockIdx.x * 8 + c.wid);
    f32x4 xn[4];
    if (r < NR) { const float* src = row_src(r);
#pragma unroll
        for (int i = 0; i < 4; ++i) xn[i] = *(const f32x4*)(src + i * 256 + c.lane * 4); }
    while (r < NR) {
        f32x4 x[4];
#pragma unroll
        for (int i = 0; i < 4; ++i) x[i] = xn[i];
        const int rn = next_row(r + stride);
        if (rn < NR) { const float* src = row_src(rn);
#pragma unroll
            for (int i = 0; i < 4; ++i) xn[i] = *(const f32x4*)(src + i * 256 + c.lane * 4); }
        const int b = r / RPB, j = r - b * RPB; const bool isctx = j < CTX;
        float ss = 0.f;
#pragma unroll
        for (int i = 0; i < 4; ++i) ss += x[i][0] * x[i][0] + x[i][1] * x[i][1] + x[i][2] * x[i][2] + x[i][3] * x[i][3];
        ss = wave_sum(ss);
        const float rstd = rsqrtf(ss * (1.f / D) + NORM_EPS);
        const float* mt = C_MODT + ((size_t)l * 5 + (isctx ? 4 : b)) * 6144;
        const float* sh = mt + (WHICH == 0 ? 0 : 3) * D; const float* scl = mt + (WHICH == 0 ? 1 : 4) * D;
        bf16_t* dst = C_HB + (size_t)r * D;
        float* xr = xrow(c, r);
#pragma unroll
        for (int i = 0; i < 4; ++i) { const int col = i * 256 + c.lane * 4;
            const f32x4 gv = *(const f32x4*)(g + col), sv = *(const f32x4*)(sh + col), cv = *(const f32x4*)(scl + col);
            float y[4];
#pragma unroll
            for (int e = 0; e < 4; ++e) y[e] = x[i][e] * rstd * gv[e] * (1.f + cv[e]) + sv[e];
            u32x2 w = {cvtpk(y[0], y[1]), cvtpk(y[2], y[3])};
            *(u32x2*)(dst + col) = w;
            if (WHICH == 0 && l == 0) *(f32x4*)(xr + col) = x[i]; }
        r = rn;
    }
}

constexpr int GEMM_LDS = 98304;
template <class Epi>
__device__ __forceinline__ void gemm_tile(const Ctx& c, const bf16_t* __restrict__ A, int lda, const bf16_t* __restrict__ Bt, int ldb, int K, int m0, int n0, char* lds, const Epi& epi) {
    const int tid = c.tid, lane = tid & 63, wid = tid >> 6, r32 = lane & 31, hi = lane >> 5, wm = wid >> 1, wn = wid & 1;
    char* As = lds; char* Bs = lds + 65536;
    f32x16 acc[2][2];
#pragma unroll
    for (int m = 0; m < 2; ++m)
#pragma unroll
        for (int n = 0; n < 2; ++n) zero_acc(acc[m][n]);
    u32x4 ra[4], rb[2];
    const int srow = tid >> 3, sch = tid & 7;
    const bf16_t* Ag = A + (size_t)(m0 + srow) * lda + sch * 8;
    const bf16_t* Bg = Bt + (size_t)(n0 + srow) * ldb + sch * 8;
    const int swoff = srow * 128 + ((sch ^ ((srow >> 1) & 7)) << 4);
#define GLOAD(k0) do { _Pragma("unroll") for (int i = 0; i < 4; ++i) ra[i] = *(const u32x4*)(Ag + (size_t)(64 * i) * lda + (k0)); \
                       _Pragma("unroll") for (int i = 0; i < 2; ++i) rb[i] = *(const u32x4*)(Bg + (size_t)(64 * i) * ldb + (k0)); } while (0)
#define SWRITE(buf) do { _Pragma("unroll") for (int i = 0; i < 4; ++i) *(u32x4*)(As + (buf) * 32768 + swoff + i * 8192) = ra[i]; \
                         _Pragma("unroll") for (int i = 0; i < 2; ++i) *(u32x4*)(Bs + (buf) * 16384 + swoff + i * 8192) = rb[i]; } while (0)
    const int nk = K >> 6;
    GLOAD(0); SWRITE(0); __syncthreads();
    for (int kt = 0; kt < nk; ++kt) {
        const int buf = kt & 1;
        if (kt + 1 < nk) GLOAD((kt + 1) * 64);
        const char* Ab = As + buf * 32768; const char* Bb = Bs + buf * 16384;
#pragma unroll
        for (int ks = 0; ks < 4; ++ks) {
            bf16x8 a[2], b[2];
#pragma unroll
            for (int m = 0; m < 2; ++m) { const int row = wm * 64 + m * 32 + r32; a[m] = *(const bf16x8*)(Ab + row * 128 + (((ks * 2 + hi) ^ ((row >> 1) & 7)) << 4)); }
#pragma unroll
            for (int n = 0; n < 2; ++n) { const int row = wn * 64 + n * 32 + r32; b[n] = *(const bf16x8*)(Bb + row * 128 + (((ks * 2 + hi) ^ ((row >> 1) & 7)) << 4)); }
#pragma unroll
            for (int m = 0; m < 2; ++m)
#pragma unroll
                for (int n = 0; n < 2; ++n) acc[m][n] = __builtin_amdgcn_mfma_f32_32x32x16_bf16(a[m], b[n], acc[m][n], 0, 0, 0);
        }
        if (kt + 1 < nk) SWRITE(buf ^ 1);
        __syncthreads();
    }
#undef GLOAD
#undef SWRITE
    epi(acc, m0 + wm * 64, n0 + wn * 64, r32, hi);
}
struct EpiBf16 {
    bf16_t* C; int ldc; float scale;
    __device__ __forceinline__ void operator()(const f32x16 (&acc)[2][2], int row0, int col0, int r32, int hi) const {
        bf16_t* base = C + (size_t)(row0 + 4 * hi) * ldc + col0 + r32;
#pragma unroll
        for (int m = 0; m < 2; ++m)
#pragma unroll
            for (int r = 0; r < 16; ++r) { bf16_t* p = base + (size_t)(m * 32 + (r & 3) + 8 * (r >> 2)) * ldc;
                p[0] = f2bf(acc[m][0][r] * scale); p[32] = f2bf(acc[m][1][r] * scale);
                asm volatile("" ::: "memory"); }
    }
};

template <int MX> struct ScanCfg;
template <> struct ScanCfg<0> { static constexpr int DK = 32; };
template <> struct ScanCfg<1> { static constexpr int DK = 64; };

constexpr int BP = 72;
typedef float f32x4v __attribute__((ext_vector_type(4)));
__device__ __forceinline__ bf16x8 frag16(const bf16_t* tile, int row0, int k0, int lane) { return *(const bf16x8*)(tile + (row0 + (lane & 15)) * BP + k0 + 8 * (lane >> 4)); }

constexpr int SCAN_TAB_OFF = 128000;
__device__ __forceinline__ void scan_tables(const Ctx& c, int l, char* lds) {
    float* wtab = (float*)(lds + SCAN_TAB_OFF); float* btab = wtab + 2 * 16 * 128; float* lbtab = btab + 2 * 128;
    for (int i = c.tid; i < 2 * 16 * 128; i += 512) wtab[i] = CIN(10)[(size_t)l * 2 * 16 * 128 + i];
    if (c.tid < 256) { btab[c.tid] = CIN(11)[(size_t)l * 256 + c.tid];
        float lb = 0.f; if (l > 0) { const float r0 = CIN(13)[c.tid], r1 = CIN(13)[256 + c.tid]; lb = 1.f / (1.f + __expf(r0 - r1)); }
        lbtab[c.tid] = lb; }
    __syncthreads();
}
template <int MX, bool WANT_Q>
__device__ __forceinline__ void scan_load(const Ctx& c, int l, int b, int h, int cc, int dir, float* qt, float* kt, float* gt, bf16_t* VT, float* tmp, const char* ldsb) {
    constexpr int DK = ScanCfg<MX>::DK, PK = DK + 1;
    const int tid = c.tid;
    const int t = tid >> 3, j0 = (tid & 7) * 8;
    const bf16_t* pr = C_P + (size_t)(b * RPB + cc * 64 + (dir ? 63 - t : t)) * INC;
    const u32x4 vv = *(const u32x4*)(pr + (MX == 0 ? GLA_V : HG_I) + h * 64 + j0);
    if (MX == 0) {
        float* zt = tmp; const float* wt = (const float*)(ldsb + SCAN_TAB_OFF) + dir * 16 * 128 + h * 32; const float* bt = (const float*)(ldsb + SCAN_TAB_OFF) + 2 * 16 * 128 + dir * 128 + h * 32;
        const int j4 = (tid & 7) * 4;
        const u32x2 kv = *(const u32x2*)(pr + GLA_K + h * 32 + j4);
        u32x2 qv = {0u, 0u}; if (WANT_Q) qv = *(const u32x2*)(pr + GLA_Q + h * 32 + j4);
        u32x4 zv = {0u, 0u, 0u, 0u};
        if (tid < 128) zv = *(const u32x4*)(C_P + (size_t)(b * RPB + cc * 64 + (dir ? 63 - (tid >> 1) : (tid >> 1))) * INC + (dir ? GLA_ZB : GLA_ZF) + (tid & 1) * 8);
        if (tid < 128) { float* zp = zt + (tid >> 1) * 16 + (tid & 1) * 8;
#pragma unroll
            for (int q = 0; q < 4; ++q) { zp[2 * q] = bflo(zv[q]); zp[2 * q + 1] = bfhi(zv[q]); } }
        __syncthreads();
#pragma unroll
        for (int e = 0; e < 4; ++e) { const int j = j4 + e;
            float a = bt[j];
#pragma unroll
            for (int k = 0; k < 16; ++k) a += zt[t * 16 + k] * wt[k * 128 + j];
            gt[t * PK + j] = logsigmoid_f(a) * (1.f / 16.f);
            kt[t * PK + j] = (e & 1) ? bfhi(kv[e >> 1]) : bflo(kv[e >> 1]);
            if (WANT_Q) qt[t * PK + j] = ((e & 1) ? bfhi(qv[e >> 1]) : bflo(qv[e >> 1])) * 0.17677669529663687f; }
    } else {
        const u32x4 zv = *(const u32x4*)(pr + (dir ? HG_ZB : HG_ZF) + h * 64 + j0);
        u32x4 qv = {0u, 0u, 0u, 0u}; if (WANT_Q) qv = *(const u32x4*)(pr + HG_Q + h * 64 + j0);
        float lbv[8];
        { const float* lbt = (const float*)(ldsb + SCAN_TAB_OFF) + 2 * 16 * 128 + 2 * 128 + h * 64 + j0;
#pragma unroll
          for (int e = 0; e < 8; ++e) lbv[e] = lbt[e]; }
#pragma unroll
        for (int e = 0; e < 8; ++e) { const int j = j0 + e;
            const float z = fminf(fmaxf((e & 1) ? bfhi(zv[e >> 1]) : bflo(zv[e >> 1]), -80.f), 80.f); const float lb = lbv[e];
            const float ez = __expf(-z), sg = __builtin_amdgcn_rcpf(1.f + ez);
            gt[t * PK + j] = fmaxf(__logf(lb + (1.f - lb) * sg), -69.07755279f);
            kt[t * PK + j] = (1.f - lb) * ez * sg;
            if (WANT_Q) { const float qz = (e & 1) ? bfhi(qv[e >> 1]) : bflo(qv[e >> 1]); qt[t * PK + j] = qz * __builtin_amdgcn_rcpf(1.f + __expf(-qz)); } }
    }
#pragma unroll
    for (int e = 0; e < 8; ++e) VT[(j0 + e) * BP + t] = (bf16_t)((e & 1) ? (vv[e >> 1] >> 16) : (vv[e >> 1] & 0xffffu));
    __syncthreads();
    { float x[DK / 8];
#pragma unroll
        for (int u = 0; u < DK / 8; ++u) x[u] = gt[c.lane * PK + c.wid + 8 * u];
#pragma unroll
        for (int d = 1; d < 64; d <<= 1)
#pragma unroll
            for (int u = 0; u < DK / 8; ++u) { const float y = __shfl_up(x[u], d, 64); if (c.lane >= d) x[u] += y; }
#pragma unroll
        for (int u = 0; u < DK / 8; ++u) gt[c.lane * PK + c.wid + 8 * u] = x[u]; }
    __syncthreads();
}

template <int MX>
__device__ void scanA_item(const Ctx& c, int l, int b, int h, int cc, int dir, char* lds) {
    constexpr int DK = ScanCfg<MX>::DK, PK = DK + 1;
    float* kt = (float*)lds; float* gt = kt + 64 * PK; bf16_t* VT = (bf16_t*)(gt + 64 * PK); bf16_t* KET = VT + 64 * BP; float* tmp = (float*)(KET + 64 * BP);
    scan_load<MX, false>(c, l, b, h, cc, dir, nullptr, kt, gt, VT, tmp, lds);
    const int tid = c.tid, lane = c.lane;
    for (int i = tid; i < 64 * DK; i += 512) { const int s_ = i & 63, k = i >> 6; KET[k * BP + s_] = f2bf(kt[s_ * PK + k] * __expf(gt[63 * PK + k] - gt[s_ * PK + k])); }
    __syncthreads();
    const int ch = (b * 4 + h) * 2 + dir;
    bf16_t* S = (MX == 0 ? C_SG : C_SH) + ((size_t)ch * NCHUNK + cc) * (DK * 64);
    for (int tile = c.wid; tile < (DK / 16) * 4; tile += 8) { const int tk = tile >> 2, tj = tile & 3;
        f32x4v acc = {0.f, 0.f, 0.f, 0.f};
#pragma unroll
        for (int ks = 0; ks < 2; ++ks) acc = __builtin_amdgcn_mfma_f32_16x16x32_bf16(frag16(KET, tk * 16, ks * 32, lane), frag16(VT, tj * 16, ks * 32, lane), acc, 0, 0, 0);
#pragma unroll
        for (int i = 0; i < 4; ++i) S[(tk * 16 + 4 * (lane >> 4) + i) * 64 + tj * 16 + (lane & 15)] = f2bf(acc[i]); }
    if (tid < DK) (MX == 0 ? C_DG : C_DH)[((size_t)ch * NCHUNK + cc) * DK + tid] = __expf(gt[63 * PK + tid]);
    __syncthreads();
}
__device__ void scanB_item(const Ctx& c, int item) {
    const int e = item * 512 + c.tid;
    const bool hg = e >= 65536; const int ee = hg ? e - 65536 : e;
    const int DK = hg ? 64 : 32; const int per = DK * 64;
    const int ch = ee / per, ij = ee % per, i = ij >> 6; const int dir = ch & 1;
    bf16_t* S = (hg ? C_SH : C_SG) + (size_t)ch * NCHUNK * per + ij;
    const float* Dc = (hg ? C_DH : C_DG) + (size_t)ch * NCHUNK * DK + i;
    float st = 0.f;
    for (int n0 = 0; n0 < NCHUNK; n0 += 6) {
        float sv[6], dv[6];
#pragma unroll
        for (int u = 0; u < 6; ++u) { const int n = n0 + u; const int cc = dir ? (n < 4 ? 3 - n : 135 - n) : n; sv[u] = bf2f(S[(size_t)cc * per]); dv[u] = Dc[(size_t)cc * DK]; }
#pragma unroll
        for (int u = 0; u < 6; ++u) { const int n = n0 + u; const int cc = dir ? (n < 4 ? 3 - n : 135 - n) : n; S[(size_t)cc * per] = f2bf(st); st = dv[u] * st + sv[u]; }
    }
}
template <int MX>
__device__ void scanC_item(const Ctx& c, int l, int b, int h, int cc, char* lds) {
    constexpr int DK = ScanCfg<MX>::DK, PK = DK + 1;
    float* qt = (float*)lds; float* kt = qt + 64 * PK; float* gt = kt + 64 * PK; float* ot = gt + 64 * PK;
    bf16_t* VT = (bf16_t*)(ot + 64 * 65); bf16_t* QS = VT + 64 * BP; bf16_t* QG = QS + 64 * BP; bf16_t* KS = QG + 64 * BP;
    bf16_t* SC = KS + 96 * BP; bf16_t* ST = SC + 64 * BP; float* tmp = (float*)(ST + 64 * BP);
    const int tid = c.tid, lane = c.lane;
    for (int dir = 0; dir < 2; ++dir) {
        scan_load<MX, true>(c, l, b, h, cc, dir, qt, kt, gt, VT, tmp, lds);
        const int ch = (b * 4 + h) * 2 + dir;
        const bf16_t* Sg = (MX == 0 ? C_SG : C_SH) + ((size_t)ch * NCHUNK + cc) * (DK * 64);
        if (tid < DK * 8) { const int k = tid >> 3, jb = (tid & 7) * 8; const u32x4 sr = *(const u32x4*)(Sg + tid * 8);
#pragma unroll
            for (int e = 0; e < 8; ++e) ST[(jb + e) * BP + k] = (bf16_t)((e & 1) ? (sr[e >> 1] >> 16) : (sr[e >> 1] & 0xffffu)); }
        for (int i = tid; i < 64 * DK; i += 512) { const int t = i / DK, k = i % DK; const int I = t >> 4;
            const float bt = gt[t * PK + k], qv = qt[t * PK + k], kv = kt[t * PK + k];
            const float Bi = I ? gt[(16 * I - 1) * PK + k] : 0.f;
            QS[t * BP + k] = f2bf(qv * __expf(bt - Bi));
            QG[t * BP + k] = f2bf(qv * __expf(bt));
            if (t < 16) KS[t * BP + k] = f2bf(kv * __expf(gt[15 * PK + k] - bt));
            if (t < 32) KS[(16 + t) * BP + k] = f2bf(kv * __expf(gt[31 * PK + k] - bt));
            if (t < 48) KS[(48 + t) * BP + k] = f2bf(kv * __expf(gt[47 * PK + k] - bt)); }
        { const int blk = tid >> 7, tl = (tid >> 3) & 15, s0 = (tid & 7) * 2; const int t = blk * 16 + tl;
            float a0 = 0.f, a1 = 0.f;
            if (s0 <= tl) { const int sa = blk * 16 + s0, sb = sa + 1;
                for (int k = 0; k < DK; ++k) { const float qv = qt[t * PK + k], bv = gt[t * PK + k];
                    a0 += qv * kt[sa * PK + k] * __expf(fminf(bv - gt[sa * PK + k], 0.f));
                    a1 += qv * kt[sb * PK + k] * __expf(fminf(bv - gt[sb * PK + k], 0.f)); }
                if (s0 + 1 > tl) a1 = 0.f; }
            SC[t * BP + blk * 16 + s0] = f2bf(a0); SC[t * BP + blk * 16 + s0 + 1] = f2bf(a1);
            for (int J = blk + 1; J < 4; ++J) { SC[t * BP + J * 16 + s0] = 0; SC[t * BP + J * 16 + s0 + 1] = 0; } }
        __syncthreads();
        if (c.wid < 6) { const int I = c.wid < 1 ? 1 : (c.wid < 3 ? 2 : 3), J = c.wid < 1 ? 0 : (c.wid < 3 ? c.wid - 1 : c.wid - 3);
            const bf16_t* KSI = KS + (I == 1 ? 0 : (I == 2 ? 16 : 48)) * BP;
            f32x4v acc = {0.f, 0.f, 0.f, 0.f};
#pragma unroll
            for (int ks = 0; ks < DK / 32; ++ks) acc = __builtin_amdgcn_mfma_f32_16x16x32_bf16(frag16(QS, I * 16, ks * 32, lane), frag16(KSI, J * 16, ks * 32, lane), acc, 0, 0, 0);
#pragma unroll
            for (int i = 0; i < 4; ++i) SC[(I * 16 + 4 * (lane >> 4) + i) * BP + J * 16 + (lane & 15)] = f2bf(acc[i]); }
        __syncthreads();
#pragma unroll
        for (int u = 0; u < 2; ++u) { const int tile = c.wid * 2 + u; const int ti = tile >> 2, tj = tile & 3;
            f32x4v acc = {0.f, 0.f, 0.f, 0.f};
#pragma unroll
            for (int ks = 0; ks < 2; ++ks) acc = __builtin_amdgcn_mfma_f32_16x16x32_bf16(frag16(SC, ti * 16, ks * 32, lane), frag16(VT, tj * 16, ks * 32, lane), acc, 0, 0, 0);
#pragma unroll
            for (int ks = 0; ks < DK / 32; ++ks) acc = __builtin_amdgcn_mfma_f32_16x16x32_bf16(frag16(QG, ti * 16, ks * 32, lane), frag16(ST, tj * 16, ks * 32, lane), acc, 0, 0, 0);
#pragma unroll
            for (int i = 0; i < 4; ++i) { const int t = ti * 16 + 4 * (lane >> 4) + i; const int to = dir ? 63 - t : t; float* op = ot + to * 65 + tj * 16 + (lane & 15);
                if (dir == 0) *op = acc[i]; else *op += acc[i]; } }
        __syncthreads();
    }
    { const int t = tid >> 3, j0 = (tid & 7) * 8; float o[8]; float ss = 0.f;
#pragma unroll
        for (int j = 0; j < 8; ++j) { o[j] = ot[t * 65 + j0 + j]; ss += o[j] * o[j]; }
        ss += __shfl_xor(ss, 1, 64); ss += __shfl_xor(ss, 2, 64); ss += __shfl_xor(ss, 4, 64);
        const float rstd = rsqrtf(ss * (1.f / 64.f) + NORM_EPS);
        const int r = b * RPB + cc * 64 + t;
        const float* gn = CIN(MX == 0 ? 12 : 14) + l * 64;
        const u32x4 gp = *(const u32x4*)(C_P + (size_t)r * INC + (MX == 0 ? GLA_R : HG_OG) + h * 64 + j0);
        float y[8];
#pragma unroll
        for (int j = 0; j < 8; ++j) y[j] = o[j] * rstd * gn[j0 + j] * silu_f((j & 1) ? bfhi(gp[j >> 1]) : bflo(gp[j >> 1]));
        u32x4 w = {cvtpk(y[0], y[1]), cvtpk(y[2], y[3]), cvtpk(y[4], y[5]), cvtpk(y[6], y[7])};
        *(u32x4*)(C_HB + (size_t)r * D + MX * 256 + h * 64 + j0) = w; }
    __syncthreads();
}

__device__ __forceinline__ void rope_cs(int pos, int i, float& cs, float& sn) {
    const float freq = __expf(-(float)i * (9.210340371976184f / 8.f));
    const float ang = (float)pos * freq;
    const float n = rintf(ang * 0.15915494309189535f);
    float rr = fmaf(-n, 6.2831854820251465f, ang); rr = fmaf(-n, -1.7484555e-7f, rr);
    cs = __cosf(rr); sn = __sinf(rr);
}

__device__ void ph_prep_rows(const Ctx& c, int l) {
    const float* gq = CIN(15) + l * 192; const float* gkv = CIN(16) + l * 128;
    for (int r = blockIdx.x * 8 + c.wid; r < NR; r += gridDim.x * 8) {
        const int b = r / RPB, j = r - b * RPB; bf16_t* pr = C_P + (size_t)r * INC;
        { float v[3]; float ss = 0.f;
#pragma unroll
            for (int i = 0; i < 3; ++i) { v[i] = bf2f(pr[MLA_CQ + c.lane + 64 * i]); ss += v[i] * v[i]; }
            ss = wave_sum(ss); const float rstd = rsqrtf(ss * (1.f / 192.f) + NORM_EPS);
#pragma unroll
            for (int i = 0; i < 3; ++i) pr[MLA_CQ + c.lane + 64 * i] = f2bf(v[i] * rstd * gq[c.lane + 64 * i]); }
        { float v[2]; float ss = 0.f;
#pragma unroll
            for (int i = 0; i < 2; ++i) { v[i] = bf2f(pr[MLA_CKV + c.lane + 64 * i]); ss += v[i] * v[i]; }
            ss = wave_sum(ss); const float rstd = rsqrtf(ss * (1.f / 128.f) + NORM_EPS);
#pragma unroll
            for (int i = 0; i < 2; ++i) pr[MLA_CKV + c.lane + 64 * i] = f2bf(v[i] * rstd * gkv[c.lane + 64 * i]); }
        if (j >= CTX) { const int t = j - CTX; const int prow = t >> 6, pcol = t & 63;
            for (int pp = c.lane; pp < 34 * 8; pp += 64) { const int g = pp >> 3, i = pp & 7;
                int col; if (g < 16) col = DF_Q + (g >> 1) * 32 + (g & 1) * 16; else if (g < 32) col = DF_K + ((g - 16) >> 1) * 32 + (g & 1) * 16; else col = MLA_KR + (g - 32) * 16;
                float cs, sn; rope_cs((g & 1) ? pcol : prow, i, cs, sn);
                const float x1 = bf2f(pr[col + i]), x2 = bf2f(pr[col + 8 + i]);
                pr[col + i] = f2bf(x1 * cs - x2 * sn); pr[col + 8 + i] = f2bf(x1 * sn + x2 * cs); } }
    }
}
__device__ void ph_rope_q(const Ctx& c) {
    for (int r = blockIdx.x * 8 + c.wid; r < NR; r += gridDim.x * 8) {
        const int b = r / RPB, j = r - b * RPB; if (j < CTX) continue;
        const int t = j - CTX; const int prow = t >> 6, pcol = t & 63;
        const int h = c.lane >> 4, g = (c.lane >> 3) & 1, i = c.lane & 7;
        bf16_t* q = C_QM + (size_t)r * 384 + h * 96 + 64 + g * 16;
        float cs, sn; rope_cs(g ? pcol : prow, i, cs, sn);
        const float x1 = bf2f(q[i]), x2 = bf2f(q[8 + i]);
        q[i] = f2bf(x1 * cs - x2 * sn); q[8 + i] = f2bf(x1 * sn + x2 * cs);
    }
}

__device__ __forceinline__ int v_st(int k, int cidx) { const int kk = (k & ~0xC) | ((k & 4) << 1) | ((k & 8) >> 1); return ((kk >> 3) * 2 + (cidx >> 5)) * 512 + ((kk & 7) * 32 + (cidx & 31)) * 2; }
__device__ __forceinline__ int v_rd_base(int lane) { return ((lane & 3) << 3) | (((lane >> 2) & 3) << 6) | (((lane >> 4) & 1) << 5) | (((lane >> 5) & 1) << 8); }
constexpr int v_rd_off(int d0, int ks, int half) { return d0 * 512 + ks * 2048 + half * 1024; }
template <int OFF> __device__ __forceinline__ s16x4 tr_read(int vb) { s16x4 r; asm volatile("ds_read_b64_tr_b16 %0, %1 offset:%2" : "=&v"(r) : "v"(vb), "i"(OFF) : "memory"); return r; }
template <int D0> __device__ __forceinline__ void pv_one(f32x16& od, int vb, bf16x8 pa0, bf16x8 pa1, bf16x8 pa2, bf16x8 pa3) {
    const s16x4 l0 = tr_read<v_rd_off(D0, 0, 0)>(vb), h0 = tr_read<v_rd_off(D0, 0, 1)>(vb), l1 = tr_read<v_rd_off(D0, 1, 0)>(vb), h1 = tr_read<v_rd_off(D0, 1, 1)>(vb);
    const s16x4 l2 = tr_read<v_rd_off(D0, 2, 0)>(vb), h2 = tr_read<v_rd_off(D0, 2, 1)>(vb), l3 = tr_read<v_rd_off(D0, 3, 0)>(vb), h3 = tr_read<v_rd_off(D0, 3, 1)>(vb);
    asm volatile("s_waitcnt lgkmcnt(0)" ::: "memory"); __builtin_amdgcn_sched_barrier(0);
#define PKV(L, H) (bf16x8){L[0], L[1], L[2], L[3], H[0], H[1], H[2], H[3]}
    od = __builtin_amdgcn_mfma_f32_32x32x16_bf16(pa0, PKV(l0, h0), od, 0, 0, 0);
    od = __builtin_amdgcn_mfma_f32_32x32x16_bf16(pa1, PKV(l1, h1), od, 0, 0, 0);
    od = __builtin_amdgcn_mfma_f32_32x32x16_bf16(pa2, PKV(l2, h2), od, 0, 0, 0);
    od = __builtin_amdgcn_mfma_f32_32x32x16_bf16(pa3, PKV(l3, h3), od, 0, 0, 0);
#undef PKV
}
constexpr float ATT_BIG = 1.0995116e12f;
constexpr float ATT_ZBIG = 1.2379400392853803e27f, ATT_ZSMALL = 8.673617379884035e-19f;
__device__ __forceinline__ float rowmax_tile(const f32x16& p0, const f32x16& p1) {
    float pmax = p0[0];
#pragma unroll
    for (int r = 1; r < 16; ++r) pmax = fmaxf(pmax, p0[r]);
#pragma unroll
    for (int r = 0; r < 16; ++r) pmax = fmaxf(pmax, p1[r]);
    auto rr = __builtin_amdgcn_permlane32_swap(__float_as_uint(pmax), __float_as_uint(pmax), false, false);
    return fmaxf(__uint_as_float(rr[0]), __uint_as_float(rr[1]));
}
__device__ __forceinline__ void softmax_tile(f32x16& p0, f32x16& p1, float& M, const float Mused, float& l_reg, const bool first,
                                             bf16x8& pa0, bf16x8& pa1, bf16x8& pa2, bf16x8& pa3, f32x16 (&o)[2], float* wsl, const int r32, const int hi) {
    if (__builtin_expect(__any(Mused != M), 0)) {
        asm volatile("" ::: "memory");
        const float dM = Mused - M;
#pragma unroll
        for (int r = 0; r < 16; ++r) { p0[r] += dM; p1[r] += dM; }
    }
    if (first) {
        float pmax = p0[0];
#pragma unroll
        for (int r = 1; r < 16; ++r) pmax = fmaxf(pmax, p0[r]);
#pragma unroll
        for (int r = 0; r < 16; ++r) pmax = fmaxf(pmax, p1[r]);
        { auto rr = __builtin_amdgcn_permlane32_swap(__float_as_uint(pmax), __float_as_uint(pmax), false, false); pmax = fmaxf(__uint_as_float(rr[0]), __uint_as_float(rr[1])); }
        M = pmax;
#pragma unroll
        for (int r = 0; r < 16; ++r) { p0[r] -= pmax; p1[r] -= pmax; }
    }
    float ps = 0.f;
#pragma unroll
    for (int r = 0; r < 16; ++r) { p0[r] = __builtin_amdgcn_exp2f(p0[r]); ps += p0[r]; }
#pragma unroll
    for (int r = 0; r < 16; ++r) { p1[r] = __builtin_amdgcn_exp2f(p1[r]); ps += p1[r]; }
    { auto rr = __builtin_amdgcn_permlane32_swap(__float_as_uint(ps), __float_as_uint(ps), false, false); ps = __uint_as_float(rr[0]) + __uint_as_float(rr[1]); }
    if (__builtin_expect(__any(ps > ATT_BIG), 0)) {
        asm volatile("" ::: "memory");
        float pm = p0[0];
#pragma unroll
        for (int r = 1; r < 16; ++r) pm = fmaxf(pm, p0[r]);
#pragma unroll
        for (int r = 0; r < 16; ++r) pm = fmaxf(pm, p1[r]);
        { auto rr = __builtin_amdgcn_permlane32_swap(__float_as_uint(pm), __float_as_uint(pm), false, false); pm = fmaxf(__uint_as_float(rr[0]), __uint_as_float(rr[1])); }
        const float alpha = pm > 1.f ? __builtin_amdgcn_rcpf(pm) : 1.f;
        M -= __builtin_amdgcn_logf(alpha);
#pragma unroll
        for (int r = 0; r < 16; ++r) { p0[r] *= alpha; p1[r] *= alpha; }
        ps *= alpha; l_reg *= alpha;
        if (hi == 0) wsl[r32] = alpha;
        asm volatile("s_waitcnt lgkmcnt(0)" ::: "memory");
#pragma unroll
        for (int r = 0; r < 16; ++r) { const float av = wsl[crow(r, hi)]; o[0][r] *= av; o[1][r] *= av; }
        asm volatile("" ::: "memory");
    }
    l_reg += ps;
#define PK4(P, BASE, OUT) do { unsigned a0 = cvtpk(P[BASE + 0], P[BASE + 1]), a1 = cvtpk(P[BASE + 2], P[BASE + 3]);   \
    unsigned b0 = cvtpk(P[BASE + 4], P[BASE + 5]), b1 = cvtpk(P[BASE + 6], P[BASE + 7]);                              \
    auto r0 = __builtin_amdgcn_permlane32_swap(a0, b0, false, false); auto r1 = __builtin_amdgcn_permlane32_swap(a1, b1, false, false); \
    u32x4 w = {r0[0], r1[0], r0[1], r1[1]}; OUT = *reinterpret_cast<bf16x8*>(&w); } while (0)
    PK4(p0, 0, pa0); PK4(p0, 8, pa1); PK4(p1, 0, pa2); PK4(p1, 8, pa3);
#undef PK4
}

constexpr int ATT_STAGE = 2 * 16384 + 2 * 8192;
constexpr int ATT_LDS = 65536 + 49152 + 8 * 64 * 4 + 16;
template <bool DIFF>
__device__ void attn_item(const Ctx& c, int l, int b, int hd, int qrow0, int krow0, int nkeys, char* lds) {
    constexpr int DQK = DIFF ? 32 : 96, NMAP = DIFF ? 2 : 1, ND0 = DQK / 16, NU = 2 * NMAP;
    constexpr int KP = DIFF ? 64 : 256;
    constexpr int KSZ = 64 * KP;
    constexpr int NKR = DIFF ? 2 : 3;
    const int tid_ = mk_tid(c.wid);
    const int tid = tid_, lane = tid_ & 63, wid = c.wid, r32 = lane & 31, hi = lane >> 5;
    char* K_lds0 = lds; char* V_lds0 = lds + 2 * 16384; float* wsl = (float*)(lds + 2 * ATT_STAGE) + wid * 64;
    const float scale = DIFF ? 0.17677669529663687f : 0.10206207261596575f;
    const float C = scale * 1.4426950408889634f;
    bf16x8 qr[NMAP][ND0];
    { const int qrow = qrow0 + wid * 32 + r32;
#pragma unroll
        for (int m = 0; m < NMAP; ++m)
#pragma unroll
            for (int d0 = 0; d0 < ND0; ++d0) {
                const bf16_t* p = DIFF ? C_P + (size_t)qrow * INC + DF_Q + (hd * 2 + m) * 32 + d0 * 16 + hi * 8
                                       : C_QM + (size_t)qrow * 384 + hd * 96 + d0 * 16 + hi * 8;
                qr[m][d0] = *(const bf16x8*)p; } }
    f32x16 o[NMAP][2]; float m_reg[NMAP], l_reg[NMAP];
#pragma unroll
    for (int m = 0; m < NMAP; ++m) { m_reg[m] = 0.f; l_reg[m] = 0.f;
#pragma unroll
        for (int d = 0; d < 2; ++d) zero_acc(o[m][d]); }
    constexpr int NKP = DIFF ? 2 : 4;
    int ksrc[NKP], vsrc[2];
#pragma unroll
    for (int q = 0; q < NKP; ++q) { const int off = (wid * NKP + q) * 1024 + lane * 16;
        if (DIFF) { const int blk = off >> 12, key = (off & 4095) >> 6, slot = (off & 63) >> 4, ch = slot ^ ((key >> 2) & 3);
            ksrc[q] = ((blk >> 1) * 64 + key) * INC + DF_K + (hd * 2 + (blk & 1)) * 32 + ch * 8; }
        else { const int tile = off >> 14, key = (off & 16383) >> 8, slot = (off & 255) >> 4, ch = slot ^ (key & 15);
            ksrc[q] = ch < 8 ? -1 - ((tile * 64 + key) * 512 + hd * 128 + ch * 8) : (ch < 12 ? (tile * 64 + key) * INC + MLA_KR + (ch - 8) * 8 : (int)0x80000000); } }
#pragma unroll
    for (int q = 0; q < 2; ++q) { const int off = (wid * 2 + q) * 1024 + lane * 16; const int tile = off >> 13, w = off & 8191;
        const int sub = w >> 9, within = w & 511; const int kk = (sub >> 1) * 8 + (within >> 6); const int col = (sub & 1) * 32 + ((within & 63) >> 1);
        const int key = (kk & ~0xC) | ((kk & 4) << 1) | ((kk & 8) >> 1);
        vsrc[q] = DIFF ? (tile * 64 + key) * INC + DF_V + hd * 64 + col : (tile * 64 + key) * 512 + hd * 128 + 64 + col; }
    const int vb0 = (int)(uintptr_t)V_lds0 + v_rd_base(lane);
#define ADMA(buf, kr) do { \
        _Pragma("unroll") for (int q = 0; q < NKP; ++q) { LAS unsigned* dst_ = (LAS unsigned*)(LAS char*)(K_lds0 + (buf) * ATT_STAGE + (wid * NKP + q) * 1024); \
            if (DIFF || ksrc[q] >= 0) __builtin_amdgcn_global_load_lds((const unsigned*)(C_P + (size_t)(kr) * INC + ksrc[q]), dst_, 16, 0, 0); \
            else if (ksrc[q] != (int)0x80000000) __builtin_amdgcn_global_load_lds((const unsigned*)(C_KVM + (size_t)(kr) * 512 + (-1 - ksrc[q])), dst_, 16, 0, 0); } \
        _Pragma("unroll") for (int q = 0; q < 2; ++q) { LAS unsigned* dst_ = (LAS unsigned*)(LAS char*)(V_lds0 + (buf) * ATT_STAGE + (wid * 2 + q) * 1024); \
            __builtin_amdgcn_global_load_lds((const unsigned*)((DIFF ? C_P + (size_t)(kr) * INC : C_KVM + (size_t)(kr) * 512) + vsrc[q]), dst_, 16, 0, 0); } } while (0)
    const int NS = nkeys >> 7;
    ADMA(0, krow0);
    for (int j = 0; j < NS; ++j) {
        asm volatile("s_waitcnt vmcnt(0)" ::: "memory");
        __syncthreads();
        if (j + 1 < NS) ADMA((j + 1) & 1, krow0 + (j + 1) * 128);
        const char* K_lds = K_lds0 + (j & 1) * ATT_STAGE; const int vb = vb0 + (j & 1) * ATT_STAGE;
        f32x16 p0[2], p1[2]; float mused[2];
#define QKT(u) do { constexpr int tt_ = (u) / NMAP, m_ = (u) % NMAP; const char* Kb = K_lds + (tt_ * NMAP + m_) * KSZ; \
            _Pragma("unroll") for (int d0 = 0; d0 < ND0; ++d0) { bf16x8 b0, b1; \
                if (DIFF) { const int ch = d0 * 2 + hi; const int ra = r32, rb = 32 + r32; \
                    b0 = *(const bf16x8*)(Kb + ra * 64 + ((ch ^ ((ra >> 2) & 3)) << 4)); b1 = *(const bf16x8*)(Kb + rb * 64 + ((ch ^ ((rb >> 2) & 3)) << 4)); } \
                else { const int cb = d0 * 32 + hi * 16; const int ra = r32, rb = 32 + r32; \
                    b0 = *(const bf16x8*)(Kb + ra * 256 + (cb ^ ((ra & 15) << 4))); b1 = *(const bf16x8*)(Kb + rb * 256 + (cb ^ ((rb & 15) << 4))); } \
                if (d0 == 0) { const float nm_ = -m_reg[m_]; mused[(u) & 1] = m_reg[m_]; const f32x16 z = {nm_,nm_,nm_,nm_,nm_,nm_,nm_,nm_,nm_,nm_,nm_,nm_,nm_,nm_,nm_,nm_}; \
                    p0[(u) & 1] = __builtin_amdgcn_mfma_f32_32x32x16_bf16(b0, qr[m_][0], z, 0, 0, 0); p1[(u) & 1] = __builtin_amdgcn_mfma_f32_32x32x16_bf16(b1, qr[m_][0], z, 0, 0, 0); \
                    asm volatile("" :: "v"(b0), "v"(b1));   } \
                else { p0[(u) & 1] = __builtin_amdgcn_mfma_f32_32x32x16_bf16(b0, qr[m_][d0], p0[(u) & 1], 0, 0, 0); p1[(u) & 1] = __builtin_amdgcn_mfma_f32_32x32x16_bf16(b1, qr[m_][d0], p1[(u) & 1], 0, 0, 0); } } \
            if (!DIFF) {   \
                __builtin_amdgcn_sched_group_barrier(0x100, 4, 0); \
                _Pragma("unroll") for (int g_ = 0; g_ < 4; ++g_) { __builtin_amdgcn_sched_group_barrier(0x8, 2, 0); __builtin_amdgcn_sched_group_barrier(0x100, 2, 0); } \
                __builtin_amdgcn_sched_group_barrier(0x8, 4, 0); } } while (0)
        QKT(0);
#pragma unroll
        for (int u = 0; u < NU; ++u) {
            const int tt = u / NMAP, m = u % NMAP;
            if (u + 1 < NU) { if (u == 0) QKT(1); else if (u == 1) QKT(2); else QKT(3); }
            bf16x8 pa0, pa1, pa2, pa3;
            softmax_tile(p0[u & 1], p1[u & 1], m_reg[m], mused[u & 1], l_reg[m], (j == 0) && (tt == 0), pa0, pa1, pa2, pa3, o[m], wsl, r32, hi);
            pv_one<0>(o[m][0], vb + tt * 8192, pa0, pa1, pa2, pa3);
            pv_one<1>(o[m][1], vb + tt * 8192, pa0, pa1, pa2, pa3);
        }
#undef QKT
    }
#undef ADMA
    float rli[NMAP][16];
#pragma unroll
    for (int m = 0; m < NMAP; ++m) {
        asm volatile("s_waitcnt lgkmcnt(0)" ::: "memory");
        if (hi == 0) wsl[r32] = l_reg[m];
        asm volatile("s_waitcnt lgkmcnt(0)" ::: "memory");
#pragma unroll
        for (int r = 0; r < 16; ++r) rli[m][r] = __builtin_amdgcn_rcpf(wsl[crow(r, hi)]);
    }
    const int orow0 = qrow0 + wid * 32;
    if (!DIFF) {
#pragma unroll
        for (int r = 0; r < 16; ++r) { bf16_t* dst = C_HB + (size_t)(orow0 + crow(r, hi)) * D + 512 + hd * 64 + r32;
            dst[0] = f2bf(o[0][0][r] * rli[0][r]); dst[32] = f2bf(o[0][1][r] * rli[0][r]); }
    } else {
        const float* lp = CIN(19) + l * 128; const float* gn = CIN(20) + l * 64; asm volatile("" : "+s"(lp), "+s"(gn));
        float s1 = lp[r32] * lp[32 + r32], s2 = lp[64 + r32] * lp[96 + r32];
#pragma unroll
        for (int o = 1; o < 32; o <<= 1) { s1 += shx(s1, o, lane); s2 += shx(s2, o, lane); }
        const float lam_init = (l == 0) ? 0.2f : 0.35550906759097f;
        const float lam = __expf(s1) - __expf(s2) + lam_init;
        const float g0 = gn[r32] * (1.f - lam_init), g1 = gn[32 + r32] * (1.f - lam_init);
#pragma unroll
        for (int r = 0; r < 16; ++r) {
            const float v0 = o[0][0][r] * rli[0][r] - lam * o[NMAP - 1][0][r] * rli[NMAP - 1][r];
            const float v1 = o[0][1][r] * rli[0][r] - lam * o[NMAP - 1][1][r] * rli[NMAP - 1][r];
            float ss = v0 * v0 + v1 * v1;
            ss += shx(ss, 1, lane); ss += shx(ss, 2, lane); ss += shx(ss, 4, lane); ss += shx(ss, 8, lane); ss += shx(ss, 16, lane);
            const float rstd = rsqrtf(ss * (1.f / 64.f) + NORM_EPS);
            bf16_t* dst = C_HB + (size_t)(orow0 + crow(r, hi)) * D + 768 + hd * 64 + r32;
            dst[0] = f2bf(v0 * rstd * g0); dst[32] = f2bf(v1 * rstd * g1); }
    }
    __syncthreads();
}
template <bool DIFF>
__device__ bool attn_item_pair(const Ctx& c, int l, int b, int hd, int qrow0, int krow0, int nkeys, char* lds) {
    constexpr int DQK = DIFF ? 32 : 96, NMAP = DIFF ? 2 : 1, ND0 = DQK / 16, NU = 2 * NMAP;
    constexpr int KP = DIFF ? 64 : 256;
    constexpr int KSZ = 64 * KP;
    constexpr int NKR = DIFF ? 2 : 3;
    const int tid_ = mk_tid(c.wid);
    const int tid = tid_, lane = tid_ & 63, wid = c.wid, r32 = lane & 31, hi = lane >> 5;
    char* K_lds0 = lds; char* V_lds0 = lds + 65536; float* wsl = (float*)(lds + 65536 + 49152) + wid * 64;
    const float scale = DIFF ? 0.17677669529663687f : 0.10206207261596575f;
    const float C = scale * 1.4426950408889634f;
    bf16x8 qr[NMAP][ND0];
    { const int qrow = qrow0 + wid * 32 + r32;
#pragma unroll
        for (int m = 0; m < NMAP; ++m)
#pragma unroll
            for (int d0 = 0; d0 < ND0; ++d0) {
                const bf16_t* p = DIFF ? C_P + (size_t)qrow * INC + DF_Q + (hd * 2 + m) * 32 + d0 * 16 + hi * 8
                                       : C_QM + (size_t)qrow * 384 + hd * 96 + d0 * 16 + hi * 8;
                qr[m][d0] = *(const bf16x8*)p; } }
    f32x16 o[NMAP][2]; float m_reg[NMAP], l_reg[NMAP];
#pragma unroll
    for (int m = 0; m < NMAP; ++m) { m_reg[m] = 0.f; l_reg[m] = 0.f;
#pragma unroll
        for (int d = 0; d < 2; ++d) zero_acc(o[m][d]); }
    constexpr int NKP = DIFF ? 2 : 4;
    int ksrc[NKP], vsrc[2];
#pragma unroll
    for (int q = 0; q < NKP; ++q) { const int off = (wid * NKP + q) * 1024 + lane * 16;
        if (DIFF) { const int blk = off >> 12, key = (off & 4095) >> 6, slot = (off & 63) >> 4, ch = slot ^ ((key >> 2) & 3);
            ksrc[q] = ((blk >> 1) * 64 + key) * INC + DF_K + (hd * 2 + (blk & 1)) * 32 + ch * 8; }
        else { const int tile = off >> 14, key = (off & 16383) >> 8, slot = (off & 255) >> 4, ch = slot ^ (key & 15);
            ksrc[q] = ch < 8 ? -1 - ((tile * 64 + key) * 512 + hd * 128 + ch * 8) : (ch < 12 ? (tile * 64 + key) * INC + MLA_KR + (ch - 8) * 8 : (int)0x80000000); } }
#pragma unroll
    for (int q = 0; q < 2; ++q) { const int off = (wid * 2 + q) * 1024 + lane * 16; const int tile = off >> 13, w = off & 8191;
        const int sub = w >> 9, within = w & 511; const int kk = (sub >> 1) * 8 + (within >> 6); const int col = (sub & 1) * 32 + ((within & 63) >> 1);
        const int key = kk;
        vsrc[q] = DIFF ? (tile * 64 + key) * INC + DF_V + hd * 64 + col : (tile * 64 + key) * 512 + hd * 128 + 64 + col; }
    const int vb0 = (int)(uintptr_t)V_lds0 + v_rd_base(lane);
    unsigned kbo[NKP], vbo[2];
#pragma unroll
    for (int q = 0; q < NKP; ++q) kbo[q] = (DIFF || ksrc[q] >= 0) ? (unsigned)ksrc[q] * 2u : (unsigned)(-1 - ksrc[q]) * 2u;
#pragma unroll
    for (int q = 0; q < 2; ++q) vbo[q] = (unsigned)vsrc[q] * 2u;
#define ADMA(kbuf, vbuf, kr) do { const char* pb_ = (const char*)C_P + (size_t)(kr) * (INC * 2); const char* kb_ = (const char*)C_KVM + (size_t)(kr) * 1024; asm volatile("" : "+s"(pb_), "+s"(kb_)); \
        _Pragma("unroll") for (int q = 0; q < NKP; ++q) { LAS unsigned* dst_ = (LAS unsigned*)(LAS char*)(K_lds0 + (kbuf) * 32768 + (wid * NKP + q) * 1024); \
            unsigned o_ = kbo[q]; asm volatile("" : "+v"(o_));     \
            if (DIFF || ksrc[q] >= 0) __builtin_amdgcn_global_load_lds((const unsigned*)(pb_ + (size_t)o_), dst_, 16, 0, 0); \
            else if (ksrc[q] != (int)0x80000000) __builtin_amdgcn_global_load_lds((const unsigned*)(kb_ + (size_t)o_), dst_, 16, 0, 0); } \
        _Pragma("unroll") for (int q = 0; q < 2; ++q) { LAS unsigned* dst_ = (LAS unsigned*)(LAS char*)(V_lds0 + (vbuf) * 16384 + (wid * 2 + q) * 1024); \
            unsigned o_ = vbo[q]; asm volatile("" : "+v"(o_)); \
            __builtin_amdgcn_global_load_lds((const unsigned*)((DIFF ? pb_ : kb_) + (size_t)o_), dst_, 16, 0, 0); } } while (0)
    float lsA = 0.f, lsB = 0.f;
    const int NS = nkeys >> 7;
    ADMA(0, 0, krow0);
    f32x16 a0, a1, b0, b1;
    zero_acc(a0); zero_acc(a1); zero_acc(b0); zero_acc(b1);
    bf16x8 pa[4], pb[4];
    int vslot = 0, vbp = vb0;
#define PKV(L, H) (bf16x8){L[0], L[1], L[2], L[3], H[0], H[1], H[2], H[3]}
#define PK4(P, BASE, OUT) do { u32x4 w = {cvtpk(P[BASE + 0], P[BASE + 1]), cvtpk(P[BASE + 2], P[BASE + 3]), cvtpk(P[BASE + 4], P[BASE + 5]), cvtpk(P[BASE + 6], P[BASE + 7])}; \
    OUT = *reinterpret_cast<bf16x8*>(&w); } while (0)
#define PACKP() do { PK4(a0, 0, pa[0]); PK4(b0, 0, pb[0]); PK4(a0, 8, pa[1]); PK4(b0, 8, pb[1]); PK4(a1, 0, pa[2]); PK4(b1, 0, pb[2]); PK4(a1, 8, pa[3]); PK4(b1, 8, pb[3]); } while (0)
#define CHK(X, B, PS) do { X[B] = __builtin_amdgcn_exp2f(X[B]); X[B + 1] = __builtin_amdgcn_exp2f(X[B + 1]); X[B + 2] = __builtin_amdgcn_exp2f(X[B + 2]); X[B + 3] = __builtin_amdgcn_exp2f(X[B + 3]); \
        PS += X[B]; PS += X[B + 1]; PS += X[B + 2]; PS += X[B + 3]; } while (0)
#define CHUNK(c) do { if ((c) == 0) CHK(a0, 0, psA); else if ((c) == 1) CHK(b0, 0, psB); else if ((c) == 2) CHK(a0, 4, psA); else if ((c) == 3) CHK(b0, 4, psB); \
        else if ((c) == 4) CHK(a0, 8, psA); else if ((c) == 5) CHK(b0, 8, psB); else if ((c) == 6) CHK(a0, 12, psA); else if ((c) == 7) CHK(b0, 12, psB); \
        else if ((c) == 8) CHK(a1, 0, psA); else if ((c) == 9) CHK(b1, 0, psB); else if ((c) == 10) CHK(a1, 4, psA); else if ((c) == 11) CHK(b1, 4, psB); \
        else if ((c) == 12) CHK(a1, 8, psA); else if ((c) == 13) CHK(b1, 8, psB); else if ((c) == 14) CHK(a1, 12, psA); else CHK(b1, 12, psB); \
        __builtin_amdgcn_sched_barrier(0); } while (0)
#define VREAD(D0B, VB, TA, TB) \
        const int va_##D0B = (VB) + (TA) * 8192, vq_##D0B = (VB) + (TB) * 8192; \
        const s16x4 l0##D0B = tr_read<v_rd_off(D0B, 0, 0)>(va_##D0B), h0##D0B = tr_read<v_rd_off(D0B, 0, 1)>(va_##D0B), l1##D0B = tr_read<v_rd_off(D0B, 1, 0)>(va_##D0B), h1##D0B = tr_read<v_rd_off(D0B, 1, 1)>(va_##D0B); \
        const s16x4 l2##D0B = tr_read<v_rd_off(D0B, 2, 0)>(va_##D0B), h2##D0B = tr_read<v_rd_off(D0B, 2, 1)>(va_##D0B), l3##D0B = tr_read<v_rd_off(D0B, 3, 0)>(va_##D0B), h3##D0B = tr_read<v_rd_off(D0B, 3, 1)>(va_##D0B); \
        s16x4 m0##D0B = l0##D0B, n0##D0B = h0##D0B, m1##D0B = l1##D0B, n1##D0B = h1##D0B, m2##D0B = l2##D0B, n2##D0B = h2##D0B, m3##D0B = l3##D0B, n3##D0B = h3##D0B; \
        if (!DIFF) { m0##D0B = tr_read<v_rd_off(D0B, 0, 0)>(vq_##D0B); n0##D0B = tr_read<v_rd_off(D0B, 0, 1)>(vq_##D0B); m1##D0B = tr_read<v_rd_off(D0B, 1, 0)>(vq_##D0B); n1##D0B = tr_read<v_rd_off(D0B, 1, 1)>(vq_##D0B); \
            m2##D0B = tr_read<v_rd_off(D0B, 2, 0)>(vq_##D0B); n2##D0B = tr_read<v_rd_off(D0B, 2, 1)>(vq_##D0B); m3##D0B = tr_read<v_rd_off(D0B, 3, 0)>(vq_##D0B); n3##D0B = tr_read<v_rd_off(D0B, 3, 1)>(vq_##D0B); }
#define VWAIT() do { asm volatile("s_waitcnt lgkmcnt(0)" ::: "memory"); __builtin_amdgcn_sched_barrier(0); } while (0)
#define PVM(D0B, i) do { f32x16& accA = o[0][D0B]; f32x16& accB = o[NMAP - 1][D0B]; \
        if ((i) == 0) accA = __builtin_amdgcn_mfma_f32_32x32x16_bf16(pa[0], PKV(l0##D0B, h0##D0B), accA, 0, 0, 0); else if ((i) == 1) accB = __builtin_amdgcn_mfma_f32_32x32x16_bf16(pb[0], PKV(m0##D0B, n0##D0B), accB, 0, 0, 0); \
        else if ((i) == 2) accA = __builtin_amdgcn_mfma_f32_32x32x16_bf16(pa[1], PKV(l1##D0B, h1##D0B), accA, 0, 0, 0); else if ((i) == 3) accB = __builtin_amdgcn_mfma_f32_32x32x16_bf16(pb[1], PKV(m1##D0B, n1##D0B), accB, 0, 0, 0); \
        else if ((i) == 4) accA = __builtin_amdgcn_mfma_f32_32x32x16_bf16(pa[2], PKV(l2##D0B, h2##D0B), accA, 0, 0, 0); else if ((i) == 5) accB = __builtin_amdgcn_mfma_f32_32x32x16_bf16(pb[2], PKV(m2##D0B, n2##D0B), accB, 0, 0, 0); \
        else if ((i) == 6) accA = __builtin_amdgcn_mfma_f32_32x32x16_bf16(pa[3], PKV(l3##D0B, h3##D0B), accA, 0, 0, 0); else accB = __builtin_amdgcn_mfma_f32_32x32x16_bf16(pb[3], PKV(m3##D0B, n3##D0B), accB, 0, 0, 0); } while (0)
#define STEP3_PV(VB, TA, TB) do { float psA = 0.f, psB = 0.f; \
        VREAD(0, VB, TA, TB) \
        VWAIT(); \
        PVM(0, 0); CHUNK(0); PVM(0, 1); CHUNK(1); PVM(0, 2); CHUNK(2); PVM(0, 3); CHUNK(3); PVM(0, 4); CHUNK(4); PVM(0, 5); CHUNK(5); \
        VREAD(1, VB, TA, TB) \
        __builtin_amdgcn_sched_barrier(0); \
        PVM(0, 6); CHUNK(6); PVM(0, 7); CHUNK(7); \
        VWAIT(); \
        PVM(1, 0); CHUNK(8); PVM(1, 1); CHUNK(9); PVM(1, 2); CHUNK(10); PVM(1, 3); CHUNK(11); PVM(1, 4); CHUNK(12); PVM(1, 5); CHUNK(13); PVM(1, 6); CHUNK(14); PVM(1, 7); CHUNK(15); \
        lsA += psA; lsB += psB; } while (0)
    constexpr int NG = ND0 / 2, NPI = DIFF ? 2 : 1, TLA = DIFF ? 1 : 0, TLB = 1;
    for (int j = 0; j < NS; ++j) {
        asm volatile("s_waitcnt vmcnt(0)" ::: "memory");
        __syncthreads();
        const int vnext = (vslot == 2) ? 0 : vslot + 1;
        if (j + 1 < NS) ADMA((j + 1) & 1, vnext, krow0 + (j + 1) * 128);
        const char* K_lds = K_lds0 + (j & 1) * 32768; const int vb = vb0 + vslot * 16384;
#define KFR(tt, m, d0, h) (*(const bf16x8*)(K_lds + ((tt) * NMAP + (m)) * KSZ + \
            (DIFF ? (((h) * 32 + r32) * 64 + ((((d0) * 2 + hi) ^ ((((h) * 32 + r32) >> 2) & 3)) << 4)) : (((h) * 32 + r32) * 256 + (((d0) * 32 + hi * 16) ^ ((((h) * 32 + r32) & 15) << 4))))))
#define KGRP(F, g, TA, TB) do { F[0] = KFR(TA, 0, 2 * (g), 0); F[1] = KFR(TB, NMAP - 1, 2 * (g), 0); F[2] = KFR(TA, 0, 2 * (g), 1); F[3] = KFR(TB, NMAP - 1, 2 * (g), 1); \
            F[4] = KFR(TA, 0, 2 * (g) + 1, 0); F[5] = KFR(TB, NMAP - 1, 2 * (g) + 1, 0); F[6] = KFR(TA, 0, 2 * (g) + 1, 1); F[7] = KFR(TB, NMAP - 1, 2 * (g) + 1, 1); } while (0)
#define QGRP(F, g) do { \
            if ((g) == 0) { const f32x16 z_ = {0.f,0.f,0.f,0.f,0.f,0.f,0.f,0.f,0.f,0.f,0.f,0.f,0.f,0.f,0.f,0.f};     \
                a0 = __builtin_amdgcn_mfma_f32_32x32x16_bf16(F[0], qr[0][0], z_, 0, 0, 0); b0 = __builtin_amdgcn_mfma_f32_32x32x16_bf16(F[1], qr[NMAP - 1][0], z_, 0, 0, 0); \
                a1 = __builtin_amdgcn_mfma_f32_32x32x16_bf16(F[2], qr[0][0], z_, 0, 0, 0); b1 = __builtin_amdgcn_mfma_f32_32x32x16_bf16(F[3], qr[NMAP - 1][0], z_, 0, 0, 0); } \
            else { a0 = __builtin_amdgcn_mfma_f32_32x32x16_bf16(F[0], qr[0][2 * (g)], a0, 0, 0, 0); b0 = __builtin_amdgcn_mfma_f32_32x32x16_bf16(F[1], qr[NMAP - 1][2 * (g)], b0, 0, 0, 0); \
                a1 = __builtin_amdgcn_mfma_f32_32x32x16_bf16(F[2], qr[0][2 * (g)], a1, 0, 0, 0); b1 = __builtin_amdgcn_mfma_f32_32x32x16_bf16(F[3], qr[NMAP - 1][2 * (g)], b1, 0, 0, 0); } \
            a0 = __builtin_amdgcn_mfma_f32_32x32x16_bf16(F[4], qr[0][2 * (g) + 1], a0, 0, 0, 0); b0 = __builtin_amdgcn_mfma_f32_32x32x16_bf16(F[5], qr[NMAP - 1][2 * (g) + 1], b0, 0, 0, 0); \
            a1 = __builtin_amdgcn_mfma_f32_32x32x16_bf16(F[6], qr[0][2 * (g) + 1], a1, 0, 0, 0); b1 = __builtin_amdgcn_mfma_f32_32x32x16_bf16(F[7], qr[NMAP - 1][2 * (g) + 1], b1, 0, 0, 0); } while (0)
#pragma unroll
        for (int pi = 0; pi < NPI; ++pi) {
            const int tA = DIFF ? pi : 0, tB = DIFF ? pi : 1;
            bf16x8 kf0[8], kf1[8];
            KGRP(kf0, 0, tA, tB); if (NG > 1) KGRP(kf1, 1, tA, tB);
            __builtin_amdgcn_sched_barrier(0);
            PACKP();
            __builtin_amdgcn_sched_barrier(0);
            QGRP(kf0, 0);
            if (NG > 1) { __builtin_amdgcn_sched_barrier(0); KGRP(kf0, 2, tA, tB); __builtin_amdgcn_sched_barrier(0); QGRP(kf1, 1); QGRP(kf0, 2); }
            __builtin_amdgcn_sched_barrier(0);
            if (pi == 0) STEP3_PV(vbp, TLA, TLB);
            else STEP3_PV(vb, pi - 1, pi - 1);
        }
#undef KFR
#undef KGRP
#undef QGRP
        vbp = vb; vslot = vnext;
    }
    { PACKP();
      __builtin_amdgcn_sched_barrier(0);
      VREAD(0, vbp, TLA, TLB)
      VREAD(1, vbp, TLA, TLB)
      VWAIT();
      PVM(0, 0); PVM(0, 1); PVM(0, 2); PVM(0, 3); PVM(0, 4); PVM(0, 5); PVM(0, 6); PVM(0, 7);
      PVM(1, 0); PVM(1, 1); PVM(1, 2); PVM(1, 3); PVM(1, 4); PVM(1, 5); PVM(1, 6); PVM(1, 7); }
#undef STEP3_PV
#undef PVM
#undef VWAIT
#undef VREAD
#undef CHUNK
#undef CHK
#undef PACKP
#undef PK4
#undef PKV
#undef ADMA
    const int tide = mk_tid(c.wid), lanee = tide & 63, r32e = lanee & 31, hie = lanee >> 5;
    { auto rr = __builtin_amdgcn_permlane32_swap(__float_as_uint(lsA), __float_as_uint(lsA), false, false); lsA = __uint_as_float(rr[0]) + __uint_as_float(rr[1]); }
    { auto rr = __builtin_amdgcn_permlane32_swap(__float_as_uint(lsB), __float_as_uint(lsB), false, false); lsB = __uint_as_float(rr[0]) + __uint_as_float(rr[1]); }
    if (DIFF) { l_reg[0] = lsA; l_reg[NMAP - 1] = lsB; } else l_reg[0] = lsA + lsB;
    float rli[NMAP][16];
#pragma unroll
    for (int m = 0; m < NMAP; ++m) {
        asm volatile("s_waitcnt lgkmcnt(0)" ::: "memory");
        if (hie == 0) wsl[r32e] = l_reg[m];
        asm volatile("s_waitcnt lgkmcnt(0)" ::: "memory");
#pragma unroll
        for (int r = 0; r < 16; ++r) rli[m][r] = __builtin_amdgcn_rcpf(wsl[crow(r, hie)]);
    }
    const int orow0 = qrow0 + wid * 32;
    if (!DIFF) {
#pragma unroll
        for (int r = 0; r < 16; ++r) { bf16_t* dst = C_HB + (size_t)(orow0 + crow(r, hie)) * D + 512 + hd * 64 + r32e;
            dst[0] = f2bf(o[0][0][r] * rli[0][r]); dst[32] = f2bf(o[0][1][r] * rli[0][r]); }
    } else {
        const float* lp = CIN(19) + l * 128; const float* gn = CIN(20) + l * 64; asm volatile("" : "+s"(lp), "+s"(gn));
        float s1 = lp[r32e] * lp[32 + r32e], s2 = lp[64 + r32e] * lp[96 + r32e];
#pragma unroll
        for (int o = 1; o < 32; o <<= 1) { s1 += shx(s1, o, lanee); s2 += shx(s2, o, lanee); }
        const float lam_init = (l == 0) ? 0.2f : 0.35550906759097f;
        const float lam = __expf(s1) - __expf(s2) + lam_init;
        const float g0 = gn[r32e] * (1.f - lam_init), g1 = gn[32 + r32e] * (1.f - lam_init);
#pragma unroll
        for (int r = 0; r < 16; ++r) {
            const float v0 = o[0][0][r] * rli[0][r] - lam * o[NMAP - 1][0][r] * rli[NMAP - 1][r];
            const float v1 = o[0][1][r] * rli[0][r] - lam * o[NMAP - 1][1][r] * rli[NMAP - 1][r];
            float ss = v0 * v0 + v1 * v1;
            ss += shx(ss, 1, lanee); ss += shx(ss, 2, lanee); ss += shx(ss, 4, lanee); ss += shx(ss, 8, lanee); ss += shx(ss, 16, lanee);
            const float rstd = rsqrtf(ss * (1.f / 64.f) + NORM_EPS);
            bf16_t* dst = C_HB + (size_t)(orow0 + crow(r, hie)) * D + 768 + hd * 64 + r32e;
            dst[0] = f2bf(v0 * rstd * g0); dst[32] = f2bf(v1 * rstd * g1); }
    }
    int* flag = (int*)(lds + 65536 + 49152 + 8 * 64 * 4);
    __syncthreads();
    if (tide == 0) *flag = 0;
    __syncthreads();
    if (!(l_reg[0] <= ATT_ZBIG && l_reg[0] >= ATT_ZSMALL) || !(l_reg[NMAP - 1] <= ATT_ZBIG && l_reg[NMAP - 1] >= ATT_ZSMALL)) *flag = 1;
    __syncthreads();
    const bool redo = *flag != 0;
    __syncthreads();
    return redo;
}
template <int G, int I>
__device__ __forceinline__ void att_microop(f32x16& p0, f32x16& p1, float& ps, bf16x8 (&pa)[4]) {
    f32x16& P = (G < 2) ? p0 : p1; constexpr int B = (G & 1) * 8;
    if constexpr (I < 4) { constexpr int r = B + 2 * I;
        P[r] = __builtin_amdgcn_exp2f(P[r]); P[r + 1] = __builtin_amdgcn_exp2f(P[r + 1]); ps += P[r]; ps += P[r + 1]; }
    else { const unsigned a0 = cvtpk(P[B + 0], P[B + 1]), a1 = cvtpk(P[B + 2], P[B + 3]), b0 = cvtpk(P[B + 4], P[B + 5]), b1 = cvtpk(P[B + 6], P[B + 7]);
        auto r0 = __builtin_amdgcn_permlane32_swap(a0, b0, false, false); auto r1 = __builtin_amdgcn_permlane32_swap(a1, b1, false, false);
        u32x4 w = {r0[0], r1[0], r0[1], r1[1]}; pa[G] = *reinterpret_cast<bf16x8*>(&w); }
}
template <int GB, int S, int NSL>
__device__ __forceinline__ void att_slot_ops(f32x16& p0, f32x16& p1, float& ps, bf16x8 (&pa)[4]) {
#define MOP(m) if constexpr (((m) * NSL) / 10 == S) att_microop<GB + (m) / 5, (m) % 5>(p0, p1, ps, pa);
    MOP(0) MOP(1) MOP(2) MOP(3) MOP(4) MOP(5) MOP(6) MOP(7) MOP(8) MOP(9)
#undef MOP
}
template <bool DIFF>
__device__ bool attn_item_fast(const Ctx& c, int l, int b, int hd, int qrow0, int krow0, int nkeys, char* lds) {
    constexpr int DQK = DIFF ? 32 : 96, NMAP = DIFF ? 2 : 1, ND0 = DQK / 16, NU = 2 * NMAP, NA = 2 * ND0;
    constexpr int KP = DIFF ? 64 : 256, KSZ = 64 * KP;
    const int tid_ = mk_tid(c.wid);
    const int tid = tid_, lane = tid_ & 63, wid = c.wid, r32 = lane & 31, hi = lane >> 5;
    char* K_lds0 = lds; char* V_lds0 = lds + 2 * 16384; float* wsl = (float*)(lds + 2 * ATT_STAGE) + wid * 64;
    bf16x8 qr[NMAP][ND0];
    { const int qrow = qrow0 + wid * 32 + r32;
#pragma unroll
        for (int m = 0; m < NMAP; ++m)
#pragma unroll
            for (int d0 = 0; d0 < ND0; ++d0) {
                const bf16_t* p = DIFF ? C_P + (size_t)qrow * INC + DF_Q + (hd * 2 + m) * 32 + d0 * 16 + hi * 8
                                       : C_QM + (size_t)qrow * 384 + hd * 96 + d0 * 16 + hi * 8;
                qr[m][d0] = *(const bf16x8*)p; } }
    f32x16 o[NMAP][2]; float m_reg[NMAP], l_reg[NMAP];
#pragma unroll
    for (int m = 0; m < NMAP; ++m) { m_reg[m] = 0.f; l_reg[m] = 0.f;
#pragma unroll
        for (int d = 0; d < 2; ++d) zero_acc(o[m][d]); }
    constexpr int NKP = DIFF ? 2 : 4;
    int ksrc[NKP], vsrc[2];
#pragma unroll
    for (int q = 0; q < NKP; ++q) { const int off = (wid * NKP + q) * 1024 + lane * 16;
        if (DIFF) { const int blk = off >> 12, key = (off & 4095) >> 6, slot = (off & 63) >> 4, ch = slot ^ ((key >> 2) & 3);
            ksrc[q] = ((blk >> 1) * 64 + key) * INC + DF_K + (hd * 2 + (blk & 1)) * 32 + ch * 8; }
        else { const int tile = off >> 14, key = (off & 16383) >> 8, slot = (off & 255) >> 4, ch = slot ^ (key & 15);
            ksrc[q] = ch < 8 ? -1 - ((tile * 64 + key) * 512 + hd * 128 + ch * 8) : (ch < 12 ? (tile * 64 + key) * INC + MLA_KR + (ch - 8) * 8 : (int)0x80000000); } }
#pragma unroll
    for (int q = 0; q < 2; ++q) { const int off = (wid * 2 + q) * 1024 + lane * 16; const int tile = off >> 13, w = off & 8191;
        const int sub = w >> 9, within = w & 511; const int kk = (sub >> 1) * 8 + (within >> 6); const int col = (sub & 1) * 32 + ((within & 63) >> 1);
        const int key = (kk & ~0xC) | ((kk & 4) << 1) | ((kk & 8) >> 1);
        vsrc[q] = DIFF ? (tile * 64 + key) * INC + DF_V + hd * 64 + col : (tile * 64 + key) * 512 + hd * 128 + 64 + col; }
    const int vb0 = (int)(uintptr_t)V_lds0 + v_rd_base(lane);
#define ADMA(buf, kr) do { \
        _Pragma("unroll") for (int q = 0; q < NKP; ++q) { LAS unsigned* dst_ = (LAS unsigned*)(LAS char*)(K_lds0 + (buf) * ATT_STAGE + (wid * NKP + q) * 1024); \
            if (DIFF || ksrc[q] >= 0) __builtin_amdgcn_global_load_lds((const unsigned*)(C_P + (size_t)(kr) * INC + ksrc[q]), dst_, 16, 0, 0); \
            else if (ksrc[q] != (int)0x80000000) __builtin_amdgcn_global_load_lds((const unsigned*)(C_KVM + (size_t)(kr) * 512 + (-1 - ksrc[q])), dst_, 16, 0, 0); } \
        _Pragma("unroll") for (int q = 0; q < 2; ++q) { LAS unsigned* dst_ = (LAS unsigned*)(LAS char*)(V_lds0 + (buf) * ATT_STAGE + (wid * 2 + q) * 1024); \
            __builtin_amdgcn_global_load_lds((const unsigned*)((DIFF ? C_P + (size_t)(kr) * INC : C_KVM + (size_t)(kr) * 512) + vsrc[q]), dst_, 16, 0, 0); } } while (0)
#define SB() __builtin_amdgcn_sched_barrier(0)
    const int NS = nkeys >> 7;
    ADMA(0, krow0);
    float bad = 0.f;
    for (int j = 0; j < NS; ++j) {
        asm volatile("s_waitcnt vmcnt(0)" ::: "memory");
        __syncthreads();
        if (j + 1 < NS) ADMA((j + 1) & 1, krow0 + (j + 1) * 128);
        const char* K_lds = K_lds0 + (j & 1) * ATT_STAGE; const int vb = vb0 + (j & 1) * ATT_STAGE;
        f32x16 p0[2], p1[2]; bf16x8 pa[2][4]; float ps[2]; bf16x8 kfw[3];
#define KFRAG(u, d0, h) (*(const bf16x8*)(K_lds + (((u) / NMAP) * NMAP + ((u) % NMAP)) * KSZ + \
            (DIFF ? (((h) * 32 + r32) * 64 + ((((d0) * 2 + hi) ^ ((((h) * 32 + r32) >> 2) & 3)) << 4)) : (((h) * 32 + r32) * 256 + (((d0) * 32 + hi * 16) ^ ((((h) * 32 + r32) & 15) << 4))))))
#define QMFMA(u, s, frag) do { constexpr int d0_ = (s) >> 1, m_ = (u) % NMAP; f32x16& acc_ = ((s) & 1) ? p1[(u) & 1] : p0[(u) & 1]; \
            if (d0_ == 0) { const float nm_ = -m_reg[m_]; const f32x16 z = {nm_,nm_,nm_,nm_,nm_,nm_,nm_,nm_,nm_,nm_,nm_,nm_,nm_,nm_,nm_,nm_}; acc_ = __builtin_amdgcn_mfma_f32_32x32x16_bf16(frag, qr[m_][0], z, 0, 0, 0); } \
            else acc_ = __builtin_amdgcn_mfma_f32_32x32x16_bf16(frag, qr[m_][d0_], acc_, 0, 0, 0); } while (0)
        if (j == 0) {
#pragma unroll
            for (int m = 0; m < NMAP; ++m) {
#pragma unroll
                for (int d0 = 0; d0 < ND0; ++d0) { const bf16x8 f0 = KFRAG(m, d0, 0), f1 = KFRAG(m, d0, 1);
                    if (d0 == 0) { const f32x16 z = {0.f,0.f,0.f,0.f,0.f,0.f,0.f,0.f,0.f,0.f,0.f,0.f,0.f,0.f,0.f,0.f};
                        p0[0] = __builtin_amdgcn_mfma_f32_32x32x16_bf16(f0, qr[m][0], z, 0, 0, 0); p1[0] = __builtin_amdgcn_mfma_f32_32x32x16_bf16(f1, qr[m][0], z, 0, 0, 0); }
                    else { p0[0] = __builtin_amdgcn_mfma_f32_32x32x16_bf16(f0, qr[m][d0], p0[0], 0, 0, 0); p1[0] = __builtin_amdgcn_mfma_f32_32x32x16_bf16(f1, qr[m][d0], p1[0], 0, 0, 0); } }
                m_reg[m] = rowmax_tile(p0[0], p1[0]); }
        }
        {
#pragma unroll
            for (int sidx = 0; sidx < NA; ++sidx) { const bf16x8 f = (sidx & 1) ? KFRAG(0, sidx >> 1, 1) : KFRAG(0, sidx >> 1, 0);
                if (sidx == 0) QMFMA(0, 0, f); else if (sidx == 1) QMFMA(0, 1, f); else if (sidx == 2) QMFMA(0, 2, f); else if (sidx == 3) QMFMA(0, 3, f);
                else if (sidx == 4) QMFMA(0, 4, f); else if (sidx == 5) QMFMA(0, 5, f); else if (sidx == 6) QMFMA(0, 6, f); else if (sidx == 7) QMFMA(0, 7, f);
                else if (sidx == 8) QMFMA(0, 8, f); else if (sidx == 9) QMFMA(0, 9, f); else if (sidx == 10) QMFMA(0, 10, f); else QMFMA(0, 11, f); }
            ps[0] = 0.f;
            att_slot_ops<0, 0, 1>(p0[0], p1[0], ps[0], pa[0]);
            SB();
        }
#define STEP(u) do { constexpr int m_ = (u) % NMAP, tt_ = (u) / NMAP; constexpr bool nxt_ = ((u) + 1 < NU); \
              \
            if (nxt_) { ps[((u) + 1) & 1] = 0.f; kfw[0] = KFRAG((u) + 1, 0, 0); kfw[1] = KFRAG((u) + 1, 0, 1); \
                PHA(u, 0) PHA(u, 1) PHA(u, 2) PHA(u, 3) if (NA > 4) { PHA(u, 4) PHA(u, 5) PHA(u, 6) PHA(u, 7) PHA(u, 8) PHA(u, 9) PHA(u, 10) PHA(u, 11) } } \
            else { att_slot_ops<2, 0, 1>(p0[(u) & 1], p1[(u) & 1], ps[(u) & 1], pa[(u) & 1]); SB(); } \
            { float t_ = ps[(u) & 1]; auto rr = __builtin_amdgcn_permlane32_swap(__float_as_uint(t_), __float_as_uint(t_), false, false); t_ = __uint_as_float(rr[0]) + __uint_as_float(rr[1]); \
              l_reg[m_] += t_; bad = fmaxf(bad, t_); } \
              \
            PHB(u, 0) PHB(u, 1) } while (0)
#define PHA(u, s) { if ((s) < NA) { if ((s) + 2 < NA) kfw[((s) + 2) % 3] = (((s) + 2) & 1) ? KFRAG((u) + 1, ((s) + 2) >> 1, 1) : KFRAG((u) + 1, ((s) + 2) >> 1, 0); \
              QMFMA((u) + 1, (s), kfw[(s) % 3]); \
              att_slot_ops<2, (s), NA>(p0[(u) & 1], p1[(u) & 1], ps[(u) & 1], pa[(u) & 1]); SB(); } }
#define PHB(u, d0b) { const int vbb_ = vb + ((u) / NMAP) * 8192; \
              const s16x4 l0 = tr_read<v_rd_off(d0b, 0, 0)>(vbb_), h0 = tr_read<v_rd_off(d0b, 0, 1)>(vbb_), l1 = tr_read<v_rd_off(d0b, 1, 0)>(vbb_), h1 = tr_read<v_rd_off(d0b, 1, 1)>(vbb_); \
              const s16x4 l2 = tr_read<v_rd_off(d0b, 2, 0)>(vbb_), h2 = tr_read<v_rd_off(d0b, 2, 1)>(vbb_), l3 = tr_read<v_rd_off(d0b, 3, 0)>(vbb_), h3 = tr_read<v_rd_off(d0b, 3, 1)>(vbb_); \
              asm volatile("s_waitcnt lgkmcnt(0)" ::: "memory"); SB(); \
              f32x16& od_ = o[(u) % NMAP][d0b]; \
              od_ = __builtin_amdgcn_mfma_f32_32x32x16_bf16(pa[(u) & 1][0], PKV(l0, h0), od_, 0, 0, 0); if ((u) + 1 < NU) att_slot_ops<0, (d0b) * 4 + 0, 8>(p0[((u) + 1) & 1], p1[((u) + 1) & 1], ps[((u) + 1) & 1], pa[((u) + 1) & 1]); SB(); \
              od_ = __builtin_amdgcn_mfma_f32_32x32x16_bf16(pa[(u) & 1][1], PKV(l1, h1), od_, 0, 0, 0); if ((u) + 1 < NU) att_slot_ops<0, (d0b) * 4 + 1, 8>(p0[((u) + 1) & 1], p1[((u) + 1) & 1], ps[((u) + 1) & 1], pa[((u) + 1) & 1]); SB(); \
              od_ = __builtin_amdgcn_mfma_f32_32x32x16_bf16(pa[(u) & 1][2], PKV(l2, h2), od_, 0, 0, 0); if ((u) + 1 < NU) att_slot_ops<0, (d0b) * 4 + 2, 8>(p0[((u) + 1) & 1], p1[((u) + 1) & 1], ps[((u) + 1) & 1], pa[((u) + 1) & 1]); SB(); \
              od_ = __builtin_amdgcn_mfma_f32_32x32x16_bf16(pa[(u) & 1][3], PKV(l3, h3), od_, 0, 0, 0); if ((u) + 1 < NU) att_slot_ops<0, (d0b) * 4 + 3, 8>(p0[((u) + 1) & 1], p1[((u) + 1) & 1], ps[((u) + 1) & 1], pa[((u) + 1) & 1]); SB(); }
#define PKV(L, H) (bf16x8){L[0], L[1], L[2], L[3], H[0], H[1], H[2], H[3]}
        STEP(0); STEP(1);
        if (NU > 2) { STEP(2 % NU); STEP(3 % NU); }
#undef PKV
#undef PHB
#undef PHA
#undef STEP
#undef QMFMA
#undef KFRAG
    }
#undef SB
#undef ADMA
    float rli[NMAP][16];
#pragma unroll
    for (int m = 0; m < NMAP; ++m) {
        asm volatile("s_waitcnt lgkmcnt(0)" ::: "memory");
        if (hi == 0) wsl[r32] = l_reg[m];
        asm volatile("s_waitcnt lgkmcnt(0)" ::: "memory");
#pragma unroll
        for (int r = 0; r < 16; ++r) rli[m][r] = __builtin_amdgcn_rcpf(wsl[crow(r, hi)]);
    }
    const int orow0 = qrow0 + wid * 32;
    if (!DIFF) {
#pragma unroll
        for (int r = 0; r < 16; ++r) { bf16_t* dst = C_HB + (size_t)(orow0 + crow(r, hi)) * D + 512 + hd * 64 + r32;
            dst[0] = f2bf(o[0][0][r] * rli[0][r]); dst[32] = f2bf(o[0][1][r] * rli[0][r]); }
    } else {
        const float* lp = CIN(19) + l * 128; const float* gn = CIN(20) + l * 64; asm volatile("" : "+s"(lp), "+s"(gn));
        float s1 = lp[r32] * lp[32 + r32], s2 = lp[64 + r32] * lp[96 + r32];
#pragma unroll
        for (int o = 1; o < 32; o <<= 1) { s1 += shx(s1, o, lane); s2 += shx(s2, o, lane); }
        const float lam_init = (l == 0) ? 0.2f : 0.35550906759097f;
        const float lam = __expf(s1) - __expf(s2) + lam_init;
        const float g0 = gn[r32] * (1.f - lam_init), g1 = gn[32 + r32] * (1.f - lam_init);
#pragma unroll
        for (int r = 0; r < 16; ++r) {
            const float v0 = o[0][0][r] * rli[0][r] - lam * o[NMAP - 1][0][r] * rli[NMAP - 1][r];
            const float v1 = o[0][1][r] * rli[0][r] - lam * o[NMAP - 1][1][r] * rli[NMAP - 1][r];
            float ss = v0 * v0 + v1 * v1;
            ss += shx(ss, 1, lane); ss += shx(ss, 2, lane); ss += shx(ss, 4, lane); ss += shx(ss, 8, lane); ss += shx(ss, 16, lane);
            const float rstd = rsqrtf(ss * (1.f / 64.f) + NORM_EPS);
            bf16_t* dst = C_HB + (size_t)(orow0 + crow(r, hi)) * D + 768 + hd * 64 + r32;
            dst[0] = f2bf(v0 * rstd * g0); dst[32] = f2bf(v1 * rstd * g1); }
    }
    int* flag = (int*)(lds + 2 * ATT_STAGE + 8 * 64 * 4);
    __syncthreads();
    if (tid == 0) *flag = 0;
    __syncthreads();
    if (!(bad <= ATT_BIG)) *flag = 1;
    __syncthreads();
    const bool redo = *flag != 0;
    __syncthreads();
    return redo;
}
#ifndef PAIR_DIFF
#define PAIR_DIFF 1
#endif
#ifndef PAIR_MLA
#define PAIR_MLA 1
#endif
__device__ void ph_attn(const Ctx& c, int l, char* lds) {
    const bool need_ctx = (l < DEPTH - 1);
    const int nitem = 1024 + (need_ctx ? 32 : 0);
    for (int it = blockIdx.x; it < nitem; it += gridDim.x) {
        bool diff; int b, hd, q0, k0, nk;
        if (it < 1024) { const int combo = ((it >> 8) << 3) | (it & 7), qt = (it >> 3) & 31; diff = combo < 16; b = (combo >> 2) & 3; hd = combo & 3; q0 = b * RPB + CTX + qt * 256; k0 = b * RPB; nk = RPB; }
        else { const int u = it - 1024; diff = u < 16; b = u & 3; hd = (u >> 2) & 3; q0 = b * RPB; k0 = b * RPB; nk = CTX; }
#if PAIR_DIFF
        if (diff) { if (attn_item_pair<true>(c, l, b, hd, q0, k0, nk, lds)) attn_item<true>(c, l, b, hd, q0, k0, nk, lds); }
#else
        if (diff) attn_item<true>(c, l, b, hd, q0, k0, nk, lds);
#endif
#if PAIR_MLA
        else { if (attn_item_pair<false>(c, l, b, hd, q0, k0, nk, lds)) attn_item<false>(c, l, b, hd, q0, k0, nk, lds); }
#else
        else { if (attn_item_fast<false>(c, l, b, hd, q0, k0, nk, lds)) attn_item<false>(c, l, b, hd, q0, k0, nk, lds); }
#endif
    }
}

typedef float f32v2 __attribute__((ext_vector_type(2)));
__device__ void cvt_tables(const Ctx& c, int l) {
    for (int row = blockIdx.x * 8 + c.wid; row < 2 * NEXP; row += gridDim.x * 8) {
        const bool isu = row < NEXP; const int e = isu ? row : row - NEXP;
        const float* s = CIN(isu ? 23 : 24) + ((size_t)l * NEXP + e) * D + c.lane * 16;
        f32x4 v[4]; float mx = 0.f;
#pragma unroll
        for (int i = 0; i < 4; ++i) { v[i] = *(const f32x4*)(s + 4 * i); mx = fmaxf(mx, fmaxf(fmaxf(fabsf(v[i][0]), fabsf(v[i][1])), fmaxf(fabsf(v[i][2]), fabsf(v[i][3])))); }
#pragma unroll
        for (int o = 32; o >= 1; o >>= 1) mx = fmaxf(mx, __shfl_xor(mx, o, 64));
        const float q = mx > 0.f ? 256.f / mx : 0.f;
        if (c.lane == 0) (isu ? C_SU : C_SV)[e] = mx * (1.f / 256.f);
        u32x4 w;
#pragma unroll
        for (int i = 0; i < 4; ++i) { int p = 0; p = __builtin_amdgcn_cvt_pk_fp8_f32(v[i][0] * q, v[i][1] * q, p, false); p = __builtin_amdgcn_cvt_pk_fp8_f32(v[i][2] * q, v[i][3] * q, p, true); w[i] = (unsigned)p; }
        *(u32x4*)((isu ? C_TU8 : C_TV8) + ((size_t)(c.lane >> 3) * NEXP + e) * 128 + (c.lane & 7) * 16) = w;
    }
}
__device__ __forceinline__ unsigned ford(float x) { const unsigned u = __float_as_uint(x); return (u & 0x80000000u) ? ~u : (u | 0x80000000u); }
__device__ __forceinline__ float funord(unsigned k) { const unsigned u = (k & 0x80000000u) ? (k & 0x7fffffffu) : ~k; return __uint_as_float(u); }
__device__ __forceinline__ void sort16_desc(unsigned (&v)[16]) {
#pragma unroll
    for (int k = 2; k <= 16; k <<= 1)
#pragma unroll
        for (int j = k >> 1; j > 0; j >>= 1)
#pragma unroll
            for (int i = 0; i < 16; ++i) { const int l = i ^ j; if (l > i) { const unsigned a = v[i], b = v[l]; const unsigned hi = max(a, b), lo = min(a, b);
                if ((i & k) == 0) { v[i] = hi; v[l] = lo; } else { v[i] = lo; v[l] = hi; } } }
}
__device__ __forceinline__ void merge16_desc(unsigned (&t)[16], const unsigned (&v)[16]) {
#pragma unroll
    for (int i = 0; i < 16; ++i) t[i] = max(t[i], v[15 - i]);
#pragma unroll
    for (int j = 8; j > 0; j >>= 1)
#pragma unroll
        for (int i = 0; i < 16; ++i) { const int l = i ^ j; if (l > i) { const unsigned a = t[i], b = t[l]; t[i] = max(a, b); t[l] = min(a, b); } }
}
constexpr int TOPK_LDS = 2 * 128 * 129 * 4;
__device__ void peer_topk_item(const Ctx& c, int l, int tm, int h, char* lds) {
    float* S = (float*)lds;
    const int tid = c.tid, lane = c.lane, wid = c.wid, r32 = lane & 31, hi = lane >> 5, wm = wid >> 1, wn = wid & 1;
    const int row0 = tm * 128;
    bf16x8 fa[2][8];
#pragma unroll
    for (int p = 0; p < 2; ++p) { const bf16_t* Ap = C_Q2 + (size_t)(row0 + wm * 32 + r32) * 2048 + h * 256 + p * 128 + hi * 8;
#pragma unroll
        for (int ks = 0; ks < 8; ++ks) fa[p][ks] = *(const bf16x8*)(Ap + ks * 16); }
#pragma unroll
    for (int p = 0; p < 2; ++p) {
        f32x16 acc[2];
        zero_acc(acc[0]); zero_acc(acc[1]);
        const bf16_t* Bp = C_KEYS + ((((size_t)l * 8 + h) * 2 + p) * 128 + wn * 64 + r32) * 128 + hi * 8;
        bf16x8 fb0[8], fb1[8];
#pragma unroll
        for (int ks = 0; ks < 8; ++ks) { fb0[ks] = *(const bf16x8*)(Bp + ks * 16); fb1[ks] = *(const bf16x8*)(Bp + 32 * 128 + ks * 16); }
        asm volatile("" : "+v"(fa[p][0]), "+v"(fa[p][1]), "+v"(fa[p][2]), "+v"(fa[p][3]), "+v"(fa[p][4]), "+v"(fa[p][5]), "+v"(fa[p][6]), "+v"(fa[p][7]));
        asm volatile("" : "+v"(fb0[0]), "+v"(fb0[1]), "+v"(fb0[2]), "+v"(fb0[3]), "+v"(fb0[4]), "+v"(fb0[5]), "+v"(fb0[6]), "+v"(fb0[7]));
        asm volatile("" : "+v"(fb1[0]), "+v"(fb1[1]), "+v"(fb1[2]), "+v"(fb1[3]), "+v"(fb1[4]), "+v"(fb1[5]), "+v"(fb1[6]), "+v"(fb1[7]));
#pragma unroll
        for (int ks = 0; ks < 8; ++ks) {
            acc[0] = __builtin_amdgcn_mfma_f32_32x32x16_bf16(fa[p][ks], fb0[ks], acc[0], 0, 0, 0);
            acc[1] = __builtin_amdgcn_mfma_f32_32x32x16_bf16(fa[p][ks], fb1[ks], acc[1], 0, 0, 0);
        }
#pragma unroll
        for (int n = 0; n < 2; ++n)
#pragma unroll
            for (int r = 0; r < 16; ++r) S[(p * 128 + wm * 32 + crow(r, hi)) * 129 + wn * 64 + n * 32 + r32] = acc[n][r];
    }
    __syncthreads();
    unsigned tk[16];
    { const int list = tid >> 1, half = tid & 1; const float* sr = S + list * 129 + half * 64;
#pragma unroll
        for (int g = 0; g < 4; ++g) { unsigned v[16];
#pragma unroll
            for (int i = 0; i < 16; ++i) { const int n = half * 64 + g * 16 + i; v[i] = (ford(sr[g * 16 + i]) & ~127u) | (unsigned)(127 - n); }
            sort16_desc(v);
            if (g == 0) {
#pragma unroll
                for (int i = 0; i < 16; ++i) tk[i] = v[i]; }
            else merge16_desc(tk, v); } }
    __syncthreads();
    unsigned* X = (unsigned*)lds;
    unsigned* L = X + 256 * 17;
    if (tid & 1) {
#pragma unroll
        for (int i = 0; i < 16; ++i) X[(tid >> 1) * 17 + i] = tk[i]; }
    __syncthreads();
    if (!(tid & 1)) { unsigned v[16];
#pragma unroll
        for (int i = 0; i < 16; ++i) v[i] = X[(tid >> 1) * 17 + i];
        merge16_desc(tk, v);
#pragma unroll
        for (int i = 0; i < 16; ++i) L[(tid >> 1) * 17 + i] = tk[i]; }
    __syncthreads();
    unsigned bk[16];
    const int row = (tid >> 1) & 127, hh = tid & 1;
    const unsigned* l0 = L + row * 17; const unsigned* l1 = L + (128 + row) * 17;
    if (tid < 256) {
        float s0[8], s1[16];
#pragma unroll
        for (int ii = 0; ii < 8; ++ii) s0[ii] = funord(l0[2 * ii + hh] & ~127u);
#pragma unroll
        for (int j = 0; j < 16; ++j) s1[j] = funord(l1[j] & ~127u);
        unsigned ck[32];
        { int slot = 0;
#pragma unroll
            for (int ii = 0; ii < 8; ++ii)
#pragma unroll
                for (int j = 0; j < 16; ++j) if ((2 * ii + 1) * (j + 1) <= 16) {
                    const int i = 2 * ii + hh; const bool ok = (i + 1) * (j + 1) <= 16;
                    const unsigned key = (ford(s0[ii] + s1[j]) & ~255u) | (unsigned)(255 - (i * 16 + j));
                    ck[slot] = ok ? key : 0u; ++slot; }
#pragma unroll
            for (; slot < 32; ++slot) ck[slot] = 0u; }
        unsigned v0[16], v1[16];
#pragma unroll
        for (int i = 0; i < 16; ++i) { v0[i] = ck[i]; v1[i] = ck[16 + i]; }
        sort16_desc(v0); sort16_desc(v1);
        merge16_desc(v0, v1);
#pragma unroll
        for (int i = 0; i < 16; ++i) bk[i] = v0[i];
    }
    __syncthreads();
    if (tid < 256 && hh) {
#pragma unroll
        for (int i = 0; i < 16; ++i) X[row * 17 + i] = bk[i]; }
    __syncthreads();
    if (tid < 256 && !hh) { unsigned v[16];
#pragma unroll
        for (int i = 0; i < 16; ++i) v[i] = X[row * 17 + i];
        merge16_desc(bk, v);
        float best[16]; int eid[16]; float mx = -1e30f;
#pragma unroll
        for (int q = 0; q < 16; ++q) { const int ij = 255 - (int)(bk[q] & 255u); const int i = ij >> 4, j = ij & 15;
            const unsigned k0 = l0[i], k1 = l1[j];
            best[q] = funord(k0 & ~127u) + funord(k1 & ~127u);
            eid[q] = (127 - (int)(k0 & 127u)) * 128 + (127 - (int)(k1 & 127u));
            mx = fmaxf(mx, best[q]); }
        float sum = 0.f;
#pragma unroll
        for (int q = 0; q < 16; ++q) { best[q] = __expf(best[q] - mx); sum += best[q]; }
        const float inv = 1.f / sum;
        const size_t o = (size_t)(row0 + row) * 128 + h * 16;
#pragma unroll
        for (int q = 0; q < 16; q += 4) { *(u32x4*)(C_EI + o + q) = (u32x4){(unsigned)eid[q], (unsigned)eid[q + 1], (unsigned)eid[q + 2], (unsigned)eid[q + 3]};
            *(f32x4*)(C_EG + o + q) = (f32x4){best[q] * inv, best[q + 1] * inv, best[q + 2] * inv, best[q + 3] * inv}; }
    }
    __syncthreads();
}
__device__ __forceinline__ float gelu_tanh(float x) { const float u = 0.7978845608028654f * (x + 0.044715f * x * x * x); const float t = 1.f - 2.f / (1.f + __expf(2.f * u)); return 0.5f * x * (1.f + t); }
__device__ __forceinline__ int tok_row(int ti, bool need_ctx) { return need_ctx ? ti : (ti >> 13) * RPB + CTX + (ti & 8191); }
struct PeerTok { u32x4 t[16]; u32x4 xa, xb; f32v2 xv, gv; };
__device__ __forceinline__ void peer_issue(PeerTok& T, const unsigned char* t8, const int* el, const bf16_t* xp, int grp, bool want_x) {
#pragma unroll
    for (int u = 0; u < 16; ++u) { const int e = el[u * 8 + grp]; T.t[u] = *(const u32x4*)(t8 + (size_t)e * 128); }
    if (want_x) { T.xa = *(const u32x4*)xp; T.xb = *(const u32x4*)(xp + 8); }
}
__device__ __forceinline__ void peer_u_compute(const PeerTok& T, float* pp, int sub, int grp, int lane) {
    f32v2 x2[8];
#pragma unroll
    for (int q = 0; q < 4; ++q) { x2[q] = (f32v2){bflo(T.xa[q]), bfhi(T.xa[q])}; x2[4 + q] = (f32v2){bflo(T.xb[q]), bfhi(T.xb[q])}; }
    float keep[2];
#pragma unroll
    for (int hf = 0; hf < 2; ++hf) {
        float a[8];
#pragma unroll
        for (int u = 0; u < 8; ++u) { f32v2 s2 = {0.f, 0.f};
#pragma unroll
            for (int q = 0; q < 4; ++q) { const unsigned w = T.t[hf * 8 + u][q];
                s2 = __builtin_elementwise_fma(__builtin_amdgcn_cvt_pk_f32_fp8(w, false), x2[2 * q], s2);
                s2 = __builtin_elementwise_fma(__builtin_amdgcn_cvt_pk_f32_fp8(w, true), x2[2 * q + 1], s2); }
            a[u] = s2[0] + s2[1]; }
        const bool b2 = (lane & 4) != 0, b1 = (lane & 2) != 0, b0 = (lane & 1) != 0;
        float r4[4], r2[2];
#pragma unroll
        for (int q = 0; q < 4; ++q) { const float mine = b2 ? a[4 + q] : a[q], oth = b2 ? a[q] : a[4 + q]; r4[q] = mine + __shfl_xor(oth, 4, 64); }
#pragma unroll
        for (int q = 0; q < 2; ++q) { const float mine = b1 ? r4[2 + q] : r4[q], oth = b1 ? r4[q] : r4[2 + q]; r2[q] = mine + __shfl_xor(oth, 2, 64); }
        { const float mine = b0 ? r2[1] : r2[0], oth = b0 ? r2[0] : r2[1]; keep[hf] = mine + __shfl_xor(oth, 1, 64); }
    }
    pp[sub * 8 + grp] = keep[0]; pp[(8 + sub) * 8 + grp] = keep[1];
}
__device__ void peer_u_item(const Ctx& c, int l, int j, int tb, char* lds) {
    const bool need_ctx = (l < DEPTH - 1);
    int* el = (int*)lds + c.wid * 256;
    const int lane = c.lane, sub = lane & 7, grp = lane >> 3;
    const unsigned char* t8 = C_TU8 + (size_t)j * NEXP * 128 + sub * 16;
    const int tok0 = tb * 128 + c.wid * 16;
    const int xoff = j * 128 + sub * 16;
    PeerTok A, B;
    int e0, e1;
    { const int r = tok_row(tok0, need_ctx); e0 = C_EI[(size_t)r * 128 + lane]; e1 = C_EI[(size_t)r * 128 + 64 + lane];
      el[lane] = e0; el[64 + lane] = e1;
      peer_issue(A, t8, el, C_HB + (size_t)r * D + xoff, grp, true);
      const int r1 = tok_row(tok0 + 1, need_ctx); e0 = C_EI[(size_t)r1 * 128 + lane]; e1 = C_EI[(size_t)r1 * 128 + 64 + lane]; }
#pragma unroll 1
    for (int k = 0; k < 16; k += 2) {
        { const int r1 = tok_row(tok0 + k + 1, need_ctx); el[128 + lane] = e0; el[192 + lane] = e1;
          peer_issue(B, t8, el + 128, C_HB + (size_t)r1 * D + xoff, grp, true);
          if (k + 2 < 16) { const int r2 = tok_row(tok0 + k + 2, need_ctx); e0 = C_EI[(size_t)r2 * 128 + lane]; e1 = C_EI[(size_t)r2 * 128 + 64 + lane]; } }
        peer_u_compute(A, C_PART + ((size_t)j * NR + tok_row(tok0 + k, need_ctx)) * 128, sub, grp, lane);
        if (k + 2 < 16) { const int r2 = tok_row(tok0 + k + 2, need_ctx); el[lane] = e0; el[64 + lane] = e1;
          peer_issue(A, t8, el, C_HB + (size_t)r2 * D + xoff, grp, true);
          if (k + 3 < 16) { const int r3 = tok_row(tok0 + k + 3, need_ctx); e0 = C_EI[(size_t)r3 * 128 + lane]; e1 = C_EI[(size_t)r3 * 128 + 64 + lane]; } }
        peer_u_compute(B, C_PART + ((size_t)j * NR + tok_row(tok0 + k + 1, need_ctx)) * 128, sub, grp, lane);
    }
}
__device__ void ph_peer_combine(const Ctx& c, int l) {
    const bool need_ctx = (l < DEPTH - 1);
    const int ntok = need_ctx ? NR : NB * SEQ;
    for (int ti = blockIdx.x * 8 + c.wid; ti < ntok; ti += gridDim.x * 8) {
        const int r = tok_row(ti, need_ctx);
#pragma unroll
        for (int hf = 0; hf < 2; ++hf) { const size_t o = (size_t)r * 128 + hf * 64 + c.lane;
            const int e = C_EI[o]; float sacc = 0.f;
#pragma unroll
            for (int jj = 0; jj < 8; ++jj) sacc += C_PART[((size_t)jj * NR + r) * 128 + hf * 64 + c.lane];
            C_EG[o] = C_EG[o] * gelu_tanh(sacc * C_SU[e]) * C_SV[e]; }
    }
}
__device__ __forceinline__ void peer_v_compute(const PeerTok& T, const float* wl, float* xo, int grp, int lane) {
    f32v2 acc[8];
#pragma unroll
    for (int q = 0; q < 8; ++q) acc[q] = (f32v2){0.f, 0.f};
#pragma unroll
    for (int u = 0; u < 16; ++u) { const float wv = wl[u * 8 + grp]; const f32v2 w2 = {wv, wv};
#pragma unroll
        for (int q = 0; q < 4; ++q) { const unsigned w = T.t[u][q];
            acc[2 * q] = __builtin_elementwise_fma(__builtin_amdgcn_cvt_pk_f32_fp8(w, false), w2, acc[2 * q]);
            acc[2 * q + 1] = __builtin_elementwise_fma(__builtin_amdgcn_cvt_pk_f32_fp8(w, true), w2, acc[2 * q + 1]); } }
    const bool b5 = (lane & 32) != 0, b4 = (lane & 16) != 0, b3 = (lane & 8) != 0;
    f32v2 r4[4], r2[2], r1;
#pragma unroll
    for (int q = 0; q < 4; ++q) { const f32v2 mine = b5 ? acc[4 + q] : acc[q], oth = b5 ? acc[q] : acc[4 + q];
        r4[q] = (f32v2){mine[0] + __shfl_xor(oth[0], 32, 64), mine[1] + __shfl_xor(oth[1], 32, 64)}; }
#pragma unroll
    for (int q = 0; q < 2; ++q) { const f32v2 mine = b4 ? r4[2 + q] : r4[q], oth = b4 ? r4[q] : r4[2 + q];
        r2[q] = (f32v2){mine[0] + __shfl_xor(oth[0], 16, 64), mine[1] + __shfl_xor(oth[1], 16, 64)}; }
    { const f32v2 mine = b3 ? r2[1] : r2[0], oth = b3 ? r2[0] : r2[1]; r1 = (f32v2){mine[0] + __shfl_xor(oth[0], 8, 64), mine[1] + __shfl_xor(oth[1], 8, 64)}; }
    f32v2 xv = T.xv; const f32v2 gv = T.gv;
    xv[0] += gv[0] * r1[0]; xv[1] += gv[1] * r1[1];
    *(f32v2*)xo = xv;
}
__device__ void peer_v_item(const Ctx& c, int l, int j, int tb, char* lds) {
    const bool need_ctx = (l < DEPTH - 1);
    int* el = (int*)lds + c.wid * 512; float* wl = (float*)(el + 256);
    const int lane = c.lane, sub = lane & 7, grp = lane >> 3;
    const unsigned char* t8 = C_TV8 + (size_t)j * NEXP * 128 + sub * 16;
    const int tok0 = tb * 128 + c.wid * 16;
    const int col = j * 128 + sub * 16 + ((lane & 32) ? 8 : 0) + ((lane & 16) ? 4 : 0) + ((lane & 8) ? 2 : 0);
    const float* gate5 = C_MODT + (size_t)l * 5 * 6144 + 5 * D + col;
    PeerTok A, B;
    int e0, e1; float w0, w1;
#define VISSUE(T, tok, eoff) do { const int r_ = tok_row((tok), need_ctx); const int b_ = r_ / RPB; const bool ctx_ = (r_ - b_ * RPB) < CTX; \
        peer_issue(T, t8, el + (eoff), nullptr, grp, false); T.xv = *(const f32v2*)(xrow(c, r_) + col); T.gv = *(const f32v2*)(gate5 + (size_t)(ctx_ ? 4 : b_) * 6144); } while (0)
#define VFETCH(tok) do { const int r_ = tok_row((tok), need_ctx); e0 = C_EI[(size_t)r_ * 128 + lane]; e1 = C_EI[(size_t)r_ * 128 + 64 + lane]; w0 = C_EG[(size_t)r_ * 128 + lane]; w1 = C_EG[(size_t)r_ * 128 + 64 + lane]; } while (0)
    VFETCH(tok0);
    el[lane] = e0; el[64 + lane] = e1; wl[lane] = w0; wl[64 + lane] = w1;
    VISSUE(A, tok0, 0);
    VFETCH(tok0 + 1);
#pragma unroll 1
    for (int k = 0; k < 16; k += 2) {
        el[128 + lane] = e0; el[192 + lane] = e1; wl[128 + lane] = w0; wl[192 + lane] = w1;
        VISSUE(B, tok0 + k + 1, 128);
        if (k + 2 < 16) VFETCH(tok0 + k + 2);
        peer_v_compute(A, wl, xrow(c, tok_row(tok0 + k, need_ctx)) + col, grp, lane);
        if (k + 2 < 16) { el[lane] = e0; el[64 + lane] = e1; wl[lane] = w0; wl[64 + lane] = w1;
          VISSUE(A, tok0 + k + 2, 0);
          if (k + 3 < 16) VFETCH(tok0 + k + 3); }
        peer_v_compute(B, wl + 128, xrow(c, tok_row(tok0 + k + 1, need_ctx)) + col, grp, lane);
    }
#undef VISSUE
#undef VFETCH
}
template <int SUB>
__device__ void ph_peer_expert(const Ctx& c, int l, char* lds) {
    const bool need_ctx = (l < DEPTH - 1);
    unsigned* cnt = (unsigned*)CWS(WS_CTL) + 4096 + ((l * 2 + SUB) * 8) * 64;
    const int nitem = (need_ctx ? NR : NB * SEQ) / 128;
    const int x = (int)(xb_xcc_id() & 7u);
    volatile int* sh = (volatile int*)(lds + 16384);
    for (int jo = 0; jo < 8; ++jo) { const int j = (x + jo) & 7;
        int nxt = 0;
        if (c.tid == 0) nxt = (int)__hip_atomic_fetch_add(&cnt[j * 64], 1u, __ATOMIC_RELAXED, __HIP_MEMORY_SCOPE_AGENT);
        for (;;) {
            if (c.tid == 0) *sh = nxt;
            __syncthreads(); const int it = *sh; __syncthreads();
            if (it >= nitem) break;
            if (c.tid == 0) nxt = (int)__hip_atomic_fetch_add(&cnt[j * 64], 1u, __ATOMIC_RELAXED, __HIP_MEMORY_SCOPE_AGENT);
            if (SUB == 0) peer_u_item(c, l, j, it, lds); else peer_v_item(c, l, j, it, lds);
        }
    }
}
__device__ void ph_final(const Ctx& c) {
    const float* g = CIN(25);
    const int stride = gridDim.x * 8;
    int r = blockIdx.x * 8 + c.wid;
    f32x4 xn[4];
    if (r < NB * SEQ) { const float* src = COUT + ((size_t)r << 10);
#pragma unroll
        for (int i = 0; i < 4; ++i) xn[i] = *(const f32x4*)(src + i * 256 + c.lane * 4); }
    for (; r < NB * SEQ; r += stride) {
        float* xr = COUT + ((size_t)r << 10);
        f32x4 x[4]; float ss = 0.f;
#pragma unroll
        for (int i = 0; i < 4; ++i) { x[i] = xn[i]; ss += x[i][0] * x[i][0] + x[i][1] * x[i][1] + x[i][2] * x[i][2] + x[i][3] * x[i][3]; }
        if (r + stride < NB * SEQ) { const float* src = COUT + ((size_t)(r + stride) << 10);
#pragma unroll
            for (int i = 0; i < 4; ++i) xn[i] = *(const f32x4*)(src + i * 256 + c.lane * 4); }
        ss = wave_sum(ss); const float rstd = rsqrtf(ss * (1.f / D) + NORM_EPS);
#pragma unroll
        for (int i = 0; i < 4; ++i) { const int col = i * 256 + c.lane * 4; const f32x4 gv = *(const f32x4*)(g + col); f32x4 y;
#pragma unroll
            for (int e = 0; e < 4; ++e) y[e] = x[i][e] * rstd * gv[e];
            *(f32x4*)(xr + col) = y; }
    }
}

namespace pg8 {
#define PG8_LAS __attribute__((address_space(3)))
typedef unsigned short bf16_t;
typedef short bf16x8 __attribute__((ext_vector_type(8)));
typedef float f32x4 __attribute__((ext_vector_type(4)));
typedef unsigned u32x4 __attribute__((ext_vector_type(4)));
constexpr int BM = 256, BK = 64, HALF = 128, HTB = HALF * BK * 2  , STAGE_BYTES = 8 * HTB, NXCD = 8, WGM = 8;

__host__ __device__ __forceinline__ int lds_byte(int r, int c) { const int st = (r >> 4) * 2 + (c >> 5), rr = r & 15, cc = c & 31, ob = rr * 64 + cc * 2; return st * 1024 + (ob ^ (((ob >> 9) & 1) << 5)); }
__host__ __device__ __forceinline__ void stage_rc(int b, int& R, int& C) { const int st = b / 1024, sb = b % 1024, swz = sb ^ (((sb >> 9) & 1) << 5); R = (st >> 1) * 16 + swz / 64; C = (st & 1) * 32 + (swz % 64) / 2; }
__host__ __device__ __forceinline__ int perm32(int rho) { const int n = rho >> 4, i = rho & 15; return 8 * (i >> 2) + 4 * n + (i & 3); }

struct Unit { int pm, pn; };
struct Gemm { const bf16_t* A; const bf16_t* Bt; int M, N, K; };
struct TileOrder {
    int nM, nN, nwg, G, c; bool skip_ctx;
    __device__ void init(int nM_, int nN_, int G_, int c_, bool skip) { nM = nM_; nN = nN_; nwg = nM_ * nN_; G = G_; c = c_; skip_ctx = skip; }
    __device__ bool next(int i, Unit& u) const {
        const long L = (long)i * G + c; if (L >= nwg) return false;
        int wgid = (int)L; { const int q = nwg / NXCD, r = nwg % NXCD, xcd = wgid % NXCD, off = wgid / NXCD; wgid = (xcd < r ? xcd * (q + 1) : r * (q + 1) + (xcd - r) * q) + off; }
        const int nig = WGM * nN, gid = wgid / nig, fm = gid * WGM, gsz = (nM - fm) < WGM ? (nM - fm) : WGM;
        int pm = fm + ((wgid % nig) % gsz); u.pn = (wgid % nig) / gsz;
        if (skip_ctx) pm = 33 * (pm >> 5) + 1 + (pm & 31);
        u.pm = pm; return true;
    }
    __device__ __forceinline__ void a_ready(const Unit&) const {}
    __device__ __forceinline__ void done(const Unit&) const {}
};
template <class Epi, class Sched, bool STAMP = false>
__device__ __forceinline__ void gemm_phase(PG8_LAS unsigned char* lds, const Gemm g, const Sched& S, const Epi& E, unsigned long long* stamps, int w0) {
    const int tid = mk_tid(w0), wid = w0, lane = tid & 63, wr = wid >> 2, wc = wid & 3, fr = lane & 15, fq = lane >> 4;
    const int K = g.K, nt = K / BK;
    int ts_lo = 0, ts_hi = 0, nts = 0; const unsigned long long rt_entry = STAMP ? (unsigned long long)wall_clock64() : 0ull;
#define PG8_STAMP() do { if (STAMP && wid == 0 && nts < 64) { const unsigned long long _c = (unsigned long long)clock64(); \
        ts_lo = (lane == nts) ? (int)(unsigned)_c : ts_lo; ts_hi = (lane == nts) ? (int)(unsigned)(_c >> 32) : ts_hi; ++nts; } } while (0)
    PG8_STAMP();
    unsigned voffA[2], voffB[2];
#pragma unroll
    for (int i = 0; i < 2; ++i) { int R, C; stage_rc(tid * 16 + i * 8192, R, C); const int Rb = Epi::PERM ? ((R & ~31) + perm32(R & 31)) : R;
        voffA[i] = (unsigned)(R * K + C) * 2u; voffB[i] = (unsigned)(Rb * K + C) * 2u; }
    const size_t kstep = (size_t)(BK * 2);
    const size_t hstep = (size_t)HALF * K * 2;
    const size_t tstep = 2 * hstep;
    const unsigned ldsw = (unsigned)wid * 1024u;
    const int aoff = lds_byte(wr * 64 + fr, fq * 8), boff = lds_byte(wc * 32 + fr, fq * 8);
#define PG8_SA(b, h) (((b) * 2 + (h)) * HTB)
#define PG8_SB(b, h) ((4 + (b) * 2 + (h)) * HTB)
#define PG8_STAGE(bufoff, gbase, voff) do { _Pragma("unroll") for (int _i = 0; _i < 2; ++_i) \
        __builtin_amdgcn_global_load_lds((const unsigned*)((const char*)(gbase) + (voff)[_i]), (PG8_LAS unsigned*)(lds + (bufoff) + ldsw + _i * 8192), 16, 0, 0); } while (0)
#define PG8_LDA(dst, b, h) do { _Pragma("unroll") for (int m = 0; m < 4; ++m) _Pragma("unroll") for (int k = 0; k < 2; ++k) dst[m][k] = *(const PG8_LAS bf16x8*)(lds + PG8_SA(b, h) + aoff + m * 2048 + k * 1024); } while (0)
#define PG8_LDB(dst, b, h) do { _Pragma("unroll") for (int n = 0; n < 2; ++n) _Pragma("unroll") for (int k = 0; k < 2; ++k) dst[n][k] = *(const PG8_LAS bf16x8*)(lds + PG8_SB(b, h) + boff + n * 2048 + k * 1024); } while (0)
#define PG8_MMA(ai, bj, At, Bt) do { __builtin_amdgcn_s_setprio(1); _Pragma("unroll") for (int m = 0; m < 4; ++m) _Pragma("unroll") for (int n = 0; n < 2; ++n) _Pragma("unroll") for (int k = 0; k < 2; ++k) \
        acc[ai][bj][m][n] = __builtin_amdgcn_mfma_f32_16x16x32_bf16(Bt[n][k], At[m][k], acc[ai][bj][m][n], 0, 0, 0); __builtin_amdgcn_s_setprio(0); } while (0)
#define PG8_WAIT_V(n) asm volatile("s_waitcnt vmcnt(" #n ")" ::: "memory")
#define PG8_WAIT_L(n) asm volatile("s_waitcnt lgkmcnt(" #n ")" ::: "memory")
#define PG8_BAR __builtin_amdgcn_s_barrier()
#define PG8_SCHED __builtin_amdgcn_sched_barrier(0)
    Unit cur, nxt; int ui = 0;
    if (!S.next(0, cur)) return;
    f32x4 acc[2][2][4][2];
#pragma unroll
    for (int a = 0; a < 2; ++a)
#pragma unroll
        for (int b = 0; b < 2; ++b)
#pragma unroll
            for (int m = 0; m < 4; ++m)
#pragma unroll
                for (int n = 0; n < 2; ++n) acc[a][b][m][n] = (f32x4){0.f, 0.f, 0.f, 0.f};
    bf16x8 At[4][2], B0[2][2], B1[2][2];
    const char* cA = (const char*)g.A + (size_t)cur.pm * tstep; const char* cB = (const char*)g.Bt + (size_t)cur.pn * tstep;
    S.a_ready(cur);
    PG8_STAGE(PG8_SB(0, 0), cB, voffB); PG8_STAGE(PG8_SA(0, 0), cA, voffA); PG8_STAGE(PG8_SB(0, 1), cB + hstep, voffB); PG8_STAGE(PG8_SA(0, 1), cA + hstep, voffA);
    if (wr == 1) PG8_BAR;
    PG8_WAIT_V(4); PG8_BAR;
    PG8_STAGE(PG8_SB(1, 0), cB + kstep, voffB); PG8_STAGE(PG8_SA(1, 0), cA + kstep, voffA); PG8_STAGE(PG8_SB(1, 1), cB + hstep + kstep, voffB);
    PG8_WAIT_V(6); PG8_BAR;
    PG8_STAMP();
    for (;;) {
        const bool has_next = S.next(ui + 1, nxt);
        const char* nA = has_next ? (const char*)g.A + (size_t)nxt.pm * tstep : cA; const char* nB = has_next ? (const char*)g.Bt + (size_t)nxt.pn * tstep : cB;
        for (int t = 0; t < nt; t += 2) {
            const bool last = (t == nt - 2);
            const char* a1 = cA + (size_t)(t + 1) * kstep;
            const char* a2 = last ? nA : cA + (size_t)(t + 2) * kstep; const char* b2 = last ? nB : cB + (size_t)(t + 2) * kstep;
            const char* a3 = a2 + kstep; const char* b3 = b2 + kstep;
            if (last && has_next) S.a_ready(nxt);
            PG8_LDB(B0, 0, 0); PG8_SCHED; PG8_LDA(At, 0, 0); PG8_STAGE(PG8_SA(1, 1), a1 + hstep, voffA);
            PG8_WAIT_L(8); PG8_BAR; PG8_WAIT_L(0); PG8_MMA(0, 0, At, B0); PG8_BAR; PG8_SCHED;
            PG8_LDB(B1, 0, 1); PG8_STAGE(PG8_SB(0, 0), b2, voffB);
            PG8_BAR; PG8_WAIT_L(0); PG8_MMA(0, 1, At, B1); PG8_BAR;
            PG8_LDA(At, 0, 1); PG8_STAGE(PG8_SA(0, 0), a2, voffA);
            PG8_BAR; PG8_WAIT_L(0); PG8_MMA(1, 0, At, B0); PG8_BAR; PG8_SCHED;
            PG8_STAGE(PG8_SB(0, 1), b2 + hstep, voffB);
            PG8_WAIT_V(6); PG8_BAR; PG8_MMA(1, 1, At, B1); PG8_BAR;
            PG8_LDB(B0, 1, 0); PG8_SCHED; PG8_LDA(At, 1, 0); PG8_STAGE(PG8_SA(0, 1), a2 + hstep, voffA);
            PG8_WAIT_L(8); PG8_BAR; PG8_WAIT_L(0); PG8_MMA(0, 0, At, B0); PG8_BAR; PG8_SCHED;
            PG8_LDB(B1, 1, 1); PG8_STAGE(PG8_SB(1, 0), b3, voffB);
            PG8_BAR; PG8_WAIT_L(0); PG8_MMA(0, 1, At, B1); PG8_BAR;
            PG8_LDA(At, 1, 1); PG8_STAGE(PG8_SA(1, 0), a3, voffA);
            PG8_BAR; PG8_WAIT_L(0); PG8_MMA(1, 0, At, B0); PG8_BAR; PG8_SCHED;
            PG8_STAGE(PG8_SB(1, 1), b3 + hstep, voffB);
            PG8_WAIT_V(6); PG8_BAR; PG8_MMA(1, 1, At, B1); PG8_BAR;
        }
        PG8_STAMP();
        if constexpr (!Epi::AFTER_DRAIN) { E(acc, cur, wr, wc, fr, fq); S.done(cur); }
        PG8_STAMP();
        if (!has_next) break;
#pragma unroll
        for (int a = 0; a < 2; ++a)
#pragma unroll
            for (int b = 0; b < 2; ++b)
#pragma unroll
                for (int m = 0; m < 4; ++m)
#pragma unroll
                    for (int n = 0; n < 2; ++n) acc[a][b][m][n] = (f32x4){0.f, 0.f, 0.f, 0.f};
        cur = nxt; cA = nA; cB = nB; ++ui;
    }
    PG8_WAIT_V(0);
    if (wr == 0) PG8_BAR;
    PG8_BAR;
    if constexpr (Epi::AFTER_DRAIN) { E.fused(acc, cur, wr, wc, fr, fq, lds, wid, lane); S.done(cur); }
    PG8_STAMP();
    if (STAMP && wid == 0) { stamps[lane] = lane < nts ? (((unsigned long long)(unsigned)ts_hi << 32) | (unsigned)ts_lo) : 0ull;
        if (lane == 62) stamps[62] = rt_entry; if (lane == 63) stamps[63] = (unsigned long long)wall_clock64(); }
#undef PG8_STAMP
#undef PG8_SA
#undef PG8_SB
#undef PG8_STAGE
#undef PG8_LDA
#undef PG8_LDB
#undef PG8_MMA
#undef PG8_WAIT_V
#undef PG8_WAIT_L
#undef PG8_BAR
#undef PG8_SCHED
}

struct EpiStoreBf16 {
    static constexpr bool PERM = true, AFTER_DRAIN = false;
    bf16_t* O; int ldc; int ncols; int slo, shi; float scale;
    __device__ __forceinline__ void operator()(const f32x4 (&acc)[2][2][4][2], const Unit& u, int wr, int wc, int fr, int fq) const {
        const int row0 = u.pm * BM + wr * 64 + fr, col0 = u.pn * BM + wc * 32 + 8 * fq;
        float sc[2];
#pragma unroll
        for (int bj = 0; bj < 2; ++bj) { const int cb = u.pn * BM + bj * HALF; sc[bj] = (cb >= slo && cb < shi) ? scale : 1.f; }
#pragma unroll
        for (int ai = 0; ai < 2; ++ai)
#pragma unroll
            for (int m = 0; m < 4; ++m) { bf16_t* rowp = O + (size_t)(row0 + ai * HALF + m * 16) * ldc + col0;
#pragma unroll
                for (int bj = 0; bj < 2; ++bj) if (col0 + bj * HALF < ncols) { const f32x4 v0 = acc[ai][bj][m][0] * sc[bj], v1 = acc[ai][bj][m][1] * sc[bj];
                    u32x4 w; w.x = ::cvtpk(v0[0], v0[1]); w.y = ::cvtpk(v0[2], v0[3]); w.z = ::cvtpk(v1[0], v1[1]); w.w = ::cvtpk(v1[2], v1[3]);
                    *(u32x4*)(rowp + bj * HALF) = w; }
                asm volatile("" ::: "memory"); }
    }
};
struct EpiResidX {
    static constexpr bool PERM = false, AFTER_DRAIN = false;
    float* xc; float* xout; const float* gate_l;
    __device__ __forceinline__ void operator()(const f32x4 (&acc)[2][2][4][2], const Unit& u, int wr, int wc, int fr, int fq) const {
        const int rowt = u.pm * BM; const int b = rowt / RPB, j0 = rowt - b * RPB; const bool isctx = j0 < CTX;
        float* xb = isctx ? xc + ((size_t)(b * CTX + j0) << 10) : xout + ((size_t)(b * SEQ + j0 - CTX) << 10);
        const float* gt = gate_l + (size_t)(isctx ? 4 : b) * 6144;
        const int r0 = wr * 64 + fr, col0 = u.pn * BM + wc * 32 + 4 * fq;
        f32x4 gv[2][2];
#pragma unroll
        for (int bj = 0; bj < 2; ++bj)
#pragma unroll
            for (int n = 0; n < 2; ++n) gv[bj][n] = *(const f32x4*)(gt + col0 + bj * HALF + n * 16);
#pragma unroll
        for (int ai = 0; ai < 2; ++ai)
#pragma unroll
            for (int m = 0; m < 4; ++m) { float* rowp = xb + ((size_t)(r0 + ai * HALF + m * 16) << 10) + col0;
#pragma unroll
                for (int bj = 0; bj < 2; ++bj)
#pragma unroll
                    for (int n = 0; n < 2; ++n) { f32x4* p = (f32x4*)(rowp + bj * HALF + n * 16); *p = *p + gv[bj][n] * acc[ai][bj][m][n]; }
                asm volatile("" ::: "memory"); }
    }
};
}

constexpr int LDS_BYTES = 144 * 1024;
static_assert(TOPK_LDS + 16 <= LDS_BYTES && GEMM_LDS + 16 <= LDS_BYTES && ATT_LDS + 16 <= LDS_BYTES, "LDS budget");
constexpr int PPL = 13;
constexpr int N_PHASES = 1 + PPL * DEPTH + 1;
extern __shared__ __attribute__((aligned(16))) char g_lds[];

#define PHASE_FN __device__ __forceinline__ void
PHASE_FN f_p0(int w0) { const Ctx c = fresh_ctx(w0); ph_p0(c, g_lds); }
PHASE_FN f_norm0(int w0, int l) { const Ctx c = fresh_ctx(w0); ph_norm<0>(c, l); }
PHASE_FN f_norm1(int w0, int l) { const Ctx c = fresh_ctx(w0); ph_norm<1>(c, l); }
PHASE_FN f_gemm_in(int w0, int l) { const Ctx c = fresh_ctx(w0);
    pg8::Gemm g{C_HB, C_WIN + (size_t)l * INC * D, NR, 3328, D};
    pg8::TileOrder S; S.init(132, 13, (int)gridDim.x, (int)blockIdx.x, false);
    pg8::EpiStoreBf16 E{C_P, INC, INC, DF_Q, DF_Q + 256, 0.17677669529663687f * 1.4426950408889634f};
    pg8::gemm_phase<pg8::EpiStoreBf16, pg8::TileOrder>((PG8_LAS unsigned char*)g_lds, g, S, E, nullptr, w0); }
PHASE_FN f_prep(int w0, int l) {
    const Ctx c = fresh_ctx(w0); char* lds = g_lds;
    ph_prep_rows(c, l);
    scan_tables(c, l, lds);
    { const int G = (int)gridDim.x, N = 16 * NCHUNK * 2, R = (N + G - 1) / G;
      for (int q = 0; q < 2 * R; ++q) { const int mx = q & 1; int u = (q >> 1) * G + (int)blockIdx.x; if (u >= N) continue;
        const int dir = u & 1; u >>= 1; const int cc = u % NCHUNK; u /= NCHUNK; const int h = u & 3, b = u >> 2;
        if (mx == 0) scanA_item<0>(c, l, b, h, cc, dir, lds); else scanA_item<1>(c, l, b, h, cc, dir, lds); } }
}
PHASE_FN f_upproj(int w0, int l) {
    const Ctx c = fresh_ctx(w0); char* lds = g_lds;
    EpiBf16 eq{C_QM, 384, 0.10206207261596575f * 1.4426950408889634f}, ekv{C_KVM, 512, 1.f};
    for (int it = blockIdx.x; it < 132 * 7 + 384; it += gridDim.x) {
        if (it < 132 * 7) { const int tm = it / 7, tn = it % 7;
            if (tn < 3) gemm_tile(c, C_P + MLA_CQ, INC, C_WUQ + (size_t)l * 384 * 192, 192, 192, tm * 256, tn * 128, lds, eq);
            else gemm_tile(c, C_P + MLA_CKV, INC, C_WUKV + (size_t)l * 512 * 128, 128, 128, tm * 256, (tn - 3) * 128, lds, ekv); }
        else scanB_item(c, it - 132 * 7); }
}
PHASE_FN f_scanc(int w0, int l) {
    const Ctx c = fresh_ctx(w0); char* lds = g_lds; const bool need_ctx = (l < DEPTH - 1);
    ph_rope_q(c);
    scan_tables(c, l, lds);
    { const int G = (int)gridDim.x, N = 16 * NCHUNK, R = (N + G - 1) / G;
      for (int q = 0; q < 2 * R; ++q) { const int mx = q & 1; int u = (q >> 1) * G + (int)blockIdx.x; if (u >= N) continue;
        const int cc = u % NCHUNK; u /= NCHUNK; const int h = u & 3, b = u >> 2;
        if (cc < 4 && !need_ctx) continue;
        if (mx == 0) scanC_item<0>(c, l, b, h, cc, lds); else scanC_item<1>(c, l, b, h, cc, lds); } }
}
PHASE_FN f_attn(int w0, int l) { const Ctx c = fresh_ctx(w0); ph_attn(c, l, g_lds); }
PHASE_FN f_gemm_out(int w0, int l) {
    const Ctx c = fresh_ctx(w0); const bool need_ctx = (l < DEPTH - 1);
    { pg8::Gemm g{C_HB, C_WOUT + (size_t)l * D * D, NR, D, D};
      pg8::TileOrder S; S.init(need_ctx ? 132 : 128, 4, (int)gridDim.x, (int)blockIdx.x, !need_ctx);
      pg8::EpiResidX E{C_XC, COUT, C_MODT + (size_t)l * 5 * 6144 + 2 * D};
      pg8::gemm_phase<pg8::EpiResidX, pg8::TileOrder>((PG8_LAS unsigned char*)g_lds, g, S, E, nullptr, w0); }
    cvt_tables(c, l);
}
PHASE_FN f_peer_q(int w0, int l) {
    const Ctx c = fresh_ctx(w0); const bool need_ctx = (l < DEPTH - 1);
    pg8::Gemm g{C_HB, C_WQ + (size_t)l * 2048 * D, NR, 2048, D};
    pg8::TileOrder S; S.init(need_ctx ? 132 : 128, 8, (int)gridDim.x, (int)blockIdx.x, !need_ctx);
    pg8::EpiStoreBf16 E{C_Q2, 2048, 2048, 0, 0, 1.f};
    pg8::gemm_phase<pg8::EpiStoreBf16, pg8::TileOrder>((PG8_LAS unsigned char*)g_lds, g, S, E, nullptr, w0);
}
PHASE_FN f_topk(int w0, int l) {
    const Ctx c = fresh_ctx(w0); char* lds = g_lds; const bool need_ctx = (l < DEPTH - 1);
    for (int it = blockIdx.x; it < 264 * 8; it += gridDim.x) { const int tm = it >> 3, h = it & 7;
        if ((tm % 66) < 2 && !need_ctx) continue;
        peer_topk_item(c, l, tm, h, lds); }
}
PHASE_FN f_expert_u(int w0, int l) { const Ctx c = fresh_ctx(w0); ph_peer_expert<0>(c, l, g_lds); }
PHASE_FN f_expert_c(int w0, int l) { const Ctx c = fresh_ctx(w0); ph_peer_combine(c, l); }
PHASE_FN f_expert_v(int w0, int l) { const Ctx c = fresh_ctx(w0); ph_peer_expert<1>(c, l, g_lds); }
PHASE_FN f_final(int w0) { const Ctx c = fresh_ctx(w0); ph_final(c); }

__global__ void __launch_bounds__(512, 2) mk_fwd(Params p) {
    volatile LAS unsigned* bst = (volatile LAS unsigned*)(g_lds + LDS_BYTES - 16);
    const bool t0 = threadIdx.x == 0; const int w0 = __builtin_amdgcn_readfirstlane((int)threadIdx.x >> 6);
    if (t0) { bst[0] = 0u; bst[1] = 0u; bst[2] = 0u; bst[3] = 0u; }
    __syncthreads();
    XcdBarrier bar; bar.bar = (unsigned*)(p.ws + WS_CTL); bar.x = 0; bar.st = bst; bar.t0 = t0;
    const int lo = p.ph_lo, hi = p.ph_hi;
    const bool multi = (hi - lo) > 1;
    if (multi) bar = xcd_barrier_post((unsigned*)(p.ws + WS_CTL), bst, t0);
#ifndef PHMASK
#define PHMASK 0xFFFF
#endif
#define EN(s) ((PHMASK >> (s)) & 1)
#define IN(k) (lo <= (k) && (k) < hi)
#define SEAM(k) do { if (IN(k) && IN((k) + 1)) xcd_barrier(bar); } while (0)
    if (EN(0) && IN(0)) f_p0(w0);
    SEAM(0);
#define LAYER(l) do { constexpr int base = 1 + PPL * (l); \
        if (EN(1) && IN(base + 0)) f_norm0(w0, l); SEAM(base + 0); \
        if (EN(2) && IN(base + 1)) f_gemm_in(w0, l); SEAM(base + 1); \
        if (EN(3) && IN(base + 2)) f_prep(w0, l); SEAM(base + 2); \
        if (EN(4) && IN(base + 3)) f_upproj(w0, l); SEAM(base + 3); \
        if (EN(5) && IN(base + 4)) f_scanc(w0, l); SEAM(base + 4); \
        if (EN(6) && IN(base + 5)) f_attn(w0, l); SEAM(base + 5); \
        if (EN(7) && IN(base + 6)) f_gemm_out(w0, l); SEAM(base + 6); \
        if (EN(8) && IN(base + 7)) f_norm1(w0, l); SEAM(base + 7); \
        if (EN(9) && IN(base + 8)) f_peer_q(w0, l); SEAM(base + 8); \
        if (EN(10) && IN(base + 9)) f_topk(w0, l); SEAM(base + 9); \
        if (EN(11) && IN(base + 10)) f_expert_u(w0, l); SEAM(base + 10); \
        if (EN(12) && IN(base + 11)) f_expert_c(w0, l); SEAM(base + 11); \
        if (EN(13) && IN(base + 12)) f_expert_v(w0, l); SEAM(base + 12); } while (0)
    LAYER(0);
    LAYER(1);
#undef LAYER
    if (EN(14) && IN(N_PHASES - 1)) f_final(w0);
#undef IN
#undef SEAM
}

extern "C" void kernel_launch(void* const* d_in, const int* in_sizes, int n_in, void* d_out, int out_size, void* d_ws, size_t ws_size, hipStream_t stream) {
    static int grid = 0;
    if (grid == 0) {
        if (n_in != 26 || in_sizes[0] != NB * SEQ * D || out_size != NB * SEQ * D || ws_size < WS_END) {
            fprintf(stderr, "kernel_launch: shape/workspace mismatch: n_in %d in0 %d out %d ws %zu (need %zu); nothing launched\n", n_in, n_in > 0 ? in_sizes[0] : -1, out_size, ws_size, (size_t)WS_END);
            grid = -1; return; }
        int dev = 0, cus = 0, per_cu = 0;
        if (hipGetDevice(&dev) != hipSuccess || hipDeviceGetAttribute(&cus, hipDeviceAttributeMultiprocessorCount, dev) != hipSuccess) { grid = -1; return; }
        if (hipFuncSetAttribute((const void*)mk_fwd, hipFuncAttributeMaxDynamicSharedMemorySize, LDS_BYTES) != hipSuccess) { fprintf(stderr, "kernel_launch: hipFuncSetAttribute failed\n"); grid = -1; return; }
        if (hipOccupancyMaxActiveBlocksPerMultiprocessor(&per_cu, (const void*)mk_fwd, 512, LDS_BYTES) != hipSuccess || per_cu < 1)
            fprintf(stderr, "kernel_launch: note: occupancy query reports %d workgroups per CU\n", per_cu);
        (void)hipGetLastError();
        grid = cus;
    }
    if (grid < 0) return;
    if (hipMemsetAsync((char*)d_ws + WS_CTL, 0, CTL_BYTES, stream) != hipSuccess) { fprintf(stderr, "kernel_launch: memset failed\n"); return; }
    Params p{};
    for (int i = 0; i < 26; ++i) p.in[i] = (const float*)d_in[i];
    p.out = (float*)d_out; p.ws = (unsigned char*)d_ws;
#if MK_PER_PHASE
    for (int k = 0; k < N_PHASES; ++k) { p.ph_lo = k; p.ph_hi = k + 1; hipLaunchKernelGGL(mk_fwd, dim3(grid), dim3(512), LDS_BYTES, stream, p); }
#else
    p.ph_lo = 0; p.ph_hi = N_PHASES; hipLaunchKernelGGL(mk_fwd, dim3(grid), dim3(512), LDS_BYTES, stream, p);
#endif
    const hipError_t le = hipPeekAtLastError();
    if (le != hipSuccess) fprintf(stderr, "kernel_launch: launch failed: %s\n", hipGetErrorName(le));
}
```

```cpp
#include <hip/hip_runtime.h>
#include <cstdio>
#include <cstdint>

#ifndef MK_PER_PHASE
#define MK_PER_PHASE 0
#endif

constexpr int D = 1024, NB = 4, SEQ = 8192, CTX = 256, DEPTH = 2;
constexpr int RPB = CTX + SEQ;
constexpr int NR = NB * RPB;
constexpr int INC = 3200;
constexpr int GLA_Q = 0, GLA_K = 128, GLA_V = 256, GLA_R = 512, GLA_ZF = 768, GLA_ZB = 784;
constexpr int HG_Q = 800, HG_I = 1056, HG_OG = 1312, HG_ZF = 1568, HG_ZB = 1824;
constexpr int MLA_CQ = 2080, MLA_CKV = 2272, MLA_KR = 2400;
constexpr int DF_Q = 2432, DF_K = 2688, DF_V = 2944;
constexpr int NCHUNK = RPB / 64;
constexpr int NEXP = 16384;
constexpr float NORM_EPS = 1e-6f;

typedef unsigned short bf16_t;
typedef short bf16x8 __attribute__((ext_vector_type(8)));
typedef short s16x4 __attribute__((ext_vector_type(4)));
typedef float f32x16 __attribute__((ext_vector_type(16)));
typedef float f32x4 __attribute__((ext_vector_type(4)));
typedef unsigned u32x4 __attribute__((ext_vector_type(4)));
typedef unsigned u32x2 __attribute__((ext_vector_type(2)));

constexpr size_t al256(size_t x) { return (x + 255) / 256 * 256; }
constexpr size_t WS_CTL = 0;
constexpr size_t CTL_BYTES = 65536;
constexpr size_t WS_MOD = WS_CTL + CTL_BYTES;
constexpr size_t WS_XC = al256(WS_MOD + (size_t)2 * 5 * 6144 * 4);
constexpr size_t WS_WIN = al256(WS_XC + (size_t)NB * CTX * D * 4);
constexpr size_t WS_WOUT = al256(WS_WIN + (size_t)2 * INC * D * 2);
constexpr size_t WS_WQ = al256(WS_WOUT + (size_t)2 * D * D * 2);
constexpr size_t WS_WUQ = al256(WS_WQ + (size_t)2 * 2048 * D * 2);
constexpr size_t WS_WUKV = al256(WS_WUQ + (size_t)2 * 384 * 192 * 2);
constexpr size_t WS_KEYS = al256(WS_WUKV + (size_t)2 * 512 * 128 * 2);
constexpr size_t WS_HB = al256(WS_KEYS + (size_t)2 * 16 * 128 * 128 * 2);
constexpr size_t WS_QM = al256(WS_HB + (size_t)NR * D * 2);
constexpr size_t WS_KVM = al256(WS_QM + (size_t)NR * 384 * 2);
constexpr size_t WS_SG = al256(WS_KVM + (size_t)NR * 512 * 2);
constexpr size_t WS_SH = al256(WS_SG + (size_t)32 * NCHUNK * 2048 * 2);
constexpr size_t WS_DG = al256(WS_SH + (size_t)32 * NCHUNK * 4096 * 2);
constexpr size_t WS_DH = al256(WS_DG + (size_t)32 * NCHUNK * 32 * 4);
constexpr size_t WS_P = al256(WS_DH + (size_t)32 * NCHUNK * 64 * 4);
constexpr size_t WS_END = al256(WS_P + (size_t)NR * INC * 2);
constexpr size_t WS_TU8 = WS_P;
constexpr size_t WS_TV8 = WS_P + (size_t)NEXP * D;
constexpr size_t WS_SU = WS_TV8 + (size_t)NEXP * D;
constexpr size_t WS_SV = WS_SU + (size_t)NEXP * 4;
constexpr size_t WS_Q2 = WS_P + (size_t)64 * 1024 * 1024;
constexpr size_t WS_PART = WS_Q2;
static_assert(WS_SV + (size_t)NEXP * 4 <= WS_Q2, "alias overflow 0");
static_assert(WS_Q2 + (size_t)NR * 2048 * 2 <= WS_END, "alias overflow");
constexpr size_t WS_EI = WS_SG;
constexpr size_t WS_EG = WS_EI + (size_t)NR * 128 * 4;
static_assert(WS_EG + (size_t)NR * 128 * 4 <= WS_DG, "alias overflow 2");

#define XB_TMO      128
#define XB_XCNT(j)  (256  + 64 * (j))
#define XB_XSUB(j)  (1280 + 64 * (j))
#define XB_XGEN(j)  (2304 + 64 * (j))
#define XB_TOP      3328
#define XB_TOPGEN   3392
#define XCD_BAR_WORDS 3456
#define XB_SPIN_CAP (1u << 22)
#define LAS __attribute__((address_space(3)))

__device__ __forceinline__ unsigned xb_ld(unsigned* p)              { return __hip_atomic_load(p, __ATOMIC_RELAXED, __HIP_MEMORY_SCOPE_AGENT); }
__device__ __forceinline__ unsigned xb_add(unsigned* p, unsigned v) { return __hip_atomic_fetch_add(p, v, __ATOMIC_RELAXED, __HIP_MEMORY_SCOPE_AGENT); }
__device__ __forceinline__ unsigned xb_xcc_id() { return (unsigned)__builtin_amdgcn_s_getreg((3 << 11) | 20) & 0xFu; }
#define XB_SPIN(cond, bar) do { unsigned _sp = 0; while (cond) { __builtin_amdgcn_s_sleep(1); \
    if ((++_sp & 255u) == 0u) { if (xb_ld(&(bar)[XB_TMO])) break; if (_sp > XB_SPIN_CAP) { atomicAdd(&(bar)[XB_TMO], 1u); break; } } } } while (0)

struct XcdBarrier { unsigned* bar; unsigned x; volatile LAS unsigned* st; bool t0; };

__device__ __forceinline__ XcdBarrier xcd_barrier_post(unsigned* bar, volatile LAS unsigned* st, bool t0) {
    XcdBarrier b; b.bar = bar; b.x = xb_xcc_id(); b.st = st; b.t0 = t0;
    if (t0) (void)xb_add(&bar[XB_XCNT(b.x)], 1u);
    return b;
}
__device__ __forceinline__ void xcd_barrier_complete(unsigned* bar, unsigned x, unsigned& nloc, unsigned& nx) {
    const unsigned G = gridDim.x * gridDim.y * gridDim.z;
    unsigned sum, cnt, mine, sp = 0u;
    for (;;) {
        sum = 0u; cnt = 0u; mine = 0u;
#pragma unroll
        for (unsigned j = 0; j < 16; ++j) { const unsigned c = xb_ld(&bar[XB_XCNT(j)]); sum += c; cnt += (c > 0u) ? 1u : 0u; mine = (j == x) ? c : mine; }
        if (sum == G) break;
        __builtin_amdgcn_s_sleep(1);
        if ((++sp & 255u) == 0u) { if (xb_ld(&bar[XB_TMO])) break; if (sp > XB_SPIN_CAP) { atomicAdd(&bar[XB_TMO], 1u); break; } }
    }
    nloc = mine > 0u ? mine : 1u; nx = cnt > 0u ? cnt : 1u;
}
__device__ __forceinline__ void xcd_barrier(const XcdBarrier& b) {
    asm volatile("s_waitcnt vmcnt(0)" ::: "memory");
    __syncthreads();
    if (b.t0) {
        unsigned* bar = b.bar;
        __builtin_amdgcn_s_waitcnt(0);
        unsigned nloc = b.st[0], nx = b.st[1];
        if (nloc == 0u) { xcd_barrier_complete(bar, b.x, nloc, nx); b.st[0] = nloc; b.st[1] = nx; }
        const unsigned old = xb_add(&bar[XB_XSUB(b.x)], 1u);
        const unsigned gen = old / nloc;
        if (old + 1u == (gen + 1u) * nloc) {
            __builtin_amdgcn_fence(__ATOMIC_RELEASE, "agent");
            asm volatile("s_waitcnt vmcnt(0)" ::: "memory");
            const unsigned og = xb_add(&bar[XB_TOP], 1u);
            const unsigned tg = og / nx;
            if (og + 1u == (tg + 1u) * nx) xb_add(&bar[XB_TOPGEN], 1u);
            else XB_SPIN(xb_ld(&bar[XB_TOPGEN]) == tg, bar);
            __builtin_amdgcn_fence(__ATOMIC_ACQUIRE, "agent");
            xb_add(&bar[XB_XGEN(b.x)], 1u);
            asm volatile("s_waitcnt vmcnt(0)" ::: "memory");
        } else {
            XB_SPIN(xb_ld(&bar[XB_XGEN(b.x)]) == gen, bar);
            __builtin_amdgcn_fence(__ATOMIC_ACQUIRE, "agent");
            asm volatile("s_waitcnt vmcnt(0)" ::: "memory");
        }
    }
    __syncthreads();
}

typedef __bf16 bf16v2_t __attribute__((ext_vector_type(2)));
typedef float f32v2_t __attribute__((ext_vector_type(2)));
__device__ __forceinline__ unsigned cvtpk(float lo, float hi) { const f32v2_t v = {lo, hi}; const bf16v2_t b = __builtin_convertvector(v, bf16v2_t); return __builtin_bit_cast(unsigned, b); }
__device__ __forceinline__ bf16_t f2bf(float x) { const __bf16 b = (__bf16)x; return __builtin_bit_cast(bf16_t, b); }
__device__ __forceinline__ float bf2f(bf16_t h) { return __uint_as_float(((unsigned)h) << 16); }
__device__ __forceinline__ float bflo(unsigned w) { return __uint_as_float(w << 16); }
__device__ __forceinline__ float bfhi(unsigned w) { return __uint_as_float(w & 0xffff0000u); }
__device__ __forceinline__ float silu_f(float x) { return x / (1.f + __expf(-x)); }
__device__ __forceinline__ float logsigmoid_f(float z) { return fminf(z, 0.f) - __logf(1.f + __expf(-fabsf(z))); }
__device__ __forceinline__ float wave_sum(float v) {
#pragma unroll
    for (int o = 32; o >= 1; o >>= 1) v += __shfl_xor(v, o, 64);
    return v;
}
__device__ __forceinline__ void zero_acc(f32x16& a) {
#pragma unroll
    for (int r = 0; r < 16; ++r) a[r] = 0.f;
    asm volatile("" : "+v"(a));
}
__device__ __forceinline__ int crow(int r, int hi) { return (r & 3) + 8 * (r >> 2) + 4 * hi; }

struct Params { const float* in[26]; float* out; unsigned char* ws; int ph_lo, ph_hi; };
typedef const __attribute__((address_space(4))) Params* KParams;
struct Ctx {
    KParams pp;
    int tid, lane, wid;
};
__device__ __forceinline__ int mk_tid(int w0) { unsigned m = ~0u; asm volatile("" : "+s"(m)); return (w0 << 6) | (int)__builtin_amdgcn_mbcnt_hi(m, __builtin_amdgcn_mbcnt_lo(m, 0u)); }
__device__ __forceinline__ float shx(float v, int o, int lane) { return __int_as_float(__builtin_amdgcn_ds_bpermute((lane ^ o) << 2, __float_as_int(v))); }
__device__ __forceinline__ Ctx fresh_ctx(int w0) {
    Ctx c; unsigned long long a = (unsigned long long)__builtin_amdgcn_kernarg_segment_ptr(); asm volatile("" : "+s"(a)); c.pp = (KParams)a;
    int t = mk_tid(w0); asm volatile("" : "+v"(t)); c.tid = t; c.lane = t & 63; c.wid = w0;
    return c;
}
#define CIN(i)   (c.pp->in[i])
#define COUT     (c.pp->out)
#define CWS(off) (c.pp->ws + (off))
#define C_MODT ((float*)CWS(WS_MOD))
#define C_XC   ((float*)CWS(WS_XC))
#define C_WIN  ((bf16_t*)CWS(WS_WIN))
#define C_WOUT ((bf16_t*)CWS(WS_WOUT))
#define C_WQ   ((bf16_t*)CWS(WS_WQ))
#define C_WUQ  ((bf16_t*)CWS(WS_WUQ))
#define C_WUKV ((bf16_t*)CWS(WS_WUKV))
#define C_KEYS ((bf16_t*)CWS(WS_KEYS))
#define C_HB   ((bf16_t*)CWS(WS_HB))
#define C_QM   ((bf16_t*)CWS(WS_QM))
#define C_KVM  ((bf16_t*)CWS(WS_KVM))
#define C_P    ((bf16_t*)CWS(WS_P))
#define C_TU8  ((unsigned char*)CWS(WS_TU8))
#define C_TV8  ((unsigned char*)CWS(WS_TV8))
#define C_SU   ((float*)CWS(WS_SU))
#define C_SV   ((float*)CWS(WS_SV))
#define C_PART ((float*)CWS(WS_PART))
#define C_Q2   ((bf16_t*)CWS(WS_Q2))
#define C_SG   ((bf16_t*)CWS(WS_SG))
#define C_SH   ((bf16_t*)CWS(WS_SH))
#define C_DG   ((float*)CWS(WS_DG))
#define C_DH   ((float*)CWS(WS_DH))
#define C_EI   ((int*)CWS(WS_EI))
#define C_EG   ((float*)CWS(WS_EG))

__device__ __forceinline__ float* xrow(const Ctx& c, int r) {
    const int b = r / RPB, j = r - b * RPB;
    return j < CTX ? C_XC + ((size_t)(b * CTX + j) << 10) : COUT + ((size_t)(b * SEQ + (j - CTX)) << 10);
}
__device__ __forceinline__ const float* inrow(const Ctx& c, int r) {
    const int b = r / RPB, j = r - b * RPB;
    return j < CTX ? CIN(2) + ((size_t)(b * CTX + j) << 10) : CIN(0) + ((size_t)(b * SEQ + (j - CTX)) << 10);
}

__device__ void p0_mod_item(const Ctx& c, int item, char* lds) {
    float* sc = (float*)lds;
    float* red = sc + 5 * 1024;
    const int tid = c.tid;
    for (int i = tid; i < 5 * 1024; i += 512) { const int v = i >> 10, k = i & 1023; const float x = (v < 4) ? CIN(1)[v * 1024 + k] : CIN(3)[k]; sc[i] = silu_f(x); }
    __syncthreads();
    const int l = item / 96, n0 = (item % 96) * 64;
    const int col = tid & 63, kg = tid >> 6;
    const float* w = CIN(4) + (size_t)l * 1024 * 6144 + n0 + col;
    float a[5] = {0.f, 0.f, 0.f, 0.f, 0.f};
#pragma unroll 8
    for (int kk = 0; kk < 128; ++kk) { const int k = kg * 128 + kk; const float wv = w[(size_t)k * 6144];
#pragma unroll
        for (int v = 0; v < 5; ++v) a[v] += sc[v * 1024 + k] * wv; }
#pragma unroll
    for (int v = 0; v < 5; ++v) red[(kg * 64 + col) * 5 + v] = a[v];
    __syncthreads();
    if (tid < 320) { const int cc = tid / 5, v = tid % 5; float s = 0.f;
#pragma unroll
        for (int g = 0; g < 8; ++g) s += red[(g * 64 + cc) * 5 + v];
        C_MODT[((size_t)l * 5 + v) * 6144 + n0 + cc] = s + CIN(5)[l * 6144 + n0 + cc]; }
    __syncthreads();
}
__device__ void p0_tr_tile(const float* __restrict__ src, bf16_t* __restrict__ dst, int K, int N, int k0, int n0, int tid, char* lds) {
    float* t = (float*)lds;
#pragma unroll
    for (int i = 0; i < 2; ++i) { const int k = (tid >> 4) + 32 * i, n4 = (tid & 15) * 4;
        const f32x4 v = *(const f32x4*)(src + (size_t)(k0 + k) * N + n0 + n4);
        t[k * 65 + n4 + 0] = v[0]; t[k * 65 + n4 + 1] = v[1]; t[k * 65 + n4 + 2] = v[2]; t[k * 65 + n4 + 3] = v[3]; }
    __syncthreads();
    { const int n = tid >> 3, k8 = (tid & 7) * 8; u32x4 w;
#pragma unroll
        for (int j = 0; j < 4; ++j) w[j] = cvtpk(t[(k8 + 2 * j) * 65 + n], t[(k8 + 2 * j + 1) * 65 + n]);
        *(u32x4*)(dst + (size_t)(n0 + n) * K + k0 + k8) = w; }
    __syncthreads();
}
__device__ void ph_p0(const Ctx& c, char* lds) {
    constexpr int T_WIN = 16 * 50, T_WOUT = 16 * 16, T_WQ = 16 * 32, T_UQ = 3 * 6, T_UKV = 2 * 8;
    constexpr int PER_L = T_WIN + T_WOUT + T_WQ + T_UQ + T_UKV;
    constexpr int NITEM = 192 + 2 * PER_L;
    for (int it = blockIdx.x; it < NITEM; it += gridDim.x) {
        if (it < 192) { p0_mod_item(c, it, lds); continue; }
        int t = it - 192; const int l = t / PER_L; t -= l * PER_L;
        if (t < T_WIN) { p0_tr_tile(CIN(8) + (size_t)l * D * INC, C_WIN + (size_t)l * INC * D, D, INC, (t / 50) * 64, (t % 50) * 64, c.tid, lds); continue; } t -= T_WIN;
        if (t < T_WOUT) { p0_tr_tile(CIN(9) + (size_t)l * D * D, C_WOUT + (size_t)l * D * D, D, D, (t / 16) * 64, (t % 16) * 64, c.tid, lds); continue; } t -= T_WOUT;
        if (t < T_WQ) { p0_tr_tile(CIN(21) + (size_t)l * D * 2048, C_WQ + (size_t)l * 2048 * D, D, 2048, (t / 32) * 64, (t % 32) * 64, c.tid, lds); continue; } t -= T_WQ;
        if (t < T_UQ) { p0_tr_tile(CIN(17) + (size_t)l * 192 * 384, C_WUQ + (size_t)l * 384 * 192, 192, 384, (t / 6) * 64, (t % 6) * 64, c.tid, lds); continue; } t -= T_UQ;
        p0_tr_tile(CIN(18) + (size_t)l * 128 * 512, C_WUKV + (size_t)l * 512 * 128, 128, 512, (t / 8) * 64, (t % 8) * 64, c.tid, lds);
    }
    const size_t nk8 = (size_t)2 * 16 * 128 * 128 / 8;
    for (size_t i = (size_t)blockIdx.x * 512 + c.tid; i < nk8; i += (size_t)gridDim.x * 512) {
        const f32x4 a = *(const f32x4*)(CIN(22) + i * 8), b = *(const f32x4*)(CIN(22) + i * 8 + 4);
        u32x4 w = {cvtpk(a[0], a[1]), cvtpk(a[2], a[3]), cvtpk(b[0], b[1]), cvtpk(b[2], b[3])};
        *(u32x4*)(C_KEYS + i * 8) = w;
    }
}

template <int WHICH>
__device__ void ph_norm(const Ctx& c, int l) {
    const float* g = CIN(WHICH == 0 ? 6 : 7) + l * D;
    const bool need_ctx = (l < DEPTH - 1);
    const int stride = gridDim.x * 8;
    auto next_row = [&](int r) { for (; r < NR; r += stride) { const int j = r % RPB; if (!(WHICH == 1 && j < CTX && !need_ctx)) break; } return r; };
    auto row_src = [&](int r) { return (WHICH == 0 && l == 0) ? inrow(c, r) : (const float*)xrow(c, r); };
    int r = next_row(blockIdx.x * 8 + c.wid);
    f32x4 xn[4];
    if (r < NR) { const float* src = row_src(r);
#pragma unroll
        for (int i = 0; i < 4; ++i) xn[i] = *(const f32x4*)(src + i * 256 + c.lane * 4); }
    while (r < NR) {
        f32x4 x[4];
#pragma unroll
        for (int i = 0; i < 4; ++i) x[i] = xn[i];
        const int rn = next_row(r + stride);
        if (rn < NR) { const float* src = row_src(rn);
#pragma unroll
            for (int i = 0; i < 4; ++i) xn[i] = *(const f32x4*)(src + i * 256 + c.lane * 4); }
        const int b = r / RPB, j = r - b * RPB; const bool isctx = j < CTX;
        float ss = 0.f;
#pragma unroll
        for (int i = 0; i < 4; ++i) ss += x[i][0] * x[i][0] + x[i][1] * x[i][1] + x[i][2] * x[i][2] + x[i][3] * x[i][3];
        ss = wave_sum(ss);
        const float rstd = rsqrtf(ss * (1.f / D) + NORM_EPS);
        const float* mt = C_MODT + ((size_t)l * 5 + (isctx ? 4 : b)) * 6144;
        const float* sh = mt + (WHICH == 0 ? 0 : 3) * D; const float* scl = mt + (WHICH == 0 ? 1 : 4) * D;
        bf16_t* dst = C_HB + (size_t)r * D;
        float* xr = xrow(c, r);
#pragma unroll
        for (int i = 0; i < 4; ++i) { const int col = i * 256 + c.lane * 4;
            const f32x4 gv = *(const f32x4*)(g + col), sv = *(const f32x4*)(sh + col), cv = *(const f32x4*)(scl + col);
            float y[4];
#pragma unroll
            for (int e = 0; e < 4; ++e) y[e] = x[i][e] * rstd * gv[e] * (1.f + cv[e]) + sv[e];
            u32x2 w = {cvtpk(y[0], y[1]), cvtpk(y[2], y[3])};
            *(u32x2*)(dst + col) = w;
            if (WHICH == 0 && l == 0) *(f32x4*)(xr + col) = x[i]; }
        r = rn;
    }
}

constexpr int GEMM_LDS = 98304;
template <class Epi>
__device__ __forceinline__ void gemm_tile(const Ctx& c, const bf16_t* __restrict__ A, int lda, const bf16_t* __restrict__ Bt, int ldb, int K, int m0, int n0, char* lds, const Epi& epi) {
    const int tid = c.tid, lane = tid & 63, wid = tid >> 6, r32 = lane & 31, hi = lane >> 5, wm = wid >> 1, wn = wid & 1;
    char* As = lds; char* Bs = lds + 65536;
    f32x16 acc[2][2];
#pragma unroll
    for (int m = 0; m < 2; ++m)
#pragma unroll
        for (int n = 0; n < 2; ++n) zero_acc(acc[m][n]);
    u32x4 ra[4], rb[2];
    const int srow = tid >> 3, sch = tid & 7;
    const bf16_t* Ag = A + (size_t)(m0 + srow) * lda + sch * 8;
    const bf16_t* Bg = Bt + (size_t)(n0 + srow) * ldb + sch * 8;
    const int swoff = srow * 128 + ((sch ^ ((srow >> 1) & 7)) << 4);
#define GLOAD(k0) do { _Pragma("unroll") for (int i = 0; i < 4; ++i) ra[i] = *(const u32x4*)(Ag + (size_t)(64 * i) * lda + (k0)); \
                       _Pragma("unroll") for (int i = 0; i < 2; ++i) rb[i] = *(const u32x4*)(Bg + (size_t)(64 * i) * ldb + (k0)); } while (0)
#define SWRITE(buf) do { _Pragma("unroll") for (int i = 0; i < 4; ++i) *(u32x4*)(As + (buf) * 32768 + swoff + i * 8192) = ra[i]; \
                         _Pragma("unroll") for (int i = 0; i < 2; ++i) *(u32x4*)(Bs + (buf) * 16384 + swoff + i * 8192) = rb[i]; } while (0)
    const int nk = K >> 6;
    GLOAD(0); SWRITE(0); __syncthreads();
    for (int kt = 0; kt < nk; ++kt) {
        const int buf = kt & 1;
        if (kt + 1 < nk) GLOAD((kt + 1) * 64);
        const char* Ab = As + buf * 32768; const char* Bb = Bs + buf * 16384;
#pragma unroll
        for (int ks = 0; ks < 4; ++ks) {
            bf16x8 a[2], b[2];
#pragma unroll
            for (int m = 0; m < 2; ++m) { const int row = wm * 64 + m * 32 + r32; a[m] = *(const bf16x8*)(Ab + row * 128 + (((ks * 2 + hi) ^ ((row >> 1) & 7)) << 4)); }
#pragma unroll
            for (int n = 0; n < 2; ++n) { const int row = wn * 64 + n * 32 + r32; b[n] = *(const bf16x8*)(Bb + row * 128 + (((ks * 2 + hi) ^ ((row >> 1) & 7)) << 4)); }
#pragma unroll
            for (int m = 0; m < 2; ++m)
#pragma unroll
                for (int n = 0; n < 2; ++n) acc[m][n] = __builtin_amdgcn_mfma_f32_32x32x16_bf16(a[m], b[n], acc[m][n], 0, 0, 0);
        }
        if (kt + 1 < nk) SWRITE(buf ^ 1);
        __syncthreads();
    }
#undef GLOAD
#undef SWRITE
    epi(acc, m0 + wm * 64, n0 + wn * 64, r32, hi);
}
struct EpiBf16 {
    bf16_t* C; int ldc; float scale;
    __device__ __forceinline__ void operator()(const f32x16 (&acc)[2][2], int row0, int col0, int r32, int hi) const {
        bf16_t* base = C + (size_t)(row0 + 4 * hi) * ldc + col0 + r32;
#pragma unroll
        for (int m = 0; m < 2; ++m)
#pragma unroll
            for (int r = 0; r < 16; ++r) { bf16_t* p = base + (size_t)(m * 32 + (r & 3) + 8 * (r >> 2)) * ldc;
                p[0] = f2bf(acc[m][0][r] * scale); p[32] = f2bf(acc[m][1][r] * scale);
                asm volatile("" ::: "memory"); }
    }
};

template <int MX> struct ScanCfg;
template <> struct ScanCfg<0> { static constexpr int DK = 32; };
template <> struct ScanCfg<1> { static constexpr int DK = 64; };

constexpr int BP = 72;
typedef float f32x4v __attribute__((ext_vector_type(4)));
__device__ __forceinline__ bf16x8 frag16(const bf16_t* tile, int row0, int k0, int lane) { return *(const bf16x8*)(tile + (row0 + (lane & 15)) * BP + k0 + 8 * (lane >> 4)); }

constexpr int SCAN_TAB_OFF = 128000;
__device__ __forceinline__ void scan_tables(const Ctx& c, int l, char* lds) {
    float* wtab = (float*)(lds + SCAN_TAB_OFF); float* btab = wtab + 2 * 16 * 128; float* lbtab = btab + 2 * 128;
    for (int i = c.tid; i < 2 * 16 * 128; i += 512) wtab[i] = CIN(10)[(size_t)l * 2 * 16 * 128 + i];
    if (c.tid < 256) { btab[c.tid] = CIN(11)[(size_t)l * 256 + c.tid];
        float lb = 0.f; if (l > 0) { const float r0 = CIN(13)[c.tid], r1 = CIN(13)[256 + c.tid]; lb = 1.f / (1.f + __expf(r0 - r1)); }
        lbtab[c.tid] = lb; }
    __syncthreads();
}
template <int MX, bool WANT_Q>
__device__ __forceinline__ void scan_load(const Ctx& c, int l, int b, int h, int cc, int dir, float* qt, float* kt, float* gt, bf16_t* VT, float* tmp, const char* ldsb) {
    constexpr int DK = ScanCfg<MX>::DK, PK = DK + 1;
    const int tid = c.tid;
    const int t = tid >> 3, j0 = (tid & 7) * 8;
    const bf16_t* pr = C_P + (size_t)(b * RPB + cc * 64 + (dir ? 63 - t : t)) * INC;
    const u32x4 vv = *(const u32x4*)(pr + (MX == 0 ? GLA_V : HG_I) + h * 64 + j0);
    if (MX == 0) {
        float* zt = tmp; const float* wt = (const float*)(ldsb + SCAN_TAB_OFF) + dir * 16 * 128 + h * 32; const float* bt = (const float*)(ldsb + SCAN_TAB_OFF) + 2 * 16 * 128 + dir * 128 + h * 32;
        const int j4 = (tid & 7) * 4;
        const u32x2 kv = *(const u32x2*)(pr + GLA_K + h * 32 + j4);
        u32x2 qv = {0u, 0u}; if (WANT_Q) qv = *(const u32x2*)(pr + GLA_Q + h * 32 + j4);
        u32x4 zv = {0u, 0u, 0u, 0u};
        if (tid < 128) zv = *(const u32x4*)(C_P + (size_t)(b * RPB + cc * 64 + (dir ? 63 - (tid >> 1) : (tid >> 1))) * INC + (dir ? GLA_ZB : GLA_ZF) + (tid & 1) * 8);
        if (tid < 128) { float* zp = zt + (tid >> 1) * 16 + (tid & 1) * 8;
#pragma unroll
            for (int q = 0; q < 4; ++q) { zp[2 * q] = bflo(zv[q]); zp[2 * q + 1] = bfhi(zv[q]); } }
        __syncthreads();
#pragma unroll
        for (int e = 0; e < 4; ++e) { const int j = j4 + e;
            float a = bt[j];
#pragma unroll
            for (int k = 0; k < 16; ++k) a += zt[t * 16 + k] * wt[k * 128 + j];
            gt[t * PK + j] = logsigmoid_f(a) * (1.f / 16.f);
            kt[t * PK + j] = (e & 1) ? bfhi(kv[e >> 1]) : bflo(kv[e >> 1]);
            if (WANT_Q) qt[t * PK + j] = ((e & 1) ? bfhi(qv[e >> 1]) : bflo(qv[e >> 1])) * 0.17677669529663687f; }
    } else {
        const u32x4 zv = *(const u32x4*)(pr + (dir ? HG_ZB : HG_ZF) + h * 64 + j0);
        u32x4 qv = {0u, 0u, 0u, 0u}; if (WANT_Q) qv = *(const u32x4*)(pr + HG_Q + h * 64 + j0);
        float lbv[8];
        { const float* lbt = (const float*)(ldsb + SCAN_TAB_OFF) + 2 * 16 * 128 + 2 * 128 + h * 64 + j0;
#pragma unroll
          for (int e = 0; e < 8; ++e) lbv[e] = lbt[e]; }
#pragma unroll
        for (int e = 0; e < 8; ++e) { const int j = j0 + e;
            const float z = fminf(fmaxf((e & 1) ? bfhi(zv[e >> 1]) : bflo(zv[e >> 1]), -80.f), 80.f); const float lb = lbv[e];
            const float ez = __expf(-z), sg = __builtin_amdgcn_rcpf(1.f + ez);
            gt[t * PK + j] = fmaxf(__logf(lb + (1.f - lb) * sg), -69.07755279f);
            kt[t * PK + j] = (1.f - lb) * ez * sg;
            if (WANT_Q) { const float qz = (e & 1) ? bfhi(qv[e >> 1]) : bflo(qv[e >> 1]); qt[t * PK + j] = qz * __builtin_amdgcn_rcpf(1.f + __expf(-qz)); } }
    }
#pragma unroll
    for (int e = 0; e < 8; ++e) VT[(j0 + e) * BP + t] = (bf16_t)((e & 1) ? (vv[e >> 1] >> 16) : (vv[e >> 1] & 0xffffu));
    __syncthreads();
    { float x[DK / 8];
#pragma unroll
        for (int u = 0; u < DK / 8; ++u) x[u] = gt[c.lane * PK + c.wid + 8 * u];
#pragma unroll
        for (int d = 1; d < 64; d <<= 1)
#pragma unroll
            for (int u = 0; u < DK / 8; ++u) { const float y = __shfl_up(x[u], d, 64); if (c.lane >= d) x[u] += y; }
#pragma unroll
        for (int u = 0; u < DK / 8; ++u) gt[c.lane * PK + c.wid + 8 * u] = x[u]; }
    __syncthreads();
}

template <int MX>
__device__ void scanA_item(const Ctx& c, int l, int b, int h, int cc, int dir, char* lds) {
    constexpr int DK = ScanCfg<MX>::DK, PK = DK + 1;
    float* kt = (float*)lds; float* gt = kt + 64 * PK; bf16_t* VT = (bf16_t*)(gt + 64 * PK); bf16_t* KET = VT + 64 * BP; float* tmp = (float*)(KET + 64 * BP);
    scan_load<MX, false>(c, l, b, h, cc, dir, nullptr, kt, gt, VT, tmp, lds);
    const int tid = c.tid, lane = c.lane;
    for (int i = tid; i < 64 * DK; i += 512) { const int s_ = i & 63, k = i >> 6; KET[k * BP + s_] = f2bf(kt[s_ * PK + k] * __expf(gt[63 * PK + k] - gt[s_ * PK + k])); }
    __syncthreads();
    const int ch = (b * 4 + h) * 2 + dir;
    bf16_t* S = (MX == 0 ? C_SG : C_SH) + ((size_t)ch * NCHUNK + cc) * (DK * 64);
    for (int tile = c.wid; tile < (DK / 16) * 4; tile += 8) { const int tk = tile >> 2, tj = tile & 3;
        f32x4v acc = {0.f, 0.f, 0.f, 0.f};
#pragma unroll
        for (int ks = 0; ks < 2; ++ks) acc = __builtin_amdgcn_mfma_f32_16x16x32_bf16(frag16(KET, tk * 16, ks * 32, lane), frag16(VT, tj * 16, ks * 32, lane), acc, 0, 0, 0);
#pragma unroll
        for (int i = 0; i < 4; ++i) S[(tk * 16 + 4 * (lane >> 4) + i) * 64 + tj * 16 + (lane & 15)] = f2bf(acc[i]); }
    if (tid < DK) (MX == 0 ? C_DG : C_DH)[((size_t)ch * NCHUNK + cc) * DK + tid] = __expf(gt[63 * PK + tid]);
    __syncthreads();
}
__device__ void scanB_item(const Ctx& c, int item) {
    const int e = item * 512 + c.tid;
    const bool hg = e >= 65536; const int ee = hg ? e - 65536 : e;
    const int DK = hg ? 64 : 32; const int per = DK * 64;
    const int ch = ee / per, ij = ee % per, i = ij >> 6; const int dir = ch & 1;
    bf16_t* S = (hg ? C_SH : C_SG) + (size_t)ch * NCHUNK * per + ij;
    const float* Dc = (hg ? C_DH : C_DG) + (size_t)ch * NCHUNK * DK + i;
    float st = 0.f;
    for (int n0 = 0; n0 < NCHUNK; n0 += 6) {
        float sv[6], dv[6];
#pragma unroll
        for (int u = 0; u < 6; ++u) { const int n = n0 + u; const int cc = dir ? (n < 4 ? 3 - n : 135 - n) : n; sv[u] = bf2f(S[(size_t)cc * per]); dv[u] = Dc[(size_t)cc * DK]; }
#pragma unroll
        for (int u = 0; u < 6; ++u) { const int n = n0 + u; const int cc = dir ? (n < 4 ? 3 - n : 135 - n) : n; S[(size_t)cc * per] = f2bf(st); st = dv[u] * st + sv[u]; }
    }
}
template <int MX>
__device__ void scanC_item(const Ctx& c, int l, int b, int h, int cc, char* lds) {
    constexpr int DK = ScanCfg<MX>::DK, PK = DK + 1;
    float* qt = (float*)lds; float* kt = qt + 64 * PK; float* gt = kt + 64 * PK; float* ot = gt + 64 * PK;
    bf16_t* VT = (bf16_t*)(ot + 64 * 65); bf16_t* QS = VT + 64 * BP; bf16_t* QG = QS + 64 * BP; bf16_t* KS = QG + 64 * BP;
    bf16_t* SC = KS + 96 * BP; bf16_t* ST = SC + 64 * BP; float* tmp = (float*)(ST + 64 * BP);
    const int tid = c.tid, lane = c.lane;
    for (int dir = 0; dir < 2; ++dir) {
        scan_load<MX, true>(c, l, b, h, cc, dir, qt, kt, gt, VT, tmp, lds);
        const int ch = (b * 4 + h) * 2 + dir;
        const bf16_t* Sg = (MX == 0 ? C_SG : C_SH) + ((size_t)ch * NCHUNK + cc) * (DK * 64);
        if (tid < DK * 8) { const int k = tid >> 3, jb = (tid & 7) * 8; const u32x4 sr = *(const u32x4*)(Sg + tid * 8);
#pragma unroll
            for (int e = 0; e < 8; ++e) ST[(jb + e) * BP + k] = (bf16_t)((e & 1) ? (sr[e >> 1] >> 16) : (sr[e >> 1] & 0xffffu)); }
        for (int i = tid; i < 64 * DK; i += 512) { const int t = i / DK, k = i % DK; const int I = t >> 4;
            const float bt = gt[t * PK + k], qv = qt[t * PK + k], kv = kt[t * PK + k];
            const float Bi = I ? gt[(16 * I - 1) * PK + k] : 0.f;
            QS[t * BP + k] = f2bf(qv * __expf(bt - Bi));
            QG[t * BP + k] = f2bf(qv * __expf(bt));
            if (t < 16) KS[t * BP + k] = f2bf(kv * __expf(gt[15 * PK + k] - bt));
            if (t < 32) KS[(16 + t) * BP + k] = f2bf(kv * __expf(gt[31 * PK + k] - bt));
            if (t < 48) KS[(48 + t) * BP + k] = f2bf(kv * __expf(gt[47 * PK + k] - bt)); }
        { const int blk = tid >> 7, tl = (tid >> 3) & 15, s0 = (tid & 7) * 2; const int t = blk * 16 + tl;
            float a0 = 0.f, a1 = 0.f;
            if (s0 <= tl) { const int sa = blk * 16 + s0, sb = sa + 1;
                for (int k = 0; k < DK; ++k) { const float qv = qt[t * PK + k], bv = gt[t * PK + k];
                    a0 += qv * kt[sa * PK + k] * __expf(fminf(bv - gt[sa * PK + k], 0.f));
                    a1 += qv * kt[sb * PK + k] * __expf(fminf(bv - gt[sb * PK + k], 0.f)); }
                if (s0 + 1 > tl) a1 = 0.f; }
            SC[t * BP + blk * 16 + s0] = f2bf(a0); SC[t * BP + blk * 16 + s0 + 1] = f2bf(a1);
            for (int J = blk + 1; J < 4; ++J) { SC[t * BP + J * 16 + s0] = 0; SC[t * BP + J * 16 + s0 + 1] = 0; } }
        __syncthreads();
        if (c.wid < 6) { const int I = c.wid < 1 ? 1 : (c.wid < 3 ? 2 : 3), J = c.wid < 1 ? 0 : (c.wid < 3 ? c.wid - 1 : c.wid - 3);
            const bf16_t* KSI = KS + (I == 1 ? 0 : (I == 2 ? 16 : 48)) * BP;
            f32x4v acc = {0.f, 0.f, 0.f, 0.f};
#pragma unroll
            for (int ks = 0; ks < DK / 32; ++ks) acc = __builtin_amdgcn_mfma_f32_16x16x32_bf16(frag16(QS, I * 16, ks * 32, lane), frag16(KSI, J * 16, ks * 32, lane), acc, 0, 0, 0);
#pragma unroll
            for (int i = 0; i < 4; ++i) SC[(I * 16 + 4 * (lane >> 4) + i) * BP + J * 16 + (lane & 15)] = f2bf(acc[i]); }
        __syncthreads();
#pragma unroll
        for (int u = 0; u < 2; ++u) { const int tile = c.wid * 2 + u; const int ti = tile >> 2, tj = tile & 3;
            f32x4v acc = {0.f, 0.f, 0.f, 0.f};
#pragma unroll
            for (int ks = 0; ks < 2; ++ks) acc = __builtin_amdgcn_mfma_f32_16x16x32_bf16(frag16(SC, ti * 16, ks * 32, lane), frag16(VT, tj * 16, ks * 32, lane), acc, 0, 0, 0);
#pragma unroll
            for (int ks = 0; ks < DK / 32; ++ks) acc = __builtin_amdgcn_mfma_f32_16x16x32_bf16(frag16(QG, ti * 16, ks * 32, lane), frag16(ST, tj * 16, ks * 32, lane), acc, 0, 0, 0);
#pragma unroll
            for (int i = 0; i < 4; ++i) { const int t = ti * 16 + 4 * (lane >> 4) + i; const int to = dir ? 63 - t : t; float* op = ot + to * 65 + tj * 16 + (lane & 15);
                if (dir == 0) *op = acc[i]; else *op += acc[i]; } }
        __syncthreads();
    }
    { const int t = tid >> 3, j0 = (tid & 7) * 8; float o[8]; float ss = 0.f;
#pragma unroll
        for (int j = 0; j < 8; ++j) { o[j] = ot[t * 65 + j0 + j]; ss += o[j] * o[j]; }
        ss += __shfl_xor(ss, 1, 64); ss += __shfl_xor(ss, 2, 64); ss += __shfl_xor(ss, 4, 64);
        const float rstd = rsqrtf(ss * (1.f / 64.f) + NORM_EPS);
        const int r = b * RPB + cc * 64 + t;
        const float* gn = CIN(MX == 0 ? 12 : 14) + l * 64;
        const u32x4 gp = *(const u32x4*)(C_P + (size_t)r * INC + (MX == 0 ? GLA_R : HG_OG) + h * 64 + j0);
        float y[8];
#pragma unroll
        for (int j = 0; j < 8; ++j) y[j] = o[j] * rstd * gn[j0 + j] * silu_f((j & 1) ? bfhi(gp[j >> 1]) : bflo(gp[j >> 1]));
        u32x4 w = {cvtpk(y[0], y[1]), cvtpk(y[2], y[3]), cvtpk(y[4], y[5]), cvtpk(y[6], y[7])};
        *(u32x4*)(C_HB + (size_t)r * D + MX * 256 + h * 64 + j0) = w; }
    __syncthreads();
}

__device__ __forceinline__ void rope_cs(int pos, int i, float& cs, float& sn) {
    const float freq = __expf(-(float)i * (9.210340371976184f / 8.f));
    const float ang = (float)pos * freq;
    const float n = rintf(ang * 0.15915494309189535f);
    float rr = fmaf(-n, 6.2831854820251465f, ang); rr = fmaf(-n, -1.7484555e-7f, rr);
    cs = __cosf(rr); sn = __sinf(rr);
}

__device__ void ph_prep_rows(const Ctx& c, int l) {
    const float* gq = CIN(15) + l * 192; const float* gkv = CIN(16) + l * 128;
    for (int r = blockIdx.x * 8 + c.wid; r < NR; r += gridDim.x * 8) {
        const int b = r / RPB, j = r - b * RPB; bf16_t* pr = C_P + (size_t)r * INC;
        { float v[3]; float ss = 0.f;
#pragma unroll
            for (int i = 0; i < 3; ++i) { v[i] = bf2f(pr[MLA_CQ + c.lane + 64 * i]); ss += v[i] * v[i]; }
            ss = wave_sum(ss); const float rstd = rsqrtf(ss * (1.f / 192.f) + NORM_EPS);
#pragma unroll
            for (int i = 0; i < 3; ++i) pr[MLA_CQ + c.lane + 64 * i] = f2bf(v[i] * rstd * gq[c.lane + 64 * i]); }
        { float v[2]; float ss = 0.f;
#pragma unroll
            for (int i = 0; i < 2; ++i) { v[i] = bf2f(pr[MLA_CKV + c.lane + 64 * i]); ss += v[i] * v[i]; }
            ss = wave_sum(ss); const float rstd = rsqrtf(ss * (1.f / 128.f) + NORM_EPS);
#pragma unroll
            for (int i = 0; i < 2; ++i) pr[MLA_CKV + c.lane + 64 * i] = f2bf(v[i] * rstd * gkv[c.lane + 64 * i]); }
        if (j >= CTX) { const int t = j - CTX; const int prow = t >> 6, pcol = t & 63;
            for (int pp = c.lane; pp < 34 * 8; pp += 64) { const int g = pp >> 3, i = pp & 7;
                int col; if (g < 16) col = DF_Q + (g >> 1) * 32 + (g & 1) * 16; else if (g < 32) col = DF_K + ((g - 16) >> 1) * 32 + (g & 1) * 16; else col = MLA_KR + (g - 32) * 16;
                float cs, sn; rope_cs((g & 1) ? pcol : prow, i, cs, sn);
                const float x1 = bf2f(pr[col + i]), x2 = bf2f(pr[col + 8 + i]);
                pr[col + i] = f2bf(x1 * cs - x2 * sn); pr[col + 8 + i] = f2bf(x1 * sn + x2 * cs); } }
    }
}
__device__ void ph_rope_q(const Ctx& c) {
    for (int r = blockIdx.x * 8 + c.wid; r < NR; r += gridDim.x * 8) {
        const int b = r / RPB, j = r - b * RPB; if (j < CTX) continue;
        const int t = j - CTX; const int prow = t >> 6, pcol = t & 63;
        const int h = c.lane >> 4, g = (c.lane >> 3) & 1, i = c.lane & 7;
        bf16_t* q = C_QM + (size_t)r * 384 + h * 96 + 64 + g * 16;
        float cs, sn; rope_cs(g ? pcol : prow, i, cs, sn);
        const float x1 = bf2f(q[i]), x2 = bf2f(q[8 + i]);
        q[i] = f2bf(x1 * cs - x2 * sn); q[8 + i] = f2bf(x1 * sn + x2 * cs);
    }
}

__device__ __forceinline__ int v_st(int k, int cidx) { const int kk = (k & ~0xC) | ((k & 4) << 1) | ((k & 8) >> 1); return ((kk >> 3) * 2 + (cidx >> 5)) * 512 + ((kk & 7) * 32 + (cidx & 31)) * 2; }
__device__ __forceinline__ int v_rd_base(int lane) { return ((lane & 3) << 3) | (((lane >> 2) & 3) << 6) | (((lane >> 4) & 1) << 5) | (((lane >> 5) & 1) << 8); }
constexpr int v_rd_off(int d0, int ks, int half) { return d0 * 512 + ks * 2048 + half * 1024; }
template <int OFF> __device__ __forceinline__ s16x4 tr_read(int vb) { s16x4 r; asm volatile("ds_read_b64_tr_b16 %0, %1 offset:%2" : "=&v"(r) : "v"(vb), "i"(OFF) : "memory"); return r; }
template <int D0> __device__ __forceinline__ void pv_one(f32x16& od, int vb, bf16x8 pa0, bf16x8 pa1, bf16x8 pa2, bf16x8 pa3) {
    const s16x4 l0 = tr_read<v_rd_off(D0, 0, 0)>(vb), h0 = tr_read<v_rd_off(D0, 0, 1)>(vb), l1 = tr_read<v_rd_off(D0, 1, 0)>(vb), h1 = tr_read<v_rd_off(D0, 1, 1)>(vb);
    const s16x4 l2 = tr_read<v_rd_off(D0, 2, 0)>(vb), h2 = tr_read<v_rd_off(D0, 2, 1)>(vb), l3 = tr_read<v_rd_off(D0, 3, 0)>(vb), h3 = tr_read<v_rd_off(D0, 3, 1)>(vb);
    asm volatile("s_waitcnt lgkmcnt(0)" ::: "memory"); __builtin_amdgcn_sched_barrier(0);
#define PKV(L, H) (bf16x8){L[0], L[1], L[2], L[3], H[0], H[1], H[2], H[3]}
    od = __builtin_amdgcn_mfma_f32_32x32x16_bf16(pa0, PKV(l0, h0), od, 0, 0, 0);
    od = __builtin_amdgcn_mfma_f32_32x32x16_bf16(pa1, PKV(l1, h1), od, 0, 0, 0);
    od = __builtin_amdgcn_mfma_f32_32x32x16_bf16(pa2, PKV(l2, h2), od, 0, 0, 0);
    od = __builtin_amdgcn_mfma_f32_32x32x16_bf16(pa3, PKV(l3, h3), od, 0, 0, 0);
#undef PKV
}
constexpr float ATT_BIG = 1.0995116e12f;
constexpr float ATT_ZBIG = 1.2379400392853803e27f, ATT_ZSMALL = 8.673617379884035e-19f;
__device__ __forceinline__ float rowmax_tile(const f32x16& p0, const f32x16& p1) {
    float pmax = p0[0];
#pragma unroll
    for (int r = 1; r < 16; ++r) pmax = fmaxf(pmax, p0[r]);
#pragma unroll
    for (int r = 0; r < 16; ++r) pmax = fmaxf(pmax, p1[r]);
    auto rr = __builtin_amdgcn_permlane32_swap(__float_as_uint(pmax), __float_as_uint(pmax), false, false);
    return fmaxf(__uint_as_float(rr[0]), __uint_as_float(rr[1]));
}
__device__ __forceinline__ void softmax_tile(f32x16& p0, f32x16& p1, float& M, const float Mused, float& l_reg, const bool first,
                                             bf16x8& pa0, bf16x8& pa1, bf16x8& pa2, bf16x8& pa3, f32x16 (&o)[2], float* wsl, const int r32, const int hi) {
    if (__builtin_expect(__any(Mused != M), 0)) {
        asm volatile("" ::: "memory");
        const float dM = Mused - M;
#pragma unroll
        for (int r = 0; r < 16; ++r) { p0[r] += dM; p1[r] += dM; }
    }
    if (first) {
        float pmax = p0[0];
#pragma unroll
        for (int r = 1; r < 16; ++r) pmax = fmaxf(pmax, p0[r]);
#pragma unroll
        for (int r = 0; r < 16; ++r) pmax = fmaxf(pmax, p1[r]);
        { auto rr = __builtin_amdgcn_permlane32_swap(__float_as_uint(pmax), __float_as_uint(pmax), false, false); pmax = fmaxf(__uint_as_float(rr[0]), __uint_as_float(rr[1])); }
        M = pmax;
#pragma unroll
        for (int r = 0; r < 16; ++r) { p0[r] -= pmax; p1[r] -= pmax; }
    }
    float ps = 0.f;
#pragma unroll
    for (int r = 0; r < 16; ++r) { p0[r] = __builtin_amdgcn_exp2f(p0[r]); ps += p0[r]; }
#pragma unroll
    for (int r = 0; r < 16; ++r) { p1[r] = __builtin_amdgcn_exp2f(p1[r]); ps += p1[r]; }
    { auto rr = __builtin_amdgcn_permlane32_swap(__float_as_uint(ps), __float_as_uint(ps), false, false); ps = __uint_as_float(rr[0]) + __uint_as_float(rr[1]); }
    if (__builtin_expect(__any(ps > ATT_BIG), 0)) {
        asm volatile("" ::: "memory");
        float pm = p0[0];
#pragma unroll
        for (int r = 1; r < 16; ++r) pm = fmaxf(pm, p0[r]);
#pragma unroll
        for (int r = 0; r < 16; ++r) pm = fmaxf(pm, p1[r]);
        { auto rr = __builtin_amdgcn_permlane32_swap(__float_as_uint(pm), __float_as_uint(pm), false, false); pm = fmaxf(__uint_as_float(rr[0]), __uint_as_float(rr[1])); }
        const float alpha = pm > 1.f ? __builtin_amdgcn_rcpf(pm) : 1.f;
        M -= __builtin_amdgcn_logf(alpha);
#pragma unroll
        for (int r = 0; r < 16; ++r) { p0[r] *= alpha; p1[r] *= alpha; }
        ps *= alpha; l_reg *= alpha;
        if (hi == 0) wsl[r32] = alpha;
        asm volatile("s_waitcnt lgkmcnt(0)" ::: "memory");
#pragma unroll
        for (int r = 0; r < 16; ++r) { const float av = wsl[crow(r, hi)]; o[0][r] *= av; o[1][r] *= av; }
        asm volatile("" ::: "memory");
    }
    l_reg += ps;
#define PK4(P, BASE, OUT) do { unsigned a0 = cvtpk(P[BASE + 0], P[BASE + 1]), a1 = cvtpk(P[BASE + 2], P[BASE + 3]);   \
    unsigned b0 = cvtpk(P[BASE + 4], P[BASE + 5]), b1 = cvtpk(P[BASE + 6], P[BASE + 7]);                              \
    auto r0 = __builtin_amdgcn_permlane32_swap(a0, b0, false, false); auto r1 = __builtin_amdgcn_permlane32_swap(a1, b1, false, false); \
    u32x4 w = {r0[0], r1[0], r0[1], r1[1]}; OUT = *reinterpret_cast<bf16x8*>(&w); } while (0)
    PK4(p0, 0, pa0); PK4(p0, 8, pa1); PK4(p1, 0, pa2); PK4(p1, 8, pa3);
#undef PK4
}

constexpr int ATT_STAGE = 2 * 16384 + 2 * 8192;
constexpr int ATT_LDS = 65536 + 49152 + 8 * 64 * 4 + 16;
template <bool DIFF>
__device__ void attn_item(const Ctx& c, int l, int b, int hd, int qrow0, int krow0, int nkeys, char* lds) {
    constexpr int DQK = DIFF ? 32 : 96, NMAP = DIFF ? 2 : 1, ND0 = DQK / 16, NU = 2 * NMAP;
    constexpr int KP = DIFF ? 64 : 256;
    constexpr int KSZ = 64 * KP;
    constexpr int NKR = DIFF ? 2 : 3;
    const int tid_ = mk_tid(c.wid);
    const int tid = tid_, lane = tid_ & 63, wid = c.wid, r32 = lane & 31, hi = lane >> 5;
    char* K_lds0 = lds; char* V_lds0 = lds + 2 * 16384; float* wsl = (float*)(lds + 2 * ATT_STAGE) + wid * 64;
    const float scale = DIFF ? 0.17677669529663687f : 0.10206207261596575f;
    const float C = scale * 1.4426950408889634f;
    bf16x8 qr[NMAP][ND0];
    { const int qrow = qrow0 + wid * 32 + r32;
#pragma unroll
        for (int m = 0; m < NMAP; ++m)
#pragma unroll
            for (int d0 = 0; d0 < ND0; ++d0) {
                const bf16_t* p = DIFF ? C_P + (size_t)qrow * INC + DF_Q + (hd * 2 + m) * 32 + d0 * 16 + hi * 8
                                       : C_QM + (size_t)qrow * 384 + hd * 96 + d0 * 16 + hi * 8;
                qr[m][d0] = *(const bf16x8*)p; } }
    f32x16 o[NMAP][2]; float m_reg[NMAP], l_reg[NMAP];
#pragma unroll
    for (int m = 0; m < NMAP; ++m) { m_reg[m] = 0.f; l_reg[m] = 0.f;
#pragma unroll
        for (int d = 0; d < 2; ++d) zero_acc(o[m][d]); }
    constexpr int NKP = DIFF ? 2 : 4;
    int ksrc[NKP], vsrc[2];
#pragma unroll
    for (int q = 0; q < NKP; ++q) { const int off = (wid * NKP + q) * 1024 + lane * 16;
        if (DIFF) { const int blk = off >> 12, key = (off & 4095) >> 6, slot = (off & 63) >> 4, ch = slot ^ ((key >> 2) & 3);
            ksrc[q] = ((blk >> 1) * 64 + key) * INC + DF_K + (hd * 2 + (blk & 1)) * 32 + ch * 8; }
        else { const int tile = off >> 14, key = (off & 16383) >> 8, slot = (off & 255) >> 4, ch = slot ^ (key & 15);
            ksrc[q] = ch < 8 ? -1 - ((tile * 64 + key) * 512 + hd * 128 + ch * 8) : (ch < 12 ? (tile * 64 + key) * INC + MLA_KR + (ch - 8) * 8 : (int)0x80000000); } }
#pragma unroll
    for (int q = 0; q < 2; ++q) { const int off = (wid * 2 + q) * 1024 + lane * 16; const int tile = off >> 13, w = off & 8191;
        const int sub = w >> 9, within = w & 511; const int kk = (sub >> 1) * 8 + (within >> 6); const int col = (sub & 1) * 32 + ((within & 63) >> 1);
        const int key = (kk & ~0xC) | ((kk & 4) << 1) | ((kk & 8) >> 1);
        vsrc[q] = DIFF ? (tile * 64 + key) * INC + DF_V + hd * 64 + col : (tile * 64 + key) * 512 + hd * 128 + 64 + col; }
    const int vb0 = (int)(uintptr_t)V_lds0 + v_rd_base(lane);
#define ADMA(buf, kr) do { \
        _Pragma("unroll") for (int q = 0; q < NKP; ++q) { LAS unsigned* dst_ = (LAS unsigned*)(LAS char*)(K_lds0 + (buf) * ATT_STAGE + (wid * NKP + q) * 1024); \
            if (DIFF || ksrc[q] >= 0) __builtin_amdgcn_global_load_lds((const unsigned*)(C_P + (size_t)(kr) * INC + ksrc[q]), dst_, 16, 0, 0); \
            else if (ksrc[q] != (int)0x80000000) __builtin_amdgcn_global_load_lds((const unsigned*)(C_KVM + (size_t)(kr) * 512 + (-1 - ksrc[q])), dst_, 16, 0, 0); } \
        _Pragma("unroll") for (int q = 0; q < 2; ++q) { LAS unsigned* dst_ = (LAS unsigned*)(LAS char*)(V_lds0 + (buf) * ATT_STAGE + (wid * 2 + q) * 1024); \
            __builtin_amdgcn_global_load_lds((const unsigned*)((DIFF ? C_P + (size_t)(kr) * INC : C_KVM + (size_t)(kr) * 512) + vsrc[q]), dst_, 16, 0, 0); } } while (0)
    const int NS = nkeys >> 7;
    ADMA(0, krow0);
    for (int j = 0; j < NS; ++j) {
        asm volatile("s_waitcnt vmcnt(0)" ::: "memory");
        __syncthreads();
        if (j + 1 < NS) ADMA((j + 1) & 1, krow0 + (j + 1) * 128);
        const char* K_lds = K_lds0 + (j & 1) * ATT_STAGE; const int vb = vb0 + (j & 1) * ATT_STAGE;
        f32x16 p0[2], p1[2]; float mused[2];
#define QKT(u) do { constexpr int tt_ = (u) / NMAP, m_ = (u) % NMAP; const char* Kb = K_lds + (tt_ * NMAP + m_) * KSZ; \
            _Pragma("unroll") for (int d0 = 0; d0 < ND0; ++d0) { bf16x8 b0, b1; \
                if (DIFF) { const int ch = d0 * 2 + hi; const int ra = r32, rb = 32 + r32; \
                    b0 = *(const bf16x8*)(Kb + ra * 64 + ((ch ^ ((ra >> 2) & 3)) << 4)); b1 = *(const bf16x8*)(Kb + rb * 64 + ((ch ^ ((rb >> 2) & 3)) << 4)); } \
                else { const int cb = d0 * 32 + hi * 16; const int ra = r32, rb = 32 + r32; \
                    b0 = *(const bf16x8*)(Kb + ra * 256 + (cb ^ ((ra & 15) << 4))); b1 = *(const bf16x8*)(Kb + rb * 256 + (cb ^ ((rb & 15) << 4))); } \
                if (d0 == 0) { const float nm_ = -m_reg[m_]; mused[(u) & 1] = m_reg[m_]; const f32x16 z = {nm_,nm_,nm_,nm_,nm_,nm_,nm_,nm_,nm_,nm_,nm_,nm_,nm_,nm_,nm_,nm_}; \
                    p0[(u) & 1] = __builtin_amdgcn_mfma_f32_32x32x16_bf16(b0, qr[m_][0], z, 0, 0, 0); p1[(u) & 1] = __builtin_amdgcn_mfma_f32_32x32x16_bf16(b1, qr[m_][0], z, 0, 0, 0); \
                    asm volatile("" :: "v"(b0), "v"(b1));   } \
                else { p0[(u) & 1] = __builtin_amdgcn_mfma_f32_32x32x16_bf16(b0, qr[m_][d0], p0[(u) & 1], 0, 0, 0); p1[(u) & 1] = __builtin_amdgcn_mfma_f32_32x32x16_bf16(b1, qr[m_][d0], p1[(u) & 1], 0, 0, 0); } } \
            if (!DIFF) {   \
                __builtin_amdgcn_sched_group_barrier(0x100, 4, 0); \
                _Pragma("unroll") for (int g_ = 0; g_ < 4; ++g_) { __builtin_amdgcn_sched_group_barrier(0x8, 2, 0); __builtin_amdgcn_sched_group_barrier(0x100, 2, 0); } \
                __builtin_amdgcn_sched_group_barrier(0x8, 4, 0); } } while (0)
        QKT(0);
#pragma unroll
        for (int u = 0; u < NU; ++u) {
            const int tt = u / NMAP, m = u % NMAP;
            if (u + 1 < NU) { if (u == 0) QKT(1); else if (u == 1) QKT(2); else QKT(3); }
            bf16x8 pa0, pa1, pa2, pa3;
            softmax_tile(p0[u & 1], p1[u & 1], m_reg[m], mused[u & 1], l_reg[m], (j == 0) && (tt == 0), pa0, pa1, pa2, pa3, o[m], wsl, r32, hi);
            pv_one<0>(o[m][0], vb + tt * 8192, pa0, pa1, pa2, pa3);
            pv_one<1>(o[m][1], vb + tt * 8192, pa0, pa1, pa2, pa3);
        }
#undef QKT
    }
#undef ADMA
    float rli[NMAP][16];
#pragma unroll
    for (int m = 0; m < NMAP; ++m) {
        asm volatile("s_waitcnt lgkmcnt(0)" ::: "memory");
        if (hi == 0) wsl[r32] = l_reg[m];
        asm volatile("s_waitcnt lgkmcnt(0)" ::: "memory");
#pragma unroll
        for (int r = 0; r < 16; ++r) rli[m][r] = __builtin_amdgcn_rcpf(wsl[crow(r, hi)]);
    }
    const int orow0 = qrow0 + wid * 32;
    if (!DIFF) {
#pragma unroll
        for (int r = 0; r < 16; ++r) { bf16_t* dst = C_HB + (size_t)(orow0 + crow(r, hi)) * D + 512 + hd * 64 + r32;
            dst[0] = f2bf(o[0][0][r] * rli[0][r]); dst[32] = f2bf(o[0][1][r] * rli[0][r]); }
    } else {
        const float* lp = CIN(19) + l * 128; const float* gn = CIN(20) + l * 64; asm volatile("" : "+s"(lp), "+s"(gn));
        float s1 = lp[r32] * lp[32 + r32], s2 = lp[64 + r32] * lp[96 + r32];
#pragma unroll
        for (int o = 1; o < 32; o <<= 1) { s1 += shx(s1, o, lane); s2 += shx(s2, o, lane); }
        const float lam_init = (l == 0) ? 0.2f : 0.35550906759097f;
        const float lam = __expf(s1) - __expf(s2) + lam_init;
        const float g0 = gn[r32] * (1.f - lam_init), g1 = gn[32 + r32] * (1.f - lam_init);
#pragma unroll
        for (int r = 0; r < 16; ++r) {
            const float v0 = o[0][0][r] * rli[0][r] - lam * o[NMAP - 1][0][r] * rli[NMAP - 1][r];
            const float v1 = o[0][1][r] * rli[0][r] - lam * o[NMAP - 1][1][r] * rli[NMAP - 1][r];
            float ss = v0 * v0 + v1 * v1;
            ss += shx(ss, 1, lane); ss += shx(ss, 2, lane); ss += shx(ss, 4, lane); ss += shx(ss, 8, lane); ss += shx(ss, 16, lane);
            const float rstd = rsqrtf(ss * (1.f / 64.f) + NORM_EPS);
            bf16_t* dst = C_HB + (size_t)(orow0 + crow(r, hi)) * D + 768 + hd * 64 + r32;
            dst[0] = f2bf(v0 * rstd * g0); dst[32] = f2bf(v1 * rstd * g1); }
    }
    __syncthreads();
}
template <bool DIFF>
__device__ bool attn_item_pair(const Ctx& c, int l, int b, int hd, int qrow0, int krow0, int nkeys, char* lds) {
    constexpr int DQK = DIFF ? 32 : 96, NMAP = DIFF ? 2 : 1, ND0 = DQK / 16, NU = 2 * NMAP;
    constexpr int KP = DIFF ? 64 : 256;
    constexpr int KSZ = 64 * KP;
    constexpr int NKR = DIFF ? 2 : 3;
    const int tid_ = mk_tid(c.wid);
    const int tid = tid_, lane = tid_ & 63, wid = c.wid, r32 = lane & 31, hi = lane >> 5;
    char* K_lds0 = lds; char* V_lds0 = lds + 65536; float* wsl = (float*)(lds + 65536 + 49152) + wid * 64;
    const float scale = DIFF ? 0.17677669529663687f : 0.10206207261596575f;
    const float C = scale * 1.4426950408889634f;
    bf16x8 qr[NMAP][ND0];
    { const int qrow = qrow0 + wid * 32 + r32;
#pragma unroll
        for (int m = 0; m < NMAP; ++m)
#pragma unroll
            for (int d0 = 0; d0 < ND0; ++d0) {
                const bf16_t* p = DIFF ? C_P + (size_t)qrow * INC + DF_Q + (hd * 2 + m) * 32 + d0 * 16 + hi * 8
                                       : C_QM + (size_t)qrow * 384 + hd * 96 + d0 * 16 + hi * 8;
                qr[m][d0] = *(const bf16x8*)p; } }
    f32x16 o[NMAP][2]; float m_reg[NMAP], l_reg[NMAP];
#pragma unroll
    for (int m = 0; m < NMAP; ++m) { m_reg[m] = 0.f; l_reg[m] = 0.f;
#pragma unroll
        for (int d = 0; d < 2; ++d) zero_acc(o[m][d]); }
    constexpr int NKP = DIFF ? 2 : 4;
    int ksrc[NKP], vsrc[2];
#pragma unroll
    for (int q = 0; q < NKP; ++q) { const int off = (wid * NKP + q) * 1024 + lane * 16;
        if (DIFF) { const int blk = off >> 12, key = (off & 4095) >> 6, slot = (off & 63) >> 4, ch = slot ^ ((key >> 2) & 3);
            ksrc[q] = ((blk >> 1) * 64 + key) * INC + DF_K + (hd * 2 + (blk & 1)) * 32 + ch * 8; }
        else { const int tile = off >> 14, key = (off & 16383) >> 8, slot = (off & 255) >> 4, ch = slot ^ (key & 15);
            ksrc[q] = ch < 8 ? -1 - ((tile * 64 + key) * 512 + hd * 128 + ch * 8) : (ch < 12 ? (tile * 64 + key) * INC + MLA_KR + (ch - 8) * 8 : (int)0x80000000); } }
#pragma unroll
    for (int q = 0; q < 2; ++q) { const int off = (wid * 2 + q) * 1024 + lane * 16; const int tile = off >> 13, w = off & 8191;
        const int sub = w >> 9, within = w & 511; const int kk = (sub >> 1) * 8 + (within >> 6); const int col = (sub & 1) * 32 + ((within & 63) >> 1);
        const int key = kk;
        vsrc[q] = DIFF ? (tile * 64 + key) * INC + DF_V + hd * 64 + col : (tile * 64 + key) * 512 + hd * 128 + 64 + col; }
    const int vb0 = (int)(uintptr_t)V_lds0 + v_rd_base(lane);
    unsigned kbo[NKP], vbo[2];
#pragma unroll
    for (int q = 0; q < NKP; ++q) kbo[q] = (DIFF || ksrc[q] >= 0) ? (unsigned)ksrc[q] * 2u : (unsigned)(-1 - ksrc[q]) * 2u;
#pragma unroll
    for (int q = 0; q < 2; ++q) vbo[q] = (unsigned)vsrc[q] * 2u;
#define ADMA(kbuf, vbuf, kr) do { const char* pb_ = (const char*)C_P + (size_t)(kr) * (INC * 2); const char* kb_ = (const char*)C_KVM + (size_t)(kr) * 1024; asm volatile("" : "+s"(pb_), "+s"(kb_)); \
        _Pragma("unroll") for (int q = 0; q < NKP; ++q) { LAS unsigned* dst_ = (LAS unsigned*)(LAS char*)(K_lds0 + (kbuf) * 32768 + (wid * NKP + q) * 1024); \
            unsigned o_ = kbo[q]; asm volatile("" : "+v"(o_));     \
            if (DIFF || ksrc[q] >= 0) __builtin_amdgcn_global_load_lds((const unsigned*)(pb_ + (size_t)o_), dst_, 16, 0, 0); \
            else if (ksrc[q] != (int)0x80000000) __builtin_amdgcn_global_load_lds((const unsigned*)(kb_ + (size_t)o_), dst_, 16, 0, 0); } \
        _Pragma("unroll") for (int q = 0; q < 2; ++q) { LAS unsigned* dst_ = (LAS unsigned*)(LAS char*)(V_lds0 + (vbuf) * 16384 + (wid * 2 + q) * 1024); \
            unsigned o_ = vbo[q]; asm volatile("" : "+v"(o_)); \
            __builtin_amdgcn_global_load_lds((const unsigned*)((DIFF ? pb_ : kb_) + (size_t)o_), dst_, 16, 0, 0); } } while (0)
    float lsA = 0.f, lsB = 0.f;
    const int NS = nkeys >> 7;
    ADMA(0, 0, krow0);
    f32x16 a0, a1, b0, b1;
    zero_acc(a0); zero_acc(a1); zero_acc(b0); zero_acc(b1);
    bf16x8 pa[4], pb[4];
    int vslot = 0, vbp = vb0;
#define PKV(L, H) (bf16x8){L[0], L[1], L[2], L[3], H[0], H[1], H[2], H[3]}
#define PK4(P, BASE, OUT) do { u32x4 w = {cvtpk(P[BASE + 0], P[BASE + 1]), cvtpk(P[BASE + 2], P[BASE + 3]), cvtpk(P[BASE + 4], P[BASE + 5]), cvtpk(P[BASE + 6], P[BASE + 7])}; \
    OUT = *reinterpret_cast<bf16x8*>(&w); } while (0)
#define PACKP() do { PK4(a0, 0, pa[0]); PK4(b0, 0, pb[0]); PK4(a0, 8, pa[1]); PK4(b0, 8, pb[1]); PK4(a1, 0, pa[2]); PK4(b1, 0, pb[2]); PK4(a1, 8, pa[3]); PK4(b1, 8, pb[3]); } while (0)
#define CHK(X, B, PS) do { X[B] = __builtin_amdgcn_exp2f(X[B]); X[B + 1] = __builtin_amdgcn_exp2f(X[B + 1]); X[B + 2] = __builtin_amdgcn_exp2f(X[B + 2]); X[B + 3] = __builtin_amdgcn_exp2f(X[B + 3]); \
        PS += X[B]; PS += X[B + 1]; PS += X[B + 2]; PS += X[B + 3]; } while (0)
#define CHUNK(c) do { if ((c) == 0) CHK(a0, 0, psA); else if ((c) == 1) CHK(b0, 0, psB); else if ((c) == 2) CHK(a0, 4, psA); else if ((c) == 3) CHK(b0, 4, psB); \
        else if ((c) == 4) CHK(a0, 8, psA); else if ((c) == 5) CHK(b0, 8, psB); else if ((c) == 6) CHK(a0, 12, psA); else if ((c) == 7) CHK(b0, 12, psB); \
        else if ((c) == 8) CHK(a1, 0, psA); else if ((c) == 9) CHK(b1, 0, psB); else if ((c) == 10) CHK(a1, 4, psA); else if ((c) == 11) CHK(b1, 4, psB); \
        else if ((c) == 12) CHK(a1, 8, psA); else if ((c) == 13) CHK(b1, 8, psB); else if ((c) == 14) CHK(a1, 12, psA); else CHK(b1, 12, psB); \
        __builtin_amdgcn_sched_barrier(0); } while (0)
#define VREAD(D0B, VB, TA, TB) \
        const int va_##D0B = (VB) + (TA) * 8192, vq_##D0B = (VB) + (TB) * 8192; \
        const s16x4 l0##D0B = tr_read<v_rd_off(D0B, 0, 0)>(va_##D0B), h0##D0B = tr_read<v_rd_off(D0B, 0, 1)>(va_##D0B), l1##D0B = tr_read<v_rd_off(D0B, 1, 0)>(va_##D0B), h1##D0B = tr_read<v_rd_off(D0B, 1, 1)>(va_##D0B); \
        const s16x4 l2##D0B = tr_read<v_rd_off(D0B, 2, 0)>(va_##D0B), h2##D0B = tr_read<v_rd_off(D0B, 2, 1)>(va_##D0B), l3##D0B = tr_read<v_rd_off(D0B, 3, 0)>(va_##D0B), h3##D0B = tr_read<v_rd_off(D0B, 3, 1)>(va_##D0B); \
        s16x4 m0##D0B = l0##D0B, n0##D0B = h0##D0B, m1##D0B = l1##D0B, n1##D0B = h1##D0B, m2##D0B = l2##D0B, n2##D0B = h2##D0B, m3##D0B = l3##D0B, n3##D0B = h3##D0B; \
        if (!DIFF) { m0##D0B = tr_read<v_rd_off(D0B, 0, 0)>(vq_##D0B); n0##D0B = tr_read<v_rd_off(D0B, 0, 1)>(vq_##D0B); m1##D0B = tr_read<v_rd_off(D0B, 1, 0)>(vq_##D0B); n1##D0B = tr_read<v_rd_off(D0B, 1, 1)>(vq_##D0B); \
            m2##D0B = tr_read<v_rd_off(D0B, 2, 0)>(vq_##D0B); n2##D0B = tr_read<v_rd_off(D0B, 2, 1)>(vq_##D0B); m3##D0B = tr_read<v_rd_off(D0B, 3, 0)>(vq_##D0B); n3##D0B = tr_read<v_rd_off(D0B, 3, 1)>(vq_##D0B); }
#define VWAIT() do { asm volatile("s_waitcnt lgkmcnt(0)" ::: "memory"); __builtin_amdgcn_sched_barrier(0); } while (0)
#define PVM(D0B, i) do { f32x16& accA = o[0][D0B]; f32x16& accB = o[NMAP - 1][D0B]; \
        if ((i) == 0) accA = __builtin_amdgcn_mfma_f32_32x32x16_bf16(pa[0], PKV(l0##D0B, h0##D0B), accA, 0, 0, 0); else if ((i) == 1) accB = __builtin_amdgcn_mfma_f32_32x32x16_bf16(pb[0], PKV(m0##D0B, n0##D0B), accB, 0, 0, 0); \
        else if ((i) == 2) accA = __builtin_amdgcn_mfma_f32_32x32x16_bf16(pa[1], PKV(l1##D0B, h1##D0B), accA, 0, 0, 0); else if ((i) == 3) accB = __builtin_amdgcn_mfma_f32_32x32x16_bf16(pb[1], PKV(m1##D0B, n1##D0B), accB, 0, 0, 0); \
        else if ((i) == 4) accA = __builtin_amdgcn_mfma_f32_32x32x16_bf16(pa[2], PKV(l2##D0B, h2##D0B), accA, 0, 0, 0); else if ((i) == 5) accB = __builtin_amdgcn_mfma_f32_32x32x16_bf16(pb[2], PKV(m2##D0B, n2##D0B), accB, 0, 0, 0); \
        else if ((i) == 6) accA = __builtin_amdgcn_mfma_f32_32x32x16_bf16(pa[3], PKV(l3##D0B, h3##D0B), accA, 0, 0, 0); else accB = __builtin_amdgcn_mfma_f32_32x32x16_bf16(pb[3], PKV(m3##D0B, n3##D0B), accB, 0, 0, 0); } while (0)
#define STEP3_PV(VB, TA, TB) do { float psA = 0.f, psB = 0.f; \
        VREAD(0, VB, TA, TB) \
        VWAIT(); \
        PVM(0, 0); CHUNK(0); PVM(0, 1); CHUNK(1); PVM(0, 2); CHUNK(2); PVM(0, 3); CHUNK(3); PVM(0, 4); CHUNK(4); PVM(0, 5); CHUNK(5); \
        VREAD(1, VB, TA, TB) \
        __builtin_amdgcn_sched_barrier(0); \
        PVM(0, 6); CHUNK(6); PVM(0, 7); CHUNK(7); \
        VWAIT(); \
        PVM(1, 0); CHUNK(8); PVM(1, 1); CHUNK(9); PVM(1, 2); CHUNK(10); PVM(1, 3); CHUNK(11); PVM(1, 4); CHUNK(12); PVM(1, 5); CHUNK(13); PVM(1, 6); CHUNK(14); PVM(1, 7); CHUNK(15); \
        lsA += psA; lsB += psB; } while (0)
    constexpr int NG = ND0 / 2, NPI = DIFF ? 2 : 1, TLA = DIFF ? 1 : 0, TLB = 1;
    for (int j = 0; j < NS; ++j) {
        asm volatile("s_waitcnt vmcnt(0)" ::: "memory");
        __syncthreads();
        const int vnext = (vslot == 2) ? 0 : vslot + 1;
        if (j + 1 < NS) ADMA((j + 1) & 1, vnext, krow0 + (j + 1) * 128);
        const char* K_lds = K_lds0 + (j & 1) * 32768; const int vb = vb0 + vslot * 16384;
#define KFR(tt, m, d0, h) (*(const bf16x8*)(K_lds + ((tt) * NMAP + (m)) * KSZ + \
            (DIFF ? (((h) * 32 + r32) * 64 + ((((d0) * 2 + hi) ^ ((((h) * 32 + r32) >> 2) & 3)) << 4)) : (((h) * 32 + r32) * 256 + (((d0) * 32 + hi * 16) ^ ((((h) * 32 + r32) & 15) << 4))))))
#define KGRP(F, g, TA, TB) do { F[0] = KFR(TA, 0, 2 * (g), 0); F[1] = KFR(TB, NMAP - 1, 2 * (g), 0); F[2] = KFR(TA, 0, 2 * (g), 1); F[3] = KFR(TB, NMAP - 1, 2 * (g), 1); \
            F[4] = KFR(TA, 0, 2 * (g) + 1, 0); F[5] = KFR(TB, NMAP - 1, 2 * (g) + 1, 0); F[6] = KFR(TA, 0, 2 * (g) + 1, 1); F[7] = KFR(TB, NMAP - 1, 2 * (g) + 1, 1); } while (0)
#define QGRP(F, g) do { \
            if ((g) == 0) { const f32x16 z_ = {0.f,0.f,0.f,0.f,0.f,0.f,0.f,0.f,0.f,0.f,0.f,0.f,0.f,0.f,0.f,0.f};     \
                a0 = __builtin_amdgcn_mfma_f32_32x32x16_bf16(F[0], qr[0][0], z_, 0, 0, 0); b0 = __builtin_amdgcn_mfma_f32_32x32x16_bf16(F[1], qr[NMAP - 1][0], z_, 0, 0, 0); \
                a1 = __builtin_amdgcn_mfma_f32_32x32x16_bf16(F[2], qr[0][0], z_, 0, 0, 0); b1 = __builtin_amdgcn_mfma_f32_32x32x16_bf16(F[3], qr[NMAP - 1][0], z_, 0, 0, 0); } \
            else { a0 = __builtin_amdgcn_mfma_f32_32x32x16_bf16(F[0], qr[0][2 * (g)], a0, 0, 0, 0); b0 = __builtin_amdgcn_mfma_f32_32x32x16_bf16(F[1], qr[NMAP - 1][2 * (g)], b0, 0, 0, 0); \
                a1 = __builtin_amdgcn_mfma_f32_32x32x16_bf16(F[2], qr[0][2 * (g)], a1, 0, 0, 0); b1 = __builtin_amdgcn_mfma_f32_32x32x16_bf16(F[3], qr[NMAP - 1][2 * (g)], b1, 0, 0, 0); } \
            a0 = __builtin_amdgcn_mfma_f32_32x32x16_bf16(F[4], qr[0][2 * (g) + 1], a0, 0, 0, 0); b0 = __builtin_amdgcn_mfma_f32_32x32x16_bf16(F[5], qr[NMAP - 1][2 * (g) + 1], b0, 0, 0, 0); \
            a1 = __builtin_amdgcn_mfma_f32_32x32x16_bf16(F[6], qr[0][2 * (g) + 1], a1, 0, 0, 0); b1 = __builtin_amdgcn_mfma_f32_32x32x16_bf16(F[7], qr[NMAP - 1][2 * (g) + 1], b1, 0, 0, 0); } while (0)
#pragma unroll
        for (int pi = 0; pi < NPI; ++pi) {
            const int tA = DIFF ? pi : 0, tB = DIFF ? pi : 1;
            bf16x8 kf0[8], kf1[8];
            KGRP(kf0, 0, tA, tB); if (NG > 1) KGRP(kf1, 1, tA, tB);
            __builtin_amdgcn_sched_barrier(0);
            PACKP();
            __builtin_amdgcn_sched_barrier(0);
            QGRP(kf0, 0);
            if (NG > 1) { __builtin_amdgcn_sched_barrier(0); KGRP(kf0, 2, tA, tB); __builtin_amdgcn_sched_barrier(0); QGRP(kf1, 1); QGRP(kf0, 2); }
            __builtin_amdgcn_sched_barrier(0);
            if (pi == 0) STEP3_PV(vbp, TLA, TLB);
            else STEP3_PV(vb, pi - 1, pi - 1);
        }
#undef KFR
#undef KGRP
#undef QGRP
        vbp = vb; vslot = vnext;
    }
    { PACKP();
      __builtin_amdgcn_sched_barrier(0);
      VREAD(0, vbp, TLA, TLB)
      VREAD(1, vbp, TLA, TLB)
      VWAIT();
      PVM(0, 0); PVM(0, 1); PVM(0, 2); PVM(0, 3); PVM(0, 4); PVM(0, 5); PVM(0, 6); PVM(0, 7);
      PVM(1, 0); PVM(1, 1); PVM(1, 2); PVM(1, 3); PVM(1, 4); PVM(1, 5); PVM(1, 6); PVM(1, 7); }
#undef STEP3_PV
#undef PVM
#undef VWAIT
#undef VREAD
#undef CHUNK
#undef CHK
#undef PACKP
#undef PK4
#undef PKV
#undef ADMA
    const int tide = mk_tid(c.wid), lanee = tide & 63, r32e = lanee & 31, hie = lanee >> 5;
    { auto rr = __builtin_amdgcn_permlane32_swap(__float_as_uint(lsA), __float_as_uint(lsA), false, false); lsA = __uint_as_float(rr[0]) + __uint_as_float(rr[1]); }
    { auto rr = __builtin_amdgcn_permlane32_swap(__float_as_uint(lsB), __float_as_uint(lsB), false, false); lsB = __uint_as_float(rr[0]) + __uint_as_float(rr[1]); }
    if (DIFF) { l_reg[0] = lsA; l_reg[NMAP - 1] = lsB; } else l_reg[0] = lsA + lsB;
    float rli[NMAP][16];
#pragma unroll
    for (int m = 0; m < NMAP; ++m) {
        asm volatile("s_waitcnt lgkmcnt(0)" ::: "memory");
        if (hie == 0) wsl[r32e] = l_reg[m];
        asm volatile("s_waitcnt lgkmcnt(0)" ::: "memory");
#pragma unroll
        for (int r = 0; r < 16; ++r) rli[m][r] = __builtin_amdgcn_rcpf(wsl[crow(r, hie)]);
    }
    const int orow0 = qrow0 + wid * 32;
    if (!DIFF) {
#pragma unroll
        for (int r = 0; r < 16; ++r) { bf16_t* dst = C_HB + (size_t)(orow0 + crow(r, hie)) * D + 512 + hd * 64 + r32e;
            dst[0] = f2bf(o[0][0][r] * rli[0][r]); dst[32] = f2bf(o[0][1][r] * rli[0][r]); }
    } else {
        const float* lp = CIN(19) + l * 128; const float* gn = CIN(20) + l * 64; asm volatile("" : "+s"(lp), "+s"(gn));
        float s1 = lp[r32e] * lp[32 + r32e], s2 = lp[64 + r32e] * lp[96 + r32e];
#pragma unroll
        for (int o = 1; o < 32; o <<= 1) { s1 += shx(s1, o, lanee); s2 += shx(s2, o, lanee); }
        const float lam_init = (l == 0) ? 0.2f : 0.35550906759097f;
        const float lam = __expf(s1) - __expf(s2) + lam_init;
        const float g0 = gn[r32e] * (1.f - lam_init), g1 = gn[32 + r32e] * (1.f - lam_init);
#pragma unroll
        for (int r = 0; r < 16; ++r) {
            const float v0 = o[0][0][r] * rli[0][r] - lam * o[NMAP - 1][0][r] * rli[NMAP - 1][r];
            const float v1 = o[0][1][r] * rli[0][r] - lam * o[NMAP - 1][1][r] * rli[NMAP - 1][r];
            float ss = v0 * v0 + v1 * v1;
            ss += shx(ss, 1, lanee); ss += shx(ss, 2, lanee); ss += shx(ss, 4, lanee); ss += shx(ss, 8, lanee); ss += shx(ss, 16, lanee);
            const float rstd = rsqrtf(ss * (1.f / 64.f) + NORM_EPS);
            bf16_t* dst = C_HB + (size_t)(orow0 + crow(r, hie)) * D + 768 + hd * 64 + r32e;
            dst[0] = f2bf(v0 * rstd * g0); dst[32] = f2bf(v1 * rstd * g1); }
    }
    int* flag = (int*)(lds + 65536 + 49152 + 8 * 64 * 4);
    __syncthreads();
    if (tide == 0) *flag = 0;
    __syncthreads();
    if (!(l_reg[0] <= ATT_ZBIG && l_reg[0] >= ATT_ZSMALL) || !(l_reg[NMAP - 1] <= ATT_ZBIG && l_reg[NMAP - 1] >= ATT_ZSMALL)) *flag = 1;
    __syncthreads();
    const bool redo = *flag != 0;
    __syncthreads();
    return redo;
}
__device__ void ph_attn(const Ctx& c, int l, char* lds) {
    const bool need_ctx = (l < DEPTH - 1);
    const int nitem = 1024 + (need_ctx ? 32 : 0);
    for (int it = blockIdx.x; it < nitem; it += gridDim.x) {
        bool diff; int b, hd, q0, k0, nk;
        if (it < 1024) { const int combo = ((it >> 8) << 3) | (it & 7), qt = (it >> 3) & 31; diff = combo < 16; b = (combo >> 2) & 3; hd = combo & 3; q0 = b * RPB + CTX + qt * 256; k0 = b * RPB; nk = RPB; }
        else { const int u = it - 1024; diff = u < 16; b = u & 3; hd = (u >> 2) & 3; q0 = b * RPB; k0 = b * RPB; nk = CTX; }
        if (diff) { if (attn_item_pair<true>(c, l, b, hd, q0, k0, nk, lds)) attn_item<true>(c, l, b, hd, q0, k0, nk, lds); }
        else { if (attn_item_pair<false>(c, l, b, hd, q0, k0, nk, lds)) attn_item<false>(c, l, b, hd, q0, k0, nk, lds); }
    }
}

typedef float f32v2 __attribute__((ext_vector_type(2)));
__device__ void cvt_tables(const Ctx& c, int l) {
    for (int row = blockIdx.x * 8 + c.wid; row < 2 * NEXP; row += gridDim.x * 8) {
        const bool isu = row < NEXP; const int e = isu ? row : row - NEXP;
        const float* s = CIN(isu ? 23 : 24) + ((size_t)l * NEXP + e) * D + c.lane * 16;
        f32x4 v[4]; float mx = 0.f;
#pragma unroll
        for (int i = 0; i < 4; ++i) { v[i] = *(const f32x4*)(s + 4 * i); mx = fmaxf(mx, fmaxf(fmaxf(fabsf(v[i][0]), fabsf(v[i][1])), fmaxf(fabsf(v[i][2]), fabsf(v[i][3])))); }
#pragma unroll
        for (int o = 32; o >= 1; o >>= 1) mx = fmaxf(mx, __shfl_xor(mx, o, 64));
        const float q = mx > 0.f ? 256.f / mx : 0.f;
        if (c.lane == 0) (isu ? C_SU : C_SV)[e] = mx * (1.f / 256.f);
        u32x4 w;
#pragma unroll
        for (int i = 0; i < 4; ++i) { int p = 0; p = __builtin_amdgcn_cvt_pk_fp8_f32(v[i][0] * q, v[i][1] * q, p, false); p = __builtin_amdgcn_cvt_pk_fp8_f32(v[i][2] * q, v[i][3] * q, p, true); w[i] = (unsigned)p; }
        *(u32x4*)((isu ? C_TU8 : C_TV8) + ((size_t)(c.lane >> 3) * NEXP + e) * 128 + (c.lane & 7) * 16) = w;
    }
}
__device__ __forceinline__ unsigned ford(float x) { const unsigned u = __float_as_uint(x); return (u & 0x80000000u) ? ~u : (u | 0x80000000u); }
__device__ __forceinline__ float funord(unsigned k) { const unsigned u = (k & 0x80000000u) ? (k & 0x7fffffffu) : ~k; return __uint_as_float(u); }
__device__ __forceinline__ void sort16_desc(unsigned (&v)[16]) {
#pragma unroll
    for (int k = 2; k <= 16; k <<= 1)
#pragma unroll
        for (int j = k >> 1; j > 0; j >>= 1)
#pragma unroll
            for (int i = 0; i < 16; ++i) { const int l = i ^ j; if (l > i) { const unsigned a = v[i], b = v[l]; const unsigned hi = max(a, b), lo = min(a, b);
                if ((i & k) == 0) { v[i] = hi; v[l] = lo; } else { v[i] = lo; v[l] = hi; } } }
}
__device__ __forceinline__ void merge16_desc(unsigned (&t)[16], const unsigned (&v)[16]) {
#pragma unroll
    for (int i = 0; i < 16; ++i) t[i] = max(t[i], v[15 - i]);
#pragma unroll
    for (int j = 8; j > 0; j >>= 1)
#pragma unroll
        for (int i = 0; i < 16; ++i) { const int l = i ^ j; if (l > i) { const unsigned a = t[i], b = t[l]; t[i] = max(a, b); t[l] = min(a, b); } }
}
constexpr int TOPK_LDS = 2 * 128 * 129 * 4;
__device__ void peer_topk_item(const Ctx& c, int l, int tm, int h, char* lds) {
    float* S = (float*)lds;
    const int tid = c.tid, lane = c.lane, wid = c.wid, r32 = lane & 31, hi = lane >> 5, wm = wid >> 1, wn = wid & 1;
    const int row0 = tm * 128;
    bf16x8 fa[2][8];
#pragma unroll
    for (int p = 0; p < 2; ++p) { const bf16_t* Ap = C_Q2 + (size_t)(row0 + wm * 32 + r32) * 2048 + h * 256 + p * 128 + hi * 8;
#pragma unroll
        for (int ks = 0; ks < 8; ++ks) fa[p][ks] = *(const bf16x8*)(Ap + ks * 16); }
#pragma unroll
    for (int p = 0; p < 2; ++p) {
        f32x16 acc[2];
        zero_acc(acc[0]); zero_acc(acc[1]);
        const bf16_t* Bp = C_KEYS + ((((size_t)l * 8 + h) * 2 + p) * 128 + wn * 64 + r32) * 128 + hi * 8;
        bf16x8 fb0[8], fb1[8];
#pragma unroll
        for (int ks = 0; ks < 8; ++ks) { fb0[ks] = *(const bf16x8*)(Bp + ks * 16); fb1[ks] = *(const bf16x8*)(Bp + 32 * 128 + ks * 16); }
        asm volatile("" : "+v"(fa[p][0]), "+v"(fa[p][1]), "+v"(fa[p][2]), "+v"(fa[p][3]), "+v"(fa[p][4]), "+v"(fa[p][5]), "+v"(fa[p][6]), "+v"(fa[p][7]));
        asm volatile("" : "+v"(fb0[0]), "+v"(fb0[1]), "+v"(fb0[2]), "+v"(fb0[3]), "+v"(fb0[4]), "+v"(fb0[5]), "+v"(fb0[6]), "+v"(fb0[7]));
        asm volatile("" : "+v"(fb1[0]), "+v"(fb1[1]), "+v"(fb1[2]), "+v"(fb1[3]), "+v"(fb1[4]), "+v"(fb1[5]), "+v"(fb1[6]), "+v"(fb1[7]));
#pragma unroll
        for (int ks = 0; ks < 8; ++ks) {
            acc[0] = __builtin_amdgcn_mfma_f32_32x32x16_bf16(fa[p][ks], fb0[ks], acc[0], 0, 0, 0);
            acc[1] = __builtin_amdgcn_mfma_f32_32x32x16_bf16(fa[p][ks], fb1[ks], acc[1], 0, 0, 0);
        }
#pragma unroll
        for (int n = 0; n < 2; ++n)
#pragma unroll
            for (int r = 0; r < 16; ++r) S[(p * 128 + wm * 32 + crow(r, hi)) * 129 + wn * 64 + n * 32 + r32] = acc[n][r];
    }
    __syncthreads();
    unsigned tk[16];
    { const int list = tid >> 1, half = tid & 1; const float* sr = S + list * 129 + half * 64;
#pragma unroll
        for (int g = 0; g < 4; ++g) { unsigned v[16];
#pragma unroll
            for (int i = 0; i < 16; ++i) { const int n = half * 64 + g * 16 + i; v[i] = (ford(sr[g * 16 + i]) & ~127u) | (unsigned)(127 - n); }
            sort16_desc(v);
            if (g == 0) {
#pragma unroll
                for (int i = 0; i < 16; ++i) tk[i] = v[i]; }
            else merge16_desc(tk, v); } }
    __syncthreads();
    unsigned* X = (unsigned*)lds;
    unsigned* L = X + 256 * 17;
    if (tid & 1) {
#pragma unroll
        for (int i = 0; i < 16; ++i) X[(tid >> 1) * 17 + i] = tk[i]; }
    __syncthreads();
    if (!(tid & 1)) { unsigned v[16];
#pragma unroll
        for (int i = 0; i < 16; ++i) v[i] = X[(tid >> 1) * 17 + i];
        merge16_desc(tk, v);
#pragma unroll
        for (int i = 0; i < 16; ++i) L[(tid >> 1) * 17 + i] = tk[i]; }
    __syncthreads();
    unsigned bk[16];
    const int row = (tid >> 1) & 127, hh = tid & 1;
    const unsigned* l0 = L + row * 17; const unsigned* l1 = L + (128 + row) * 17;
    if (tid < 256) {
        float s0[8], s1[16];
#pragma unroll
        for (int ii = 0; ii < 8; ++ii) s0[ii] = funord(l0[2 * ii + hh] & ~127u);
#pragma unroll
        for (int j = 0; j < 16; ++j) s1[j] = funord(l1[j] & ~127u);
        unsigned ck[32];
        { int slot = 0;
#pragma unroll
            for (int ii = 0; ii < 8; ++ii)
#pragma unroll
                for (int j = 0; j < 16; ++j) if ((2 * ii + 1) * (j + 1) <= 16) {
                    const int i = 2 * ii + hh; const bool ok = (i + 1) * (j + 1) <= 16;
                    const unsigned key = (ford(s0[ii] + s1[j]) & ~255u) | (unsigned)(255 - (i * 16 + j));
                    ck[slot] = ok ? key : 0u; ++slot; }
#pragma unroll
            for (; slot < 32; ++slot) ck[slot] = 0u; }
        unsigned v0[16], v1[16];
#pragma unroll
        for (int i = 0; i < 16; ++i) { v0[i] = ck[i]; v1[i] = ck[16 + i]; }
        sort16_desc(v0); sort16_desc(v1);
        merge16_desc(v0, v1);
#pragma unroll
        for (int i = 0; i < 16; ++i) bk[i] = v0[i];
    }
    __syncthreads();
    if (tid < 256 && hh) {
#pragma unroll
        for (int i = 0; i < 16; ++i) X[row * 17 + i] = bk[i]; }
    __syncthreads();
    if (tid < 256 && !hh) { unsigned v[16];
#pragma unroll
        for (int i = 0; i < 16; ++i) v[i] = X[row * 17 + i];
        merge16_desc(bk, v);
        float best[16]; int eid[16]; float mx = -1e30f;
#pragma unroll
        for (int q = 0; q < 16; ++q) { const int ij = 255 - (int)(bk[q] & 255u); const int i = ij >> 4, j = ij & 15;
            const unsigned k0 = l0[i], k1 = l1[j];
            best[q] = funord(k0 & ~127u) + funord(k1 & ~127u);
            eid[q] = (127 - (int)(k0 & 127u)) * 128 + (127 - (int)(k1 & 127u));
            mx = fmaxf(mx, best[q]); }
        float sum = 0.f;
#pragma unroll
        for (int q = 0; q < 16; ++q) { best[q] = __expf(best[q] - mx); sum += best[q]; }
        const float inv = 1.f / sum;
        const size_t o = (size_t)(row0 + row) * 128 + h * 16;
#pragma unroll
        for (int q = 0; q < 16; q += 4) { *(u32x4*)(C_EI + o + q) = (u32x4){(unsigned)eid[q], (unsigned)eid[q + 1], (unsigned)eid[q + 2], (unsigned)eid[q + 3]};
            *(f32x4*)(C_EG + o + q) = (f32x4){best[q] * inv, best[q + 1] * inv, best[q + 2] * inv, best[q + 3] * inv}; }
    }
    __syncthreads();
}
__device__ __forceinline__ float gelu_tanh(float x) { const float u = 0.7978845608028654f * (x + 0.044715f * x * x * x); const float t = 1.f - 2.f / (1.f + __expf(2.f * u)); return 0.5f * x * (1.f + t); }
__device__ __forceinline__ int tok_row(int ti, bool need_ctx) { return need_ctx ? ti : (ti >> 13) * RPB + CTX + (ti & 8191); }
struct PeerTok { u32x4 t[16]; u32x4 xa, xb; f32v2 xv, gv; };
__device__ __forceinline__ void peer_issue(PeerTok& T, const unsigned char* t8, const int* el, const bf16_t* xp, int grp, bool want_x) {
#pragma unroll
    for (int u = 0; u < 16; ++u) { const int e = el[u * 8 + grp]; T.t[u] = *(const u32x4*)(t8 + (size_t)e * 128); }
    if (want_x) { T.xa = *(const u32x4*)xp; T.xb = *(const u32x4*)(xp + 8); }
}
__device__ __forceinline__ void peer_u_compute(const PeerTok& T, float* pp, int sub, int grp, int lane) {
    f32v2 x2[8];
#pragma unroll
    for (int q = 0; q < 4; ++q) { x2[q] = (f32v2){bflo(T.xa[q]), bfhi(T.xa[q])}; x2[4 + q] = (f32v2){bflo(T.xb[q]), bfhi(T.xb[q])}; }
    float keep[2];
#pragma unroll
    for (int hf = 0; hf < 2; ++hf) {
        float a[8];
#pragma unroll
        for (int u = 0; u < 8; ++u) { f32v2 s2 = {0.f, 0.f};
#pragma unroll
            for (int q = 0; q < 4; ++q) { const unsigned w = T.t[hf * 8 + u][q];
                s2 = __builtin_elementwise_fma(__builtin_amdgcn_cvt_pk_f32_fp8(w, false), x2[2 * q], s2);
                s2 = __builtin_elementwise_fma(__builtin_amdgcn_cvt_pk_f32_fp8(w, true), x2[2 * q + 1], s2); }
            a[u] = s2[0] + s2[1]; }
        const bool b2 = (lane & 4) != 0, b1 = (lane & 2) != 0, b0 = (lane & 1) != 0;
        float r4[4], r2[2];
#pragma unroll
        for (int q = 0; q < 4; ++q) { const float mine = b2 ? a[4 + q] : a[q], oth = b2 ? a[q] : a[4 + q]; r4[q] = mine + __shfl_xor(oth, 4, 64); }
#pragma unroll
        for (int q = 0; q < 2; ++q) { const float mine = b1 ? r4[2 + q] : r4[q], oth = b1 ? r4[q] : r4[2 + q]; r2[q] = mine + __shfl_xor(oth, 2, 64); }
        { const float mine = b0 ? r2[1] : r2[0], oth = b0 ? r2[0] : r2[1]; keep[hf] = mine + __shfl_xor(oth, 1, 64); }
    }
    pp[sub * 8 + grp] = keep[0]; pp[(8 + sub) * 8 + grp] = keep[1];
}
__device__ void peer_u_item(const Ctx& c, int l, int j, int tb, char* lds) {
    const bool need_ctx = (l < DEPTH - 1);
    int* el = (int*)lds + c.wid * 256;
    const int lane = c.lane, sub = lane & 7, grp = lane >> 3;
    const unsigned char* t8 = C_TU8 + (size_t)j * NEXP * 128 + sub * 16;
    const int tok0 = tb * 128 + c.wid * 16;
    const int xoff = j * 128 + sub * 16;
    PeerTok A, B;
    int e0, e1;
    { const int r = tok_row(tok0, need_ctx); e0 = C_EI[(size_t)r * 128 + lane]; e1 = C_EI[(size_t)r * 128 + 64 + lane];
      el[lane] = e0; el[64 + lane] = e1;
      peer_issue(A, t8, el, C_HB + (size_t)r * D + xoff, grp, true);
      const int r1 = tok_row(tok0 + 1, need_ctx); e0 = C_EI[(size_t)r1 * 128 + lane]; e1 = C_EI[(size_t)r1 * 128 + 64 + lane]; }
#pragma unroll 1
    for (int k = 0; k < 16; k += 2) {
        { const int r1 = tok_row(tok0 + k + 1, need_ctx); el[128 + lane] = e0; el[192 + lane] = e1;
          peer_issue(B, t8, el + 128, C_HB + (size_t)r1 * D + xoff, grp, true);
          if (k + 2 < 16) { const int r2 = tok_row(tok0 + k + 2, need_ctx); e0 = C_EI[(size_t)r2 * 128 + lane]; e1 = C_EI[(size_t)r2 * 128 + 64 + lane]; } }
        peer_u_compute(A, C_PART + ((size_t)j * NR + tok_row(tok0 + k, need_ctx)) * 128, sub, grp, lane);
        if (k + 2 < 16) { const int r2 = tok_row(tok0 + k + 2, need_ctx); el[lane] = e0; el[64 + lane] = e1;
          peer_issue(A, t8, el, C_HB + (size_t)r2 * D + xoff, grp, true);
          if (k + 3 < 16) { const int r3 = tok_row(tok0 + k + 3, need_ctx); e0 = C_EI[(size_t)r3 * 128 + lane]; e1 = C_EI[(size_t)r3 * 128 + 64 + lane]; } }
        peer_u_compute(B, C_PART + ((size_t)j * NR + tok_row(tok0 + k + 1, need_ctx)) * 128, sub, grp, lane);
    }
}
__device__ void ph_peer_combine(const Ctx& c, int l) {
    const bool need_ctx = (l < DEPTH - 1);
    const int ntok = need_ctx ? NR : NB * SEQ;
    for (int ti = blockIdx.x * 8 + c.wid; ti < ntok; ti += gridDim.x * 8) {
        const int r = tok_row(ti, need_ctx);
#pragma unroll
        for (int hf = 0; hf < 2; ++hf) { const size_t o = (size_t)r * 128 + hf * 64 + c.lane;
            const int e = C_EI[o]; float sacc = 0.f;
#pragma unroll
            for (int jj = 0; jj < 8; ++jj) sacc += C_PART[((size_t)jj * NR + r) * 128 + hf * 64 + c.lane];
            C_EG[o] = C_EG[o] * gelu_tanh(sacc * C_SU[e]) * C_SV[e]; }
    }
}
__device__ __forceinline__ void peer_v_compute(const PeerTok& T, const float* wl, float* xo, int grp, int lane) {
    f32v2 acc[8];
#pragma unroll
    for (int q = 0; q < 8; ++q) acc[q] = (f32v2){0.f, 0.f};
#pragma unroll
    for (int u = 0; u < 16; ++u) { const float wv = wl[u * 8 + grp]; const f32v2 w2 = {wv, wv};
#pragma unroll
        for (int q = 0; q < 4; ++q) { const unsigned w = T.t[u][q];
            acc[2 * q] = __builtin_elementwise_fma(__builtin_amdgcn_cvt_pk_f32_fp8(w, false), w2, acc[2 * q]);
            acc[2 * q + 1] = __builtin_elementwise_fma(__builtin_amdgcn_cvt_pk_f32_fp8(w, true), w2, acc[2 * q + 1]); } }
    const bool b5 = (lane & 32) != 0, b4 = (lane & 16) != 0, b3 = (lane & 8) != 0;
    f32v2 r4[4], r2[2], r1;
#pragma unroll
    for (int q = 0; q < 4; ++q) { const f32v2 mine = b5 ? acc[4 + q] : acc[q], oth = b5 ? acc[q] : acc[4 + q];
        r4[q] = (f32v2){mine[0] + __shfl_xor(oth[0], 32, 64), mine[1] + __shfl_xor(oth[1], 32, 64)}; }
#pragma unroll
    for (int q = 0; q < 2; ++q) { const f32v2 mine = b4 ? r4[2 + q] : r4[q], oth = b4 ? r4[q] : r4[2 + q];
        r2[q] = (f32v2){mine[0] + __shfl_xor(oth[0], 16, 64), mine[1] + __shfl_xor(oth[1], 16, 64)}; }
    { const f32v2 mine = b3 ? r2[1] : r2[0], oth = b3 ? r2[0] : r2[1]; r1 = (f32v2){mine[0] + __shfl_xor(oth[0], 8, 64), mine[1] + __shfl_xor(oth[1], 8, 64)}; }
    f32v2 xv = T.xv; const f32v2 gv = T.gv;
    xv[0] += gv[0] * r1[0]; xv[1] += gv[1] * r1[1];
    *(f32v2*)xo = xv;
}
__device__ void peer_v_item(const Ctx& c, int l, int j, int tb, char* lds) {
    const bool need_ctx = (l < DEPTH - 1);
    int* el = (int*)lds + c.wid * 512; float* wl = (float*)(el + 256);
    const int lane = c.lane, sub = lane & 7, grp = lane >> 3;
    const unsigned char* t8 = C_TV8 + (size_t)j * NEXP * 128 + sub * 16;
    const int tok0 = tb * 128 + c.wid * 16;
    const int col = j * 128 + sub * 16 + ((lane & 32) ? 8 : 0) + ((lane & 16) ? 4 : 0) + ((lane & 8) ? 2 : 0);
    const float* gate5 = C_MODT + (size_t)l * 5 * 6144 + 5 * D + col;
    PeerTok A, B;
    int e0, e1; float w0, w1;
#define VISSUE(T, tok, eoff) do { const int r_ = tok_row((tok), need_ctx); const int b_ = r_ / RPB; const bool ctx_ = (r_ - b_ * RPB) < CTX; \
        peer_issue(T, t8, el + (eoff), nullptr, grp, false); T.xv = *(const f32v2*)(xrow(c, r_) + col); T.gv = *(const f32v2*)(gate5 + (size_t)(ctx_ ? 4 : b_) * 6144); } while (0)
#define VFETCH(tok) do { const int r_ = tok_row((tok), need_ctx); e0 = C_EI[(size_t)r_ * 128 + lane]; e1 = C_EI[(size_t)r_ * 128 + 64 + lane]; w0 = C_EG[(size_t)r_ * 128 + lane]; w1 = C_EG[(size_t)r_ * 128 + 64 + lane]; } while (0)
    VFETCH(tok0);
    el[lane] = e0; el[64 + lane] = e1; wl[lane] = w0; wl[64 + lane] = w1;
    VISSUE(A, tok0, 0);
    VFETCH(tok0 + 1);
#pragma unroll 1
    for (int k = 0; k < 16; k += 2) {
        el[128 + lane] = e0; el[192 + lane] = e1; wl[128 + lane] = w0; wl[192 + lane] = w1;
        VISSUE(B, tok0 + k + 1, 128);
        if (k + 2 < 16) VFETCH(tok0 + k + 2);
        peer_v_compute(A, wl, xrow(c, tok_row(tok0 + k, need_ctx)) + col, grp, lane);
        if (k + 2 < 16) { el[lane] = e0; el[64 + lane] = e1; wl[lane] = w0; wl[64 + lane] = w1;
          VISSUE(A, tok0 + k + 2, 0);
          if (k + 3 < 16) VFETCH(tok0 + k + 3); }
        peer_v_compute(B, wl + 128, xrow(c, tok_row(tok0 + k + 1, need_ctx)) + col, grp, lane);
    }
#undef VISSUE
#undef VFETCH
}
template <int SUB>
__device__ void ph_peer_expert(const Ctx& c, int l, char* lds) {
    const bool need_ctx = (l < DEPTH - 1);
    unsigned* cnt = (unsigned*)CWS(WS_CTL) + 4096 + ((l * 2 + SUB) * 8) * 64;
    const int nitem = (need_ctx ? NR : NB * SEQ) / 128;
    const int x = (int)(xb_xcc_id() & 7u);
    volatile int* sh = (volatile int*)(lds + 16384);
    for (int jo = 0; jo < 8; ++jo) { const int j = (x + jo) & 7;
        int nxt = 0;
        if (c.tid == 0) nxt = (int)__hip_atomic_fetch_add(&cnt[j * 64], 1u, __ATOMIC_RELAXED, __HIP_MEMORY_SCOPE_AGENT);
        for (;;) {
            if (c.tid == 0) *sh = nxt;
            __syncthreads(); const int it = *sh; __syncthreads();
            if (it >= nitem) break;
            if (c.tid == 0) nxt = (int)__hip_atomic_fetch_add(&cnt[j * 64], 1u, __ATOMIC_RELAXED, __HIP_MEMORY_SCOPE_AGENT);
            if (SUB == 0) peer_u_item(c, l, j, it, lds); else peer_v_item(c, l, j, it, lds);
        }
    }
}
__device__ void ph_final(const Ctx& c) {
    const float* g = CIN(25);
    const int stride = gridDim.x * 8;
    int r = blockIdx.x * 8 + c.wid;
    f32x4 xn[4];
    if (r < NB * SEQ) { const float* src = COUT + ((size_t)r << 10);
#pragma unroll
        for (int i = 0; i < 4; ++i) xn[i] = *(const f32x4*)(src + i * 256 + c.lane * 4); }
    for (; r < NB * SEQ; r += stride) {
        float* xr = COUT + ((size_t)r << 10);
        f32x4 x[4]; float ss = 0.f;
#pragma unroll
        for (int i = 0; i < 4; ++i) { x[i] = xn[i]; ss += x[i][0] * x[i][0] + x[i][1] * x[i][1] + x[i][2] * x[i][2] + x[i][3] * x[i][3]; }
        if (r + stride < NB * SEQ) { const float* src = COUT + ((size_t)(r + stride) << 10);
#pragma unroll
            for (int i = 0; i < 4; ++i) xn[i] = *(const f32x4*)(src + i * 256 + c.lane * 4); }
        ss = wave_sum(ss); const float rstd = rsqrtf(ss * (1.f / D) + NORM_EPS);
#pragma unroll
        for (int i = 0; i < 4; ++i) { const int col = i * 256 + c.lane * 4; const f32x4 gv = *(const f32x4*)(g + col); f32x4 y;
#pragma unroll
            for (int e = 0; e < 4; ++e) y[e] = x[i][e] * rstd * gv[e];
            *(f32x4*)(xr + col) = y; }
    }
}

namespace pg8 {
#define PG8_LAS __attribute__((address_space(3)))
typedef unsigned short bf16_t;
typedef short bf16x8 __attribute__((ext_vector_type(8)));
typedef float f32x4 __attribute__((ext_vector_type(4)));
typedef unsigned u32x4 __attribute__((ext_vector_type(4)));
constexpr int BM = 256, BK = 64, HALF = 128, HTB = HALF * BK * 2  , STAGE_BYTES = 8 * HTB, NXCD = 8, WGM = 8;

__host__ __device__ __forceinline__ int lds_byte(int r, int c) { const int st = (r >> 4) * 2 + (c >> 5), rr = r & 15, cc = c & 31, ob = rr * 64 + cc * 2; return st * 1024 + (ob ^ (((ob >> 9) & 1) << 5)); }
__host__ __device__ __forceinline__ void stage_rc(int b, int& R, int& C) { const int st = b / 1024, sb = b % 1024, swz = sb ^ (((sb >> 9) & 1) << 5); R = (st >> 1) * 16 + swz / 64; C = (st & 1) * 32 + (swz % 64) / 2; }
__host__ __device__ __forceinline__ int perm32(int rho) { const int n = rho >> 4, i = rho & 15; return 8 * (i >> 2) + 4 * n + (i & 3); }

struct Unit { int pm, pn; };
struct Gemm { const bf16_t* A; const bf16_t* Bt; int M, N, K; };
struct TileOrder {
    int nM, nN, nwg, G, c; bool skip_ctx;
    __device__ void init(int nM_, int nN_, int G_, int c_, bool skip) { nM = nM_; nN = nN_; nwg = nM_ * nN_; G = G_; c = c_; skip_ctx = skip; }
    __device__ bool next(int i, Unit& u) const {
        const long L = (long)i * G + c; if (L >= nwg) return false;
        int wgid = (int)L; { const int q = nwg / NXCD, r = nwg % NXCD, xcd = wgid % NXCD, off = wgid / NXCD; wgid = (xcd < r ? xcd * (q + 1) : r * (q + 1) + (xcd - r) * q) + off; }
        const int nig = WGM * nN, gid = wgid / nig, fm = gid * WGM, gsz = (nM - fm) < WGM ? (nM - fm) : WGM;
        int pm = fm + ((wgid % nig) % gsz); u.pn = (wgid % nig) / gsz;
        if (skip_ctx) pm = 33 * (pm >> 5) + 1 + (pm & 31);
        u.pm = pm; return true;
    }
    __device__ __forceinline__ void a_ready(const Unit&) const {}
    __device__ __forceinline__ void done(const Unit&) const {}
};
template <class Epi, class Sched, bool STAMP = false>
__device__ __forceinline__ void gemm_phase(PG8_LAS unsigned char* lds, const Gemm g, const Sched& S, const Epi& E, unsigned long long* stamps, int w0) {
    const int tid = mk_tid(w0), wid = w0, lane = tid & 63, wr = wid >> 2, wc = wid & 3, fr = lane & 15, fq = lane >> 4;
    const int K = g.K, nt = K / BK;
    int ts_lo = 0, ts_hi = 0, nts = 0; const unsigned long long rt_entry = STAMP ? (unsigned long long)wall_clock64() : 0ull;
#define PG8_STAMP() do { if (STAMP && wid == 0 && nts < 64) { const unsigned long long _c = (unsigned long long)clock64(); \
        ts_lo = (lane == nts) ? (int)(unsigned)_c : ts_lo; ts_hi = (lane == nts) ? (int)(unsigned)(_c >> 32) : ts_hi; ++nts; } } while (0)
    PG8_STAMP();
    unsigned voffA[2], voffB[2];
#pragma unroll
    for (int i = 0; i < 2; ++i) { int R, C; stage_rc(tid * 16 + i * 8192, R, C); const int Rb = Epi::PERM ? ((R & ~31) + perm32(R & 31)) : R;
        voffA[i] = (unsigned)(R * K + C) * 2u; voffB[i] = (unsigned)(Rb * K + C) * 2u; }
    const size_t kstep = (size_t)(BK * 2);
    const size_t hstep = (size_t)HALF * K * 2;
    const size_t tstep = 2 * hstep;
    const unsigned ldsw = (unsigned)wid * 1024u;
    const int aoff = lds_byte(wr * 64 + fr, fq * 8), boff = lds_byte(wc * 32 + fr, fq * 8);
#define PG8_SA(b, h) (((b) * 2 + (h)) * HTB)
#define PG8_SB(b, h) ((4 + (b) * 2 + (h)) * HTB)
#define PG8_STAGE(bufoff, gbase, voff) do { _Pragma("unroll") for (int _i = 0; _i < 2; ++_i) \
        __builtin_amdgcn_global_load_lds((const unsigned*)((const char*)(gbase) + (voff)[_i]), (PG8_LAS unsigned*)(lds + (bufoff) + ldsw + _i * 8192), 16, 0, 0); } while (0)
#define PG8_LDA(dst, b, h) do { _Pragma("unroll") for (int m = 0; m < 4; ++m) _Pragma("unroll") for (int k = 0; k < 2; ++k) dst[m][k] = *(const PG8_LAS bf16x8*)(lds + PG8_SA(b, h) + aoff + m * 2048 + k * 1024); } while (0)
#define PG8_LDB(dst, b, h) do { _Pragma("unroll") for (int n = 0; n < 2; ++n) _Pragma("unroll") for (int k = 0; k < 2; ++k) dst[n][k] = *(const PG8_LAS bf16x8*)(lds + PG8_SB(b, h) + boff + n * 2048 + k * 1024); } while (0)
#define PG8_MMA(ai, bj, At, Bt) do { __builtin_amdgcn_s_setprio(1); _Pragma("unroll") for (int m = 0; m < 4; ++m) _Pragma("unroll") for (int n = 0; n < 2; ++n) _Pragma("unroll") for (int k = 0; k < 2; ++k) \
        acc[ai][bj][m][n] = __builtin_amdgcn_mfma_f32_16x16x32_bf16(Bt[n][k], At[m][k], acc[ai][bj][m][n], 0, 0, 0); __builtin_amdgcn_s_setprio(0); } while (0)
#define PG8_WAIT_V(n) asm volatile("s_waitcnt vmcnt(" #n ")" ::: "memory")
#define PG8_WAIT_L(n) asm volatile("s_waitcnt lgkmcnt(" #n ")" ::: "memory")
#define PG8_BAR __builtin_amdgcn_s_barrier()
#define PG8_SCHED __builtin_amdgcn_sched_barrier(0)
    Unit cur, nxt; int ui = 0;
    if (!S.next(0, cur)) return;
    f32x4 acc[2][2][4][2];
#pragma unroll
    for (int a = 0; a < 2; ++a)
#pragma unroll
        for (int b = 0; b < 2; ++b)
#pragma unroll
            for (int m = 0; m < 4; ++m)
#pragma unroll
                for (int n = 0; n < 2; ++n) acc[a][b][m][n] = (f32x4){0.f, 0.f, 0.f, 0.f};
    bf16x8 At[4][2], B0[2][2], B1[2][2];
    const char* cA = (const char*)g.A + (size_t)cur.pm * tstep; const char* cB = (const char*)g.Bt + (size_t)cur.pn * tstep;
    S.a_ready(cur);
    PG8_STAGE(PG8_SB(0, 0), cB, voffB); PG8_STAGE(PG8_SA(0, 0), cA, voffA); PG8_STAGE(PG8_SB(0, 1), cB + hstep, voffB); PG8_STAGE(PG8_SA(0, 1), cA + hstep, voffA);
    if (wr == 1) PG8_BAR;
    PG8_WAIT_V(4); PG8_BAR;
    PG8_STAGE(PG8_SB(1, 0), cB + kstep, voffB); PG8_STAGE(PG8_SA(1, 0), cA + kstep, voffA); PG8_STAGE(PG8_SB(1, 1), cB + hstep + kstep, voffB);
    PG8_WAIT_V(6); PG8_BAR;
    PG8_STAMP();
    for (;;) {
        const bool has_next = S.next(ui + 1, nxt);
        const char* nA = has_next ? (const char*)g.A + (size_t)nxt.pm * tstep : cA; const char* nB = has_next ? (const char*)g.Bt + (size_t)nxt.pn * tstep : cB;
        for (int t = 0; t < nt; t += 2) {
            const bool last = (t == nt - 2);
            const char* a1 = cA + (size_t)(t + 1) * kstep;
            const char* a2 = last ? nA : cA + (size_t)(t + 2) * kstep; const char* b2 = last ? nB : cB + (size_t)(t + 2) * kstep;
            const char* a3 = a2 + kstep; const char* b3 = b2 + kstep;
            if (last && has_next) S.a_ready(nxt);
            PG8_LDB(B0, 0, 0); PG8_SCHED; PG8_LDA(At, 0, 0); PG8_STAGE(PG8_SA(1, 1), a1 + hstep, voffA);
            PG8_WAIT_L(8); PG8_BAR; PG8_WAIT_L(0); PG8_MMA(0, 0, At, B0); PG8_BAR; PG8_SCHED;
            PG8_LDB(B1, 0, 1); PG8_STAGE(PG8_SB(0, 0), b2, voffB);
            PG8_BAR; PG8_WAIT_L(0); PG8_MMA(0, 1, At, B1); PG8_BAR;
            PG8_LDA(At, 0, 1); PG8_STAGE(PG8_SA(0, 0), a2, voffA);
            PG8_BAR; PG8_WAIT_L(0); PG8_MMA(1, 0, At, B0); PG8_BAR; PG8_SCHED;
            PG8_STAGE(PG8_SB(0, 1), b2 + hstep, voffB);
            PG8_WAIT_V(6); PG8_BAR; PG8_MMA(1, 1, At, B1); PG8_BAR;
            PG8_LDB(B0, 1, 0); PG8_SCHED; PG8_LDA(At, 1, 0); PG8_STAGE(PG8_SA(0, 1), a2 + hstep, voffA);
            PG8_WAIT_L(8); PG8_BAR; PG8_WAIT_L(0); PG8_MMA(0, 0, At, B0); PG8_BAR; PG8_SCHED;
            PG8_LDB(B1, 1, 1); PG8_STAGE(PG8_SB(1, 0), b3, voffB);
            PG8_BAR; PG8_WAIT_L(0); PG8_MMA(0, 1, At, B1); PG8_BAR;
            PG8_LDA(At, 1, 1); PG8_STAGE(PG8_SA(1, 0), a3, voffA);
            PG8_BAR; PG8_WAIT_L(0); PG8_MMA(1, 0, At, B0); PG8_BAR; PG8_SCHED;
            PG8_STAGE(PG8_SB(1, 1), b3 + hstep, voffB);
            PG8_WAIT_V(6); PG8_BAR; PG8_MMA(1, 1, At, B1); PG8_BAR;
        }
        PG8_STAMP();
        if constexpr (!Epi::AFTER_DRAIN) { E(acc, cur, wr, wc, fr, fq); S.done(cur); }
        PG8_STAMP();
        if (!has_next) break;
#pragma unroll
        for (int a = 0; a < 2; ++a)
#pragma unroll
            for (int b = 0; b < 2; ++b)
#pragma unroll
                for (int m = 0; m < 4; ++m)
#pragma unroll
                    for (int n = 0; n < 2; ++n) acc[a][b][m][n] = (f32x4){0.f, 0.f, 0.f, 0.f};
        cur = nxt; cA = nA; cB = nB; ++ui;
    }
    PG8_WAIT_V(0);
    if (wr == 0) PG8_BAR;
    PG8_BAR;
    if constexpr (Epi::AFTER_DRAIN) { E.fused(acc, cur, wr, wc, fr, fq, lds, wid, lane); S.done(cur); }
    PG8_STAMP();
    if (STAMP && wid == 0) { stamps[lane] = lane < nts ? (((unsigned long long)(unsigned)ts_hi << 32) | (unsigned)ts_lo) : 0ull;
        if (lane == 62) stamps[62] = rt_entry; if (lane == 63) stamps[63] = (unsigned long long)wall_clock64(); }
#undef PG8_STAMP
#undef PG8_SA
#undef PG8_SB
#undef PG8_STAGE
#undef PG8_LDA
#undef PG8_LDB
#undef PG8_MMA
#undef PG8_WAIT_V
#undef PG8_WAIT_L
#undef PG8_BAR
#undef PG8_SCHED
}

struct EpiStoreBf16 {
    static constexpr bool PERM = true, AFTER_DRAIN = false;
    bf16_t* O; int ldc; int ncols; int slo, shi; float scale;
    __device__ __forceinline__ void operator()(const f32x4 (&acc)[2][2][4][2], const Unit& u, int wr, int wc, int fr, int fq) const {
        const int row0 = u.pm * BM + wr * 64 + fr, col0 = u.pn * BM + wc * 32 + 8 * fq;
        float sc[2];
#pragma unroll
        for (int bj = 0; bj < 2; ++bj) { const int cb = u.pn * BM + bj * HALF; sc[bj] = (cb >= slo && cb < shi) ? scale : 1.f; }
#pragma unroll
        for (int ai = 0; ai < 2; ++ai)
#pragma unroll
            for (int m = 0; m < 4; ++m) { bf16_t* rowp = O + (size_t)(row0 + ai * HALF + m * 16) * ldc + col0;
#pragma unroll
                for (int bj = 0; bj < 2; ++bj) if (col0 + bj * HALF < ncols) { const f32x4 v0 = acc[ai][bj][m][0] * sc[bj], v1 = acc[ai][bj][m][1] * sc[bj];
                    u32x4 w; w.x = ::cvtpk(v0[0], v0[1]); w.y = ::cvtpk(v0[2], v0[3]); w.z = ::cvtpk(v1[0], v1[1]); w.w = ::cvtpk(v1[2], v1[3]);
                    *(u32x4*)(rowp + bj * HALF) = w; }
                asm volatile("" ::: "memory"); }
    }
};
struct EpiResidX {
    static constexpr bool PERM = false, AFTER_DRAIN = false;
    float* xc; float* xout; const float* gate_l;
    __device__ __forceinline__ void operator()(const f32x4 (&acc)[2][2][4][2], const Unit& u, int wr, int wc, int fr, int fq) const {
        const int rowt = u.pm * BM; const int b = rowt / RPB, j0 = rowt - b * RPB; const bool isctx = j0 < CTX;
        float* xb = isctx ? xc + ((size_t)(b * CTX + j0) << 10) : xout + ((size_t)(b * SEQ + j0 - CTX) << 10);
        const float* gt = gate_l + (size_t)(isctx ? 4 : b) * 6144;
        const int r0 = wr * 64 + fr, col0 = u.pn * BM + wc * 32 + 4 * fq;
        f32x4 gv[2][2];
#pragma unroll
        for (int bj = 0; bj < 2; ++bj)
#pragma unroll
            for (int n = 0; n < 2; ++n) gv[bj][n] = *(const f32x4*)(gt + col0 + bj * HALF + n * 16);
#pragma unroll
        for (int ai = 0; ai < 2; ++ai)
#pragma unroll
            for (int m = 0; m < 4; ++m) { float* rowp = xb + ((size_t)(r0 + ai * HALF + m * 16) << 10) + col0;
#pragma unroll
                for (int bj = 0; bj < 2; ++bj)
#pragma unroll
                    for (int n = 0; n < 2; ++n) { f32x4* p = (f32x4*)(rowp + bj * HALF + n * 16); *p = *p + gv[bj][n] * acc[ai][bj][m][n]; }
                asm volatile("" ::: "memory"); }
    }
};
}

constexpr int LDS_BYTES = 144 * 1024;
static_assert(TOPK_LDS + 16 <= LDS_BYTES && GEMM_LDS + 16 <= LDS_BYTES && ATT_LDS + 16 <= LDS_BYTES, "LDS budget");
constexpr int PPL = 13;
constexpr int N_PHASES = 1 + PPL * DEPTH + 1;
extern __shared__ __attribute__((aligned(16))) char g_lds[];

#define PHASE_FN __device__ __forceinline__ void
PHASE_FN f_p0(int w0) { const Ctx c = fresh_ctx(w0); ph_p0(c, g_lds); }
PHASE_FN f_norm0(int w0, int l) { const Ctx c = fresh_ctx(w0); ph_norm<0>(c, l); }
PHASE_FN f_norm1(int w0, int l) { const Ctx c = fresh_ctx(w0); ph_norm<1>(c, l); }
PHASE_FN f_gemm_in(int w0, int l) { const Ctx c = fresh_ctx(w0);
    pg8::Gemm g{C_HB, C_WIN + (size_t)l * INC * D, NR, 3328, D};
    pg8::TileOrder S; S.init(132, 13, (int)gridDim.x, (int)blockIdx.x, false);
    pg8::EpiStoreBf16 E{C_P, INC, INC, DF_Q, DF_Q + 256, 0.17677669529663687f * 1.4426950408889634f};
    pg8::gemm_phase<pg8::EpiStoreBf16, pg8::TileOrder>((PG8_LAS unsigned char*)g_lds, g, S, E, nullptr, w0); }
PHASE_FN f_prep(int w0, int l) {
    const Ctx c = fresh_ctx(w0); char* lds = g_lds;
    ph_prep_rows(c, l);
    scan_tables(c, l, lds);
    { const int G = (int)gridDim.x, N = 16 * NCHUNK * 2, R = (N + G - 1) / G;
      for (int q = 0; q < 2 * R; ++q) { const int mx = q & 1; int u = (q >> 1) * G + (int)blockIdx.x; if (u >= N) continue;
        const int dir = u & 1; u >>= 1; const int cc = u % NCHUNK; u /= NCHUNK; const int h = u & 3, b = u >> 2;
        if (mx == 0) scanA_item<0>(c, l, b, h, cc, dir, lds); else scanA_item<1>(c, l, b, h, cc, dir, lds); } }
}
PHASE_FN f_upproj(int w0, int l) {
    const Ctx c = fresh_ctx(w0); char* lds = g_lds;
    EpiBf16 eq{C_QM, 384, 0.10206207261596575f * 1.4426950408889634f}, ekv{C_KVM, 512, 1.f};
    for (int it = blockIdx.x; it < 132 * 7 + 384; it += gridDim.x) {
        if (it < 132 * 7) { const int tm = it / 7, tn = it % 7;
            if (tn < 3) gemm_tile(c, C_P + MLA_CQ, INC, C_WUQ + (size_t)l * 384 * 192, 192, 192, tm * 256, tn * 128, lds, eq);
            else gemm_tile(c, C_P + MLA_CKV, INC, C_WUKV + (size_t)l * 512 * 128, 128, 128, tm * 256, (tn - 3) * 128, lds, ekv); }
        else scanB_item(c, it - 132 * 7); }
}
PHASE_FN f_scanc(int w0, int l) {
    const Ctx c = fresh_ctx(w0); char* lds = g_lds; const bool need_ctx = (l < DEPTH - 1);
    ph_rope_q(c);
    scan_tables(c, l, lds);
    { const int G = (int)gridDim.x, N = 16 * NCHUNK, R = (N + G - 1) / G;
      for (int q = 0; q < 2 * R; ++q) { const int mx = q & 1; int u = (q >> 1) * G + (int)blockIdx.x; if (u >= N) continue;
        const int cc = u % NCHUNK; u /= NCHUNK; const int h = u & 3, b = u >> 2;
        if (cc < 4 && !need_ctx) continue;
        if (mx == 0) scanC_item<0>(c, l, b, h, cc, lds); else scanC_item<1>(c, l, b, h, cc, lds); } }
}
PHASE_FN f_attn(int w0, int l) { const Ctx c = fresh_ctx(w0); ph_attn(c, l, g_lds); }
PHASE_FN f_gemm_out(int w0, int l) {
    const Ctx c = fresh_ctx(w0); const bool need_ctx = (l < DEPTH - 1);
    { pg8::Gemm g{C_HB, C_WOUT + (size_t)l * D * D, NR, D, D};
      pg8::TileOrder S; S.init(need_ctx ? 132 : 128, 4, (int)gridDim.x, (int)blockIdx.x, !need_ctx);
      pg8::EpiResidX E{C_XC, COUT, C_MODT + (size_t)l * 5 * 6144 + 2 * D};
      pg8::gemm_phase<pg8::EpiResidX, pg8::TileOrder>((PG8_LAS unsigned char*)g_lds, g, S, E, nullptr, w0); }
    cvt_tables(c, l);
}
PHASE_FN f_peer_q(int w0, int l) {
    const Ctx c = fresh_ctx(w0); const bool need_ctx = (l < DEPTH - 1);
    pg8::Gemm g{C_HB, C_WQ + (size_t)l * 2048 * D, NR, 2048, D};
    pg8::TileOrder S; S.init(need_ctx ? 132 : 128, 8, (int)gridDim.x, (int)blockIdx.x, !need_ctx);
    pg8::EpiStoreBf16 E{C_Q2, 2048, 2048, 0, 0, 1.f};
    pg8::gemm_phase<pg8::EpiStoreBf16, pg8::TileOrder>((PG8_LAS unsigned char*)g_lds, g, S, E, nullptr, w0);
}
PHASE_FN f_topk(int w0, int l) {
    const Ctx c = fresh_ctx(w0); char* lds = g_lds; const bool need_ctx = (l < DEPTH - 1);
    for (int it = blockIdx.x; it < 264 * 8; it += gridDim.x) { const int tm = it >> 3, h = it & 7;
        if ((tm % 66) < 2 && !need_ctx) continue;
        peer_topk_item(c, l, tm, h, lds); }
}
PHASE_FN f_expert_u(int w0, int l) { const Ctx c = fresh_ctx(w0); ph_peer_expert<0>(c, l, g_lds); }
PHASE_FN f_expert_c(int w0, int l) { const Ctx c = fresh_ctx(w0); ph_peer_combine(c, l); }
PHASE_FN f_expert_v(int w0, int l) { const Ctx c = fresh_ctx(w0); ph_peer_expert<1>(c, l, g_lds); }
PHASE_FN f_final(int w0) { const Ctx c = fresh_ctx(w0); ph_final(c); }

__global__ void __launch_bounds__(512, 2) mk_fwd(Params p) {
    volatile LAS unsigned* bst = (volatile LAS unsigned*)(g_lds + LDS_BYTES - 16);
    const bool t0 = threadIdx.x == 0; const int w0 = __builtin_amdgcn_readfirstlane((int)threadIdx.x >> 6);
    if (t0) { bst[0] = 0u; bst[1] = 0u; bst[2] = 0u; bst[3] = 0u; }
    __syncthreads();
    XcdBarrier bar; bar.bar = (unsigned*)(p.ws + WS_CTL); bar.x = 0; bar.st = bst; bar.t0 = t0;
    const int lo = p.ph_lo, hi = p.ph_hi;
    const bool multi = (hi - lo) > 1;
    if (multi) bar = xcd_barrier_post((unsigned*)(p.ws + WS_CTL), bst, t0);
#ifndef PHMASK
#define PHMASK 0xFFFF
#endif
#define EN(s) ((PHMASK >> (s)) & 1)
#define IN(k) (lo <= (k) && (k) < hi)
#define SEAM(k) do { if (IN(k) && IN((k) + 1)) xcd_barrier(bar); } while (0)
    if (EN(0) && IN(0)) f_p0(w0);
    SEAM(0);
#define LAYER(l) do { constexpr int base = 1 + PPL * (l); \
        if (EN(1) && IN(base + 0)) f_norm0(w0, l); SEAM(base + 0); \
        if (EN(2) && IN(base + 1)) f_gemm_in(w0, l); SEAM(base + 1); \
        if (EN(3) && IN(base + 2)) f_prep(w0, l); SEAM(base + 2); \
        if (EN(4) && IN(base + 3)) f_upproj(w0, l); SEAM(base + 3); \
        if (EN(5) && IN(base + 4)) f_scanc(w0, l); SEAM(base + 4); \
        if (EN(6) && IN(base + 5)) f_attn(w0, l); SEAM(base + 5); \
        if (EN(7) && IN(base + 6)) f_gemm_out(w0, l); SEAM(base + 6); \
        if (EN(8) && IN(base + 7)) f_norm1(w0, l); SEAM(base + 7); \
        if (EN(9) && IN(base + 8)) f_peer_q(w0, l); SEAM(base + 8); \
        if (EN(10) && IN(base + 9)) f_topk(w0, l); SEAM(base + 9); \
        if (EN(11) && IN(base + 10)) f_expert_u(w0, l); SEAM(base + 10); \
        if (EN(12) && IN(base + 11)) f_expert_c(w0, l); SEAM(base + 11); \
        if (EN(13) && IN(base + 12)) f_expert_v(w0, l); SEAM(base + 12); } while (0)
    LAYER(0);
    LAYER(1);
#undef LAYER
    if (EN(14) && IN(N_PHASES - 1)) f_final(w0);
#undef IN
#undef SEAM
}

extern "C" void kernel_launch(void* const* d_in, const int* in_sizes, int n_in, void* d_out, int out_size, void* d_ws, size_t ws_size, hipStream_t stream) {
    static int grid = 0;
    if (grid == 0) {
        if (n_in != 26 || in_sizes[0] != NB * SEQ * D || out_size != NB * SEQ * D || ws_size < WS_END) {
            fprintf(stderr, "kernel_launch: shape/workspace mismatch: n_in %d in0 %d out %d ws %zu (need %zu); nothing launched\n", n_in, n_in > 0 ? in_sizes[0] : -1, out_size, ws_size, (size_t)WS_END);
            grid = -1; return; }
        int dev = 0, cus = 0, per_cu = 0;
        if (hipGetDevice(&dev) != hipSuccess || hipDeviceGetAttribute(&cus, hipDeviceAttributeMultiprocessorCount, dev) != hipSuccess) { grid = -1; return; }
        if (hipFuncSetAttribute((const void*)mk_fwd, hipFuncAttributeMaxDynamicSharedMemorySize, LDS_BYTES) != hipSuccess) { fprintf(stderr, "kernel_launch: hipFuncSetAttribute failed\n"); grid = -1; return; }
        if (hipOccupancyMaxActiveBlocksPerMultiprocessor(&per_cu, (const void*)mk_fwd, 512, LDS_BYTES) != hipSuccess || per_cu < 1)
            fprintf(stderr, "kernel_launch: note: occupancy query reports %d workgroups per CU\n", per_cu);
        (void)hipGetLastError();
        grid = cus;
    }
    if (grid < 0) return;
    if (hipMemsetAsync((char*)d_ws + WS_CTL, 0, CTL_BYTES, stream) != hipSuccess) { fprintf(stderr, "kernel_launch: memset failed\n"); return; }
    Params p{};
    for (int i = 0; i < 26; ++i) p.in[i] = (const float*)d_in[i];
    p.out = (float*)d_out; p.ws = (unsigned char*)d_ws;
#if MK_PER_PHASE
    for (int k = 0; k < N_PHASES; ++k) { p.ph_lo = k; p.ph_hi = k + 1; hipLaunchKernelGGL(mk_fwd, dim3(grid), dim3(512), LDS_BYTES, stream, p); }
#else
    p.ph_lo = 0; p.ph_hi = N_PHASES; hipLaunchKernelGGL(mk_fwd, dim3(grid), dim3(512), LDS_BYTES, stream, p);
#endif
    const hipError_t le = hipPeekAtLastError();
    if (le != hipSuccess) fprintf(stderr, "kernel_launch: launch failed: %s\n", hipGetErrorName(le));
}
```

```cpp
#include <hip/hip_runtime.h>
#include <cstdio>
#include <cstdint>

#ifndef MK_PER_PHASE
#define MK_PER_PHASE 0
#endif

constexpr int D = 1024, NB = 4, SEQ = 8192, CTX = 256, DEPTH = 2;
constexpr int RPB = CTX + SEQ;
constexpr int NR = NB * RPB;
constexpr int INC = 3200;
constexpr int GLA_Q = 0, GLA_K = 128, GLA_V = 256, GLA_R = 512, GLA_ZF = 768, GLA_ZB = 784;
constexpr int HG_Q = 800, HG_I = 1056, HG_OG = 1312, HG_ZF = 1568, HG_ZB = 1824;
constexpr int MLA_CQ = 2080, MLA_CKV = 2272, MLA_KR = 2400;
constexpr int DF_Q = 2432, DF_K = 2688, DF_V = 2944;
constexpr int NCHUNK = RPB / 64;
constexpr int NEXP = 16384;
constexpr float NORM_EPS = 1e-6f;

typedef unsigned short bf16_t;
typedef short bf16x8 __attribute__((ext_vector_type(8)));
typedef short s16x4 __attribute__((ext_vector_type(4)));
typedef float f32x16 __attribute__((ext_vector_type(16)));
typedef float f32x4 __attribute__((ext_vector_type(4)));
typedef unsigned u32x4 __attribute__((ext_vector_type(4)));
typedef unsigned u32x2 __attribute__((ext_vector_type(2)));

constexpr size_t al256(size_t x) { return (x + 255) / 256 * 256; }
constexpr size_t WS_CTL = 0;
constexpr size_t CTL_BYTES = 65536;
constexpr size_t WS_MOD = WS_CTL + CTL_BYTES;
constexpr size_t WS_XC = al256(WS_MOD + (size_t)2 * 5 * 6144 * 4);
constexpr size_t WS_WIN = al256(WS_XC + (size_t)NB * CTX * D * 4);
constexpr size_t WS_WOUT = al256(WS_WIN + (size_t)2 * INC * D * 2);
constexpr size_t WS_WQ = al256(WS_WOUT + (size_t)2 * D * D * 2);
constexpr size_t WS_WUQ = al256(WS_WQ + (size_t)2 * 2048 * D * 2);
constexpr size_t WS_WUKV = al256(WS_WUQ + (size_t)2 * 384 * 192 * 2);
constexpr size_t WS_KEYS = al256(WS_WUKV + (size_t)2 * 512 * 128 * 2);
constexpr size_t WS_HB = al256(WS_KEYS + (size_t)2 * 16 * 128 * 128 * 2);
constexpr size_t WS_QM = al256(WS_HB + (size_t)NR * D * 2);
constexpr size_t WS_KVM = al256(WS_QM + (size_t)NR * 384 * 2);
constexpr size_t WS_SG = al256(WS_KVM + (size_t)NR * 512 * 2);
constexpr size_t WS_SH = al256(WS_SG + (size_t)32 * NCHUNK * 2048 * 2);
constexpr size_t WS_DG = al256(WS_SH + (size_t)32 * NCHUNK * 4096 * 2);
constexpr size_t WS_DH = al256(WS_DG + (size_t)32 * NCHUNK * 32 * 4);
constexpr size_t WS_P = al256(WS_DH + (size_t)32 * NCHUNK * 64 * 4);
constexpr size_t WS_END = al256(WS_P + (size_t)NR * INC * 2);
constexpr size_t WS_TU8 = WS_P;
constexpr size_t WS_TV8 = WS_P + (size_t)NEXP * D;
constexpr size_t WS_SU = WS_TV8 + (size_t)NEXP * D;
constexpr size_t WS_SV = WS_SU + (size_t)NEXP * 4;
constexpr size_t WS_Q2 = WS_P + (size_t)64 * 1024 * 1024;
constexpr size_t WS_PART = WS_Q2;
static_assert(WS_SV + (size_t)NEXP * 4 <= WS_Q2, "alias overflow 0");
static_assert(WS_Q2 + (size_t)NR * 2048 * 2 <= WS_END, "alias overflow");
constexpr size_t WS_EI = WS_SG;
constexpr size_t WS_EG = WS_EI + (size_t)NR * 128 * 4;
static_assert(WS_EG + (size_t)NR * 128 * 4 <= WS_DG, "alias overflow 2");

#define XB_TMO      128
#define XB_XCNT(j)  (256  + 64 * (j))
#define XB_XSUB(j)  (1280 + 64 * (j))
#define XB_XGEN(j)  (2304 + 64 * (j))
#define XB_TOP      3328
#define XB_TOPGEN   3392
#define XCD_BAR_WORDS 3456
#define XB_SPIN_CAP (1u << 22)
#define LAS __attribute__((address_space(3)))

__device__ __forceinline__ unsigned xb_ld(unsigned* p)              { return __hip_atomic_load(p, __ATOMIC_RELAXED, __HIP_MEMORY_SCOPE_AGENT); }
__device__ __forceinline__ unsigned xb_add(unsigned* p, unsigned v) { return __hip_atomic_fetch_add(p, v, __ATOMIC_RELAXED, __HIP_MEMORY_SCOPE_AGENT); }
__device__ __forceinline__ unsigned xb_xcc_id() { return (unsigned)__builtin_amdgcn_s_getreg((3 << 11) | 20) & 0xFu; }
#define XB_SPIN(cond, bar) do { unsigned _sp = 0; while (cond) { __builtin_amdgcn_s_sleep(1); \
    if ((++_sp & 255u) == 0u) { if (xb_ld(&(bar)[XB_TMO])) break; if (_sp > XB_SPIN_CAP) { atomicAdd(&(bar)[XB_TMO], 1u); break; } } } } while (0)

struct XcdBarrier { unsigned* bar; unsigned x; volatile LAS unsigned* st; bool t0; };

__device__ __forceinline__ XcdBarrier xcd_barrier_post(unsigned* bar, volatile LAS unsigned* st, bool t0) {
    XcdBarrier b; b.bar = bar; b.x = xb_xcc_id(); b.st = st; b.t0 = t0;
    if (t0) (void)xb_add(&bar[XB_XCNT(b.x)], 1u);
    return b;
}
__device__ __forceinline__ void xcd_barrier_complete(unsigned* bar, unsigned x, unsigned& nloc, unsigned& nx) {
    const unsigned G = gridDim.x * gridDim.y * gridDim.z;
    unsigned sum, cnt, mine, sp = 0u;
    for (;;) {
        sum = 0u; cnt = 0u; mine = 0u;
#pragma unroll
        for (unsigned j = 0; j < 16; ++j) { const unsigned c = xb_ld(&bar[XB_XCNT(j)]); sum += c; cnt += (c > 0u) ? 1u : 0u; mine = (j == x) ? c : mine; }
        if (sum == G) break;
        __builtin_amdgcn_s_sleep(1);
        if ((++sp & 255u) == 0u) { if (xb_ld(&bar[XB_TMO])) break; if (sp > XB_SPIN_CAP) { atomicAdd(&bar[XB_TMO], 1u); break; } }
    }
    nloc = mine > 0u ? mine : 1u; nx = cnt > 0u ? cnt : 1u;
}
__device__ __forceinline__ void xcd_barrier(const XcdBarrier& b) {
    asm volatile("s_waitcnt vmcnt(0)" ::: "memory");
    __syncthreads();
    if (b.t0) {
        unsigned* bar = b.bar;
        __builtin_amdgcn_s_waitcnt(0);
        unsigned nloc = b.st[0], nx = b.st[1];
        if (nloc == 0u) { xcd_barrier_complete(bar, b.x, nloc, nx); b.st[0] = nloc; b.st[1] = nx; }
        const unsigned old = xb_add(&bar[XB_XSUB(b.x)], 1u);
        const unsigned gen = old / nloc;
        if (old + 1u == (gen + 1u) * nloc) {
            __builtin_amdgcn_fence(__ATOMIC_RELEASE, "agent");
            asm volatile("s_waitcnt vmcnt(0)" ::: "memory");
            const unsigned og = xb_add(&bar[XB_TOP], 1u);
            const unsigned tg = og / nx;
            if (og + 1u == (tg + 1u) * nx) xb_add(&bar[XB_TOPGEN], 1u);
            else XB_SPIN(xb_ld(&bar[XB_TOPGEN]) == tg, bar);
            __builtin_amdgcn_fence(__ATOMIC_ACQUIRE, "agent");
            xb_add(&bar[XB_XGEN(b.x)], 1u);
            asm volatile("s_waitcnt vmcnt(0)" ::: "memory");
        } else {
            XB_SPIN(xb_ld(&bar[XB_XGEN(b.x)]) == gen, bar);
            __builtin_amdgcn_fence(__ATOMIC_ACQUIRE, "agent");
            asm volatile("s_waitcnt vmcnt(0)" ::: "memory");
        }
    }
    __syncthreads();
}

typedef __bf16 bf16v2_t __attribute__((ext_vector_type(2)));
typedef float f32v2_t __attribute__((ext_vector_type(2)));
__device__ __forceinline__ unsigned cvtpk(float lo, float hi) { const f32v2_t v = {lo, hi}; const bf16v2_t b = __builtin_convertvector(v, bf16v2_t); return __builtin_bit_cast(unsigned, b); }
__device__ __forceinline__ bf16_t f2bf(float x) { const __bf16 b = (__bf16)x; return __builtin_bit_cast(bf16_t, b); }
__device__ __forceinline__ float bf2f(bf16_t h) { return __uint_as_float(((unsigned)h) << 16); }
__device__ __forceinline__ float bflo(unsigned w) { return __uint_as_float(w << 16); }
__device__ __forceinline__ float bfhi(unsigned w) { return __uint_as_float(w & 0xffff0000u); }
__device__ __forceinline__ float silu_f(float x) { return x / (1.f + __expf(-x)); }
__device__ __forceinline__ float logsigmoid_f(float z) { return fminf(z, 0.f) - __logf(1.f + __expf(-fabsf(z))); }
__device__ __forceinline__ float wave_sum(float v) {
#pragma unroll
    for (int o = 32; o >= 1; o >>= 1) v += __shfl_xor(v, o, 64);
    return v;
}
__device__ __forceinline__ void zero_acc(f32x16& a) {
#pragma unroll
    for (int r = 0; r < 16; ++r) a[r] = 0.f;
    asm volatile("" : "+v"(a));
}
__device__ __forceinline__ int crow(int r, int hi) { return (r & 3) + 8 * (r >> 2) + 4 * hi; }

struct Params { const float* in[26]; float* out; unsigned char* ws; int ph_lo, ph_hi; };
typedef const __attribute__((address_space(4))) Params* KParams;
struct Ctx {
    KParams pp;
    int tid, lane, wid;
};
__device__ __forceinline__ int mk_tid(int w0) { unsigned m = ~0u; asm volatile("" : "+s"(m)); return (w0 << 6) | (int)__builtin_amdgcn_mbcnt_hi(m, __builtin_amdgcn_mbcnt_lo(m, 0u)); }
__device__ __forceinline__ float shx(float v, int o, int lane) { return __int_as_float(__builtin_amdgcn_ds_bpermute((lane ^ o) << 2, __float_as_int(v))); }
__device__ __forceinline__ Ctx fresh_ctx(int w0) {
    Ctx c; unsigned long long a = (unsigned long long)__builtin_amdgcn_kernarg_segment_ptr(); asm volatile("" : "+s"(a)); c.pp = (KParams)a;
    int t = mk_tid(w0); asm volatile("" : "+v"(t)); c.tid = t; c.lane = t & 63; c.wid = w0;
    return c;
}
#define CIN(i)   (c.pp->in[i])
#define COUT     (c.pp->out)
#define CWS(off) (c.pp->ws + (off))
#define C_MODT ((float*)CWS(WS_MOD))
#define C_XC   ((float*)CWS(WS_XC))
#define C_WIN  ((bf16_t*)CWS(WS_WIN))
#define C_WOUT ((bf16_t*)CWS(WS_WOUT))
#define C_WQ   ((bf16_t*)CWS(WS_WQ))
#define C_WUQ  ((bf16_t*)CWS(WS_WUQ))
#define C_WUKV ((bf16_t*)CWS(WS_WUKV))
#define C_KEYS ((bf16_t*)CWS(WS_KEYS))
#define C_HB   ((bf16_t*)CWS(WS_HB))
#define C_QM   ((bf16_t*)CWS(WS_QM))
#define C_KVM  ((bf16_t*)CWS(WS_KVM))
#define C_P    ((bf16_t*)CWS(WS_P))
#define C_TU8  ((unsigned char*)CWS(WS_TU8))
#define C_TV8  ((unsigned char*)CWS(WS_TV8))
#define C_SU   ((float*)CWS(WS_SU))
#define C_SV   ((float*)CWS(WS_SV))
#define C_PART ((float*)CWS(WS_PART))
#define C_Q2   ((bf16_t*)CWS(WS_Q2))
#define C_SG   ((bf16_t*)CWS(WS_SG))
#define C_SH   ((bf16_t*)CWS(WS_SH))
#define C_DG   ((float*)CWS(WS_DG))
#define C_DH   ((float*)CWS(WS_DH))
#define C_EI   ((int*)CWS(WS_EI))
#define C_EG   ((float*)CWS(WS_EG))

__device__ __forceinline__ float* xrow(const Ctx& c, int r) {
    const int b = r / RPB, j = r - b * RPB;
    return j < CTX ? C_XC + ((size_t)(b * CTX + j) << 10) : COUT + ((size_t)(b * SEQ + (j - CTX)) << 10);
}
__device__ __forceinline__ const float* inrow(const Ctx& c, int r) {
    const int b = r / RPB, j = r - b * RPB;
    return j < CTX ? CIN(2) + ((size_t)(b * CTX + j) << 10) : CIN(0) + ((size_t)(b * SEQ + (j - CTX)) << 10);
}

__device__ void p0_mod_item(const Ctx& c, int item, char* lds) {
    float* sc = (float*)lds;
    float* red = sc + 5 * 1024;
    const int tid = c.tid;
    for (int i = tid; i < 5 * 1024; i += 512) { const int v = i >> 10, k = i & 1023; const float x = (v < 4) ? CIN(1)[v * 1024 + k] : CIN(3)[k]; sc[i] = silu_f(x); }
    __syncthreads();
    const int l = item / 96, n0 = (item % 96) * 64;
    const int col = tid & 63, kg = tid >> 6;
    const float* w = CIN(4) + (size_t)l * 1024 * 6144 + n0 + col;
    float a[5] = {0.f, 0.f, 0.f, 0.f, 0.f};
#pragma unroll 8
    for (int kk = 0; kk < 128; ++kk) { const int k = kg * 128 + kk; const float wv = w[(size_t)k * 6144];
#pragma unroll
        for (int v = 0; v < 5; ++v) a[v] += sc[v * 1024 + k] * wv; }
#pragma unroll
    for (int v = 0; v < 5; ++v) red[(kg * 64 + col) * 5 + v] = a[v];
    __syncthreads();
    if (tid < 320) { const int cc = tid / 5, v = tid % 5; float s = 0.f;
#pragma unroll
        for (int g = 0; g < 8; ++g) s += red[(g * 64 + cc) * 5 + v];
        C_MODT[((size_t)l * 5 + v) * 6144 + n0 + cc] = s + CIN(5)[l * 6144 + n0 + cc]; }
    __syncthreads();
}
__device__ void p0_tr_tile(const float* __restrict__ src, bf16_t* __restrict__ dst, int K, int N, int k0, int n0, int tid, char* lds) {
    float* t = (float*)lds;
#pragma unroll
    for (int i = 0; i < 2; ++i) { const int k = (tid >> 4) + 32 * i, n4 = (tid & 15) * 4;
        const f32x4 v = *(const f32x4*)(src + (size_t)(k0 + k) * N + n0 + n4);
        t[k * 65 + n4 + 0] = v[0]; t[k * 65 + n4 + 1] = v[1]; t[k * 65 + n4 + 2] = v[2]; t[k * 65 + n4 + 3] = v[3]; }
    __syncthreads();
    { const int n = tid >> 3, k8 = (tid & 7) * 8; u32x4 w;
#pragma unroll
        for (int j = 0; j < 4; ++j) w[j] = cvtpk(t[(k8 + 2 * j) * 65 + n], t[(k8 + 2 * j + 1) * 65 + n]);
        *(u32x4*)(dst + (size_t)(n0 + n) * K + k0 + k8) = w; }
    __syncthreads();
}
__device__ void ph_p0(const Ctx& c, char* lds) {
    constexpr int T_WIN = 16 * 50, T_WOUT = 16 * 16, T_WQ = 16 * 32, T_UQ = 3 * 6, T_UKV = 2 * 8;
    constexpr int PER_L = T_WIN + T_WOUT + T_WQ + T_UQ + T_UKV;
    constexpr int NITEM = 192 + 2 * PER_L;
    for (int it = blockIdx.x; it < NITEM; it += gridDim.x) {
        if (it < 192) { p0_mod_item(c, it, lds); continue; }
        int t = it - 192; const int l = t / PER_L; t -= l * PER_L;
        if (t < T_WIN) { p0_tr_tile(CIN(8) + (size_t)l * D * INC, C_WIN + (size_t)l * INC * D, D, INC, (t / 50) * 64, (t % 50) * 64, c.tid, lds); continue; } t -= T_WIN;
        if (t < T_WOUT) { p0_tr_tile(CIN(9) + (size_t)l * D * D, C_WOUT + (size_t)l * D * D, D, D, (t / 16) * 64, (t % 16) * 64, c.tid, lds); continue; } t -= T_WOUT;
        if (t < T_WQ) { p0_tr_tile(CIN(21) + (size_t)l * D * 2048, C_WQ + (size_t)l * 2048 * D, D, 2048, (t / 32) * 64, (t % 32) * 64, c.tid, lds); continue; } t -= T_WQ;
        if (t < T_UQ) { p0_tr_tile(CIN(17) + (size_t)l * 192 * 384, C_WUQ + (size_t)l * 384 * 192, 192, 384, (t / 6) * 64, (t % 6) * 64, c.tid, lds); continue; } t -= T_UQ;
        p0_tr_tile(CIN(18) + (size_t)l * 128 * 512, C_WUKV + (size_t)l * 512 * 128, 128, 512, (t / 8) * 64, (t % 8) * 64, c.tid, lds);
    }
    const size_t nk8 = (size_t)2 * 16 * 128 * 128 / 8;
    for (size_t i = (size_t)blockIdx.x * 512 + c.tid; i < nk8; i += (size_t)gridDim.x * 512) {
        const f32x4 a = *(const f32x4*)(CIN(22) + i * 8), b = *(const f32x4*)(CIN(22) + i * 8 + 4);
        u32x4 w = {cvtpk(a[0], a[1]), cvtpk(a[2], a[3]), cvtpk(b[0], b[1]), cvtpk(b[2], b[3])};
        *(u32x4*)(C_KEYS + i * 8) = w;
    }
}

template <int WHICH>
__device__ void ph_norm(const Ctx& c, int l) {
    const float* g = CIN(WHICH == 0 ? 6 : 7) + l * D;
    const bool need_ctx = (l < DEPTH - 1);
    const int stride = gridDim.x * 8;
    auto next_row = [&](int r) { for (; r < NR; r += stride) { const int j = r % RPB; if (!(WHICH == 1 && j < CTX && !need_ctx)) break; } return r; };
    auto row_src = [&](int r) { return (WHICH == 0 && l == 0) ? inrow(c, r) : (const float*)xrow(c, r); };
    int r = next_row(blockIdx.x * 8 + c.wid);
    f32x4 xn[4];
    if (r < NR) { const float* src = row_src(r);
#pragma unroll
        for (int i = 0; i < 4; ++i) xn[i] = *(const f32x4*)(src + i * 256 + c.lane * 4); }
    while (r < NR) {
        f32x4 x[4];
#pragma unroll
        for (int i = 0; i < 4; ++i) x[i] = xn[i];
        const int rn = next_row(r + stride);
        if (rn < NR) { const float* src = row_src(rn);
#pragma unroll
            for (int i = 0; i < 4; ++i) xn[i] = *(const f32x4*)(src + i * 256 + c.lane * 4); }
        const int b = r / RPB, j = r - b * RPB; const bool isctx = j < CTX;
        float ss = 0.f;
#pragma unroll
        for (int i = 0; i < 4; ++i) ss += x[i][0] * x[i][0] + x[i][1] * x[i][1] + x[i][2] * x[i][2] + x[i][3] * x[i][3];
        ss = wave_sum(ss);
        const float rstd = rsqrtf(ss * (1.f / D) + NORM_EPS);
        const float* mt = C_MODT + ((size_t)l * 5 + (isctx ? 4 : b)) * 6144;
        const float* sh = mt + (WHICH == 0 ? 0 : 3) * D; const float* scl = mt + (WHICH == 0 ? 1 : 4) * D;
        bf16_t* dst = C_HB + (size_t)r * D;
        float* xr = xrow(c, r);
#pragma unroll
        for (int i = 0; i < 4; ++i) { const int col = i * 256 + c.lane * 4;
            const f32x4 gv = *(const f32x4*)(g + col), sv = *(const f32x4*)(sh + col), cv = *(const f32x4*)(scl + col);
            float y[4];
#pragma unroll
            for (int e = 0; e < 4; ++e) y[e] = x[i][e] * rstd * gv[e] * (1.f + cv[e]) + sv[e];
            u32x2 w = {cvtpk(y[0], y[1]), cvtpk(y[2], y[3])};
            *(u32x2*)(dst + col) = w;
            if (WHICH == 0 && l == 0) *(f32x4*)(xr + col) = x[i]; }
        r = rn;
    }
}

constexpr int GEMM_LDS = 98304;
template <class Epi>
__device__ __forceinline__ void gemm_tile(const Ctx& c, const bf16_t* __restrict__ A, int lda, const bf16_t* __restrict__ Bt, int ldb, int K, int m0, int n0, char* lds, const Epi& epi) {
    const int tid = c.tid, lane = tid & 63, wid = tid >> 6, r32 = lane & 31, hi = lane >> 5, wm = wid >> 1, wn = wid & 1;
    char* As = lds; char* Bs = lds + 65536;
    f32x16 acc[2][2];
#pragma unroll
    for (int m = 0; m < 2; ++m)
#pragma unroll
        for (int n = 0; n < 2; ++n) zero_acc(acc[m][n]);
    u32x4 ra[4], rb[2];
    const int srow = tid >> 3, sch = tid & 7;
    const bf16_t* Ag = A + (size_t)(m0 + srow) * lda + sch * 8;
    const bf16_t* Bg = Bt + (size_t)(n0 + srow) * ldb + sch * 8;
    const int swoff = srow * 128 + ((sch ^ ((srow >> 1) & 7)) << 4);
#define GLOAD(k0) do { _Pragma("unroll") for (int i = 0; i < 4; ++i) ra[i] = *(const u32x4*)(Ag + (size_t)(64 * i) * lda + (k0)); \
                       _Pragma("unroll") for (int i = 0; i < 2; ++i) rb[i] = *(const u32x4*)(Bg + (size_t)(64 * i) * ldb + (k0)); } while (0)
#define SWRITE(buf) do { _Pragma("unroll") for (int i = 0; i < 4; ++i) *(u32x4*)(As + (buf) * 32768 + swoff + i * 8192) = ra[i]; \
                         _Pragma("unroll") for (int i = 0; i < 2; ++i) *(u32x4*)(Bs + (buf) * 16384 + swoff + i * 8192) = rb[i]; } while (0)
    const int nk = K >> 6;
    GLOAD(0); SWRITE(0); __syncthreads();
    for (int kt = 0; kt < nk; ++kt) {
        const int buf = kt & 1;
        if (kt + 1 < nk) GLOAD((kt + 1) * 64);
        const char* Ab = As + buf * 32768; const char* Bb = Bs + buf * 16384;
#pragma unroll
        for (int ks = 0; ks < 4; ++ks) {
            bf16x8 a[2], b[2];
#pragma unroll
            for (int m = 0; m < 2; ++m) { const int row = wm * 64 + m * 32 + r32; a[m] = *(const bf16x8*)(Ab + row * 128 + (((ks * 2 + hi) ^ ((row >> 1) & 7)) << 4)); }
#pragma unroll
            for (int n = 0; n < 2; ++n) { const int row = wn * 64 + n * 32 + r32; b[n] = *(const bf16x8*)(Bb + row * 128 + (((ks * 2 + hi) ^ ((row >> 1) & 7)) << 4)); }
#pragma unroll
            for (int m = 0; m < 2; ++m)
#pragma unroll
                for (int n = 0; n < 2; ++n) acc[m][n] = __builtin_amdgcn_mfma_f32_32x32x16_bf16(a[m], b[n], acc[m][n], 0, 0, 0);
        }
        if (kt + 1 < nk) SWRITE(buf ^ 1);
        __syncthreads();
    }
#undef GLOAD
#undef SWRITE
    epi(acc, m0 + wm * 64, n0 + wn * 64, r32, hi);
}
struct EpiBf16 {
    bf16_t* C; int ldc; float scale;
    __device__ __forceinline__ void operator()(const f32x16 (&acc)[2][2], int row0, int col0, int r32, int hi) const {
        bf16_t* base = C + (size_t)(row0 + 4 * hi) * ldc + col0 + r32;
#pragma unroll
        for (int m = 0; m < 2; ++m)
#pragma unroll
            for (int r = 0; r < 16; ++r) { bf16_t* p = base + (size_t)(m * 32 + (r & 3) + 8 * (r >> 2)) * ldc;
                p[0] = f2bf(acc[m][0][r] * scale); p[32] = f2bf(acc[m][1][r] * scale);
                asm volatile("" ::: "memory"); }
    }
};

template <int MX> struct ScanCfg;
template <> struct ScanCfg<0> { static constexpr int DK = 32; };
template <> struct ScanCfg<1> { static constexpr int DK = 64; };

constexpr int BP = 72;
typedef float f32x4v __attribute__((ext_vector_type(4)));
__device__ __forceinline__ bf16x8 frag16(const bf16_t* tile, int row0, int k0, int lane) { return *(const bf16x8*)(tile + (row0 + (lane & 15)) * BP + k0 + 8 * (lane >> 4)); }

constexpr int SCAN_TAB_OFF = 128000;
__device__ __forceinline__ void scan_tables(const Ctx& c, int l, char* lds) {
    float* wtab = (float*)(lds + SCAN_TAB_OFF); float* btab = wtab + 2 * 16 * 128; float* lbtab = btab + 2 * 128;
    for (int i = c.tid; i < 2 * 16 * 128; i += 512) wtab[i] = CIN(10)[(size_t)l * 2 * 16 * 128 + i];
    if (c.tid < 256) { btab[c.tid] = CIN(11)[(size_t)l * 256 + c.tid];
        float lb = 0.f; if (l > 0) { const float r0 = CIN(13)[c.tid], r1 = CIN(13)[256 + c.tid]; lb = 1.f / (1.f + __expf(r0 - r1)); }
        lbtab[c.tid] = lb; }
    __syncthreads();
}
struct ScanLd { u32x4 vv, zv, qv4; u32x2 kv, qv2; };
template <int MX, bool WANT_Q>
__device__ __forceinline__ ScanLd scan_issue(const Ctx& c, int b, int h, int cc, int dir) {
    const int tid = c.tid; const int t = tid >> 3, j0 = (tid & 7) * 8;
    const bf16_t* pr = C_P + (size_t)(b * RPB + cc * 64 + (dir ? 63 - t : t)) * INC;
    ScanLd r; r.zv = (u32x4){0u, 0u, 0u, 0u}; r.qv4 = r.zv; r.kv = (u32x2){0u, 0u}; r.qv2 = r.kv;
    r.vv = *(const u32x4*)(pr + (MX == 0 ? GLA_V : HG_I) + h * 64 + j0);
    if (MX == 0) { const int j4 = (tid & 7) * 4;
        r.kv = *(const u32x2*)(pr + GLA_K + h * 32 + j4);
        if (WANT_Q) r.qv2 = *(const u32x2*)(pr + GLA_Q + h * 32 + j4);
        if (tid < 128) r.zv = *(const u32x4*)(C_P + (size_t)(b * RPB + cc * 64 + (dir ? 63 - (tid >> 1) : (tid >> 1))) * INC + (dir ? GLA_ZB : GLA_ZF) + (tid & 1) * 8);
    } else {
        r.zv = *(const u32x4*)(pr + (dir ? HG_ZB : HG_ZF) + h * 64 + j0);
        if (WANT_Q) r.qv4 = *(const u32x4*)(pr + HG_Q + h * 64 + j0); }
    return r;
}
template <int MX, bool WANT_Q>
__device__ __forceinline__ void scan_load(const Ctx& c, const ScanLd& ld, int h, int dir, float* qt, float* kt, float* gt, bf16_t* VT, float* tmp, const char* ldsb) {
    constexpr int DK = ScanCfg<MX>::DK, PK = DK + 1;
    const int tid = c.tid;
    const int t = tid >> 3, j0 = (tid & 7) * 8;
    const u32x4 vv = ld.vv;
    if (MX == 0) {
        float* zt = tmp; const float* wt = (const float*)(ldsb + SCAN_TAB_OFF) + dir * 16 * 128 + h * 32; const float* bt = (const float*)(ldsb + SCAN_TAB_OFF) + 2 * 16 * 128 + dir * 128 + h * 32;
        const int j4 = (tid & 7) * 4;
        const u32x2 kv = ld.kv; const u32x2 qv = ld.qv2; const u32x4 zv = ld.zv;
        if (tid < 128) { float* zp = zt + (tid >> 1) * 16 + (tid & 1) * 8;
#pragma unroll
            for (int q = 0; q < 4; ++q) { zp[2 * q] = bflo(zv[q]); zp[2 * q + 1] = bfhi(zv[q]); } }
        __syncthreads();
#pragma unroll
        for (int e = 0; e < 4; ++e) { const int j = j4 + e;
            float a = bt[j];
#pragma unroll
            for (int k = 0; k < 16; ++k) a += zt[t * 16 + k] * wt[k * 128 + j];
            gt[t * PK + j] = logsigmoid_f(a) * (1.f / 16.f);
            kt[t * PK + j] = (e & 1) ? bfhi(kv[e >> 1]) : bflo(kv[e >> 1]);
            if (WANT_Q) qt[t * PK + j] = ((e & 1) ? bfhi(qv[e >> 1]) : bflo(qv[e >> 1])) * 0.17677669529663687f; }
    } else {
        const u32x4 zv = ld.zv; const u32x4 qv = ld.qv4;
        float lbv[8];
        { const float* lbt = (const float*)(ldsb + SCAN_TAB_OFF) + 2 * 16 * 128 + 2 * 128 + h * 64 + j0;
#pragma unroll
          for (int e = 0; e < 8; ++e) lbv[e] = lbt[e]; }
#pragma unroll
        for (int e = 0; e < 8; ++e) { const int j = j0 + e;
            const float z = fminf(fmaxf((e & 1) ? bfhi(zv[e >> 1]) : bflo(zv[e >> 1]), -80.f), 80.f); const float lb = lbv[e];
            const float ez = __expf(-z), sg = __builtin_amdgcn_rcpf(1.f + ez);
            gt[t * PK + j] = fmaxf(__logf(lb + (1.f - lb) * sg), -69.07755279f);
            kt[t * PK + j] = (1.f - lb) * ez * sg;
            if (WANT_Q) { const float qz = (e & 1) ? bfhi(qv[e >> 1]) : bflo(qv[e >> 1]); qt[t * PK + j] = qz * __builtin_amdgcn_rcpf(1.f + __expf(-qz)); } }
    }
#pragma unroll
    for (int e = 0; e < 8; ++e) VT[(j0 + e) * BP + t] = (bf16_t)((e & 1) ? (vv[e >> 1] >> 16) : (vv[e >> 1] & 0xffffu));
    __syncthreads();
    { float x[DK / 8];
#pragma unroll
        for (int u = 0; u < DK / 8; ++u) x[u] = gt[c.lane * PK + c.wid + 8 * u];
#pragma unroll
        for (int d = 1; d < 64; d <<= 1)
#pragma unroll
            for (int u = 0; u < DK / 8; ++u) { const float y = __shfl_up(x[u], d, 64); if (c.lane >= d) x[u] += y; }
#pragma unroll
        for (int u = 0; u < DK / 8; ++u) gt[c.lane * PK + c.wid + 8 * u] = x[u]; }
    __syncthreads();
}

template <int MX>
__device__ void scanA_item(const Ctx& c, int l, int b, int h, int cc, int dir, char* lds) {
    constexpr int DK = ScanCfg<MX>::DK, PK = DK + 1;
    float* kt = (float*)lds; float* gt = kt + 64 * PK; bf16_t* VT = (bf16_t*)(gt + 64 * PK); bf16_t* KET = VT + 64 * BP; float* tmp = (float*)(KET + 64 * BP);
    { const ScanLd ld = scan_issue<MX, false>(c, b, h, cc, dir); scan_load<MX, false>(c, ld, h, dir, nullptr, kt, gt, VT, tmp, lds); }
    const int tid = c.tid, lane = c.lane;
    for (int i = tid; i < 64 * DK; i += 512) { const int s_ = i & 63, k = i >> 6; KET[k * BP + s_] = f2bf(kt[s_ * PK + k] * __expf(gt[63 * PK + k] - gt[s_ * PK + k])); }
    __syncthreads();
    const int ch = (b * 4 + h) * 2 + dir;
    bf16_t* S = (MX == 0 ? C_SG : C_SH) + ((size_t)ch * NCHUNK + cc) * (DK * 64);
    for (int tile = c.wid; tile < (DK / 16) * 4; tile += 8) { const int tk = tile >> 2, tj = tile & 3;
        f32x4v acc = {0.f, 0.f, 0.f, 0.f};
#pragma unroll
        for (int ks = 0; ks < 2; ++ks) acc = __builtin_amdgcn_mfma_f32_16x16x32_bf16(frag16(KET, tk * 16, ks * 32, lane), frag16(VT, tj * 16, ks * 32, lane), acc, 0, 0, 0);
#pragma unroll
        for (int i = 0; i < 4; ++i) S[(tk * 16 + 4 * (lane >> 4) + i) * 64 + tj * 16 + (lane & 15)] = f2bf(acc[i]); }
    if (tid < DK) (MX == 0 ? C_DG : C_DH)[((size_t)ch * NCHUNK + cc) * DK + tid] = __expf(gt[63 * PK + tid]);
    __syncthreads();
}
__device__ void scanB_item(const Ctx& c, int item) {
    const int e = item * 512 + c.tid;
    const bool hg = e >= 65536; const int ee = hg ? e - 65536 : e;
    const int DK = hg ? 64 : 32; const int per = DK * 64;
    const int ch = ee / per, ij = ee % per, i = ij >> 6; const int dir = ch & 1;
    bf16_t* S = (hg ? C_SH : C_SG) + (size_t)ch * NCHUNK * per + ij;
    const float* Dc = (hg ? C_DH : C_DG) + (size_t)ch * NCHUNK * DK + i;
    float st = 0.f;
    for (int n0 = 0; n0 < NCHUNK; n0 += 6) {
        float sv[6], dv[6];
#pragma unroll
        for (int u = 0; u < 6; ++u) { const int n = n0 + u; const int cc = dir ? (n < 4 ? 3 - n : 135 - n) : n; sv[u] = bf2f(S[(size_t)cc * per]); dv[u] = Dc[(size_t)cc * DK]; }
#pragma unroll
        for (int u = 0; u < 6; ++u) { const int n = n0 + u; const int cc = dir ? (n < 4 ? 3 - n : 135 - n) : n; S[(size_t)cc * per] = f2bf(st); st = dv[u] * st + sv[u]; }
    }
}
template <int MX>
__device__ void scanC_item(const Ctx& c, int l, int b, int h, int cc, char* lds) {
    constexpr int DK = ScanCfg<MX>::DK, PK = DK + 1;
    float* qt = (float*)lds; float* kt = qt + 64 * PK; float* gt = kt + 64 * PK; float* ot = gt + 64 * PK;
    bf16_t* VT = (bf16_t*)(ot + 64 * 65); bf16_t* QS = VT + 64 * BP; bf16_t* QG = QS + 64 * BP; bf16_t* KS = QG + 64 * BP;
    bf16_t* SC = KS + 96 * BP; bf16_t* ST = SC + 64 * BP; float* tmp = (float*)(ST + 64 * BP);
    const int tid = c.tid, lane = c.lane;
    ScanLd ldd[2]; u32x4 srd[2];
#pragma unroll
    for (int dir = 0; dir < 2; ++dir) { ldd[dir] = scan_issue<MX, true>(c, b, h, cc, dir);
        const bf16_t* Sg = (MX == 0 ? C_SG : C_SH) + ((size_t)((b * 4 + h) * 2 + dir) * NCHUNK + cc) * (DK * 64);
        srd[dir] = (u32x4){0u, 0u, 0u, 0u}; if (tid < DK * 8) srd[dir] = *(const u32x4*)(Sg + tid * 8); }
    const u32x4 gp = *(const u32x4*)(C_P + (size_t)(b * RPB + cc * 64 + (tid >> 3)) * INC + (MX == 0 ? GLA_R : HG_OG) + h * 64 + (tid & 7) * 8);
#pragma unroll
    for (int dir = 0; dir < 2; ++dir) {
        scan_load<MX, true>(c, ldd[dir], h, dir, qt, kt, gt, VT, tmp, lds);
        if (tid < DK * 8) { const int k = tid >> 3, jb = (tid & 7) * 8; const u32x4 sr = srd[dir];
#pragma unroll
            for (int e = 0; e < 8; ++e) ST[(jb + e) * BP + k] = (bf16_t)((e & 1) ? (sr[e >> 1] >> 16) : (sr[e >> 1] & 0xffffu)); }
        for (int i = tid; i < 64 * DK; i += 512) { const int t = i / DK, k = i % DK; const int I = t >> 4;
            const float bt = gt[t * PK + k], qv = qt[t * PK + k], kv = kt[t * PK + k];
            const float Bi = I ? gt[(16 * I - 1) * PK + k] : 0.f;
            QS[t * BP + k] = f2bf(qv * __expf(bt - Bi));
            QG[t * BP + k] = f2bf(qv * __expf(bt));
            if (t < 16) KS[t * BP + k] = f2bf(kv * __expf(gt[15 * PK + k] - bt));
            if (t < 32) KS[(16 + t) * BP + k] = f2bf(kv * __expf(gt[31 * PK + k] - bt));
            if (t < 48) KS[(48 + t) * BP + k] = f2bf(kv * __expf(gt[47 * PK + k] - bt)); }
        { const int blk = tid >> 7, tl = (tid >> 3) & 15, s0 = (tid & 7) * 2; const int t = blk * 16 + tl;
            float a0 = 0.f, a1 = 0.f;
            if (s0 <= tl) { const int sa = blk * 16 + s0, sb = sa + 1;
                for (int k = 0; k < DK; ++k) { const float qv = qt[t * PK + k], bv = gt[t * PK + k];
                    a0 += qv * kt[sa * PK + k] * __expf(fminf(bv - gt[sa * PK + k], 0.f));
                    a1 += qv * kt[sb * PK + k] * __expf(fminf(bv - gt[sb * PK + k], 0.f)); }
                if (s0 + 1 > tl) a1 = 0.f; }
            SC[t * BP + blk * 16 + s0] = f2bf(a0); SC[t * BP + blk * 16 + s0 + 1] = f2bf(a1);
            for (int J = blk + 1; J < 4; ++J) { SC[t * BP + J * 16 + s0] = 0; SC[t * BP + J * 16 + s0 + 1] = 0; } }
        __syncthreads();
        if (c.wid < 6) { const int I = c.wid < 1 ? 1 : (c.wid < 3 ? 2 : 3), J = c.wid < 1 ? 0 : (c.wid < 3 ? c.wid - 1 : c.wid - 3);
            const bf16_t* KSI = KS + (I == 1 ? 0 : (I == 2 ? 16 : 48)) * BP;
            f32x4v acc = {0.f, 0.f, 0.f, 0.f};
#pragma unroll
            for (int ks = 0; ks < DK / 32; ++ks) acc = __builtin_amdgcn_mfma_f32_16x16x32_bf16(frag16(QS, I * 16, ks * 32, lane), frag16(KSI, J * 16, ks * 32, lane), acc, 0, 0, 0);
#pragma unroll
            for (int i = 0; i < 4; ++i) SC[(I * 16 + 4 * (lane >> 4) + i) * BP + J * 16 + (lane & 15)] = f2bf(acc[i]); }
        __syncthreads();
#pragma unroll
        for (int u = 0; u < 2; ++u) { const int tile = c.wid * 2 + u; const int ti = tile >> 2, tj = tile & 3;
            f32x4v acc = {0.f, 0.f, 0.f, 0.f};
#pragma unroll
            for (int ks = 0; ks < 2; ++ks) acc = __builtin_amdgcn_mfma_f32_16x16x32_bf16(frag16(SC, ti * 16, ks * 32, lane), frag16(VT, tj * 16, ks * 32, lane), acc, 0, 0, 0);
#pragma unroll
            for (int ks = 0; ks < DK / 32; ++ks) acc = __builtin_amdgcn_mfma_f32_16x16x32_bf16(frag16(QG, ti * 16, ks * 32, lane), frag16(ST, tj * 16, ks * 32, lane), acc, 0, 0, 0);
#pragma unroll
            for (int i = 0; i < 4; ++i) { const int t = ti * 16 + 4 * (lane >> 4) + i; const int to = dir ? 63 - t : t; float* op = ot + to * 65 + tj * 16 + (lane & 15);
                if (dir == 0) *op = acc[i]; else *op += acc[i]; } }
        __syncthreads();
    }
    { const int t = tid >> 3, j0 = (tid & 7) * 8; float o[8]; float ss = 0.f;
#pragma unroll
        for (int j = 0; j < 8; ++j) { o[j] = ot[t * 65 + j0 + j]; ss += o[j] * o[j]; }
        ss += __shfl_xor(ss, 1, 64); ss += __shfl_xor(ss, 2, 64); ss += __shfl_xor(ss, 4, 64);
        const float rstd = rsqrtf(ss * (1.f / 64.f) + NORM_EPS);
        const int r = b * RPB + cc * 64 + t;
        const float* gn = CIN(MX == 0 ? 12 : 14) + l * 64;
        float y[8];
#pragma unroll
        for (int j = 0; j < 8; ++j) y[j] = o[j] * rstd * gn[j0 + j] * silu_f((j & 1) ? bfhi(gp[j >> 1]) : bflo(gp[j >> 1]));
        u32x4 w = {cvtpk(y[0], y[1]), cvtpk(y[2], y[3]), cvtpk(y[4], y[5]), cvtpk(y[6], y[7])};
        *(u32x4*)(C_HB + (size_t)r * D + MX * 256 + h * 64 + j0) = w; }
    __syncthreads();
}

__device__ __forceinline__ void rope_cs(int pos, int i, float& cs, float& sn) {
    const float freq = __expf(-(float)i * (9.210340371976184f / 8.f));
    const float ang = (float)pos * freq;
    const float n = rintf(ang * 0.15915494309189535f);
    float rr = fmaf(-n, 6.2831854820251465f, ang); rr = fmaf(-n, -1.7484555e-7f, rr);
    cs = __cosf(rr); sn = __sinf(rr);
}

__device__ void ph_prep_rows(const Ctx& c, int l) {
    const float* gq = CIN(15) + l * 192; const float* gkv = CIN(16) + l * 128;
    for (int r = blockIdx.x * 8 + c.wid; r < NR; r += gridDim.x * 8) {
        const int b = r / RPB, j = r - b * RPB; bf16_t* pr = C_P + (size_t)r * INC;
        { float v[3]; float ss = 0.f;
#pragma unroll
            for (int i = 0; i < 3; ++i) { v[i] = bf2f(pr[MLA_CQ + c.lane + 64 * i]); ss += v[i] * v[i]; }
            ss = wave_sum(ss); const float rstd = rsqrtf(ss * (1.f / 192.f) + NORM_EPS);
#pragma unroll
            for (int i = 0; i < 3; ++i) pr[MLA_CQ + c.lane + 64 * i] = f2bf(v[i] * rstd * gq[c.lane + 64 * i]); }
        { float v[2]; float ss = 0.f;
#pragma unroll
            for (int i = 0; i < 2; ++i) { v[i] = bf2f(pr[MLA_CKV + c.lane + 64 * i]); ss += v[i] * v[i]; }
            ss = wave_sum(ss); const float rstd = rsqrtf(ss * (1.f / 128.f) + NORM_EPS);
#pragma unroll
            for (int i = 0; i < 2; ++i) pr[MLA_CKV + c.lane + 64 * i] = f2bf(v[i] * rstd * gkv[c.lane + 64 * i]); }
        if (j >= CTX) { const int t = j - CTX; const int prow = t >> 6, pcol = t & 63;
            for (int pp = c.lane; pp < 34 * 8; pp += 64) { const int g = pp >> 3, i = pp & 7;
                int col; if (g < 16) col = DF_Q + (g >> 1) * 32 + (g & 1) * 16; else if (g < 32) col = DF_K + ((g - 16) >> 1) * 32 + (g & 1) * 16; else col = MLA_KR + (g - 32) * 16;
                float cs, sn; rope_cs((g & 1) ? pcol : prow, i, cs, sn);
                const float x1 = bf2f(pr[col + i]), x2 = bf2f(pr[col + 8 + i]);
                pr[col + i] = f2bf(x1 * cs - x2 * sn); pr[col + 8 + i] = f2bf(x1 * sn + x2 * cs); } }
    }
}
__device__ void ph_rope_q(const Ctx& c) {
    for (int r = blockIdx.x * 8 + c.wid; r < NR; r += gridDim.x * 8) {
        const int b = r / RPB, j = r - b * RPB; if (j < CTX) continue;
        const int t = j - CTX; const int prow = t >> 6, pcol = t & 63;
        const int h = c.lane >> 4, g = (c.lane >> 3) & 1, i = c.lane & 7;
        bf16_t* q = C_QM + (size_t)r * 384 + h * 96 + 64 + g * 16;
        float cs, sn; rope_cs(g ? pcol : prow, i, cs, sn);
        const float x1 = bf2f(q[i]), x2 = bf2f(q[8 + i]);
        q[i] = f2bf(x1 * cs - x2 * sn); q[8 + i] = f2bf(x1 * sn + x2 * cs);
    }
}

__device__ __forceinline__ int v_st(int k, int cidx) { const int kk = (k & ~0xC) | ((k & 4) << 1) | ((k & 8) >> 1); return ((kk >> 3) * 2 + (cidx >> 5)) * 512 + ((kk & 7) * 32 + (cidx & 31)) * 2; }
__device__ __forceinline__ int v_rd_base(int lane) { return ((lane & 3) << 3) | (((lane >> 2) & 3) << 6) | (((lane >> 4) & 1) << 5) | (((lane >> 5) & 1) << 8); }
constexpr int v_rd_off(int d0, int ks, int half) { return d0 * 512 + ks * 2048 + half * 1024; }
template <int OFF> __device__ __forceinline__ s16x4 tr_read(int vb) { s16x4 r; asm volatile("ds_read_b64_tr_b16 %0, %1 offset:%2" : "=&v"(r) : "v"(vb), "i"(OFF) : "memory"); return r; }
template <int D0> __device__ __forceinline__ void pv_one(f32x16& od, int vb, bf16x8 pa0, bf16x8 pa1, bf16x8 pa2, bf16x8 pa3) {
    const s16x4 l0 = tr_read<v_rd_off(D0, 0, 0)>(vb), h0 = tr_read<v_rd_off(D0, 0, 1)>(vb), l1 = tr_read<v_rd_off(D0, 1, 0)>(vb), h1 = tr_read<v_rd_off(D0, 1, 1)>(vb);
    const s16x4 l2 = tr_read<v_rd_off(D0, 2, 0)>(vb), h2 = tr_read<v_rd_off(D0, 2, 1)>(vb), l3 = tr_read<v_rd_off(D0, 3, 0)>(vb), h3 = tr_read<v_rd_off(D0, 3, 1)>(vb);
    asm volatile("s_waitcnt lgkmcnt(0)" ::: "memory"); __builtin_amdgcn_sched_barrier(0);
#define PKV(L, H) (bf16x8){L[0], L[1], L[2], L[3], H[0], H[1], H[2], H[3]}
    od = __builtin_amdgcn_mfma_f32_32x32x16_bf16(pa0, PKV(l0, h0), od, 0, 0, 0);
    od = __builtin_amdgcn_mfma_f32_32x32x16_bf16(pa1, PKV(l1, h1), od, 0, 0, 0);
    od = __builtin_amdgcn_mfma_f32_32x32x16_bf16(pa2, PKV(l2, h2), od, 0, 0, 0);
    od = __builtin_amdgcn_mfma_f32_32x32x16_bf16(pa3, PKV(l3, h3), od, 0, 0, 0);
#undef PKV
}
constexpr float ATT_BIG = 1.0995116e12f;
constexpr float ATT_ZBIG = 1.2379400392853803e27f, ATT_ZSMALL = 8.673617379884035e-19f;
__device__ __forceinline__ float rowmax_tile(const f32x16& p0, const f32x16& p1) {
    float pmax = p0[0];
#pragma unroll
    for (int r = 1; r < 16; ++r) pmax = fmaxf(pmax, p0[r]);
#pragma unroll
    for (int r = 0; r < 16; ++r) pmax = fmaxf(pmax, p1[r]);
    auto rr = __builtin_amdgcn_permlane32_swap(__float_as_uint(pmax), __float_as_uint(pmax), false, false);
    return fmaxf(__uint_as_float(rr[0]), __uint_as_float(rr[1]));
}
__device__ __forceinline__ void softmax_tile(f32x16& p0, f32x16& p1, float& M, const float Mused, float& l_reg, const bool first,
                                             bf16x8& pa0, bf16x8& pa1, bf16x8& pa2, bf16x8& pa3, f32x16 (&o)[2], float* wsl, const int r32, const int hi) {
    if (__builtin_expect(__any(Mused != M), 0)) {
        asm volatile("" ::: "memory");
        const float dM = Mused - M;
#pragma unroll
        for (int r = 0; r < 16; ++r) { p0[r] += dM; p1[r] += dM; }
    }
    if (first) {
        float pmax = p0[0];
#pragma unroll
        for (int r = 1; r < 16; ++r) pmax = fmaxf(pmax, p0[r]);
#pragma unroll
        for (int r = 0; r < 16; ++r) pmax = fmaxf(pmax, p1[r]);
        { auto rr = __builtin_amdgcn_permlane32_swap(__float_as_uint(pmax), __float_as_uint(pmax), false, false); pmax = fmaxf(__uint_as_float(rr[0]), __uint_as_float(rr[1])); }
        M = pmax;
#pragma unroll
        for (int r = 0; r < 16; ++r) { p0[r] -= pmax; p1[r] -= pmax; }
    }
    float ps = 0.f;
#pragma unroll
    for (int r = 0; r < 16; ++r) { p0[r] = __builtin_amdgcn_exp2f(p0[r]); ps += p0[r]; }
#pragma unroll
    for (int r = 0; r < 16; ++r) { p1[r] = __builtin_amdgcn_exp2f(p1[r]); ps += p1[r]; }
    { auto rr = __builtin_amdgcn_permlane32_swap(__float_as_uint(ps), __float_as_uint(ps), false, false); ps = __uint_as_float(rr[0]) + __uint_as_float(rr[1]); }
    if (__builtin_expect(__any(ps > ATT_BIG), 0)) {
        asm volatile("" ::: "memory");
        float pm = p0[0];
#pragma unroll
        for (int r = 1; r < 16; ++r) pm = fmaxf(pm, p0[r]);
#pragma unroll
        for (int r = 0; r < 16; ++r) pm = fmaxf(pm, p1[r]);
        { auto rr = __builtin_amdgcn_permlane32_swap(__float_as_uint(pm), __float_as_uint(pm), false, false); pm = fmaxf(__uint_as_float(rr[0]), __uint_as_float(rr[1])); }
        const float alpha = pm > 1.f ? __builtin_amdgcn_rcpf(pm) : 1.f;
        M -= __builtin_amdgcn_logf(alpha);
#pragma unroll
        for (int r = 0; r < 16; ++r) { p0[r] *= alpha; p1[r] *= alpha; }
        ps *= alpha; l_reg *= alpha;
        if (hi == 0) wsl[r32] = alpha;
        asm volatile("s_waitcnt lgkmcnt(0)" ::: "memory");
#pragma unroll
        for (int r = 0; r < 16; ++r) { const float av = wsl[crow(r, hi)]; o[0][r] *= av; o[1][r] *= av; }
        asm volatile("" ::: "memory");
    }
    l_reg += ps;
#define PK4(P, BASE, OUT) do { unsigned a0 = cvtpk(P[BASE + 0], P[BASE + 1]), a1 = cvtpk(P[BASE + 2], P[BASE + 3]);   \
    unsigned b0 = cvtpk(P[BASE + 4], P[BASE + 5]), b1 = cvtpk(P[BASE + 6], P[BASE + 7]);                              \
    auto r0 = __builtin_amdgcn_permlane32_swap(a0, b0, false, false); auto r1 = __builtin_amdgcn_permlane32_swap(a1, b1, false, false); \
    u32x4 w = {r0[0], r1[0], r0[1], r1[1]}; OUT = *reinterpret_cast<bf16x8*>(&w); } while (0)
    PK4(p0, 0, pa0); PK4(p0, 8, pa1); PK4(p1, 0, pa2); PK4(p1, 8, pa3);
#undef PK4
}

constexpr int ATT_STAGE = 2 * 16384 + 2 * 8192;
constexpr int ATT_LDS = 65536 + 49152 + 8 * 64 * 4 + 16;
template <bool DIFF>
__device__ void attn_item(const Ctx& c, int l, int b, int hd, int qrow0, int krow0, int nkeys, char* lds) {
    constexpr int DQK = DIFF ? 32 : 96, NMAP = DIFF ? 2 : 1, ND0 = DQK / 16, NU = 2 * NMAP;
    constexpr int KP = DIFF ? 64 : 256;
    constexpr int KSZ = 64 * KP;
    constexpr int NKR = DIFF ? 2 : 3;
    const int tid_ = mk_tid(c.wid);
    const int tid = tid_, lane = tid_ & 63, wid = c.wid, r32 = lane & 31, hi = lane >> 5;
    char* K_lds0 = lds; char* V_lds0 = lds + 2 * 16384; float* wsl = (float*)(lds + 2 * ATT_STAGE) + wid * 64;
    const float scale = DIFF ? 0.17677669529663687f : 0.10206207261596575f;
    const float C = scale * 1.4426950408889634f;
    bf16x8 qr[NMAP][ND0];
    { const int qrow = qrow0 + wid * 32 + r32;
#pragma unroll
        for (int m = 0; m < NMAP; ++m)
#pragma unroll
            for (int d0 = 0; d0 < ND0; ++d0) {
                const bf16_t* p = DIFF ? C_P + (size_t)qrow * INC + DF_Q + (hd * 2 + m) * 32 + d0 * 16 + hi * 8
                                       : C_QM + (size_t)qrow * 384 + hd * 96 + d0 * 16 + hi * 8;
                qr[m][d0] = *(const bf16x8*)p; } }
    f32x16 o[NMAP][2]; float m_reg[NMAP], l_reg[NMAP];
#pragma unroll
    for (int m = 0; m < NMAP; ++m) { m_reg[m] = 0.f; l_reg[m] = 0.f;
#pragma unroll
        for (int d = 0; d < 2; ++d) zero_acc(o[m][d]); }
    constexpr int NKP = DIFF ? 2 : 4;
    int ksrc[NKP], vsrc[2];
#pragma unroll
    for (int q = 0; q < NKP; ++q) { const int off = (wid * NKP + q) * 1024 + lane * 16;
        if (DIFF) { const int blk = off >> 12, key = (off & 4095) >> 6, slot = (off & 63) >> 4, ch = slot ^ ((key >> 2) & 3);
            ksrc[q] = ((blk >> 1) * 64 + key) * INC + DF_K + (hd * 2 + (blk & 1)) * 32 + ch * 8; }
        else { const int tile = off >> 14, key = (off & 16383) >> 8, slot = (off & 255) >> 4, ch = slot ^ (key & 15);
            ksrc[q] = ch < 8 ? -1 - ((tile * 64 + key) * 512 + hd * 128 + ch * 8) : (ch < 12 ? (tile * 64 + key) * INC + MLA_KR + (ch - 8) * 8 : (int)0x80000000); } }
#pragma unroll
    for (int q = 0; q < 2; ++q) { const int off = (wid * 2 + q) * 1024 + lane * 16; const int tile = off >> 13, w = off & 8191;
        const int sub = w >> 9, within = w & 511; const int kk = (sub >> 1) * 8 + (within >> 6); const int col = (sub & 1) * 32 + ((within & 63) >> 1);
        const int key = (kk & ~0xC) | ((kk & 4) << 1) | ((kk & 8) >> 1);
        vsrc[q] = DIFF ? (tile * 64 + key) * INC + DF_V + hd * 64 + col : (tile * 64 + key) * 512 + hd * 128 + 64 + col; }
    const int vb0 = (int)(uintptr_t)V_lds0 + v_rd_base(lane);
#define ADMA(buf, kr) do { \
        _Pragma("unroll") for (int q = 0; q < NKP; ++q) { LAS unsigned* dst_ = (LAS unsigned*)(LAS char*)(K_lds0 + (buf) * ATT_STAGE + (wid * NKP + q) * 1024); \
            if (DIFF || ksrc[q] >= 0) __builtin_amdgcn_global_load_lds((const unsigned*)(C_P + (size_t)(kr) * INC + ksrc[q]), dst_, 16, 0, 0); \
            else if (ksrc[q] != (int)0x80000000) __builtin_amdgcn_global_load_lds((const unsigned*)(C_KVM + (size_t)(kr) * 512 + (-1 - ksrc[q])), dst_, 16, 0, 0); } \
        _Pragma("unroll") for (int q = 0; q < 2; ++q) { LAS unsigned* dst_ = (LAS unsigned*)(LAS char*)(V_lds0 + (buf) * ATT_STAGE + (wid * 2 + q) * 1024); \
            __builtin_amdgcn_global_load_lds((const unsigned*)((DIFF ? C_P + (size_t)(kr) * INC : C_KVM + (size_t)(kr) * 512) + vsrc[q]), dst_, 16, 0, 0); } } while (0)
    const int NS = nkeys >> 7;
    ADMA(0, krow0);
    for (int j = 0; j < NS; ++j) {
        asm volatile("s_waitcnt vmcnt(0)" ::: "memory");
        __syncthreads();
        if (j + 1 < NS) ADMA((j + 1) & 1, krow0 + (j + 1) * 128);
        const char* K_lds = K_lds0 + (j & 1) * ATT_STAGE; const int vb = vb0 + (j & 1) * ATT_STAGE;
        f32x16 p0[2], p1[2]; float mused[2];
#define QKT(u) do { constexpr int tt_ = (u) / NMAP, m_ = (u) % NMAP; const char* Kb = K_lds + (tt_ * NMAP + m_) * KSZ; \
            _Pragma("unroll") for (int d0 = 0; d0 < ND0; ++d0) { bf16x8 b0, b1; \
                if (DIFF) { const int ch = d0 * 2 + hi; const int ra = r32, rb = 32 + r32; \
                    b0 = *(const bf16x8*)(Kb + ra * 64 + ((ch ^ ((ra >> 2) & 3)) << 4)); b1 = *(const bf16x8*)(Kb + rb * 64 + ((ch ^ ((rb >> 2) & 3)) << 4)); } \
                else { const int cb = d0 * 32 + hi * 16; const int ra = r32, rb = 32 + r32; \
                    b0 = *(const bf16x8*)(Kb + ra * 256 + (cb ^ ((ra & 15) << 4))); b1 = *(const bf16x8*)(Kb + rb * 256 + (cb ^ ((rb & 15) << 4))); } \
                if (d0 == 0) { const float nm_ = -m_reg[m_]; mused[(u) & 1] = m_reg[m_]; const f32x16 z = {nm_,nm_,nm_,nm_,nm_,nm_,nm_,nm_,nm_,nm_,nm_,nm_,nm_,nm_,nm_,nm_}; \
                    p0[(u) & 1] = __builtin_amdgcn_mfma_f32_32x32x16_bf16(b0, qr[m_][0], z, 0, 0, 0); p1[(u) & 1] = __builtin_amdgcn_mfma_f32_32x32x16_bf16(b1, qr[m_][0], z, 0, 0, 0); \
                    asm volatile("" :: "v"(b0), "v"(b1));   } \
                else { p0[(u) & 1] = __builtin_amdgcn_mfma_f32_32x32x16_bf16(b0, qr[m_][d0], p0[(u) & 1], 0, 0, 0); p1[(u) & 1] = __builtin_amdgcn_mfma_f32_32x32x16_bf16(b1, qr[m_][d0], p1[(u) & 1], 0, 0, 0); } } \
            if (!DIFF) {   \
                __builtin_amdgcn_sched_group_barrier(0x100, 4, 0); \
                _Pragma("unroll") for (int g_ = 0; g_ < 4; ++g_) { __builtin_amdgcn_sched_group_barrier(0x8, 2, 0); __builtin_amdgcn_sched_group_barrier(0x100, 2, 0); } \
                __builtin_amdgcn_sched_group_barrier(0x8, 4, 0); } } while (0)
        QKT(0);
#pragma unroll
        for (int u = 0; u < NU; ++u) {
            const int tt = u / NMAP, m = u % NMAP;
            if (u + 1 < NU) { if (u == 0) QKT(1); else if (u == 1) QKT(2); else QKT(3); }
            bf16x8 pa0, pa1, pa2, pa3;
            softmax_tile(p0[u & 1], p1[u & 1], m_reg[m], mused[u & 1], l_reg[m], (j == 0) && (tt == 0), pa0, pa1, pa2, pa3, o[m], wsl, r32, hi);
            pv_one<0>(o[m][0], vb + tt * 8192, pa0, pa1, pa2, pa3);
            pv_one<1>(o[m][1], vb + tt * 8192, pa0, pa1, pa2, pa3);
        }
#undef QKT
    }
#undef ADMA
    float rli[NMAP][16];
#pragma unroll
    for (int m = 0; m < NMAP; ++m) {
        asm volatile("s_waitcnt lgkmcnt(0)" ::: "memory");
        if (hi == 0) wsl[r32] = l_reg[m];
        asm volatile("s_waitcnt lgkmcnt(0)" ::: "memory");
#pragma unroll
        for (int r = 0; r < 16; ++r) rli[m][r] = __builtin_amdgcn_rcpf(wsl[crow(r, hi)]);
    }
    const int orow0 = qrow0 + wid * 32;
    if (!DIFF) {
#pragma unroll
        for (int r = 0; r < 16; ++r) { bf16_t* dst = C_HB + (size_t)(orow0 + crow(r, hi)) * D + 512 + hd * 64 + r32;
            dst[0] = f2bf(o[0][0][r] * rli[0][r]); dst[32] = f2bf(o[0][1][r] * rli[0][r]); }
    } else {
        const float* lp = CIN(19) + l * 128; const float* gn = CIN(20) + l * 64; asm volatile("" : "+s"(lp), "+s"(gn));
        float s1 = lp[r32] * lp[32 + r32], s2 = lp[64 + r32] * lp[96 + r32];
#pragma unroll
        for (int o = 1; o < 32; o <<= 1) { s1 += shx(s1, o, lane); s2 += shx(s2, o, lane); }
        const float lam_init = (l == 0) ? 0.2f : 0.35550906759097f;
        const float lam = __expf(s1) - __expf(s2) + lam_init;
        const float g0 = gn[r32] * (1.f - lam_init), g1 = gn[32 + r32] * (1.f - lam_init);
#pragma unroll
        for (int r = 0; r < 16; ++r) {
            const float v0 = o[0][0][r] * rli[0][r] - lam * o[NMAP - 1][0][r] * rli[NMAP - 1][r];
            const float v1 = o[0][1][r] * rli[0][r] - lam * o[NMAP - 1][1][r] * rli[NMAP - 1][r];
            float ss = v0 * v0 + v1 * v1;
            ss += shx(ss, 1, lane); ss += shx(ss, 2, lane); ss += shx(ss, 4, lane); ss += shx(ss, 8, lane); ss += shx(ss, 16, lane);
            const float rstd = rsqrtf(ss * (1.f / 64.f) + NORM_EPS);
            bf16_t* dst = C_HB + (size_t)(orow0 + crow(r, hi)) * D + 768 + hd * 64 + r32;
            dst[0] = f2bf(v0 * rstd * g0); dst[32] = f2bf(v1 * rstd * g1); }
    }
    __syncthreads();
}
template <bool DIFF>
__device__ bool attn_item_pair(const Ctx& c, int l, int b, int hd, int qrow0, int krow0, int nkeys, char* lds) {
    constexpr int DQK = DIFF ? 32 : 96, NMAP = DIFF ? 2 : 1, ND0 = DQK / 16, NU = 2 * NMAP;
    constexpr int KP = DIFF ? 64 : 256;
    constexpr int KSZ = 64 * KP;
    constexpr int NKR = DIFF ? 2 : 3;
    const int tid_ = mk_tid(c.wid);
    const int tid = tid_, lane = tid_ & 63, wid = c.wid, r32 = lane & 31, hi = lane >> 5;
    char* K_lds0 = lds; char* V_lds0 = lds + 65536; float* wsl = (float*)(lds + 65536 + 49152) + wid * 64;
    const float scale = DIFF ? 0.17677669529663687f : 0.10206207261596575f;
    const float C = scale * 1.4426950408889634f;
    bf16x8 qr[NMAP][ND0];
    { const int qrow = qrow0 + wid * 32 + r32;
#pragma unroll
        for (int m = 0; m < NMAP; ++m)
#pragma unroll
            for (int d0 = 0; d0 < ND0; ++d0) {
                const bf16_t* p = DIFF ? C_P + (size_t)qrow * INC + DF_Q + (hd * 2 + m) * 32 + d0 * 16 + hi * 8
                                       : C_QM + (size_t)qrow * 384 + hd * 96 + d0 * 16 + hi * 8;
                qr[m][d0] = *(const bf16x8*)p; } }
    f32x16 o[NMAP][2]; float m_reg[NMAP], l_reg[NMAP];
#pragma unroll
    for (int m = 0; m < NMAP; ++m) { m_reg[m] = 0.f; l_reg[m] = 0.f;
#pragma unroll
        for (int d = 0; d < 2; ++d) zero_acc(o[m][d]); }
    constexpr int NKP = DIFF ? 2 : 4;
    int ksrc[NKP], vsrc[2];
#pragma unroll
    for (int q = 0; q < NKP; ++q) { const int off = (wid * NKP + q) * 1024 + lane * 16;
        if (DIFF) { const int blk = off >> 12, key = (off & 4095) >> 6, slot = (off & 63) >> 4, ch = slot ^ ((key >> 2) & 3);
            ksrc[q] = ((blk >> 1) * 64 + key) * INC + DF_K + (hd * 2 + (blk & 1)) * 32 + ch * 8; }
        else { const int tile = off >> 14, key = (off & 16383) >> 8, slot = (off & 255) >> 4, ch = slot ^ (key & 15);
            ksrc[q] = ch < 8 ? -1 - ((tile * 64 + key) * 512 + hd * 128 + ch * 8) : (ch < 12 ? (tile * 64 + key) * INC + MLA_KR + (ch - 8) * 8 : (int)0x80000000); } }
#pragma unroll
    for (int q = 0; q < 2; ++q) { const int off = (wid * 2 + q) * 1024 + lane * 16; const int tile = off >> 13, w = off & 8191;
        const int sub = w >> 9, within = w & 511; const int kk = (sub >> 1) * 8 + (within >> 6); const int col = (sub & 1) * 32 + ((within & 63) >> 1);
        const int key = kk;
        vsrc[q] = DIFF ? (tile * 64 + key) * INC + DF_V + hd * 64 + col : (tile * 64 + key) * 512 + hd * 128 + 64 + col; }
    const int vb0 = (int)(uintptr_t)V_lds0 + v_rd_base(lane);
    unsigned kbo[NKP], vbo[2];
#pragma unroll
    for (int q = 0; q < NKP; ++q) kbo[q] = (DIFF || ksrc[q] >= 0) ? (unsigned)ksrc[q] * 2u : (unsigned)(-1 - ksrc[q]) * 2u;
#pragma unroll
    for (int q = 0; q < 2; ++q) vbo[q] = (unsigned)vsrc[q] * 2u;
#define ADMA(kbuf, vbuf, kr) do { const char* pb_ = (const char*)C_P + (size_t)(kr) * (INC * 2); const char* kb_ = (const char*)C_KVM + (size_t)(kr) * 1024; asm volatile("" : "+s"(pb_), "+s"(kb_)); \
        _Pragma("unroll") for (int q = 0; q < NKP; ++q) { LAS unsigned* dst_ = (LAS unsigned*)(LAS char*)(K_lds0 + (kbuf) * 32768 + (wid * NKP + q) * 1024); \
            unsigned o_ = kbo[q]; asm volatile("" : "+v"(o_));     \
            if (DIFF || ksrc[q] >= 0) __builtin_amdgcn_global_load_lds((const unsigned*)(pb_ + (size_t)o_), dst_, 16, 0, 0); \
            else if (ksrc[q] != (int)0x80000000) __builtin_amdgcn_global_load_lds((const unsigned*)(kb_ + (size_t)o_), dst_, 16, 0, 0); } \
        _Pragma("unroll") for (int q = 0; q < 2; ++q) { LAS unsigned* dst_ = (LAS unsigned*)(LAS char*)(V_lds0 + (vbuf) * 16384 + (wid * 2 + q) * 1024); \
            unsigned o_ = vbo[q]; asm volatile("" : "+v"(o_)); \
            __builtin_amdgcn_global_load_lds((const unsigned*)((DIFF ? pb_ : kb_) + (size_t)o_), dst_, 16, 0, 0); } } while (0)
    float lsA = 0.f, lsB = 0.f;
    const int NS = nkeys >> 7;
    ADMA(0, 0, krow0);
    f32x16 a0, a1, b0, b1;
    zero_acc(a0); zero_acc(a1); zero_acc(b0); zero_acc(b1);
    bf16x8 pa[4], pb[4];
    int vslot = 0, vbp = vb0;
#define PKV(L, H) (bf16x8){L[0], L[1], L[2], L[3], H[0], H[1], H[2], H[3]}
#define PK4(P, BASE, OUT) do { u32x4 w = {cvtpk(P[BASE + 0], P[BASE + 1]), cvtpk(P[BASE + 2], P[BASE + 3]), cvtpk(P[BASE + 4], P[BASE + 5]), cvtpk(P[BASE + 6], P[BASE + 7])}; \
    OUT = *reinterpret_cast<bf16x8*>(&w); } while (0)
#define PACKP() do { PK4(a0, 0, pa[0]); PK4(b0, 0, pb[0]); PK4(a0, 8, pa[1]); PK4(b0, 8, pb[1]); PK4(a1, 0, pa[2]); PK4(b1, 0, pb[2]); PK4(a1, 8, pa[3]); PK4(b1, 8, pb[3]); } while (0)
#define CHK(X, B, PS) do { X[B] = __builtin_amdgcn_exp2f(X[B]); X[B + 1] = __builtin_amdgcn_exp2f(X[B + 1]); X[B + 2] = __builtin_amdgcn_exp2f(X[B + 2]); X[B + 3] = __builtin_amdgcn_exp2f(X[B + 3]); \
        PS += X[B]; PS += X[B + 1]; PS += X[B + 2]; PS += X[B + 3]; } while (0)
#define CHUNK(c) do { if ((c) == 0) CHK(a0, 0, psA); else if ((c) == 1) CHK(b0, 0, psB); else if ((c) == 2) CHK(a0, 4, psA); else if ((c) == 3) CHK(b0, 4, psB); \
        else if ((c) == 4) CHK(a0, 8, psA); else if ((c) == 5) CHK(b0, 8, psB); else if ((c) == 6) CHK(a0, 12, psA); else if ((c) == 7) CHK(b0, 12, psB); \
        else if ((c) == 8) CHK(a1, 0, psA); else if ((c) == 9) CHK(b1, 0, psB); else if ((c) == 10) CHK(a1, 4, psA); else if ((c) == 11) CHK(b1, 4, psB); \
        else if ((c) == 12) CHK(a1, 8, psA); else if ((c) == 13) CHK(b1, 8, psB); else if ((c) == 14) CHK(a1, 12, psA); else CHK(b1, 12, psB); \
        __builtin_amdgcn_sched_barrier(0); } while (0)
#define VREAD(D0B, VB, TA, TB) \
        const int va_##D0B = (VB) + (TA) * 8192, vq_##D0B = (VB) + (TB) * 8192; \
        const s16x4 l0##D0B = tr_read<v_rd_off(D0B, 0, 0)>(va_##D0B), h0##D0B = tr_read<v_rd_off(D0B, 0, 1)>(va_##D0B), l1##D0B = tr_read<v_rd_off(D0B, 1, 0)>(va_##D0B), h1##D0B = tr_read<v_rd_off(D0B, 1, 1)>(va_##D0B); \
        const s16x4 l2##D0B = tr_read<v_rd_off(D0B, 2, 0)>(va_##D0B), h2##D0B = tr_read<v_rd_off(D0B, 2, 1)>(va_##D0B), l3##D0B = tr_read<v_rd_off(D0B, 3, 0)>(va_##D0B), h3##D0B = tr_read<v_rd_off(D0B, 3, 1)>(va_##D0B); \
        s16x4 m0##D0B = l0##D0B, n0##D0B = h0##D0B, m1##D0B = l1##D0B, n1##D0B = h1##D0B, m2##D0B = l2##D0B, n2##D0B = h2##D0B, m3##D0B = l3##D0B, n3##D0B = h3##D0B; \
        if (!DIFF) { m0##D0B = tr_read<v_rd_off(D0B, 0, 0)>(vq_##D0B); n0##D0B = tr_read<v_rd_off(D0B, 0, 1)>(vq_##D0B); m1##D0B = tr_read<v_rd_off(D0B, 1, 0)>(vq_##D0B); n1##D0B = tr_read<v_rd_off(D0B, 1, 1)>(vq_##D0B); \
            m2##D0B = tr_read<v_rd_off(D0B, 2, 0)>(vq_##D0B); n2##D0B = tr_read<v_rd_off(D0B, 2, 1)>(vq_##D0B); m3##D0B = tr_read<v_rd_off(D0B, 3, 0)>(vq_##D0B); n3##D0B = tr_read<v_rd_off(D0B, 3, 1)>(vq_##D0B); }
#define VWAIT() do { asm volatile("s_waitcnt lgkmcnt(0)" ::: "memory"); __builtin_amdgcn_sched_barrier(0); } while (0)
#define PVM(D0B, i) do { f32x16& accA = o[0][D0B]; f32x16& accB = o[NMAP - 1][D0B]; \
        if ((i) == 0) accA = __builtin_amdgcn_mfma_f32_32x32x16_bf16(pa[0], PKV(l0##D0B, h0##D0B), accA, 0, 0, 0); else if ((i) == 1) accB = __builtin_amdgcn_mfma_f32_32x32x16_bf16(pb[0], PKV(m0##D0B, n0##D0B), accB, 0, 0, 0); \
        else if ((i) == 2) accA = __builtin_amdgcn_mfma_f32_32x32x16_bf16(pa[1], PKV(l1##D0B, h1##D0B), accA, 0, 0, 0); else if ((i) == 3) accB = __builtin_amdgcn_mfma_f32_32x32x16_bf16(pb[1], PKV(m1##D0B, n1##D0B), accB, 0, 0, 0); \
        else if ((i) == 4) accA = __builtin_amdgcn_mfma_f32_32x32x16_bf16(pa[2], PKV(l2##D0B, h2##D0B), accA, 0, 0, 0); else if ((i) == 5) accB = __builtin_amdgcn_mfma_f32_32x32x16_bf16(pb[2], PKV(m2##D0B, n2##D0B), accB, 0, 0, 0); \
        else if ((i) == 6) accA = __builtin_amdgcn_mfma_f32_32x32x16_bf16(pa[3], PKV(l3##D0B, h3##D0B), accA, 0, 0, 0); else accB = __builtin_amdgcn_mfma_f32_32x32x16_bf16(pb[3], PKV(m3##D0B, n3##D0B), accB, 0, 0, 0); } while (0)
#define STEP3_PV(VB, TA, TB) do { float psA = 0.f, psB = 0.f; \
        VREAD(0, VB, TA, TB) \
        VWAIT(); \
        PVM(0, 0); CHUNK(0); PVM(0, 1); CHUNK(1); PVM(0, 2); CHUNK(2); PVM(0, 3); CHUNK(3); PVM(0, 4); CHUNK(4); PVM(0, 5); CHUNK(5); \
        VREAD(1, VB, TA, TB) \
        __builtin_amdgcn_sched_barrier(0); \
        PVM(0, 6); CHUNK(6); PVM(0, 7); CHUNK(7); \
        VWAIT(); \
        PVM(1, 0); CHUNK(8); PVM(1, 1); CHUNK(9); PVM(1, 2); CHUNK(10); PVM(1, 3); CHUNK(11); PVM(1, 4); CHUNK(12); PVM(1, 5); CHUNK(13); PVM(1, 6); CHUNK(14); PVM(1, 7); CHUNK(15); \
        lsA += psA; lsB += psB; } while (0)
    constexpr int NG = ND0 / 2, NPI = DIFF ? 2 : 1, TLA = DIFF ? 1 : 0, TLB = 1;
    for (int j = 0; j < NS; ++j) {
        asm volatile("s_waitcnt vmcnt(0)" ::: "memory");
        __syncthreads();
        const int vnext = (vslot == 2) ? 0 : vslot + 1;
        if (j + 1 < NS) ADMA((j + 1) & 1, vnext, krow0 + (j + 1) * 128);
        const char* K_lds = K_lds0 + (j & 1) * 32768; const int vb = vb0 + vslot * 16384;
#define KFR(tt, m, d0, h) (*(const bf16x8*)(K_lds + ((tt) * NMAP + (m)) * KSZ + \
            (DIFF ? (((h) * 32 + r32) * 64 + ((((d0) * 2 + hi) ^ ((((h) * 32 + r32) >> 2) & 3)) << 4)) : (((h) * 32 + r32) * 256 + (((d0) * 32 + hi * 16) ^ ((((h) * 32 + r32) & 15) << 4))))))
#define KGRP(F, g, TA, TB) do { F[0] = KFR(TA, 0, 2 * (g), 0); F[1] = KFR(TB, NMAP - 1, 2 * (g), 0); F[2] = KFR(TA, 0, 2 * (g), 1); F[3] = KFR(TB, NMAP - 1, 2 * (g), 1); \
            F[4] = KFR(TA, 0, 2 * (g) + 1, 0); F[5] = KFR(TB, NMAP - 1, 2 * (g) + 1, 0); F[6] = KFR(TA, 0, 2 * (g) + 1, 1); F[7] = KFR(TB, NMAP - 1, 2 * (g) + 1, 1); } while (0)
#define QGRP(F, g) do { \
            if ((g) == 0) { const f32x16 z_ = {0.f,0.f,0.f,0.f,0.f,0.f,0.f,0.f,0.f,0.f,0.f,0.f,0.f,0.f,0.f,0.f};     \
                a0 = __builtin_amdgcn_mfma_f32_32x32x16_bf16(F[0], qr[0][0], z_, 0, 0, 0); b0 = __builtin_amdgcn_mfma_f32_32x32x16_bf16(F[1], qr[NMAP - 1][0], z_, 0, 0, 0); \
                a1 = __builtin_amdgcn_mfma_f32_32x32x16_bf16(F[2], qr[0][0], z_, 0, 0, 0); b1 = __builtin_amdgcn_mfma_f32_32x32x16_bf16(F[3], qr[NMAP - 1][0], z_, 0, 0, 0); } \
            else { a0 = __builtin_amdgcn_mfma_f32_32x32x16_bf16(F[0], qr[0][2 * (g)], a0, 0, 0, 0); b0 = __builtin_amdgcn_mfma_f32_32x32x16_bf16(F[1], qr[NMAP - 1][2 * (g)], b0, 0, 0, 0); \
                a1 = __builtin_amdgcn_mfma_f32_32x32x16_bf16(F[2], qr[0][2 * (g)], a1, 0, 0, 0); b1 = __builtin_amdgcn_mfma_f32_32x32x16_bf16(F[3], qr[NMAP - 1][2 * (g)], b1, 0, 0, 0); } \
            a0 = __builtin_amdgcn_mfma_f32_32x32x16_bf16(F[4], qr[0][2 * (g) + 1], a0, 0, 0, 0); b0 = __builtin_amdgcn_mfma_f32_32x32x16_bf16(F[5], qr[NMAP - 1][2 * (g) + 1], b0, 0, 0, 0); \
            a1 = __builtin_amdgcn_mfma_f32_32x32x16_bf16(F[6], qr[0][2 * (g) + 1], a1, 0, 0, 0); b1 = __builtin_amdgcn_mfma_f32_32x32x16_bf16(F[7], qr[NMAP - 1][2 * (g) + 1], b1, 0, 0, 0); } while (0)
#pragma unroll
        for (int pi = 0; pi < NPI; ++pi) {
            const int tA = DIFF ? pi : 0, tB = DIFF ? pi : 1;
            bf16x8 kf0[8], kf1[8];
            KGRP(kf0, 0, tA, tB); if (NG > 1) KGRP(kf1, 1, tA, tB);
            __builtin_amdgcn_sched_barrier(0);
            PACKP();
            __builtin_amdgcn_sched_barrier(0);
            QGRP(kf0, 0);
            if (NG > 1) { __builtin_amdgcn_sched_barrier(0); KGRP(kf0, 2, tA, tB); __builtin_amdgcn_sched_barrier(0); QGRP(kf1, 1); QGRP(kf0, 2); }
            __builtin_amdgcn_sched_barrier(0);
            if (pi == 0) STEP3_PV(vbp, TLA, TLB);
            else STEP3_PV(vb, pi - 1, pi - 1);
        }
#undef KFR
#undef KGRP
#undef QGRP
        vbp = vb; vslot = vnext;
    }
    { PACKP();
      __builtin_amdgcn_sched_barrier(0);
      VREAD(0, vbp, TLA, TLB)
      VREAD(1, vbp, TLA, TLB)
      VWAIT();
      PVM(0, 0); PVM(0, 1); PVM(0, 2); PVM(0, 3); PVM(0, 4); PVM(0, 5); PVM(0, 6); PVM(0, 7);
      PVM(1, 0); PVM(1, 1); PVM(1, 2); PVM(1, 3); PVM(1, 4); PVM(1, 5); PVM(1, 6); PVM(1, 7); }
#undef STEP3_PV
#undef PVM
#undef VWAIT
#undef VREAD
#undef CHUNK
#undef CHK
#undef PACKP
#undef PK4
#undef PKV
#undef ADMA
    const int tide = mk_tid(c.wid), lanee = tide & 63, r32e = lanee & 31, hie = lanee >> 5;
    { auto rr = __builtin_amdgcn_permlane32_swap(__float_as_uint(lsA), __float_as_uint(lsA), false, false); lsA = __uint_as_float(rr[0]) + __uint_as_float(rr[1]); }
    { auto rr = __builtin_amdgcn_permlane32_swap(__float_as_uint(lsB), __float_as_uint(lsB), false, false); lsB = __uint_as_float(rr[0]) + __uint_as_float(rr[1]); }
    if (DIFF) { l_reg[0] = lsA; l_reg[NMAP - 1] = lsB; } else l_reg[0] = lsA + lsB;
    float rli[NMAP][16];
#pragma unroll
    for (int m = 0; m < NMAP; ++m) {
        asm volatile("s_waitcnt lgkmcnt(0)" ::: "memory");
        if (hie == 0) wsl[r32e] = l_reg[m];
        asm volatile("s_waitcnt lgkmcnt(0)" ::: "memory");
#pragma unroll
        for (int r = 0; r < 16; ++r) rli[m][r] = __builtin_amdgcn_rcpf(wsl[crow(r, hie)]);
    }
    const int orow0 = qrow0 + wid * 32;
    if (!DIFF) {
#pragma unroll
        for (int r = 0; r < 16; ++r) { bf16_t* dst = C_HB + (size_t)(orow0 + crow(r, hie)) * D + 512 + hd * 64 + r32e;
            dst[0] = f2bf(o[0][0][r] * rli[0][r]); dst[32] = f2bf(o[0][1][r] * rli[0][r]); }
    } else {
        const float* lp = CIN(19) + l * 128; const float* gn = CIN(20) + l * 64; asm volatile("" : "+s"(lp), "+s"(gn));
        float s1 = lp[r32e] * lp[32 + r32e], s2 = lp[64 + r32e] * lp[96 + r32e];
#pragma unroll
        for (int o = 1; o < 32; o <<= 1) { s1 += shx(s1, o, lanee); s2 += shx(s2, o, lanee); }
        const float lam_init = (l == 0) ? 0.2f : 0.35550906759097f;
        const float lam = __expf(s1) - __expf(s2) + lam_init;
        const float g0 = gn[r32e] * (1.f - lam_init), g1 = gn[32 + r32e] * (1.f - lam_init);
#pragma unroll
        for (int r = 0; r < 16; ++r) {
            const float v0 = o[0][0][r] * rli[0][r] - lam * o[NMAP - 1][0][r] * rli[NMAP - 1][r];
            const float v1 = o[0][1][r] * rli[0][r] - lam * o[NMAP - 1][1][r] * rli[NMAP - 1][r];
            float ss = v0 * v0 + v1 * v1;
            ss += shx(ss, 1, lanee); ss += shx(ss, 2, lanee); ss += shx(ss, 4, lanee); ss += shx(ss, 8, lanee); ss += shx(ss, 16, lanee);
            const float rstd = rsqrtf(ss * (1.f / 64.f) + NORM_EPS);
            bf16_t* dst = C_HB + (size_t)(orow0 + crow(r, hie)) * D + 768 + hd * 64 + r32e;
            dst[0] = f2bf(v0 * rstd * g0); dst[32] = f2bf(v1 * rstd * g1); }
    }
    int* flag = (int*)(lds + 65536 + 49152 + 8 * 64 * 4);
    __syncthreads();
    if (tide == 0) *flag = 0;
    __syncthreads();
    if (!(l_reg[0] <= ATT_ZBIG && l_reg[0] >= ATT_ZSMALL) || !(l_reg[NMAP - 1] <= ATT_ZBIG && l_reg[NMAP - 1] >= ATT_ZSMALL)) *flag = 1;
    __syncthreads();
    const bool redo = *flag != 0;
    __syncthreads();
    return redo;
}
__device__ void ph_attn(const Ctx& c, int l, char* lds) {
    const bool need_ctx = (l < DEPTH - 1);
    const int nitem = 1024 + (need_ctx ? 32 : 0);
    for (int it = blockIdx.x; it < nitem; it += gridDim.x) {
        bool diff; int b, hd, q0, k0, nk;
        if (it < 1024) { const int combo = ((it >> 8) << 3) | (it & 7), qt = (it >> 3) & 31; diff = combo < 16; b = (combo >> 2) & 3; hd = combo & 3; q0 = b * RPB + CTX + qt * 256; k0 = b * RPB; nk = RPB; }
        else { const int u = it - 1024; diff = u < 16; b = u & 3; hd = (u >> 2) & 3; q0 = b * RPB; k0 = b * RPB; nk = CTX; }
        if (diff) { if (attn_item_pair<true>(c, l, b, hd, q0, k0, nk, lds)) attn_item<true>(c, l, b, hd, q0, k0, nk, lds); }
        else { if (attn_item_pair<false>(c, l, b, hd, q0, k0, nk, lds)) attn_item<false>(c, l, b, hd, q0, k0, nk, lds); }
    }
}

typedef float f32v2 __attribute__((ext_vector_type(2)));
__device__ void cvt_tables(const Ctx& c, int l) {
    for (int row = blockIdx.x * 8 + c.wid; row < 2 * NEXP; row += gridDim.x * 8) {
        const bool isu = row < NEXP; const int e = isu ? row : row - NEXP;
        const float* s = CIN(isu ? 23 : 24) + ((size_t)l * NEXP + e) * D + c.lane * 16;
        f32x4 v[4]; float mx = 0.f;
#pragma unroll
        for (int i = 0; i < 4; ++i) { v[i] = *(const f32x4*)(s + 4 * i); mx = fmaxf(mx, fmaxf(fmaxf(fabsf(v[i][0]), fabsf(v[i][1])), fmaxf(fabsf(v[i][2]), fabsf(v[i][3])))); }
#pragma unroll
        for (int o = 32; o >= 1; o >>= 1) mx = fmaxf(mx, __shfl_xor(mx, o, 64));
        const float q = mx > 0.f ? 256.f / mx : 0.f;
        if (c.lane == 0) (isu ? C_SU : C_SV)[e] = mx * (1.f / 256.f);
        u32x4 w;
#pragma unroll
        for (int i = 0; i < 4; ++i) { int p = 0; p = __builtin_amdgcn_cvt_pk_fp8_f32(v[i][0] * q, v[i][1] * q, p, false); p = __builtin_amdgcn_cvt_pk_fp8_f32(v[i][2] * q, v[i][3] * q, p, true); w[i] = (unsigned)p; }
        *(u32x4*)((isu ? C_TU8 : C_TV8) + ((size_t)(c.lane >> 3) * NEXP + e) * 128 + (c.lane & 7) * 16) = w;
    }
}
__device__ __forceinline__ unsigned ford(float x) { const unsigned u = __float_as_uint(x); return (u & 0x80000000u) ? ~u : (u | 0x80000000u); }
__device__ __forceinline__ float funord(unsigned k) { const unsigned u = (k & 0x80000000u) ? (k & 0x7fffffffu) : ~k; return __uint_as_float(u); }
__device__ __forceinline__ void sort16_desc(unsigned (&v)[16]) {
#pragma unroll
    for (int k = 2; k <= 16; k <<= 1)
#pragma unroll
        for (int j = k >> 1; j > 0; j >>= 1)
#pragma unroll
            for (int i = 0; i < 16; ++i) { const int l = i ^ j; if (l > i) { const unsigned a = v[i], b = v[l]; const unsigned hi = max(a, b), lo = min(a, b);
                if ((i & k) == 0) { v[i] = hi; v[l] = lo; } else { v[i] = lo; v[l] = hi; } } }
}
__device__ __forceinline__ void merge16_desc(unsigned (&t)[16], const unsigned (&v)[16]) {
#pragma unroll
    for (int i = 0; i < 16; ++i) t[i] = max(t[i], v[15 - i]);
#pragma unroll
    for (int j = 8; j > 0; j >>= 1)
#pragma unroll
        for (int i = 0; i < 16; ++i) { const int l = i ^ j; if (l > i) { const unsigned a = t[i], b = t[l]; t[i] = max(a, b); t[l] = min(a, b); } }
}
constexpr int TOPK_LDS = 2 * 128 * 129 * 4;
__device__ void peer_topk_item(const Ctx& c, int l, int tm, int h, char* lds) {
    float* S = (float*)lds;
    const int tid = c.tid, lane = c.lane, wid = c.wid, r32 = lane & 31, hi = lane >> 5, wm = wid >> 1, wn = wid & 1;
    const int row0 = tm * 128;
    bf16x8 fa[2][8];
#pragma unroll
    for (int p = 0; p < 2; ++p) { const bf16_t* Ap = C_Q2 + (size_t)(row0 + wm * 32 + r32) * 2048 + h * 256 + p * 128 + hi * 8;
#pragma unroll
        for (int ks = 0; ks < 8; ++ks) fa[p][ks] = *(const bf16x8*)(Ap + ks * 16); }
#pragma unroll
    for (int p = 0; p < 2; ++p) {
        f32x16 acc[2];
        zero_acc(acc[0]); zero_acc(acc[1]);
        const bf16_t* Bp = C_KEYS + ((((size_t)l * 8 + h) * 2 + p) * 128 + wn * 64 + r32) * 128 + hi * 8;
        bf16x8 fb0[8], fb1[8];
#pragma unroll
        for (int ks = 0; ks < 8; ++ks) { fb0[ks] = *(const bf16x8*)(Bp + ks * 16); fb1[ks] = *(const bf16x8*)(Bp + 32 * 128 + ks * 16); }
        asm volatile("" : "+v"(fa[p][0]), "+v"(fa[p][1]), "+v"(fa[p][2]), "+v"(fa[p][3]), "+v"(fa[p][4]), "+v"(fa[p][5]), "+v"(fa[p][6]), "+v"(fa[p][7]));
        asm volatile("" : "+v"(fb0[0]), "+v"(fb0[1]), "+v"(fb0[2]), "+v"(fb0[3]), "+v"(fb0[4]), "+v"(fb0[5]), "+v"(fb0[6]), "+v"(fb0[7]));
        asm volatile("" : "+v"(fb1[0]), "+v"(fb1[1]), "+v"(fb1[2]), "+v"(fb1[3]), "+v"(fb1[4]), "+v"(fb1[5]), "+v"(fb1[6]), "+v"(fb1[7]));
#pragma unroll
        for (int ks = 0; ks < 8; ++ks) {
            acc[0] = __builtin_amdgcn_mfma_f32_32x32x16_bf16(fa[p][ks], fb0[ks], acc[0], 0, 0, 0);
            acc[1] = __builtin_amdgcn_mfma_f32_32x32x16_bf16(fa[p][ks], fb1[ks], acc[1], 0, 0, 0);
        }
#pragma unroll
        for (int n = 0; n < 2; ++n)
#pragma unroll
            for (int r = 0; r < 16; ++r) S[(p * 128 + wm * 32 + crow(r, hi)) * 129 + wn * 64 + n * 32 + r32] = acc[n][r];
    }
    __syncthreads();
    unsigned tk[16];
    { const int list = tid >> 1, half = tid & 1; const float* sr = S + list * 129 + half * 64;
#pragma unroll
        for (int g = 0; g < 4; ++g) { unsigned v[16];
#pragma unroll
            for (int i = 0; i < 16; ++i) { const int n = half * 64 + g * 16 + i; v[i] = (ford(sr[g * 16 + i]) & ~127u) | (unsigned)(127 - n); }
            sort16_desc(v);
            if (g == 0) {
#pragma unroll
                for (int i = 0; i < 16; ++i) tk[i] = v[i]; }
            else merge16_desc(tk, v); } }
    __syncthreads();
    unsigned* X = (unsigned*)lds;
    unsigned* L = X + 256 * 17;
    if (tid & 1) {
#pragma unroll
        for (int i = 0; i < 16; ++i) X[(tid >> 1) * 17 + i] = tk[i]; }
    __syncthreads();
    if (!(tid & 1)) { unsigned v[16];
#pragma unroll
        for (int i = 0; i < 16; ++i) v[i] = X[(tid >> 1) * 17 + i];
        merge16_desc(tk, v);
#pragma unroll
        for (int i = 0; i < 16; ++i) L[(tid >> 1) * 17 + i] = tk[i]; }
    __syncthreads();
    unsigned bk[16];
    const int row = (tid >> 1) & 127, hh = tid & 1;
    const unsigned* l0 = L + row * 17; const unsigned* l1 = L + (128 + row) * 17;
    if (tid < 256) {
        float s0[8], s1[16];
#pragma unroll
        for (int ii = 0; ii < 8; ++ii) s0[ii] = funord(l0[2 * ii + hh] & ~127u);
#pragma unroll
        for (int j = 0; j < 16; ++j) s1[j] = funord(l1[j] & ~127u);
        unsigned ck[32];
        { int slot = 0;
#pragma unroll
            for (int ii = 0; ii < 8; ++ii)
#pragma unroll
                for (int j = 0; j < 16; ++j) if ((2 * ii + 1) * (j + 1) <= 16) {
                    const int i = 2 * ii + hh; const bool ok = (i + 1) * (j + 1) <= 16;
                    const unsigned key = (ford(s0[ii] + s1[j]) & ~255u) | (unsigned)(255 - (i * 16 + j));
                    ck[slot] = ok ? key : 0u; ++slot; }
#pragma unroll
            for (; slot < 32; ++slot) ck[slot] = 0u; }
        unsigned v0[16], v1[16];
#pragma unroll
        for (int i = 0; i < 16; ++i) { v0[i] = ck[i]; v1[i] = ck[16 + i]; }
        sort16_desc(v0); sort16_desc(v1);
        merge16_desc(v0, v1);
#pragma unroll
        for (int i = 0; i < 16; ++i) bk[i] = v0[i];
    }
    __syncthreads();
    if (tid < 256 && hh) {
#pragma unroll
        for (int i = 0; i < 16; ++i) X[row * 17 + i] = bk[i]; }
    __syncthreads();
    if (tid < 256 && !hh) { unsigned v[16];
#pragma unroll
        for (int i = 0; i < 16; ++i) v[i] = X[row * 17 + i];
        merge16_desc(bk, v);
        float best[16]; int eid[16]; float mx = -1e30f;
#pragma unroll
        for (int q = 0; q < 16; ++q) { const int ij = 255 - (int)(bk[q] & 255u); const int i = ij >> 4, j = ij & 15;
            const unsigned k0 = l0[i], k1 = l1[j];
            best[q] = funord(k0 & ~127u) + funord(k1 & ~127u);
            eid[q] = (127 - (int)(k0 & 127u)) * 128 + (127 - (int)(k1 & 127u));
            mx = fmaxf(mx, best[q]); }
        float sum = 0.f;
#pragma unroll
        for (int q = 0; q < 16; ++q) { best[q] = __expf(best[q] - mx); sum += best[q]; }
        const float inv = 1.f / sum;
        const size_t o = (size_t)(row0 + row) * 128 + h * 16;
#pragma unroll
        for (int q = 0; q < 16; q += 4) { *(u32x4*)(C_EI + o + q) = (u32x4){(unsigned)eid[q], (unsigned)eid[q + 1], (unsigned)eid[q + 2], (unsigned)eid[q + 3]};
            *(f32x4*)(C_EG + o + q) = (f32x4){best[q] * inv, best[q + 1] * inv, best[q + 2] * inv, best[q + 3] * inv}; }
    }
    __syncthreads();
}
__device__ __forceinline__ float gelu_tanh(float x) { const float u = 0.7978845608028654f * (x + 0.044715f * x * x * x); const float t = 1.f - 2.f / (1.f + __expf(2.f * u)); return 0.5f * x * (1.f + t); }
__device__ __forceinline__ int tok_row(int ti, bool need_ctx) { return need_ctx ? ti : (ti >> 13) * RPB + CTX + (ti & 8191); }
struct PeerTok { u32x4 t[16]; u32x4 xa, xb; f32v2 xv, gv; };
__device__ __forceinline__ void peer_issue(PeerTok& T, const unsigned char* t8, const int* el, const bf16_t* xp, int grp, bool want_x) {
#pragma unroll
    for (int u = 0; u < 16; ++u) { const int e = el[u * 8 + grp]; T.t[u] = *(const u32x4*)(t8 + (size_t)e * 128); }
    if (want_x) { T.xa = *(const u32x4*)xp; T.xb = *(const u32x4*)(xp + 8); }
}
__device__ __forceinline__ void peer_u_compute(const PeerTok& T, float* pp, int sub, int grp, int lane) {
    f32v2 x2[8];
#pragma unroll
    for (int q = 0; q < 4; ++q) { x2[q] = (f32v2){bflo(T.xa[q]), bfhi(T.xa[q])}; x2[4 + q] = (f32v2){bflo(T.xb[q]), bfhi(T.xb[q])}; }
    float keep[2];
#pragma unroll
    for (int hf = 0; hf < 2; ++hf) {
        float a[8];
#pragma unroll
        for (int u = 0; u < 8; ++u) { f32v2 s2 = {0.f, 0.f};
#pragma unroll
            for (int q = 0; q < 4; ++q) { const unsigned w = T.t[hf * 8 + u][q];
                s2 = __builtin_elementwise_fma(__builtin_amdgcn_cvt_pk_f32_fp8(w, false), x2[2 * q], s2);
                s2 = __builtin_elementwise_fma(__builtin_amdgcn_cvt_pk_f32_fp8(w, true), x2[2 * q + 1], s2); }
            a[u] = s2[0] + s2[1]; }
        const bool b2 = (lane & 4) != 0, b1 = (lane & 2) != 0, b0 = (lane & 1) != 0;
        float r4[4], r2[2];
#pragma unroll
        for (int q = 0; q < 4; ++q) { const float mine = b2 ? a[4 + q] : a[q], oth = b2 ? a[q] : a[4 + q]; r4[q] = mine + __shfl_xor(oth, 4, 64); }
#pragma unroll
        for (int q = 0; q < 2; ++q) { const float mine = b1 ? r4[2 + q] : r4[q], oth = b1 ? r4[q] : r4[2 + q]; r2[q] = mine + __shfl_xor(oth, 2, 64); }
        { const float mine = b0 ? r2[1] : r2[0], oth = b0 ? r2[0] : r2[1]; keep[hf] = mine + __shfl_xor(oth, 1, 64); }
    }
    pp[sub * 8 + grp] = keep[0]; pp[(8 + sub) * 8 + grp] = keep[1];
}
__device__ void peer_u_item(const Ctx& c, int l, int j, int tb, char* lds) {
    const bool need_ctx = (l < DEPTH - 1);
    int* el = (int*)lds + c.wid * 256;
    const int lane = c.lane, sub = lane & 7, grp = lane >> 3;
    const unsigned char* t8 = C_TU8 + (size_t)j * NEXP * 128 + sub * 16;
    const int tok0 = tb * 128 + c.wid * 16;
    const int xoff = j * 128 + sub * 16;
    PeerTok A, B;
    int e0, e1;
    { const int r = tok_row(tok0, need_ctx); e0 = C_EI[(size_t)r * 128 + lane]; e1 = C_EI[(size_t)r * 128 + 64 + lane];
      el[lane] = e0; el[64 + lane] = e1;
      peer_issue(A, t8, el, C_HB + (size_t)r * D + xoff, grp, true);
      const int r1 = tok_row(tok0 + 1, need_ctx); e0 = C_EI[(size_t)r1 * 128 + lane]; e1 = C_EI[(size_t)r1 * 128 + 64 + lane]; }
#pragma unroll 1
    for (int k = 0; k < 16; k += 2) {
        { const int r1 = tok_row(tok0 + k + 1, need_ctx); el[128 + lane] = e0; el[192 + lane] = e1;
          peer_issue(B, t8, el + 128, C_HB + (size_t)r1 * D + xoff, grp, true);
          if (k + 2 < 16) { const int r2 = tok_row(tok0 + k + 2, need_ctx); e0 = C_EI[(size_t)r2 * 128 + lane]; e1 = C_EI[(size_t)r2 * 128 + 64 + lane]; } }
        peer_u_compute(A, C_PART + ((size_t)j * NR + tok_row(tok0 + k, need_ctx)) * 128, sub, grp, lane);
        if (k + 2 < 16) { const int r2 = tok_row(tok0 + k + 2, need_ctx); el[lane] = e0; el[64 + lane] = e1;
          peer_issue(A, t8, el, C_HB + (size_t)r2 * D + xoff, grp, true);
          if (k + 3 < 16) { const int r3 = tok_row(tok0 + k + 3, need_ctx); e0 = C_EI[(size_t)r3 * 128 + lane]; e1 = C_EI[(size_t)r3 * 128 + 64 + lane]; } }
        peer_u_compute(B, C_PART + ((size_t)j * NR + tok_row(tok0 + k + 1, need_ctx)) * 128, sub, grp, lane);
    }
}
__device__ void ph_peer_combine(const Ctx& c, int l) {
    const bool need_ctx = (l < DEPTH - 1);
    const int ntok = need_ctx ? NR : NB * SEQ;
    for (int ti = blockIdx.x * 8 + c.wid; ti < ntok; ti += gridDim.x * 8) {
        const int r = tok_row(ti, need_ctx);
#pragma unroll
        for (int hf = 0; hf < 2; ++hf) { const size_t o = (size_t)r * 128 + hf * 64 + c.lane;
            const int e = C_EI[o]; float sacc = 0.f;
#pragma unroll
            for (int jj = 0; jj < 8; ++jj) sacc += C_PART[((size_t)jj * NR + r) * 128 + hf * 64 + c.lane];
            C_EG[o] = C_EG[o] * gelu_tanh(sacc * C_SU[e]) * C_SV[e]; }
    }
}
__device__ __forceinline__ void peer_v_compute(const PeerTok& T, const float* wl, float* xo, int grp, int lane) {
    f32v2 acc[8];
#pragma unroll
    for (int q = 0; q < 8; ++q) acc[q] = (f32v2){0.f, 0.f};
#pragma unroll
    for (int u = 0; u < 16; ++u) { const float wv = wl[u * 8 + grp]; const f32v2 w2 = {wv, wv};
#pragma unroll
        for (int q = 0; q < 4; ++q) { const unsigned w = T.t[u][q];
            acc[2 * q] = __builtin_elementwise_fma(__builtin_amdgcn_cvt_pk_f32_fp8(w, false), w2, acc[2 * q]);
            acc[2 * q + 1] = __builtin_elementwise_fma(__builtin_amdgcn_cvt_pk_f32_fp8(w, true), w2, acc[2 * q + 1]); } }
    const bool b5 = (lane & 32) != 0, b4 = (lane & 16) != 0, b3 = (lane & 8) != 0;
    f32v2 r4[4], r2[2], r1;
#pragma unroll
    for (int q = 0; q < 4; ++q) { const f32v2 mine = b5 ? acc[4 + q] : acc[q], oth = b5 ? acc[q] : acc[4 + q];
        r4[q] = (f32v2){mine[0] + __shfl_xor(oth[0], 32, 64), mine[1] + __shfl_xor(oth[1], 32, 64)}; }
#pragma unroll
    for (int q = 0; q < 2; ++q) { const f32v2 mine = b4 ? r4[2 + q] : r4[q], oth = b4 ? r4[q] : r4[2 + q];
        r2[q] = (f32v2){mine[0] + __shfl_xor(oth[0], 16, 64), mine[1] + __shfl_xor(oth[1], 16, 64)}; }
    { const f32v2 mine = b3 ? r2[1] : r2[0], oth = b3 ? r2[0] : r2[1]; r1 = (f32v2){mine[0] + __shfl_xor(oth[0], 8, 64), mine[1] + __shfl_xor(oth[1], 8, 64)}; }
    f32v2 xv = T.xv; const f32v2 gv = T.gv;
    xv[0] += gv[0] * r1[0]; xv[1] += gv[1] * r1[1];
    *(f32v2*)xo = xv;
}
__device__ void peer_v_item(const Ctx& c, int l, int j, int tb, char* lds) {
    const bool need_ctx = (l < DEPTH - 1);
    int* el = (int*)lds + c.wid * 512; float* wl = (float*)(el + 256);
    const int lane = c.lane, sub = lane & 7, grp = lane >> 3;
    const unsigned char* t8 = C_TV8 + (size_t)j * NEXP * 128 + sub * 16;
    const int tok0 = tb * 128 + c.wid * 16;
    const int col = j * 128 + sub * 16 + ((lane & 32) ? 8 : 0) + ((lane & 16) ? 4 : 0) + ((lane & 8) ? 2 : 0);
    const float* gate5 = C_MODT + (size_t)l * 5 * 6144 + 5 * D + col;
    PeerTok A, B;
    int e0, e1; float w0, w1;
#define VISSUE(T, tok, eoff) do { const int r_ = tok_row((tok), need_ctx); const int b_ = r_ / RPB; const bool ctx_ = (r_ - b_ * RPB) < CTX; \
        peer_issue(T, t8, el + (eoff), nullptr, grp, false); T.xv = *(const f32v2*)(xrow(c, r_) + col); T.gv = *(const f32v2*)(gate5 + (size_t)(ctx_ ? 4 : b_) * 6144); } while (0)
#define VFETCH(tok) do { const int r_ = tok_row((tok), need_ctx); e0 = C_EI[(size_t)r_ * 128 + lane]; e1 = C_EI[(size_t)r_ * 128 + 64 + lane]; w0 = C_EG[(size_t)r_ * 128 + lane]; w1 = C_EG[(size_t)r_ * 128 + 64 + lane]; } while (0)
    VFETCH(tok0);
    el[lane] = e0; el[64 + lane] = e1; wl[lane] = w0; wl[64 + lane] = w1;
    VISSUE(A, tok0, 0);
    VFETCH(tok0 + 1);
#pragma unroll 1
    for (int k = 0; k < 16; k += 2) {
        el[128 + lane] = e0; el[192 + lane] = e1; wl[128 + lane] = w0; wl[192 + lane] = w1;
        VISSUE(B, tok0 + k + 1, 128);
        if (k + 2 < 16) VFETCH(tok0 + k + 2);
        peer_v_compute(A, wl, xrow(c, tok_row(tok0 + k, need_ctx)) + col, grp, lane);
        if (k + 2 < 16) { el[lane] = e0; el[64 + lane] = e1; wl[lane] = w0; wl[64 + lane] = w1;
          VISSUE(A, tok0 + k + 2, 0);
          if (k + 3 < 16) VFETCH(tok0 + k + 3); }
        peer_v_compute(B, wl + 128, xrow(c, tok_row(tok0 + k + 1, need_ctx)) + col, grp, lane);
    }
#undef VISSUE
#undef VFETCH
}
template <int SUB>
__device__ void ph_peer_expert(const Ctx& c, int l, char* lds) {
    const bool need_ctx = (l < DEPTH - 1);
    unsigned* cnt = (unsigned*)CWS(WS_CTL) + 4096 + ((l * 2 + SUB) * 8) * 64;
    const int nitem = (need_ctx ? NR : NB * SEQ) / 128;
    const int x = (int)(xb_xcc_id() & 7u);
    volatile int* sh = (volatile int*)(lds + 16384);
    for (int jo = 0; jo < 8; ++jo) { const int j = (x + jo) & 7;
        int nxt = 0;
        if (c.tid == 0) nxt = (int)__hip_atomic_fetch_add(&cnt[j * 64], 1u, __ATOMIC_RELAXED, __HIP_MEMORY_SCOPE_AGENT);
        for (;;) {
            if (c.tid == 0) *sh = nxt;
            __syncthreads(); const int it = *sh; __syncthreads();
            if (it >= nitem) break;
            if (c.tid == 0) nxt = (int)__hip_atomic_fetch_add(&cnt[j * 64], 1u, __ATOMIC_RELAXED, __HIP_MEMORY_SCOPE_AGENT);
            if (SUB == 0) peer_u_item(c, l, j, it, lds); else peer_v_item(c, l, j, it, lds);
        }
    }
}
__device__ void ph_final(const Ctx& c) {
    const float* g = CIN(25);
    const int stride = gridDim.x * 8;
    int r = blockIdx.x * 8 + c.wid;
    f32x4 xn[4];
    if (r < NB * SEQ) { const float* src = COUT + ((size_t)r << 10);
#pragma unroll
        for (int i = 0; i < 4; ++i) xn[i] = *(const f32x4*)(src + i * 256 + c.lane * 4); }
    for (; r < NB * SEQ; r += stride) {
        float* xr = COUT + ((size_t)r << 10);
        f32x4 x[4]; float ss = 0.f;
#pragma unroll
        for (int i = 0; i < 4; ++i) { x[i] = xn[i]; ss += x[i][0] * x[i][0] + x[i][1] * x[i][1] + x[i][2] * x[i][2] + x[i][3] * x[i][3]; }
        if (r + stride < NB * SEQ) { const float* src = COUT + ((size_t)(r + stride) << 10);
#pragma unroll
            for (int i = 0; i < 4; ++i) xn[i] = *(const f32x4*)(src + i * 256 + c.lane * 4); }
        ss = wave_sum(ss); const float rstd = rsqrtf(ss * (1.f / D) + NORM_EPS);
#pragma unroll
        for (int i = 0; i < 4; ++i) { const int col = i * 256 + c.lane * 4; const f32x4 gv = *(const f32x4*)(g + col); f32x4 y;
#pragma unroll
            for (int e = 0; e < 4; ++e) y[e] = x[i][e] * rstd * gv[e];
            *(f32x4*)(xr + col) = y; }
    }
}

namespace pg8 {
#define PG8_LAS __attribute__((address_space(3)))
typedef unsigned short bf16_t;
typedef short bf16x8 __attribute__((ext_vector_type(8)));
typedef float f32x4 __attribute__((ext_vector_type(4)));
typedef unsigned u32x4 __attribute__((ext_vector_type(4)));
constexpr int BM = 256, BK = 64, HALF = 128, HTB = HALF * BK * 2  , STAGE_BYTES = 8 * HTB, NXCD = 8, WGM = 8;

__host__ __device__ __forceinline__ int lds_byte(int r, int c) { const int st = (r >> 4) * 2 + (c >> 5), rr = r & 15, cc = c & 31, ob = rr * 64 + cc * 2; return st * 1024 + (ob ^ (((ob >> 9) & 1) << 5)); }
__host__ __device__ __forceinline__ void stage_rc(int b, int& R, int& C) { const int st = b / 1024, sb = b % 1024, swz = sb ^ (((sb >> 9) & 1) << 5); R = (st >> 1) * 16 + swz / 64; C = (st & 1) * 32 + (swz % 64) / 2; }
__host__ __device__ __forceinline__ int perm32(int rho) { const int n = rho >> 4, i = rho & 15; return 8 * (i >> 2) + 4 * n + (i & 3); }

struct Unit { int pm, pn; };
struct Gemm { const bf16_t* A; const bf16_t* Bt; int M, N, K; };
struct TileOrder {
    int nM, nN, nwg, G, c; bool skip_ctx;
    __device__ void init(int nM_, int nN_, int G_, int c_, bool skip) { nM = nM_; nN = nN_; nwg = nM_ * nN_; G = G_; c = c_; skip_ctx = skip; }
    __device__ bool next(int i, Unit& u) const {
        const long L = (long)i * G + c; if (L >= nwg) return false;
        int wgid = (int)L; { const int q = nwg / NXCD, r = nwg % NXCD, xcd = wgid % NXCD, off = wgid / NXCD; wgid = (xcd < r ? xcd * (q + 1) : r * (q + 1) + (xcd - r) * q) + off; }
        const int nig = WGM * nN, gid = wgid / nig, fm = gid * WGM, gsz = (nM - fm) < WGM ? (nM - fm) : WGM;
        int pm = fm + ((wgid % nig) % gsz); u.pn = (wgid % nig) / gsz;
        if (skip_ctx) pm = 33 * (pm >> 5) + 1 + (pm & 31);
        u.pm = pm; return true;
    }
    __device__ __forceinline__ void a_ready(const Unit&) const {}
    __device__ __forceinline__ void done(const Unit&) const {}
};
template <class Epi, class Sched, bool STAMP = false>
__device__ __forceinline__ void gemm_phase(PG8_LAS unsigned char* lds, const Gemm g, const Sched& S, const Epi& E, unsigned long long* stamps, int w0) {
    const int tid = mk_tid(w0), wid = w0, lane = tid & 63, wr = wid >> 2, wc = wid & 3, fr = lane & 15, fq = lane >> 4;
    const int K = g.K, nt = K / BK;
    int ts_lo = 0, ts_hi = 0, nts = 0; const unsigned long long rt_entry = STAMP ? (unsigned long long)wall_clock64() : 0ull;
#define PG8_STAMP() do { if (STAMP && wid == 0 && nts < 64) { const unsigned long long _c = (unsigned long long)clock64(); \
        ts_lo = (lane == nts) ? (int)(unsigned)_c : ts_lo; ts_hi = (lane == nts) ? (int)(unsigned)(_c >> 32) : ts_hi; ++nts; } } while (0)
    PG8_STAMP();
    unsigned voffA[2], voffB[2];
#pragma unroll
    for (int i = 0; i < 2; ++i) { int R, C; stage_rc(tid * 16 + i * 8192, R, C); const int Rb = Epi::PERM ? ((R & ~31) + perm32(R & 31)) : R;
        voffA[i] = (unsigned)(R * K + C) * 2u; voffB[i] = (unsigned)(Rb * K + C) * 2u; }
    const size_t kstep = (size_t)(BK * 2);
    const size_t hstep = (size_t)HALF * K * 2;
    const size_t tstep = 2 * hstep;
    const unsigned ldsw = (unsigned)wid * 1024u;
    const int aoff = lds_byte(wr * 64 + fr, fq * 8), boff = lds_byte(wc * 32 + fr, fq * 8);
#define PG8_SA(b, h) (((b) * 2 + (h)) * HTB)
#define PG8_SB(b, h) ((4 + (b) * 2 + (h)) * HTB)
#define PG8_STAGE(bufoff, gbase, voff) do { _Pragma("unroll") for (int _i = 0; _i < 2; ++_i) \
        __builtin_amdgcn_global_load_lds((const unsigned*)((const char*)(gbase) + (voff)[_i]), (PG8_LAS unsigned*)(lds + (bufoff) + ldsw + _i * 8192), 16, 0, 0); } while (0)
#define PG8_LDA(dst, b, h) do { _Pragma("unroll") for (int m = 0; m < 4; ++m) _Pragma("unroll") for (int k = 0; k < 2; ++k) dst[m][k] = *(const PG8_LAS bf16x8*)(lds + PG8_SA(b, h) + aoff + m * 2048 + k * 1024); } while (0)
#define PG8_LDB(dst, b, h) do { _Pragma("unroll") for (int n = 0; n < 2; ++n) _Pragma("unroll") for (int k = 0; k < 2; ++k) dst[n][k] = *(const PG8_LAS bf16x8*)(lds + PG8_SB(b, h) + boff + n * 2048 + k * 1024); } while (0)
#define PG8_MMA(ai, bj, At, Bt) do { __builtin_amdgcn_s_setprio(1); _Pragma("unroll") for (int m = 0; m < 4; ++m) _Pragma("unroll") for (int n = 0; n < 2; ++n) _Pragma("unroll") for (int k = 0; k < 2; ++k) \
        acc[ai][bj][m][n] = __builtin_amdgcn_mfma_f32_16x16x32_bf16(Bt[n][k], At[m][k], acc[ai][bj][m][n], 0, 0, 0); __builtin_amdgcn_s_setprio(0); } while (0)
#define PG8_WAIT_V(n) asm volatile("s_waitcnt vmcnt(" #n ")" ::: "memory")
#define PG8_WAIT_L(n) asm volatile("s_waitcnt lgkmcnt(" #n ")" ::: "memory")
#define PG8_BAR __builtin_amdgcn_s_barrier()
#define PG8_SCHED __builtin_amdgcn_sched_barrier(0)
    Unit cur, nxt; int ui = 0;
    if (!S.next(0, cur)) return;
    f32x4 acc[2][2][4][2];
#pragma unroll
    for (int a = 0; a < 2; ++a)
#pragma unroll
        for (int b = 0; b < 2; ++b)
#pragma unroll
            for (int m = 0; m < 4; ++m)
#pragma unroll
                for (int n = 0; n < 2; ++n) acc[a][b][m][n] = (f32x4){0.f, 0.f, 0.f, 0.f};
    bf16x8 At[4][2], B0[2][2], B1[2][2];
    const char* cA = (const char*)g.A + (size_t)cur.pm * tstep; const char* cB = (const char*)g.Bt + (size_t)cur.pn * tstep;
    S.a_ready(cur);
    PG8_STAGE(PG8_SB(0, 0), cB, voffB); PG8_STAGE(PG8_SA(0, 0), cA, voffA); PG8_STAGE(PG8_SB(0, 1), cB + hstep, voffB); PG8_STAGE(PG8_SA(0, 1), cA + hstep, voffA);
    if (wr == 1) PG8_BAR;
    PG8_WAIT_V(4); PG8_BAR;
    PG8_STAGE(PG8_SB(1, 0), cB + kstep, voffB); PG8_STAGE(PG8_SA(1, 0), cA + kstep, voffA); PG8_STAGE(PG8_SB(1, 1), cB + hstep + kstep, voffB);
    PG8_WAIT_V(6); PG8_BAR;
    PG8_STAMP();
    for (;;) {
        const bool has_next = S.next(ui + 1, nxt);
        const char* nA = has_next ? (const char*)g.A + (size_t)nxt.pm * tstep : cA; const char* nB = has_next ? (const char*)g.Bt + (size_t)nxt.pn * tstep : cB;
        for (int t = 0; t < nt; t += 2) {
            const bool last = (t == nt - 2);
            const char* a1 = cA + (size_t)(t + 1) * kstep;
            const char* a2 = last ? nA : cA + (size_t)(t + 2) * kstep; const char* b2 = last ? nB : cB + (size_t)(t + 2) * kstep;
            const char* a3 = a2 + kstep; const char* b3 = b2 + kstep;
            if (last && has_next) S.a_ready(nxt);
            PG8_LDB(B0, 0, 0); PG8_SCHED; PG8_LDA(At, 0, 0); PG8_STAGE(PG8_SA(1, 1), a1 + hstep, voffA);
            PG8_WAIT_L(8); PG8_BAR; PG8_WAIT_L(0); PG8_MMA(0, 0, At, B0); PG8_BAR; PG8_SCHED;
            PG8_LDB(B1, 0, 1); PG8_STAGE(PG8_SB(0, 0), b2, voffB);
            PG8_BAR; PG8_WAIT_L(0); PG8_MMA(0, 1, At, B1); PG8_BAR;
            PG8_LDA(At, 0, 1); PG8_STAGE(PG8_SA(0, 0), a2, voffA);
            PG8_BAR; PG8_WAIT_L(0); PG8_MMA(1, 0, At, B0); PG8_BAR; PG8_SCHED;
            PG8_STAGE(PG8_SB(0, 1), b2 + hstep, voffB);
            PG8_WAIT_V(6); PG8_BAR; PG8_MMA(1, 1, At, B1); PG8_BAR;
            PG8_LDB(B0, 1, 0); PG8_SCHED; PG8_LDA(At, 1, 0); PG8_STAGE(PG8_SA(0, 1), a2 + hstep, voffA);
            PG8_WAIT_L(8); PG8_BAR; PG8_WAIT_L(0); PG8_MMA(0, 0, At, B0); PG8_BAR; PG8_SCHED;
            PG8_LDB(B1, 1, 1); PG8_STAGE(PG8_SB(1, 0), b3, voffB);
            PG8_BAR; PG8_WAIT_L(0); PG8_MMA(0, 1, At, B1); PG8_BAR;
            PG8_LDA(At, 1, 1); PG8_STAGE(PG8_SA(1, 0), a3, voffA);
            PG8_BAR; PG8_WAIT_L(0); PG8_MMA(1, 0, At, B0); PG8_BAR; PG8_SCHED;
            PG8_STAGE(PG8_SB(1, 1), b3 + hstep, voffB);
            PG8_WAIT_V(6); PG8_BAR; PG8_MMA(1, 1, At, B1); PG8_BAR;
        }
        PG8_STAMP();
        if constexpr (!Epi::AFTER_DRAIN) { E(acc, cur, wr, wc, fr, fq); S.done(cur); }
        PG8_STAMP();
        if (!has_next) break;
#pragma unroll
        for (int a = 0; a < 2; ++a)
#pragma unroll
            for (int b = 0; b < 2; ++b)
#pragma unroll
                for (int m = 0; m < 4; ++m)
#pragma unroll
                    for (int n = 0; n < 2; ++n) acc[a][b][m][n] = (f32x4){0.f, 0.f, 0.f, 0.f};
        cur = nxt; cA = nA; cB = nB; ++ui;
    }
    PG8_WAIT_V(0);
    if (wr == 0) PG8_BAR;
    PG8_BAR;
    if constexpr (Epi::AFTER_DRAIN) { E.fused(acc, cur, wr, wc, fr, fq, lds, wid, lane); S.done(cur); }
    PG8_STAMP();
    if (STAMP && wid == 0) { stamps[lane] = lane < nts ? (((unsigned long long)(unsigned)ts_hi << 32) | (unsigned)ts_lo) : 0ull;
        if (lane == 62) stamps[62] = rt_entry; if (lane == 63) stamps[63] = (unsigned long long)wall_clock64(); }
#undef PG8_STAMP
#undef PG8_SA
#undef PG8_SB
#undef PG8_STAGE
#undef PG8_LDA
#undef PG8_LDB
#undef PG8_MMA
#undef PG8_WAIT_V
#undef PG8_WAIT_L
#undef PG8_BAR
#undef PG8_SCHED
}

struct EpiStoreBf16 {
    static constexpr bool PERM = true, AFTER_DRAIN = false;
    bf16_t* O; int ldc; int ncols; int slo, shi; float scale;
    __device__ __forceinline__ void operator()(const f32x4 (&acc)[2][2][4][2], const Unit& u, int wr, int wc, int fr, int fq) const {
        const int row0 = u.pm * BM + wr * 64 + fr, col0 = u.pn * BM + wc * 32 + 8 * fq;
        float sc[2];
#pragma unroll
        for (int bj = 0; bj < 2; ++bj) { const int cb = u.pn * BM + bj * HALF; sc[bj] = (cb >= slo && cb < shi) ? scale : 1.f; }
#pragma unroll
        for (int ai = 0; ai < 2; ++ai)
#pragma unroll
            for (int m = 0; m < 4; ++m) { bf16_t* rowp = O + (size_t)(row0 + ai * HALF + m * 16) * ldc + col0;
#pragma unroll
                for (int bj = 0; bj < 2; ++bj) if (col0 + bj * HALF < ncols) { const f32x4 v0 = acc[ai][bj][m][0] * sc[bj], v1 = acc[ai][bj][m][1] * sc[bj];
                    u32x4 w; w.x = ::cvtpk(v0[0], v0[1]); w.y = ::cvtpk(v0[2], v0[3]); w.z = ::cvtpk(v1[0], v1[1]); w.w = ::cvtpk(v1[2], v1[3]);
                    *(u32x4*)(rowp + bj * HALF) = w; }
                asm volatile("" ::: "memory"); }
    }
};
struct EpiResidX {
    static constexpr bool PERM = false, AFTER_DRAIN = false;
    float* xc; float* xout; const float* gate_l;
    __device__ __forceinline__ void operator()(const f32x4 (&acc)[2][2][4][2], const Unit& u, int wr, int wc, int fr, int fq) const {
        const int rowt = u.pm * BM; const int b = rowt / RPB, j0 = rowt - b * RPB; const bool isctx = j0 < CTX;
        float* xb = isctx ? xc + ((size_t)(b * CTX + j0) << 10) : xout + ((size_t)(b * SEQ + j0 - CTX) << 10);
        const float* gt = gate_l + (size_t)(isctx ? 4 : b) * 6144;
        const int r0 = wr * 64 + fr, col0 = u.pn * BM + wc * 32 + 4 * fq;
        f32x4 gv[2][2];
#pragma unroll
        for (int bj = 0; bj < 2; ++bj)
#pragma unroll
            for (int n = 0; n < 2; ++n) gv[bj][n] = *(const f32x4*)(gt + col0 + bj * HALF + n * 16);
#pragma unroll
        for (int ai = 0; ai < 2; ++ai)
#pragma unroll
            for (int m = 0; m < 4; ++m) { float* rowp = xb + ((size_t)(r0 + ai * HALF + m * 16) << 10) + col0;
#pragma unroll
                for (int bj = 0; bj < 2; ++bj)
#pragma unroll
                    for (int n = 0; n < 2; ++n) { f32x4* p = (f32x4*)(rowp + bj * HALF + n * 16); *p = *p + gv[bj][n] * acc[ai][bj][m][n]; }
                asm volatile("" ::: "memory"); }
    }
};
}

constexpr int LDS_BYTES = 144 * 1024;
static_assert(TOPK_LDS + 16 <= LDS_BYTES && GEMM_LDS + 16 <= LDS_BYTES && ATT_LDS + 16 <= LDS_BYTES, "LDS budget");
constexpr int PPL = 13;
constexpr int N_PHASES = 1 + PPL * DEPTH + 1;
extern __shared__ __attribute__((aligned(16))) char g_lds[];

#define PHASE_FN __device__ __forceinline__ void
PHASE_FN f_p0(int w0) { const Ctx c = fresh_ctx(w0); ph_p0(c, g_lds); }
PHASE_FN f_norm0(int w0, int l) { const Ctx c = fresh_ctx(w0); ph_norm<0>(c, l); }
PHASE_FN f_norm1(int w0, int l) { const Ctx c = fresh_ctx(w0); ph_norm<1>(c, l); }
PHASE_FN f_gemm_in(int w0, int l) { const Ctx c = fresh_ctx(w0);
    pg8::Gemm g{C_HB, C_WIN + (size_t)l * INC * D, NR, 3328, D};
    pg8::TileOrder S; S.init(132, 13, (int)gridDim.x, (int)blockIdx.x, false);
    pg8::EpiStoreBf16 E{C_P, INC, INC, DF_Q, DF_Q + 256, 0.17677669529663687f * 1.4426950408889634f};
    pg8::gemm_phase<pg8::EpiStoreBf16, pg8::TileOrder>((PG8_LAS unsigned char*)g_lds, g, S, E, nullptr, w0); }
PHASE_FN f_prep(int w0, int l) {
    const Ctx c = fresh_ctx(w0); char* lds = g_lds;
    ph_prep_rows(c, l);
    scan_tables(c, l, lds);
    { const int G = (int)gridDim.x, N = 16 * NCHUNK * 2, R = (N + G - 1) / G;
      for (int q = 0; q < 2 * R; ++q) { const int mx = q & 1; int u = (q >> 1) * G + (int)blockIdx.x; if (u >= N) continue;
        const int dir = u & 1; u >>= 1; const int cc = u % NCHUNK; u /= NCHUNK; const int h = u & 3, b = u >> 2;
        if (mx == 0) scanA_item<0>(c, l, b, h, cc, dir, lds); else scanA_item<1>(c, l, b, h, cc, dir, lds); } }
}
PHASE_FN f_upproj(int w0, int l) {
    const Ctx c = fresh_ctx(w0); char* lds = g_lds;
    EpiBf16 eq{C_QM, 384, 0.10206207261596575f * 1.4426950408889634f}, ekv{C_KVM, 512, 1.f};
    for (int it = blockIdx.x; it < 132 * 7 + 384; it += gridDim.x) {
        if (it < 132 * 7) { const int tm = it / 7, tn = it % 7;
            if (tn < 3) gemm_tile(c, C_P + MLA_CQ, INC, C_WUQ + (size_t)l * 384 * 192, 192, 192, tm * 256, tn * 128, lds, eq);
            else gemm_tile(c, C_P + MLA_CKV, INC, C_WUKV + (size_t)l * 512 * 128, 128, 128, tm * 256, (tn - 3) * 128, lds, ekv); }
        else scanB_item(c, it - 132 * 7); }
}
PHASE_FN f_scanc(int w0, int l) {
    const Ctx c = fresh_ctx(w0); char* lds = g_lds; const bool need_ctx = (l < DEPTH - 1);
    ph_rope_q(c);
    scan_tables(c, l, lds);
    { const int G = (int)gridDim.x, N = 16 * NCHUNK, R = (N + G - 1) / G;
      for (int q = 0; q < 2 * R; ++q) { const int mx = q & 1; int u = (q >> 1) * G + (int)blockIdx.x; if (u >= N) continue;
        const int cc = u % NCHUNK; u /= NCHUNK; const int h = u & 3, b = u >> 2;
        if (cc < 4 && !need_ctx) continue;
        if (mx == 0) scanC_item<0>(c, l, b, h, cc, lds); else scanC_item<1>(c, l, b, h, cc, lds); } }
}
PHASE_FN f_attn(int w0, int l) { const Ctx c = fresh_ctx(w0); ph_attn(c, l, g_lds); }
PHASE_FN f_gemm_out(int w0, int l) {
    const Ctx c = fresh_ctx(w0); const bool need_ctx = (l < DEPTH - 1);
    { pg8::Gemm g{C_HB, C_WOUT + (size_t)l * D * D, NR, D, D};
      pg8::TileOrder S; S.init(need_ctx ? 132 : 128, 4, (int)gridDim.x, (int)blockIdx.x, !need_ctx);
      pg8::EpiResidX E{C_XC, COUT, C_MODT + (size_t)l * 5 * 6144 + 2 * D};
      pg8::gemm_phase<pg8::EpiResidX, pg8::TileOrder>((PG8_LAS unsigned char*)g_lds, g, S, E, nullptr, w0); }
    cvt_tables(c, l);
}
PHASE_FN f_peer_q(int w0, int l) {
    const Ctx c = fresh_ctx(w0); const bool need_ctx = (l < DEPTH - 1);
    pg8::Gemm g{C_HB, C_WQ + (size_t)l * 2048 * D, NR, 2048, D};
    pg8::TileOrder S; S.init(need_ctx ? 132 : 128, 8, (int)gridDim.x, (int)blockIdx.x, !need_ctx);
    pg8::EpiStoreBf16 E{C_Q2, 2048, 2048, 0, 0, 1.f};
    pg8::gemm_phase<pg8::EpiStoreBf16, pg8::TileOrder>((PG8_LAS unsigned char*)g_lds, g, S, E, nullptr, w0);
}
PHASE_FN f_topk(int w0, int l) {
    const Ctx c = fresh_ctx(w0); char* lds = g_lds; const bool need_ctx = (l < DEPTH - 1);
    for (int it = blockIdx.x; it < 264 * 8; it += gridDim.x) { const int tm = it >> 3, h = it & 7;
        if ((tm % 66) < 2 && !need_ctx) continue;
        peer_topk_item(c, l, tm, h, lds); }
}
PHASE_FN f_expert_u(int w0, int l) { const Ctx c = fresh_ctx(w0); ph_peer_expert<0>(c, l, g_lds); }
PHASE_FN f_expert_c(int w0, int l) { const Ctx c = fresh_ctx(w0); ph_peer_combine(c, l); }
PHASE_FN f_expert_v(int w0, int l) { const Ctx c = fresh_ctx(w0); ph_peer_expert<1>(c, l, g_lds); }
PHASE_FN f_final(int w0) { const Ctx c = fresh_ctx(w0); ph_final(c); }

__global__ void __launch_bounds__(512, 2) mk_fwd(Params p) {
    volatile LAS unsigned* bst = (volatile LAS unsigned*)(g_lds + LDS_BYTES - 16);
    const bool t0 = threadIdx.x == 0; const int w0 = __builtin_amdgcn_readfirstlane((int)threadIdx.x >> 6);
    if (t0) { bst[0] = 0u; bst[1] = 0u; bst[2] = 0u; bst[3] = 0u; }
    __syncthreads();
    XcdBarrier bar; bar.bar = (unsigned*)(p.ws + WS_CTL); bar.x = 0; bar.st = bst; bar.t0 = t0;
    const int lo = p.ph_lo, hi = p.ph_hi;
    const bool multi = (hi - lo) > 1;
    if (multi) bar = xcd_barrier_post((unsigned*)(p.ws + WS_CTL), bst, t0);
#ifndef PHMASK
#define PHMASK 0xFFFF
#endif
#define EN(s) ((PHMASK >> (s)) & 1)
#define IN(k) (lo <= (k) && (k) < hi)
#define SEAM(k) do { if (IN(k) && IN((k) + 1)) xcd_barrier(bar); } while (0)
    if (EN(0) && IN(0)) f_p0(w0);
    SEAM(0);
#define LAYER(l) do { constexpr int base = 1 + PPL * (l); \
        if (EN(1) && IN(base + 0)) f_norm0(w0, l); SEAM(base + 0); \
        if (EN(2) && IN(base + 1)) f_gemm_in(w0, l); SEAM(base + 1); \
        if (EN(3) && IN(base + 2)) f_prep(w0, l); SEAM(base + 2); \
        if (EN(4) && IN(base + 3)) f_upproj(w0, l); SEAM(base + 3); \
        if (EN(5) && IN(base + 4)) f_scanc(w0, l); SEAM(base + 4); \
        if (EN(6) && IN(base + 5)) f_attn(w0, l); SEAM(base + 5); \
        if (EN(7) && IN(base + 6)) f_gemm_out(w0, l); SEAM(base + 6); \
        if (EN(8) && IN(base + 7)) f_norm1(w0, l); SEAM(base + 7); \
        if (EN(9) && IN(base + 8)) f_peer_q(w0, l); SEAM(base + 8); \
        if (EN(10) && IN(base + 9)) f_topk(w0, l); SEAM(base + 9); \
        if (EN(11) && IN(base + 10)) f_expert_u(w0, l); SEAM(base + 10); \
        if (EN(12) && IN(base + 11)) f_expert_c(w0, l); SEAM(base + 11); \
        if (EN(13) && IN(base + 12)) f_expert_v(w0, l); SEAM(base + 12); } while (0)
    LAYER(0);
    LAYER(1);
#undef LAYER
    if (EN(14) && IN(N_PHASES - 1)) f_final(w0);
#undef IN
#undef SEAM
}

extern "C" void kernel_launch(void* const* d_in, const int* in_sizes, int n_in, void* d_out, int out_size, void* d_ws, size_t ws_size, hipStream_t stream) {
    static int grid = 0;
    if (grid == 0) {
        if (n_in != 26 || in_sizes[0] != NB * SEQ * D || out_size != NB * SEQ * D || ws_size < WS_END) {
            fprintf(stderr, "kernel_launch: shape/workspace mismatch: n_in %d in0 %d out %d ws %zu (need %zu); nothing launched\n", n_in, n_in > 0 ? in_sizes[0] : -1, out_size, ws_size, (size_t)WS_END);
            grid = -1; return; }
        int dev = 0, cus = 0, per_cu = 0;
        if (hipGetDevice(&dev) != hipSuccess || hipDeviceGetAttribute(&cus, hipDeviceAttributeMultiprocessorCount, dev) != hipSuccess) { grid = -1; return; }
        if (hipFuncSetAttribute((const void*)mk_fwd, hipFuncAttributeMaxDynamicSharedMemorySize, LDS_BYTES) != hipSuccess) { fprintf(stderr, "kernel_launch: hipFuncSetAttribute failed\n"); grid = -1; return; }
        if (hipOccupancyMaxActiveBlocksPerMultiprocessor(&per_cu, (const void*)mk_fwd, 512, LDS_BYTES) != hipSuccess || per_cu < 1)
            fprintf(stderr, "kernel_launch: note: occupancy query reports %d workgroups per CU\n", per_cu);
        (void)hipGetLastError();
        grid = cus;
    }
    if (grid < 0) return;
    if (hipMemsetAsync((char*)d_ws + WS_CTL, 0, CTL_BYTES, stream) != hipSuccess) { fprintf(stderr, "kernel_launch: memset failed\n"); return; }
    Params p{};
    for (int i = 0; i < 26; ++i) p.in[i] = (const float*)d_in[i];
    p.out = (float*)d_out; p.ws = (unsigned char*)d_ws;
#if MK_PER_PHASE
    for (int k = 0; k < N_PHASES; ++k) { p.ph_lo = k; p.ph_hi = k + 1; hipLaunchKernelGGL(mk_fwd, dim3(grid), dim3(512), LDS_BYTES, stream, p); }
#else
    p.ph_lo = 0; p.ph_hi = N_PHASES; hipLaunchKernelGGL(mk_fwd, dim3(grid), dim3(512), LDS_BYTES, stream, p);
#endif
    const hipError_t le = hipPeekAtLastError();
    if (le != hipSuccess) fprintf(stderr, "kernel_launch: launch failed: %s\n", hipGetErrorName(le));
}
```

```cpp
#include <hip/hip_runtime.h>
#include <cstdio>
#include <cstdint>

#ifndef MK_PER_PHASE
#define MK_PER_PHASE 0
#endif

constexpr int D = 1024, NB = 4, SEQ = 8192, CTX = 256, DEPTH = 2;
constexpr int RPB = CTX + SEQ;
constexpr int NR = NB * RPB;
constexpr int INC = 3200;
constexpr int GLA_Q = 0, GLA_K = 128, GLA_V = 256, GLA_R = 512, GLA_ZF = 768, GLA_ZB = 784;
constexpr int HG_Q = 800, HG_I = 1056, HG_OG = 1312, HG_ZF = 1568, HG_ZB = 1824;
constexpr int MLA_CQ = 2080, MLA_CKV = 2272, MLA_KR = 2400;
constexpr int DF_Q = 2432, DF_K = 2688, DF_V = 2944;
constexpr int NCHUNK = RPB / 64;
constexpr int NEXP = 16384;
constexpr float NORM_EPS = 1e-6f;

typedef unsigned short bf16_t;
typedef short bf16x8 __attribute__((ext_vector_type(8)));
typedef short s16x4 __attribute__((ext_vector_type(4)));
typedef float f32x16 __attribute__((ext_vector_type(16)));
typedef float f32x4 __attribute__((ext_vector_type(4)));
typedef unsigned u32x4 __attribute__((ext_vector_type(4)));
typedef unsigned u32x2 __attribute__((ext_vector_type(2)));

constexpr size_t al256(size_t x) { return (x + 255) / 256 * 256; }
constexpr size_t WS_CTL = 0;
constexpr size_t CTL_BYTES = 65536;
constexpr size_t WS_MOD = WS_CTL + CTL_BYTES;
constexpr size_t WS_XC = al256(WS_MOD + (size_t)2 * 5 * 6144 * 4);
constexpr size_t WS_WIN = al256(WS_XC + (size_t)NB * CTX * D * 4);
constexpr size_t WS_WOUT = al256(WS_WIN + (size_t)2 * INC * D * 2);
constexpr size_t WS_WQ = al256(WS_WOUT + (size_t)2 * D * D * 2);
constexpr size_t WS_WUQ = al256(WS_WQ + (size_t)2 * 2048 * D * 2);
constexpr size_t WS_WUKV = al256(WS_WUQ + (size_t)2 * 384 * 192 * 2);
constexpr size_t WS_KEYS = al256(WS_WUKV + (size_t)2 * 512 * 128 * 2);
constexpr size_t WS_HB = al256(WS_KEYS + (size_t)2 * 16 * 128 * 128 * 2);
constexpr size_t WS_QM = al256(WS_HB + (size_t)NR * D * 2);
constexpr size_t WS_KVM = al256(WS_QM + (size_t)NR * 384 * 2);
constexpr size_t WS_SG = al256(WS_KVM + (size_t)NR * 512 * 2);
constexpr size_t WS_SH = al256(WS_SG + (size_t)32 * NCHUNK * 2048 * 2);
constexpr size_t WS_DG = al256(WS_SH + (size_t)32 * NCHUNK * 4096 * 2);
constexpr size_t WS_DH = al256(WS_DG + (size_t)32 * NCHUNK * 32 * 4);
constexpr size_t WS_P = al256(WS_DH + (size_t)32 * NCHUNK * 64 * 4);
constexpr size_t WS_XB = al256(WS_P + (size_t)NR * INC * 2);
constexpr size_t WS_END = al256(WS_XB + (size_t)NR * D * 2);
constexpr size_t WS_TU8 = WS_P;
constexpr size_t WS_TV8 = WS_P + (size_t)NEXP * D;
constexpr size_t WS_SU = WS_TV8 + (size_t)NEXP * D;
constexpr size_t WS_SV = WS_SU + (size_t)NEXP * 4;
constexpr size_t WS_Q2 = WS_P + (size_t)64 * 1024 * 1024;
constexpr size_t WS_PART = WS_Q2;
static_assert(WS_SV + (size_t)NEXP * 4 <= WS_Q2, "alias overflow 0");
static_assert(WS_Q2 + (size_t)NR * 2048 * 2 <= WS_END, "alias overflow");
constexpr size_t WS_EI = WS_SG;
constexpr size_t WS_EG = WS_EI + (size_t)NR * 128 * 4;
static_assert(WS_EG + (size_t)NR * 128 * 4 + (size_t)NR * 128 * 2 <= WS_DG, "alias overflow 2");

#define XB_TMO      128
#define XB_XCNT(j)  (256  + 64 * (j))
#define XB_XSUB(j)  (1280 + 64 * (j))
#define XB_XGEN(j)  (2304 + 64 * (j))
#define XB_TOP      3328
#define XB_TOPGEN   3392
#define XCD_BAR_WORDS 3456
#define XB_SPIN_CAP (1u << 22)
#define LAS __attribute__((address_space(3)))

__device__ __forceinline__ unsigned xb_ld(unsigned* p)              { return __hip_atomic_load(p, __ATOMIC_RELAXED, __HIP_MEMORY_SCOPE_AGENT); }
__device__ __forceinline__ unsigned xb_add(unsigned* p, unsigned v) { return __hip_atomic_fetch_add(p, v, __ATOMIC_RELAXED, __HIP_MEMORY_SCOPE_AGENT); }
__device__ __forceinline__ unsigned xb_xcc_id() { return (unsigned)__builtin_amdgcn_s_getreg((3 << 11) | 20) & 0xFu; }
#define XB_SPIN(cond, bar) do { unsigned _sp = 0; while (cond) { __builtin_amdgcn_s_sleep(1); \
    if ((++_sp & 255u) == 0u) { if (xb_ld(&(bar)[XB_TMO])) break; if (_sp > XB_SPIN_CAP) { atomicAdd(&(bar)[XB_TMO], 1u); break; } } } } while (0)

struct XcdBarrier { unsigned* bar; unsigned x; volatile LAS unsigned* st; bool t0; };

__device__ __forceinline__ XcdBarrier xcd_barrier_post(unsigned* bar, volatile LAS unsigned* st, bool t0) {
    XcdBarrier b; b.bar = bar; b.x = xb_xcc_id(); b.st = st; b.t0 = t0;
    if (t0) (void)xb_add(&bar[XB_XCNT(b.x)], 1u);
    return b;
}
__device__ __forceinline__ void xcd_barrier_complete(unsigned* bar, unsigned x, unsigned& nloc, unsigned& nx) {
    const unsigned G = gridDim.x * gridDim.y * gridDim.z;
    unsigned sum, cnt, mine, sp = 0u;
    for (;;) {
        sum = 0u; cnt = 0u; mine = 0u;
#pragma unroll
        for (unsigned j = 0; j < 16; ++j) { const unsigned c = xb_ld(&bar[XB_XCNT(j)]); sum += c; cnt += (c > 0u) ? 1u : 0u; mine = (j == x) ? c : mine; }
        if (sum == G) break;
        __builtin_amdgcn_s_sleep(1);
        if ((++sp & 255u) == 0u) { if (xb_ld(&bar[XB_TMO])) break; if (sp > XB_SPIN_CAP) { atomicAdd(&bar[XB_TMO], 1u); break; } }
    }
    nloc = mine > 0u ? mine : 1u; nx = cnt > 0u ? cnt : 1u;
}
__device__ __forceinline__ void xcd_barrier(const XcdBarrier& b) {
    asm volatile("s_waitcnt vmcnt(0)" ::: "memory");
    __syncthreads();
    if (b.t0) {
        unsigned* bar = b.bar;
        __builtin_amdgcn_s_waitcnt(0);
        unsigned nloc = b.st[0], nx = b.st[1];
        if (nloc == 0u) { xcd_barrier_complete(bar, b.x, nloc, nx); b.st[0] = nloc; b.st[1] = nx; }
        const unsigned old = xb_add(&bar[XB_XSUB(b.x)], 1u);
        const unsigned gen = old / nloc;
        if (old + 1u == (gen + 1u) * nloc) {
            __builtin_amdgcn_fence(__ATOMIC_RELEASE, "agent");
            asm volatile("s_waitcnt vmcnt(0)" ::: "memory");
            const unsigned og = xb_add(&bar[XB_TOP], 1u);
            const unsigned tg = og / nx;
            if (og + 1u == (tg + 1u) * nx) xb_add(&bar[XB_TOPGEN], 1u);
            else XB_SPIN(xb_ld(&bar[XB_TOPGEN]) == tg, bar);
            __builtin_amdgcn_fence(__ATOMIC_ACQUIRE, "agent");
            xb_add(&bar[XB_XGEN(b.x)], 1u);
            asm volatile("s_waitcnt vmcnt(0)" ::: "memory");
        } else {
            XB_SPIN(xb_ld(&bar[XB_XGEN(b.x)]) == gen, bar);
            __builtin_amdgcn_fence(__ATOMIC_ACQUIRE, "agent");
            asm volatile("s_waitcnt vmcnt(0)" ::: "memory");
        }
    }
    __syncthreads();
}

typedef __bf16 bf16v2_t __attribute__((ext_vector_type(2)));
typedef float f32v2_t __attribute__((ext_vector_type(2)));
__device__ __forceinline__ unsigned cvtpk(float lo, float hi) { const f32v2_t v = {lo, hi}; const bf16v2_t b = __builtin_convertvector(v, bf16v2_t); return __builtin_bit_cast(unsigned, b); }
__device__ __forceinline__ bf16_t f2bf(float x) { const __bf16 b = (__bf16)x; return __builtin_bit_cast(bf16_t, b); }
__device__ __forceinline__ float bf2f(bf16_t h) { return __uint_as_float(((unsigned)h) << 16); }
__device__ __forceinline__ float bflo(unsigned w) { return __uint_as_float(w << 16); }
__device__ __forceinline__ float bfhi(unsigned w) { return __uint_as_float(w & 0xffff0000u); }
__device__ __forceinline__ float silu_f(float x) { return x / (1.f + __expf(-x)); }
__device__ __forceinline__ float logsigmoid_f(float z) { return fminf(z, 0.f) - __logf(1.f + __expf(-fabsf(z))); }
__device__ __forceinline__ float wave_sum(float v) {
#pragma unroll
    for (int o = 32; o >= 1; o >>= 1) v += __shfl_xor(v, o, 64);
    return v;
}
__device__ __forceinline__ void zero_acc(f32x16& a) {
#pragma unroll
    for (int r = 0; r < 16; ++r) a[r] = 0.f;
    asm volatile("" : "+v"(a));
}
__device__ __forceinline__ int crow(int r, int hi) { return (r & 3) + 8 * (r >> 2) + 4 * hi; }

struct Params { const float* in[26]; float* out; unsigned char* ws; int ph_lo, ph_hi; };
typedef const __attribute__((address_space(4))) Params* KParams;
struct Ctx {
    KParams pp;
    int tid, lane, wid;
};
__device__ __forceinline__ int mk_tid(int w0) { unsigned m = ~0u; asm volatile("" : "+s"(m)); return (w0 << 6) | (int)__builtin_amdgcn_mbcnt_hi(m, __builtin_amdgcn_mbcnt_lo(m, 0u)); }
__device__ __forceinline__ float shx(float v, int o, int lane) { return __int_as_float(__builtin_amdgcn_ds_bpermute((lane ^ o) << 2, __float_as_int(v))); }
__device__ __forceinline__ Ctx fresh_ctx(int w0) {
    Ctx c; unsigned long long a = (unsigned long long)__builtin_amdgcn_kernarg_segment_ptr(); asm volatile("" : "+s"(a)); c.pp = (KParams)a;
    int t = mk_tid(w0); asm volatile("" : "+v"(t)); c.tid = t; c.lane = t & 63; c.wid = w0;
    return c;
}
#define CIN(i)   (c.pp->in[i])
#define COUT     (c.pp->out)
#define CWS(off) (c.pp->ws + (off))
#define C_MODT ((float*)CWS(WS_MOD))
#define C_XC   ((float*)CWS(WS_XC))
#define C_WIN  ((bf16_t*)CWS(WS_WIN))
#define C_WOUT ((bf16_t*)CWS(WS_WOUT))
#define C_WQ   ((bf16_t*)CWS(WS_WQ))
#define C_WUQ  ((bf16_t*)CWS(WS_WUQ))
#define C_WUKV ((bf16_t*)CWS(WS_WUKV))
#define C_KEYS ((bf16_t*)CWS(WS_KEYS))
#define C_HB   ((bf16_t*)CWS(WS_HB))
#define C_QM   ((bf16_t*)CWS(WS_QM))
#define C_KVM  ((bf16_t*)CWS(WS_KVM))
#define C_P    ((bf16_t*)CWS(WS_P))
#define C_TU8  ((unsigned char*)CWS(WS_TU8))
#define C_TV8  ((unsigned char*)CWS(WS_TV8))
#define C_SU   ((float*)CWS(WS_SU))
#define C_SV   ((float*)CWS(WS_SV))
#define C_PART ((bf16_t*)CWS(WS_PART))
#define C_Q2   ((bf16_t*)CWS(WS_Q2))
#define C_SG   ((bf16_t*)CWS(WS_SG))
#define C_SH   ((bf16_t*)CWS(WS_SH))
#define C_DG   ((float*)CWS(WS_DG))
#define C_DH   ((float*)CWS(WS_DH))
#define C_EI   ((unsigned short*)CWS(WS_EI))
#define C_EI32 ((const unsigned*)CWS(WS_EI))
#define C_WB   ((bf16_t*)CWS(WS_EG + (size_t)NR * 128 * 4))
#define C_WB32 ((const unsigned*)CWS(WS_EG + (size_t)NR * 128 * 4))
#define C_EG   ((float*)CWS(WS_EG))

__device__ __forceinline__ bf16_t* xrow(const Ctx& c, int r) { return (bf16_t*)CWS(WS_XB) + ((size_t)r << 10); }
__device__ __forceinline__ const float* inrow(const Ctx& c, int r) {
    const int b = r / RPB, j = r - b * RPB;
    return j < CTX ? CIN(2) + ((size_t)(b * CTX + j) << 10) : CIN(0) + ((size_t)(b * SEQ + (j - CTX)) << 10);
}

__device__ void p0_mod_item(const Ctx& c, int item, char* lds) {
    float* sc = (float*)lds;
    float* red = sc + 5 * 1024;
    const int tid = c.tid;
    for (int i = tid; i < 5 * 1024; i += 512) { const int v = i >> 10, k = i & 1023; const float x = (v < 4) ? CIN(1)[v * 1024 + k] : CIN(3)[k]; sc[i] = silu_f(x); }
    __syncthreads();
    const int l = item / 96, n0 = (item % 96) * 64;
    const int col = tid & 63, kg = tid >> 6;
    const float* w = CIN(4) + (size_t)l * 1024 * 6144 + n0 + col;
    float a[5] = {0.f, 0.f, 0.f, 0.f, 0.f};
#pragma unroll 8
    for (int kk = 0; kk < 128; ++kk) { const int k = kg * 128 + kk; const float wv = w[(size_t)k * 6144];
#pragma unroll
        for (int v = 0; v < 5; ++v) a[v] += sc[v * 1024 + k] * wv; }
#pragma unroll
    for (int v = 0; v < 5; ++v) red[(kg * 64 + col) * 5 + v] = a[v];
    __syncthreads();
    if (tid < 320) { const int cc = tid / 5, v = tid % 5; float s = 0.f;
#pragma unroll
        for (int g = 0; g < 8; ++g) s += red[(g * 64 + cc) * 5 + v];
        C_MODT[((size_t)l * 5 + v) * 6144 + n0 + cc] = s + CIN(5)[l * 6144 + n0 + cc]; }
    __syncthreads();
}
__device__ void p0_tr_tile(const float* __restrict__ src, bf16_t* __restrict__ dst, int K, int N, int k0, int n0, int tid, char* lds) {
    float* t = (float*)lds;
#pragma unroll
    for (int i = 0; i < 2; ++i) { const int k = (tid >> 4) + 32 * i, n4 = (tid & 15) * 4;
        const f32x4 v = *(const f32x4*)(src + (size_t)(k0 + k) * N + n0 + n4);
        t[k * 65 + n4 + 0] = v[0]; t[k * 65 + n4 + 1] = v[1]; t[k * 65 + n4 + 2] = v[2]; t[k * 65 + n4 + 3] = v[3]; }
    __syncthreads();
    { const int n = tid >> 3, k8 = (tid & 7) * 8; u32x4 w;
#pragma unroll
        for (int j = 0; j < 4; ++j) w[j] = cvtpk(t[(k8 + 2 * j) * 65 + n], t[(k8 + 2 * j + 1) * 65 + n]);
        *(u32x4*)(dst + (size_t)(n0 + n) * K + k0 + k8) = w; }
    __syncthreads();
}
__device__ void ph_p0(const Ctx& c, char* lds) {
    constexpr int T_WIN = 16 * 50, T_WOUT = 16 * 16, T_WQ = 16 * 32, T_UQ = 3 * 6, T_UKV = 2 * 8;
    constexpr int PER_L = T_WIN + T_WOUT + T_WQ + T_UQ + T_UKV;
    constexpr int NITEM = 192 + 2 * PER_L;
    for (int it = blockIdx.x; it < NITEM; it += gridDim.x) {
        if (it < 192) { p0_mod_item(c, it, lds); continue; }
        int t = it - 192; const int l = t / PER_L; t -= l * PER_L;
        if (t < T_WIN) { p0_tr_tile(CIN(8) + (size_t)l * D * INC, C_WIN + (size_t)l * INC * D, D, INC, (t / 50) * 64, (t % 50) * 64, c.tid, lds); continue; } t -= T_WIN;
        if (t < T_WOUT) { p0_tr_tile(CIN(9) + (size_t)l * D * D, C_WOUT + (size_t)l * D * D, D, D, (t / 16) * 64, (t % 16) * 64, c.tid, lds); continue; } t -= T_WOUT;
        if (t < T_WQ) { p0_tr_tile(CIN(21) + (size_t)l * D * 2048, C_WQ + (size_t)l * 2048 * D, D, 2048, (t / 32) * 64, (t % 32) * 64, c.tid, lds); continue; } t -= T_WQ;
        if (t < T_UQ) { p0_tr_tile(CIN(17) + (size_t)l * 192 * 384, C_WUQ + (size_t)l * 384 * 192, 192, 384, (t / 6) * 64, (t % 6) * 64, c.tid, lds); continue; } t -= T_UQ;
        p0_tr_tile(CIN(18) + (size_t)l * 128 * 512, C_WUKV + (size_t)l * 512 * 128, 128, 512, (t / 8) * 64, (t % 8) * 64, c.tid, lds);
    }
    const size_t nk8 = (size_t)2 * 16 * 128 * 128 / 8;
    for (size_t i = (size_t)blockIdx.x * 512 + c.tid; i < nk8; i += (size_t)gridDim.x * 512) {
        const f32x4 a = *(const f32x4*)(CIN(22) + i * 8), b = *(const f32x4*)(CIN(22) + i * 8 + 4);
        u32x4 w = {cvtpk(a[0], a[1]), cvtpk(a[2], a[3]), cvtpk(b[0], b[1]), cvtpk(b[2], b[3])};
        *(u32x4*)(C_KEYS + i * 8) = w;
    }
}

template <int WHICH>
__device__ void ph_norm(const Ctx& c, int l) {
    const float* g = CIN(WHICH == 0 ? 6 : 7) + l * D;
    const bool need_ctx = (l < DEPTH - 1);
    const int stride = gridDim.x * 8;
    auto next_row = [&](int r) { for (; r < NR; r += stride) { const int j = r % RPB; if (!(WHICH == 1 && j < CTX && !need_ctx)) break; } return r; };
    const bool f32src = (WHICH == 0 && l == 0);
    auto ldrow = [&](int r, u32x4 (&o)[4]) {
        if (f32src) { const float* src = inrow(c, r);
#pragma unroll
            for (int i = 0; i < 4; ++i) o[i] = *(const u32x4*)(src + i * 256 + c.lane * 4); }
        else { const bf16_t* src = xrow(c, r);
#pragma unroll
            for (int i = 0; i < 4; ++i) { const u32x2 w = *(const u32x2*)(src + i * 256 + c.lane * 4); o[i] = (u32x4){w[0], w[1], 0u, 0u}; } } };
    int r = next_row(blockIdx.x * 8 + c.wid);
    u32x4 xn[4];
    if (r < NR) ldrow(r, xn);
    while (r < NR) {
        f32x4 x[4];
#pragma unroll
        for (int i = 0; i < 4; ++i) x[i] = f32src ? (f32x4){__uint_as_float(xn[i][0]), __uint_as_float(xn[i][1]), __uint_as_float(xn[i][2]), __uint_as_float(xn[i][3])}
                                                  : (f32x4){bflo(xn[i][0]), bfhi(xn[i][0]), bflo(xn[i][1]), bfhi(xn[i][1])};
        const int rn = next_row(r + stride);
        if (rn < NR) ldrow(rn, xn);
        const int b = r / RPB, j = r - b * RPB; const bool isctx = j < CTX;
        float ss = 0.f;
#pragma unroll
        for (int i = 0; i < 4; ++i) ss += x[i][0] * x[i][0] + x[i][1] * x[i][1] + x[i][2] * x[i][2] + x[i][3] * x[i][3];
        ss = wave_sum(ss);
        const float rstd = rsqrtf(ss * (1.f / D) + NORM_EPS);
        const float* mt = C_MODT + ((size_t)l * 5 + (isctx ? 4 : b)) * 6144;
        const float* sh = mt + (WHICH == 0 ? 0 : 3) * D; const float* scl = mt + (WHICH == 0 ? 1 : 4) * D;
        bf16_t* dst = C_HB + (size_t)r * D;
        bf16_t* xr = xrow(c, r);
#pragma unroll
        for (int i = 0; i < 4; ++i) { const int col = i * 256 + c.lane * 4;
            const f32x4 gv = *(const f32x4*)(g + col), sv = *(const f32x4*)(sh + col), cv = *(const f32x4*)(scl + col);
            float y[4];
#pragma unroll
            for (int e = 0; e < 4; ++e) y[e] = x[i][e] * rstd * gv[e] * (1.f + cv[e]) + sv[e];
            u32x2 w = {cvtpk(y[0], y[1]), cvtpk(y[2], y[3])};
            *(u32x2*)(dst + col) = w;
            if (WHICH == 0 && l == 0) *(u32x2*)(xr + col) = (u32x2){cvtpk(x[i][0], x[i][1]), cvtpk(x[i][2], x[i][3])}; }
        r = rn;
    }
}

constexpr int GEMM_LDS = 98304;
template <class Epi>
__device__ __forceinline__ void gemm_tile(const Ctx& c, const bf16_t* __restrict__ A, int lda, const bf16_t* __restrict__ Bt, int ldb, int K, int m0, int n0, char* lds, const Epi& epi) {
    const int tid = c.tid, lane = tid & 63, wid = tid >> 6, r32 = lane & 31, hi = lane >> 5, wm = wid >> 1, wn = wid & 1;
    char* As = lds; char* Bs = lds + 65536;
    f32x16 acc[2][2];
#pragma unroll
    for (int m = 0; m < 2; ++m)
#pragma unroll
        for (int n = 0; n < 2; ++n) zero_acc(acc[m][n]);
    u32x4 ra[4], rb[2];
    const int srow = tid >> 3, sch = tid & 7;
    const bf16_t* Ag = A + (size_t)(m0 + srow) * lda + sch * 8;
    const bf16_t* Bg = Bt + (size_t)(n0 + srow) * ldb + sch * 8;
    const int swoff = srow * 128 + ((sch ^ ((srow >> 1) & 7)) << 4);
#define GLOAD(k0) do { _Pragma("unroll") for (int i = 0; i < 4; ++i) ra[i] = *(const u32x4*)(Ag + (size_t)(64 * i) * lda + (k0)); \
                       _Pragma("unroll") for (int i = 0; i < 2; ++i) rb[i] = *(const u32x4*)(Bg + (size_t)(64 * i) * ldb + (k0)); } while (0)
#define SWRITE(buf) do { _Pragma("unroll") for (int i = 0; i < 4; ++i) *(u32x4*)(As + (buf) * 32768 + swoff + i * 8192) = ra[i]; \
                         _Pragma("unroll") for (int i = 0; i < 2; ++i) *(u32x4*)(Bs + (buf) * 16384 + swoff + i * 8192) = rb[i]; } while (0)
    const int nk = K >> 6;
    GLOAD(0); SWRITE(0); __syncthreads();
    for (int kt = 0; kt < nk; ++kt) {
        const int buf = kt & 1;
        if (kt + 1 < nk) GLOAD((kt + 1) * 64);
        const char* Ab = As + buf * 32768; const char* Bb = Bs + buf * 16384;
#pragma unroll
        for (int ks = 0; ks < 4; ++ks) {
            bf16x8 a[2], b[2];
#pragma unroll
            for (int m = 0; m < 2; ++m) { const int row = wm * 64 + m * 32 + r32; a[m] = *(const bf16x8*)(Ab + row * 128 + (((ks * 2 + hi) ^ ((row >> 1) & 7)) << 4)); }
#pragma unroll
            for (int n = 0; n < 2; ++n) { const int row = wn * 64 + n * 32 + r32; b[n] = *(const bf16x8*)(Bb + row * 128 + (((ks * 2 + hi) ^ ((row >> 1) & 7)) << 4)); }
#pragma unroll
            for (int m = 0; m < 2; ++m)
#pragma unroll
                for (int n = 0; n < 2; ++n) acc[m][n] = __builtin_amdgcn_mfma_f32_32x32x16_bf16(a[m], b[n], acc[m][n], 0, 0, 0);
        }
        if (kt + 1 < nk) SWRITE(buf ^ 1);
        __syncthreads();
    }
#undef GLOAD
#undef SWRITE
    epi(acc, m0 + wm * 64, n0 + wn * 64, r32, hi);
}
struct EpiBf16 {
    bf16_t* C; int ldc; float scale;
    __device__ __forceinline__ void operator()(const f32x16 (&acc)[2][2], int row0, int col0, int r32, int hi) const {
        bf16_t* base = C + (size_t)(row0 + 4 * hi) * ldc + col0 + r32;
#pragma unroll
        for (int m = 0; m < 2; ++m)
#pragma unroll
            for (int r = 0; r < 16; ++r) { bf16_t* p = base + (size_t)(m * 32 + (r & 3) + 8 * (r >> 2)) * ldc;
                p[0] = f2bf(acc[m][0][r] * scale); p[32] = f2bf(acc[m][1][r] * scale);
                asm volatile("" ::: "memory"); }
    }
};

template <int MX> struct ScanCfg;
template <> struct ScanCfg<0> { static constexpr int DK = 32; };
template <> struct ScanCfg<1> { static constexpr int DK = 64; };

constexpr int BP = 72;
typedef float f32x4v __attribute__((ext_vector_type(4)));
__device__ __forceinline__ bf16x8 frag16(const bf16_t* tile, int row0, int k0, int lane) { return *(const bf16x8*)(tile + (row0 + (lane & 15)) * BP + k0 + 8 * (lane >> 4)); }

constexpr int SCAN_TAB_OFF = 128000;
__device__ __forceinline__ void scan_tables(const Ctx& c, int l, char* lds) {
    float* wtab = (float*)(lds + SCAN_TAB_OFF); float* btab = wtab + 2 * 16 * 128; float* lbtab = btab + 2 * 128;
    for (int i = c.tid; i < 2 * 16 * 128; i += 512) wtab[i] = CIN(10)[(size_t)l * 2 * 16 * 128 + i];
    if (c.tid < 256) { btab[c.tid] = CIN(11)[(size_t)l * 256 + c.tid];
        float lb = 0.f; if (l > 0) { const float r0 = CIN(13)[c.tid], r1 = CIN(13)[256 + c.tid]; lb = 1.f / (1.f + __expf(r0 - r1)); }
        lbtab[c.tid] = lb; }
    __syncthreads();
}
struct ScanLd { u32x4 vv, zv, qv4; u32x2 kv, qv2; };
template <int MX, bool WANT_Q>
__device__ __forceinline__ ScanLd scan_issue(const Ctx& c, int b, int h, int cc, int dir) {
    const int tid = c.tid; const int t = tid >> 3, j0 = (tid & 7) * 8;
    const bf16_t* pr = C_P + (size_t)(b * RPB + cc * 64 + (dir ? 63 - t : t)) * INC;
    ScanLd r; r.zv = (u32x4){0u, 0u, 0u, 0u}; r.qv4 = r.zv; r.kv = (u32x2){0u, 0u}; r.qv2 = r.kv;
    r.vv = *(const u32x4*)(pr + (MX == 0 ? GLA_V : HG_I) + h * 64 + j0);
    if (MX == 0) { const int j4 = (tid & 7) * 4;
        r.kv = *(const u32x2*)(pr + GLA_K + h * 32 + j4);
        if (WANT_Q) r.qv2 = *(const u32x2*)(pr + GLA_Q + h * 32 + j4);
        if (tid < 128) r.zv = *(const u32x4*)(C_P + (size_t)(b * RPB + cc * 64 + (dir ? 63 - (tid >> 1) : (tid >> 1))) * INC + (dir ? GLA_ZB : GLA_ZF) + (tid & 1) * 8);
    } else {
        r.zv = *(const u32x4*)(pr + (dir ? HG_ZB : HG_ZF) + h * 64 + j0);
        if (WANT_Q) r.qv4 = *(const u32x4*)(pr + HG_Q + h * 64 + j0); }
    return r;
}
template <int MX, bool WANT_Q>
__device__ __forceinline__ void scan_load(const Ctx& c, const ScanLd& ld, int h, int dir, float* qt, float* kt, float* gt, bf16_t* VT, float* tmp, const char* ldsb) {
    constexpr int DK = ScanCfg<MX>::DK, PK = DK + 1;
    const int tid = c.tid;
    const int t = tid >> 3, j0 = (tid & 7) * 8;
    const u32x4 vv = ld.vv;
    if (MX == 0) {
        float* zt = tmp; const float* wt = (const float*)(ldsb + SCAN_TAB_OFF) + dir * 16 * 128 + h * 32; const float* bt = (const float*)(ldsb + SCAN_TAB_OFF) + 2 * 16 * 128 + dir * 128 + h * 32;
        const int j4 = (tid & 7) * 4;
        const u32x2 kv = ld.kv; const u32x2 qv = ld.qv2; const u32x4 zv = ld.zv;
        if (tid < 128) { float* zp = zt + (tid >> 1) * 16 + (tid & 1) * 8;
#pragma unroll
            for (int q = 0; q < 4; ++q) { zp[2 * q] = bflo(zv[q]); zp[2 * q + 1] = bfhi(zv[q]); } }
        __syncthreads();
#pragma unroll
        for (int e = 0; e < 4; ++e) { const int j = j4 + e;
            float a = bt[j];
#pragma unroll
            for (int k = 0; k < 16; ++k) a += zt[t * 16 + k] * wt[k * 128 + j];
            gt[t * PK + j] = logsigmoid_f(a) * (1.f / 16.f);
            kt[t * PK + j] = (e & 1) ? bfhi(kv[e >> 1]) : bflo(kv[e >> 1]);
            if (WANT_Q) qt[t * PK + j] = ((e & 1) ? bfhi(qv[e >> 1]) : bflo(qv[e >> 1])) * 0.17677669529663687f; }
    } else {
        const u32x4 zv = ld.zv; const u32x4 qv = ld.qv4;
        float lbv[8];
        { const float* lbt = (const float*)(ldsb + SCAN_TAB_OFF) + 2 * 16 * 128 + 2 * 128 + h * 64 + j0;
#pragma unroll
          for (int e = 0; e < 8; ++e) lbv[e] = lbt[e]; }
#pragma unroll
        for (int e = 0; e < 8; ++e) { const int j = j0 + e;
            const float z = fminf(fmaxf((e & 1) ? bfhi(zv[e >> 1]) : bflo(zv[e >> 1]), -80.f), 80.f); const float lb = lbv[e];
            const float ez = __expf(-z), sg = __builtin_amdgcn_rcpf(1.f + ez);
            gt[t * PK + j] = fmaxf(__logf(lb + (1.f - lb) * sg), -69.07755279f);
            kt[t * PK + j] = (1.f - lb) * ez * sg;
            if (WANT_Q) { const float qz = (e & 1) ? bfhi(qv[e >> 1]) : bflo(qv[e >> 1]); qt[t * PK + j] = qz * __builtin_amdgcn_rcpf(1.f + __expf(-qz)); } }
    }
#pragma unroll
    for (int e = 0; e < 8; ++e) VT[(j0 + e) * BP + t] = (bf16_t)((e & 1) ? (vv[e >> 1] >> 16) : (vv[e >> 1] & 0xffffu));
    __syncthreads();
    { float x[DK / 8];
#pragma unroll
        for (int u = 0; u < DK / 8; ++u) x[u] = gt[c.lane * PK + c.wid + 8 * u];
#pragma unroll
        for (int d = 1; d < 64; d <<= 1)
#pragma unroll
            for (int u = 0; u < DK / 8; ++u) { const float y = __shfl_up(x[u], d, 64); if (c.lane >= d) x[u] += y; }
#pragma unroll
        for (int u = 0; u < DK / 8; ++u) gt[c.lane * PK + c.wid + 8 * u] = x[u]; }
    __syncthreads();
}

template <int MX>
__device__ void scanA_item(const Ctx& c, int l, int b, int h, int cc, int dir, char* lds) {
    constexpr int DK = ScanCfg<MX>::DK, PK = DK + 1;
    float* kt = (float*)lds; float* gt = kt + 64 * PK; bf16_t* VT = (bf16_t*)(gt + 64 * PK); bf16_t* KET = VT + 64 * BP; float* tmp = (float*)(KET + 64 * BP);
    { const ScanLd ld = scan_issue<MX, false>(c, b, h, cc, dir); scan_load<MX, false>(c, ld, h, dir, nullptr, kt, gt, VT, tmp, lds); }
    const int tid = c.tid, lane = c.lane;
    for (int i = tid; i < 64 * DK; i += 512) { const int s_ = i & 63, k = i >> 6; KET[k * BP + s_] = f2bf(kt[s_ * PK + k] * __expf(gt[63 * PK + k] - gt[s_ * PK + k])); }
    __syncthreads();
    const int ch = (b * 4 + h) * 2 + dir;
    bf16_t* S = (MX == 0 ? C_SG : C_SH) + ((size_t)ch * NCHUNK + cc) * (DK * 64);
    for (int tile = c.wid; tile < (DK / 16) * 4; tile += 8) { const int tk = tile >> 2, tj = tile & 3;
        f32x4v acc = {0.f, 0.f, 0.f, 0.f};
#pragma unroll
        for (int ks = 0; ks < 2; ++ks) acc = __builtin_amdgcn_mfma_f32_16x16x32_bf16(frag16(KET, tk * 16, ks * 32, lane), frag16(VT, tj * 16, ks * 32, lane), acc, 0, 0, 0);
#pragma unroll
        for (int i = 0; i < 4; ++i) S[(tk * 16 + 4 * (lane >> 4) + i) * 64 + tj * 16 + (lane & 15)] = f2bf(acc[i]); }
    if (tid < DK) (MX == 0 ? C_DG : C_DH)[((size_t)ch * NCHUNK + cc) * DK + tid] = __expf(gt[63 * PK + tid]);
    __syncthreads();
}
__device__ void scanB_item(const Ctx& c, int item) {
    const int e = item * 512 + c.tid;
    const bool hg = e >= 65536; const int ee = hg ? e - 65536 : e;
    const int DK = hg ? 64 : 32; const int per = DK * 64;
    const int ch = ee / per, ij = ee % per, i = ij >> 6; const int dir = ch & 1;
    bf16_t* S = (hg ? C_SH : C_SG) + (size_t)ch * NCHUNK * per + ij;
    const float* Dc = (hg ? C_DH : C_DG) + (size_t)ch * NCHUNK * DK + i;
    float st = 0.f;
    for (int n0 = 0; n0 < NCHUNK; n0 += 6) {
        float sv[6], dv[6];
#pragma unroll
        for (int u = 0; u < 6; ++u) { const int n = n0 + u; const int cc = dir ? (n < 4 ? 3 - n : 135 - n) : n; sv[u] = bf2f(S[(size_t)cc * per]); dv[u] = Dc[(size_t)cc * DK]; }
#pragma unroll
        for (int u = 0; u < 6; ++u) { const int n = n0 + u; const int cc = dir ? (n < 4 ? 3 - n : 135 - n) : n; S[(size_t)cc * per] = f2bf(st); st = dv[u] * st + sv[u]; }
    }
}
template <int MX>
__device__ void scanC_item(const Ctx& c, int l, int b, int h, int cc, char* lds) {
    constexpr int DK = ScanCfg<MX>::DK, PK = DK + 1;
    float* qt = (float*)lds; float* kt = qt + 64 * PK; float* gt = kt + 64 * PK; float* ot = gt + 64 * PK;
    bf16_t* VT = (bf16_t*)(ot + 64 * 65); bf16_t* QS = VT + 64 * BP; bf16_t* QG = QS + 64 * BP; bf16_t* KS = QG + 64 * BP;
    bf16_t* SC = KS + 96 * BP; bf16_t* ST = SC + 64 * BP; float* tmp = (float*)(ST + 64 * BP);
    const int tid = c.tid, lane = c.lane;
    ScanLd ldd[2]; u32x4 srd[2];
#pragma unroll
    for (int dir = 0; dir < 2; ++dir) { ldd[dir] = scan_issue<MX, true>(c, b, h, cc, dir);
        const bf16_t* Sg = (MX == 0 ? C_SG : C_SH) + ((size_t)((b * 4 + h) * 2 + dir) * NCHUNK + cc) * (DK * 64);
        srd[dir] = (u32x4){0u, 0u, 0u, 0u}; if (tid < DK * 8) srd[dir] = *(const u32x4*)(Sg + tid * 8); }
    const u32x4 gp = *(const u32x4*)(C_P + (size_t)(b * RPB + cc * 64 + (tid >> 3)) * INC + (MX == 0 ? GLA_R : HG_OG) + h * 64 + (tid & 7) * 8);
#pragma unroll
    for (int dir = 0; dir < 2; ++dir) {
        scan_load<MX, true>(c, ldd[dir], h, dir, qt, kt, gt, VT, tmp, lds);
        if (tid < DK * 8) { const int k = tid >> 3, jb = (tid & 7) * 8; const u32x4 sr = srd[dir];
#pragma unroll
            for (int e = 0; e < 8; ++e) ST[(jb + e) * BP + k] = (bf16_t)((e & 1) ? (sr[e >> 1] >> 16) : (sr[e >> 1] & 0xffffu)); }
        for (int i = tid; i < 64 * DK; i += 512) { const int t = i / DK, k = i % DK; const int I = t >> 4;
            const float bt = gt[t * PK + k], qv = qt[t * PK + k], kv = kt[t * PK + k];
            const float Bi = I ? gt[(16 * I - 1) * PK + k] : 0.f;
            QS[t * BP + k] = f2bf(qv * __expf(bt - Bi));
            QG[t * BP + k] = f2bf(qv * __expf(bt));
            if (t < 16) KS[t * BP + k] = f2bf(kv * __expf(gt[15 * PK + k] - bt));
            if (t < 32) KS[(16 + t) * BP + k] = f2bf(kv * __expf(gt[31 * PK + k] - bt));
            if (t < 48) KS[(48 + t) * BP + k] = f2bf(kv * __expf(gt[47 * PK + k] - bt)); }
        {
#pragma unroll
            for (int u = 0; u < 2; ++u) { const int idx = tid + 512 * u; const int t = idx >> 4, cg = idx & 15;
                if (cg > (t >> 2)) *(u32x2*)(SC + t * BP + cg * 4) = (u32x2){0u, 0u}; }
            if (tid < 320) { const int kh = tid & 1, uidx = tid >> 1; const int blk = uidx / 40, w = uidx - blk * 40;
                int tl, g4;
                if (w < 4) { tl = w; g4 = 0; } else if (w < 12) { const int x = w - 4; tl = 4 + (x >> 1); g4 = x & 1; }
                else if (w < 24) { const int x = w - 12; const int x3 = x / 3; tl = 8 + x3; g4 = x - x3 * 3; } else { const int x = w - 24; tl = 12 + (x >> 2); g4 = x & 3; }
                const int t = blk * 16 + tl, sb = blk * 16 + g4 * 4;
                const float* qp = qt + t * PK + kh * (DK / 2); const float* bp = gt + t * PK + kh * (DK / 2);
                const float* kp = kt + sb * PK + kh * (DK / 2); const float* gs = gt + sb * PK + kh * (DK / 2);
                float a0 = 0.f, a1 = 0.f, a2 = 0.f, a3 = 0.f;
                for (int k = 0; k < DK / 2; ++k) { const float qv = qp[k], bv = bp[k];
                    a0 += qv * kp[k] * __expf(fminf(bv - gs[k], 0.f));
                    a1 += qv * kp[PK + k] * __expf(fminf(bv - gs[PK + k], 0.f));
                    a2 += qv * kp[2 * PK + k] * __expf(fminf(bv - gs[2 * PK + k], 0.f));
                    a3 += qv * kp[3 * PK + k] * __expf(fminf(bv - gs[3 * PK + k], 0.f)); }
                a0 += __shfl_xor(a0, 1, 64); a1 += __shfl_xor(a1, 1, 64); a2 += __shfl_xor(a2, 1, 64); a3 += __shfl_xor(a3, 1, 64);
                if (kh == 0) { const int c0 = g4 * 4;
                    if (c0 + 0 > tl) a0 = 0.f; if (c0 + 1 > tl) a1 = 0.f; if (c0 + 2 > tl) a2 = 0.f; if (c0 + 3 > tl) a3 = 0.f;
                    *(u32x2*)(SC + t * BP + sb) = (u32x2){cvtpk(a0, a1), cvtpk(a2, a3)}; } } }
        __syncthreads();
        if (c.wid < 6) { const int I = c.wid < 1 ? 1 : (c.wid < 3 ? 2 : 3), J = c.wid < 1 ? 0 : (c.wid < 3 ? c.wid - 1 : c.wid - 3);
            const bf16_t* KSI = KS + (I == 1 ? 0 : (I == 2 ? 16 : 48)) * BP;
            f32x4v acc = {0.f, 0.f, 0.f, 0.f};
#pragma unroll
            for (int ks = 0; ks < DK / 32; ++ks) acc = __builtin_amdgcn_mfma_f32_16x16x32_bf16(frag16(QS, I * 16, ks * 32, lane), frag16(KSI, J * 16, ks * 32, lane), acc, 0, 0, 0);
#pragma unroll
            for (int i = 0; i < 4; ++i) SC[(I * 16 + 4 * (lane >> 4) + i) * BP + J * 16 + (lane & 15)] = f2bf(acc[i]); }
        __syncthreads();
#pragma unroll
        for (int u = 0; u < 2; ++u) { const int tile = c.wid * 2 + u; const int ti = tile >> 2, tj = tile & 3;
            f32x4v acc = {0.f, 0.f, 0.f, 0.f};
#pragma unroll
            for (int ks = 0; ks < 2; ++ks) acc = __builtin_amdgcn_mfma_f32_16x16x32_bf16(frag16(SC, ti * 16, ks * 32, lane), frag16(VT, tj * 16, ks * 32, lane), acc, 0, 0, 0);
#pragma unroll
            for (int ks = 0; ks < DK / 32; ++ks) acc = __builtin_amdgcn_mfma_f32_16x16x32_bf16(frag16(QG, ti * 16, ks * 32, lane), frag16(ST, tj * 16, ks * 32, lane), acc, 0, 0, 0);
#pragma unroll
            for (int i = 0; i < 4; ++i) { const int t = ti * 16 + 4 * (lane >> 4) + i; const int to = dir ? 63 - t : t; float* op = ot + to * 65 + tj * 16 + (lane & 15);
                if (dir == 0) *op = acc[i]; else *op += acc[i]; } }
        __syncthreads();
    }
    { const int t = tid >> 3, j0 = (tid & 7) * 8; float o[8]; float ss = 0.f;
#pragma unroll
        for (int j = 0; j < 8; ++j) { o[j] = ot[t * 65 + j0 + j]; ss += o[j] * o[j]; }
        ss += __shfl_xor(ss, 1, 64); ss += __shfl_xor(ss, 2, 64); ss += __shfl_xor(ss, 4, 64);
        const float rstd = rsqrtf(ss * (1.f / 64.f) + NORM_EPS);
        const int r = b * RPB + cc * 64 + t;
        const float* gn = CIN(MX == 0 ? 12 : 14) + l * 64;
        float y[8];
#pragma unroll
        for (int j = 0; j < 8; ++j) y[j] = o[j] * rstd * gn[j0 + j] * silu_f((j & 1) ? bfhi(gp[j >> 1]) : bflo(gp[j >> 1]));
        u32x4 w = {cvtpk(y[0], y[1]), cvtpk(y[2], y[3]), cvtpk(y[4], y[5]), cvtpk(y[6], y[7])};
        *(u32x4*)(C_HB + (size_t)r * D + MX * 256 + h * 64 + j0) = w; }
    __syncthreads();
}

__device__ __forceinline__ void rope_cs(int pos, int i, float& cs, float& sn) {
    const float freq = __expf(-(float)i * (9.210340371976184f / 8.f));
    const float ang = (float)pos * freq;
    const float n = rintf(ang * 0.15915494309189535f);
    float rr = fmaf(-n, 6.2831854820251465f, ang); rr = fmaf(-n, -1.7484555e-7f, rr);
    cs = __cosf(rr); sn = __sinf(rr);
}

__device__ void ph_prep_rows(const Ctx& c, int l) {
    const float* gq = CIN(15) + l * 192; const float* gkv = CIN(16) + l * 128;
    const int lane = c.lane; const int stride = gridDim.x * 8;
    for (int ra = blockIdx.x * 8 + c.wid; ra < NR; ra += 2 * stride) {
        const bool two = ra + stride < NR;
        unsigned* prp[2]; bool lat[2]; int prow[2], pcol[2];
        unsigned wq0[2], wq1[2], wkv[2], rx1[2][3], rx2[2][3]; int rd[3];
#pragma unroll
        for (int u = 0; u < 3; ++u) { const int un = lane + 64 * u; const int g = un >> 2, k = un & 3;
            int col; if (g < 16) col = DF_Q + (g >> 1) * 32 + (g & 1) * 16; else if (g < 32) col = DF_K + ((g - 16) >> 1) * 32 + (g & 1) * 16; else col = MLA_KR + (g - 32) * 16;
            rd[u] = col / 2 + k; }
#pragma unroll
        for (int t = 0; t < 2; ++t) { const int r = (t == 0 || two) ? ra + t * stride : ra; const int b = r / RPB, j = r - b * RPB;
            unsigned* pr = (unsigned*)(C_P + (size_t)r * INC); prp[t] = pr;
            lat[t] = j >= CTX; const int tt = j - CTX; prow[t] = tt >> 6; pcol[t] = tt & 63;
            wq0[t] = pr[MLA_CQ / 2 + lane]; wq1[t] = 0u; if (lane < 32) wq1[t] = pr[MLA_CQ / 2 + 64 + lane];
            wkv[t] = pr[MLA_CKV / 2 + lane];
#pragma unroll
            for (int u = 0; u < 3; ++u) { const int un = lane + 64 * u; rx1[t][u] = 0u; rx2[t][u] = 0u;
                if (lat[t] && un < 34 * 4) { rx1[t][u] = pr[rd[u]]; rx2[t][u] = pr[rd[u] + 4]; } } }
#pragma unroll
        for (int t = 0; t < 2; ++t) { if (t == 1 && !two) break; unsigned* pr = prp[t];
            { const float v0 = bflo(wq0[t]), v1 = bfhi(wq0[t]), v2 = bflo(wq1[t]), v3 = bfhi(wq1[t]);
                const float ss = wave_sum(v0 * v0 + v1 * v1 + v2 * v2 + v3 * v3); const float rstd = rsqrtf(ss * (1.f / 192.f) + NORM_EPS);
                pr[MLA_CQ / 2 + lane] = cvtpk(v0 * rstd * gq[2 * lane], v1 * rstd * gq[2 * lane + 1]);
                if (lane < 32) pr[MLA_CQ / 2 + 64 + lane] = cvtpk(v2 * rstd * gq[128 + 2 * lane], v3 * rstd * gq[128 + 2 * lane + 1]); }
            { const float v0 = bflo(wkv[t]), v1 = bfhi(wkv[t]);
                const float ss = wave_sum(v0 * v0 + v1 * v1); const float rstd = rsqrtf(ss * (1.f / 128.f) + NORM_EPS);
                pr[MLA_CKV / 2 + lane] = cvtpk(v0 * rstd * gkv[2 * lane], v1 * rstd * gkv[2 * lane + 1]); }
            if (lat[t]) {
#pragma unroll
                for (int u = 0; u < 3; ++u) { const int un = lane + 64 * u; const int g = un >> 2, k = un & 3;
                    if (un < 34 * 4) { const int pos = (g & 1) ? pcol[t] : prow[t]; float c0, s0, c1, s1; rope_cs(pos, 2 * k, c0, s0); rope_cs(pos, 2 * k + 1, c1, s1);
                        const float a0 = bflo(rx1[t][u]), a1 = bfhi(rx1[t][u]), b0 = bflo(rx2[t][u]), b1 = bfhi(rx2[t][u]);
                        pr[rd[u]] = cvtpk(a0 * c0 - b0 * s0, a1 * c1 - b1 * s1); pr[rd[u] + 4] = cvtpk(a0 * s0 + b0 * c0, a1 * s1 + b1 * c1); } } } }
    }
}
__device__ void ph_rope_q(const Ctx& c) {
    const int hw = c.lane >> 5, ul = c.lane & 31; const int h = ul >> 3, g = (ul >> 2) & 1, k = ul & 3;
    const int step = gridDim.x * 16;
    for (int r0 = (blockIdx.x * 8 + c.wid) * 2 + hw; r0 < NR; r0 += 2 * step) {
        unsigned* q[2]; bool ok[2]; unsigned w1[2], w2[2]; int pos[2];
#pragma unroll
        for (int t = 0; t < 2; ++t) { const int r = r0 + t * step; const int rc = r < NR ? r : r0; const int b = rc / RPB, j = rc - b * RPB;
            ok[t] = (r < NR) && (j >= CTX); const int tt = j - CTX; pos[t] = g ? (tt & 63) : (tt >> 6);
            q[t] = (unsigned*)(C_QM + (size_t)rc * 384 + h * 96 + 64 + g * 16) + k; w1[t] = 0u; w2[t] = 0u;
            if (ok[t]) { w1[t] = q[t][0]; w2[t] = q[t][4]; } }
#pragma unroll
        for (int t = 0; t < 2; ++t) if (ok[t]) { float c0, s0, c1, s1; rope_cs(pos[t], 2 * k, c0, s0); rope_cs(pos[t], 2 * k + 1, c1, s1);
            const float a0 = bflo(w1[t]), a1 = bfhi(w1[t]), b0 = bflo(w2[t]), b1 = bfhi(w2[t]);
            q[t][0] = cvtpk(a0 * c0 - b0 * s0, a1 * c1 - b1 * s1); q[t][4] = cvtpk(a0 * s0 + b0 * c0, a1 * s1 + b1 * c1); }
    }
}

__device__ __forceinline__ int v_st(int k, int cidx) { const int kk = (k & ~0xC) | ((k & 4) << 1) | ((k & 8) >> 1); return ((kk >> 3) * 2 + (cidx >> 5)) * 512 + ((kk & 7) * 32 + (cidx & 31)) * 2; }
__device__ __forceinline__ int v_rd_base(int lane) { return ((lane & 3) << 3) | (((lane >> 2) & 3) << 6) | (((lane >> 4) & 1) << 5) | (((lane >> 5) & 1) << 8); }
constexpr int v_rd_off(int d0, int ks, int half) { return d0 * 512 + ks * 2048 + half * 1024; }
template <int OFF> __device__ __forceinline__ s16x4 tr_read(int vb) { s16x4 r; asm volatile("ds_read_b64_tr_b16 %0, %1 offset:%2" : "=&v"(r) : "v"(vb), "i"(OFF) : "memory"); return r; }
template <int D0> __device__ __forceinline__ void pv_one(f32x16& od, int vb, bf16x8 pa0, bf16x8 pa1, bf16x8 pa2, bf16x8 pa3) {
    const s16x4 l0 = tr_read<v_rd_off(D0, 0, 0)>(vb), h0 = tr_read<v_rd_off(D0, 0, 1)>(vb), l1 = tr_read<v_rd_off(D0, 1, 0)>(vb), h1 = tr_read<v_rd_off(D0, 1, 1)>(vb);
    const s16x4 l2 = tr_read<v_rd_off(D0, 2, 0)>(vb), h2 = tr_read<v_rd_off(D0, 2, 1)>(vb), l3 = tr_read<v_rd_off(D0, 3, 0)>(vb), h3 = tr_read<v_rd_off(D0, 3, 1)>(vb);
    asm volatile("s_waitcnt lgkmcnt(0)" ::: "memory"); __builtin_amdgcn_sched_barrier(0);
#define PKV(L, H) (bf16x8){L[0], L[1], L[2], L[3], H[0], H[1], H[2], H[3]}
    od = __builtin_amdgcn_mfma_f32_32x32x16_bf16(pa0, PKV(l0, h0), od, 0, 0, 0);
    od = __builtin_amdgcn_mfma_f32_32x32x16_bf16(pa1, PKV(l1, h1), od, 0, 0, 0);
    od = __builtin_amdgcn_mfma_f32_32x32x16_bf16(pa2, PKV(l2, h2), od, 0, 0, 0);
    od = __builtin_amdgcn_mfma_f32_32x32x16_bf16(pa3, PKV(l3, h3), od, 0, 0, 0);
#undef PKV
}
constexpr float ATT_BIG = 1.0995116e12f;
constexpr float ATT_ZBIG = 1.2379400392853803e27f, ATT_ZSMALL = 8.673617379884035e-19f;
__device__ __forceinline__ float rowmax_tile(const f32x16& p0, const f32x16& p1) {
    float pmax = p0[0];
#pragma unroll
    for (int r = 1; r < 16; ++r) pmax = fmaxf(pmax, p0[r]);
#pragma unroll
    for (int r = 0; r < 16; ++r) pmax = fmaxf(pmax, p1[r]);
    auto rr = __builtin_amdgcn_permlane32_swap(__float_as_uint(pmax), __float_as_uint(pmax), false, false);
    return fmaxf(__uint_as_float(rr[0]), __uint_as_float(rr[1]));
}
__device__ __forceinline__ void softmax_tile(f32x16& p0, f32x16& p1, float& M, const float Mused, float& l_reg, const bool first,
                                             bf16x8& pa0, bf16x8& pa1, bf16x8& pa2, bf16x8& pa3, f32x16 (&o)[2], float* wsl, const int r32, const int hi) {
    if (__builtin_expect(__any(Mused != M), 0)) {
        asm volatile("" ::: "memory");
        const float dM = Mused - M;
#pragma unroll
        for (int r = 0; r < 16; ++r) { p0[r] += dM; p1[r] += dM; }
    }
    if (first) {
        float pmax = p0[0];
#pragma unroll
        for (int r = 1; r < 16; ++r) pmax = fmaxf(pmax, p0[r]);
#pragma unroll
        for (int r = 0; r < 16; ++r) pmax = fmaxf(pmax, p1[r]);
        { auto rr = __builtin_amdgcn_permlane32_swap(__float_as_uint(pmax), __float_as_uint(pmax), false, false); pmax = fmaxf(__uint_as_float(rr[0]), __uint_as_float(rr[1])); }
        M = pmax;
#pragma unroll
        for (int r = 0; r < 16; ++r) { p0[r] -= pmax; p1[r] -= pmax; }
    }
    float ps = 0.f;
#pragma unroll
    for (int r = 0; r < 16; ++r) { p0[r] = __builtin_amdgcn_exp2f(p0[r]); ps += p0[r]; }
#pragma unroll
    for (int r = 0; r < 16; ++r) { p1[r] = __builtin_amdgcn_exp2f(p1[r]); ps += p1[r]; }
    { auto rr = __builtin_amdgcn_permlane32_swap(__float_as_uint(ps), __float_as_uint(ps), false, false); ps = __uint_as_float(rr[0]) + __uint_as_float(rr[1]); }
    if (__builtin_expect(__any(ps > ATT_BIG), 0)) {
        asm volatile("" ::: "memory");
        float pm = p0[0];
#pragma unroll
        for (int r = 1; r < 16; ++r) pm = fmaxf(pm, p0[r]);
#pragma unroll
        for (int r = 0; r < 16; ++r) pm = fmaxf(pm, p1[r]);
        { auto rr = __builtin_amdgcn_permlane32_swap(__float_as_uint(pm), __float_as_uint(pm), false, false); pm = fmaxf(__uint_as_float(rr[0]), __uint_as_float(rr[1])); }
        const float alpha = pm > 1.f ? __builtin_amdgcn_rcpf(pm) : 1.f;
        M -= __builtin_amdgcn_logf(alpha);
#pragma unroll
        for (int r = 0; r < 16; ++r) { p0[r] *= alpha; p1[r] *= alpha; }
        ps *= alpha; l_reg *= alpha;
        if (hi == 0) wsl[r32] = alpha;
        asm volatile("s_waitcnt lgkmcnt(0)" ::: "memory");
#pragma unroll
        for (int r = 0; r < 16; ++r) { const float av = wsl[crow(r, hi)]; o[0][r] *= av; o[1][r] *= av; }
        asm volatile("" ::: "memory");
    }
    l_reg += ps;
#define PK4(P, BASE, OUT) do { unsigned a0 = cvtpk(P[BASE + 0], P[BASE + 1]), a1 = cvtpk(P[BASE + 2], P[BASE + 3]);   \
    unsigned b0 = cvtpk(P[BASE + 4], P[BASE + 5]), b1 = cvtpk(P[BASE + 6], P[BASE + 7]);                              \
    auto r0 = __builtin_amdgcn_permlane32_swap(a0, b0, false, false); auto r1 = __builtin_amdgcn_permlane32_swap(a1, b1, false, false); \
    u32x4 w = {r0[0], r1[0], r0[1], r1[1]}; OUT = *reinterpret_cast<bf16x8*>(&w); } while (0)
    PK4(p0, 0, pa0); PK4(p0, 8, pa1); PK4(p1, 0, pa2); PK4(p1, 8, pa3);
#undef PK4
}

constexpr int ATT_STAGE = 2 * 16384 + 2 * 8192;
constexpr int ATT_LDS = 65536 + 49152 + 8 * 64 * 4 + 16;
template <bool DIFF>
__device__ void attn_item(const Ctx& c, int l, int b, int hd, int qrow0, int krow0, int nkeys, char* lds) {
    constexpr int DQK = DIFF ? 32 : 96, NMAP = DIFF ? 2 : 1, ND0 = DQK / 16, NU = 2 * NMAP;
    constexpr int KP = DIFF ? 64 : 256;
    constexpr int KSZ = 64 * KP;
    constexpr int NKR = DIFF ? 2 : 3;
    const int tid_ = mk_tid(c.wid);
    const int tid = tid_, lane = tid_ & 63, wid = c.wid, r32 = lane & 31, hi = lane >> 5;
    char* K_lds0 = lds; char* V_lds0 = lds + 2 * 16384; float* wsl = (float*)(lds + 2 * ATT_STAGE) + wid * 64;
    const float scale = DIFF ? 0.17677669529663687f : 0.10206207261596575f;
    const float C = scale * 1.4426950408889634f;
    bf16x8 qr[NMAP][ND0];
    { const int qrow = qrow0 + wid * 32 + r32;
#pragma unroll
        for (int m = 0; m < NMAP; ++m)
#pragma unroll
            for (int d0 = 0; d0 < ND0; ++d0) {
                const bf16_t* p = DIFF ? C_P + (size_t)qrow * INC + DF_Q + (hd * 2 + m) * 32 + d0 * 16 + hi * 8
                                       : C_QM + (size_t)qrow * 384 + hd * 96 + d0 * 16 + hi * 8;
                qr[m][d0] = *(const bf16x8*)p; } }
    f32x16 o[NMAP][2]; float m_reg[NMAP], l_reg[NMAP];
#pragma unroll
    for (int m = 0; m < NMAP; ++m) { m_reg[m] = 0.f; l_reg[m] = 0.f;
#pragma unroll
        for (int d = 0; d < 2; ++d) zero_acc(o[m][d]); }
    constexpr int NKP = DIFF ? 2 : 4;
    int ksrc[NKP], vsrc[2];
#pragma unroll
    for (int q = 0; q < NKP; ++q) { const int off = (wid * NKP + q) * 1024 + lane * 16;
        if (DIFF) { const int blk = off >> 12, key = (off & 4095) >> 6, slot = (off & 63) >> 4, ch = slot ^ ((key >> 2) & 3);
            ksrc[q] = ((blk >> 1) * 64 + key) * INC + DF_K + (hd * 2 + (blk & 1)) * 32 + ch * 8; }
        else { const int tile = off >> 14, key = (off & 16383) >> 8, slot = (off & 255) >> 4, ch = slot ^ (key & 15);
            ksrc[q] = ch < 8 ? -1 - ((tile * 64 + key) * 512 + hd * 128 + ch * 8) : (ch < 12 ? (tile * 64 + key) * INC + MLA_KR + (ch - 8) * 8 : (int)0x80000000); } }
#pragma unroll
    for (int q = 0; q < 2; ++q) { const int off = (wid * 2 + q) * 1024 + lane * 16; const int tile = off >> 13, w = off & 8191;
        const int sub = w >> 9, within = w & 511; const int kk = (sub >> 1) * 8 + (within >> 6); const int col = (sub & 1) * 32 + ((within & 63) >> 1);
        const int key = (kk & ~0xC) | ((kk & 4) << 1) | ((kk & 8) >> 1);
        vsrc[q] = DIFF ? (tile * 64 + key) * INC + DF_V + hd * 64 + col : (tile * 64 + key) * 512 + hd * 128 + 64 + col; }
    const int vb0 = (int)(uintptr_t)V_lds0 + v_rd_base(lane);
#define ADMA(buf, kr) do { \
        _Pragma("unroll") for (int q = 0; q < NKP; ++q) { LAS unsigned* dst_ = (LAS unsigned*)(LAS char*)(K_lds0 + (buf) * ATT_STAGE + (wid * NKP + q) * 1024); \
            if (DIFF || ksrc[q] >= 0) __builtin_amdgcn_global_load_lds((const unsigned*)(C_P + (size_t)(kr) * INC + ksrc[q]), dst_, 16, 0, 0); \
            else if (ksrc[q] != (int)0x80000000) __builtin_amdgcn_global_load_lds((const unsigned*)(C_KVM + (size_t)(kr) * 512 + (-1 - ksrc[q])), dst_, 16, 0, 0); } \
        _Pragma("unroll") for (int q = 0; q < 2; ++q) { LAS unsigned* dst_ = (LAS unsigned*)(LAS char*)(V_lds0 + (buf) * ATT_STAGE + (wid * 2 + q) * 1024); \
            __builtin_amdgcn_global_load_lds((const unsigned*)((DIFF ? C_P + (size_t)(kr) * INC : C_KVM + (size_t)(kr) * 512) + vsrc[q]), dst_, 16, 0, 0); } } while (0)
    const int NS = nkeys >> 7;
    ADMA(0, krow0);
    for (int j = 0; j < NS; ++j) {
        asm volatile("s_waitcnt vmcnt(0)" ::: "memory");
        __syncthreads();
        if (j + 1 < NS) ADMA((j + 1) & 1, krow0 + (j + 1) * 128);
        const char* K_lds = K_lds0 + (j & 1) * ATT_STAGE; const int vb = vb0 + (j & 1) * ATT_STAGE;
        f32x16 p0[2], p1[2]; float mused[2];
#define QKT(u) do { constexpr int tt_ = (u) / NMAP, m_ = (u) % NMAP; const char* Kb = K_lds + (tt_ * NMAP + m_) * KSZ; \
            _Pragma("unroll") for (int d0 = 0; d0 < ND0; ++d0) { bf16x8 b0, b1; \
                if (DIFF) { const int ch = d0 * 2 + hi; const int ra = r32, rb = 32 + r32; \
                    b0 = *(const bf16x8*)(Kb + ra * 64 + ((ch ^ ((ra >> 2) & 3)) << 4)); b1 = *(const bf16x8*)(Kb + rb * 64 + ((ch ^ ((rb >> 2) & 3)) << 4)); } \
                else { const int cb = d0 * 32 + hi * 16; const int ra = r32, rb = 32 + r32; \
                    b0 = *(const bf16x8*)(Kb + ra * 256 + (cb ^ ((ra & 15) << 4))); b1 = *(const bf16x8*)(Kb + rb * 256 + (cb ^ ((rb & 15) << 4))); } \
                if (d0 == 0) { const float nm_ = -m_reg[m_]; mused[(u) & 1] = m_reg[m_]; const f32x16 z = {nm_,nm_,nm_,nm_,nm_,nm_,nm_,nm_,nm_,nm_,nm_,nm_,nm_,nm_,nm_,nm_}; \
                    p0[(u) & 1] = __builtin_amdgcn_mfma_f32_32x32x16_bf16(b0, qr[m_][0], z, 0, 0, 0); p1[(u) & 1] = __builtin_amdgcn_mfma_f32_32x32x16_bf16(b1, qr[m_][0], z, 0, 0, 0); \
                    asm volatile("" :: "v"(b0), "v"(b1));   } \
                else { p0[(u) & 1] = __builtin_amdgcn_mfma_f32_32x32x16_bf16(b0, qr[m_][d0], p0[(u) & 1], 0, 0, 0); p1[(u) & 1] = __builtin_amdgcn_mfma_f32_32x32x16_bf16(b1, qr[m_][d0], p1[(u) & 1], 0, 0, 0); } } \
            if (!DIFF) {   \
                __builtin_amdgcn_sched_group_barrier(0x100, 4, 0); \
                _Pragma("unroll") for (int g_ = 0; g_ < 4; ++g_) { __builtin_amdgcn_sched_group_barrier(0x8, 2, 0); __builtin_amdgcn_sched_group_barrier(0x100, 2, 0); } \
                __builtin_amdgcn_sched_group_barrier(0x8, 4, 0); } } while (0)
        QKT(0);
#pragma unroll
        for (int u = 0; u < NU; ++u) {
            const int tt = u / NMAP, m = u % NMAP;
            if (u + 1 < NU) { if (u == 0) QKT(1); else if (u == 1) QKT(2); else QKT(3); }
            bf16x8 pa0, pa1, pa2, pa3;
            softmax_tile(p0[u & 1], p1[u & 1], m_reg[m], mused[u & 1], l_reg[m], (j == 0) && (tt == 0), pa0, pa1, pa2, pa3, o[m], wsl, r32, hi);
            pv_one<0>(o[m][0], vb + tt * 8192, pa0, pa1, pa2, pa3);
            pv_one<1>(o[m][1], vb + tt * 8192, pa0, pa1, pa2, pa3);
        }
#undef QKT
    }
#undef ADMA
    float rli[NMAP][16];
#pragma unroll
    for (int m = 0; m < NMAP; ++m) {
        asm volatile("s_waitcnt lgkmcnt(0)" ::: "memory");
        if (hi == 0) wsl[r32] = l_reg[m];
        asm volatile("s_waitcnt lgkmcnt(0)" ::: "memory");
#pragma unroll
        for (int r = 0; r < 16; ++r) rli[m][r] = __builtin_amdgcn_rcpf(wsl[crow(r, hi)]);
    }
    const int orow0 = qrow0 + wid * 32;
    if (!DIFF) {
#pragma unroll
        for (int r = 0; r < 16; ++r) { bf16_t* dst = C_HB + (size_t)(orow0 + crow(r, hi)) * D + 512 + hd * 64 + r32;
            dst[0] = f2bf(o[0][0][r] * rli[0][r]); dst[32] = f2bf(o[0][1][r] * rli[0][r]); }
    } else {
        const float* lp = CIN(19) + l * 128; const float* gn = CIN(20) + l * 64; asm volatile("" : "+s"(lp), "+s"(gn));
        float s1 = lp[r32] * lp[32 + r32], s2 = lp[64 + r32] * lp[96 + r32];
#pragma unroll
        for (int o = 1; o < 32; o <<= 1) { s1 += shx(s1, o, lane); s2 += shx(s2, o, lane); }
        const float lam_init = (l == 0) ? 0.2f : 0.35550906759097f;
        const float lam = __expf(s1) - __expf(s2) + lam_init;
        const float g0 = gn[r32] * (1.f - lam_init), g1 = gn[32 + r32] * (1.f - lam_init);
#pragma unroll
        for (int r = 0; r < 16; ++r) {
            const float v0 = o[0][0][r] * rli[0][r] - lam * o[NMAP - 1][0][r] * rli[NMAP - 1][r];
            const float v1 = o[0][1][r] * rli[0][r] - lam * o[NMAP - 1][1][r] * rli[NMAP - 1][r];
            float ss = v0 * v0 + v1 * v1;
            ss += shx(ss, 1, lane); ss += shx(ss, 2, lane); ss += shx(ss, 4, lane); ss += shx(ss, 8, lane); ss += shx(ss, 16, lane);
            const float rstd = rsqrtf(ss * (1.f / 64.f) + NORM_EPS);
            bf16_t* dst = C_HB + (size_t)(orow0 + crow(r, hi)) * D + 768 + hd * 64 + r32;
            dst[0] = f2bf(v0 * rstd * g0); dst[32] = f2bf(v1 * rstd * g1); }
    }
    __syncthreads();
}
template <bool DIFF>
__device__ bool attn_item_pair(const Ctx& c, int l, int b, int hd, int qrow0, int krow0, int nkeys, char* lds) {
    constexpr int DQK = DIFF ? 32 : 96, NMAP = DIFF ? 2 : 1, ND0 = DQK / 16, NU = 2 * NMAP;
    constexpr int KP = DIFF ? 64 : 256;
    constexpr int KSZ = 64 * KP;
    constexpr int NKR = DIFF ? 2 : 3;
    const int tid_ = mk_tid(c.wid);
    const int tid = tid_, lane = tid_ & 63, wid = c.wid, r32 = lane & 31, hi = lane >> 5;
    char* K_lds0 = lds; char* V_lds0 = lds + 65536; float* wsl = (float*)(lds + 65536 + 49152) + wid * 64;
    const float scale = DIFF ? 0.17677669529663687f : 0.10206207261596575f;
    const float C = scale * 1.4426950408889634f;
    bf16x8 qr[NMAP][ND0];
    { const int qrow = qrow0 + wid * 32 + r32;
#pragma unroll
        for (int m = 0; m < NMAP; ++m)
#pragma unroll
            for (int d0 = 0; d0 < ND0; ++d0) {
                const bf16_t* p = DIFF ? C_P + (size_t)qrow * INC + DF_Q + (hd * 2 + m) * 32 + d0 * 16 + hi * 8
                                       : C_QM + (size_t)qrow * 384 + hd * 96 + d0 * 16 + hi * 8;
                qr[m][d0] = *(const bf16x8*)p; } }
    f32x16 o[NMAP][2]; float m_reg[NMAP], l_reg[NMAP];
#pragma unroll
    for (int m = 0; m < NMAP; ++m) { m_reg[m] = 0.f; l_reg[m] = 0.f;
#pragma unroll
        for (int d = 0; d < 2; ++d) zero_acc(o[m][d]); }
    constexpr int NKP = DIFF ? 2 : 4;
    int ksrc[NKP], vsrc[2];
#pragma unroll
    for (int q = 0; q < NKP; ++q) { const int off = (wid * NKP + q) * 1024 + lane * 16;
        if (DIFF) { const int blk = off >> 12, key = (off & 4095) >> 6, slot = (off & 63) >> 4, ch = slot ^ ((key >> 2) & 3);
            ksrc[q] = ((blk >> 1) * 64 + key) * INC + DF_K + (hd * 2 + (blk & 1)) * 32 + ch * 8; }
        else { const int tile = off >> 14, key = (off & 16383) >> 8, slot = (off & 255) >> 4, ch = slot ^ (key & 15);
            ksrc[q] = ch < 8 ? -1 - ((tile * 64 + key) * 512 + hd * 128 + ch * 8) : (ch < 12 ? (tile * 64 + key) * INC + MLA_KR + (ch - 8) * 8 : (int)0x80000000); } }
#pragma unroll
    for (int q = 0; q < 2; ++q) { const int off = (wid * 2 + q) * 1024 + lane * 16; const int tile = off >> 13, w = off & 8191;
        const int sub = w >> 9, within = w & 511; const int kk = (sub >> 1) * 8 + (within >> 6); const int col = (sub & 1) * 32 + ((within & 63) >> 1);
        const int key = kk;
        vsrc[q] = DIFF ? (tile * 64 + key) * INC + DF_V + hd * 64 + col : (tile * 64 + key) * 512 + hd * 128 + 64 + col; }
    const int vb0 = (int)(uintptr_t)V_lds0 + v_rd_base(lane);
    unsigned kbo[NKP], vbo[2];
#pragma unroll
    for (int q = 0; q < NKP; ++q) kbo[q] = (DIFF || ksrc[q] >= 0) ? (unsigned)ksrc[q] * 2u : (unsigned)(-1 - ksrc[q]) * 2u;
#pragma unroll
    for (int q = 0; q < 2; ++q) vbo[q] = (unsigned)vsrc[q] * 2u;
#define ADMA(kbuf, vbuf, kr) do { const char* pb_ = (const char*)C_P + (size_t)(kr) * (INC * 2); const char* kb_ = (const char*)C_KVM + (size_t)(kr) * 1024; asm volatile("" : "+s"(pb_), "+s"(kb_)); \
        _Pragma("unroll") for (int q = 0; q < NKP; ++q) { LAS unsigned* dst_ = (LAS unsigned*)(LAS char*)(K_lds0 + (kbuf) * 32768 + (wid * NKP + q) * 1024); \
            unsigned o_ = kbo[q]; asm volatile("" : "+v"(o_));     \
            if (DIFF || ksrc[q] >= 0) __builtin_amdgcn_global_load_lds((const unsigned*)(pb_ + (size_t)o_), dst_, 16, 0, 0); \
            else if (ksrc[q] != (int)0x80000000) __builtin_amdgcn_global_load_lds((const unsigned*)(kb_ + (size_t)o_), dst_, 16, 0, 0); } \
        _Pragma("unroll") for (int q = 0; q < 2; ++q) { LAS unsigned* dst_ = (LAS unsigned*)(LAS char*)(V_lds0 + (vbuf) * 16384 + (wid * 2 + q) * 1024); \
            unsigned o_ = vbo[q]; asm volatile("" : "+v"(o_)); \
            __builtin_amdgcn_global_load_lds((const unsigned*)((DIFF ? pb_ : kb_) + (size_t)o_), dst_, 16, 0, 0); } } while (0)
    float lsA = 0.f, lsB = 0.f;
    const int NS = nkeys >> 7;
    ADMA(0, 0, krow0);
    f32x16 a0, a1, b0, b1;
    zero_acc(a0); zero_acc(a1); zero_acc(b0); zero_acc(b1);
    bf16x8 pa[4], pb[4];
    int vslot = 0, vbp = vb0;
#define PKV(L, H) (bf16x8){L[0], L[1], L[2], L[3], H[0], H[1], H[2], H[3]}
#define PK4(P, BASE, OUT) do { u32x4 w = {cvtpk(P[BASE + 0], P[BASE + 1]), cvtpk(P[BASE + 2], P[BASE + 3]), cvtpk(P[BASE + 4], P[BASE + 5]), cvtpk(P[BASE + 6], P[BASE + 7])}; \
    OUT = *reinterpret_cast<bf16x8*>(&w); } while (0)
#define PACKP() do { PK4(a0, 0, pa[0]); PK4(b0, 0, pb[0]); PK4(a0, 8, pa[1]); PK4(b0, 8, pb[1]); PK4(a1, 0, pa[2]); PK4(b1, 0, pb[2]); PK4(a1, 8, pa[3]); PK4(b1, 8, pb[3]); } while (0)
#define CHK(X, B, PS) do { X[B] = __builtin_amdgcn_exp2f(X[B]); X[B + 1] = __builtin_amdgcn_exp2f(X[B + 1]); X[B + 2] = __builtin_amdgcn_exp2f(X[B + 2]); X[B + 3] = __builtin_amdgcn_exp2f(X[B + 3]); \
        PS += X[B]; PS += X[B + 1]; PS += X[B + 2]; PS += X[B + 3]; } while (0)
#define CHUNK(c) do { if ((c) == 0) CHK(a0, 0, psA); else if ((c) == 1) CHK(b0, 0, psB); else if ((c) == 2) CHK(a0, 4, psA); else if ((c) == 3) CHK(b0, 4, psB); \
        else if ((c) == 4) CHK(a0, 8, psA); else if ((c) == 5) CHK(b0, 8, psB); else if ((c) == 6) CHK(a0, 12, psA); else if ((c) == 7) CHK(b0, 12, psB); \
        else if ((c) == 8) CHK(a1, 0, psA); else if ((c) == 9) CHK(b1, 0, psB); else if ((c) == 10) CHK(a1, 4, psA); else if ((c) == 11) CHK(b1, 4, psB); \
        else if ((c) == 12) CHK(a1, 8, psA); else if ((c) == 13) CHK(b1, 8, psB); else if ((c) == 14) CHK(a1, 12, psA); else CHK(b1, 12, psB); \
        __builtin_amdgcn_sched_barrier(0); } while (0)
#define VREAD(D0B, VB, TA, TB) \
        const int va_##D0B = (VB) + (TA) * 8192, vq_##D0B = (VB) + (TB) * 8192; \
        const s16x4 l0##D0B = tr_read<v_rd_off(D0B, 0, 0)>(va_##D0B), h0##D0B = tr_read<v_rd_off(D0B, 0, 1)>(va_##D0B), l1##D0B = tr_read<v_rd_off(D0B, 1, 0)>(va_##D0B), h1##D0B = tr_read<v_rd_off(D0B, 1, 1)>(va_##D0B); \
        const s16x4 l2##D0B = tr_read<v_rd_off(D0B, 2, 0)>(va_##D0B), h2##D0B = tr_read<v_rd_off(D0B, 2, 1)>(va_##D0B), l3##D0B = tr_read<v_rd_off(D0B, 3, 0)>(va_##D0B), h3##D0B = tr_read<v_rd_off(D0B, 3, 1)>(va_##D0B); \
        s16x4 m0##D0B = l0##D0B, n0##D0B = h0##D0B, m1##D0B = l1##D0B, n1##D0B = h1##D0B, m2##D0B = l2##D0B, n2##D0B = h2##D0B, m3##D0B = l3##D0B, n3##D0B = h3##D0B; \
        if (!DIFF) { m0##D0B = tr_read<v_rd_off(D0B, 0, 0)>(vq_##D0B); n0##D0B = tr_read<v_rd_off(D0B, 0, 1)>(vq_##D0B); m1##D0B = tr_read<v_rd_off(D0B, 1, 0)>(vq_##D0B); n1##D0B = tr_read<v_rd_off(D0B, 1, 1)>(vq_##D0B); \
            m2##D0B = tr_read<v_rd_off(D0B, 2, 0)>(vq_##D0B); n2##D0B = tr_read<v_rd_off(D0B, 2, 1)>(vq_##D0B); m3##D0B = tr_read<v_rd_off(D0B, 3, 0)>(vq_##D0B); n3##D0B = tr_read<v_rd_off(D0B, 3, 1)>(vq_##D0B); }
#define VWAIT() do { asm volatile("s_waitcnt lgkmcnt(0)" ::: "memory"); __builtin_amdgcn_sched_barrier(0); } while (0)
#define PVM(D0B, i) do { f32x16& accA = o[0][D0B]; f32x16& accB = o[NMAP - 1][D0B]; \
        if ((i) == 0) accA = __builtin_amdgcn_mfma_f32_32x32x16_bf16(pa[0], PKV(l0##D0B, h0##D0B), accA, 0, 0, 0); else if ((i) == 1) accB = __builtin_amdgcn_mfma_f32_32x32x16_bf16(pb[0], PKV(m0##D0B, n0##D0B), accB, 0, 0, 0); \
        else if ((i) == 2) accA = __builtin_amdgcn_mfma_f32_32x32x16_bf16(pa[1], PKV(l1##D0B, h1##D0B), accA, 0, 0, 0); else if ((i) == 3) accB = __builtin_amdgcn_mfma_f32_32x32x16_bf16(pb[1], PKV(m1##D0B, n1##D0B), accB, 0, 0, 0); \
        else if ((i) == 4) accA = __builtin_amdgcn_mfma_f32_32x32x16_bf16(pa[2], PKV(l2##D0B, h2##D0B), accA, 0, 0, 0); else if ((i) == 5) accB = __builtin_amdgcn_mfma_f32_32x32x16_bf16(pb[2], PKV(m2##D0B, n2##D0B), accB, 0, 0, 0); \
        else if ((i) == 6) accA = __builtin_amdgcn_mfma_f32_32x32x16_bf16(pa[3], PKV(l3##D0B, h3##D0B), accA, 0, 0, 0); else accB = __builtin_amdgcn_mfma_f32_32x32x16_bf16(pb[3], PKV(m3##D0B, n3##D0B), accB, 0, 0, 0); } while (0)
#define STEP3_PV(VB, TA, TB) do { float psA = 0.f, psB = 0.f; \
        VREAD(0, VB, TA, TB) \
        VWAIT(); \
        PVM(0, 0); CHUNK(0); PVM(0, 1); CHUNK(1); PVM(0, 2); CHUNK(2); PVM(0, 3); CHUNK(3); PVM(0, 4); CHUNK(4); PVM(0, 5); CHUNK(5); \
        VREAD(1, VB, TA, TB) \
        __builtin_amdgcn_sched_barrier(0); \
        PVM(0, 6); CHUNK(6); PVM(0, 7); CHUNK(7); \
        VWAIT(); \
        PVM(1, 0); CHUNK(8); PVM(1, 1); CHUNK(9); PVM(1, 2); CHUNK(10); PVM(1, 3); CHUNK(11); PVM(1, 4); CHUNK(12); PVM(1, 5); CHUNK(13); PVM(1, 6); CHUNK(14); PVM(1, 7); CHUNK(15); \
        lsA += psA; lsB += psB; } while (0)
    constexpr int NG = ND0 / 2, NPI = DIFF ? 2 : 1, TLA = DIFF ? 1 : 0, TLB = 1;
    for (int j = 0; j < NS; ++j) {
        asm volatile("s_waitcnt vmcnt(0)" ::: "memory");
        __syncthreads();
        const int vnext = (vslot == 2) ? 0 : vslot + 1;
        if (j + 1 < NS) ADMA((j + 1) & 1, vnext, krow0 + (j + 1) * 128);
        const char* K_lds = K_lds0 + (j & 1) * 32768; const int vb = vb0 + vslot * 16384;
#define KFR(tt, m, d0, h) (*(const bf16x8*)(K_lds + ((tt) * NMAP + (m)) * KSZ + \
            (DIFF ? (((h) * 32 + r32) * 64 + ((((d0) * 2 + hi) ^ ((((h) * 32 + r32) >> 2) & 3)) << 4)) : (((h) * 32 + r32) * 256 + (((d0) * 32 + hi * 16) ^ ((((h) * 32 + r32) & 15) << 4))))))
#define KGRP(F, g, TA, TB) do { F[0] = KFR(TA, 0, 2 * (g), 0); F[1] = KFR(TB, NMAP - 1, 2 * (g), 0); F[2] = KFR(TA, 0, 2 * (g), 1); F[3] = KFR(TB, NMAP - 1, 2 * (g), 1); \
            F[4] = KFR(TA, 0, 2 * (g) + 1, 0); F[5] = KFR(TB, NMAP - 1, 2 * (g) + 1, 0); F[6] = KFR(TA, 0, 2 * (g) + 1, 1); F[7] = KFR(TB, NMAP - 1, 2 * (g) + 1, 1); } while (0)
#define QGRP(F, g) do { \
            if ((g) == 0) { const f32x16 z_ = {0.f,0.f,0.f,0.f,0.f,0.f,0.f,0.f,0.f,0.f,0.f,0.f,0.f,0.f,0.f,0.f};     \
                a0 = __builtin_amdgcn_mfma_f32_32x32x16_bf16(F[0], qr[0][0], z_, 0, 0, 0); b0 = __builtin_amdgcn_mfma_f32_32x32x16_bf16(F[1], qr[NMAP - 1][0], z_, 0, 0, 0); \
                a1 = __builtin_amdgcn_mfma_f32_32x32x16_bf16(F[2], qr[0][0], z_, 0, 0, 0); b1 = __builtin_amdgcn_mfma_f32_32x32x16_bf16(F[3], qr[NMAP - 1][0], z_, 0, 0, 0); } \
            else { a0 = __builtin_amdgcn_mfma_f32_32x32x16_bf16(F[0], qr[0][2 * (g)], a0, 0, 0, 0); b0 = __builtin_amdgcn_mfma_f32_32x32x16_bf16(F[1], qr[NMAP - 1][2 * (g)], b0, 0, 0, 0); \
                a1 = __builtin_amdgcn_mfma_f32_32x32x16_bf16(F[2], qr[0][2 * (g)], a1, 0, 0, 0); b1 = __builtin_amdgcn_mfma_f32_32x32x16_bf16(F[3], qr[NMAP - 1][2 * (g)], b1, 0, 0, 0); } \
            a0 = __builtin_amdgcn_mfma_f32_32x32x16_bf16(F[4], qr[0][2 * (g) + 1], a0, 0, 0, 0); b0 = __builtin_amdgcn_mfma_f32_32x32x16_bf16(F[5], qr[NMAP - 1][2 * (g) + 1], b0, 0, 0, 0); \
            a1 = __builtin_amdgcn_mfma_f32_32x32x16_bf16(F[6], qr[0][2 * (g) + 1], a1, 0, 0, 0); b1 = __builtin_amdgcn_mfma_f32_32x32x16_bf16(F[7], qr[NMAP - 1][2 * (g) + 1], b1, 0, 0, 0); } while (0)
#pragma unroll
        for (int pi = 0; pi < NPI; ++pi) {
            const int tA = DIFF ? pi : 0, tB = DIFF ? pi : 1;
            bf16x8 kf0[8], kf1[8];
            KGRP(kf0, 0, tA, tB); if (NG > 1) KGRP(kf1, 1, tA, tB);
            __builtin_amdgcn_sched_barrier(0);
            PACKP();
            __builtin_amdgcn_sched_barrier(0);
            QGRP(kf0, 0);
            if (NG > 1) { __builtin_amdgcn_sched_barrier(0); KGRP(kf0, 2, tA, tB); __builtin_amdgcn_sched_barrier(0); QGRP(kf1, 1); QGRP(kf0, 2); }
            __builtin_amdgcn_sched_barrier(0);
            if (pi == 0) STEP3_PV(vbp, TLA, TLB);
            else STEP3_PV(vb, pi - 1, pi - 1);
        }
#undef KFR
#undef KGRP
#undef QGRP
        vbp = vb; vslot = vnext;
    }
    { PACKP();
      __builtin_amdgcn_sched_barrier(0);
      VREAD(0, vbp, TLA, TLB)
      VREAD(1, vbp, TLA, TLB)
      VWAIT();
      PVM(0, 0); PVM(0, 1); PVM(0, 2); PVM(0, 3); PVM(0, 4); PVM(0, 5); PVM(0, 6); PVM(0, 7);
      PVM(1, 0); PVM(1, 1); PVM(1, 2); PVM(1, 3); PVM(1, 4); PVM(1, 5); PVM(1, 6); PVM(1, 7); }
#undef STEP3_PV
#undef PVM
#undef VWAIT
#undef VREAD
#undef CHUNK
#undef CHK
#undef PACKP
#undef PK4
#undef PKV
#undef ADMA
    const int tide = mk_tid(c.wid), lanee = tide & 63, r32e = lanee & 31, hie = lanee >> 5;
    { auto rr = __builtin_amdgcn_permlane32_swap(__float_as_uint(lsA), __float_as_uint(lsA), false, false); lsA = __uint_as_float(rr[0]) + __uint_as_float(rr[1]); }
    { auto rr = __builtin_amdgcn_permlane32_swap(__float_as_uint(lsB), __float_as_uint(lsB), false, false); lsB = __uint_as_float(rr[0]) + __uint_as_float(rr[1]); }
    if (DIFF) { l_reg[0] = lsA; l_reg[NMAP - 1] = lsB; } else l_reg[0] = lsA + lsB;
    float rli[NMAP][16];
#pragma unroll
    for (int m = 0; m < NMAP; ++m) {
        asm volatile("s_waitcnt lgkmcnt(0)" ::: "memory");
        if (hie == 0) wsl[r32e] = l_reg[m];
        asm volatile("s_waitcnt lgkmcnt(0)" ::: "memory");
#pragma unroll
        for (int r = 0; r < 16; ++r) rli[m][r] = __builtin_amdgcn_rcpf(wsl[crow(r, hie)]);
    }
    const int orow0 = qrow0 + wid * 32;
    if (!DIFF) {
#pragma unroll
        for (int r = 0; r < 16; ++r) { bf16_t* dst = C_HB + (size_t)(orow0 + crow(r, hie)) * D + 512 + hd * 64 + r32e;
            dst[0] = f2bf(o[0][0][r] * rli[0][r]); dst[32] = f2bf(o[0][1][r] * rli[0][r]); }
    } else {
        const float* lp = CIN(19) + l * 128; const float* gn = CIN(20) + l * 64; asm volatile("" : "+s"(lp), "+s"(gn));
        float s1 = lp[r32e] * lp[32 + r32e], s2 = lp[64 + r32e] * lp[96 + r32e];
#pragma unroll
        for (int o = 1; o < 32; o <<= 1) { s1 += shx(s1, o, lanee); s2 += shx(s2, o, lanee); }
        const float lam_init = (l == 0) ? 0.2f : 0.35550906759097f;
        const float lam = __expf(s1) - __expf(s2) + lam_init;
        const float g0 = gn[r32e] * (1.f - lam_init), g1 = gn[32 + r32e] * (1.f - lam_init);
#pragma unroll
        for (int r = 0; r < 16; ++r) {
            const float v0 = o[0][0][r] * rli[0][r] - lam * o[NMAP - 1][0][r] * rli[NMAP - 1][r];
            const float v1 = o[0][1][r] * rli[0][r] - lam * o[NMAP - 1][1][r] * rli[NMAP - 1][r];
            float ss = v0 * v0 + v1 * v1;
            ss += shx(ss, 1, lanee); ss += shx(ss, 2, lanee); ss += shx(ss, 4, lanee); ss += shx(ss, 8, lanee); ss += shx(ss, 16, lanee);
            const float rstd = rsqrtf(ss * (1.f / 64.f) + NORM_EPS);
            bf16_t* dst = C_HB + (size_t)(orow0 + crow(r, hie)) * D + 768 + hd * 64 + r32e;
            dst[0] = f2bf(v0 * rstd * g0); dst[32] = f2bf(v1 * rstd * g1); }
    }
    int* flag = (int*)(lds + 65536 + 49152 + 8 * 64 * 4);
    __syncthreads();
    if (tide == 0) *flag = 0;
    __syncthreads();
    if (!(l_reg[0] <= ATT_ZBIG && l_reg[0] >= ATT_ZSMALL) || !(l_reg[NMAP - 1] <= ATT_ZBIG && l_reg[NMAP - 1] >= ATT_ZSMALL)) *flag = 1;
    __syncthreads();
    const bool redo = *flag != 0;
    __syncthreads();
    return redo;
}
__device__ void ph_attn(const Ctx& c, int l, char* lds) {
    const bool need_ctx = (l < DEPTH - 1);
    const int nitem = 1024 + (need_ctx ? 32 : 0);
    for (int it = blockIdx.x; it < nitem; it += gridDim.x) {
        bool diff; int b, hd, q0, k0, nk;
        if (it < 1024) { const int combo = ((it >> 8) << 3) | (it & 7), qt = (it >> 3) & 31; diff = combo < 16; b = (combo >> 2) & 3; hd = combo & 3; q0 = b * RPB + CTX + qt * 256; k0 = b * RPB; nk = RPB; }
        else { const int u = it - 1024; diff = u < 16; b = u & 3; hd = (u >> 2) & 3; q0 = b * RPB; k0 = b * RPB; nk = CTX; }
        if (diff) { if (attn_item_pair<true>(c, l, b, hd, q0, k0, nk, lds)) attn_item<true>(c, l, b, hd, q0, k0, nk, lds); }
        else { if (attn_item_pair<false>(c, l, b, hd, q0, k0, nk, lds)) attn_item<false>(c, l, b, hd, q0, k0, nk, lds); }
    }
}

typedef float f32v2 __attribute__((ext_vector_type(2)));
__device__ void cvt_tables(const Ctx& c, int l) {
    const int stride = gridDim.x * 8;
    for (int row0 = blockIdx.x * 8 + c.wid; row0 < 2 * NEXP; row0 += 2 * stride) {
        const bool two = row0 + stride < 2 * NEXP;
        f32x4 v[2][4];
#pragma unroll
        for (int t = 0; t < 2; ++t) { const int row = (t == 0 || two) ? row0 + t * stride : row0; const bool isu = row < NEXP; const int e = isu ? row : row - NEXP;
            const float* s = CIN(isu ? 23 : 24) + ((size_t)l * NEXP + e) * D + c.lane * 16;
#pragma unroll
            for (int i = 0; i < 4; ++i) v[t][i] = *(const f32x4*)(s + 4 * i); }
#pragma unroll
        for (int t = 0; t < 2; ++t) { if (t == 1 && !two) break; const int row = row0 + t * stride; const bool isu = row < NEXP; const int e = isu ? row : row - NEXP;
            float mx = 0.f;
#pragma unroll
            for (int i = 0; i < 4; ++i) mx = fmaxf(mx, fmaxf(fmaxf(fabsf(v[t][i][0]), fabsf(v[t][i][1])), fmaxf(fabsf(v[t][i][2]), fabsf(v[t][i][3]))));
#pragma unroll
            for (int o = 32; o >= 1; o >>= 1) mx = fmaxf(mx, __shfl_xor(mx, o, 64));
            const float q = mx > 0.f ? 256.f / mx : 0.f;
            if (c.lane == 0) (isu ? C_SU : C_SV)[e] = mx * (1.f / 256.f);
            u32x4 w;
#pragma unroll
            for (int i = 0; i < 4; ++i) { int p = 0; p = __builtin_amdgcn_cvt_pk_fp8_f32(v[t][i][0] * q, v[t][i][1] * q, p, false); p = __builtin_amdgcn_cvt_pk_fp8_f32(v[t][i][2] * q, v[t][i][3] * q, p, true); w[i] = (unsigned)p; }
            *(u32x4*)((isu ? C_TU8 : C_TV8) + ((size_t)(c.lane >> 3) * NEXP + e) * 128 + (c.lane & 7) * 16) = w; }
    }
}
__device__ __forceinline__ unsigned ford(float x) { const unsigned u = __float_as_uint(x); return (u & 0x80000000u) ? ~u : (u | 0x80000000u); }
__device__ __forceinline__ float funord(unsigned k) { const unsigned u = (k & 0x80000000u) ? (k & 0x7fffffffu) : ~k; return __uint_as_float(u); }
__device__ __forceinline__ void sort16_desc(unsigned (&v)[16]) {
#pragma unroll
    for (int k = 2; k <= 16; k <<= 1)
#pragma unroll
        for (int j = k >> 1; j > 0; j >>= 1)
#pragma unroll
            for (int i = 0; i < 16; ++i) { const int l = i ^ j; if (l > i) { const unsigned a = v[i], b = v[l]; const unsigned hi = max(a, b), lo = min(a, b);
                if ((i & k) == 0) { v[i] = hi; v[l] = lo; } else { v[i] = lo; v[l] = hi; } } }
}
__device__ __forceinline__ void merge16_desc(unsigned (&t)[16], const unsigned (&v)[16]) {
#pragma unroll
    for (int i = 0; i < 16; ++i) t[i] = max(t[i], v[15 - i]);
#pragma unroll
    for (int j = 8; j > 0; j >>= 1)
#pragma unroll
        for (int i = 0; i < 16; ++i) { const int l = i ^ j; if (l > i) { const unsigned a = t[i], b = t[l]; t[i] = max(a, b); t[l] = min(a, b); } }
}
constexpr int TOPK_LDS = 2 * 128 * 129 * 4;
__device__ __forceinline__ void topk_load_keys(const Ctx& c, int l, int h, bf16x8 (&fbk)[1][2][8]) {
    const int lane = c.lane, r32 = lane & 31, hi = lane >> 5, wn = c.wid & 1;
#pragma unroll
    for (int p = 0; p < 1; ++p) { const bf16_t* Bp = C_KEYS + ((((size_t)l * 8 + h) * 2 + p) * 128 + wn * 64 + r32) * 128 + hi * 8;
#pragma unroll
        for (int ks = 0; ks < 8; ++ks) { fbk[p][0][ks] = *(const bf16x8*)(Bp + ks * 16); fbk[p][1][ks] = *(const bf16x8*)(Bp + 32 * 128 + ks * 16); } }
}
template <bool HOIST>
__device__ void peer_topk_item(const Ctx& c, int l, int tm, int h, char* lds, bf16x8 (&fbk)[1][2][8]) {
    float* S = (float*)lds;
    const int tid = c.tid, lane = c.lane, wid = c.wid, r32 = lane & 31, hi = lane >> 5, wm = wid >> 1, wn = wid & 1;
    const int row0 = tm * 128;
    bf16x8 fa[2][8];
#pragma unroll
    for (int p = 0; p < 2; ++p) { const bf16_t* Ap = C_Q2 + (size_t)(row0 + wm * 32 + r32) * 2048 + h * 256 + p * 128 + hi * 8;
#pragma unroll
        for (int ks = 0; ks < 8; ++ks) fa[p][ks] = *(const bf16x8*)(Ap + ks * 16); }
#pragma unroll
    for (int p = 0; p < 2; ++p) {
        f32x16 acc[2];
        zero_acc(acc[0]); zero_acc(acc[1]);
        bf16x8 fb0[8], fb1[8];
        if (HOIST && p == 0) {
#pragma unroll
            for (int ks = 0; ks < 8; ++ks) { fb0[ks] = fbk[0][0][ks]; fb1[ks] = fbk[0][1][ks]; } }
        else { const bf16_t* Bp = C_KEYS + ((((size_t)l * 8 + h) * 2 + p) * 128 + wn * 64 + r32) * 128 + hi * 8;
#pragma unroll
            for (int ks = 0; ks < 8; ++ks) { fb0[ks] = *(const bf16x8*)(Bp + ks * 16); fb1[ks] = *(const bf16x8*)(Bp + 32 * 128 + ks * 16); } }
        asm volatile("" : "+v"(fa[p][0]), "+v"(fa[p][1]), "+v"(fa[p][2]), "+v"(fa[p][3]), "+v"(fa[p][4]), "+v"(fa[p][5]), "+v"(fa[p][6]), "+v"(fa[p][7]));
        if (!(HOIST && p == 0)) {
        asm volatile("" : "+v"(fb0[0]), "+v"(fb0[1]), "+v"(fb0[2]), "+v"(fb0[3]), "+v"(fb0[4]), "+v"(fb0[5]), "+v"(fb0[6]), "+v"(fb0[7]));
        asm volatile("" : "+v"(fb1[0]), "+v"(fb1[1]), "+v"(fb1[2]), "+v"(fb1[3]), "+v"(fb1[4]), "+v"(fb1[5]), "+v"(fb1[6]), "+v"(fb1[7])); }
#pragma unroll
        for (int ks = 0; ks < 8; ++ks) {
            acc[0] = __builtin_amdgcn_mfma_f32_32x32x16_bf16(fa[p][ks], fb0[ks], acc[0], 0, 0, 0);
            acc[1] = __builtin_amdgcn_mfma_f32_32x32x16_bf16(fa[p][ks], fb1[ks], acc[1], 0, 0, 0);
        }
#pragma unroll
        for (int n = 0; n < 2; ++n)
#pragma unroll
            for (int r = 0; r < 16; ++r) S[(p * 128 + wm * 32 + crow(r, hi)) * 129 + wn * 64 + n * 32 + r32] = acc[n][r];
    }
    __syncthreads();
    unsigned tk[16];
    { const int list = tid >> 1, half = tid & 1; const float* sr = S + list * 129 + half * 64;
#pragma unroll
        for (int g = 0; g < 4; ++g) { unsigned v[16];
#pragma unroll
            for (int i = 0; i < 16; ++i) { const int n = half * 64 + g * 16 + i; v[i] = (ford(sr[g * 16 + i]) & ~127u) | (unsigned)(127 - n); }
            sort16_desc(v);
            if (g == 0) {
#pragma unroll
                for (int i = 0; i < 16; ++i) tk[i] = v[i]; }
            else merge16_desc(tk, v); } }
    __syncthreads();
    unsigned* X = (unsigned*)lds;
    unsigned* L = X + 256 * 17;
    if (tid & 1) {
#pragma unroll
        for (int i = 0; i < 16; ++i) X[(tid >> 1) * 17 + i] = tk[i]; }
    __syncthreads();
    if (!(tid & 1)) { unsigned v[16];
#pragma unroll
        for (int i = 0; i < 16; ++i) v[i] = X[(tid >> 1) * 17 + i];
        merge16_desc(tk, v);
#pragma unroll
        for (int i = 0; i < 16; ++i) L[(tid >> 1) * 17 + i] = tk[i]; }
    __syncthreads();
    unsigned bk[16];
    const int row = (tid >> 1) & 127, hh = tid & 1;
    const unsigned* l0 = L + row * 17; const unsigned* l1 = L + (128 + row) * 17;
    if (tid < 256) {
        float s0[8], s1[16];
#pragma unroll
        for (int ii = 0; ii < 8; ++ii) s0[ii] = funord(l0[2 * ii + hh] & ~127u);
#pragma unroll
        for (int j = 0; j < 16; ++j) s1[j] = funord(l1[j] & ~127u);
        unsigned ck[32];
        { int slot = 0;
#pragma unroll
            for (int ii = 0; ii < 8; ++ii)
#pragma unroll
                for (int j = 0; j < 16; ++j) if ((2 * ii + 1) * (j + 1) <= 16) {
                    const int i = 2 * ii + hh; const bool ok = (i + 1) * (j + 1) <= 16;
                    const unsigned key = (ford(s0[ii] + s1[j]) & ~255u) | (unsigned)(255 - (i * 16 + j));
                    ck[slot] = ok ? key : 0u; ++slot; }
#pragma unroll
            for (; slot < 32; ++slot) ck[slot] = 0u; }
        unsigned v0[16], v1[16];
#pragma unroll
        for (int i = 0; i < 16; ++i) { v0[i] = ck[i]; v1[i] = ck[16 + i]; }
        sort16_desc(v0); sort16_desc(v1);
        merge16_desc(v0, v1);
#pragma unroll
        for (int i = 0; i < 16; ++i) bk[i] = v0[i];
    }
    __syncthreads();
    if (tid < 256 && hh) {
#pragma unroll
        for (int i = 0; i < 16; ++i) X[row * 17 + i] = bk[i]; }
    __syncthreads();
    if (tid < 256 && !hh) { unsigned v[16];
#pragma unroll
        for (int i = 0; i < 16; ++i) v[i] = X[row * 17 + i];
        merge16_desc(bk, v);
        float best[16]; int eid[16]; float mx = -1e30f;
#pragma unroll
        for (int q = 0; q < 16; ++q) { const int ij = 255 - (int)(bk[q] & 255u); const int i = ij >> 4, j = ij & 15;
            const unsigned k0 = l0[i], k1 = l1[j];
            best[q] = funord(k0 & ~127u) + funord(k1 & ~127u);
            eid[q] = (127 - (int)(k0 & 127u)) * 128 + (127 - (int)(k1 & 127u));
            mx = fmaxf(mx, best[q]); }
        float sum = 0.f;
#pragma unroll
        for (int q = 0; q < 16; ++q) { best[q] = __expf(best[q] - mx); sum += best[q]; }
        const float inv = 1.f / sum;
        const size_t o = (size_t)(row0 + row) * 128 + h * 16;
#pragma unroll
        for (int q = 0; q < 16; q += 4) { *(u32x2*)(C_EI + o + q) = (u32x2){(unsigned)eid[q] | ((unsigned)eid[q + 1] << 16), (unsigned)eid[q + 2] | ((unsigned)eid[q + 3] << 16)};
            *(f32x4*)(C_EG + o + q) = (f32x4){best[q] * inv, best[q + 1] * inv, best[q + 2] * inv, best[q + 3] * inv}; }
    }
    __syncthreads();
}
__device__ __forceinline__ float gelu_tanh(float x) { const float u = 0.7978845608028654f * (x + 0.044715f * x * x * x); const float t = 1.f - 2.f / (1.f + __expf(2.f * u)); return 0.5f * x * (1.f + t); }
__device__ __forceinline__ int tok_row(int ti, bool need_ctx) { return need_ctx ? ti : (ti >> 13) * RPB + CTX + (ti & 8191); }
struct PeerTok { u32x4 t[16]; u32x4 xa, xb; unsigned xv; f32v2 gv; };
__device__ __forceinline__ void peer_issue(PeerTok& T, const unsigned char* t8, const int* el, const bf16_t* xp, int grp, bool want_x) {
#pragma unroll
    for (int u = 0; u < 16; ++u) { const int e = el[u * 8 + grp]; T.t[u] = *(const u32x4*)(t8 + (size_t)e * 128); }
    if (want_x) { T.xa = *(const u32x4*)xp; T.xb = *(const u32x4*)(xp + 8); }
}
__device__ __forceinline__ void peer_issue16(PeerTok& T, const unsigned char* t8, const unsigned short* el, int grp) {
#pragma unroll
    for (int u = 0; u < 16; ++u) { const int e = (int)el[u * 8 + grp]; T.t[u] = *(const u32x4*)(t8 + (size_t)e * 128); }
}
__device__ __forceinline__ void peer_u_compute(const PeerTok& T, bf16_t* pp, int sub, int grp, int lane) {
    f32v2 x2[8];
#pragma unroll
    for (int q = 0; q < 4; ++q) { x2[q] = (f32v2){bflo(T.xa[q]), bfhi(T.xa[q])}; x2[4 + q] = (f32v2){bflo(T.xb[q]), bfhi(T.xb[q])}; }
    float keep[2];
#pragma unroll
    for (int hf = 0; hf < 2; ++hf) {
        float a[8];
#pragma unroll
        for (int u = 0; u < 8; ++u) { f32v2 s2 = {0.f, 0.f};
#pragma unroll
            for (int q = 0; q < 4; ++q) { const unsigned w = T.t[hf * 8 + u][q];
                s2 = __builtin_elementwise_fma(__builtin_amdgcn_cvt_pk_f32_fp8(w, false), x2[2 * q], s2);
                s2 = __builtin_elementwise_fma(__builtin_amdgcn_cvt_pk_f32_fp8(w, true), x2[2 * q + 1], s2); }
            a[u] = s2[0] + s2[1]; }
        const bool b2 = (lane & 4) != 0, b1 = (lane & 2) != 0, b0 = (lane & 1) != 0;
        float r4[4], r2[2];
#pragma unroll
        for (int q = 0; q < 4; ++q) { const float mine = b2 ? a[4 + q] : a[q], oth = b2 ? a[q] : a[4 + q]; r4[q] = mine + __shfl_xor(oth, 4, 64); }
#pragma unroll
        for (int q = 0; q < 2; ++q) { const float mine = b1 ? r4[2 + q] : r4[q], oth = b1 ? r4[q] : r4[2 + q]; r2[q] = mine + __shfl_xor(oth, 2, 64); }
        { const float mine = b0 ? r2[1] : r2[0], oth = b0 ? r2[0] : r2[1]; keep[hf] = mine + __shfl_xor(oth, 1, 64); }
    }
    pp[sub * 8 + grp] = f2bf(keep[0]); pp[(8 + sub) * 8 + grp] = f2bf(keep[1]);
}
__device__ void peer_u_item(const Ctx& c, int l, int j, int tb, char* lds) {
    const bool need_ctx = (l < DEPTH - 1);
    const int lane = c.lane, sub = lane & 7, grp = lane >> 3;
    unsigned short* els = (unsigned short*)(lds + 20480) + c.wid * 2048;
    unsigned* xs = (unsigned*)(lds + 53248) + c.wid * 1024;
    const unsigned char* t8 = C_TU8 + (size_t)j * NEXP * 128 + sub * 16;
    const int tok0 = tb * 128 + c.wid * 16;
    { u32x4 idv[4], xv[4]; const int tl = lane >> 4, pc = (lane & 15) * 8;
#pragma unroll
      for (int q = 0; q < 4; ++q) { const int r = tok_row(tok0 + q * 4 + tl, need_ctx);
          idv[q] = *(const u32x4*)(C_EI + (size_t)r * 128 + pc); xv[q] = *(const u32x4*)(C_HB + (size_t)r * D + j * 128 + pc); }
#pragma unroll
      for (int q = 0; q < 4; ++q) { *(u32x4*)(els + (q * 4 + tl) * 128 + pc) = idv[q]; *(u32x4*)(xs + (q * 4 + tl) * 64 + pc / 2) = xv[q]; } }
    asm volatile("" ::: "memory");
    PeerTok A, B;
    peer_issue16(A, t8, els, grp);
#pragma unroll 1
    for (int k = 0; k < 16; k += 2) {
        peer_issue16(B, t8, els + (k + 1) * 128, grp);
        A.xa = *(const u32x4*)(xs + k * 64 + sub * 8); A.xb = *(const u32x4*)(xs + k * 64 + sub * 8 + 4);
        peer_u_compute(A, C_PART + ((size_t)j * NR + tok_row(tok0 + k, need_ctx)) * 128, sub, grp, lane);
        if (k + 2 < 16) peer_issue16(A, t8, els + (k + 2) * 128, grp);
        B.xa = *(const u32x4*)(xs + (k + 1) * 64 + sub * 8); B.xb = *(const u32x4*)(xs + (k + 1) * 64 + sub * 8 + 4);
        peer_u_compute(B, C_PART + ((size_t)j * NR + tok_row(tok0 + k + 1, need_ctx)) * 128, sub, grp, lane);
    }
}
__device__ void ph_peer_combine(const Ctx& c, int l) {
    const bool need_ctx = (l < DEPTH - 1);
    const int ntok = need_ctx ? NR : NB * SEQ;
    const int stride = gridDim.x * 8;
    for (int ti = blockIdx.x * 8 + c.wid; ti < ntok; ti += 2 * stride) {
        const bool two = ti + stride < ntok;
        int rr[2]; rr[0] = tok_row(ti, need_ctx); rr[1] = tok_row(two ? ti + stride : ti, need_ctx);
        unsigned ep[2]; f32v2 gg[2]; unsigned pw[2][8];
#pragma unroll
        for (int t = 0; t < 2; ++t) { const size_t o2 = (size_t)rr[t] * 64 + c.lane;
            ep[t] = C_EI32[o2]; gg[t] = *(const f32v2*)(C_EG + 2 * o2);
#pragma unroll
            for (int jj = 0; jj < 8; ++jj) pw[t][jj] = *(const unsigned*)(C_PART + ((size_t)jj * NR + rr[t]) * 128 + 2 * c.lane); }
        float sua[2], sub_[2], sva[2], svb[2];
#pragma unroll
        for (int t = 0; t < 2; ++t) { const int ea = (int)(ep[t] & 0xffffu), eb = (int)(ep[t] >> 16); sua[t] = C_SU[ea]; sub_[t] = C_SU[eb]; sva[t] = C_SV[ea]; svb[t] = C_SV[eb]; }
#pragma unroll
        for (int t = 0; t < 2; ++t) { float sa = 0.f, sb = 0.f;
#pragma unroll
            for (int jj = 0; jj < 8; ++jj) { sa += bflo(pw[t][jj]); sb += bfhi(pw[t][jj]); }
            if (t == 0 || two) *(unsigned*)(C_WB + 2 * ((size_t)rr[t] * 64 + c.lane)) = cvtpk(gg[t][0] * gelu_tanh(sa * sua[t]) * sva[t], gg[t][1] * gelu_tanh(sb * sub_[t]) * svb[t]); }
    }
}
__device__ __forceinline__ void peer_v_compute(const PeerTok& T, const bf16_t* wl, bf16_t* xo, int grp, int lane) {
    f32v2 acc[8];
#pragma unroll
    for (int q = 0; q < 8; ++q) acc[q] = (f32v2){0.f, 0.f};
#pragma unroll
    for (int u = 0; u < 16; ++u) { const float wv = bf2f(wl[u * 8 + grp]); const f32v2 w2 = {wv, wv};
#pragma unroll
        for (int q = 0; q < 4; ++q) { const unsigned w = T.t[u][q];
            acc[2 * q] = __builtin_elementwise_fma(__builtin_amdgcn_cvt_pk_f32_fp8(w, false), w2, acc[2 * q]);
            acc[2 * q + 1] = __builtin_elementwise_fma(__builtin_amdgcn_cvt_pk_f32_fp8(w, true), w2, acc[2 * q + 1]); } }
    const bool b5 = (lane & 32) != 0, b4 = (lane & 16) != 0, b3 = (lane & 8) != 0;
    f32v2 r4[4], r2[2], r1;
#pragma unroll
    for (int q = 0; q < 4; ++q) { const f32v2 mine = b5 ? acc[4 + q] : acc[q], oth = b5 ? acc[q] : acc[4 + q];
        r4[q] = (f32v2){mine[0] + __shfl_xor(oth[0], 32, 64), mine[1] + __shfl_xor(oth[1], 32, 64)}; }
#pragma unroll
    for (int q = 0; q < 2; ++q) { const f32v2 mine = b4 ? r4[2 + q] : r4[q], oth = b4 ? r4[q] : r4[2 + q];
        r2[q] = (f32v2){mine[0] + __shfl_xor(oth[0], 16, 64), mine[1] + __shfl_xor(oth[1], 16, 64)}; }
    { const f32v2 mine = b3 ? r2[1] : r2[0], oth = b3 ? r2[0] : r2[1]; r1 = (f32v2){mine[0] + __shfl_xor(oth[0], 8, 64), mine[1] + __shfl_xor(oth[1], 8, 64)}; }
    f32v2 xv = {bflo(T.xv), bfhi(T.xv)}; const f32v2 gv = T.gv;
    xv[0] += gv[0] * r1[0]; xv[1] += gv[1] * r1[1];
    *(unsigned*)xo = cvtpk(xv[0], xv[1]);
}
__device__ void peer_v_item(const Ctx& c, int l, int j, int tb, char* lds) {
    const bool need_ctx = (l < DEPTH - 1);
    const int lane = c.lane, sub = lane & 7, grp = lane >> 3;
    unsigned short* els = (unsigned short*)(lds + 20480) + c.wid * 2048;
    bf16_t* wls = (bf16_t*)(lds + 53248) + c.wid * 2048;
    const unsigned char* t8 = C_TV8 + (size_t)j * NEXP * 128 + sub * 16;
    const int tok0 = tb * 128 + c.wid * 16;
    const int col = j * 128 + sub * 16 + ((lane & 32) ? 8 : 0) + ((lane & 16) ? 4 : 0) + ((lane & 8) ? 2 : 0);
    { u32x4 idv[4], wv[4]; const int tl = lane >> 4, pc = (lane & 15) * 8;
#pragma unroll
      for (int q = 0; q < 4; ++q) { const int r = tok_row(tok0 + q * 4 + tl, need_ctx);
          idv[q] = *(const u32x4*)(C_EI + (size_t)r * 128 + pc); wv[q] = *(const u32x4*)(C_WB + (size_t)r * 128 + pc); }
#pragma unroll
      for (int q = 0; q < 4; ++q) { *(u32x4*)(els + (q * 4 + tl) * 128 + pc) = idv[q]; *(u32x4*)(wls + (q * 4 + tl) * 128 + pc) = wv[q]; } }
    asm volatile("" ::: "memory");
    f32v2 gv;
    { const int r0 = tok_row(tok0, need_ctx); const int b0 = r0 / RPB; const bool ctx0 = (r0 - b0 * RPB) < CTX;
      gv = *(const f32v2*)(C_MODT + (size_t)l * 5 * 6144 + 5 * D + col + (size_t)(ctx0 ? 4 : b0) * 6144); }
    PeerTok A, B;
#define VISSUE(T, k_) do { peer_issue16(T, t8, els + (k_) * 128, grp); T.xv = *(const unsigned*)(xrow(c, tok_row(tok0 + (k_), need_ctx)) + col); T.gv = gv; } while (0)
    VISSUE(A, 0);
#pragma unroll 1
    for (int k = 0; k < 16; k += 2) {
        VISSUE(B, k + 1);
        peer_v_compute(A, wls + k * 128, xrow(c, tok_row(tok0 + k, need_ctx)) + col, grp, lane);
        if (k + 2 < 16) VISSUE(A, k + 2);
        peer_v_compute(B, wls + (k + 1) * 128, xrow(c, tok_row(tok0 + k + 1, need_ctx)) + col, grp, lane);
    }
#undef VISSUE
}
template <int SUB>
__device__ void ph_peer_expert(const Ctx& c, int l, char* lds) {
    const bool need_ctx = (l < DEPTH - 1);
    unsigned* cnt = (unsigned*)CWS(WS_CTL) + 4096 + ((l * 2 + SUB) * 8) * 64;
    const int nitem = (need_ctx ? NR : NB * SEQ) / 128;
    const int x = (int)(xb_xcc_id() & 7u);
    volatile int* sh = (volatile int*)(lds + 16384);
    for (int jo = 0; jo < 8; ++jo) { const int j = (x + jo) & 7;
        int nxt = 0;
        if (c.tid == 0) nxt = (int)__hip_atomic_fetch_add(&cnt[j * 64], 1u, __ATOMIC_RELAXED, __HIP_MEMORY_SCOPE_AGENT);
        for (;;) {
            if (c.tid == 0) *sh = nxt;
            __syncthreads(); const int it = *sh; __syncthreads();
            if (it >= nitem) break;
            if (c.tid == 0) nxt = (int)__hip_atomic_fetch_add(&cnt[j * 64], 1u, __ATOMIC_RELAXED, __HIP_MEMORY_SCOPE_AGENT);
            if (SUB == 0) peer_u_item(c, l, j, it, lds); else peer_v_item(c, l, j, it, lds);
        }
    }
}
__device__ void ph_final(const Ctx& c) {
    const float* g = CIN(25);
    const int stride = gridDim.x * 8;
    int r = blockIdx.x * 8 + c.wid;
    auto src_row = [&](int rr) { return xrow(c, (rr >> 13) * RPB + CTX + (rr & (SEQ - 1))); };
    u32x2 xn[4];
    if (r < NB * SEQ) { const bf16_t* src = src_row(r);
#pragma unroll
        for (int i = 0; i < 4; ++i) xn[i] = *(const u32x2*)(src + i * 256 + c.lane * 4); }
    for (; r < NB * SEQ; r += stride) {
        float* xr = COUT + ((size_t)r << 10);
        f32x4 x[4]; float ss = 0.f;
#pragma unroll
        for (int i = 0; i < 4; ++i) { x[i] = (f32x4){bflo(xn[i][0]), bfhi(xn[i][0]), bflo(xn[i][1]), bfhi(xn[i][1])}; ss += x[i][0] * x[i][0] + x[i][1] * x[i][1] + x[i][2] * x[i][2] + x[i][3] * x[i][3]; }
        if (r + stride < NB * SEQ) { const bf16_t* src = src_row(r + stride);
#pragma unroll
            for (int i = 0; i < 4; ++i) xn[i] = *(const u32x2*)(src + i * 256 + c.lane * 4); }
        ss = wave_sum(ss); const float rstd = rsqrtf(ss * (1.f / D) + NORM_EPS);
#pragma unroll
        for (int i = 0; i < 4; ++i) { const int col = i * 256 + c.lane * 4; const f32x4 gv = *(const f32x4*)(g + col); f32x4 y;
#pragma unroll
            for (int e = 0; e < 4; ++e) y[e] = x[i][e] * rstd * gv[e];
            *(f32x4*)(xr + col) = y; }
    }
}

namespace pg8 {
#define PG8_LAS __attribute__((address_space(3)))
typedef unsigned short bf16_t;
typedef short bf16x8 __attribute__((ext_vector_type(8)));
typedef float f32x4 __attribute__((ext_vector_type(4)));
typedef unsigned u32x4 __attribute__((ext_vector_type(4)));
constexpr int BM = 256, BK = 64, HALF = 128, HTB = HALF * BK * 2  , STAGE_BYTES = 8 * HTB, NXCD = 8, WGM = 8;

__host__ __device__ __forceinline__ int lds_byte(int r, int c) { const int st = (r >> 4) * 2 + (c >> 5), rr = r & 15, cc = c & 31, ob = rr * 64 + cc * 2; return st * 1024 + (ob ^ (((ob >> 9) & 1) << 5)); }
__host__ __device__ __forceinline__ void stage_rc(int b, int& R, int& C) { const int st = b / 1024, sb = b % 1024, swz = sb ^ (((sb >> 9) & 1) << 5); R = (st >> 1) * 16 + swz / 64; C = (st & 1) * 32 + (swz % 64) / 2; }
__host__ __device__ __forceinline__ int perm32(int rho) { const int n = rho >> 4, i = rho & 15; return 8 * (i >> 2) + 4 * n + (i & 3); }

struct Unit { int pm, pn; };
struct Gemm { const bf16_t* A; const bf16_t* Bt; int M, N, K; };
struct TileOrder {
    int nM, nN, nwg, G, c; bool skip_ctx;
    __device__ void init(int nM_, int nN_, int G_, int c_, bool skip) { nM = nM_; nN = nN_; nwg = nM_ * nN_; G = G_; c = c_; skip_ctx = skip; }
    __device__ bool next(int i, Unit& u) const {
        const long L = (long)i * G + c; if (L >= nwg) return false;
        int wgid = (int)L; { const int q = nwg / NXCD, r = nwg % NXCD, xcd = wgid % NXCD, off = wgid / NXCD; wgid = (xcd < r ? xcd * (q + 1) : r * (q + 1) + (xcd - r) * q) + off; }
        const int nig = WGM * nN, gid = wgid / nig, fm = gid * WGM, gsz = (nM - fm) < WGM ? (nM - fm) : WGM;
        int pm = fm + ((wgid % nig) % gsz); u.pn = (wgid % nig) / gsz;
        if (skip_ctx) pm = 33 * (pm >> 5) + 1 + (pm & 31);
        u.pm = pm; return true;
    }
    __device__ __forceinline__ void a_ready(const Unit&) const {}
    __device__ __forceinline__ void done(const Unit&) const {}
};
template <class Epi, class Sched, bool STAMP = false>
__device__ __forceinline__ void gemm_phase(PG8_LAS unsigned char* lds, const Gemm g, const Sched& S, const Epi& E, unsigned long long* stamps, int w0) {
    const int tid = mk_tid(w0), wid = w0, lane = tid & 63, wr = wid >> 2, wc = wid & 3, fr = lane & 15, fq = lane >> 4;
    const int K = g.K, nt = K / BK;
    int ts_lo = 0, ts_hi = 0, nts = 0; const unsigned long long rt_entry = STAMP ? (unsigned long long)wall_clock64() : 0ull;
#define PG8_STAMP() do { if (STAMP && wid == 0 && nts < 64) { const unsigned long long _c = (unsigned long long)clock64(); \
        ts_lo = (lane == nts) ? (int)(unsigned)_c : ts_lo; ts_hi = (lane == nts) ? (int)(unsigned)(_c >> 32) : ts_hi; ++nts; } } while (0)
    PG8_STAMP();
    unsigned voffA[2], voffB[2];
#pragma unroll
    for (int i = 0; i < 2; ++i) { int R, C; stage_rc(tid * 16 + i * 8192, R, C); const int Rb = Epi::PERM ? ((R & ~31) + perm32(R & 31)) : R;
        voffA[i] = (unsigned)(R * K + C) * 2u; voffB[i] = (unsigned)(Rb * K + C) * 2u; }
    const size_t kstep = (size_t)(BK * 2);
    const size_t hstep = (size_t)HALF * K * 2;
    const size_t tstep = 2 * hstep;
    const unsigned ldsw = (unsigned)wid * 1024u;
    const int aoff = lds_byte(wr * 64 + fr, fq * 8), boff = lds_byte(wc * 32 + fr, fq * 8);
#define PG8_SA(b, h) (((b) * 2 + (h)) * HTB)
#define PG8_SB(b, h) ((4 + (b) * 2 + (h)) * HTB)
#define PG8_STAGE(bufoff, gbase, voff) do { _Pragma("unroll") for (int _i = 0; _i < 2; ++_i) \
        __builtin_amdgcn_global_load_lds((const unsigned*)((const char*)(gbase) + (voff)[_i]), (PG8_LAS unsigned*)(lds + (bufoff) + ldsw + _i * 8192), 16, 0, 0); } while (0)
#define PG8_LDA(dst, b, h) do { _Pragma("unroll") for (int m = 0; m < 4; ++m) _Pragma("unroll") for (int k = 0; k < 2; ++k) dst[m][k] = *(const PG8_LAS bf16x8*)(lds + PG8_SA(b, h) + aoff + m * 2048 + k * 1024); } while (0)
#define PG8_LDB(dst, b, h) do { _Pragma("unroll") for (int n = 0; n < 2; ++n) _Pragma("unroll") for (int k = 0; k < 2; ++k) dst[n][k] = *(const PG8_LAS bf16x8*)(lds + PG8_SB(b, h) + boff + n * 2048 + k * 1024); } while (0)
#define PG8_MMA(ai, bj, At, Bt) do { __builtin_amdgcn_s_setprio(1); _Pragma("unroll") for (int m = 0; m < 4; ++m) _Pragma("unroll") for (int n = 0; n < 2; ++n) _Pragma("unroll") for (int k = 0; k < 2; ++k) \
        acc[ai][bj][m][n] = __builtin_amdgcn_mfma_f32_16x16x32_bf16(Bt[n][k], At[m][k], acc[ai][bj][m][n], 0, 0, 0); __builtin_amdgcn_s_setprio(0); } while (0)
#define PG8_WAIT_V(n) asm volatile("s_waitcnt vmcnt(" #n ")" ::: "memory")
#define PG8_WAIT_L(n) asm volatile("s_waitcnt lgkmcnt(" #n ")" ::: "memory")
#define PG8_BAR __builtin_amdgcn_s_barrier()
#define PG8_SCHED __builtin_amdgcn_sched_barrier(0)
    Unit cur, nxt; int ui = 0;
    if (!S.next(0, cur)) return;
    f32x4 acc[2][2][4][2];
#pragma unroll
    for (int a = 0; a < 2; ++a)
#pragma unroll
        for (int b = 0; b < 2; ++b)
#pragma unroll
            for (int m = 0; m < 4; ++m)
#pragma unroll
                for (int n = 0; n < 2; ++n) acc[a][b][m][n] = (f32x4){0.f, 0.f, 0.f, 0.f};
    bf16x8 At[4][2], B0[2][2], B1[2][2];
    const char* cA = (const char*)g.A + (size_t)cur.pm * tstep; const char* cB = (const char*)g.Bt + (size_t)cur.pn * tstep;
    S.a_ready(cur);
    PG8_STAGE(PG8_SB(0, 0), cB, voffB); PG8_STAGE(PG8_SA(0, 0), cA, voffA); PG8_STAGE(PG8_SB(0, 1), cB + hstep, voffB); PG8_STAGE(PG8_SA(0, 1), cA + hstep, voffA);
    if (wr == 1) PG8_BAR;
    PG8_WAIT_V(4); PG8_BAR;
    PG8_STAGE(PG8_SB(1, 0), cB + kstep, voffB); PG8_STAGE(PG8_SA(1, 0), cA + kstep, voffA); PG8_STAGE(PG8_SB(1, 1), cB + hstep + kstep, voffB);
    PG8_WAIT_V(6); PG8_BAR;
    PG8_STAMP();
    for (;;) {
        const bool has_next = S.next(ui + 1, nxt);
        const char* nA = has_next ? (const char*)g.A + (size_t)nxt.pm * tstep : cA; const char* nB = has_next ? (const char*)g.Bt + (size_t)nxt.pn * tstep : cB;
        for (int t = 0; t < nt; t += 2) {
            const bool last = (t == nt - 2);
            const char* a1 = cA + (size_t)(t + 1) * kstep;
            const char* a2 = last ? nA : cA + (size_t)(t + 2) * kstep; const char* b2 = last ? nB : cB + (size_t)(t + 2) * kstep;
            const char* a3 = a2 + kstep; const char* b3 = b2 + kstep;
            if (last && has_next) S.a_ready(nxt);
            PG8_LDB(B0, 0, 0); PG8_SCHED; PG8_LDA(At, 0, 0); PG8_STAGE(PG8_SA(1, 1), a1 + hstep, voffA);
            PG8_WAIT_L(8); PG8_BAR; PG8_WAIT_L(0); PG8_MMA(0, 0, At, B0); PG8_BAR; PG8_SCHED;
            PG8_LDB(B1, 0, 1); PG8_STAGE(PG8_SB(0, 0), b2, voffB);
            PG8_BAR; PG8_WAIT_L(0); PG8_MMA(0, 1, At, B1); PG8_BAR;
            PG8_LDA(At, 0, 1); PG8_STAGE(PG8_SA(0, 0), a2, voffA);
            PG8_BAR; PG8_WAIT_L(0); PG8_MMA(1, 0, At, B0); PG8_BAR; PG8_SCHED;
            PG8_STAGE(PG8_SB(0, 1), b2 + hstep, voffB);
            PG8_WAIT_V(6); PG8_BAR; PG8_MMA(1, 1, At, B1); PG8_BAR;
            PG8_LDB(B0, 1, 0); PG8_SCHED; PG8_LDA(At, 1, 0); PG8_STAGE(PG8_SA(0, 1), a2 + hstep, voffA);
            PG8_WAIT_L(8); PG8_BAR; PG8_WAIT_L(0); PG8_MMA(0, 0, At, B0); PG8_BAR; PG8_SCHED;
            PG8_LDB(B1, 1, 1); PG8_STAGE(PG8_SB(1, 0), b3, voffB);
            PG8_BAR; PG8_WAIT_L(0); PG8_MMA(0, 1, At, B1); PG8_BAR;
            PG8_LDA(At, 1, 1); PG8_STAGE(PG8_SA(1, 0), a3, voffA);
            PG8_BAR; PG8_WAIT_L(0); PG8_MMA(1, 0, At, B0); PG8_BAR; PG8_SCHED;
            PG8_STAGE(PG8_SB(1, 1), b3 + hstep, voffB);
            PG8_WAIT_V(6); PG8_BAR; PG8_MMA(1, 1, At, B1); PG8_BAR;
        }
        PG8_STAMP();
        if constexpr (!Epi::AFTER_DRAIN) { E(acc, cur, wr, wc, fr, fq); S.done(cur); }
        PG8_STAMP();
        if (!has_next) break;
#pragma unroll
        for (int a = 0; a < 2; ++a)
#pragma unroll
            for (int b = 0; b < 2; ++b)
#pragma unroll
                for (int m = 0; m < 4; ++m)
#pragma unroll
                    for (int n = 0; n < 2; ++n) acc[a][b][m][n] = (f32x4){0.f, 0.f, 0.f, 0.f};
        cur = nxt; cA = nA; cB = nB; ++ui;
    }
    PG8_WAIT_V(0);
    if (wr == 0) PG8_BAR;
    PG8_BAR;
    if constexpr (Epi::AFTER_DRAIN) { E.fused(acc, cur, wr, wc, fr, fq, lds, wid, lane); S.done(cur); }
    PG8_STAMP();
    if (STAMP && wid == 0) { stamps[lane] = lane < nts ? (((unsigned long long)(unsigned)ts_hi << 32) | (unsigned)ts_lo) : 0ull;
        if (lane == 62) stamps[62] = rt_entry; if (lane == 63) stamps[63] = (unsigned long long)wall_clock64(); }
#undef PG8_STAMP
#undef PG8_SA
#undef PG8_SB
#undef PG8_STAGE
#undef PG8_LDA
#undef PG8_LDB
#undef PG8_MMA
#undef PG8_WAIT_V
#undef PG8_WAIT_L
#undef PG8_BAR
#undef PG8_SCHED
}

struct EpiStoreBf16 {
    static constexpr bool PERM = true, AFTER_DRAIN = false;
    bf16_t* O; int ldc; int ncols; int slo, shi; float scale;
    __device__ __forceinline__ void operator()(const f32x4 (&acc)[2][2][4][2], const Unit& u, int wr, int wc, int fr, int fq) const {
        const int row0 = u.pm * BM + wr * 64 + fr, col0 = u.pn * BM + wc * 32 + 8 * fq;
        float sc[2];
#pragma unroll
        for (int bj = 0; bj < 2; ++bj) { const int cb = u.pn * BM + bj * HALF; sc[bj] = (cb >= slo && cb < shi) ? scale : 1.f; }
#pragma unroll
        for (int ai = 0; ai < 2; ++ai)
#pragma unroll
            for (int m = 0; m < 4; ++m) { bf16_t* rowp = O + (size_t)(row0 + ai * HALF + m * 16) * ldc + col0;
#pragma unroll
                for (int bj = 0; bj < 2; ++bj) if (col0 + bj * HALF < ncols) { const f32x4 v0 = acc[ai][bj][m][0] * sc[bj], v1 = acc[ai][bj][m][1] * sc[bj];
                    u32x4 w; w.x = ::cvtpk(v0[0], v0[1]); w.y = ::cvtpk(v0[2], v0[3]); w.z = ::cvtpk(v1[0], v1[1]); w.w = ::cvtpk(v1[2], v1[3]);
                    *(u32x4*)(rowp + bj * HALF) = w; }
                asm volatile("" ::: "memory"); }
    }
};
struct EpiResidX {
    static constexpr bool PERM = false, AFTER_DRAIN = false;
    bf16_t* xbuf; const float* gate_l;
    __device__ __forceinline__ void operator()(const f32x4 (&acc)[2][2][4][2], const Unit& u, int wr, int wc, int fr, int fq) const {
        const int rowt = u.pm * BM; const int b = rowt / RPB, j0 = rowt - b * RPB; const bool isctx = j0 < CTX;
        bf16_t* xb = xbuf + ((size_t)rowt << 10);
        const float* gt = gate_l + (size_t)(isctx ? 4 : b) * 6144;
        const int r0 = wr * 64 + fr, col0 = u.pn * BM + wc * 32 + 4 * fq;
        f32x4 gv[2][2];
#pragma unroll
        for (int bj = 0; bj < 2; ++bj)
#pragma unroll
            for (int n = 0; n < 2; ++n) gv[bj][n] = *(const f32x4*)(gt + col0 + bj * HALF + n * 16);
#pragma unroll
        for (int ai = 0; ai < 2; ++ai)
#pragma unroll
            for (int m = 0; m < 4; ++m) { bf16_t* rowp = xb + ((size_t)(r0 + ai * HALF + m * 16) << 10) + col0;
#pragma unroll
                for (int bj = 0; bj < 2; ++bj)
#pragma unroll
                    for (int n = 0; n < 2; ++n) { u32x2* p = (u32x2*)(rowp + bj * HALF + n * 16); const u32x2 w = *p; const f32x4 a = gv[bj][n] * acc[ai][bj][m][n];
                        *p = (u32x2){cvtpk(bflo(w[0]) + a[0], bfhi(w[0]) + a[1]), cvtpk(bflo(w[1]) + a[2], bfhi(w[1]) + a[3])}; }
                asm volatile("" ::: "memory"); }
    }
};
}

constexpr int LDS_BYTES = 144 * 1024;
static_assert(TOPK_LDS + 16 <= LDS_BYTES && GEMM_LDS + 16 <= LDS_BYTES && ATT_LDS + 16 <= LDS_BYTES, "LDS budget");
constexpr int PPL = 13;
constexpr int N_PHASES = 1 + PPL * DEPTH + 1;
extern __shared__ __attribute__((aligned(16))) char g_lds[];

#define PHASE_FN __device__ __forceinline__ void
PHASE_FN f_p0(int w0) { const Ctx c = fresh_ctx(w0); ph_p0(c, g_lds); }
PHASE_FN f_norm0(int w0, int l) { const Ctx c = fresh_ctx(w0); ph_norm<0>(c, l); }
PHASE_FN f_norm1(int w0, int l) { const Ctx c = fresh_ctx(w0); ph_norm<1>(c, l); }
PHASE_FN f_gemm_in(int w0, int l) { const Ctx c = fresh_ctx(w0);
    pg8::Gemm g{C_HB, C_WIN + (size_t)l * INC * D, NR, 3328, D};
    pg8::TileOrder S; S.init(132, 13, (int)gridDim.x, (int)blockIdx.x, false);
    pg8::EpiStoreBf16 E{C_P, INC, INC, DF_Q, DF_Q + 256, 0.17677669529663687f * 1.4426950408889634f};
    pg8::gemm_phase<pg8::EpiStoreBf16, pg8::TileOrder>((PG8_LAS unsigned char*)g_lds, g, S, E, nullptr, w0); }
PHASE_FN f_prep(int w0, int l) {
    const Ctx c = fresh_ctx(w0); char* lds = g_lds;
    ph_prep_rows(c, l);
    scan_tables(c, l, lds);
    { const int G = (int)gridDim.x, N = 16 * NCHUNK * 2, R = (N + G - 1) / G;
      for (int q = 0; q < 2 * R; ++q) { const int mx = q & 1; int u = (q >> 1) * G + (int)blockIdx.x; if (u >= N) continue;
        const int dir = u & 1; u >>= 1; const int cc = u % NCHUNK; u /= NCHUNK; const int h = u & 3, b = u >> 2;
        if (mx == 0) scanA_item<0>(c, l, b, h, cc, dir, lds); else scanA_item<1>(c, l, b, h, cc, dir, lds); } }
}
PHASE_FN f_upproj(int w0, int l) {
    const Ctx c = fresh_ctx(w0); char* lds = g_lds;
    EpiBf16 eq{C_QM, 384, 0.10206207261596575f * 1.4426950408889634f}, ekv{C_KVM, 512, 1.f};
    for (int it = blockIdx.x; it < 132 * 7 + 384; it += gridDim.x) {
        if (it < 132 * 7) { const int tm = it / 7, tn = it % 7;
            if (tn < 3) gemm_tile(c, C_P + MLA_CQ, INC, C_WUQ + (size_t)l * 384 * 192, 192, 192, tm * 256, tn * 128, lds, eq);
            else gemm_tile(c, C_P + MLA_CKV, INC, C_WUKV + (size_t)l * 512 * 128, 128, 128, tm * 256, (tn - 3) * 128, lds, ekv); }
        else scanB_item(c, it - 132 * 7); }
}
PHASE_FN f_scanc(int w0, int l) {
    const Ctx c = fresh_ctx(w0); char* lds = g_lds; const bool need_ctx = (l < DEPTH - 1);
    ph_rope_q(c);
    scan_tables(c, l, lds);
    { const int G = (int)gridDim.x, N = 16 * NCHUNK, R = (N + G - 1) / G;
      for (int q = 0; q < 2 * R; ++q) { const int mx = q & 1; int u = (q >> 1) * G + (int)blockIdx.x; if (u >= N) continue;
        const int cc = u % NCHUNK; u /= NCHUNK; const int h = u & 3, b = u >> 2;
        if (cc < 4 && !need_ctx) continue;
        if (mx == 0) scanC_item<0>(c, l, b, h, cc, lds); else scanC_item<1>(c, l, b, h, cc, lds); } }
}
PHASE_FN f_attn(int w0, int l) { const Ctx c = fresh_ctx(w0); ph_attn(c, l, g_lds); }
PHASE_FN f_gemm_out(int w0, int l) {
    const Ctx c = fresh_ctx(w0); const bool need_ctx = (l < DEPTH - 1);
    { pg8::Gemm g{C_HB, C_WOUT + (size_t)l * D * D, NR, D, D};
      pg8::TileOrder S; S.init(need_ctx ? 132 : 128, 4, (int)gridDim.x, (int)blockIdx.x, !need_ctx);
      pg8::EpiResidX E{xrow(c, 0), C_MODT + (size_t)l * 5 * 6144 + 2 * D};
      pg8::gemm_phase<pg8::EpiResidX, pg8::TileOrder>((PG8_LAS unsigned char*)g_lds, g, S, E, nullptr, w0); }
    cvt_tables(c, l);
}
PHASE_FN f_peer_q(int w0, int l) {
    const Ctx c = fresh_ctx(w0); const bool need_ctx = (l < DEPTH - 1);
    pg8::Gemm g{C_HB, C_WQ + (size_t)l * 2048 * D, NR, 2048, D};
    pg8::TileOrder S; S.init(need_ctx ? 132 : 128, 8, (int)gridDim.x, (int)blockIdx.x, !need_ctx);
    pg8::EpiStoreBf16 E{C_Q2, 2048, 2048, 0, 0, 1.f};
    pg8::gemm_phase<pg8::EpiStoreBf16, pg8::TileOrder>((PG8_LAS unsigned char*)g_lds, g, S, E, nullptr, w0);
}
PHASE_FN f_topk(int w0, int l) {
    const Ctx c = fresh_ctx(w0); char* lds = g_lds; const bool need_ctx = (l < DEPTH - 1);
    bf16x8 fbk[1][2][8];
    if ((gridDim.x & 7u) == 0u) {
        topk_load_keys(c, l, (int)(blockIdx.x & 7u), fbk);
        for (int it = blockIdx.x; it < 264 * 8; it += gridDim.x) { const int tm = it >> 3, h = it & 7;
            if ((tm % 66) < 2 && !need_ctx) continue;
            peer_topk_item<true>(c, l, tm, h, lds, fbk); }
    } else {
        for (int it = blockIdx.x; it < 264 * 8; it += gridDim.x) { const int tm = it >> 3, h = it & 7;
            if ((tm % 66) < 2 && !need_ctx) continue;
            peer_topk_item<false>(c, l, tm, h, lds, fbk); }
    }
}
PHASE_FN f_expert_u(int w0, int l) { const Ctx c = fresh_ctx(w0); ph_peer_expert<0>(c, l, g_lds); }
PHASE_FN f_expert_c(int w0, int l) { const Ctx c = fresh_ctx(w0); ph_peer_combine(c, l); }
PHASE_FN f_expert_v(int w0, int l) { const Ctx c = fresh_ctx(w0); ph_peer_expert<1>(c, l, g_lds); }
PHASE_FN f_final(int w0) { const Ctx c = fresh_ctx(w0); ph_final(c); }

__global__ void __launch_bounds__(512, 2) mk_fwd(Params p) {
    volatile LAS unsigned* bst = (volatile LAS unsigned*)(g_lds + LDS_BYTES - 16);
    const bool t0 = threadIdx.x == 0; const int w0 = __builtin_amdgcn_readfirstlane((int)threadIdx.x >> 6);
    if (t0) { bst[0] = 0u; bst[1] = 0u; bst[2] = 0u; bst[3] = 0u; }
    __syncthreads();
    XcdBarrier bar; bar.bar = (unsigned*)(p.ws + WS_CTL); bar.x = 0; bar.st = bst; bar.t0 = t0;
    const int lo = p.ph_lo, hi = p.ph_hi;
    const bool multi = (hi - lo) > 1;
    if (multi) bar = xcd_barrier_post((unsigned*)(p.ws + WS_CTL), bst, t0);
#ifndef PHMASK
#define PHMASK 0xFFFF
#endif
#define EN(s) ((PHMASK >> (s)) & 1)
#define IN(k) (lo <= (k) && (k) < hi)
#define SEAM(k) do { if (IN(k) && IN((k) + 1)) xcd_barrier(bar); } while (0)
    if (EN(0) && IN(0)) f_p0(w0);
    SEAM(0);
#define LAYER(l) do { constexpr int base = 1 + PPL * (l); \
        if (EN(1) && IN(base + 0)) f_norm0(w0, l); SEAM(base + 0); \
        if (EN(2) && IN(base + 1)) f_gemm_in(w0, l); SEAM(base + 1); \
        if (EN(3) && IN(base + 2)) f_prep(w0, l); SEAM(base + 2); \
        if (EN(4) && IN(base + 3)) f_upproj(w0, l); SEAM(base + 3); \
        if (EN(5) && IN(base + 4)) f_scanc(w0, l); SEAM(base + 4); \
        if (EN(6) && IN(base + 5)) f_attn(w0, l); SEAM(base + 5); \
        if (EN(7) && IN(base + 6)) f_gemm_out(w0, l); SEAM(base + 6); \
        if (EN(8) && IN(base + 7)) f_norm1(w0, l); SEAM(base + 7); \
        if (EN(9) && IN(base + 8)) f_peer_q(w0, l); SEAM(base + 8); \
        if (EN(10) && IN(base + 9)) f_topk(w0, l); SEAM(base + 9); \
        if (EN(11) && IN(base + 10)) f_expert_u(w0, l); SEAM(base + 10); \
        if (EN(12) && IN(base + 11)) f_expert_c(w0, l); SEAM(base + 11); \
        if (EN(13) && IN(base + 12)) f_expert_v(w0, l); SEAM(base + 12); } while (0)
    LAYER(0);
    LAYER(1);
#undef LAYER
    if (EN(14) && IN(N_PHASES - 1)) f_final(w0);
#undef IN
#undef SEAM
}

extern "C" void kernel_launch(void* const* d_in, const int* in_sizes, int n_in, void* d_out, int out_size, void* d_ws, size_t ws_size, hipStream_t stream) {
    static int grid = 0;
    if (grid == 0) {
        if (n_in != 26 || in_sizes[0] != NB * SEQ * D || out_size != NB * SEQ * D || ws_size < WS_END) {
            fprintf(stderr, "kernel_launch: shape/workspace mismatch: n_in %d in0 %d out %d ws %zu (need %zu); nothing launched\n", n_in, n_in > 0 ? in_sizes[0] : -1, out_size, ws_size, (size_t)WS_END);
            grid = -1; return; }
        int dev = 0, cus = 0, per_cu = 0;
        if (hipGetDevice(&dev) != hipSuccess || hipDeviceGetAttribute(&cus, hipDeviceAttributeMultiprocessorCount, dev) != hipSuccess) { grid = -1; return; }
        if (hipFuncSetAttribute((const void*)mk_fwd, hipFuncAttributeMaxDynamicSharedMemorySize, LDS_BYTES) != hipSuccess) { fprintf(stderr, "kernel_launch: hipFuncSetAttribute failed\n"); grid = -1; return; }
        if (hipOccupancyMaxActiveBlocksPerMultiprocessor(&per_cu, (const void*)mk_fwd, 512, LDS_BYTES) != hipSuccess || per_cu < 1)
            fprintf(stderr, "kernel_launch: note: occupancy query reports %d workgroups per CU\n", per_cu);
        (void)hipGetLastError();
        grid = cus;
    }
    if (grid < 0) return;
    if (hipMemsetAsync((char*)d_ws + WS_CTL, 0, CTL_BYTES, stream) != hipSuccess) { fprintf(stderr, "kernel_launch: memset failed\n"); return; }
    Params p{};
    for (int i = 0; i < 26; ++i) p.in[i] = (const float*)d_in[i];
    p.out = (float*)d_out; p.ws = (unsigned char*)d_ws;
#if MK_PER_PHASE
    for (int k = 0; k < N_PHASES; ++k) { p.ph_lo = k; p.ph_hi = k + 1; hipLaunchKernelGGL(mk_fwd, dim3(grid), dim3(512), LDS_BYTES, stream, p); }
#else
    p.ph_lo = 0; p.ph_hi = N_PHASES; hipLaunchKernelGGL(mk_fwd, dim3(grid), dim3(512), LDS_BYTES, stream, p);
#endif
    const hipError_t le = hipPeekAtLastError();
    if (le != hipSuccess) fprintf(stderr, "kernel_launch: launch failed: %s\n", hipGetErrorName(le));
}
```
